# Optimizing an MI355X kernel written in HIP

```python
import jax, jax.numpy as jnp
from jax import lax

D_MODEL = 2048
BATCH = 4
SEQ = 2048
DEPTH = 2

BLOCK = 128
ROPE_THETA = 10000.0
NORM_EPS = 1e-6
N_BRANCH = 4

SB_HEADS = 8
SB_DIM = 128
SB_W = SB_HEADS * SB_DIM

RW_HEADS = 16
RW_DIM = 64
RW_W = RW_HEADS * RW_DIM
RW_LORA_W = 96
RW_LORA_A = 96
RW_LORA_G = 64
RW_SIZES = (RW_W, RW_W, RW_W, RW_LORA_W, RW_LORA_A, RW_LORA_G)
RW_IN = 3 * RW_W + RW_LORA_W + RW_LORA_A + RW_LORA_G
RW_GN_EPS = 64e-5

DSA_HEADS = 8
DSA_DIM = 128
DSA_W = DSA_HEADS * DSA_DIM
DSA_KV_RANK = 256
IDX_HEADS = 16
IDX_DIM = 64
IDX_TOPK_MAX = 256

SW_HEADS = 16
SW_KV_HEADS = 2
SW_DIM = 64
SW_W = SW_HEADS * SW_DIM
WINDOW = 128

BRANCH_W = 1024

IN_SIZES = (SB_W, SB_W, SB_W,
            RW_IN,
            DSA_W, DSA_KV_RANK, IDX_HEADS * IDX_DIM, IDX_DIM, IDX_HEADS,
            SW_W, SW_KV_HEADS * SW_DIM, SW_KV_HEADS * SW_DIM,
            N_BRANCH * D_MODEL)
N_IN = 3 * SB_W + RW_IN + DSA_W + DSA_KV_RANK + IDX_HEADS * IDX_DIM + IDX_DIM + IDX_HEADS + SW_W + 2 * SW_KV_HEADS * SW_DIM + N_BRANCH * D_MODEL

FFN_DENSE = 7168
N_EXPERTS = 8
TOP_K = 2
FFN_EXPERT = 7168
PLE_DIM = 256
N_DENSE_LAYERS = (DEPTH + 1) // 2
N_MOE_LAYERS = DEPTH // 2

kernel_name = 'hybrid_gated_sb_rwkv7_dsa_swa_moe'


def rms_norm(x, gain, eps=NORM_EPS):
    xf = x.astype(jnp.float32)
    xf = xf * lax.rsqrt(jnp.mean(xf * xf, axis=-1, keepdims=True) + eps)
    return (xf * gain.astype(jnp.float32)).astype(x.dtype)


def split_cols(u, sizes):
    parts, start = [], 0
    for size in sizes:
        parts.append(u[..., start:start + size])
        start += size
    return parts


def split_heads(u, n_heads):
    return u.reshape(u.shape[0], u.shape[1], n_heads, u.shape[-1] // n_heads)


def rope(u, positions):
    half = u.shape[-1] // 2
    inv_freq = ROPE_THETA ** (-jnp.arange(half, dtype=jnp.float32) / half)
    ang = positions.astype(jnp.float32)[..., None] * inv_freq
    cos = jnp.cos(ang)[:, :, None, :]
    sin = jnp.sin(ang)[:, :, None, :]
    uf = u.astype(jnp.float32)
    u1, u2 = uf[..., :half], uf[..., half:]
    return jnp.concatenate([u1 * cos - u2 * sin, u2 * cos + u1 * sin], axis=-1).astype(u.dtype)


def to_blocks(u):
    b, s = u.shape[:2]
    return u.reshape((b, s // BLOCK, BLOCK) + u.shape[2:]).swapaxes(0, 1)


def from_blocks(u):
    nb, b = u.shape[:2]
    return u.swapaxes(0, 1).reshape((b, nb * BLOCK) + u.shape[3:])


def token_shift(u):
    return jnp.pad(u, ((0, 0), (1, 0), (0, 0)))[:, :-1]


def stick_breaking_attention(q, k, v):
    b, s, _, dh = q.shape
    scale = dh ** -0.5
    key_pos = jnp.arange(s)

    def one_block(args):
        q_b, start = args
        z = jnp.einsum('bqhd,bshd->bhqs', q_b, k).astype(jnp.float32) * scale
        q_pos = start + jnp.arange(BLOCK)
        before = key_pos[None, :] < q_pos[:, None]
        log_keep = jnp.where(before, jax.nn.log_sigmoid(-z), 0.0)
        log_between = lax.cumsum(log_keep, axis=3, reverse=True) - log_keep
        w = jnp.where(before, jnp.exp(jax.nn.log_sigmoid(z) + log_between), 0.0)
        return jnp.einsum('bhqs,bshd->bqhd', w.astype(v.dtype), v)

    starts = jnp.arange(s // BLOCK) * BLOCK
    out = lax.map(one_block, (to_blocks(q), starts))
    return from_blocks(out).reshape(b, s, SB_W)


def rwkv7_time_mix(u, mu, w0, w2, a0, a2, g2, k_k, k_a, r_k, ln_g, ln_b):
    b, s, _ = u.shape
    f32 = jnp.float32
    u = u + mu * (token_shift(u) - u)
    r, k, v, w_lo, a_lo, g_lo = split_cols(u, RW_SIZES)
    w_log = -jax.nn.softplus(-(w0 + jnp.tanh(w_lo) @ w2)) - 0.5
    decay = jnp.exp(-jnp.exp(w_log.astype(f32)))
    a = jax.nn.sigmoid(a0 + a_lo @ a2)
    g = jax.nn.sigmoid(g_lo) @ g2
    kk = split_heads((k * k_k).astype(f32), RW_HEADS)
    kk = kk / jnp.maximum(jnp.sqrt(jnp.sum(kk * kk, axis=-1, keepdims=True)), 1e-12)
    k = k * (1.0 + (a - 1.0) * k_a)
    r_h, k_h, v_h, w_h, a_h = [split_heads(t.astype(f32), RW_HEADS) for t in (r, k, v, decay, a)]

    def step(state, inp):
        r_t, w_t, k_t, v_t, kk_t, a_t = inp
        s_kk = jnp.einsum('bhvk,bhk->bhv', state, kk_t)
        state = (state * w_t[:, :, None, :]
                 - s_kk[..., None] * (kk_t * a_t)[:, :, None, :]
                 + v_t[..., None] * k_t[:, :, None, :])
        return state, jnp.einsum('bhvk,bhk->bhv', state, r_t)

    state0 = jnp.zeros((b, RW_HEADS, RW_DIM, RW_DIM), f32)
    xs = tuple(t.swapaxes(0, 1) for t in (r_h, w_h, k_h, v_h, kk, a_h))
    _, y = lax.scan(step, state0, xs)
    y = y.swapaxes(0, 1)
    mean = jnp.mean(y, axis=-1, keepdims=True)
    var = jnp.mean(jnp.square(y - mean), axis=-1, keepdims=True)
    y = ((y - mean) * lax.rsqrt(var + RW_GN_EPS) * ln_g.astype(f32).reshape(RW_HEADS, RW_DIM)
         + ln_b.astype(f32).reshape(RW_HEADS, RW_DIM))
    bonus = jnp.sum(r_h * k_h * r_k.astype(f32), axis=-1, keepdims=True) * v_h
    return (y + bonus).reshape(b, s, RW_W).astype(u.dtype) * g


def dsa_attention(q, c_kv, q_idx, k_idx, w_idx, positions, q_gain, k_gain, kv_gain, w_uk, w_uv):
    b, s, _ = q.shape
    f32 = jnp.float32
    q = rope(rms_norm(split_heads(q, DSA_HEADS), q_gain), positions)
    c = rms_norm(c_kv, kv_gain)
    k = rope(rms_norm(c @ w_uk, k_gain)[:, :, None, :], positions)[:, :, 0]
    v = c @ w_uv
    q_idx = rope(split_heads(q_idx, IDX_HEADS), positions)
    k_idx = rope(k_idx[:, :, None, :], positions)[:, :, 0]
    w_idx = w_idx * (IDX_HEADS ** -0.5 * IDX_DIM ** -0.5)
    top_k = min(IDX_TOPK_MAX, s // 4)
    key_pos = jnp.arange(s)
    gather = jax.vmap(lambda table, idx: table[idx])

    def one_block(args):
        q_b, qi_b, wi_b, start = args
        q_pos = start + jnp.arange(BLOCK)
        causal = key_pos[None, :] <= q_pos[:, None]
        score = jax.nn.relu(jnp.einsum('bqhd,bsd->bqhs', qi_b, k_idx))
        score = jnp.einsum('bqhs,bqh->bqs', score, wi_b).astype(f32)
        score = jnp.where(causal[None], score, -jnp.inf)
        _, sel = lax.top_k(score, top_k)
        valid = sel <= q_pos[None, :, None]
        k_sel = gather(k, sel)
        v_sel = gather(v, sel)
        logits = jnp.einsum('bqhd,bqkd->bqhk', q_b, k_sel).astype(f32) * DSA_DIM ** -0.5
        logits = jnp.where(valid[:, :, None, :], logits, -jnp.inf)
        prob = jax.nn.softmax(logits, axis=-1)
        return jnp.einsum('bqhk,bqkd->bqhd', prob.astype(v.dtype), v_sel)

    starts = jnp.arange(s // BLOCK) * BLOCK
    out = lax.map(one_block, (to_blocks(q), to_blocks(q_idx), to_blocks(w_idx), starts))
    return from_blocks(out).reshape(b, s, DSA_W)


def sliding_window_attention(q, k, v, positions, q_gain, k_gain, sinks):
    b, s = q.shape[:2]
    nb = s // BLOCK
    grp = SW_HEADS // SW_KV_HEADS
    f32 = jnp.float32
    q = rope(rms_norm(q, q_gain), positions)
    k = rope(rms_norm(k, k_gain), positions)
    q_b = q.reshape(b, nb, BLOCK, SW_KV_HEADS, grp, SW_DIM)
    k_b = k.reshape(b, nb, BLOCK, SW_KV_HEADS, SW_DIM)
    v_b = v.reshape(b, nb, BLOCK, SW_KV_HEADS, SW_DIM)
    prev = lambda t: jnp.pad(t, ((0, 0), (1, 0), (0, 0), (0, 0), (0, 0)))[:, :-1]
    k_cat = jnp.concatenate([prev(k_b), k_b], axis=2)
    v_cat = jnp.concatenate([prev(v_b), v_b], axis=2)
    q_off = jnp.arange(BLOCK)
    k_off = jnp.arange(2 * BLOCK) - BLOCK
    dist = q_off[:, None] - k_off[None, :]
    band = (dist >= 0) & (dist < WINDOW)
    in_seq = (jnp.arange(nb)[:, None] * BLOCK + k_off[None, :]) >= 0
    mask = band[None] & in_seq[:, None, :]
    logits = jnp.einsum('bnqkgd,bnskd->bnkgqs', q_b, k_cat).astype(f32) * SW_DIM ** -0.5
    logits = jnp.where(mask[None, :, None, None], logits, -jnp.inf)
    sink = jnp.broadcast_to(sinks.astype(f32).reshape(SW_KV_HEADS, grp)[None, None, :, :, None, None],
                            logits.shape[:-1] + (1,))
    prob = jax.nn.softmax(jnp.concatenate([logits, sink], axis=-1), axis=-1)[..., :-1]
    out = jnp.einsum('bnkgqs,bnskd->bnqkgd', prob.astype(v.dtype), v_cat)
    return out.reshape(b, s, SW_W)


def swiglu(h, w_gate, w_up, w_down):
    return (jax.nn.silu(h @ w_gate) * (h @ w_up)) @ w_down


def moe_swiglu(h, router, w_gate, w_up, w_down):
    logits = (h @ router).astype(jnp.float32)
    top_val, top_idx = lax.top_k(logits, TOP_K)
    top_w = jax.nn.softmax(top_val, axis=-1)
    combine = jnp.sum(jax.nn.one_hot(top_idx, N_EXPERTS, dtype=jnp.float32) * top_w[..., None], axis=-2)
    combine = combine.astype(h.dtype)
    out = jnp.zeros_like(h)
    for e in range(N_EXPERTS):
        out = out + combine[..., e:e + 1] * swiglu(h, w_gate[e], w_up[e], w_down[e])
    return out


def setup_inputs(seed: int = 0) -> dict:
    key = jax.random.key(seed)
    ks = iter(jax.random.split(key, 48))
    f32 = jnp.float32
    L = DEPTH

    def normal(shape, scale):
        return jax.random.normal(next(ks), shape, f32) * scale

    def gain(shape):
        return 1.0 + normal(shape, 0.05)

    return {
        'x': normal((BATCH, SEQ, D_MODEL), 1.0),
        'p': normal((L, BATCH, SEQ, PLE_DIM), 1.0),
        'positions': (jax.random.randint(next(ks), (BATCH, 1), 0, 1024) + jnp.arange(SEQ)[None, :]).astype(jnp.int32),
        'w_in': normal((L, D_MODEL, N_IN), D_MODEL ** -0.5),
        'mix_norm': gain((L, D_MODEL)),
        'ffn_norm': gain((L, D_MODEL)),
        'ple_norm': gain((L, D_MODEL)),
        'rw_mu': jax.random.uniform(next(ks), (L, RW_IN), f32),
        'rw_w0': -1.5 + normal((L, RW_W), 0.5),
        'rw_w2': normal((L, RW_LORA_W, RW_W), 0.5 * RW_LORA_W ** -0.5),
        'rw_a0': normal((L, RW_W), 0.1),
        'rw_a2': normal((L, RW_LORA_A, RW_W), 0.5 * RW_LORA_A ** -0.5),
        'rw_g2': normal((L, RW_LORA_G, RW_W), RW_LORA_G ** -0.5),
        'rw_kk': 0.85 + normal((L, RW_W), 0.05),
        'rw_ka': gain((L, RW_W)),
        'rw_rk': normal((L, RW_HEADS, RW_DIM), 0.1),
        'rw_ln_g': gain((L, RW_W)),
        'rw_ln_b': normal((L, RW_W), 0.01),
        'dsa_q_norm': gain((L, DSA_DIM)),
        'dsa_k_norm': gain((L, DSA_DIM)),
        'dsa_kv_norm': gain((L, DSA_KV_RANK)),
        'dsa_w_uk': normal((L, DSA_KV_RANK, DSA_DIM), DSA_KV_RANK ** -0.5),
        'dsa_w_uv': normal((L, DSA_KV_RANK, DSA_DIM), DSA_KV_RANK ** -0.5),
        'sw_q_norm': gain((L, SW_DIM)),
        'sw_k_norm': gain((L, SW_DIM)),
        'sw_sinks': normal((L, SW_HEADS), 1.0),
        'w_branch': normal((L, N_BRANCH, BRANCH_W, D_MODEL), BRANCH_W ** -0.5),
        'w_out': normal((L, D_MODEL, D_MODEL), D_MODEL ** -0.5),
        'ffn_w_gate': normal((N_DENSE_LAYERS, D_MODEL, FFN_DENSE), D_MODEL ** -0.5),
        'ffn_w_up': normal((N_DENSE_LAYERS, D_MODEL, FFN_DENSE), D_MODEL ** -0.5),
        'ffn_w_down': normal((N_DENSE_LAYERS, FFN_DENSE, D_MODEL), FFN_DENSE ** -0.5),
        'moe_router': normal((N_MOE_LAYERS, D_MODEL, N_EXPERTS), D_MODEL ** -0.5),
        'moe_w_gate': normal((N_MOE_LAYERS, N_EXPERTS, D_MODEL, FFN_EXPERT), D_MODEL ** -0.5),
        'moe_w_up': normal((N_MOE_LAYERS, N_EXPERTS, D_MODEL, FFN_EXPERT), D_MODEL ** -0.5),
        'moe_w_down': normal((N_MOE_LAYERS, N_EXPERTS, FFN_EXPERT, D_MODEL), FFN_EXPERT ** -0.5),
        'ple_w_gate': normal((L, D_MODEL, D_MODEL), D_MODEL ** -0.5),
        'ple_w_proj': normal((L, PLE_DIM, D_MODEL), PLE_DIM ** -0.5),
    }


def reference(x, p, positions, w_in, mix_norm, ffn_norm, ple_norm,
              rw_mu, rw_w0, rw_w2, rw_a0, rw_a2, rw_g2, rw_kk, rw_ka, rw_rk, rw_ln_g, rw_ln_b,
              dsa_q_norm, dsa_k_norm, dsa_kv_norm, dsa_w_uk, dsa_w_uv,
              sw_q_norm, sw_k_norm, sw_sinks,
              w_branch, w_out,
              ffn_w_gate, ffn_w_up, ffn_w_down,
              moe_router, moe_w_gate, moe_w_up, moe_w_down,
              ple_w_gate, ple_w_proj):
    b, s, _ = x.shape
    for i in range(DEPTH):
        h = rms_norm(x, mix_norm[i])
        (sb_q, sb_k, sb_v, rw_cols, dsa_q, dsa_ckv, idx_q, idx_k, idx_w,
         sw_q, sw_k, sw_v, gate_cols) = split_cols(h @ w_in[i], IN_SIZES)
        y_a = stick_breaking_attention(split_heads(sb_q, SB_HEADS), split_heads(sb_k, SB_HEADS),
                                       split_heads(sb_v, SB_HEADS))
        y_b = rwkv7_time_mix(rw_cols, rw_mu[i], rw_w0[i], rw_w2[i], rw_a0[i], rw_a2[i], rw_g2[i],
                             rw_kk[i], rw_ka[i], rw_rk[i], rw_ln_g[i], rw_ln_b[i])
        y_c = dsa_attention(dsa_q, dsa_ckv, idx_q, idx_k, idx_w, positions,
                            dsa_q_norm[i], dsa_k_norm[i], dsa_kv_norm[i], dsa_w_uk[i], dsa_w_uv[i])
        y_d = sliding_window_attention(split_heads(sw_q, SW_HEADS), split_heads(sw_k, SW_KV_HEADS),
                                       split_heads(sw_v, SW_KV_HEADS), positions,
                                       sw_q_norm[i], sw_k_norm[i], sw_sinks[i])
        branches = jnp.stack([y_a, y_b, y_c, y_d], axis=2)
        gates = jax.nn.sigmoid(gate_cols.reshape(b, s, N_BRANCH, D_MODEL))
        up = jnp.einsum('bsnc,ncd->bsnd', branches, w_branch[i])
        x = x + jnp.sum(gates * up, axis=2) @ w_out[i]
        h = rms_norm(x, ffn_norm[i])
        if i % 2 == 0:
            x = x + swiglu(h, ffn_w_gate[i // 2], ffn_w_up[i // 2], ffn_w_down[i // 2])
        else:
            x = x + moe_swiglu(h, moe_router[i // 2], moe_w_gate[i // 2], moe_w_up[i // 2], moe_w_down[i // 2])
        hp = rms_norm(x, ple_norm[i])
        x = x + jax.nn.sigmoid(hp @ ple_w_gate[i]) * (p[i] @ ple_w_proj[i])
    return x
```

```cpp
#define MK_ONE_LAUNCH 1
#define CONV_NT 0
#include <hip/hip_runtime.h>
#include <cstdio>
#include <cstdint>

#define LAS __attribute__((address_space(3)))
#define GAS __attribute__((address_space(1)))
#define GLB __attribute__((address_space(1)))
typedef unsigned short bf16_t;
typedef short bf16x8 __attribute__((ext_vector_type(8)));
typedef float f32x4 __attribute__((ext_vector_type(4)));
typedef float f32x2 __attribute__((ext_vector_type(2)));
typedef unsigned u32x4 __attribute__((ext_vector_type(4)));
typedef unsigned u32x2 __attribute__((ext_vector_type(2)));

constexpr int NB = 4, SEQ = 2048, T = NB * SEQ, D = 2048, NL = 2;
constexpr int N_IN = 18256, N_INP = 18432, FF = 7168, NE = 8;
constexpr int UFW = 7168;
constexpr int UF_RW = 0, UF_DQ = 3328, UF_CKV = 4352, UF_IQ = 4608, UF_SQ = 5632, UF_SK = 6656, UF_SV = 6784, UF_IK = 6912, UF_IW = 6976;
constexpr int MOE_ROWS = 18432, MOE_MAXRT = 72, NCT_UP = 56, NCT_DN = 8;
constexpr int NWAVES = 8, NTHR = 512;

constexpr size_t WS_CTL = 0, CTL_BYTES = 1u << 20;
constexpr size_t SZ_WIN1 = (size_t)N_INP * D * 2, SZ_WBR1 = (size_t)4 * 2048 * 1024 * 2, SZ_DD = (size_t)D * D * 2;
constexpr size_t SZ_WGU1 = (size_t)2 * FF * D * 2, SZ_WD1 = (size_t)D * FF * 2, SZ_WLORA1 = (size_t)3072 * 256 * 2;
constexpr size_t WS_WIN = CTL_BYTES;
constexpr size_t WS_WBR = WS_WIN + NL * SZ_WIN1;
constexpr size_t WS_WOUT = WS_WBR + NL * SZ_WBR1;
constexpr size_t WS_WGU = WS_WOUT + NL * SZ_DD;
constexpr size_t WS_WD = WS_WGU + SZ_WGU1;
constexpr size_t WS_MWGU = WS_WD + SZ_WD1;
constexpr size_t WS_MWD = WS_MWGU + NE * SZ_WGU1;
constexpr size_t WS_WPG = WS_MWD + NE * SZ_WD1;
constexpr size_t WS_WPP = WS_WPG + NL * SZ_DD;
constexpr size_t WS_WLORA = WS_WPP + (size_t)NL * D * 256 * 2;
constexpr size_t WS_H = WS_WLORA + NL * SZ_WLORA1;
constexpr size_t WS_PCAT = WS_H + (size_t)T * D * 2;
constexpr size_t WS_PROJ = WS_PCAT + (size_t)T * 512 * 2;
constexpr size_t WS_ROUTE = WS_PROJ + (size_t)NL * T * D * 2;
constexpr size_t WS_TOKSLOT = WS_ROUTE + (size_t)T * 32;
constexpr size_t WS_WSLOT = WS_TOKSLOT + (size_t)T * 8;
constexpr size_t WS_ACT0 = WS_WSLOT + (size_t)MOE_ROWS * 4 + 256 * 30;
constexpr size_t SZ_T1K = (size_t)T * 1024 * 4;
constexpr size_t WS_SBQKV = (WS_ACT0 + 255) & ~(size_t)255;
constexpr size_t WS_GATE = WS_SBQKV + (size_t)T * 3072 * 2;
constexpr size_t WS_UF = WS_GATE + (size_t)T * 8192 * 2;
constexpr size_t WS_Y = WS_UF;
constexpr size_t WS_GSUM = WS_Y + (size_t)T * 4096 * 2;
constexpr size_t WS_G = WS_GSUM + (size_t)T * 2048 * 4;
constexpr size_t WS_YRAW = WS_G + (size_t)T * 2048 * 2;
constexpr size_t WS_RW = WS_UF + (size_t)T * UFW * 4;
static_assert(WS_YRAW + SZ_T1K <= WS_RW, "UF aliases");
constexpr size_t WS_R = WS_RW, WS_K = WS_RW + SZ_T1K, WS_V = WS_RW + 2 * SZ_T1K, WS_DEC = WS_RW + 3 * SZ_T1K, WS_AA = WS_RW + 4 * SZ_T1K, WS_KK = WS_RW + 5 * SZ_T1K, WS_GG = WS_RW + 6 * SZ_T1K;
constexpr size_t WS_ALORA = WS_RW + 7 * SZ_T1K;
constexpr size_t WS_QD = WS_ALORA + (size_t)T * 256 * 2;
constexpr size_t WS_KD = WS_QD + (size_t)T * 1024 * 2;
constexpr size_t WS_VD = WS_KD + (size_t)T * 128 * 2;
constexpr size_t WS_QI = WS_VD + (size_t)T * 128 * 2;
constexpr size_t WS_KI = WS_QI + (size_t)T * 1024 * 2;
constexpr size_t WS_WI = WS_KI + (size_t)T * 64 * 2;
constexpr size_t WS_QS = WS_WI + (size_t)T * 16 * 4;
constexpr size_t WS_KS = WS_QS + (size_t)T * 1024 * 2;
constexpr size_t WS_VS = WS_KS + (size_t)T * 128 * 2;
constexpr size_t WS_MIX_END = WS_VS + (size_t)T * 128 * 2;
constexpr size_t WS_ACT = WS_SBQKV;
constexpr size_t WS_HS = WS_SBQKV;
constexpr size_t WS_ACTS = WS_HS + (size_t)MOE_ROWS * D * 2;
constexpr size_t WS_OS = WS_ACTS + (size_t)MOE_ROWS * FF * 2;
constexpr size_t WS_OSP = WS_OS + (size_t)MOE_ROWS * D * 4;
constexpr size_t WS_FFN_END = WS_OSP + (size_t)256 * 65536 * 4;
constexpr size_t WS_END = WS_MIX_END > WS_FFN_END ? WS_MIX_END : WS_FFN_END;
static_assert(WS_END < (size_t)2000 * 1000 * 1000, "workspace budget");

constexpr int CW_BAR = 4096;
constexpr int CW_MOECNT = 8192;

constexpr int RING_BYTES = 131072;
constexpr int MISC_OFF = 143360;
constexpr int LDS_BYTES = 147456;

#define LDS_WAIT() asm volatile("s_waitcnt lgkmcnt(0)" ::: "memory")
#define VM_WAIT() asm volatile("s_waitcnt vmcnt(0)" ::: "memory")
__device__ __forceinline__ float bflo(unsigned u) { return __builtin_bit_cast(float, u << 16); }
__device__ __forceinline__ float bfhi(unsigned u) { return __builtin_bit_cast(float, u & 0xffff0000u); }
__device__ __forceinline__ float bf1(bf16_t u) { return __builtin_bit_cast(float, (unsigned)u << 16); }
__device__ __forceinline__ unsigned f2bf(float f) { unsigned u = __builtin_bit_cast(unsigned, f); return (u + 0x7fffu + ((u >> 16) & 1u)) >> 16; }
typedef __bf16 bf16x2v __attribute__((ext_vector_type(2)));
__device__ __forceinline__ unsigned pk2(float lo, float hi) { const f32x2 v = {lo, hi}; return __builtin_bit_cast(unsigned, __builtin_convertvector(v, bf16x2v)); }
__device__ __forceinline__ float wave_sum(float v) {
#pragma unroll
    for (int o = 1; o < 64; o <<= 1) v += __shfl_xor(v, o);
    return v;
}
__device__ __forceinline__ float wave_max(float v) {
#pragma unroll
    for (int o = 1; o < 64; o <<= 1) v = fmaxf(v, __shfl_xor(v, o));
    return v;
}
__device__ __forceinline__ float sigmoidf_(float x) { return __builtin_amdgcn_rcpf(1.0f + __builtin_amdgcn_exp2f(-1.4426950408889634f * x)); }
__device__ __forceinline__ float logsigf_(float x) { return fminf(x, 0.f) - __logf(1.0f + __expf(-fabsf(x))); }
__device__ __forceinline__ float rdlane(float v, int l) { return __builtin_bit_cast(float, __builtin_amdgcn_readlane(__builtin_bit_cast(int, v), l)); }

#define XB_TMO      128
#define XB_XCNT(j)  (256  + 64 * (j))
#define XB_XSUB(j)  (1280 + 64 * (j))
#define XB_XGEN(j)  (2304 + 64 * (j))
#define XB_TOP      3328
#define XB_TOPGEN   3392
#define XCD_BAR_WORDS 3456
#define XB_SPIN_CAP (1u << 18)
__device__ __forceinline__ unsigned xb_ld(unsigned* p)              { return __hip_atomic_load(p, __ATOMIC_RELAXED, __HIP_MEMORY_SCOPE_AGENT); }
__device__ __forceinline__ unsigned xb_add(unsigned* p, unsigned v) { return __hip_atomic_fetch_add(p, v, __ATOMIC_RELAXED, __HIP_MEMORY_SCOPE_AGENT); }
__device__ __forceinline__ unsigned xb_xcc_id() { return (unsigned)__builtin_amdgcn_s_getreg((3 << 11) | 20) & 0xFu; }
#define XB_SPIN(cond, bar) do { unsigned _sp = 0; while (cond) { __builtin_amdgcn_s_sleep(1); \
    if ((++_sp & 255u) == 0u) { if (xb_ld(&(bar)[XB_TMO])) break; if (_sp > XB_SPIN_CAP) { atomicAdd(&(bar)[XB_TMO], 1u); break; } } } } while (0)
struct XcdBarrier { unsigned* bar; unsigned x; volatile LAS unsigned* st; };
__device__ __forceinline__ XcdBarrier xcd_barrier_post(unsigned* bar, volatile LAS unsigned* st) {
    XcdBarrier b; b.bar = bar; b.x = xb_xcc_id(); b.st = st;
    if (threadIdx.x == 0) (void)xb_add(&bar[XB_XCNT(b.x)], 1u);
    return b;
}
__device__ __forceinline__ void xcd_barrier_complete(unsigned* bar, unsigned x, unsigned& nloc, unsigned& nx) {
    const unsigned G = gridDim.x * gridDim.y * gridDim.z;
    unsigned sum, cnt, mine, sp = 0u;
    for (;;) {
        sum = 0u; cnt = 0u; mine = 0u;
#pragma unroll
        for (unsigned j = 0; j < 16; ++j) { const unsigned c = xb_ld(&bar[XB_XCNT(j)]); sum += c; cnt += (c > 0u) ? 1u : 0u; mine = (j == x) ? c : mine; }
        if (sum == G) break;
        __builtin_amdgcn_s_sleep(1);
        if ((++sp & 255u) == 0u) { if (xb_ld(&bar[XB_TMO])) break; if (sp > XB_SPIN_CAP) { atomicAdd(&bar[XB_TMO], 1u); break; } }
    }
    nloc = mine > 0u ? mine : 1u; nx = cnt > 0u ? cnt : 1u;
}
__device__ __forceinline__ void xcd_barrier(const XcdBarrier& b) {
    asm volatile("s_waitcnt vmcnt(0)" ::: "memory");
    __syncthreads();
    if (threadIdx.x == 0) {
        unsigned* bar = b.bar;
        __builtin_amdgcn_s_waitcnt(0);
        unsigned nloc = b.st[0], nx = b.st[1];
        if (nloc == 0u) { xcd_barrier_complete(bar, b.x, nloc, nx); b.st[0] = nloc; b.st[1] = nx; }
        const unsigned old = xb_add(&bar[XB_XSUB(b.x)], 1u);
        const unsigned gen = old / nloc;
        if (old + 1u == (gen + 1u) * nloc) {
            __builtin_amdgcn_fence(__ATOMIC_RELEASE, "agent");
            asm volatile("s_waitcnt vmcnt(0)" ::: "memory");
            const unsigned og = xb_add(&bar[XB_TOP], 1u);
            const unsigned tg = og / nx;
            if (og + 1u == (tg + 1u) * nx) xb_add(&bar[XB_TOPGEN], 1u);
            else XB_SPIN(xb_ld(&bar[XB_TOPGEN]) == tg, bar);
            __builtin_amdgcn_fence(__ATOMIC_ACQUIRE, "agent");
            xb_add(&bar[XB_XGEN(b.x)], 1u);
            asm volatile("s_waitcnt vmcnt(0)" ::: "memory");
        } else {
            XB_SPIN(xb_ld(&bar[XB_XGEN(b.x)]) == gen, bar);
            __builtin_amdgcn_fence(__ATOMIC_ACQUIRE, "agent");
            asm volatile("s_waitcnt vmcnt(0)" ::: "memory");
        }
    }
    __syncthreads();
}
namespace pg8 {
#define PG8_LAS __attribute__((address_space(3)))
#ifndef PG8_WGM
#define PG8_WGM 4
#endif
constexpr int BM = 256, BK = 64, HALF = 128, HTB = HALF * BK * 2, STAGE_BYTES = 8 * HTB, NXCD = 8, WGM = PG8_WGM;
__host__ __device__ __forceinline__ int lds_byte(int r, int c) { const int st = (r >> 4) * 2 + (c >> 5), rr = r & 15, cc = c & 31, ob = rr * 64 + cc * 2; return st * 1024 + (ob ^ (((ob >> 9) & 1) << 5)); }
__host__ __device__ __forceinline__ void stage_rc(int b, int& R, int& C) { const int st = b / 1024, sb = b % 1024, swz = sb ^ (((sb >> 9) & 1) << 5); R = (st >> 1) * 16 + swz / 64; C = (st & 1) * 32 + (swz % 64) / 2; }
__host__ __device__ __forceinline__ int perm32(int rho) { const int n = rho >> 4, i = rho & 15; return 8 * (i >> 2) + 4 * n + (i & 3); }

struct Unit { int pm, pn, ka, kb, nt, aux; };
struct Gemm { const GLB bf16_t* A; const GLB bf16_t* Bt; int lda, K; };

struct StaticOrder {
    int nM, nN, nwg, G, c;
    __device__ __forceinline__ void init(int M, int N, int G_, int c_) { nM = M / BM; nN = N / BM; nwg = nM * nN; G = G_; c = c_; }
    __device__ __forceinline__ bool tile(long L, Unit& u) const {
        if (L >= nwg) return false;
        int wgid = (int)L; { const int q = nwg / NXCD, r = nwg % NXCD, xcd = wgid % NXCD, off = wgid / NXCD; wgid = (xcd < r ? xcd * (q + 1) : r * (q + 1) + (xcd - r) * q) + off; }
        const int nig = WGM * nN, gid = wgid / nig, fm = gid * WGM, gsz = (nM - fm) < WGM ? (nM - fm) : WGM;
        u.pm = fm + ((wgid % nig) % gsz); u.pn = (wgid % nig) / gsz; u.ka = 0; u.kb = 0; u.nt = 0; u.aux = 0; return true;
    }
    __device__ __forceinline__ bool next(int i, Unit& u) const { return tile((long)i * G + c, u); }
};
struct BranchOrder {
    int G, c, cnt;
    __device__ __forceinline__ void init(int G_, int c_) { G = G_; c = c_; cnt = (c_ < 256) ? (255 - c_) / G_ + 1 : 0; }
    __device__ __forceinline__ bool next(int i, Unit& u) const {
        if (cnt == 0) return false;
        const int n = i / cnt, r = i - n * cnt; if (n >= 4) return false;
        StaticOrder so; so.init(T, 2048, G, c); so.tile((long)r * G + c, u);
        u.pn += n * 8; u.ka = n * 1024; return true;
    }
};
struct ProjOrder {
    StaticOrder so;
    __device__ __forceinline__ void init(int G_, int c_) { so.init(T, 4096, G_, c_); }
    __device__ __forceinline__ bool next(int i, Unit& u) const { if (!so.next(i, u)) return false; u.ka = (u.pn >> 3) * 256; return true; }
};
struct MoeOrder {
    const PG8_LAS int* tab; int NT, nct, G, c;
    __device__ __forceinline__ bool next(int i, Unit& u) const {
        StaticOrder so; so.nM = NT; so.nN = nct; so.nwg = NT * nct; so.G = G; so.c = c;
        if (!so.tile((long)i * G + c, u)) return false;
        const int e = __builtin_amdgcn_readfirstlane(tab[u.pm]);
        u.pn += e * nct; u.ka = 0; return true;
    }
};

struct MoeDownOrder {
    const PG8_LAS int* tab; int NT, G, c, S;
    __device__ __forceinline__ void init(const PG8_LAS int* tab_, int NT_, int G_, int c_) { tab = tab_; NT = NT_; G = G_; c = c_;
        const int tu = (NT_ - 64) * 8; S = (tu <= 0) ? 1 : ((tu * 8 <= G_) ? 8 : ((tu * 4 <= G_) ? 4 : ((tu * 2 <= G_) ? 2 : 1))); }
    __device__ __forceinline__ bool next(int i, Unit& u) const {
        const int F = (NT < 64) ? NT : 64, nfull = F * 8, rf = (nfull + G - 1) / G;
        if (i < rf) {
            StaticOrder so; so.nM = F; so.nN = 8; so.nwg = nfull; so.G = G; so.c = c;
            if (so.tile((long)i * G + c, u)) { const int e = __builtin_amdgcn_readfirstlane(tab[u.pm]); u.pn += e * 8; return true; }
            i = rf;
        }
        const int q = (i - rf) * G + c, ntail = (NT - F) * 8 * S;
        if (q >= ntail) return false;
        const int tu = q / S, sl = q - tu * S, rt = F + (tu >> 3), pl = tu & 7;
        const int e = __builtin_amdgcn_readfirstlane(tab[rt]);
        u.pm = rt; u.pn = e * 8 + pl; u.ka = sl * (FF / S); u.kb = u.ka; u.nt = (FF / 64) / S; u.aux = 1 + sl; return true;
    }
};

template <class Epi, class Sched>
__device__ __forceinline__ void gemm_phase(PG8_LAS unsigned char* lds, const Gemm g, const Sched& S, const Epi& E) {
    int tid = threadIdx.x; asm volatile("" : "+v"(tid));
    const int wid = __builtin_amdgcn_readfirstlane(tid >> 6), lane = tid & 63, wr = wid >> 2, wc = wid & 3, fr = lane & 15, fq = lane >> 4;
    int K = g.K, lda = g.lda; asm volatile("" : "+s"(K), "+s"(lda));
    const int nt = K / BK;
    unsigned voffA[2], voffB[2];
#pragma unroll
    for (int i = 0; i < 2; ++i) { int R, C; stage_rc(tid * 16 + i * 8192, R, C); const int Rb = Epi::PERM ? ((R & ~31) + perm32(R & 31)) : R;
        voffA[i] = (unsigned)(R * lda + C) * 2u; voffB[i] = (unsigned)(Rb * K + C) * 2u; }
    const size_t kstep = (size_t)(BK * 2);
    const size_t hstepA = (size_t)HALF * lda * 2, hstepB = (size_t)HALF * K * 2;
    const size_t tstepA = 2 * hstepA, tstepB = 2 * hstepB;
    const unsigned ldsw = (unsigned)wid * 1024u;
    const int aoff = lds_byte(wr * 64 + fr, fq * 8), boff = lds_byte(wc * 32 + fr, fq * 8);
#define PG8_SA(b, h) (((b) * 2 + (h)) * HTB)
#define PG8_SB(b, h) ((4 + (b) * 2 + (h)) * HTB)
#define PG8_STAGE(bufoff, gbase, voff) do { _Pragma("unroll") for (int _i = 0; _i < 2; ++_i) \
        __builtin_amdgcn_global_load_lds((const GLB unsigned*)((const char*)(gbase) + (voff)[_i]), (PG8_LAS unsigned*)(lds + (bufoff) + ldsw + _i * 8192), 16, 0, 0); } while (0)
#define PG8_LDA(dst, b, h) do { _Pragma("unroll") for (int m = 0; m < 4; ++m) _Pragma("unroll") for (int k = 0; k < 2; ++k) dst[m][k] = *(const PG8_LAS bf16x8*)(lds + PG8_SA(b, h) + aoff + m * 2048 + k * 1024); } while (0)
#define PG8_LDB(dst, b, h) do { _Pragma("unroll") for (int n = 0; n < 2; ++n) _Pragma("unroll") for (int k = 0; k < 2; ++k) dst[n][k] = *(const PG8_LAS bf16x8*)(lds + PG8_SB(b, h) + boff + n * 2048 + k * 1024); } while (0)
#define PG8_MMA(ai, bj, At, Bt) do { __builtin_amdgcn_s_setprio(1); _Pragma("unroll") for (int m = 0; m < 4; ++m) _Pragma("unroll") for (int n = 0; n < 2; ++n) _Pragma("unroll") for (int k = 0; k < 2; ++k) \
        acc[ai][bj][m][n] = __builtin_amdgcn_mfma_f32_16x16x32_bf16(Bt[n][k], At[m][k], acc[ai][bj][m][n], 0, 0, 0); __builtin_amdgcn_s_setprio(0); } while (0)
#define PG8_WAIT_V(n) asm volatile("s_waitcnt vmcnt(" #n ")" ::: "memory")
#define PG8_WAIT_L(n) asm volatile("s_waitcnt lgkmcnt(" #n ")" ::: "memory")
#define PG8_BAR __builtin_amdgcn_s_barrier()
#define PG8_SCHED __builtin_amdgcn_sched_barrier(0)
    Unit cur, nxt; int ui = 0;
    if (!S.next(0, cur)) return;
    f32x4 acc[2][2][4][2];
#pragma unroll
    for (int a = 0; a < 2; ++a)
#pragma unroll
        for (int b = 0; b < 2; ++b)
#pragma unroll
            for (int m = 0; m < 4; ++m)
#pragma unroll
                for (int n = 0; n < 2; ++n) acc[a][b][m][n] = (f32x4){0.f, 0.f, 0.f, 0.f};
    bf16x8 At[4][2], B0[2][2], B1[2][2];
    const char* cA = (const char*)g.A + (size_t)cur.pm * tstepA + (size_t)cur.ka * 2; const char* cB = (const char*)g.Bt + (size_t)cur.pn * tstepB + (size_t)cur.kb * 2;
    PG8_STAGE(PG8_SB(0, 0), cB, voffB); PG8_STAGE(PG8_SB(0, 1), cB + hstepB, voffB); PG8_STAGE(PG8_SA(0, 0), cA, voffA); PG8_STAGE(PG8_SA(0, 1), cA + hstepA, voffA);
    if (wr == 1) PG8_BAR;
    PG8_WAIT_V(2); PG8_BAR;
    PG8_STAGE(PG8_SB(1, 0), cB + kstep, voffB); PG8_STAGE(PG8_SA(1, 0), cA + kstep, voffA); PG8_STAGE(PG8_SB(1, 1), cB + hstepB + kstep, voffB);
    PG8_WAIT_V(6); PG8_BAR;
    for (;;) {
        const bool has_next = S.next(ui + 1, nxt);
        const char* nA = has_next ? (const char*)g.A + (size_t)nxt.pm * tstepA + (size_t)nxt.ka * 2 : cA; const char* nB = has_next ? (const char*)g.Bt + (size_t)nxt.pn * tstepB + (size_t)nxt.kb * 2 : cB;
        const int ntu = cur.nt ? cur.nt : nt;
        for (int t = 0; t < ntu; t += 2) {
            const bool last = (t == ntu - 2);
            const char* a1 = cA + (size_t)(t + 1) * kstep;
            const char* a2 = last ? nA : cA + (size_t)(t + 2) * kstep; const char* b2 = last ? nB : cB + (size_t)(t + 2) * kstep;
            const char* a3 = a2 + kstep; const char* b3 = b2 + kstep;
            PG8_LDB(B0, 0, 0); PG8_LDB(B1, 0, 1); PG8_SCHED; PG8_LDA(At, 0, 0); PG8_STAGE(PG8_SA(1, 1), a1 + hstepA, voffA);
            PG8_WAIT_V(8); PG8_WAIT_L(0); PG8_BAR; PG8_MMA(0, 0, At, B0); PG8_MMA(0, 1, At, B1); PG8_BAR; PG8_SCHED;
            PG8_LDA(At, 0, 1); PG8_STAGE(PG8_SB(0, 0), b2, voffB); PG8_STAGE(PG8_SB(0, 1), b2 + hstepB, voffB); PG8_STAGE(PG8_SA(0, 0), a2, voffA);
            PG8_WAIT_V(8); PG8_WAIT_L(0); PG8_BAR; PG8_MMA(1, 0, At, B0); PG8_MMA(1, 1, At, B1); PG8_BAR; PG8_SCHED;
            PG8_LDB(B0, 1, 0); PG8_LDB(B1, 1, 1); PG8_SCHED; PG8_LDA(At, 1, 0); PG8_STAGE(PG8_SA(0, 1), a2 + hstepA, voffA);
            PG8_WAIT_V(8); PG8_WAIT_L(0); PG8_BAR; PG8_MMA(0, 0, At, B0); PG8_MMA(0, 1, At, B1); PG8_BAR; PG8_SCHED;
            PG8_LDA(At, 1, 1); PG8_STAGE(PG8_SB(1, 0), b3, voffB); PG8_STAGE(PG8_SB(1, 1), b3 + hstepB, voffB); PG8_STAGE(PG8_SA(1, 0), a3, voffA);
            PG8_WAIT_V(8); PG8_WAIT_L(0); PG8_BAR; PG8_MMA(1, 0, At, B0); PG8_MMA(1, 1, At, B1); PG8_BAR; PG8_SCHED;
        }
        if (wr == 0) PG8_BAR;
        E(acc, cur, wr, wc, fr, fq);
        if (!has_next) break;
#pragma unroll
        for (int a = 0; a < 2; ++a)
#pragma unroll
            for (int b = 0; b < 2; ++b)
#pragma unroll
                for (int m = 0; m < 4; ++m)
#pragma unroll
                    for (int n = 0; n < 2; ++n) acc[a][b][m][n] = (f32x4){0.f, 0.f, 0.f, 0.f};
        cur = nxt; cA = nA; cB = nB; ++ui;
        if (wr == 1) PG8_BAR;
    }
    PG8_WAIT_V(0);
    PG8_BAR;
#undef PG8_SA
#undef PG8_SB
#undef PG8_STAGE
#undef PG8_LDA
#undef PG8_LDB
#undef PG8_MMA
#undef PG8_WAIT_V
#undef PG8_WAIT_L
#undef PG8_BAR
#undef PG8_SCHED
}

#define EPI_ROWS(u) const int row0 = (u).pm * BM + wr * 64 + fr; const int ct0 = wc * 32 + 8 * fq
#define EPI_FOR_ROWS _Pragma("unroll") for (int ai = 0; ai < 2; ++ai) _Pragma("unroll") for (int m = 0; m < 4; ++m)
__device__ __forceinline__ u32x4 pack8(f32x4 v0, f32x4 v1) { u32x4 w; w.x = pk2(v0[0], v0[1]); w.y = pk2(v0[2], v0[3]); w.z = pk2(v1[0], v1[1]); w.w = pk2(v1[2], v1[3]); return w; }
__device__ __forceinline__ void unpack8(u32x4 w, f32x4& v0, f32x4& v1) { v0 = (f32x4){bflo(w.x), bfhi(w.x), bflo(w.y), bfhi(w.y)}; v1 = (f32x4){bflo(w.z), bfhi(w.z), bflo(w.w), bfhi(w.w)}; }
__device__ __forceinline__ f32x4 sig4(f32x4 v) { return (f32x4){sigmoidf_(v[0]), sigmoidf_(v[1]), sigmoidf_(v[2]), sigmoidf_(v[3])}; }

struct EpiWin { static constexpr bool PERM = true;
    GLB bf16_t* sbqkv; GLB bf16_t* uf; GLB bf16_t* gate;
    __device__ __forceinline__ void operator()(const f32x4 (&acc)[2][2][4][2], const Unit& u, int wr, int wc, int fr, int fq) const {
        EPI_ROWS(u); const int pn = u.pn;
        if (pn < 40) {
            GLB bf16_t* base = (pn < 12) ? sbqkv + pn * 256 : uf + (pn - 12) * 256; const int ld = (pn < 12) ? 3072 : UFW;
            EPI_FOR_ROWS { GLB bf16_t* rp = base + (size_t)(row0 + ai * HALF + m * 16) * ld + ct0;
#pragma unroll
                for (int bj = 0; bj < 2; ++bj) *(GLB u32x4*)(rp + bj * HALF) = pack8(acc[ai][bj][m][0], acc[ai][bj][m][1]); }
        } else {
            EPI_FOR_ROWS { GLB bf16_t* rp = gate + (size_t)(row0 + ai * HALF + m * 16) * 8192 + (pn - 40) * 256 + ct0;
#pragma unroll
                for (int bj = 0; bj < 2; ++bj) *(GLB u32x4*)(rp + bj * HALF) = pack8(sig4(acc[ai][bj][m][0]), sig4(acc[ai][bj][m][1])); }
        }
    }
};
struct EpiNull { static constexpr bool PERM = true;
    __device__ __forceinline__ void operator()(const f32x4 (&acc)[2][2][4][2], const Unit& u, int wr, int wc, int fr, int fq) const {
#pragma unroll
        for (int ai = 0; ai < 2; ++ai)
#pragma unroll
            for (int bj = 0; bj < 2; ++bj) asm volatile("" :: "v"(acc[ai][bj][0][0]), "v"(acc[ai][bj][0][1]), "v"(acc[ai][bj][1][0]), "v"(acc[ai][bj][1][1]), "v"(acc[ai][bj][2][0]), "v"(acc[ai][bj][2][1]), "v"(acc[ai][bj][3][0]), "v"(acc[ai][bj][3][1]));
    }
};
struct EpiLora { static constexpr bool PERM = true;
    GLB float* dec; GLB bf16_t* aa; GLB bf16_t* gg; const GLB float* w0; const GLB float* a0;
    __device__ __forceinline__ void operator()(const f32x4 (&acc)[2][2][4][2], const Unit& u, int wr, int wc, int fr, int fq) const {
        EPI_ROWS(u); const int kind = u.pn >> 2, cb = (u.pn & 3) * 256 + ct0;
        EPI_FOR_ROWS { const size_t ro = (size_t)(row0 + ai * HALF + m * 16) * 1024 + cb;
#pragma unroll
            for (int bj = 0; bj < 2; ++bj) { const int co = bj * HALF;
                if (kind == 0) {
#pragma unroll
                    for (int n = 0; n < 2; ++n) { const f32x4 v = acc[ai][bj][m][n]; const f32x4 b = *(const GLB f32x4*)(w0 + cb + co + 4 * n); f32x4 o;
#pragma unroll
                        for (int j = 0; j < 4; ++j) { const float pre = v[j] + b[j]; const float y = -pre; const float sp = fmaxf(y, 0.f) + __logf(1.0f + __expf(-fabsf(y)));
                            o[j] = __expf(-__expf(-sp - 0.5f)); }
                        *(GLB f32x4*)(dec + ro + co + 4 * n) = o; }
                } else if (kind == 1) { const f32x4 b0 = *(const GLB f32x4*)(a0 + cb + co), b1 = *(const GLB f32x4*)(a0 + cb + co + 4);
                    *(GLB u32x4*)(aa + ro + co) = pack8(sig4(acc[ai][bj][m][0] + b0), sig4(acc[ai][bj][m][1] + b1)); }
                else *(GLB u32x4*)(gg + ro + co) = pack8(acc[ai][bj][m][0], acc[ai][bj][m][1]); } }
    }
};
struct EpiBranch { static constexpr bool PERM = true;
    const GLB bf16_t* gate; GLB bf16_t* gout;
    __device__ __forceinline__ void operator()(const f32x4 (&acc)[2][2][4][2], const Unit& u, int wr, int wc, int fr, int fq) const {
        EPI_ROWS(u); const int n = u.pn >> 3, cb = (u.pn & 7) * 256 + ct0;
        EPI_FOR_ROWS { const size_t r = (size_t)(row0 + ai * HALF + m * 16);
#pragma unroll
            for (int bj = 0; bj < 2; ++bj) { const int c = cb + bj * HALF; f32x4 g0, g1; unpack8(*(const GLB u32x4*)(gate + r * 8192 + n * 2048 + c), g0, g1);
                f32x4 s0 = g0 * acc[ai][bj][m][0], s1 = g1 * acc[ai][bj][m][1];
                GLB u32x4* gp = (GLB u32x4*)(gout + r * 2048 + c);
                if (n > 0) { f32x4 p0, p1; unpack8(*gp, p0, p1); s0 += p0; s1 += p1; }
                *gp = pack8(s0, s1); } }
    }
};
struct EpiResid { static constexpr bool PERM = true;
    const GLB float* resid; GLB float* out;
    __device__ __forceinline__ void operator()(const f32x4 (&acc)[2][2][4][2], const Unit& u, int wr, int wc, int fr, int fq) const {
        EPI_ROWS(u); const int cb = u.pn * 256 + ct0;
        EPI_FOR_ROWS { const size_t ro = (size_t)(row0 + ai * HALF + m * 16) * D + cb;
#pragma unroll
            for (int bj = 0; bj < 2; ++bj) { const f32x4 r0 = *(const GLB f32x4*)(resid + ro + bj * HALF), r1 = *(const GLB f32x4*)(resid + ro + bj * HALF + 4);
                *(GLB f32x4*)(out + ro + bj * HALF) = r0 + acc[ai][bj][m][0]; *(GLB f32x4*)(out + ro + bj * HALF + 4) = r1 + acc[ai][bj][m][1]; } }
    }
};
struct EpiUp { static constexpr bool PERM = true;
    GLB bf16_t* act;
    __device__ __forceinline__ void operator()(const f32x4 (&acc)[2][2][4][2], const Unit& u, int wr, int wc, int fr, int fq) const {
        EPI_ROWS(u); const int cb = (u.pn % NCT_UP) * 128 + ct0;
        EPI_FOR_ROWS { f32x4 o[2];
#pragma unroll
            for (int n = 0; n < 2; ++n) { const f32x4 g = acc[ai][0][m][n], up = acc[ai][1][m][n];
#pragma unroll
                for (int j = 0; j < 4; ++j) o[n][j] = g[j] * sigmoidf_(g[j]) * up[j]; }
            *(GLB u32x4*)(act + (size_t)(row0 + ai * HALF + m * 16) * FF + cb) = pack8(o[0], o[1]); }
    }
};
struct EpiMoeDown { static constexpr bool PERM = true;
    GLB bf16_t* os; const GLB float* wslot; GLB float* osp; int S;
    __device__ __forceinline__ void operator()(const f32x4 (&acc)[2][2][4][2], const Unit& u, int wr, int wc, int fr, int fq) const {
        EPI_ROWS(u); const int pl = u.pn % NCT_DN;
        if (u.aux == 0) {
            const int cb = pl * 256 + ct0;
            EPI_FOR_ROWS { const int r = row0 + ai * HALF + m * 16; const float w = wslot[r]; GLB bf16_t* rp = os + (size_t)r * D + cb;
#pragma unroll
                for (int bj = 0; bj < 2; ++bj) *(GLB u32x4*)(rp + bj * HALF) = pack8(acc[ai][bj][m][0] * w, acc[ai][bj][m][1] * w); }
        } else {
            GLB float* tp = osp + ((size_t)(((u.pm - 64) * 8 + pl) * S + (u.aux - 1)) << 16);
            EPI_FOR_ROWS { const int rl = wr * 64 + fr + ai * HALF + m * 16; const float w = wslot[u.pm * BM + rl]; GLB float* rp = tp + rl * 256 + ct0;
#pragma unroll
                for (int bj = 0; bj < 2; ++bj) { *(GLB f32x4*)(rp + bj * HALF) = acc[ai][bj][m][0] * w; *(GLB f32x4*)(rp + bj * HALF + 4) = acc[ai][bj][m][1] * w; } }
        }
    }
};
struct EpiPle { static constexpr bool PERM = true;
    const GLB float* resid; GLB float* out; const GLB bf16_t* proj;
    __device__ __forceinline__ void operator()(const f32x4 (&acc)[2][2][4][2], const Unit& u, int wr, int wc, int fr, int fq) const {
        EPI_ROWS(u); const int cb = u.pn * 256 + ct0;
        EPI_FOR_ROWS { const size_t ro = (size_t)(row0 + ai * HALF + m * 16) * D + cb;
#pragma unroll
            for (int bj = 0; bj < 2; ++bj) { f32x4 p0, p1; unpack8(*(const GLB u32x4*)(proj + ro + bj * HALF), p0, p1);
                const f32x4 r0 = *(const GLB f32x4*)(resid + ro + bj * HALF), r1 = *(const GLB f32x4*)(resid + ro + bj * HALF + 4);
                *(GLB f32x4*)(out + ro + bj * HALF) = r0 + sig4(acc[ai][bj][m][0]) * p0; *(GLB f32x4*)(out + ro + bj * HALF + 4) = r1 + sig4(acc[ai][bj][m][1]) * p1; } }
    }
};
struct EpiProj { static constexpr bool PERM = true;
    GLB bf16_t* proj;
    __device__ __forceinline__ void operator()(const f32x4 (&acc)[2][2][4][2], const Unit& u, int wr, int wc, int fr, int fq) const {
        EPI_ROWS(u); GLB bf16_t* base = proj + (size_t)(u.pn >> 3) * T * D + (u.pn & 7) * 256 + ct0;
        EPI_FOR_ROWS { GLB bf16_t* rp = base + (size_t)(row0 + ai * HALF + m * 16) * D;
#pragma unroll
            for (int bj = 0; bj < 2; ++bj) *(GLB u32x4*)(rp + bj * HALF) = pack8(acc[ai][bj][m][0], acc[ai][bj][m][1]); }
    }
};
}
struct Ctx {
    LAS unsigned char* lds;
    GLB unsigned char* ws;
    GLB float* out;
    int tid, lane, wave, gw, NGW, G;
};
#define WSP(type, off) ((GLB type*)(C.ws + (off)))
constexpr int INTAB_OFF = MISC_OFF + 1024;
constexpr int TAB_WS = 37, TAB_OUT = 38, TAB_RANGE = 39;
__device__ __forceinline__ const GLB void* inptr(LAS unsigned char* lds, int i) {
    const LAS unsigned* t = (const LAS unsigned*)(lds + INTAB_OFF) + 2 * i;
    const unsigned lo = __builtin_amdgcn_readfirstlane(t[0]), hi = __builtin_amdgcn_readfirstlane(t[1]);
    return (const GLB void*)(((unsigned long long)hi << 32) | lo);
}
#define INF32(i) ((const GLB float*)inptr(C.lds, (i)))
__device__ __forceinline__ Ctx make_ctx(LAS unsigned char* lds) {
    Ctx C; C.lds = lds;
    int tid = threadIdx.x; asm volatile("" : "+v"(tid));
    C.tid = tid; C.lane = tid & 63; C.wave = __builtin_amdgcn_readfirstlane(tid >> 6);
    C.G = gridDim.x; C.gw = blockIdx.x * NWAVES + C.wave; C.NGW = C.G * NWAVES;
    C.ws = (GLB unsigned char*)inptr(lds, TAB_WS); C.out = (GLB float*)inptr(lds, TAB_OUT);
    return C;
}
enum { I_X = 0, I_P, I_POS, I_WIN, I_MIXN, I_FFNN, I_PLEN, I_RWMU, I_RWW0, I_RWW2, I_RWA0, I_RWA2, I_RWG2, I_RWKK, I_RWKA, I_RWRK, I_RWLNG, I_RWLNB,
       I_DQN, I_DKN, I_DKVN, I_DWUK, I_DWUV, I_SQN, I_SKN, I_SSINK, I_WBR, I_WOUT, I_FG, I_FU, I_FD, I_MR, I_MG, I_MU, I_MD, I_PG, I_PP, N_INPUTS };

__device__ __forceinline__ void conv_tile(const GLB float* W, int ldw, int k0, int s0, int nv, GLB bf16_t* Bt, int K, int n0, LAS float* scr, int lane) {
    const int cq = lane & 15, rq = lane >> 4;
    f32x4 v[16];
#pragma unroll
    for (int i = 0; i < 16; ++i) {
        const int kk = 4 * i + rq;
        v[i] = (4 * cq < nv) ? *(const GLB f32x4*)(W + (size_t)(k0 + kk) * ldw + s0 + 4 * cq) : (f32x4){0.f, 0.f, 0.f, 0.f};
    }
#pragma unroll
    for (int i = 0; i < 16; ++i) { const int kk = 4 * i + rq; LAS float* d = scr + kk * 65 + 4 * cq; d[0] = v[i][0]; d[1] = v[i][1]; d[2] = v[i][2]; d[3] = v[i][3]; }
    LDS_WAIT();
    const int c = lane & 7;
#pragma unroll
    for (int j = 0; j < 8; ++j) { const int n = (lane >> 3) + 8 * j; const LAS float* s = scr + (8 * c) * 65 + n;
        u32x4 o; o.x = pk2(s[0 * 65], s[1 * 65]); o.y = pk2(s[2 * 65], s[3 * 65]); o.z = pk2(s[4 * 65], s[5 * 65]); o.w = pk2(s[6 * 65], s[7 * 65]);
        *(GLB u32x4*)(Bt + (size_t)(n0 + n) * K + k0 + 8 * c) = o; }
    LDS_WAIT();
}
__device__ __forceinline__ void win_map(int g, int& s0, int& nv) {
    const int d0 = 64 * g; nv = 64;
    if (d0 < 8704) s0 = d0;
    else if (d0 < 9728) s0 = 8784 + (d0 - 8704);
    else if (d0 < 9984) s0 = 9808 + (d0 - 9728);
    else if (d0 < 10240) { const int off = d0 - 9984; if (off == 0) s0 = 8704; else if (off == 64) { s0 = 8768; nv = 16; } else { s0 = 0; nv = 0; } }
    else s0 = 10064 + (d0 - 10240);
}
#ifndef MOE_SCAN_TILES
#define MOE_SCAN_TILES 42
#endif
#ifndef MOE_CONV_IN_PROLOGUE
#define MOE_CONV_IN_PROLOGUE 0
#endif
constexpr int MOE_CONV_ITEMS = NE * ((D / 64) * (2 * FF / 64) + (FF / 64) * (D / 64));
__device__ __forceinline__ void conv_moe_item(const Ctx& C, int idx, LAS float* scr, int lane) {
    constexpr int I_GU1 = (D / 64) * (2 * FF / 64), I_DN1 = (FF / 64) * (D / 64);
    if (idx < NE * I_GU1) {
        const int e = idx / I_GU1, r = idx % I_GU1, nb = r % (2 * FF / 64), kb = r / (2 * FF / 64);
        const int tile = nb >> 2, q = nb & 3; const int sc = 128 * tile + 64 * (q & 1);
        conv_tile(((q < 2) ? INF32(I_MG) : INF32(I_MU)) + (size_t)e * D * FF, FF, 64 * kb, sc, 64, WSP(bf16_t, WS_MWGU) + (size_t)e * 2 * FF * D, D, 64 * nb, scr, lane);
    } else {
        const int r0 = idx - NE * I_GU1, e = r0 / I_DN1, r = r0 % I_DN1, nb = r % 32, kb = r / 32;
        conv_tile(INF32(I_MD) + (size_t)e * FF * D, D, 64 * kb, 64 * nb, 64, WSP(bf16_t, WS_MWD) + (size_t)e * D * FF, FF, 64 * nb, scr, lane);
    }
}
__device__ __forceinline__ void ph_prologue(const Ctx& C) {
    LAS float* scr = (LAS float*)(C.lds + C.wave * 16640);
    const int gw = C.gw, NGW = C.NGW; int lane = C.lane; asm volatile("" : "+v"(lane)); lane &= 63;
    constexpr int I_WIN1 = (D / 64) * (N_INP / 64);
    constexpr int I_BR1 = (1024 / 64) * (2048 / 64);
    constexpr int I_DD = (D / 64) * (D / 64);
    constexpr int I_GU1 = (D / 64) * (2 * FF / 64);
    constexpr int I_DN1 = (FF / 64) * (D / 64);
    constexpr int I_PP1 = (256 / 64) * (D / 64);
    constexpr int S0 = 0, S1 = S0 + NL * I_WIN1, S2 = S1 + NL * 4 * I_BR1, S3 = S2 + NL * I_DD, S4 = S3 + I_GU1, S5 = S4 + I_DN1, S6 = S5 + NE * I_GU1, S7 = S6 + NE * I_DN1,
                  S8 = S7 + NL * I_DD, S9 = S8 + NL * I_PP1;
    for (int it = gw; it < S9; it += NGW) {
        if (it < S1) { const int l = it / I_WIN1, r = it % I_WIN1, nb = r % (N_INP / 64), kb = r / (N_INP / 64); int s0, nv; win_map(nb, s0, nv);
            conv_tile(INF32(I_WIN) + (size_t)l * D * N_IN, N_IN, 64 * kb, s0, nv, WSP(bf16_t, WS_WIN + l * SZ_WIN1), D, 64 * nb, scr, lane); }
        else if (it < S2) { const int q = (it - S1) / I_BR1, r = (it - S1) % I_BR1, nb = r % 32, kb = r / 32;
            conv_tile(INF32(I_WBR) + (size_t)q * 1024 * 2048, 2048, 64 * kb, 64 * nb, 64, WSP(bf16_t, WS_WBR) + (size_t)q * 2048 * 1024, 1024, 64 * nb, scr, lane); }
        else if (it < S3) { const int l = (it - S2) / I_DD, r = (it - S2) % I_DD, nb = r % 32, kb = r / 32;
            conv_tile(INF32(I_WOUT) + (size_t)l * D * D, D, 64 * kb, 64 * nb, 64, WSP(bf16_t, WS_WOUT + l * SZ_DD), D, 64 * nb, scr, lane); }
        else if (it < S4) {
            const int r = it - S3, nb = r % (2 * FF / 64), kb = r / (2 * FF / 64);
            const int tile = nb >> 2, q = nb & 3; const int sc = 128 * tile + 64 * (q & 1);
            conv_tile((q < 2) ? INF32(I_FG) : INF32(I_FU), FF, 64 * kb, sc, 64, WSP(bf16_t, WS_WGU), D, 64 * nb, scr, lane); }
        else if (it < S5) { const int r = it - S4, nb = r % 32, kb = r / 32;
            conv_tile(INF32(I_FD), D, 64 * kb, 64 * nb, 64, WSP(bf16_t, WS_WD), FF, 64 * nb, scr, lane); }
        else if (it < S7) { if (MOE_CONV_IN_PROLOGUE || it - S5 >= 2 * 1024 * MOE_SCAN_TILES) conv_moe_item(C, it - S5, scr, lane); }
        else if (it < S8) { const int l = (it - S7) / I_DD, r = (it - S7) % I_DD, nb = r % 32, kb = r / 32;
            conv_tile(INF32(I_PG) + (size_t)l * D * D, D, 64 * kb, 64 * nb, 64, WSP(bf16_t, WS_WPG + l * SZ_DD), D, 64 * nb, scr, lane); }
        else { const int l = (it - S8) / I_PP1, r = (it - S8) % I_PP1, nb = r % 32, kb = r / 32;
            conv_tile(INF32(I_PP) + (size_t)l * 256 * D, D, 64 * kb, 64 * nb, 64, WSP(bf16_t, WS_WPP) + (size_t)l * D * 256, 256, 64 * nb, scr, lane); }
    }
    for (int idx = gw * 64 + lane; idx < NL * 3072 * 256; idx += NGW * 64) {
        const int k = idx & 255, n = (idx >> 8) % 3072, l = idx / (3072 * 256);
        float v = 0.f;
        if (n < 1024) { if (k < 96) v = INF32(I_RWW2)[((size_t)l * 96 + k) * 1024 + n]; }
        else if (n < 2048) { if (k >= 96 && k < 192) v = INF32(I_RWA2)[((size_t)l * 96 + (k - 96)) * 1024 + (n - 1024)]; }
        else { if (k >= 192) v = INF32(I_RWG2)[((size_t)l * 64 + (k - 192)) * 1024 + (n - 2048)]; }
        WSP(bf16_t, WS_WLORA)[idx] = (bf16_t)f2bf(v);
    }
    for (int idx = gw * 64 + lane; idx < NL * T * 64; idx += NGW * 64) {
        const int c4 = idx & 63, t = (idx >> 6) % T, l = idx / (T * 64);
        const f32x4 v = *(const GLB f32x4*)(INF32(I_P) + ((size_t)l * T + t) * 256 + 4 * c4);
        u32x2 o; o.x = pk2(v[0], v[1]); o.y = pk2(v[2], v[3]);
        *(GLB u32x2*)(WSP(bf16_t, WS_PCAT) + (size_t)t * 512 + l * 256 + 4 * c4) = o;
    }
}

template <int MODE>
__device__ __forceinline__ void ph_norm(const Ctx& C, const GLB float* xin, GLB float* xout, const GLB float* gain, const GLB float* router, int moeS = 1) {
    int lane = C.lane; asm volatile("" : "+v"(lane)); lane &= 63;
    for (int m = C.gw; m < T; m += C.NGW) {
        const GLB f32x4* xr = (const GLB f32x4*)(xin + (size_t)m * D) + lane;
        f32x4 v[8]; float s = 0.f;
#pragma unroll
        for (int j = 0; j < 8; ++j) v[j] = xr[64 * j];
        if (MODE == 2) {
            const GLB int* ts = WSP(int, WS_TOKSLOT) + 2 * m;
#pragma unroll
            for (int q = 0; q < 2; ++q) {
                const int sl = ts[q];
                if (sl < 64 * 256 || moeS <= 1) {
                    const GLB u32x2* o0 = (const GLB u32x2*)(WSP(bf16_t, WS_OS) + (size_t)sl * D) + lane;
#pragma unroll
                    for (int j = 0; j < 8; ++j) { const u32x2 w = o0[64 * j]; v[j] = v[j] + (f32x4){bflo(w.x), bfhi(w.x), bflo(w.y), bfhi(w.y)}; }
                } else {
                    const int tu0 = ((sl >> 8) - 64) * 8, rl = sl & 255;
#pragma unroll
                    for (int j = 0; j < 8; ++j)
                        for (int k = 0; k < moeS; ++k) v[j] = v[j] + *((const GLB f32x4*)(WSP(float, WS_OSP) + ((size_t)((tu0 + j) * moeS + k) << 16) + rl * 256) + lane);
                }
            }
#pragma unroll
            for (int j = 0; j < 8; ++j) ((GLB f32x4*)(xout + (size_t)m * D) + lane)[64 * j] = v[j];
        }
#pragma unroll
        for (int j = 0; j < 8; ++j) s += (v[j][0] * v[j][0] + v[j][1] * v[j][1]) + (v[j][2] * v[j][2] + v[j][3] * v[j][3]);
        const float rstd = 1.0f / sqrtf(wave_sum(s) * (1.0f / D) + 1e-6f);
        GLB u32x2* o8 = (GLB u32x2*)(WSP(bf16_t, WS_H) + (size_t)m * D) + lane;
        float lg[NE];
        if (MODE == 1) {
#pragma unroll
            for (int e = 0; e < NE; ++e) lg[e] = 0.f;
        }
#pragma unroll
        for (int j = 0; j < 8; ++j) { const f32x4 g = ((const GLB f32x4*)gain)[lane + 64 * j]; const f32x4 hv = v[j] * rstd * g; v[j] = hv;
            u32x2 o; o.x = pk2(hv[0], hv[1]); o.y = pk2(hv[2], hv[3]); o8[64 * j] = o; }
        if (MODE == 1) {
#pragma unroll 2
            for (int j = 0; j < 8; ++j) {
#pragma unroll
                for (int q = 0; q < 4; ++q) { const GLB f32x4* rr = (const GLB f32x4*)(router + (size_t)(4 * (lane + 64 * j) + q) * NE); const f32x4 r0 = rr[0], r1 = rr[1]; const float hq = v[j][q];
                    lg[0] += hq * r0[0]; lg[1] += hq * r0[1]; lg[2] += hq * r0[2]; lg[3] += hq * r0[3]; lg[4] += hq * r1[0]; lg[5] += hq * r1[1]; lg[6] += hq * r1[2]; lg[7] += hq * r1[3]; }
            }
        }
        if (MODE == 1) {
#pragma unroll
            for (int e = 0; e < NE; ++e) lg[e] = wave_sum(lg[e]);
            if (lane == 0) {
                int e1 = 0; float v1 = lg[0];
#pragma unroll
                for (int e = 1; e < NE; ++e) if (lg[e] > v1) { v1 = lg[e]; e1 = e; }
                int e2 = -1; float v2 = -3.0e38f;
#pragma unroll
                for (int e = 0; e < NE; ++e) if (e != e1 && lg[e] > v2) { v2 = lg[e]; e2 = e; }
                const float ex = __expf(v2 - v1), w1 = 1.0f / (1.0f + ex), w2 = ex / (1.0f + ex);
                GLB unsigned* cnt = WSP(unsigned, WS_CTL) + CW_MOECNT;
                const unsigned p1 = atomicAdd((unsigned*)cnt + 64 * e1, 1u), p2 = atomicAdd((unsigned*)cnt + 64 * e2, 1u);
                GLB unsigned* rt = WSP(unsigned, WS_ROUTE) + (size_t)m * 8;
                rt[0] = (unsigned)e1; rt[1] = p1; rt[2] = __builtin_bit_cast(unsigned, w1); rt[3] = (unsigned)e2; rt[4] = p2; rt[5] = __builtin_bit_cast(unsigned, w2);
            }
        }
    }
}
__device__ __forceinline__ void moe_offsets(const Ctx& C, int (&toff)[NE + 1]) {
    const GLB unsigned* cnt = WSP(unsigned, WS_CTL) + CW_MOECNT; int acc = 0;
#pragma unroll
    for (int e = 0; e < NE; ++e) { toff[e] = acc; const unsigned c = __hip_atomic_load(cnt + 64 * e, __ATOMIC_RELAXED, __HIP_MEMORY_SCOPE_AGENT); acc += (int)((c + 255u) >> 8); }
    toff[NE] = acc;
}
constexpr int MOETAB_OFF = MISC_OFF + 2048;
__device__ __forceinline__ void moe_tile_table(const Ctx& C) {
    int toff[NE + 1]; moe_offsets(C, toff);
    LAS int* tab = (LAS int*)(C.lds + MOETAB_OFF);
    if (C.tid <= MOE_MAXRT) { int e = 0;
#pragma unroll
        for (int j = 1; j < NE; ++j) e += (C.tid >= toff[j]) ? 1 : 0;
        tab[C.tid] = (C.tid == MOE_MAXRT) ? toff[NE] : e; }
    LDS_WAIT(); __syncthreads();
}
__device__ __forceinline__ void ph_moe_gather(const Ctx& C) {
    int toff[NE + 1]; moe_offsets(C, toff);
    int lane = C.lane; asm volatile("" : "+v"(lane)); lane &= 63;
    for (int m = C.gw; m < T; m += C.NGW) {
        const GLB unsigned* rt = WSP(unsigned, WS_ROUTE) + (size_t)m * 8;
        const int e1 = (int)rt[0], p1 = (int)rt[1], e2 = (int)rt[3], p2 = (int)rt[4];
        int o1 = 0, o2 = 0;
#pragma unroll
        for (int e = 0; e < NE; ++e) { o1 = (e == e1) ? toff[e] : o1; o2 = (e == e2) ? toff[e] : o2; }
        const int s1 = o1 * 256 + p1, s2 = o2 * 256 + p2;
        const GLB u32x4* src = (const GLB u32x4*)(WSP(bf16_t, WS_H) + (size_t)m * D) + lane;
        GLB u32x4* d1 = (GLB u32x4*)(WSP(bf16_t, WS_HS) + (size_t)s1 * D) + lane; GLB u32x4* d2 = (GLB u32x4*)(WSP(bf16_t, WS_HS) + (size_t)s2 * D) + lane;
#pragma unroll
        for (int j = 0; j < 4; ++j) { const u32x4 v = src[64 * j]; d1[64 * j] = v; d2[64 * j] = v; }
        if (lane == 0) { WSP(int, WS_TOKSLOT)[2 * m] = s1; WSP(int, WS_TOKSLOT)[2 * m + 1] = s2;
            WSP(unsigned, WS_WSLOT)[s1] = rt[2]; WSP(unsigned, WS_WSLOT)[s2] = rt[5]; }
    }
}

__device__ __forceinline__ float rope_inv_freq(int i, int half) { return exp2f(-13.287712379549449f * (float)i / (float)half); }
__device__ __forceinline__ void ph_prep(const Ctx& C, int l) {
    int lane = C.lane; asm volatile("" : "+v"(lane)); lane &= 63;
    const GLB bf16_t* UF = WSP(bf16_t, WS_UF);
    const int d = lane & 31, hh = lane >> 5;
    for (int m = C.gw; m < T; m += C.NGW) {
        const int t = m % SEQ;
        const GLB bf16_t* u = UF + (size_t)m * UFW;
        const float posf = (float)((const GLB int*)inptr(C.lds, I_POS))[m];
        float qa[8], qb[8], ia[8], ib[8], sa[8], sb[8];
#pragma unroll
        for (int h = 0; h < 8; ++h) { qa[h] = bf1(u[UF_DQ + h * 128 + lane]); qb[h] = bf1(u[UF_DQ + h * 128 + 64 + lane]); }
#pragma unroll
        for (int hp = 0; hp < 8; ++hp) { const int h = 2 * hp + hh; ia[hp] = bf1(u[UF_IQ + h * 64 + d]); ib[hp] = bf1(u[UF_IQ + h * 64 + 32 + d]); sa[hp] = bf1(u[UF_SQ + h * 64 + d]); sb[hp] = bf1(u[UF_SQ + h * 64 + 32 + d]); }
        const float ika = bf1(u[UF_IK + d]), ikb = bf1(u[UF_IK + 32 + d]), iwv = bf1(u[UF_IW + (lane & 15)]);
        const float ska = bf1(u[UF_SK + hh * 64 + d]), skb = bf1(u[UF_SK + hh * 64 + 32 + d]), sv0 = bf1(u[UF_SV + lane]), sv1 = bf1(u[UF_SV + 64 + lane]);
        {
            const GLB float* mu = INF32(I_RWMU) + (size_t)l * 3328;
#pragma unroll
            for (int half = 0; half < 2; ++half) {
                constexpr int J0[2] = {0, 7}, J1[2] = {7, 13};
                f32x4 cur[7], prv[7], mm[7];
#pragma unroll
                for (int j = J0[half]; j < J1[half]; ++j) { const int c = 4 * (lane + 64 * j), q = j - J0[half];
                    { const u32x2 w = *(const GLB u32x2*)(u + UF_RW + c); cur[q] = (f32x4){bflo(w.x), bfhi(w.x), bflo(w.y), bfhi(w.y)}; }
                    if (t > 0) { const u32x2 w = *(const GLB u32x2*)(u - UFW + UF_RW + c); prv[q] = (f32x4){bflo(w.x), bfhi(w.x), bflo(w.y), bfhi(w.y)}; } else prv[q] = (f32x4){0.f, 0.f, 0.f, 0.f};
                    mm[q] = *(const GLB f32x4*)(mu + c); }
#pragma unroll
                for (int j = J0[half]; j < J1[half]; ++j) { const int c = 4 * (lane + 64 * j), q = j - J0[half];
                    const f32x4 o = cur[q] + mm[q] * (prv[q] - cur[q]);
                    if (j < 12) { GLB bf16_t* dst = WSP(bf16_t, (j < 4 ? WS_R : (j < 8 ? WS_K : WS_V))) + (size_t)m * 1024 + (c & 1023); u32x2 w; w.x = pk2(o[0], o[1]); w.y = pk2(o[2], o[3]); *(GLB u32x2*)dst = w; }
                    else { const int k = c - 3072; f32x4 a;
                        if (k < 96) a = (f32x4){tanhf(o[0]), tanhf(o[1]), tanhf(o[2]), tanhf(o[3])};
                        else if (k < 192) a = o;
                        else a = pg8::sig4(o);
                        u32x2 w; w.x = pk2(a[0], a[1]); w.y = pk2(a[2], a[3]);
                        *(GLB u32x2*)(WSP(bf16_t, WS_ALORA) + (size_t)m * 256 + k) = w; }
                }
            }
        }
        {
            const float invf = rope_inv_freq(lane, 64); float sn, cn; sincosf(posf * invf, &sn, &cn);
            const float g1 = INF32(I_DQN)[l * 128 + lane], g2 = INF32(I_DQN)[l * 128 + 64 + lane];
#pragma unroll
            for (int h = 0; h < 8; ++h) {
                const float a = qa[h], b = qb[h];
                const float rs = 1.0f / sqrtf(wave_sum(a * a + b * b) * (1.0f / 128.f) + 1e-6f);
                const float x1 = a * rs * g1, x2 = b * rs * g2;
                GLB bf16_t* q = WSP(bf16_t, WS_QD) + (size_t)m * 1024 + h * 128;
                q[lane] = (bf16_t)f2bf(x1 * cn - x2 * sn); q[64 + lane] = (bf16_t)f2bf(x2 * cn + x1 * sn);
            }
        }
        {
            const float invf = rope_inv_freq(d, 32); float sn, cn; sincosf(posf * invf, &sn, &cn);
#pragma unroll
            for (int hp = 0; hp < 8; ++hp) { const int h = 2 * hp + hh; const float a = ia[hp], b = ib[hp];
                GLB bf16_t* q = WSP(bf16_t, WS_QI) + (size_t)m * 1024 + h * 64; q[d] = (bf16_t)f2bf(a * cn - b * sn); q[32 + d] = (bf16_t)f2bf(b * cn + a * sn); }
            if (hh == 0) { GLB bf16_t* q = WSP(bf16_t, WS_KI) + (size_t)m * 64; q[d] = (bf16_t)f2bf(ika * cn - ikb * sn); q[32 + d] = (bf16_t)f2bf(ikb * cn + ika * sn); }
            if (lane < 16) WSP(float, WS_WI)[(size_t)m * 16 + lane] = iwv * 0.03125f;
            const float sg1 = INF32(I_SQN)[l * 64 + d], sg2 = INF32(I_SQN)[l * 64 + 32 + d];
#pragma unroll
            for (int hp = 0; hp < 8; ++hp) { const int h = 2 * hp + hh; const float a = sa[hp], b = sb[hp];
                float s2 = a * a + b * b;
#pragma unroll
                for (int o = 1; o < 32; o <<= 1) s2 += __shfl_xor(s2, o);
                const float rs = 1.0f / sqrtf(s2 * (1.0f / 64.f) + 1e-6f); const float x1 = a * rs * sg1, x2 = b * rs * sg2;
                GLB bf16_t* q = WSP(bf16_t, WS_QS) + (size_t)m * 1024 + h * 64; q[d] = (bf16_t)f2bf(x1 * cn - x2 * sn); q[32 + d] = (bf16_t)f2bf(x2 * cn + x1 * sn); }
            { const float kg1 = INF32(I_SKN)[l * 64 + d], kg2 = INF32(I_SKN)[l * 64 + 32 + d];
              float s2 = ska * ska + skb * skb;
#pragma unroll
              for (int o = 1; o < 32; o <<= 1) s2 += __shfl_xor(s2, o);
              const float rs = 1.0f / sqrtf(s2 * (1.0f / 64.f) + 1e-6f); const float x1 = ska * rs * kg1, x2 = skb * rs * kg2;
              GLB bf16_t* q = WSP(bf16_t, WS_KS) + (size_t)m * 128 + hh * 64; q[d] = (bf16_t)f2bf(x1 * cn - x2 * sn); q[32 + d] = (bf16_t)f2bf(x2 * cn + x1 * sn);
              GLB bf16_t* vv = WSP(bf16_t, WS_VS) + (size_t)m * 128; vv[lane] = (bf16_t)f2bf(sv0); vv[64 + lane] = (bf16_t)f2bf(sv1); }
        }
    }
}

__device__ __forceinline__ void ph_latent(const Ctx& C, int l) {
    int lane = C.lane; asm volatile("" : "+v"(lane)); lane &= 63;
    LAS float* cs = (LAS float*)(C.lds + C.wave * 8192);
    const GLB bf16_t* UF = WSP(bf16_t, WS_UF);
    const GLB float* wuk = INF32(I_DWUK) + (size_t)l * 256 * 128; const GLB float* wuv = INF32(I_DWUV) + (size_t)l * 256 * 128;
    for (int g8 = C.gw; g8 < T / 8; g8 += C.NGW) {
        const int m0 = 8 * g8;
        float cv[8][4];
#pragma unroll
        for (int tk = 0; tk < 8; ++tk)
#pragma unroll
            for (int j = 0; j < 4; ++j) cv[tk][j] = bf1(UF[(size_t)(m0 + tk) * UFW + UF_CKV + lane + 64 * j]);
#pragma unroll
        for (int tk = 0; tk < 8; ++tk) {
            float ss = 0.f;
#pragma unroll
            for (int j = 0; j < 4; ++j) ss += cv[tk][j] * cv[tk][j];
            const float rc = 1.0f / sqrtf(wave_sum(ss) * (1.0f / 256.f) + 1e-6f);
#pragma unroll
            for (int j = 0; j < 4; ++j) cs[(lane + 64 * j) * 8 + tk] = cv[tk][j] * rc * INF32(I_DKVN)[l * 256 + lane + 64 * j];
        }
        LDS_WAIT();
        float acc[8][4];
#pragma unroll
        for (int tk = 0; tk < 8; ++tk) { acc[tk][0] = 0.f; acc[tk][1] = 0.f; acc[tk][2] = 0.f; acc[tk][3] = 0.f; }
#pragma unroll 8
        for (int k = 0; k < 256; ++k) {
            const float w0 = wuk[k * 128 + lane], w1 = wuk[k * 128 + 64 + lane], w2 = wuv[k * 128 + lane], w3 = wuv[k * 128 + 64 + lane];
            const f32x4 ca = *(const LAS f32x4*)(cs + k * 8), cb = *(const LAS f32x4*)(cs + k * 8 + 4);
#pragma unroll
            for (int tk = 0; tk < 8; ++tk) { const float c = (tk < 4) ? ca[tk & 3] : cb[tk & 3]; acc[tk][0] += c * w0; acc[tk][1] += c * w1; acc[tk][2] += c * w2; acc[tk][3] += c * w3; }
        }
        const float invf = rope_inv_freq(lane, 64);
        const float g1 = INF32(I_DKN)[l * 128 + lane], g2 = INF32(I_DKN)[l * 128 + 64 + lane];
#pragma unroll
        for (int tk = 0; tk < 8; ++tk) {
            const int m = m0 + tk;
            const float posf = (float)((const GLB int*)inptr(C.lds, I_POS))[m];
            float sn, cn; sincosf(posf * invf, &sn, &cn);
            const float k1 = acc[tk][0], k2 = acc[tk][1];
            const float rk = 1.0f / sqrtf(wave_sum(k1 * k1 + k2 * k2) * (1.0f / 128.f) + 1e-6f);
            const float y1 = k1 * rk * g1, y2 = k2 * rk * g2;
            GLB bf16_t* kd = WSP(bf16_t, WS_KD) + (size_t)m * 128; GLB bf16_t* vd = WSP(bf16_t, WS_VD) + (size_t)m * 128;
            kd[lane] = (bf16_t)f2bf(y1 * cn - y2 * sn); kd[64 + lane] = (bf16_t)f2bf(y2 * cn + y1 * sn);
            vd[lane] = (bf16_t)f2bf(acc[tk][2]); vd[64 + lane] = (bf16_t)f2bf(acc[tk][3]);
        }
        LDS_WAIT();
    }
}

__device__ __forceinline__ void ph_rwkv_kk(const Ctx& C, int l) {
    int lane = C.lane; asm volatile("" : "+v"(lane)); lane &= 63;
    for (int m = C.gw; m < T; m += C.NGW) {
#pragma unroll
        for (int i = 0; i < 4; ++i) {
            const int c = 256 * i + 4 * lane; const size_t o = (size_t)m * 1024 + c;
            const f32x4 k = *(const GLB f32x4*)(WSP(float, WS_K) + o), a = *(const GLB f32x4*)(WSP(float, WS_AA) + o);
            const f32x4 kkw = *(const GLB f32x4*)(INF32(I_RWKK) + l * 1024 + c), ka = *(const GLB f32x4*)(INF32(I_RWKA) + l * 1024 + c);
            f32x4 kk = k * kkw; float s = (kk[0] * kk[0] + kk[1] * kk[1]) + (kk[2] * kk[2] + kk[3] * kk[3]);
#pragma unroll
            for (int q = 1; q < 16; q <<= 1) s += __shfl_xor(s, q);
            const float inv = 1.0f / fmaxf(sqrtf(s), 1e-12f); kk = kk * inv;
            *(GLB f32x4*)(WSP(float, WS_KK) + o) = kk;
            *(GLB f32x4*)(WSP(float, WS_K) + o) = k * (1.0f + (a - 1.0f) * ka);
            *(GLB f32x4*)(WSP(float, WS_AA) + o) = kk * a;
        }
    }
}
__device__ __forceinline__ void ph_rwkv_scan_naive(const Ctx& C) {
    if (C.wave != 0) return;
    int lane = C.lane; asm volatile("" : "+v"(lane)); lane &= 63;
    LAS float* buf = (LAS float*)C.lds;
    for (int it = blockIdx.x; it < NB * 16; it += C.G) {
        const int b = it >> 4, h = it & 15;
        float S[64];
#pragma unroll
        for (int k = 0; k < 64; ++k) S[k] = 0.f;
        const size_t base = (size_t)b * SEQ * 1024 + h * 64 + lane;
        for (int t0 = 0; t0 < SEQ; t0 += 16) {
#pragma unroll
            for (int st = 0; st < 16; ++st) { const size_t o = base + (size_t)(t0 + st) * 1024; LAS float* d = buf + st * 384 + lane;
                d[0] = WSP(float, WS_R)[o]; d[64] = WSP(float, WS_DEC)[o]; d[128] = WSP(float, WS_K)[o]; d[192] = WSP(float, WS_KK)[o]; d[256] = WSP(float, WS_AA)[o]; d[320] = WSP(float, WS_V)[o]; }
            LDS_WAIT();
            for (int st = 0; st < 16; ++st) {
                const LAS float* rb = buf + st * 384;
                float p = 0.f;
#pragma unroll
                for (int k = 0; k < 64; k += 4) { const f32x4 q = *(const LAS f32x4*)(rb + 192 + k); p += S[k] * q[0] + S[k + 1] * q[1] + S[k + 2] * q[2] + S[k + 3] * q[3]; }
                const float vv = rb[320 + lane]; float y = 0.f;
#pragma unroll
                for (int k = 0; k < 64; k += 4) { const f32x4 w = *(const LAS f32x4*)(rb + 64 + k), bb = *(const LAS f32x4*)(rb + 256 + k), kq = *(const LAS f32x4*)(rb + 128 + k), r = *(const LAS f32x4*)(rb + k);
#pragma unroll
                    for (int j = 0; j < 4; ++j) { S[k + j] = S[k + j] * w[j] - p * bb[j] + vv * kq[j]; y += S[k + j] * r[j]; } }
                WSP(float, WS_YRAW)[base + (size_t)(t0 + st) * 1024] = y;
            }
            LDS_WAIT();
        }
    }
}
__device__ __forceinline__ f32x4 ld4bf(const GLB bf16_t* q) { const u32x2 w = *(const GLB u32x2*)q; return (f32x4){bflo(w.x), bfhi(w.x), bflo(w.y), bfhi(w.y)}; }
__device__ __forceinline__ void ph_rwkv_post(const Ctx& C, int l) {
    int lane = C.lane; asm volatile("" : "+v"(lane)); lane &= 63;
    if (C.wave >= 4) return;
    for (int m = blockIdx.x * 4 + C.wave; m < T; m += C.G * 4) {
#pragma unroll
        for (int i = 0; i < 4; ++i) {
            const int c = 256 * i + 4 * lane; const size_t o = (size_t)m * 1024 + c;
            const f32x4 y = *(const GLB f32x4*)(WSP(float, WS_YRAW) + o);
            float s = (y[0] + y[1]) + (y[2] + y[3]);
#pragma unroll
            for (int q = 1; q < 16; q <<= 1) s += __shfl_xor(s, q);
            const float mean = s * (1.0f / 64.f); const f32x4 dlt = y - mean;
            float s2 = (dlt[0] * dlt[0] + dlt[1] * dlt[1]) + (dlt[2] * dlt[2] + dlt[3] * dlt[3]);
#pragma unroll
            for (int q = 1; q < 16; q <<= 1) s2 += __shfl_xor(s2, q);
            const float rstd = 1.0f / sqrtf(s2 * (1.0f / 64.f) + 64e-5f);
            const f32x4 r = ld4bf(WSP(bf16_t, WS_R) + o), kraw = ld4bf(WSP(bf16_t, WS_K) + o), av = ld4bf(WSP(bf16_t, WS_AA) + o), v = ld4bf(WSP(bf16_t, WS_V) + o), g = ld4bf(WSP(bf16_t, WS_GG) + o);
            const f32x4 k = kraw * (1.0f + (av - 1.0f) * *(const GLB f32x4*)(INF32(I_RWKA) + l * 1024 + c));
            const f32x4 rk = *(const GLB f32x4*)(INF32(I_RWRK) + l * 1024 + c), lg = *(const GLB f32x4*)(INF32(I_RWLNG) + l * 1024 + c), lb = *(const GLB f32x4*)(INF32(I_RWLNB) + l * 1024 + c);
            const f32x4 pr = r * k * rk; float bs = (pr[0] + pr[1]) + (pr[2] + pr[3]);
#pragma unroll
            for (int q = 1; q < 16; q <<= 1) bs += __shfl_xor(bs, q);
            const f32x4 res = (dlt * rstd * lg + lb + bs * v) * g;
            u32x2 w; w.x = pk2(res[0], res[1]); w.y = pk2(res[2], res[3]);
            *(GLB u32x2*)(WSP(bf16_t, WS_Y) + (size_t)m * 4096 + 1024 + c) = w;
        }
    }
}
__device__ __forceinline__ float dot8(u32x4 kv, f32x4 qa, f32x4 qb) {
    return bflo(kv.x) * qa[0] + bfhi(kv.x) * qa[1] + bflo(kv.y) * qa[2] + bfhi(kv.y) * qa[3] + bflo(kv.z) * qb[0] + bfhi(kv.z) * qb[1] + bflo(kv.w) * qb[2] + bfhi(kv.w) * qb[3];
}
__device__ __forceinline__ void ph_sb_naive(const Ctx& C) {
    int lane = C.lane; asm volatile("" : "+v"(lane));
    LAS float* qs = (LAS float*)(C.lds + C.wave * 512);
    const GLB bf16_t* QKV = WSP(bf16_t, WS_SBQKV); GLB bf16_t* Y = WSP(bf16_t, WS_Y);
    for (int it = C.gw; it < NB * 8 * SEQ; it += C.NGW) {
        const int t = it % SEQ, bh = it / SEQ, h = bh & 7, b = bh >> 3;
        const size_t m = (size_t)b * SEQ + t;
        { const unsigned qq = *(const GLB unsigned*)(QKV + m * 3072 + h * 128 + 2 * lane); qs[2 * lane] = bflo(qq); qs[2 * lane + 1] = bfhi(qq); }
        LDS_WAIT();
        float o0 = 0.f, o1 = 0.f, carry = 0.f;
        const int nch = (t + 63) >> 6;
        for (int c = nch - 1; c >= 0; --c) {
            const int s = c * 64 + lane; const bool valid = s < t; const int sc = valid ? s : 0;
            const GLB u32x4* kp = (const GLB u32x4*)(QKV + ((size_t)b * SEQ + sc) * 3072 + 1024 + h * 128);
            float dot = 0.f;
#pragma unroll
            for (int j = 0; j < 16; ++j) dot += dot8(kp[j], *(const LAS f32x4*)(qs + 8 * j), *(const LAS f32x4*)(qs + 8 * j + 4));
            const float z = dot * 0.08838834764831845f;
            const float lk = valid ? logsigf_(-z) : 0.f, lb = logsigf_(z);
            float inc = lk;
#pragma unroll
            for (int off = 1; off < 64; off <<= 1) { const float o = __shfl_down(inc, off); if (lane + off < 64) inc += o; }
            const float w = valid ? __expf(lb + carry + inc - lk) : 0.f;
            carry += rdlane(inc, 0);
            const int nk = (t - c * 64) < 64 ? (t - c * 64) : 64;
            const GLB bf16_t* vp = QKV + ((size_t)b * SEQ + c * 64) * 3072 + 2048 + h * 128 + 2 * lane;
            for (int j = 0; j < nk; ++j) { const float wj = rdlane(w, j); const unsigned vv = *(const GLB unsigned*)(vp + (size_t)j * 3072); o0 += wj * bflo(vv); o1 += wj * bfhi(vv); }
        }
        *(GLB unsigned*)(Y + m * 4096 + h * 128 + 2 * lane) = pk2(o0, o1);
        LDS_WAIT();
    }
}
__device__ __forceinline__ void ph_swa_naive(const Ctx& C, int l) {
    int lane = C.lane; asm volatile("" : "+v"(lane));
    LAS float* qs = (LAS float*)(C.lds + C.wave * 512);
    const GLB bf16_t* QS = WSP(bf16_t, WS_QS); const GLB bf16_t* KS = WSP(bf16_t, WS_KS); const GLB bf16_t* VS = WSP(bf16_t, WS_VS); GLB bf16_t* Y = WSP(bf16_t, WS_Y);
    for (int it = C.gw; it < T * 16; it += C.NGW) {
        const int h = it & 15, m = it >> 4, t = m % SEQ, b = m / SEQ, kvh = h >> 3;
        qs[lane] = bf1(QS[(size_t)m * 1024 + h * 64 + lane]);
        LDS_WAIT();
        float lg[2];
#pragma unroll
        for (int i = 0; i < 2; ++i) { const int s = t - 127 + lane + 64 * i; const bool valid = s >= 0;
            const GLB u32x4* kp = (const GLB u32x4*)(KS + ((size_t)b * SEQ + (valid ? s : 0)) * 128 + kvh * 64);
            float dot = 0.f;
#pragma unroll
            for (int j = 0; j < 8; ++j) dot += dot8(kp[j], *(const LAS f32x4*)(qs + 8 * j), *(const LAS f32x4*)(qs + 8 * j + 4));
            lg[i] = valid ? dot * 0.125f : -3.0e38f; }
        const float sink = INF32(I_SSINK)[l * 16 + h];
        const float mx = fmaxf(wave_max(fmaxf(lg[0], lg[1])), sink);
        const float e0 = (lg[0] > -1.0e38f) ? __expf(lg[0] - mx) : 0.f, e1 = (lg[1] > -1.0e38f) ? __expf(lg[1] - mx) : 0.f;
        const float den = wave_sum(e0 + e1) + __expf(sink - mx);
        const float p0 = e0 / den, p1 = e1 / den;
        float o = 0.f;
        const int j0 = (t >= 127) ? 0 : 127 - t;
        for (int j = j0; j < 128; ++j) { const float pj = (j < 64) ? rdlane(p0, j) : rdlane(p1, j - 64); const int s = t - 127 + j;
            o += pj * bf1(VS[((size_t)b * SEQ + s) * 128 + kvh * 64 + lane]); }
        Y[(size_t)m * 4096 + 3072 + h * 64 + lane] = (bf16_t)f2bf(o);
        LDS_WAIT();
    }
}
__device__ __forceinline__ unsigned ordkey(float f) { const unsigned u = __builtin_bit_cast(unsigned, f); return (u & 0x80000000u) ? ~u : (u | 0x80000000u); }
__device__ __forceinline__ void ph_dsa_naive(const Ctx& C) {
    int lane = C.lane; asm volatile("" : "+v"(lane));
    LAS float* A = (LAS float*)(C.lds + C.wave * 13312);
    LAS float* Bs = A + 1024;
    LAS int* Cs = (LAS int*)(Bs + 2048);
    const GLB bf16_t* QI = WSP(bf16_t, WS_QI); const GLB bf16_t* KI = WSP(bf16_t, WS_KI); const GLB float* WI = WSP(float, WS_WI);
    const GLB bf16_t* QD = WSP(bf16_t, WS_QD); const GLB bf16_t* KD = WSP(bf16_t, WS_KD); const GLB bf16_t* VD = WSP(bf16_t, WS_VD); GLB bf16_t* Y = WSP(bf16_t, WS_Y);
    for (int m = C.gw; m < T; m += C.NGW) {
        const int t = m % SEQ, b = m / SEQ, n = t + 1;
        const size_t bm = (size_t)b * SEQ;
#pragma unroll
        for (int i = 0; i < 2; ++i) { const int e = 8 * (lane + 64 * i); const u32x4 q = *(const GLB u32x4*)(QI + (size_t)m * 1024 + e);
            *(LAS f32x4*)(A + e) = (f32x4){bflo(q.x), bfhi(q.x), bflo(q.y), bfhi(q.y)}; *(LAS f32x4*)(A + e + 4) = (f32x4){bflo(q.z), bfhi(q.z), bflo(q.w), bfhi(q.w)}; }
        const float wl = WI[(size_t)m * 16 + (lane & 15)];
        LDS_WAIT();
        const int nch = (n + 63) >> 6;
        for (int c = 0; c < nch; ++c) {
            const int s = c * 64 + lane; const bool valid = s < n;
            const GLB u32x4* kp = (const GLB u32x4*)(KI + (bm + (valid ? s : 0)) * 64);
            u32x4 kv[8];
#pragma unroll
            for (int j = 0; j < 8; ++j) kv[j] = kp[j];
            float sc = 0.f;
#pragma unroll 1
            for (int h = 0; h < 16; ++h) { float dot = 0.f;
#pragma unroll
                for (int j = 0; j < 8; ++j) dot += dot8(kv[j], *(const LAS f32x4*)(A + h * 64 + 8 * j), *(const LAS f32x4*)(A + h * 64 + 8 * j + 4));
                sc += rdlane(wl, h) * fmaxf(dot, 0.f); }
            Bs[s] = sc;
        }
        LDS_WAIT();
        int nsel;
        if (n <= 256) { nsel = n;
#pragma unroll
            for (int i = 0; i < 4; ++i) if (lane + 64 * i < n) Cs[lane + 64 * i] = lane + 64 * i;
        } else {
            nsel = 256;
            unsigned key[32];
#pragma unroll
            for (int i = 0; i < 32; ++i) { const int s = lane + 64 * i; key[i] = (s < n) ? ordkey(Bs[s]) : 0u; }
            unsigned tau = 0u;
            for (int bit = 31; bit >= 0; --bit) {
                const unsigned cand = tau | (1u << bit); int cnt = 0;
#pragma unroll
                for (int i = 0; i < 32; ++i) cnt += (key[i] >= cand) ? 1 : 0;
#pragma unroll
                for (int o = 1; o < 64; o <<= 1) cnt += __shfl_xor(cnt, o);
                if (cnt >= 256) tau = cand;
            }
            int cgt = 0;
#pragma unroll
            for (int i = 0; i < 32; ++i) cgt += (key[i] > tau) ? 1 : 0;
#pragma unroll
            for (int o = 1; o < 64; o <<= 1) cgt += __shfl_xor(cgt, o);
            const int need = 256 - cgt;
            int base = 0, eqbase = 0;
            const unsigned long long lt = (1ull << lane) - 1ull;
#pragma unroll
            for (int i = 0; i < 32; ++i) {
                const bool gt = key[i] > tau, eq = key[i] == tau;
                const unsigned long long beq = __ballot(eq);
                const int eqrank = eqbase + __popcll(beq & lt);
                const bool sel = gt || (eq && eqrank < need);
                const unsigned long long bs = __ballot(sel);
                if (sel) Cs[base + __popcll(bs & lt)] = lane + 64 * i;
                base += __popcll(bs); eqbase += __popcll(beq);
            }
        }
        LDS_WAIT();
#pragma unroll
        for (int i = 0; i < 2; ++i) { const int e = 8 * (lane + 64 * i); const u32x4 q = *(const GLB u32x4*)(QD + (size_t)m * 1024 + e);
            *(LAS f32x4*)(A + e) = (f32x4){bflo(q.x), bfhi(q.x), bflo(q.y), bfhi(q.y)}; *(LAS f32x4*)(A + e + 4) = (f32x4){bflo(q.z), bfhi(q.z), bflo(q.w), bfhi(q.w)}; }
        LDS_WAIT();
        float lg[8][4];
#pragma unroll
        for (int i = 0; i < 4; ++i) { const int j = lane + 64 * i; const bool valid = j < nsel; const int s = valid ? Cs[j] : 0;
            const GLB u32x4* kp = (const GLB u32x4*)(KD + (bm + s) * 128);
            float a8[8];
#pragma unroll
            for (int h = 0; h < 8; ++h) a8[h] = 0.f;
#pragma unroll 1
            for (int pc = 0; pc < 16; ++pc) { const u32x4 kv = kp[pc];
#pragma unroll
                for (int h = 0; h < 8; ++h) a8[h] += dot8(kv, *(const LAS f32x4*)(A + h * 128 + 8 * pc), *(const LAS f32x4*)(A + h * 128 + 8 * pc + 4)); }
#pragma unroll
            for (int h = 0; h < 8; ++h) lg[h][i] = valid ? a8[h] * 0.08838834764831845f : -3.0e38f; }
#pragma unroll
        for (int h = 0; h < 8; ++h) {
            const float mx = wave_max(fmaxf(fmaxf(lg[h][0], lg[h][1]), fmaxf(lg[h][2], lg[h][3])));
            float e[4]; float sm = 0.f;
#pragma unroll
            for (int i = 0; i < 4; ++i) { e[i] = (lg[h][i] > -1.0e38f) ? __expf(lg[h][i] - mx) : 0.f; sm += e[i]; }
            const float inv = 1.0f / wave_sum(sm);
#pragma unroll
            for (int i = 0; i < 4; ++i) Bs[(lane + 64 * i) * 8 + h] = e[i] * inv;
        }
        LDS_WAIT();
        float o[8][2];
#pragma unroll
        for (int h = 0; h < 8; ++h) { o[h][0] = 0.f; o[h][1] = 0.f; }
        for (int j = 0; j < nsel; ++j) { const int s = Cs[j]; const unsigned vv = *(const GLB unsigned*)(VD + (bm + s) * 128 + 2 * lane); const float v0 = bflo(vv), v1 = bfhi(vv);
            const f32x4 pa = *(const LAS f32x4*)(Bs + j * 8), pb = *(const LAS f32x4*)(Bs + j * 8 + 4);
#pragma unroll
            for (int h = 0; h < 4; ++h) { o[h][0] += pa[h] * v0; o[h][1] += pa[h] * v1; o[4 + h][0] += pb[h] * v0; o[4 + h][1] += pb[h] * v1; } }
#pragma unroll
        for (int h = 0; h < 8; ++h) *(GLB unsigned*)(Y + (size_t)m * 4096 + 2048 + h * 128 + 2 * lane) = pk2(o[h][0], o[h][1]);
        LDS_WAIT();
    }
}
typedef float f32x16 __attribute__((ext_vector_type(16)));
__device__ __forceinline__ int wave_isum(int x) {
    x += __builtin_amdgcn_mov_dpp(x, 0x128, 0xf, 0xf, true); x += __builtin_amdgcn_mov_dpp(x, 0x124, 0xf, 0xf, true);
    x += __builtin_amdgcn_mov_dpp(x, 0x122, 0xf, 0xf, true); x += __builtin_amdgcn_mov_dpp(x, 0x121, 0xf, 0xf, true);
    return __builtin_amdgcn_readlane(x, 0) + __builtin_amdgcn_readlane(x, 16) + __builtin_amdgcn_readlane(x, 32) + __builtin_amdgcn_readlane(x, 48);
}
constexpr size_t WS_SBVT = WS_MIX_END;
constexpr size_t WS_SWVT = WS_SBVT + (size_t)32 * 128 * SEQ * 2;
constexpr size_t WS_VDT = WS_SWVT + (size_t)NB * 2 * 64 * SEQ * 2;
constexpr size_t WS_SC = WS_VDT + (size_t)NB * 128 * SEQ * 2;
constexpr size_t WS_SELB = WS_SC + (size_t)T * SEQ * 4;
constexpr size_t WS_END2 = WS_SELB + (size_t)T * 32 * 8;
static_assert(WS_END2 < (size_t)2000 * 1000 * 1000, "workspace budget");

__device__ __forceinline__ void vt_tile(const GLB bf16_t* src, int src_ld, GLB bf16_t* dst, LAS bf16_t* scr, int lane) {
    const int cq = lane & 7, rq = lane >> 3;
    u32x4 v[8];
#pragma unroll
    for (int j = 0; j < 8; ++j) v[j] = *(const GLB u32x4*)(src + (size_t)(rq + 8 * j) * src_ld + 8 * cq);
#pragma unroll
    for (int j = 0; j < 8; ++j) { LAS unsigned* d = (LAS unsigned*)(scr + (rq + 8 * j) * 66 + 8 * cq); d[0] = v[j].x; d[1] = v[j].y; d[2] = v[j].z; d[3] = v[j].w; }
    LDS_WAIT();
#pragma unroll
    for (int j = 0; j < 8; ++j) { const int d = rq + 8 * j; const LAS bf16_t* s = scr + (8 * cq) * 66 + d;
        u32x4 o; o.x = (unsigned)s[0] | ((unsigned)s[66] << 16); o.y = (unsigned)s[2 * 66] | ((unsigned)s[3 * 66] << 16);
        o.z = (unsigned)s[4 * 66] | ((unsigned)s[5 * 66] << 16); o.w = (unsigned)s[6 * 66] | ((unsigned)s[7 * 66] << 16);
        *(GLB u32x4*)(dst + (size_t)d * SEQ + 8 * cq) = o; }
    LDS_WAIT();
}
__device__ __forceinline__ void ph_vt(const Ctx& C) {
    int lane = C.lane; asm volatile("" : "+v"(lane)); lane &= 63;
    LAS bf16_t* scr = (LAS bf16_t*)(C.lds + 65536 + C.wave * 8448);
    for (int it = C.gw; it < 32 * 2 * 32; it += C.NGW) {
        const int sb = it & 31, db = (it >> 5) & 1, bh = it >> 6, b = bh >> 3, h = bh & 7;
        vt_tile(WSP(bf16_t, WS_SBQKV) + ((size_t)b * SEQ + 64 * sb) * 3072 + 2048 + h * 128 + 64 * db, 3072,
                WSP(bf16_t, WS_SBVT) + ((size_t)bh * 128 + 64 * db) * SEQ + 64 * sb, scr, lane);
    }
}

__device__ __forceinline__ void ph_vt_small(const Ctx& C) {
    int lane = C.lane; asm volatile("" : "+v"(lane)); lane &= 63;
    LAS bf16_t* scr = (LAS bf16_t*)(C.lds + C.wave * 8448);
    for (int it = C.gw; it < 512; it += C.NGW) {
        const int sb = it & 31, hd = (it >> 5) & 1, b = (it >> 6) & 3, which = it >> 8;
        if (which == 0) vt_tile(WSP(bf16_t, WS_VS) + ((size_t)b * SEQ + 64 * sb) * 128 + 64 * hd, 128, WSP(bf16_t, WS_SWVT) + ((size_t)(b * 2 + hd) * 64) * SEQ + 64 * sb, scr, lane);
        else vt_tile(WSP(bf16_t, WS_VD) + ((size_t)b * SEQ + 64 * sb) * 128 + 64 * hd, 128, WSP(bf16_t, WS_VDT) + ((size_t)b * 128 + 64 * hd) * SEQ + 64 * sb, scr, lane);
    }
}

__device__ __forceinline__ void sb_item(const Ctx& C, int lane, int bh, int qb) {
    const int c = lane & 31, hh = lane >> 5, b = bh >> 3, h = bh & 7, q0 = 32 * qb;
    const GLB bf16_t* QKV = WSP(bf16_t, WS_SBQKV); const GLB bf16_t* VT = WSP(bf16_t, WS_SBVT);
    const GLB bf16_t* qp = QKV + ((size_t)b * SEQ + q0 + c) * 3072 + h * 128 + 8 * hh;
    bf16x8 qf[8];
#pragma unroll
    for (int ks = 0; ks < 8; ++ks) qf[ks] = *(const GLB bf16x8*)(qp + 16 * ks);
    f32x16 O[4];
#pragma unroll
    for (int db = 0; db < 4; ++db)
#pragma unroll
        for (int r = 0; r < 16; ++r) O[db][r] = 0.f;
    float carry = 1.0f;
    const int km = 16 * ((c >> 2) & 1) + 4 * (c >> 3) + (c & 3);
    const GLB bf16_t* kbase = QKV + ((size_t)b * SEQ + km) * 3072 + 1024 + h * 128 + 8 * hh;
    const GLB bf16_t* vbase = VT + ((size_t)bh * 128 + c) * SEQ + 16 * hh;
    bf16x8 kf[8];
#pragma unroll
    for (int ks = 0; ks < 8; ++ks) kf[ks] = *(const GLB bf16x8*)(kbase + (size_t)q0 * 3072 + 16 * ks);
    for (int kt = qb; kt >= 0; --kt) {
        const int k0 = 32 * kt;
        bf16x8 vf[2][4];
#pragma unroll
        for (int s = 0; s < 2; ++s)
#pragma unroll
            for (int db = 0; db < 4; ++db) vf[s][db] = *(const GLB bf16x8*)(vbase + (size_t)(32 * db) * SEQ + k0 + 8 * s);
        f32x16 S;
#pragma unroll
        for (int r = 0; r < 16; ++r) S[r] = 0.f;
#pragma unroll
        for (int ks = 0; ks < 8; ++ks) S = __builtin_amdgcn_mfma_f32_32x32x16_bf16(kf[ks], qf[ks], S, 0, 0, 0);
        if (kt > 0) {
#pragma unroll
            for (int ks = 0; ks < 8; ++ks) kf[ks] = *(const GLB bf16x8*)(kbase + (size_t)(k0 - 32) * 3072 + 16 * ks);
        }
        const bool diag = (kt == qb);
        float w[16]; float sp = 1.0f;
#pragma unroll
        for (int r = 15; r >= 0; --r) {
            const float z = S[r] * 0.08838834764831845f;
            const float e = __expf(-fabsf(z)), rr = __builtin_amdgcn_rcpf(1.0f + e), er = e * rr;
            const bool pos = z >= 0.f;
            const bool valid = !diag || (16 * hh + r < c);
            const float beta = valid ? (pos ? rr : er) : 0.f, om = valid ? (pos ? er : rr) : 1.0f;
            w[r] = beta * sp; sp *= om;
        }
        const float tot_other = __shfl_xor(sp, 32);
        const float pre = carry * (hh == 0 ? tot_other : 1.0f);
        carry *= sp * tot_other;
        const bool live = __ballot(carry >= 1.0e-30f) != 0ull;
        bf16x8 pw[2];
#pragma unroll
        for (int s = 0; s < 2; ++s) { u32x4 t; t.x = pk2(w[8 * s] * pre, w[8 * s + 1] * pre); t.y = pk2(w[8 * s + 2] * pre, w[8 * s + 3] * pre);
            t.z = pk2(w[8 * s + 4] * pre, w[8 * s + 5] * pre); t.w = pk2(w[8 * s + 6] * pre, w[8 * s + 7] * pre); pw[s] = __builtin_bit_cast(bf16x8, t); }
#pragma unroll
        for (int s = 0; s < 2; ++s)
#pragma unroll
            for (int db = 0; db < 4; ++db) O[db] = __builtin_amdgcn_mfma_f32_32x32x16_bf16(vf[s][db], pw[s], O[db], 0, 0, 0);
        if (!live) break;
    }
    GLB bf16_t* yp = WSP(bf16_t, WS_Y) + ((size_t)b * SEQ + q0 + c) * 4096 + h * 128 + 4 * hh;
#pragma unroll
    for (int db = 0; db < 4; ++db)
#pragma unroll
        for (int a = 0; a < 4; ++a) { u32x2 o; o.x = pk2(O[db][4 * a], O[db][4 * a + 1]); o.y = pk2(O[db][4 * a + 2], O[db][4 * a + 3]);
            *(GLB u32x2*)(yp + 32 * db + 8 * a) = o; }
}
__device__ __forceinline__ void ph_sb_fast(const Ctx& C) {
    int lane = C.lane; asm volatile("" : "+v"(lane)); lane &= 63;
    const int pi = blockIdx.x * 4 + (C.wave & 3);
    if (pi < 1024) { const int bh = pi >> 5, j = pi & 31; sb_item(C, lane, bh, (C.wave >> 2) ? 63 - j : j); }
}

#ifndef SWA_OUT_OFF
#define SWA_OUT_OFF WS_Y
#endif
__device__ __forceinline__ void swa_item(const Ctx& C, int lane, int l, int b, int h, int tb) {
    const int c = lane & 31, hh = lane >> 5, t0 = 32 * tb, kvh = h >> 3;
    const GLB bf16_t* qp = WSP(bf16_t, WS_QS) + ((size_t)b * SEQ + t0 + c) * 1024 + h * 64 + 8 * hh;
    bf16x8 qf[4];
#pragma unroll
    for (int ks = 0; ks < 4; ++ks) qf[ks] = *(const GLB bf16x8*)(qp + 16 * ks);
    const int km = 16 * ((c >> 2) & 1) + 4 * (c >> 3) + (c & 3);
    const GLB bf16_t* kbase = WSP(bf16_t, WS_KS) + ((size_t)b * SEQ + km) * 128 + kvh * 64 + 8 * hh;
    const GLB bf16_t* vbase = WSP(bf16_t, WS_SWVT) + ((size_t)(b * 2 + kvh) * 64 + c) * SEQ + 16 * hh;
    float mrun = INF32(I_SSINK)[l * 16 + h], lrun = 1.0f;
    f32x16 O[2];
#pragma unroll
    for (int db = 0; db < 2; ++db)
#pragma unroll
        for (int r = 0; r < 16; ++r) O[db][r] = 0.f;
    const int i0 = (tb >= 4) ? 0 : 4 - tb;
    for (int i = i0; i < 5; ++i) {
        const int k0 = t0 - 128 + 32 * i;
        bf16x8 kf[4], vf[2][2];
#pragma unroll
        for (int ks = 0; ks < 4; ++ks) kf[ks] = *(const GLB bf16x8*)(kbase + (size_t)k0 * 128 + 16 * ks);
#pragma unroll
        for (int s = 0; s < 2; ++s)
#pragma unroll
            for (int db = 0; db < 2; ++db) vf[s][db] = *(const GLB bf16x8*)(vbase + (size_t)(32 * db) * SEQ + k0 + 8 * s);
        f32x16 a;
#pragma unroll
        for (int r = 0; r < 16; ++r) a[r] = 0.f;
#pragma unroll
        for (int ks = 0; ks < 4; ++ks) a = __builtin_amdgcn_mfma_f32_32x32x16_bf16(kf[ks], qf[ks], a, 0, 0, 0);
        float tmax = -1.0e30f;
#pragma unroll
        for (int r = 0; r < 16; ++r) { const int kr = 16 * hh + r; const bool valid = (i == 0) ? (kr > c) : ((i == 4) ? (kr <= c) : true); a[r] = valid ? a[r] * 0.125f : -1.0e30f; tmax = fmaxf(tmax, a[r]); }
        tmax = fmaxf(tmax, __shfl_xor(tmax, 32));
        const float mnew = fmaxf(mrun, tmax), alpha = __expf(mrun - mnew);
        float psum = 0.f;
#pragma unroll
        for (int r = 0; r < 16; ++r) { a[r] = __expf(a[r] - mnew); psum += a[r]; }
        psum += __shfl_xor(psum, 32);
        lrun = lrun * alpha + psum; mrun = mnew;
#pragma unroll
        for (int db = 0; db < 2; ++db)
#pragma unroll
            for (int r = 0; r < 16; ++r) O[db][r] *= alpha;
#pragma unroll
        for (int s = 0; s < 2; ++s) {
            u32x4 t; t.x = pk2(a[8 * s], a[8 * s + 1]); t.y = pk2(a[8 * s + 2], a[8 * s + 3]); t.z = pk2(a[8 * s + 4], a[8 * s + 5]); t.w = pk2(a[8 * s + 6], a[8 * s + 7]);
            const bf16x8 pw = __builtin_bit_cast(bf16x8, t);
#pragma unroll
            for (int db = 0; db < 2; ++db) O[db] = __builtin_amdgcn_mfma_f32_32x32x16_bf16(vf[s][db], pw, O[db], 0, 0, 0);
        }
    }
    const float inv = 1.0f / lrun;
    GLB bf16_t* yp = WSP(bf16_t, SWA_OUT_OFF) + ((size_t)b * SEQ + t0 + c) * 4096 + 3072 + h * 64 + 4 * hh;
#pragma unroll
    for (int db = 0; db < 2; ++db)
#pragma unroll
        for (int a4 = 0; a4 < 4; ++a4) { u32x2 o; o.x = pk2(O[db][4 * a4] * inv, O[db][4 * a4 + 1] * inv); o.y = pk2(O[db][4 * a4 + 2] * inv, O[db][4 * a4 + 3] * inv);
            *(GLB u32x2*)(yp + 32 * db + 8 * a4) = o; }
}
__device__ __forceinline__ void ph_swa_fast(const Ctx& C, int l) {
    int lane = C.lane; asm volatile("" : "+v"(lane)); lane &= 63;
    if (C.wave >= 4) return;
    for (int it = blockIdx.x * 4 + C.wave; it < NB * 64 * 16; it += C.G * 4) { const int h = it & 15, tb = (it >> 4) & 63, b = it >> 10; swa_item(C, lane, l, b, h, tb); }
}

__device__ __forceinline__ float row16_sum(float x) {
    x += __builtin_bit_cast(float, __builtin_amdgcn_mov_dpp(__builtin_bit_cast(int, x), 0x128, 0xf, 0xf, true));
    x += __builtin_bit_cast(float, __builtin_amdgcn_mov_dpp(__builtin_bit_cast(int, x), 0x124, 0xf, 0xf, true));
    x += __builtin_bit_cast(float, __builtin_amdgcn_mov_dpp(__builtin_bit_cast(int, x), 0x122, 0xf, 0xf, true));
    x += __builtin_bit_cast(float, __builtin_amdgcn_mov_dpp(__builtin_bit_cast(int, x), 0x121, 0xf, 0xf, true));
    return x;
}
__device__ __forceinline__ void ph_rwkv_scan_fast(const Ctx& C) {
    int tid = C.tid; asm volatile("" : "+v"(tid));
    const int lane = tid & 63, wave = C.wave;
    LAS float* buf = (LAS float*)C.lds;
    constexpr int CH = 32, CHF = CH * 384;
    for (int it = blockIdx.x; it < NB * 16 * 4; it += C.G) {
        const int qr = it & 3, h = (it >> 2) & 15, b = it >> 6;
        const size_t gbase = (size_t)b * SEQ * 1024 + h * 64;
        const int ro = lane >> 4, kq = lane & 15, row = 16 * qr + 4 * (wave & 3) + ro;
        float S0 = 0.f, S1 = 0.f, S2 = 0.f, S3 = 0.f;
        const int lj = tid - 256;
        auto load_chunk = [&](int cidx) {
            f32x4 v[12];
#pragma unroll
            for (int i = 0; i < 12; ++i) { const int idx = lj + 256 * i, step = idx / 96, rem = idx - step * 96, vec = rem >> 4, e4 = rem & 15;
                const size_t off = (vec == 0) ? WS_R : (vec == 1) ? WS_DEC : (vec == 2) ? WS_K : (vec == 3) ? WS_KK : (vec == 4) ? WS_AA : WS_V;
                v[i] = *(const GLB f32x4*)(WSP(float, off) + gbase + (size_t)(cidx * CH + step) * 1024 + 4 * e4); }
            LAS float* d = buf + (cidx & 1) * CHF;
#pragma unroll
            for (int i = 0; i < 12; ++i) { const int idx = lj + 256 * i, step = idx / 96, rem = idx - step * 96; *(LAS f32x4*)(d + step * 384 + rem * 4) = v[i]; }
        };
        if (wave >= 4) load_chunk(0);
        LDS_WAIT(); __syncthreads();
        for (int cidx = 0; cidx < SEQ / CH; ++cidx) {
            if (wave >= 4) { if (cidx + 1 < SEQ / CH) load_chunk(cidx + 1); }
            else {
                const LAS float* cb = buf + (cidx & 1) * CHF;
#pragma unroll 4
                for (int st = 0; st < CH; ++st) {
                    const LAS float* rb = cb + st * 384;
                    const f32x4 kk4 = *(const LAS f32x4*)(rb + 192 + 4 * kq);
                    const float p = row16_sum(S0 * kk4[0] + S1 * kk4[1] + S2 * kk4[2] + S3 * kk4[3]);
                    const f32x4 w4 = *(const LAS f32x4*)(rb + 64 + 4 * kq), b4 = *(const LAS f32x4*)(rb + 256 + 4 * kq), k4 = *(const LAS f32x4*)(rb + 128 + 4 * kq), r4 = *(const LAS f32x4*)(rb + 4 * kq);
                    const float vv = rb[320 + row];
                    S0 = S0 * w4[0] - p * b4[0] + vv * k4[0]; S1 = S1 * w4[1] - p * b4[1] + vv * k4[1]; S2 = S2 * w4[2] - p * b4[2] + vv * k4[2]; S3 = S3 * w4[3] - p * b4[3] + vv * k4[3];
                    const float y = row16_sum(S0 * r4[0] + S1 * r4[1] + S2 * r4[2] + S3 * r4[3]);
                    if (kq == 0) WSP(float, WS_YRAW)[gbase + (size_t)(cidx * CH + st) * 1024 + row] = y;
                }
            }
            LDS_WAIT(); __syncthreads();
        }
    }
}

__device__ __forceinline__ void dsa_item(const Ctx& C, int lane, int wave, int b, int g) {
    const int c = lane & 31, hh = lane >> 5, t0 = 4 * g;
    LAS float* sc = (LAS float*)(C.lds + wave * 17408);
    LAS unsigned* bm = (LAS unsigned*)(C.lds + wave * 17408 + 16384);
    const size_t bm0 = (size_t)b * SEQ;
    const int ntile = (t0 + 3) / 32 + 1;
#pragma unroll 1
    for (int p = 0; p < 2; ++p) {
        {
            const int qq = t0 + 2 * p + ((c >> 2) & 1), hd = (c & 3) + 4 * (c >> 3);
            const GLB bf16_t* qp = WSP(bf16_t, WS_QI) + (bm0 + qq) * 1024 + hd * 64 + 8 * hh;
            bf16x8 qf[4];
#pragma unroll
            for (int ks = 0; ks < 4; ++ks) qf[ks] = *(const GLB bf16x8*)(qp + 16 * ks);
            const GLB float* wp = WSP(float, WS_WI) + (bm0 + t0 + 2 * p + hh) * 16;
            f32x4 w4[4];
#pragma unroll
            for (int j = 0; j < 4; ++j) w4[j] = *(const GLB f32x4*)(wp + 4 * j);
            const GLB bf16_t* kp = WSP(bf16_t, WS_KI) + (bm0 + c) * 64 + 8 * hh;
            bf16x8 kf[4];
#pragma unroll
            for (int ks = 0; ks < 4; ++ks) kf[ks] = *(const GLB bf16x8*)(kp + 16 * ks);
            for (int kt = 0; kt < ntile; ++kt) {
                f32x16 a;
#pragma unroll
                for (int r = 0; r < 16; ++r) a[r] = 0.f;
#pragma unroll
                for (int ks = 0; ks < 4; ++ks) a = __builtin_amdgcn_mfma_f32_32x32x16_bf16(qf[ks], kf[ks], a, 0, 0, 0);
                if (kt + 1 < ntile) {
#pragma unroll
                    for (int ks = 0; ks < 4; ++ks) kf[ks] = *(const GLB bf16x8*)(kp + (size_t)(32 * (kt + 1)) * 64 + 16 * ks);
                }
                float s = 0.f;
#pragma unroll
                for (int r = 0; r < 16; ++r) s += w4[r >> 2][r & 3] * fmaxf(a[r], 0.f);
                sc[hh * 2048 + 32 * kt + c] = s;
            }
        }
        LDS_WAIT();
#pragma unroll 1
        for (int qs = 0; qs < 2; ++qs) {
            const int t = t0 + 2 * p + qs, n = t + 1;
            const LAS float* sq = sc + qs * 2048;
            unsigned myword_lo = 0u, myword_hi = 0u;
            if (n <= 256) {
#pragma unroll
                for (int i = 0; i < 4; ++i) { const unsigned long long bal = __ballot(lane + 64 * i < n); if (lane == i) { myword_lo = (unsigned)bal; myword_hi = (unsigned)(bal >> 32); } }
            } else {
                unsigned key[32];
#pragma unroll
                for (int i = 0; i < 32; ++i) { const int s = lane + 64 * i; key[i] = (s < n) ? ordkey(sq[s]) : 0u; }
                unsigned tau = 0u;
                for (int bit = 31; bit >= 0; --bit) {
                    const unsigned cand = tau | (1u << bit); int cl = 0;
#pragma unroll
                    for (int i = 0; i < 32; ++i) cl += (key[i] >= cand) ? 1 : 0;
                    const int cnt = wave_isum(cl);
                    if (cnt >= 256) { tau = cand; if (cnt == 256) break; }
                }
                int cgl = 0;
#pragma unroll
                for (int i = 0; i < 32; ++i) cgl += (key[i] > tau) ? 1 : 0;
                const int cgt = wave_isum(cgl);
                const int need = 256 - cgt; int eqbase = 0;
                const unsigned long long lt = (1ull << lane) - 1ull;
#pragma unroll
                for (int i = 0; i < 32; ++i) {
                    const bool gt = key[i] > tau, eq = key[i] == tau;
                    const unsigned long long beq = __ballot(eq);
                    const bool sel = gt || (eq && (eqbase + __popcll(beq & lt)) < need);
                    const unsigned long long bal = __ballot(sel);
                    if (lane == i) { myword_lo = (unsigned)bal; myword_hi = (unsigned)(bal >> 32); }
                    eqbase += __popcll(beq);
                }
            }
            if (lane < 32) { bm[(2 * p + qs) * 64 + 2 * lane] = myword_lo; bm[(2 * p + qs) * 64 + 2 * lane + 1] = myword_hi; }
        }
        LDS_WAIT();
    }
    const int cq = c >> 3, ch = c & 7;
    const GLB bf16_t* qp = WSP(bf16_t, WS_QD) + (bm0 + t0 + cq) * 1024 + ch * 128 + 8 * hh;
    bf16x8 qf[8];
#pragma unroll
    for (int ks = 0; ks < 8; ++ks) qf[ks] = *(const GLB bf16x8*)(qp + 16 * ks);
    const int km = 16 * ((c >> 2) & 1) + 4 * (c >> 3) + (c & 3);
    const GLB bf16_t* kbase = WSP(bf16_t, WS_KD) + (bm0 + km) * 128 + 8 * hh;
    const GLB bf16_t* vbase = WSP(bf16_t, WS_VDT) + ((size_t)b * 128 + c) * SEQ + 16 * hh;
    const LAS unsigned short* bmh = (const LAS unsigned short*)(bm + cq * 64) + hh;
    float mrun = -1.0e20f, lrun = 0.f;
    f32x16 O[4];
#pragma unroll
    for (int db = 0; db < 4; ++db)
#pragma unroll
        for (int r = 0; r < 16; ++r) O[db][r] = 0.f;
    bf16x8 kf[8];
#pragma unroll
    for (int ks = 0; ks < 8; ++ks) kf[ks] = *(const GLB bf16x8*)(kbase + 16 * ks);
    for (int kt = 0; kt < ntile; ++kt) {
        const int k0 = 32 * kt;
        bf16x8 vf[2][4];
#pragma unroll
        for (int s = 0; s < 2; ++s)
#pragma unroll
            for (int db = 0; db < 4; ++db) vf[s][db] = *(const GLB bf16x8*)(vbase + (size_t)(32 * db) * SEQ + k0 + 8 * s);
        const unsigned bits = bmh[2 * kt];
        f32x16 a;
#pragma unroll
        for (int r = 0; r < 16; ++r) a[r] = 0.f;
#pragma unroll
        for (int ks = 0; ks < 8; ++ks) a = __builtin_amdgcn_mfma_f32_32x32x16_bf16(kf[ks], qf[ks], a, 0, 0, 0);
        if (kt + 1 < ntile) {
#pragma unroll
            for (int ks = 0; ks < 8; ++ks) kf[ks] = *(const GLB bf16x8*)(kbase + (size_t)(k0 + 32) * 128 + 16 * ks);
        }
        float tmax = -1.0e30f;
#pragma unroll
        for (int r = 0; r < 16; ++r) { a[r] = ((bits >> r) & 1u) ? a[r] * 0.08838834764831845f : -1.0e30f; tmax = fmaxf(tmax, a[r]); }
        tmax = fmaxf(tmax, __shfl_xor(tmax, 32));
        if (__ballot(tmax > mrun + 8.0f) != 0ull) {
            const float mnew = fmaxf(mrun, tmax), alpha = __expf(mrun - mnew);
            lrun *= alpha; mrun = mnew;
#pragma unroll
            for (int db = 0; db < 4; ++db)
#pragma unroll
                for (int r = 0; r < 16; ++r) O[db][r] *= alpha;
        }
        float psum = 0.f;
#pragma unroll
        for (int r = 0; r < 16; ++r) { a[r] = __expf(a[r] - mrun); psum += a[r]; }
        psum += __shfl_xor(psum, 32);
        lrun += psum;
#pragma unroll
        for (int s = 0; s < 2; ++s) {
            u32x4 t; t.x = pk2(a[8 * s], a[8 * s + 1]); t.y = pk2(a[8 * s + 2], a[8 * s + 3]); t.z = pk2(a[8 * s + 4], a[8 * s + 5]); t.w = pk2(a[8 * s + 6], a[8 * s + 7]);
            const bf16x8 pw = __builtin_bit_cast(bf16x8, t);
#pragma unroll
            for (int db = 0; db < 4; ++db) O[db] = __builtin_amdgcn_mfma_f32_32x32x16_bf16(vf[s][db], pw, O[db], 0, 0, 0);
        }
    }
    const float inv = 1.0f / lrun;
    GLB bf16_t* yp = WSP(bf16_t, WS_Y) + (bm0 + t0 + cq) * 4096 + 2048 + ch * 128 + 4 * hh;
#pragma unroll
    for (int db = 0; db < 4; ++db)
#pragma unroll
        for (int a4 = 0; a4 < 4; ++a4) { u32x2 o; o.x = pk2(O[db][4 * a4] * inv, O[db][4 * a4 + 1] * inv); o.y = pk2(O[db][4 * a4 + 2] * inv, O[db][4 * a4 + 3] * inv);
            *(GLB u32x2*)(yp + 32 * db + 8 * a4) = o; }
    LDS_WAIT();
}
__device__ __forceinline__ void ph_dsa_fast(const Ctx& C) {
    int lane = C.lane; asm volatile("" : "+v"(lane)); lane &= 63;
    const int pi = blockIdx.x * 4 + (C.wave & 3);
    if (pi < 1024) { const int b = pi >> 8, j = pi & 255; dsa_item(C, lane, C.wave, b, (C.wave >> 2) ? 511 - j : j); }
}

constexpr int SCAN_CNT_OFF = MISC_OFF + 64;
__device__ __forceinline__ void ph_rwkv_scan_conv(const Ctx& C, int l) {
    int tid = C.tid; asm volatile("" : "+v"(tid));
    const int lane = tid & 63, wave = C.wave;
    if (wave >= 4) {
        LAS float* scr = (LAS float*)(C.lds + 65536 + (wave - 4) * 16640);
        constexpr int PER = MOE_CONV_ITEMS / 2 / 1024;
        const int first = l * (MOE_CONV_ITEMS / 2) + (blockIdx.x * 4 + (wave - 4)) * PER;
        if (!MOE_CONV_IN_PROLOGUE && blockIdx.x < 256)
            for (int i = 0; i < PER; ++i) conv_moe_item(C, first + i, scr, lane);
        return;
    }
    constexpr int CH = 16, CHF = CH * 384, NCH = SEQ / CH;
    LAS float* buf = (LAS float*)C.lds;
    volatile LAS unsigned* cnt = (volatile LAS unsigned*)(C.lds + SCAN_CNT_OFF);
    const int it = blockIdx.x;
    if (it >= NB * 16 * 4) return;
    const int qr = it & 3, h = (it >> 2) & 15, b = it >> 6;
    const size_t gbase = (size_t)b * SEQ * 1024 + h * 64;
    const int ro = lane >> 4, kq = lane & 15, row = 16 * qr + 4 * wave + ro;
    unsigned target = (unsigned)l * 4u * (NCH + 1);
    auto issue = [&](int cidx) {
#pragma unroll
        for (int j = 0; j < 6; ++j) { const int i = wave + 4 * j, rho = 4 * i + ro, step = rho / 6, vec = rho - 6 * step;
            const size_t off = (vec == 0) ? WS_R : (vec == 1) ? WS_DEC : (vec == 2) ? WS_K : (vec == 3) ? WS_KK : (vec == 4) ? WS_AA : WS_V;
            const GLB float* src = WSP(float, off) + gbase + (size_t)(cidx * CH + step) * 1024 + 4 * kq;
            __builtin_amdgcn_global_load_lds((const GLB unsigned*)src, (LAS unsigned*)(buf + (cidx & 1) * CHF + i * 256), 16, 0, 0); }
    };
    auto arrive_wait = [&]() {
        asm volatile("s_waitcnt vmcnt(0)" ::: "memory");
        target += 4u;
        if (lane == 0) (void)__hip_atomic_fetch_add((LAS unsigned*)(C.lds + SCAN_CNT_OFF), 1u, __ATOMIC_RELAXED, __HIP_MEMORY_SCOPE_WORKGROUP);
        while ((int)(*cnt - target) < 0) __builtin_amdgcn_s_sleep(1);
        asm volatile("" ::: "memory");
    };
    float S0 = 0.f, S1 = 0.f, S2 = 0.f, S3 = 0.f;
    issue(0); arrive_wait();
    for (int cidx = 0; cidx < NCH; ++cidx) {
        if (cidx + 1 < NCH) issue(cidx + 1);
        const LAS float* cb = buf + (cidx & 1) * CHF;
#pragma unroll 4
        for (int st = 0; st < CH; ++st) {
            const LAS float* rb = cb + st * 384;
            const f32x4 kk4 = *(const LAS f32x4*)(rb + 192 + 4 * kq);
            const float p = row16_sum(S0 * kk4[0] + S1 * kk4[1] + S2 * kk4[2] + S3 * kk4[3]);
            const f32x4 w4 = *(const LAS f32x4*)(rb + 64 + 4 * kq), b4 = *(const LAS f32x4*)(rb + 256 + 4 * kq), k4 = *(const LAS f32x4*)(rb + 128 + 4 * kq), r4 = *(const LAS f32x4*)(rb + 4 * kq);
            const float vv = rb[320 + row];
            S0 = S0 * w4[0] - p * b4[0] + vv * k4[0]; S1 = S1 * w4[1] - p * b4[1] + vv * k4[1]; S2 = S2 * w4[2] - p * b4[2] + vv * k4[2]; S3 = S3 * w4[3] - p * b4[3] + vv * k4[3];
            const float y = row16_sum(S0 * r4[0] + S1 * r4[1] + S2 * r4[2] + S3 * r4[3]);
            if (kq == 0) WSP(float, WS_YRAW)[gbase + (size_t)(cidx * CH + st) * 1024 + row] = y;
        }
        asm volatile("s_waitcnt lgkmcnt(0)" ::: "memory");
        arrive_wait();
    }
}

#ifndef SCAN3_CONV_MODE
#define SCAN3_CONV_MODE 0
#endif
#ifndef CONV_NT
#define CONV_NT 3
#endif
__device__ __forceinline__ void conv_tile_load(const GLB float* W, int ldw, int k0, int s0, f32x4 (&v)[16], int lane) {
    const int cq = lane & 15, rq = lane >> 4;
    const unsigned loff = (unsigned)(rq * ldw + 4 * cq);
    const GLB float* base = W + (size_t)k0 * ldw + s0;
#pragma unroll
    for (int i = 0; i < 16; ++i) { const GLB float* rowp = base + (size_t)(4 * i) * ldw; v[i] = CONV_NT ? __builtin_nontemporal_load((const GLB f32x4*)(rowp + loff)) : *(const GLB f32x4*)(rowp + loff); }
}
__device__ __forceinline__ void conv_tile_to_lds(const f32x4 (&v)[16], LAS float* scr, int lane) {
    const int cq = lane & 15, rq = lane >> 4;
#pragma unroll
    for (int i = 0; i < 16; ++i) { const int kk = 4 * i + rq; LAS float* d = scr + kk * 65 + 4 * cq; d[0] = v[i][0]; d[1] = v[i][1]; d[2] = v[i][2]; d[3] = v[i][3]; }
}
__device__ __forceinline__ void conv_tile_from_lds(GLB bf16_t* Bt, int K, int n0, int k0, LAS float* scr, int lane) {
    const int c = lane & 7;
#pragma unroll
    for (int j = 0; j < 8; ++j) { const int n = (lane >> 3) + 8 * j; const LAS float* s = scr + (8 * c) * 65 + n;
        u32x4 o; o.x = pk2(s[0 * 65], s[1 * 65]); o.y = pk2(s[2 * 65], s[3 * 65]); o.z = pk2(s[4 * 65], s[5 * 65]); o.w = pk2(s[6 * 65], s[7 * 65]);
        if (CONV_NT & 2) __builtin_nontemporal_store(o, (GLB u32x4*)(Bt + (size_t)(n0 + n) * K + k0 + 8 * c)); else *(GLB u32x4*)(Bt + (size_t)(n0 + n) * K + k0 + 8 * c) = o; }
}
__device__ __forceinline__ void conv_tile_finish(const f32x4 (&v)[16], GLB bf16_t* Bt, int K, int n0, int k0, LAS float* scr, int lane) {
    conv_tile_to_lds(v, scr, lane); LDS_WAIT(); conv_tile_from_lds(Bt, K, n0, k0, scr, lane); LDS_WAIT();
}
struct MoeTile { const GLB float* W; GLB bf16_t* Bt; int ldw, K, k0, s0, n0; };
__device__ __forceinline__ MoeTile moe_tile_desc(const Ctx& C, int idx) {
    constexpr int I_GU1 = (D / 64) * (2 * FF / 64), I_DN1 = (FF / 64) * (D / 64);
    MoeTile t;
    if (idx < NE * I_GU1) {
        const int e = idx / I_GU1, r = idx % I_GU1, nb = r % (2 * FF / 64), kb = r / (2 * FF / 64), tile = nb >> 2, q = nb & 3;
        t.W = ((q < 2) ? INF32(I_MG) : INF32(I_MU)) + (size_t)e * D * FF; t.ldw = FF; t.k0 = 64 * kb; t.s0 = 128 * tile + 64 * (q & 1);
        t.Bt = WSP(bf16_t, WS_MWGU) + (size_t)e * 2 * FF * D; t.K = D; t.n0 = 64 * nb;
    } else {
        const int r0 = idx - NE * I_GU1, e = r0 / I_DN1, r = r0 % I_DN1, nb = r % 32, kb = r / 32;
        t.W = INF32(I_MD) + (size_t)e * FF * D; t.ldw = D; t.k0 = 64 * kb; t.s0 = 64 * nb; t.Bt = WSP(bf16_t, WS_MWD) + (size_t)e * D * FF; t.K = FF; t.n0 = 64 * nb;
    }
    return t;
}
__device__ __forceinline__ void ph_rwkv_scan4(const Ctx& C, int l) {
    int tid = C.tid; asm volatile("" : "+v"(tid));
    const int lane = tid & 63, wave = C.wave;
    if (wave >= 4) {
        if (MOE_CONV_IN_PROLOGUE || blockIdx.x >= 256) return;
        LAS float* scr = (LAS float*)(C.lds + 65536 + (wave - 4) * 16640);
        constexpr int PER = MOE_CONV_ITEMS / 2 / 1024;
        const int first = l * (MOE_CONV_ITEMS / 2) + (blockIdx.x * 4 + (wave - 4)) * PER;
        f32x4 va[16], vb[16];
        MoeTile ta = moe_tile_desc(C, first), tb;
        conv_tile_load(ta.W, ta.ldw, ta.k0, ta.s0, va, lane);
        for (int i = 0; i < PER; i += 2) {
            tb = moe_tile_desc(C, first + i + 1);
            conv_tile_load(tb.W, tb.ldw, tb.k0, tb.s0, vb, lane);
            conv_tile_finish(va, ta.Bt, ta.K, ta.n0, ta.k0, scr, lane);
            if (i + 2 < PER) { ta = moe_tile_desc(C, first + i + 2); conv_tile_load(ta.W, ta.ldw, ta.k0, ta.s0, va, lane); }
            conv_tile_finish(vb, tb.Bt, tb.K, tb.n0, tb.k0, scr, lane);
        }
        return;
    }
    constexpr int CH = 16, CHF = CH * 384, NCH = SEQ / CH;
    LAS float* buf = (LAS float*)C.lds;
    LAS float* ybuf = (LAS float*)(C.lds + 49152);
    volatile LAS unsigned* cnt = (volatile LAS unsigned*)(C.lds + SCAN_CNT_OFF);
    const int it = blockIdx.x;
    if (it >= NB * 16 * 4) return;
    const int qr = it & 3, h = (it >> 2) & 15, b = it >> 6;
    const size_t gbase = (size_t)b * SEQ * 1024 + h * 64;
    const int ro = lane >> 4, kq = lane & 15, rloc = 4 * wave + ro;
    unsigned target = (unsigned)l * 4u * (NCH + 1);
    auto issue = [&](int cidx) {
#pragma unroll
        for (int j = 0; j < 6; ++j) { const int i = wave + 4 * j, rho = 4 * i + ro, step = rho / 6, vec = rho - 6 * step;
            const size_t off = (vec == 0) ? WS_R : (vec == 1) ? WS_DEC : (vec == 2) ? WS_K : (vec == 3) ? WS_KK : (vec == 4) ? WS_AA : WS_V;
            const GLB float* src = WSP(float, off) + gbase + (size_t)(cidx * CH + step) * 1024 + 4 * kq;
            __builtin_amdgcn_global_load_lds((const GLB unsigned*)src, (LAS unsigned*)(buf + (cidx & 1) * CHF + i * 256), 16, 0, 0); }
    };
    auto arrive_wait = [&]() {
        asm volatile("s_waitcnt vmcnt(0) lgkmcnt(0)" ::: "memory");
        target += 4u;
        if (lane == 0) (void)__hip_atomic_fetch_add((LAS unsigned*)(C.lds + SCAN_CNT_OFF), 1u, __ATOMIC_RELAXED, __HIP_MEMORY_SCOPE_WORKGROUP);
        while ((int)(*cnt - target) < 0) __builtin_amdgcn_s_sleep(1);
        asm volatile("" ::: "memory");
    };
    auto flush_y = [&](int cidx) {
        const int st = lane >> 2, r = lane & 3;
        WSP(float, WS_YRAW)[gbase + (size_t)(cidx * CH + st) * 1024 + 16 * qr + 4 * wave + r] = ybuf[(cidx & 1) * 256 + st * 16 + 4 * wave + r];
    };
    f32x2 Sa = {0.f, 0.f}, Sb = {0.f, 0.f};
    issue(0); arrive_wait();
    for (int cidx = 0; cidx < NCH; ++cidx) {
        if (cidx > 0) flush_y(cidx - 1);
        if (cidx + 1 < NCH) issue(cidx + 1);
        const LAS float* cb = buf + (cidx & 1) * CHF;
        LAS float* yb = ybuf + (cidx & 1) * 256;
#pragma unroll 4
        for (int st = 0; st < CH; ++st) {
            const LAS float* rb = cb + st * 384;
            const f32x4 kk4 = *(const LAS f32x4*)(rb + 192 + 4 * kq);
            const f32x2 tp = Sa * (f32x2){kk4[0], kk4[1]} + Sb * (f32x2){kk4[2], kk4[3]};
            const float p = row16_sum(tp[0] + tp[1]);
            const f32x4 w4 = *(const LAS f32x4*)(rb + 64 + 4 * kq), b4 = *(const LAS f32x4*)(rb + 256 + 4 * kq), k4 = *(const LAS f32x4*)(rb + 128 + 4 * kq), r4 = *(const LAS f32x4*)(rb + 4 * kq);
            const float vv = rb[320 + 16 * qr + rloc];
            const f32x2 pp = {p, p}, vv2 = {vv, vv};
            Sa = Sa * (f32x2){w4[0], w4[1]} - pp * (f32x2){b4[0], b4[1]} + vv2 * (f32x2){k4[0], k4[1]};
            Sb = Sb * (f32x2){w4[2], w4[3]} - pp * (f32x2){b4[2], b4[3]} + vv2 * (f32x2){k4[2], k4[3]};
            const f32x2 ty = Sa * (f32x2){r4[0], r4[1]} + Sb * (f32x2){r4[2], r4[3]};
            const float y = row16_sum(ty[0] + ty[1]);
            if (kq == 0) yb[st * 16 + rloc] = y;
        }
        arrive_wait();
    }
    flush_y(NCH - 1);
}

#ifndef SCAN_SCHED
#define SCAN_SCHED 3
#endif
#ifndef SCAN_UNROLL
#define SCAN_UNROLL 4
#endif
__device__ __forceinline__ void ph_rwkv_scan3(const Ctx& C, int l) {
    int tid = C.tid; asm volatile("" : "+v"(tid));
    const int lane = tid & 63, wave = C.wave;
    constexpr int CH = 16, CHF = CH * 384, NCH = SEQ / CH;
    LAS float* buf = (LAS float*)C.lds;
    LAS float* ybuf = (LAS float*)(C.lds + 49152);
    LAS float* scr = (LAS float*)(C.lds + 65536 + (wave & 3) * 16640);
    const int it = blockIdx.x;
    if (it >= NB * 16 * 4) return;
    const int qr = it & 3, h = (it >> 2) & 15, b = it >> 6;
    const size_t gbase = (size_t)b * SEQ * 1024 + h * 64;
    const int ro = lane >> 4, kq = lane & 15, rloc = 4 * (wave & 3) + ro;
    const int lj = tid - 256;
    constexpr int PER = MOE_CONV_ITEMS / 2 / 1024;
    static_assert(PER * 1024 * 2 == MOE_CONV_ITEMS && PER * 3 <= NCH, "conversion slots");
    const int cfirst = l * (MOE_CONV_ITEMS / 2) + (blockIdx.x * 4 + (wave & 3)) * PER;
    auto load_chunk = [&](int cidx) {
        f32x4 v[6];
#pragma unroll
        for (int i = 0; i < 6; ++i) { const int idx = lj + 256 * i, step = idx / 96, rem = idx - step * 96, vec = rem >> 4, e4 = rem & 15;
            const size_t off = (vec == 0) ? WS_R : (vec == 1) ? WS_DEC : (vec == 2) ? WS_K : (vec == 3) ? WS_KK : (vec == 4) ? WS_AA : WS_V;
            v[i] = *(const GLB f32x4*)(WSP(float, off) + gbase + (size_t)(cidx * CH + step) * 1024 + 4 * e4); }
        LAS float* d = buf + (cidx & 1) * CHF;
#pragma unroll
        for (int i = 0; i < 6; ++i) { const int idx = lj + 256 * i, step = idx / 96, rem = idx - step * 96; *(LAS f32x4*)(d + step * 384 + rem * 4) = v[i]; }
    };
    auto flush_y = [&](int cidx) {
        const int st = lj >> 4, r = lj & 15;
        WSP(float, WS_YRAW)[gbase + (size_t)(cidx * CH + st) * 1024 + 16 * qr + r] = ybuf[(cidx & 1) * 256 + lj];
    };
    f32x2 Sa = {0.f, 0.f}, Sb = {0.f, 0.f};
    f32x4 cv[16]; MoeTile ct; ct.W = nullptr; ct.Bt = nullptr; ct.ldw = 0; ct.K = 0; ct.k0 = 0; ct.s0 = 0; ct.n0 = 0;
#pragma unroll
    for (int i = 0; i < 16; ++i) cv[i] = (f32x4){0.f, 0.f, 0.f, 0.f};
    if (wave >= 4) load_chunk(0);
    LDS_WAIT(); __syncthreads();
    for (int cidx = 0; cidx < NCH; ++cidx) {
        if (wave >= 4) {
            if (cidx + 1 < NCH) load_chunk(cidx + 1);
            if (cidx > 0) flush_y(cidx - 1);
            if (!MOE_CONV_IN_PROLOGUE) {
                const int q3 = cidx / 3, r3 = cidx - 3 * q3;
                if (r3 == 0 && q3 < PER) { ct = moe_tile_desc(C, cfirst + q3); conv_tile_load(ct.W, ct.ldw, ct.k0, ct.s0, cv, lane); }
                else if (r3 == 1 && q3 < PER) conv_tile_finish(cv, ct.Bt, ct.K, ct.n0, ct.k0, scr, lane);
            }
        } else {
            const LAS float* cb = buf + (cidx & 1) * CHF;
            LAS float* yb = ybuf + (cidx & 1) * 256;
            __builtin_amdgcn_s_setprio(3);
#pragma unroll SCAN_UNROLL
            for (int st = 0; st < CH; ++st) {
                const LAS float* rb = cb + st * 384;
                const f32x4 kk4 = *(const LAS f32x4*)(rb + 192 + 4 * kq);
                const f32x2 tp = Sa * (f32x2){kk4[0], kk4[1]} + Sb * (f32x2){kk4[2], kk4[3]};
                const float p = row16_sum(tp[0] + tp[1]);
                const f32x4 w4 = *(const LAS f32x4*)(rb + 64 + 4 * kq), b4 = *(const LAS f32x4*)(rb + 256 + 4 * kq), k4 = *(const LAS f32x4*)(rb + 128 + 4 * kq), r4 = *(const LAS f32x4*)(rb + 4 * kq);
                const float vv = rb[320 + 16 * qr + rloc];
                const f32x2 pp = {p, p}, vv2 = {vv, vv};
                Sa = Sa * (f32x2){w4[0], w4[1]} - pp * (f32x2){b4[0], b4[1]} + vv2 * (f32x2){k4[0], k4[1]};
                Sb = Sb * (f32x2){w4[2], w4[3]} - pp * (f32x2){b4[2], b4[3]} + vv2 * (f32x2){k4[2], k4[3]};
                const f32x2 ty = Sa * (f32x2){r4[0], r4[1]} + Sb * (f32x2){r4[2], r4[3]};
                const float y = row16_sum(ty[0] + ty[1]);
                if (kq == 0) yb[st * 16 + rloc] = y;
            }
            __builtin_amdgcn_s_setprio(0);
        }
        LDS_WAIT(); __builtin_amdgcn_s_barrier(); asm volatile("" ::: "memory");
    }
    if (wave >= 4) flush_y(NCH - 1);
}


template <int CONV>
__device__ __forceinline__ void ph_rwkv_scan5(const Ctx& C, int l) {
    int tid = C.tid; asm volatile("" : "+v"(tid));
    const int lane = tid & 63, wave = C.wave;
    constexpr int CH = 16, CHF = CH * 384, NCH = SEQ / CH;
    LAS float* buf = (LAS float*)C.lds;
    LAS float* ybuf = (LAS float*)(C.lds + 49152);
    const int it = blockIdx.x;
    if (it >= NB * 16 * 4) return;
    const int qr = it & 3, h = (it >> 2) & 15, b = it >> 6;
    const size_t gbase = (size_t)b * SEQ * 1024 + h * 64;
#define SCAN5_BAR() do { LDS_WAIT(); __builtin_amdgcn_s_barrier(); asm volatile("" ::: "memory"); } while (0)
    if (wave >= 4) {
        LAS float* scr = (LAS float*)(C.lds + 65536 + (wave & 3) * 16640);
        const int lj = tid - 256;
        constexpr int PER = MOE_SCAN_TILES;
        static_assert(PER * 1024 * 2 <= MOE_CONV_ITEMS && PER * 3 + 2 <= NCH && PER % 2 == 0, "conversion slots");
        const int cfirst = ((CONV >= 2) ? 1 : l) * (1024 * PER) + (blockIdx.x * 4 + (wave & 3));
        f32x4 nx[5];
        const unsigned lo_g = (unsigned)((lj >> 4) * 1024 + 4 * (lj & 15));
        const int lo_l = (lj >> 4) * 384 + 4 * (lj & 15);
        const f32x4 kkw = *(const GLB f32x4*)(INF32(I_RWKK) + l * 1024 + h * 64 + 4 * (lj & 15)), kaw = *(const GLB f32x4*)(INF32(I_RWKA) + l * 1024 + h * 64 + 4 * (lj & 15));
        u32x2 nb[4];
        auto fetch_chunk = [&](int cidx) {
            nx[1] = *(const GLB f32x4*)(WSP(float, WS_DEC) + gbase + (size_t)(cidx * CH) * 1024 + lo_g);
#pragma unroll
            for (int i = 0; i < 4; ++i) { const size_t off = (i == 0) ? WS_R : (i == 1) ? WS_K : (i == 2) ? WS_AA : WS_V;
                nb[i] = *(const GLB u32x2*)(WSP(bf16_t, off) + gbase + (size_t)(cidx * CH) * 1024 + lo_g); }
        };
        auto put_chunk = [&](int cidx) {
            LAS float* d = buf + (cidx & 1) * CHF + lo_l;
            asm volatile("" : "+v"(nx[1]), "+v"(nb[0]), "+v"(nb[1]), "+v"(nb[2]), "+v"(nb[3]));
            nx[0] = (f32x4){bflo(nb[0].x), bfhi(nb[0].x), bflo(nb[0].y), bfhi(nb[0].y)}; nx[4] = (f32x4){bflo(nb[3].x), bfhi(nb[3].x), bflo(nb[3].y), bfhi(nb[3].y)};
            const f32x4 kr = (f32x4){bflo(nb[1].x), bfhi(nb[1].x), bflo(nb[1].y), bfhi(nb[1].y)}, av = (f32x4){bflo(nb[2].x), bfhi(nb[2].x), bflo(nb[2].y), bfhi(nb[2].y)};
            f32x4 kk = kr * kkw;
            const float ss = row16_sum((kk[0] * kk[0] + kk[1] * kk[1]) + (kk[2] * kk[2] + kk[3] * kk[3]));
            kk = kk * (1.0f / fmaxf(sqrtf(ss), 1e-12f));
            *(LAS f32x4*)(d) = nx[0]; *(LAS f32x4*)(d + 64) = nx[1]; *(LAS f32x4*)(d + 128) = kr * (1.0f + (av - 1.0f) * kaw);
            *(LAS f32x4*)(d + 192) = kk; *(LAS f32x4*)(d + 256) = kk * av; *(LAS f32x4*)(d + 320) = nx[4];
        };
        auto flush_y = [&](int cidx) {
            const int st = lj >> 4, r = lj & 15;
            WSP(float, WS_YRAW)[gbase + (size_t)(cidx * CH + st) * 1024 + 16 * qr + r] = ybuf[(cidx & 1) * 256 + lj];
        };
#if SCAN_SCHED == 3
        struct FS { f32x4 dec; u32x2 nb[4]; };
        FS fs[6];
        auto fetch2 = [&](int cidx, FS& f) {
            f.dec = *(const GLB f32x4*)(WSP(float, WS_DEC) + gbase + (size_t)(cidx * CH) * 1024 + lo_g);
#pragma unroll
            for (int i = 0; i < 4; ++i) { const size_t off = (i == 0) ? WS_R : (i == 1) ? WS_K : (i == 2) ? WS_AA : WS_V;
                f.nb[i] = *(const GLB u32x2*)(WSP(bf16_t, off) + gbase + (size_t)(cidx * CH) * 1024 + lo_g); }
        };
        auto put2 = [&](int cidx, FS& f) {
            LAS float* d = buf + (cidx & 1) * CHF + lo_l;
            asm volatile("" : "+v"(f.dec), "+v"(f.nb[0]), "+v"(f.nb[1]), "+v"(f.nb[2]), "+v"(f.nb[3]));
            const f32x4 rr = (f32x4){bflo(f.nb[0].x), bfhi(f.nb[0].x), bflo(f.nb[0].y), bfhi(f.nb[0].y)}, vv = (f32x4){bflo(f.nb[3].x), bfhi(f.nb[3].x), bflo(f.nb[3].y), bfhi(f.nb[3].y)};
            const f32x4 kr = (f32x4){bflo(f.nb[1].x), bfhi(f.nb[1].x), bflo(f.nb[1].y), bfhi(f.nb[1].y)}, av = (f32x4){bflo(f.nb[2].x), bfhi(f.nb[2].x), bflo(f.nb[2].y), bfhi(f.nb[2].y)};
            f32x4 kk = kr * kkw;
            const float ss = row16_sum((kk[0] * kk[0] + kk[1] * kk[1]) + (kk[2] * kk[2] + kk[3] * kk[3]));
            kk = kk * (1.0f / fmaxf(sqrtf(ss), 1e-12f));
            *(LAS f32x4*)(d) = rr; *(LAS f32x4*)(d + 64) = f.dec; *(LAS f32x4*)(d + 128) = kr * (1.0f + (av - 1.0f) * kaw);
            *(LAS f32x4*)(d + 192) = kk; *(LAS f32x4*)(d + 256) = kk * av; *(LAS f32x4*)(d + 320) = vv;
        };
        f32x4 cv[16]; MoeTile ct; ct.W = nullptr; ct.Bt = nullptr; ct.ldw = 0; ct.K = 0; ct.k0 = 0; ct.s0 = 0; ct.n0 = 0;
#pragma unroll
        for (int i = 0; i < 16; ++i) cv[i] = (f32x4){0.f, 0.f, 0.f, 0.f};
        {
            const int vit = blockIdx.x * 4 + (wave & 3);
            if (vit < 512) { const int sb = vit & 31, hd = (vit >> 5) & 1, vb = (vit >> 6) & 3;
                if ((vit >> 8) == 0) vt_tile(WSP(bf16_t, WS_VS) + ((size_t)vb * SEQ + 64 * sb) * 128 + 64 * hd, 128, WSP(bf16_t, WS_SWVT) + ((size_t)(vb * 2 + hd) * 64) * SEQ + 64 * sb, (LAS bf16_t*)scr, lane);
                else vt_tile(WSP(bf16_t, WS_VD) + ((size_t)vb * SEQ + 64 * sb) * 128 + 64 * hd, 128, WSP(bf16_t, WS_VDT) + ((size_t)vb * 128 + 64 * hd) * SEQ + 64 * sb, (LAS bf16_t*)scr, lane); }
        }
        static_assert(PER * 3 + 2 == NCH && PER % 2 == 0, "period schedule");
        const int off = (int)((blockIdx.x * 4u + (unsigned)(wave & 3)) & 1u);
        fetch2(0, fs[0]); put2(0, fs[0]); fetch2(1, fs[0]);
        SCAN5_BAR();
        int c = 0;
        for (; c < 1 + off; ++c) { put2(c + 1, fs[0]); fetch2(c + 2, fs[0]); if (c > 0) flush_y(c - 1); SCAN5_BAR(); }
#pragma unroll
        for (int i = 1; i < 6; ++i) fetch2(c + 1 + i, fs[i]);
        asm volatile("; MARK scan5 periodic begin");
        auto period = [&](int j6, bool first) {
#pragma unroll
            for (int m6 = 0; m6 < 6; ++m6) {
                asm volatile("; MARK m6 iter");
                put2(c + 1, fs[m6]); fetch2(c + 7 < NCH ? c + 7 : NCH - 1, fs[m6]); flush_y(c - 1);
                if (!MOE_CONV_IN_PROLOGUE && CONV && (m6 == 0 || m6 == 3)) {
                    if (!(first && m6 == 0)) conv_tile_finish(cv, ct.Bt, ct.K, ct.n0, ct.k0, scr, lane);
                    ct = moe_tile_desc(C, cfirst + 1024 * (2 * j6 + (m6 == 3 ? 1 : 0))); conv_tile_load(ct.W, ct.ldw, ct.k0, ct.s0, cv, lane);
                }
                SCAN5_BAR(); ++c;
            }
        };
        period(0, true);
        for (int j6 = 1; j6 < PER / 2; ++j6) period(j6, false);
        asm volatile("; MARK scan5 periodic end");
        for (; c < NCH; ++c) { flush_y(c - 1); SCAN5_BAR(); }
        if (!MOE_CONV_IN_PROLOGUE && CONV) conv_tile_finish(cv, ct.Bt, ct.K, ct.n0, ct.k0, scr, lane);
#elif SCAN_SCHED == 2
        struct FS { f32x4 dec; u32x2 nb[4]; };
        FS fs[2];
        auto fetch2 = [&](int cidx, FS& f) {
            f.dec = *(const GLB f32x4*)(WSP(float, WS_DEC) + gbase + (size_t)(cidx * CH) * 1024 + lo_g);
#pragma unroll
            for (int i = 0; i < 4; ++i) { const size_t off = (i == 0) ? WS_R : (i == 1) ? WS_K : (i == 2) ? WS_AA : WS_V;
                f.nb[i] = *(const GLB u32x2*)(WSP(bf16_t, off) + gbase + (size_t)(cidx * CH) * 1024 + lo_g); }
        };
        auto put2 = [&](int cidx, FS& f) {
            LAS float* d = buf + (cidx & 1) * CHF + lo_l;
            asm volatile("" : "+v"(f.dec), "+v"(f.nb[0]), "+v"(f.nb[1]), "+v"(f.nb[2]), "+v"(f.nb[3]));
            const f32x4 rr = (f32x4){bflo(f.nb[0].x), bfhi(f.nb[0].x), bflo(f.nb[0].y), bfhi(f.nb[0].y)}, vv = (f32x4){bflo(f.nb[3].x), bfhi(f.nb[3].x), bflo(f.nb[3].y), bfhi(f.nb[3].y)};
            const f32x4 kr = (f32x4){bflo(f.nb[1].x), bfhi(f.nb[1].x), bflo(f.nb[1].y), bfhi(f.nb[1].y)}, av = (f32x4){bflo(f.nb[2].x), bfhi(f.nb[2].x), bflo(f.nb[2].y), bfhi(f.nb[2].y)};
            f32x4 kk = kr * kkw;
            const float ss = row16_sum((kk[0] * kk[0] + kk[1] * kk[1]) + (kk[2] * kk[2] + kk[3] * kk[3]));
            kk = kk * (1.0f / fmaxf(sqrtf(ss), 1e-12f));
            *(LAS f32x4*)(d) = rr; *(LAS f32x4*)(d + 64) = f.dec; *(LAS f32x4*)(d + 128) = kr * (1.0f + (av - 1.0f) * kaw);
            *(LAS f32x4*)(d + 192) = kk; *(LAS f32x4*)(d + 256) = kk * av; *(LAS f32x4*)(d + 320) = vv;
        };
        f32x4 cv[16]; MoeTile ct; ct.W = nullptr; ct.Bt = nullptr; ct.ldw = 0; ct.K = 0; ct.k0 = 0; ct.s0 = 0; ct.n0 = 0;
#pragma unroll
        for (int i = 0; i < 16; ++i) cv[i] = (f32x4){0.f, 0.f, 0.f, 0.f};
        {
            const int vit = blockIdx.x * 4 + (wave & 3);
            if (vit < 512) { const int sb = vit & 31, hd = (vit >> 5) & 1, vb = (vit >> 6) & 3;
                if ((vit >> 8) == 0) vt_tile(WSP(bf16_t, WS_VS) + ((size_t)vb * SEQ + 64 * sb) * 128 + 64 * hd, 128, WSP(bf16_t, WS_SWVT) + ((size_t)(vb * 2 + hd) * 64) * SEQ + 64 * sb, (LAS bf16_t*)scr, lane);
                else vt_tile(WSP(bf16_t, WS_VD) + ((size_t)vb * SEQ + 64 * sb) * 128 + 64 * hd, 128, WSP(bf16_t, WS_VDT) + ((size_t)vb * 128 + 64 * hd) * SEQ + 64 * sb, (LAS bf16_t*)scr, lane); }
        }
        static_assert(PER * 3 + 2 == NCH && PER % 2 == 0, "period schedule");
        const int off = (int)((blockIdx.x * 4u + (unsigned)(wave & 3)) & 1u);
        fetch2(0, fs[0]); put2(0, fs[0]); fetch2(1, fs[0]);
        SCAN5_BAR();
        int c = 0;
        for (; c < 1 + off; ++c) { put2(c + 1, fs[0]); fetch2(c + 2, fs[0]); if (c > 0) flush_y(c - 1); SCAN5_BAR(); }
        fetch2(c + 2, fs[1]);
        asm volatile("; MARK scan5 periodic begin");
        auto period = [&](int j6, bool first) {
#pragma unroll
            for (int m6 = 0; m6 < 6; ++m6) {
                asm volatile("; MARK m6 iter");
                put2(c + 1, fs[m6 & 1]); fetch2(c + 3 < NCH ? c + 3 : NCH - 1, fs[m6 & 1]); flush_y(c - 1);
                if (!MOE_CONV_IN_PROLOGUE && CONV && (m6 == 0 || (m6 == 3 && CONV != 5))) {
                    if (!(first && m6 == 0)) {
                        if (CONV == 1 || CONV == 4) conv_tile_finish(cv, ct.Bt, ct.K, ct.n0, ct.k0, scr, lane);
                        else if (CONV == 3) { const int cc = lane & 7;
#pragma unroll
                            for (int j = 0; j < 8; ++j) { const int n = (lane >> 3) + 8 * j; u32x4 o; o.x = pk2(cv[2 * j][0], cv[2 * j][1]); o.y = pk2(cv[2 * j][2], cv[2 * j][3]); o.z = pk2(cv[2 * j + 1][0], cv[2 * j + 1][1]); o.w = pk2(cv[2 * j + 1][2], cv[2 * j + 1][3]);
                                *(GLB u32x4*)(ct.Bt + (size_t)(ct.n0 + n) * ct.K + ct.k0 + 8 * cc) = o; } }
                        else { asm volatile("" :: "v"(cv[0]), "v"(cv[1]), "v"(cv[2]), "v"(cv[3]), "v"(cv[4]), "v"(cv[5]), "v"(cv[6]), "v"(cv[7])); asm volatile("" :: "v"(cv[8]), "v"(cv[9]), "v"(cv[10]), "v"(cv[11]), "v"(cv[12]), "v"(cv[13]), "v"(cv[14]), "v"(cv[15])); }
                    }
                    ct = moe_tile_desc(C, cfirst + 1024 * (2 * j6 + (m6 == 3 ? 1 : 0))); conv_tile_load(ct.W, ct.ldw, ct.k0, ct.s0, cv, lane);
                }
                SCAN5_BAR(); ++c;
            }
        };
        period(0, true);
        for (int j6 = 1; j6 < PER / 2; ++j6) period(j6, false);
        asm volatile("; MARK scan5 periodic end");
        for (; c < NCH; ++c) { flush_y(c - 1); SCAN5_BAR(); }
        if (!MOE_CONV_IN_PROLOGUE && (CONV == 1 || CONV == 4)) conv_tile_finish(cv, ct.Bt, ct.K, ct.n0, ct.k0, scr, lane);
#elif SCAN_SCHED == 1
        f32x4 cv[16]; MoeTile ct; ct.W = nullptr; ct.Bt = nullptr; ct.ldw = 0; ct.K = 0; ct.k0 = 0; ct.s0 = 0; ct.n0 = 0;
#pragma unroll
        for (int i = 0; i < 16; ++i) cv[i] = (f32x4){0.f, 0.f, 0.f, 0.f};
        {
            const int vit = blockIdx.x * 4 + (wave & 3);
            if (vit < 512) { const int sb = vit & 31, hd = (vit >> 5) & 1, vb = (vit >> 6) & 3;
                if ((vit >> 8) == 0) vt_tile(WSP(bf16_t, WS_VS) + ((size_t)vb * SEQ + 64 * sb) * 128 + 64 * hd, 128, WSP(bf16_t, WS_SWVT) + ((size_t)(vb * 2 + hd) * 64) * SEQ + 64 * sb, (LAS bf16_t*)scr, lane);
                else vt_tile(WSP(bf16_t, WS_VD) + ((size_t)vb * SEQ + 64 * sb) * 128 + 64 * hd, 128, WSP(bf16_t, WS_VDT) + ((size_t)vb * 128 + 64 * hd) * SEQ + 64 * sb, (LAS bf16_t*)scr, lane); }
        }
        static_assert(PER * 3 + 2 == NCH && PER % 2 == 0, "period schedule");
        const int off = (int)((blockIdx.x * 4u + (unsigned)(wave & 3)) & 1u);
        auto plain = [&](int c) { if (c + 1 < NCH) put_chunk(c + 1); if (c + 2 < NCH) fetch_chunk(c + 2); if (c > 0) flush_y(c - 1); };
        auto plain_nc = [&](int c) { put_chunk(c + 1); fetch_chunk(c + 2 < NCH ? c + 2 : NCH - 1); flush_y(c - 1); };
        fetch_chunk(0); put_chunk(0); fetch_chunk(1);
        SCAN5_BAR();
        int c = 0;
        for (; c < 1 + off; ++c) { plain(c); SCAN5_BAR(); }
        asm volatile("; MARK scan5 periodic begin");
        auto period = [&](int j6) {
#pragma unroll
            for (int m6 = 0; m6 < 6; ++m6) {
                asm volatile("; MARK m6 iter");
                plain_nc(c);
                if (!MOE_CONV_IN_PROLOGUE && CONV) {
                    if (m6 == 0 || m6 == 3) { ct = moe_tile_desc(C, cfirst + 1024 * (2 * j6 + (m6 == 3 ? 1 : 0))); conv_tile_load(ct.W, ct.ldw, ct.k0, ct.s0, cv, lane); }
                    if (m6 == 2 || m6 == 5) conv_tile_finish(cv, ct.Bt, ct.K, ct.n0, ct.k0, scr, lane);
                }
                SCAN5_BAR(); ++c;
            }
        };
        period(0);
        for (int j6 = 1; j6 < PER / 2; ++j6) period(j6);
        asm volatile("; MARK scan5 periodic end");
        for (; c < NCH; ++c) { plain(c); SCAN5_BAR(); }
#else
        f32x4 cv[16], cv2[16]; MoeTile ct; ct.W = nullptr; ct.Bt = nullptr; ct.ldw = 0; ct.K = 0; ct.k0 = 0; ct.s0 = 0; ct.n0 = 0; MoeTile ct2 = ct;
#pragma unroll
        for (int i = 0; i < 16; ++i) { cv[i] = (f32x4){0.f, 0.f, 0.f, 0.f}; cv2[i] = cv[i]; }
        {
            const int vit = blockIdx.x * 4 + (wave & 3);
            if (vit < 512) { const int sb = vit & 31, hd = (vit >> 5) & 1, vb = (vit >> 6) & 3;
                if ((vit >> 8) == 0) vt_tile(WSP(bf16_t, WS_VS) + ((size_t)vb * SEQ + 64 * sb) * 128 + 64 * hd, 128, WSP(bf16_t, WS_SWVT) + ((size_t)(vb * 2 + hd) * 64) * SEQ + 64 * sb, (LAS bf16_t*)scr, lane);
                else vt_tile(WSP(bf16_t, WS_VD) + ((size_t)vb * SEQ + 64 * sb) * 128 + 64 * hd, 128, WSP(bf16_t, WS_VDT) + ((size_t)vb * 128 + 64 * hd) * SEQ + 64 * sb, (LAS bf16_t*)scr, lane); }
        }
        fetch_chunk(0); put_chunk(0); fetch_chunk(1);
        SCAN5_BAR();
        for (int cidx = 0; cidx < NCH; ++cidx) {
            if (cidx + 1 < NCH) put_chunk(cidx + 1);
            if (cidx + 2 < NCH) fetch_chunk(cidx + 2);
            if (cidx > 0) flush_y(cidx - 1);
            if (!MOE_CONV_IN_PROLOGUE) {
                const int j6 = cidx / 6, m6 = cidx - 6 * j6;
                if (m6 == 0 && 2 * j6 < PER) { ct = moe_tile_desc(C, cfirst + 1024 * (2 * j6)); conv_tile_load(ct.W, ct.ldw, ct.k0, ct.s0, cv, lane); }
                else if (m6 == 4 && 2 * j6 < PER) conv_tile_finish(cv, ct.Bt, ct.K, ct.n0, ct.k0, scr, lane);
                else if (m6 == 3 && 2 * j6 + 1 < PER) { ct2 = moe_tile_desc(C, cfirst + 1024 * (2 * j6 + 1)); conv_tile_load(ct2.W, ct2.ldw, ct2.k0, ct2.s0, cv2, lane); }
                else if (m6 == 1 && j6 >= 1 && 2 * j6 - 1 < PER) conv_tile_finish(cv2, ct2.Bt, ct2.K, ct2.n0, ct2.k0, scr, lane);
            }
            SCAN5_BAR();
        }
#endif
        flush_y(NCH - 1);
    } else {
        const int ro = lane >> 4, kq = lane & 15, rloc = 4 * wave + ro;
        f32x2 Sa = {0.f, 0.f}, Sb = {0.f, 0.f};
        SCAN5_BAR();
        for (int cidx = 0; cidx < NCH; ++cidx) {
            const LAS float* cb = buf + (cidx & 1) * CHF + 4 * kq;
            const LAS float* vb = buf + (cidx & 1) * CHF + 320 + 16 * qr + rloc;
            float ykeep = 0.f;
            f32x4 kk4 = *(const LAS f32x4*)(cb + 192), w4 = *(const LAS f32x4*)(cb + 64), b4 = *(const LAS f32x4*)(cb + 256), k4 = *(const LAS f32x4*)(cb + 128), r4 = *(const LAS f32x4*)(cb);
            float vv = vb[0];
#pragma unroll
            for (int st = 0; st < CH; ++st) {
                f32x4 kk4n = kk4, w4n = w4, b4n = b4, k4n = k4, r4n = r4; float vvn = vv;
                if (st + 1 < CH) { const LAS float* nb = cb + (st + 1) * 384;
                    kk4n = *(const LAS f32x4*)(nb + 192); w4n = *(const LAS f32x4*)(nb + 64); b4n = *(const LAS f32x4*)(nb + 256); k4n = *(const LAS f32x4*)(nb + 128); r4n = *(const LAS f32x4*)(nb); vvn = vb[(st + 1) * 384]; }
                const f32x2 tp = Sa * (f32x2){kk4[0], kk4[1]} + Sb * (f32x2){kk4[2], kk4[3]};
                const float p = row16_sum(tp[0] + tp[1]);
                const f32x2 pp = {p, p}, vv2 = {vv, vv};
                Sa = Sa * (f32x2){w4[0], w4[1]} - pp * (f32x2){b4[0], b4[1]} + vv2 * (f32x2){k4[0], k4[1]};
                Sb = Sb * (f32x2){w4[2], w4[3]} - pp * (f32x2){b4[2], b4[3]} + vv2 * (f32x2){k4[2], k4[3]};
                const f32x2 ty = Sa * (f32x2){r4[0], r4[1]} + Sb * (f32x2){r4[2], r4[3]};
                const float y = row16_sum(ty[0] + ty[1]);
                ykeep = (kq == st) ? y : ykeep;
                kk4 = kk4n; w4 = w4n; b4 = b4n; k4 = k4n; r4 = r4n; vv = vvn;
            }
            ybuf[(cidx & 1) * 256 + kq * 16 + rloc] = ykeep;
            SCAN5_BAR();
        }
    }
#undef SCAN5_BAR
}
struct Args { const void* in[N_INPUTS]; float* out; unsigned char* ws; int ph_lo, ph_hi; };
static_assert(sizeof(Args) == N_INPUTS * 8 + 24, "Args has no padding");

constexpr int N_PHASES = 2 + 12 + 14;

#ifndef USE_FAST
#define USE_FAST 271
#endif
#ifndef PROBE_CONV
#define PROBE_CONV 3
#endif
#ifndef PROBE_MASK
#define PROBE_MASK 0
#endif
#ifndef DBG_SKIP_MASK
#define DBG_SKIP_MASK 0
#endif

__global__ void __launch_bounds__(NTHR, 2) fwd_kernel(Args args) {
    extern __shared__ __attribute__((aligned(16))) unsigned char lds_raw[];
    LAS unsigned char* const lds = (LAS unsigned char*)lds_raw;
    {
        const int tid0 = threadIdx.x;
        volatile LAS unsigned* MISC0 = (volatile LAS unsigned*)(lds + MISC_OFF);
        for (int u = tid0; u < (LDS_BYTES - MISC_OFF) / 4; u += NTHR) MISC0[u] = 0u;
        __syncthreads();
        LAS unsigned long long* tab = (LAS unsigned long long*)(lds + INTAB_OFF);
        if (tid0 < N_INPUTS) tab[tid0] = (unsigned long long)args.in[tid0];
        if (tid0 == 64) { tab[TAB_WS] = (unsigned long long)args.ws; tab[TAB_OUT] = (unsigned long long)args.out;
            tab[TAB_RANGE] = ((unsigned long long)(unsigned)args.ph_hi << 32) | (unsigned)args.ph_lo; }
        __syncthreads();
        if (args.ph_hi - args.ph_lo > 1) (void)xcd_barrier_post((unsigned*)(args.ws + WS_CTL) + CW_BAR, MISC0 + 8);
    }
    LAS unsigned char* ring = lds;
    int ph = 0;
#define PH_BEGIN { const int lo = (int)__builtin_amdgcn_readfirstlane(((const LAS unsigned*)(lds + INTAB_OFF))[2 * TAB_RANGE]), hi = (int)__builtin_amdgcn_readfirstlane(((const LAS unsigned*)(lds + INTAB_OFF))[2 * TAB_RANGE + 1]); \
    if (ph >= lo && ph < hi) { const Ctx C = make_ctx(lds);
#define PH_END if (ph + 1 < hi) { XcdBarrier bar; bar.bar = (unsigned*)WSP(unsigned, WS_CTL) + CW_BAR; bar.x = xb_xcc_id(); bar.st = (volatile LAS unsigned*)(lds + MISC_OFF) + 8; xcd_barrier(bar); } \
    else { VM_WAIT(); __syncthreads(); } } } ++ph;
#define REP(g, ...) { GLB float* XOUT = C.out; (void)XOUT; __VA_ARGS__ } if (PROBE_MASK & (g)) { GLB float* XOUT = WSP(float, WS_SC); (void)XOUT; __VA_ARGS__ }

    PH_BEGIN REP(1,  ph_prologue(C); ph_norm<0>(C, INF32(I_X), nullptr, INF32(I_MIXN), nullptr); ) PH_END
    PH_BEGIN REP(256,  { pg8::Gemm g{WSP(bf16_t, WS_PCAT), WSP(bf16_t, WS_WPP), 512, 256}; pg8::ProjOrder S; S.init(C.G, (int)blockIdx.x); pg8::EpiProj E{WSP(bf16_t, WS_PROJ)};
        pg8::gemm_phase<pg8::EpiProj, pg8::ProjOrder>(ring, g, S, E); } ) PH_END

    { constexpr int l = 0;
        if (l > 0) { PH_BEGIN REP(32768,  ph_norm<0>(C, C.out, nullptr, INF32(I_MIXN) + l * D, nullptr); ) PH_END }
        PH_BEGIN REP(4096,  { pg8::Gemm g{WSP(bf16_t, WS_H), WSP(bf16_t, WS_WIN + l * SZ_WIN1), D, D}; pg8::StaticOrder S; S.init(T, N_INP, C.G, (int)blockIdx.x);
            pg8::EpiWin E{WSP(bf16_t, WS_SBQKV), WSP(bf16_t, WS_UF), WSP(bf16_t, WS_GATE)};
            pg8::gemm_phase<pg8::EpiWin, pg8::StaticOrder>(ring, g, S, E); } ) PH_END
        PH_BEGIN REP(16384,  ph_prep(C, l); ph_vt(C); ph_latent(C, l); ) PH_END
        PH_BEGIN REP(256,  { pg8::Gemm g{WSP(bf16_t, WS_ALORA), WSP(bf16_t, WS_WLORA + l * SZ_WLORA1), 256, 256}; pg8::StaticOrder S; S.init(T, 3072, C.G, (int)blockIdx.x);
            pg8::EpiLora E{WSP(float, WS_DEC), WSP(bf16_t, WS_AA), WSP(bf16_t, WS_GG), INF32(I_RWW0) + l * 1024, INF32(I_RWA0) + l * 1024};
            pg8::gemm_phase<pg8::EpiLora, pg8::StaticOrder>(ring, g, S, E); } ) PH_END
        PH_BEGIN REP(32,  if (!(DBG_SKIP_MASK & 2)) { if (USE_FAST & 256) { ph_rwkv_scan5<1>(C, l); if (PROBE_MASK & 2097152) ph_rwkv_scan5<0>(C, l); if ((PROBE_MASK & 4194304) && l == 0) ph_rwkv_scan5<PROBE_CONV>(C, l); } else if (USE_FAST & 128) ph_rwkv_scan4(C, l); else if (USE_FAST & 64) ph_rwkv_scan3(C, l); else if (USE_FAST & 32) ph_rwkv_scan_conv(C, l); else if (USE_FAST & 2) ph_rwkv_scan_fast(C); else ph_rwkv_scan_naive(C); } ) PH_END
        PH_BEGIN REP(8,  ph_sb_fast(C); ) REP(64,  ph_dsa_fast(C); ) REP(128,  ph_swa_fast(C, l); ) REP(65536,  ph_rwkv_post(C, l); ) PH_END
        PH_BEGIN REP(512,  { pg8::Gemm g{WSP(bf16_t, WS_Y), WSP(bf16_t, WS_WBR + l * SZ_WBR1), 4096, 1024}; pg8::BranchOrder S; S.init(C.G, (int)blockIdx.x);
            pg8::EpiBranch E{WSP(bf16_t, WS_GATE), WSP(bf16_t, WS_G)};
            pg8::gemm_phase<pg8::EpiBranch, pg8::BranchOrder>(ring, g, S, E); } ) PH_END
        PH_BEGIN { pg8::Gemm g{WSP(bf16_t, WS_G), WSP(bf16_t, WS_WOUT + l * SZ_DD), D, D}; pg8::StaticOrder S; S.init(T, D, C.G, (int)blockIdx.x);
            pg8::EpiResid E{(l == 0) ? INF32(I_X) : (const GLB float*)C.out, C.out};
            pg8::gemm_phase<pg8::EpiResid, pg8::StaticOrder>(ring, g, S, E);
            if (PROBE_MASK & 1024) { pg8::EpiNull EN; pg8::gemm_phase<pg8::EpiNull, pg8::StaticOrder>(ring, g, S, EN); } } PH_END
        PH_BEGIN if (l == 0) ph_norm<0>(C, C.out, nullptr, INF32(I_FFNN) + l * D, nullptr); else ph_norm<1>(C, C.out, nullptr, INF32(I_FFNN) + l * D, INF32(I_MR)); PH_END
        if (l == 0) {
            PH_BEGIN REP(2,  { pg8::Gemm g{WSP(bf16_t, WS_H), WSP(bf16_t, WS_WGU), D, D}; pg8::StaticOrder S; S.init(T, 2 * FF, C.G, (int)blockIdx.x); pg8::EpiUp E{WSP(bf16_t, WS_ACT)};
                pg8::gemm_phase<pg8::EpiUp, pg8::StaticOrder>(ring, g, S, E); } ) PH_END
            PH_BEGIN REP(2048,  { pg8::Gemm g{WSP(bf16_t, WS_ACT), WSP(bf16_t, WS_WD), FF, FF}; pg8::StaticOrder S; S.init(T, D, C.G, (int)blockIdx.x); pg8::EpiResid E{C.out, XOUT};
                pg8::gemm_phase<pg8::EpiResid, pg8::StaticOrder>(ring, g, S, E); } ) PH_END
            PH_BEGIN REP(32768,  ph_norm<0>(C, C.out, nullptr, INF32(I_PLEN) + l * D, nullptr); ) PH_END
        } else {
            PH_BEGIN REP(131072,  ph_moe_gather(C); ) PH_END
            PH_BEGIN REP(8192,  { moe_tile_table(C); pg8::MoeOrder S; S.tab = (const LAS int*)(C.lds + MOETAB_OFF); S.NT = __builtin_amdgcn_readfirstlane(S.tab[MOE_MAXRT]); S.nct = NCT_UP; S.G = C.G; S.c = (int)blockIdx.x;
                pg8::Gemm g{WSP(bf16_t, WS_HS), WSP(bf16_t, WS_MWGU), D, D}; pg8::EpiUp E{WSP(bf16_t, WS_ACTS)};
                pg8::gemm_phase<pg8::EpiUp, pg8::MoeOrder>(ring, g, S, E); } ) PH_END
            PH_BEGIN REP(2048,  { moe_tile_table(C); const LAS int* mtab = (const LAS int*)(C.lds + MOETAB_OFF);
                pg8::MoeDownOrder S; S.init(mtab, __builtin_amdgcn_readfirstlane(mtab[MOE_MAXRT]), C.G, (int)blockIdx.x);
                pg8::Gemm g{WSP(bf16_t, WS_ACTS), WSP(bf16_t, WS_MWD), FF, FF}; pg8::EpiMoeDown E{WSP(bf16_t, WS_OS), WSP(float, WS_WSLOT), WSP(float, WS_OSP), S.S};
                pg8::gemm_phase<pg8::EpiMoeDown, pg8::MoeDownOrder>(ring, g, S, E); } ) PH_END
            PH_BEGIN REP(16,  { int toff[NE + 1]; moe_offsets(C, toff); pg8::MoeDownOrder S; S.init(nullptr, toff[NE], C.G, 0); ph_norm<2>(C, C.out, XOUT, INF32(I_PLEN) + l * D, nullptr, S.S); } ) PH_END
        }
        PH_BEGIN REP(262144,  { pg8::Gemm g{WSP(bf16_t, WS_H), WSP(bf16_t, WS_WPG + l * SZ_DD), D, D}; pg8::StaticOrder S; S.init(T, D, C.G, (int)blockIdx.x);
            pg8::EpiPle E{C.out, XOUT, WSP(bf16_t, WS_PROJ) + (size_t)l * T * D};
            pg8::gemm_phase<pg8::EpiPle, pg8::StaticOrder>(ring, g, S, E); } ) PH_END
    }
    { constexpr int l = 1;
        if (l > 0) { PH_BEGIN REP(32768,  ph_norm<0>(C, C.out, nullptr, INF32(I_MIXN) + l * D, nullptr); ) PH_END }
        PH_BEGIN REP(4096,  { pg8::Gemm g{WSP(bf16_t, WS_H), WSP(bf16_t, WS_WIN + l * SZ_WIN1), D, D}; pg8::StaticOrder S; S.init(T, N_INP, C.G, (int)blockIdx.x);
            pg8::EpiWin E{WSP(bf16_t, WS_SBQKV), WSP(bf16_t, WS_UF), WSP(bf16_t, WS_GATE)};
            pg8::gemm_phase<pg8::EpiWin, pg8::StaticOrder>(ring, g, S, E); } ) PH_END
        PH_BEGIN REP(16384,  ph_prep(C, l); ph_vt(C); ph_latent(C, l); ) PH_END
        PH_BEGIN REP(256,  { pg8::Gemm g{WSP(bf16_t, WS_ALORA), WSP(bf16_t, WS_WLORA + l * SZ_WLORA1), 256, 256}; pg8::StaticOrder S; S.init(T, 3072, C.G, (int)blockIdx.x);
            pg8::EpiLora E{WSP(float, WS_DEC), WSP(bf16_t, WS_AA), WSP(bf16_t, WS_GG), INF32(I_RWW0) + l * 1024, INF32(I_RWA0) + l * 1024};
            pg8::gemm_phase<pg8::EpiLora, pg8::StaticOrder>(ring, g, S, E); } ) PH_END
        PH_BEGIN REP(32,  if (!(DBG_SKIP_MASK & 2)) { if (USE_FAST & 256) { ph_rwkv_scan5<1>(C, l); if (PROBE_MASK & 2097152) ph_rwkv_scan5<0>(C, l); if ((PROBE_MASK & 4194304) && l == 0) ph_rwkv_scan5<PROBE_CONV>(C, l); } else if (USE_FAST & 128) ph_rwkv_scan4(C, l); else if (USE_FAST & 64) ph_rwkv_scan3(C, l); else if (USE_FAST & 32) ph_rwkv_scan_conv(C, l); else if (USE_FAST & 2) ph_rwkv_scan_fast(C); else ph_rwkv_scan_naive(C); } ) PH_END
        PH_BEGIN REP(8,  ph_sb_fast(C); ) REP(64,  ph_dsa_fast(C); ) REP(128,  ph_swa_fast(C, l); ) REP(65536,  ph_rwkv_post(C, l); ) PH_END
        PH_BEGIN REP(512,  { pg8::Gemm g{WSP(bf16_t, WS_Y), WSP(bf16_t, WS_WBR + l * SZ_WBR1), 4096, 1024}; pg8::BranchOrder S; S.init(C.G, (int)blockIdx.x);
            pg8::EpiBranch E{WSP(bf16_t, WS_GATE), WSP(bf16_t, WS_G)};
            pg8::gemm_phase<pg8::EpiBranch, pg8::BranchOrder>(ring, g, S, E); } ) PH_END
        PH_BEGIN { pg8::Gemm g{WSP(bf16_t, WS_G), WSP(bf16_t, WS_WOUT + l * SZ_DD), D, D}; pg8::StaticOrder S; S.init(T, D, C.G, (int)blockIdx.x);
            pg8::EpiResid E{(l == 0) ? INF32(I_X) : (const GLB float*)C.out, C.out};
            pg8::gemm_phase<pg8::EpiResid, pg8::StaticOrder>(ring, g, S, E);
            if (PROBE_MASK & 1024) { pg8::EpiNull EN; pg8::gemm_phase<pg8::EpiNull, pg8::StaticOrder>(ring, g, S, EN); } } PH_END
        PH_BEGIN if (l == 0) ph_norm<0>(C, C.out, nullptr, INF32(I_FFNN) + l * D, nullptr); else ph_norm<1>(C, C.out, nullptr, INF32(I_FFNN) + l * D, INF32(I_MR)); PH_END
        if (l == 0) {
            PH_BEGIN REP(2,  { pg8::Gemm g{WSP(bf16_t, WS_H), WSP(bf16_t, WS_WGU), D, D}; pg8::StaticOrder S; S.init(T, 2 * FF, C.G, (int)blockIdx.x); pg8::EpiUp E{WSP(bf16_t, WS_ACT)};
                pg8::gemm_phase<pg8::EpiUp, pg8::StaticOrder>(ring, g, S, E); } ) PH_END
            PH_BEGIN REP(2048,  { pg8::Gemm g{WSP(bf16_t, WS_ACT), WSP(bf16_t, WS_WD), FF, FF}; pg8::StaticOrder S; S.init(T, D, C.G, (int)blockIdx.x); pg8::EpiResid E{C.out, XOUT};
                pg8::gemm_phase<pg8::EpiResid, pg8::StaticOrder>(ring, g, S, E); } ) PH_END
            PH_BEGIN REP(32768,  ph_norm<0>(C, C.out, nullptr, INF32(I_PLEN) + l * D, nullptr); ) PH_END
        } else {
            PH_BEGIN REP(131072,  ph_moe_gather(C); ) PH_END
            PH_BEGIN REP(8192,  { moe_tile_table(C); pg8::MoeOrder S; S.tab = (const LAS int*)(C.lds + MOETAB_OFF); S.NT = __builtin_amdgcn_readfirstlane(S.tab[MOE_MAXRT]); S.nct = NCT_UP; S.G = C.G; S.c = (int)blockIdx.x;
                pg8::Gemm g{WSP(bf16_t, WS_HS), WSP(bf16_t, WS_MWGU), D, D}; pg8::EpiUp E{WSP(bf16_t, WS_ACTS)};
                pg8::gemm_phase<pg8::EpiUp, pg8::MoeOrder>(ring, g, S, E); } ) PH_END
            PH_BEGIN REP(2048,  { moe_tile_table(C); const LAS int* mtab = (const LAS int*)(C.lds + MOETAB_OFF);
                pg8::MoeDownOrder S; S.init(mtab, __builtin_amdgcn_readfirstlane(mtab[MOE_MAXRT]), C.G, (int)blockIdx.x);
                pg8::Gemm g{WSP(bf16_t, WS_ACTS), WSP(bf16_t, WS_MWD), FF, FF}; pg8::EpiMoeDown E{WSP(bf16_t, WS_OS), WSP(float, WS_WSLOT), WSP(float, WS_OSP), S.S};
                pg8::gemm_phase<pg8::EpiMoeDown, pg8::MoeDownOrder>(ring, g, S, E); } ) PH_END
            PH_BEGIN REP(16,  { int toff[NE + 1]; moe_offsets(C, toff); pg8::MoeDownOrder S; S.init(nullptr, toff[NE], C.G, 0); ph_norm<2>(C, C.out, XOUT, INF32(I_PLEN) + l * D, nullptr, S.S); } ) PH_END
        }
        PH_BEGIN REP(262144,  { pg8::Gemm g{WSP(bf16_t, WS_H), WSP(bf16_t, WS_WPG + l * SZ_DD), D, D}; pg8::StaticOrder S; S.init(T, D, C.G, (int)blockIdx.x);
            pg8::EpiPle E{C.out, XOUT, WSP(bf16_t, WS_PROJ) + (size_t)l * T * D};
            pg8::gemm_phase<pg8::EpiPle, pg8::StaticOrder>(ring, g, S, E); } ) PH_END
    }
#undef PH_BEGIN
#undef PH_END
}

#ifndef MK_ONE_LAUNCH
#define MK_ONE_LAUNCH 0
#endif
extern "C" void kernel_launch(void* const* d_in, const int* in_sizes, int n_in, void* d_out, int out_size, void* d_ws, size_t ws_size, hipStream_t stream) {
    static int grid = 0;
    if (grid == 0) {
        if (n_in != N_INPUTS || out_size != T * D || ws_size < WS_END2) { fprintf(stderr, "kernel_launch: unexpected problem (n_in %d, out %d, ws %zu < %zu)\n", n_in, out_size, ws_size, (size_t)WS_END2); grid = -1; return; }
        int dev = 0, cus = 0, per_cu = 0;
        if (hipGetDevice(&dev) != hipSuccess || hipDeviceGetAttribute(&cus, hipDeviceAttributeMultiprocessorCount, dev) != hipSuccess) { grid = -1; return; }
        if (hipFuncSetAttribute((const void*)fwd_kernel, hipFuncAttributeMaxDynamicSharedMemorySize, LDS_BYTES) != hipSuccess) { fprintf(stderr, "kernel_launch: hipFuncSetAttribute failed\n"); grid = -1; return; }
        if (hipOccupancyMaxActiveBlocksPerMultiprocessor(&per_cu, (const void*)fwd_kernel, NTHR, LDS_BYTES) != hipSuccess || per_cu < 1) fprintf(stderr, "kernel_launch: occupancy query reports %d\n", per_cu);
        (void)hipGetLastError();
        grid = cus;
    }
    if (grid < 0) return;
    (void)hipMemsetAsync((char*)d_ws + WS_CTL, 0, CTL_BYTES, stream);
    Args a{};
    for (int i = 0; i < N_INPUTS; ++i) a.in[i] = d_in[i];
    a.out = (float*)d_out; a.ws = (unsigned char*)d_ws;
#if MK_ONE_LAUNCH
    a.ph_lo = 0; a.ph_hi = N_PHASES;
    hipLaunchKernelGGL(fwd_kernel, dim3(grid), dim3(NTHR), LDS_BYTES, stream, a);
#else
    for (int p = 0; p < N_PHASES; ++p) { a.ph_lo = p; a.ph_hi = p + 1; hipLaunchKernelGGL(fwd_kernel, dim3(grid), dim3(NTHR), LDS_BYTES, stream, a); }
#endif
}
```

```cpp
#define MK_ONE_LAUNCH 1
#include <hip/hip_runtime.h>
#include <cstdio>
#include <cstdint>

#define LAS __attribute__((address_space(3)))
#define GAS __attribute__((address_space(1)))
#define GLB __attribute__((address_space(1)))
typedef unsigned short bf16_t;
typedef short bf16x8 __attribute__((ext_vector_type(8)));
typedef float f32x4 __attribute__((ext_vector_type(4)));
typedef float f32x2 __attribute__((ext_vector_type(2)));
typedef unsigned u32x4 __attribute__((ext_vector_type(4)));
typedef unsigned u32x2 __attribute__((ext_vector_type(2)));

constexpr int NB = 4, SEQ = 2048, T = NB * SEQ, D = 2048, NL = 2;
constexpr int N_IN = 18256, N_INP = 18432, FF = 7168, NE = 8;
constexpr int UFW = 7168;
constexpr int UF_RW = 0, UF_DQ = 3328, UF_CKV = 4352, UF_IQ = 4608, UF_SQ = 5632, UF_SK = 6656, UF_SV = 6784, UF_IK = 6912, UF_IW = 6976;
constexpr int MOE_ROWS = 18432, MOE_MAXRT = 72, NCT_UP = 56, NCT_DN = 8;
constexpr int NWAVES = 8, NTHR = 512;

constexpr size_t WS_CTL = 0, CTL_BYTES = 1u << 20;
constexpr size_t SZ_WIN1 = (size_t)N_INP * D * 2, SZ_WBR1 = (size_t)4 * 2048 * 1024 * 2, SZ_DD = (size_t)D * D * 2;
constexpr size_t SZ_WGU1 = (size_t)2 * FF * D * 2, SZ_WD1 = (size_t)D * FF * 2, SZ_WLORA1 = (size_t)3072 * 256 * 2;
constexpr size_t WS_WIN = CTL_BYTES;
constexpr size_t WS_WBR = WS_WIN + NL * SZ_WIN1;
constexpr size_t WS_WOUT = WS_WBR + NL * SZ_WBR1;
constexpr size_t WS_WGU = WS_WOUT + NL * SZ_DD;
constexpr size_t WS_WD = WS_WGU + SZ_WGU1;
constexpr size_t WS_MWGU = WS_WD + SZ_WD1;
constexpr size_t WS_MWD = WS_MWGU + NE * SZ_WGU1;
constexpr size_t WS_WPG = WS_MWD + NE * SZ_WD1;
constexpr size_t WS_WPP = WS_WPG + NL * SZ_DD;
constexpr size_t WS_WLORA = WS_WPP + (size_t)NL * D * 256 * 2;
constexpr size_t WS_H = WS_WLORA + NL * SZ_WLORA1;
constexpr size_t WS_PCAT = WS_H + (size_t)T * D * 2;
constexpr size_t WS_PROJ = WS_PCAT + (size_t)T * 512 * 2;
constexpr size_t WS_ROUTE = WS_PROJ + (size_t)NL * T * D * 2;
constexpr size_t WS_TOKSLOT = WS_ROUTE + (size_t)T * 32;
constexpr size_t WS_WSLOT = WS_TOKSLOT + (size_t)T * 8;
constexpr size_t WS_ACT0 = WS_WSLOT + (size_t)MOE_ROWS * 4 + 256 * 30;
constexpr size_t SZ_T1K = (size_t)T * 1024 * 4;
constexpr size_t WS_SBQKV = (WS_ACT0 + 255) & ~(size_t)255;
constexpr size_t WS_GATE = WS_SBQKV + (size_t)T * 3072 * 2;
constexpr size_t WS_UF = WS_GATE + (size_t)T * 8192 * 2;
constexpr size_t WS_Y = WS_UF;
constexpr size_t WS_GSUM = WS_Y + (size_t)T * 4096 * 2;
constexpr size_t WS_G = WS_GSUM + (size_t)T * 2048 * 4;
constexpr size_t WS_YRAW = WS_G + (size_t)T * 2048 * 2;
constexpr size_t WS_RW = WS_UF + (size_t)T * UFW * 4;
static_assert(WS_YRAW + SZ_T1K <= WS_RW, "UF aliases");
constexpr size_t WS_R = WS_RW, WS_K = WS_RW + SZ_T1K, WS_V = WS_RW + 2 * SZ_T1K, WS_DEC = WS_RW + 3 * SZ_T1K, WS_AA = WS_RW + 4 * SZ_T1K, WS_KK = WS_RW + 5 * SZ_T1K, WS_GG = WS_RW + 6 * SZ_T1K;
constexpr size_t WS_ALORA = WS_RW + 7 * SZ_T1K;
constexpr size_t WS_QD = WS_ALORA + (size_t)T * 256 * 2;
constexpr size_t WS_KD = WS_QD + (size_t)T * 1024 * 2;
constexpr size_t WS_VD = WS_KD + (size_t)T * 128 * 2;
constexpr size_t WS_QI = WS_VD + (size_t)T * 128 * 2;
constexpr size_t WS_KI = WS_QI + (size_t)T * 1024 * 2;
constexpr size_t WS_WI = WS_KI + (size_t)T * 64 * 2;
constexpr size_t WS_QS = WS_WI + (size_t)T * 16 * 4;
constexpr size_t WS_KS = WS_QS + (size_t)T * 1024 * 2;
constexpr size_t WS_VS = WS_KS + (size_t)T * 128 * 2;
constexpr size_t WS_MIX_END = WS_VS + (size_t)T * 128 * 2;
constexpr size_t WS_ACT = WS_SBQKV;
constexpr size_t WS_HS = WS_SBQKV;
constexpr size_t WS_ACTS = WS_HS + (size_t)MOE_ROWS * D * 2;
constexpr size_t WS_OS = WS_ACTS + (size_t)MOE_ROWS * FF * 2;
constexpr size_t WS_OSP = WS_OS + (size_t)MOE_ROWS * D * 4;
constexpr size_t WS_FFN_END = WS_OSP + (size_t)256 * 65536 * 4;
constexpr size_t WS_END = WS_MIX_END > WS_FFN_END ? WS_MIX_END : WS_FFN_END;
static_assert(WS_END < (size_t)2000 * 1000 * 1000, "workspace budget");

constexpr int CW_BAR = 4096;
constexpr int CW_MOECNT = 8192;

constexpr int RING_BYTES = 131072;
constexpr int MISC_OFF = 143360;
constexpr int LDS_BYTES = 147456;

#define LDS_WAIT() asm volatile("s_waitcnt lgkmcnt(0)" ::: "memory")
#define VM_WAIT() asm volatile("s_waitcnt vmcnt(0)" ::: "memory")
__device__ __forceinline__ float bflo(unsigned u) { return __builtin_bit_cast(float, u << 16); }
__device__ __forceinline__ float bfhi(unsigned u) { return __builtin_bit_cast(float, u & 0xffff0000u); }
__device__ __forceinline__ float bf1(bf16_t u) { return __builtin_bit_cast(float, (unsigned)u << 16); }
__device__ __forceinline__ unsigned f2bf(float f) { unsigned u = __builtin_bit_cast(unsigned, f); return (u + 0x7fffu + ((u >> 16) & 1u)) >> 16; }
typedef __bf16 bf16x2v __attribute__((ext_vector_type(2)));
__device__ __forceinline__ unsigned pk2(float lo, float hi) { const f32x2 v = {lo, hi}; return __builtin_bit_cast(unsigned, __builtin_convertvector(v, bf16x2v)); }
__device__ __forceinline__ float wave_sum(float v) {
#pragma unroll
    for (int o = 1; o < 64; o <<= 1) v += __shfl_xor(v, o);
    return v;
}
__device__ __forceinline__ float wave_max(float v) {
#pragma unroll
    for (int o = 1; o < 64; o <<= 1) v = fmaxf(v, __shfl_xor(v, o));
    return v;
}
__device__ __forceinline__ float sigmoidf_(float x) { return __builtin_amdgcn_rcpf(1.0f + __builtin_amdgcn_exp2f(-1.4426950408889634f * x)); }
__device__ __forceinline__ float logsigf_(float x) { return fminf(x, 0.f) - __logf(1.0f + __expf(-fabsf(x))); }
__device__ __forceinline__ float rdlane(float v, int l) { return __builtin_bit_cast(float, __builtin_amdgcn_readlane(__builtin_bit_cast(int, v), l)); }

#define XB_TMO      128
#define XB_XCNT(j)  (256  + 64 * (j))
#define XB_XSUB(j)  (1280 + 64 * (j))
#define XB_XGEN(j)  (2304 + 64 * (j))
#define XB_TOP      3328
#define XB_TOPGEN   3392
#define XCD_BAR_WORDS 3456
#define XB_SPIN_CAP (1u << 18)
__device__ __forceinline__ unsigned xb_ld(unsigned* p)              { return __hip_atomic_load(p, __ATOMIC_RELAXED, __HIP_MEMORY_SCOPE_AGENT); }
__device__ __forceinline__ unsigned xb_add(unsigned* p, unsigned v) { return __hip_atomic_fetch_add(p, v, __ATOMIC_RELAXED, __HIP_MEMORY_SCOPE_AGENT); }
__device__ __forceinline__ unsigned xb_xcc_id() { return (unsigned)__builtin_amdgcn_s_getreg((3 << 11) | 20) & 0xFu; }
#define XB_SPIN(cond, bar) do { unsigned _sp = 0; while (cond) { __builtin_amdgcn_s_sleep(1); \
    if ((++_sp & 255u) == 0u) { if (xb_ld(&(bar)[XB_TMO])) break; if (_sp > XB_SPIN_CAP) { atomicAdd(&(bar)[XB_TMO], 1u); break; } } } } while (0)
struct XcdBarrier { unsigned* bar; unsigned x; volatile LAS unsigned* st; };
__device__ __forceinline__ XcdBarrier xcd_barrier_post(unsigned* bar, volatile LAS unsigned* st) {
    XcdBarrier b; b.bar = bar; b.x = xb_xcc_id(); b.st = st;
    if (threadIdx.x == 0) (void)xb_add(&bar[XB_XCNT(b.x)], 1u);
    return b;
}
__device__ __forceinline__ void xcd_barrier_complete(unsigned* bar, unsigned x, unsigned& nloc, unsigned& nx) {
    const unsigned G = gridDim.x * gridDim.y * gridDim.z;
    unsigned sum, cnt, mine, sp = 0u;
    for (;;) {
        sum = 0u; cnt = 0u; mine = 0u;
#pragma unroll
        for (unsigned j = 0; j < 16; ++j) { const unsigned c = xb_ld(&bar[XB_XCNT(j)]); sum += c; cnt += (c > 0u) ? 1u : 0u; mine = (j == x) ? c : mine; }
        if (sum == G) break;
        __builtin_amdgcn_s_sleep(1);
        if ((++sp & 255u) == 0u) { if (xb_ld(&bar[XB_TMO])) break; if (sp > XB_SPIN_CAP) { atomicAdd(&bar[XB_TMO], 1u); break; } }
    }
    nloc = mine > 0u ? mine : 1u; nx = cnt > 0u ? cnt : 1u;
}
__device__ __forceinline__ void xcd_barrier(const XcdBarrier& b) {
    asm volatile("s_waitcnt vmcnt(0)" ::: "memory");
    __syncthreads();
    if (threadIdx.x == 0) {
        unsigned* bar = b.bar;
        __builtin_amdgcn_s_waitcnt(0);
        unsigned nloc = b.st[0], nx = b.st[1];
        if (nloc == 0u) { xcd_barrier_complete(bar, b.x, nloc, nx); b.st[0] = nloc; b.st[1] = nx; }
        const unsigned old = xb_add(&bar[XB_XSUB(b.x)], 1u);
        const unsigned gen = old / nloc;
        if (old + 1u == (gen + 1u) * nloc) {
            __builtin_amdgcn_fence(__ATOMIC_RELEASE, "agent");
            asm volatile("s_waitcnt vmcnt(0)" ::: "memory");
            const unsigned og = xb_add(&bar[XB_TOP], 1u);
            const unsigned tg = og / nx;
            if (og + 1u == (tg + 1u) * nx) xb_add(&bar[XB_TOPGEN], 1u);
            else XB_SPIN(xb_ld(&bar[XB_TOPGEN]) == tg, bar);
            __builtin_amdgcn_fence(__ATOMIC_ACQUIRE, "agent");
            xb_add(&bar[XB_XGEN(b.x)], 1u);
            asm volatile("s_waitcnt vmcnt(0)" ::: "memory");
        } else {
            XB_SPIN(xb_ld(&bar[XB_XGEN(b.x)]) == gen, bar);
            __builtin_amdgcn_fence(__ATOMIC_ACQUIRE, "agent");
            asm volatile("s_waitcnt vmcnt(0)" ::: "memory");
        }
    }
    __syncthreads();
}
namespace pg8 {
#define PG8_LAS __attribute__((address_space(3)))
#ifndef PG8_WGM
#define PG8_WGM 4
#endif
constexpr int BM = 256, BK = 64, HALF = 128, HTB = HALF * BK * 2, STAGE_BYTES = 8 * HTB, NXCD = 8, WGM = PG8_WGM;
__host__ __device__ __forceinline__ int lds_byte(int r, int c) { const int st = (r >> 4) * 2 + (c >> 5), rr = r & 15, cc = c & 31, ob = rr * 64 + cc * 2; return st * 1024 + (ob ^ (((ob >> 9) & 1) << 5)); }
__host__ __device__ __forceinline__ void stage_rc(int b, int& R, int& C) { const int st = b / 1024, sb = b % 1024, swz = sb ^ (((sb >> 9) & 1) << 5); R = (st >> 1) * 16 + swz / 64; C = (st & 1) * 32 + (swz % 64) / 2; }
__host__ __device__ __forceinline__ int perm32(int rho) { const int n = rho >> 4, i = rho & 15; return 8 * (i >> 2) + 4 * n + (i & 3); }

struct Unit { int pm, pn, ka, kb, nt, aux; };
struct Gemm { const GLB bf16_t* A; const GLB bf16_t* Bt; int lda, K; };

struct StaticOrder {
    int nM, nN, nwg, G, c;
    __device__ __forceinline__ void init(int M, int N, int G_, int c_) { nM = M / BM; nN = N / BM; nwg = nM * nN; G = G_; c = c_; }
    __device__ __forceinline__ bool tile(long L, Unit& u) const {
        if (L >= nwg) return false;
        int wgid = (int)L; { const int q = nwg / NXCD, r = nwg % NXCD, xcd = wgid % NXCD, off = wgid / NXCD; wgid = (xcd < r ? xcd * (q + 1) : r * (q + 1) + (xcd - r) * q) + off; }
        const int nig = WGM * nN, gid = wgid / nig, fm = gid * WGM, gsz = (nM - fm) < WGM ? (nM - fm) : WGM;
        u.pm = fm + ((wgid % nig) % gsz); u.pn = (wgid % nig) / gsz; u.ka = 0; u.kb = 0; u.nt = 0; u.aux = 0; return true;
    }
    __device__ __forceinline__ bool next(int i, Unit& u) const { return tile((long)i * G + c, u); }
};
struct BranchOrder {
    int G, c, cnt;
    __device__ __forceinline__ void init(int G_, int c_) { G = G_; c = c_; cnt = (c_ < 256) ? (255 - c_) / G_ + 1 : 0; }
    __device__ __forceinline__ bool next(int i, Unit& u) const {
        if (cnt == 0) return false;
        const int n = i / cnt, r = i - n * cnt; if (n >= 4) return false;
        StaticOrder so; so.init(T, 2048, G, c); so.tile((long)r * G + c, u);
        u.pn += n * 8; u.ka = n * 1024; return true;
    }
};
struct ProjOrder {
    StaticOrder so;
    __device__ __forceinline__ void init(int G_, int c_) { so.init(T, 4096, G_, c_); }
    __device__ __forceinline__ bool next(int i, Unit& u) const { if (!so.next(i, u)) return false; u.ka = (u.pn >> 3) * 256; return true; }
};
struct MoeOrder {
    const PG8_LAS int* tab; int NT, nct, G, c;
    __device__ __forceinline__ bool next(int i, Unit& u) const {
        StaticOrder so; so.nM = NT; so.nN = nct; so.nwg = NT * nct; so.G = G; so.c = c;
        if (!so.tile((long)i * G + c, u)) return false;
        const int e = __builtin_amdgcn_readfirstlane(tab[u.pm]);
        u.pn += e * nct; u.ka = 0; return true;
    }
};

struct MoeDownOrder {
    const PG8_LAS int* tab; int NT, G, c, S;
    __device__ __forceinline__ void init(const PG8_LAS int* tab_, int NT_, int G_, int c_) { tab = tab_; NT = NT_; G = G_; c = c_;
        const int tu = (NT_ - 64) * 8; S = (tu <= 0) ? 1 : ((tu * 8 <= G_) ? 8 : ((tu * 4 <= G_) ? 4 : ((tu * 2 <= G_) ? 2 : 1))); }
    __device__ __forceinline__ bool next(int i, Unit& u) const {
        const int F = (NT < 64) ? NT : 64, nfull = F * 8, rf = (nfull + G - 1) / G;
        if (i < rf) {
            StaticOrder so; so.nM = F; so.nN = 8; so.nwg = nfull; so.G = G; so.c = c;
            if (so.tile((long)i * G + c, u)) { const int e = __builtin_amdgcn_readfirstlane(tab[u.pm]); u.pn += e * 8; return true; }
            i = rf;
        }
        const int q = (i - rf) * G + c, ntail = (NT - F) * 8 * S;
        if (q >= ntail) return false;
        const int tu = q / S, sl = q - tu * S, rt = F + (tu >> 3), pl = tu & 7;
        const int e = __builtin_amdgcn_readfirstlane(tab[rt]);
        u.pm = rt; u.pn = e * 8 + pl; u.ka = sl * (FF / S); u.kb = u.ka; u.nt = (FF / 64) / S; u.aux = 1 + sl; return true;
    }
};

template <class Epi, class Sched>
__device__ __forceinline__ void gemm_phase(PG8_LAS unsigned char* lds, const Gemm g, const Sched& S, const Epi& E) {
    int tid = threadIdx.x; asm volatile("" : "+v"(tid));
    const int wid = __builtin_amdgcn_readfirstlane(tid >> 6), lane = tid & 63, wr = wid >> 2, wc = wid & 3, fr = lane & 15, fq = lane >> 4;
    int K = g.K, lda = g.lda; asm volatile("" : "+s"(K), "+s"(lda));
    const int nt = K / BK;
    unsigned voffA[2], voffB[2];
#pragma unroll
    for (int i = 0; i < 2; ++i) { int R, C; stage_rc(tid * 16 + i * 8192, R, C); const int Rb = Epi::PERM ? ((R & ~31) + perm32(R & 31)) : R;
        voffA[i] = (unsigned)(R * lda + C) * 2u; voffB[i] = (unsigned)(Rb * K + C) * 2u; }
    const size_t kstep = (size_t)(BK * 2);
    const size_t hstepA = (size_t)HALF * lda * 2, hstepB = (size_t)HALF * K * 2;
    const size_t tstepA = 2 * hstepA, tstepB = 2 * hstepB;
    const unsigned ldsw = (unsigned)wid * 1024u;
    const int aoff = lds_byte(wr * 64 + fr, fq * 8), boff = lds_byte(wc * 32 + fr, fq * 8);
#define PG8_SA(b, h) (((b) * 2 + (h)) * HTB)
#define PG8_SB(b, h) ((4 + (b) * 2 + (h)) * HTB)
#define PG8_STAGE(bufoff, gbase, voff) do { _Pragma("unroll") for (int _i = 0; _i < 2; ++_i) \
        __builtin_amdgcn_global_load_lds((const GLB unsigned*)((const char*)(gbase) + (voff)[_i]), (PG8_LAS unsigned*)(lds + (bufoff) + ldsw + _i * 8192), 16, 0, 0); } while (0)
#define PG8_LDA(dst, b, h) do { _Pragma("unroll") for (int m = 0; m < 4; ++m) _Pragma("unroll") for (int k = 0; k < 2; ++k) dst[m][k] = *(const PG8_LAS bf16x8*)(lds + PG8_SA(b, h) + aoff + m * 2048 + k * 1024); } while (0)
#define PG8_LDB(dst, b, h) do { _Pragma("unroll") for (int n = 0; n < 2; ++n) _Pragma("unroll") for (int k = 0; k < 2; ++k) dst[n][k] = *(const PG8_LAS bf16x8*)(lds + PG8_SB(b, h) + boff + n * 2048 + k * 1024); } while (0)
#define PG8_MMA(ai, bj, At, Bt) do { __builtin_amdgcn_s_setprio(1); _Pragma("unroll") for (int m = 0; m < 4; ++m) _Pragma("unroll") for (int n = 0; n < 2; ++n) _Pragma("unroll") for (int k = 0; k < 2; ++k) \
        acc[ai][bj][m][n] = __builtin_amdgcn_mfma_f32_16x16x32_bf16(Bt[n][k], At[m][k], acc[ai][bj][m][n], 0, 0, 0); __builtin_amdgcn_s_setprio(0); } while (0)
#define PG8_WAIT_V(n) asm volatile("s_waitcnt vmcnt(" #n ")" ::: "memory")
#define PG8_WAIT_L(n) asm volatile("s_waitcnt lgkmcnt(" #n ")" ::: "memory")
#define PG8_BAR __builtin_amdgcn_s_barrier()
#define PG8_SCHED __builtin_amdgcn_sched_barrier(0)
    Unit cur, nxt; int ui = 0;
    if (!S.next(0, cur)) return;
    f32x4 acc[2][2][4][2];
#pragma unroll
    for (int a = 0; a < 2; ++a)
#pragma unroll
        for (int b = 0; b < 2; ++b)
#pragma unroll
            for (int m = 0; m < 4; ++m)
#pragma unroll
                for (int n = 0; n < 2; ++n) acc[a][b][m][n] = (f32x4){0.f, 0.f, 0.f, 0.f};
    bf16x8 At[4][2], B0[2][2], B1[2][2];
    const char* cA = (const char*)g.A + (size_t)cur.pm * tstepA + (size_t)cur.ka * 2; const char* cB = (const char*)g.Bt + (size_t)cur.pn * tstepB + (size_t)cur.kb * 2;
    PG8_STAGE(PG8_SB(0, 0), cB, voffB); PG8_STAGE(PG8_SB(0, 1), cB + hstepB, voffB); PG8_STAGE(PG8_SA(0, 0), cA, voffA); PG8_STAGE(PG8_SA(0, 1), cA + hstepA, voffA);
    if (wr == 1) PG8_BAR;
    PG8_WAIT_V(2); PG8_BAR;
    PG8_STAGE(PG8_SB(1, 0), cB + kstep, voffB); PG8_STAGE(PG8_SA(1, 0), cA + kstep, voffA); PG8_STAGE(PG8_SB(1, 1), cB + hstepB + kstep, voffB);
    PG8_WAIT_V(6); PG8_BAR;
    for (;;) {
        const bool has_next = S.next(ui + 1, nxt);
        const char* nA = has_next ? (const char*)g.A + (size_t)nxt.pm * tstepA + (size_t)nxt.ka * 2 : cA; const char* nB = has_next ? (const char*)g.Bt + (size_t)nxt.pn * tstepB + (size_t)nxt.kb * 2 : cB;
        const int ntu = cur.nt ? cur.nt : nt;
        for (int t = 0; t < ntu; t += 2) {
            const bool last = (t == ntu - 2);
            const char* a1 = cA + (size_t)(t + 1) * kstep;
            const char* a2 = last ? nA : cA + (size_t)(t + 2) * kstep; const char* b2 = last ? nB : cB + (size_t)(t + 2) * kstep;
            const char* a3 = a2 + kstep; const char* b3 = b2 + kstep;
            PG8_LDB(B0, 0, 0); PG8_LDB(B1, 0, 1); PG8_SCHED; PG8_LDA(At, 0, 0); PG8_STAGE(PG8_SA(1, 1), a1 + hstepA, voffA);
            PG8_WAIT_V(8); PG8_WAIT_L(0); PG8_BAR; PG8_MMA(0, 0, At, B0); PG8_MMA(0, 1, At, B1); PG8_BAR; PG8_SCHED;
            PG8_LDA(At, 0, 1); PG8_STAGE(PG8_SB(0, 0), b2, voffB); PG8_STAGE(PG8_SB(0, 1), b2 + hstepB, voffB); PG8_STAGE(PG8_SA(0, 0), a2, voffA);
            PG8_WAIT_V(8); PG8_WAIT_L(0); PG8_BAR; PG8_MMA(1, 0, At, B0); PG8_MMA(1, 1, At, B1); PG8_BAR; PG8_SCHED;
            PG8_LDB(B0, 1, 0); PG8_LDB(B1, 1, 1); PG8_SCHED; PG8_LDA(At, 1, 0); PG8_STAGE(PG8_SA(0, 1), a2 + hstepA, voffA);
            PG8_WAIT_V(8); PG8_WAIT_L(0); PG8_BAR; PG8_MMA(0, 0, At, B0); PG8_MMA(0, 1, At, B1); PG8_BAR; PG8_SCHED;
            PG8_LDA(At, 1, 1); PG8_STAGE(PG8_SB(1, 0), b3, voffB); PG8_STAGE(PG8_SB(1, 1), b3 + hstepB, voffB); PG8_STAGE(PG8_SA(1, 0), a3, voffA);
            PG8_WAIT_V(8); PG8_WAIT_L(0); PG8_BAR; PG8_MMA(1, 0, At, B0); PG8_MMA(1, 1, At, B1); PG8_BAR; PG8_SCHED;
        }
        if (wr == 0) PG8_BAR;
        E(acc, cur, wr, wc, fr, fq);
        if (!has_next) break;
#pragma unroll
        for (int a = 0; a < 2; ++a)
#pragma unroll
            for (int b = 0; b < 2; ++b)
#pragma unroll
                for (int m = 0; m < 4; ++m)
#pragma unroll
                    for (int n = 0; n < 2; ++n) acc[a][b][m][n] = (f32x4){0.f, 0.f, 0.f, 0.f};
        cur = nxt; cA = nA; cB = nB; ++ui;
        if (wr == 1) PG8_BAR;
    }
    PG8_WAIT_V(0);
    PG8_BAR;
#undef PG8_SA
#undef PG8_SB
#undef PG8_STAGE
#undef PG8_LDA
#undef PG8_LDB
#undef PG8_MMA
#undef PG8_WAIT_V
#undef PG8_WAIT_L
#undef PG8_BAR
#undef PG8_SCHED
}

#define EPI_ROWS(u) const int row0 = (u).pm * BM + wr * 64 + fr; const int ct0 = wc * 32 + 8 * fq
#define EPI_FOR_ROWS _Pragma("unroll") for (int ai = 0; ai < 2; ++ai) _Pragma("unroll") for (int m = 0; m < 4; ++m)
__device__ __forceinline__ u32x4 pack8(f32x4 v0, f32x4 v1) { u32x4 w; w.x = pk2(v0[0], v0[1]); w.y = pk2(v0[2], v0[3]); w.z = pk2(v1[0], v1[1]); w.w = pk2(v1[2], v1[3]); return w; }
__device__ __forceinline__ void unpack8(u32x4 w, f32x4& v0, f32x4& v1) { v0 = (f32x4){bflo(w.x), bfhi(w.x), bflo(w.y), bfhi(w.y)}; v1 = (f32x4){bflo(w.z), bfhi(w.z), bflo(w.w), bfhi(w.w)}; }
__device__ __forceinline__ f32x4 sig4(f32x4 v) { return (f32x4){sigmoidf_(v[0]), sigmoidf_(v[1]), sigmoidf_(v[2]), sigmoidf_(v[3])}; }

struct EpiWin { static constexpr bool PERM = true;
    GLB bf16_t* sbqkv; GLB bf16_t* uf; GLB bf16_t* gate;
    __device__ __forceinline__ void operator()(const f32x4 (&acc)[2][2][4][2], const Unit& u, int wr, int wc, int fr, int fq) const {
        EPI_ROWS(u); const int pn = u.pn;
        if (pn < 40) {
            GLB bf16_t* base = (pn < 12) ? sbqkv + pn * 256 : uf + (pn - 12) * 256; const int ld = (pn < 12) ? 3072 : UFW;
            EPI_FOR_ROWS { GLB bf16_t* rp = base + (size_t)(row0 + ai * HALF + m * 16) * ld + ct0;
#pragma unroll
                for (int bj = 0; bj < 2; ++bj) *(GLB u32x4*)(rp + bj * HALF) = pack8(acc[ai][bj][m][0], acc[ai][bj][m][1]); }
        } else {
            EPI_FOR_ROWS { GLB bf16_t* rp = gate + (size_t)(row0 + ai * HALF + m * 16) * 8192 + (pn - 40) * 256 + ct0;
#pragma unroll
                for (int bj = 0; bj < 2; ++bj) *(GLB u32x4*)(rp + bj * HALF) = pack8(sig4(acc[ai][bj][m][0]), sig4(acc[ai][bj][m][1])); }
        }
    }
};
struct EpiNull { static constexpr bool PERM = true;
    __device__ __forceinline__ void operator()(const f32x4 (&acc)[2][2][4][2], const Unit& u, int wr, int wc, int fr, int fq) const {
#pragma unroll
        for (int ai = 0; ai < 2; ++ai)
#pragma unroll
            for (int bj = 0; bj < 2; ++bj) asm volatile("" :: "v"(acc[ai][bj][0][0]), "v"(acc[ai][bj][0][1]), "v"(acc[ai][bj][1][0]), "v"(acc[ai][bj][1][1]), "v"(acc[ai][bj][2][0]), "v"(acc[ai][bj][2][1]), "v"(acc[ai][bj][3][0]), "v"(acc[ai][bj][3][1]));
    }
};
struct EpiLora { static constexpr bool PERM = true;
    GLB float* dec; GLB bf16_t* aa; GLB bf16_t* gg; const GLB float* w0; const GLB float* a0;
    __device__ __forceinline__ void operator()(const f32x4 (&acc)[2][2][4][2], const Unit& u, int wr, int wc, int fr, int fq) const {
        EPI_ROWS(u); const int kind = u.pn >> 2, cb = (u.pn & 3) * 256 + ct0;
        EPI_FOR_ROWS { const size_t ro = (size_t)(row0 + ai * HALF + m * 16) * 1024 + cb;
#pragma unroll
            for (int bj = 0; bj < 2; ++bj) { const int co = bj * HALF;
                if (kind == 0) {
#pragma unroll
                    for (int n = 0; n < 2; ++n) { const f32x4 v = acc[ai][bj][m][n]; const f32x4 b = *(const GLB f32x4*)(w0 + cb + co + 4 * n); f32x4 o;
#pragma unroll
                        for (int j = 0; j < 4; ++j) { const float pre = v[j] + b[j]; const float y = -pre; const float sp = fmaxf(y, 0.f) + __logf(1.0f + __expf(-fabsf(y)));
                            o[j] = __expf(-__expf(-sp - 0.5f)); }
                        *(GLB f32x4*)(dec + ro + co + 4 * n) = o; }
                } else if (kind == 1) { const f32x4 b0 = *(const GLB f32x4*)(a0 + cb + co), b1 = *(const GLB f32x4*)(a0 + cb + co + 4);
                    *(GLB u32x4*)(aa + ro + co) = pack8(sig4(acc[ai][bj][m][0] + b0), sig4(acc[ai][bj][m][1] + b1)); }
                else *(GLB u32x4*)(gg + ro + co) = pack8(acc[ai][bj][m][0], acc[ai][bj][m][1]); } }
    }
};
struct EpiBranch { static constexpr bool PERM = true;
    const GLB bf16_t* gate; GLB bf16_t* gout;
    __device__ __forceinline__ void operator()(const f32x4 (&acc)[2][2][4][2], const Unit& u, int wr, int wc, int fr, int fq) const {
        EPI_ROWS(u); const int n = u.pn >> 3, cb = (u.pn & 7) * 256 + ct0;
        EPI_FOR_ROWS { const size_t r = (size_t)(row0 + ai * HALF + m * 16);
#pragma unroll
            for (int bj = 0; bj < 2; ++bj) { const int c = cb + bj * HALF; f32x4 g0, g1; unpack8(*(const GLB u32x4*)(gate + r * 8192 + n * 2048 + c), g0, g1);
                f32x4 s0 = g0 * acc[ai][bj][m][0], s1 = g1 * acc[ai][bj][m][1];
                GLB u32x4* gp = (GLB u32x4*)(gout + r * 2048 + c);
                if (n > 0) { f32x4 p0, p1; unpack8(*gp, p0, p1); s0 += p0; s1 += p1; }
                *gp = pack8(s0, s1); } }
    }
};
template <bool RB, bool OB>
struct EpiResid { static constexpr bool PERM = true;
    const GLB void* resid; GLB void* out;
    __device__ __forceinline__ void operator()(const f32x4 (&acc)[2][2][4][2], const Unit& u, int wr, int wc, int fr, int fq) const {
        EPI_ROWS(u); const int cb = u.pn * 256 + ct0;
        EPI_FOR_ROWS { const size_t ro = (size_t)(row0 + ai * HALF + m * 16) * D + cb;
#pragma unroll
            for (int bj = 0; bj < 2; ++bj) { f32x4 r0, r1;
                if (RB) unpack8(*(const GLB u32x4*)((const GLB bf16_t*)resid + ro + bj * HALF), r0, r1);
                else { r0 = *(const GLB f32x4*)((const GLB float*)resid + ro + bj * HALF); r1 = *(const GLB f32x4*)((const GLB float*)resid + ro + bj * HALF + 4); }
                r0 = r0 + acc[ai][bj][m][0]; r1 = r1 + acc[ai][bj][m][1];
                if (OB) *(GLB u32x4*)((GLB bf16_t*)out + ro + bj * HALF) = pack8(r0, r1);
                else { *(GLB f32x4*)((GLB float*)out + ro + bj * HALF) = r0; *(GLB f32x4*)((GLB float*)out + ro + bj * HALF + 4) = r1; } } }
    }
};
struct EpiUp { static constexpr bool PERM = true;
    GLB bf16_t* act;
    __device__ __forceinline__ void operator()(const f32x4 (&acc)[2][2][4][2], const Unit& u, int wr, int wc, int fr, int fq) const {
        EPI_ROWS(u); const int cb = (u.pn % NCT_UP) * 128 + ct0;
        EPI_FOR_ROWS { f32x4 o[2];
#pragma unroll
            for (int n = 0; n < 2; ++n) { const f32x4 g = acc[ai][0][m][n], up = acc[ai][1][m][n];
#pragma unroll
                for (int j = 0; j < 4; ++j) o[n][j] = g[j] * sigmoidf_(g[j]) * up[j]; }
            *(GLB u32x4*)(act + (size_t)(row0 + ai * HALF + m * 16) * FF + cb) = pack8(o[0], o[1]); }
    }
};
struct EpiMoeDown { static constexpr bool PERM = true;
    GLB bf16_t* os; const GLB float* wslot; GLB float* osp; int S;
    __device__ __forceinline__ void operator()(const f32x4 (&acc)[2][2][4][2], const Unit& u, int wr, int wc, int fr, int fq) const {
        EPI_ROWS(u); const int pl = u.pn % NCT_DN;
        if (u.aux == 0) {
            const int cb = pl * 256 + ct0;
            EPI_FOR_ROWS { const int r = row0 + ai * HALF + m * 16; const float w = wslot[r]; GLB bf16_t* rp = os + (size_t)r * D + cb;
#pragma unroll
                for (int bj = 0; bj < 2; ++bj) *(GLB u32x4*)(rp + bj * HALF) = pack8(acc[ai][bj][m][0] * w, acc[ai][bj][m][1] * w); }
        } else {
            GLB float* tp = osp + ((size_t)(((u.pm - 64) * 8 + pl) * S + (u.aux - 1)) << 16);
            EPI_FOR_ROWS { const int rl = wr * 64 + fr + ai * HALF + m * 16; const float w = wslot[u.pm * BM + rl]; GLB float* rp = tp + rl * 256 + ct0;
#pragma unroll
                for (int bj = 0; bj < 2; ++bj) { *(GLB f32x4*)(rp + bj * HALF) = acc[ai][bj][m][0] * w; *(GLB f32x4*)(rp + bj * HALF + 4) = acc[ai][bj][m][1] * w; } }
        }
    }
};
template <bool OB>
struct EpiPle { static constexpr bool PERM = true;
    const GLB bf16_t* resid; GLB void* out; const GLB bf16_t* proj;
    __device__ __forceinline__ void operator()(const f32x4 (&acc)[2][2][4][2], const Unit& u, int wr, int wc, int fr, int fq) const {
        EPI_ROWS(u); const int cb = u.pn * 256 + ct0;
        EPI_FOR_ROWS { const size_t ro = (size_t)(row0 + ai * HALF + m * 16) * D + cb;
#pragma unroll
            for (int bj = 0; bj < 2; ++bj) { f32x4 p0, p1, r0, r1; unpack8(*(const GLB u32x4*)(proj + ro + bj * HALF), p0, p1); unpack8(*(const GLB u32x4*)(resid + ro + bj * HALF), r0, r1);
                r0 = r0 + sig4(acc[ai][bj][m][0]) * p0; r1 = r1 + sig4(acc[ai][bj][m][1]) * p1;
                if (OB) *(GLB u32x4*)((GLB bf16_t*)out + ro + bj * HALF) = pack8(r0, r1);
                else { *(GLB f32x4*)((GLB float*)out + ro + bj * HALF) = r0; *(GLB f32x4*)((GLB float*)out + ro + bj * HALF + 4) = r1; } } }
    }
};
struct EpiProj { static constexpr bool PERM = true;
    GLB bf16_t* proj;
    __device__ __forceinline__ void operator()(const f32x4 (&acc)[2][2][4][2], const Unit& u, int wr, int wc, int fr, int fq) const {
        EPI_ROWS(u); GLB bf16_t* base = proj + (size_t)(u.pn >> 3) * T * D + (u.pn & 7) * 256 + ct0;
        EPI_FOR_ROWS { GLB bf16_t* rp = base + (size_t)(row0 + ai * HALF + m * 16) * D;
#pragma unroll
            for (int bj = 0; bj < 2; ++bj) *(GLB u32x4*)(rp + bj * HALF) = pack8(acc[ai][bj][m][0], acc[ai][bj][m][1]); }
    }
};
}
struct Ctx {
    LAS unsigned char* lds;
    GLB unsigned char* ws;
    GLB float* out;
    int tid, lane, wave, gw, NGW, G;
};
#define WSP(type, off) ((GLB type*)(C.ws + (off)))
constexpr int INTAB_OFF = MISC_OFF + 1024;
constexpr int TAB_WS = 37, TAB_OUT = 38, TAB_RANGE = 39;
__device__ __forceinline__ const GLB void* inptr(LAS unsigned char* lds, int i) {
    const LAS unsigned* t = (const LAS unsigned*)(lds + INTAB_OFF) + 2 * i;
    const unsigned lo = __builtin_amdgcn_readfirstlane(t[0]), hi = __builtin_amdgcn_readfirstlane(t[1]);
    return (const GLB void*)(((unsigned long long)hi << 32) | lo);
}
#define INF32(i) ((const GLB float*)inptr(C.lds, (i)))
__device__ __forceinline__ Ctx make_ctx(LAS unsigned char* lds) {
    Ctx C; C.lds = lds;
    int tid = threadIdx.x; asm volatile("" : "+v"(tid));
    C.tid = tid; C.lane = tid & 63; C.wave = __builtin_amdgcn_readfirstlane(tid >> 6);
    C.G = gridDim.x; C.gw = blockIdx.x * NWAVES + C.wave; C.NGW = C.G * NWAVES;
    C.ws = (GLB unsigned char*)inptr(lds, TAB_WS); C.out = (GLB float*)inptr(lds, TAB_OUT);
    return C;
}
enum { I_X = 0, I_P, I_POS, I_WIN, I_MIXN, I_FFNN, I_PLEN, I_RWMU, I_RWW0, I_RWW2, I_RWA0, I_RWA2, I_RWG2, I_RWKK, I_RWKA, I_RWRK, I_RWLNG, I_RWLNB,
       I_DQN, I_DKN, I_DKVN, I_DWUK, I_DWUV, I_SQN, I_SKN, I_SSINK, I_WBR, I_WOUT, I_FG, I_FU, I_FD, I_MR, I_MG, I_MU, I_MD, I_PG, I_PP, N_INPUTS };

__device__ __forceinline__ void conv_tile(const GLB float* W, int ldw, int k0, int s0, int nv, GLB bf16_t* Bt, int K, int n0, LAS float* scr, int lane) {
    const int cq = lane & 15, rq = lane >> 4;
    f32x4 v[16];
#pragma unroll
    for (int i = 0; i < 16; ++i) {
        const int kk = 4 * i + rq;
        v[i] = (4 * cq < nv) ? *(const GLB f32x4*)(W + (size_t)(k0 + kk) * ldw + s0 + 4 * cq) : (f32x4){0.f, 0.f, 0.f, 0.f};
    }
#pragma unroll
    for (int i = 0; i < 16; ++i) { const int kk = 4 * i + rq; LAS float* d = scr + kk * 65 + 4 * cq; d[0] = v[i][0]; d[1] = v[i][1]; d[2] = v[i][2]; d[3] = v[i][3]; }
    LDS_WAIT();
    const int c = lane & 7;
#pragma unroll
    for (int j = 0; j < 8; ++j) { const int n = (lane >> 3) + 8 * j; const LAS float* s = scr + (8 * c) * 65 + n;
        u32x4 o; o.x = pk2(s[0 * 65], s[1 * 65]); o.y = pk2(s[2 * 65], s[3 * 65]); o.z = pk2(s[4 * 65], s[5 * 65]); o.w = pk2(s[6 * 65], s[7 * 65]);
        *(GLB u32x4*)(Bt + (size_t)(n0 + n) * K + k0 + 8 * c) = o; }
    LDS_WAIT();
}
__device__ __forceinline__ void win_map(int g, int& s0, int& nv) {
    const int d0 = 64 * g; nv = 64;
    if (d0 < 8704) s0 = d0;
    else if (d0 < 9728) s0 = 8784 + (d0 - 8704);
    else if (d0 < 9984) s0 = 9808 + (d0 - 9728);
    else if (d0 < 10240) { const int off = d0 - 9984; if (off == 0) s0 = 8704; else if (off == 64) { s0 = 8768; nv = 16; } else { s0 = 0; nv = 0; } }
    else s0 = 10064 + (d0 - 10240);
}
#ifndef MOE_SCAN_TILES
#define MOE_SCAN_TILES 42
#endif
#ifndef MOE_CONV_IN_PROLOGUE
#define MOE_CONV_IN_PROLOGUE 0
#endif
constexpr int MOE_CONV_ITEMS = NE * ((D / 64) * (2 * FF / 64) + (FF / 64) * (D / 64));
__device__ __forceinline__ void conv_moe_item(const Ctx& C, int idx, LAS float* scr, int lane) {
    constexpr int I_GU1 = (D / 64) * (2 * FF / 64), I_DN1 = (FF / 64) * (D / 64);
    if (idx < NE * I_GU1) {
        const int e = idx / I_GU1, r = idx % I_GU1, nb = r % (2 * FF / 64), kb = r / (2 * FF / 64);
        const int tile = nb >> 2, q = nb & 3; const int sc = 128 * tile + 64 * (q & 1);
        conv_tile(((q < 2) ? INF32(I_MG) : INF32(I_MU)) + (size_t)e * D * FF, FF, 64 * kb, sc, 64, WSP(bf16_t, WS_MWGU) + (size_t)e * 2 * FF * D, D, 64 * nb, scr, lane);
    } else {
        const int r0 = idx - NE * I_GU1, e = r0 / I_DN1, r = r0 % I_DN1, nb = r % 32, kb = r / 32;
        conv_tile(INF32(I_MD) + (size_t)e * FF * D, D, 64 * kb, 64 * nb, 64, WSP(bf16_t, WS_MWD) + (size_t)e * D * FF, FF, 64 * nb, scr, lane);
    }
}
__device__ __forceinline__ void ph_prologue(const Ctx& C) {
    LAS float* scr = (LAS float*)(C.lds + C.wave * 16640);
    const int gw = C.gw, NGW = C.NGW; int lane = C.lane; asm volatile("" : "+v"(lane)); lane &= 63;
    constexpr int I_WIN1 = (D / 64) * (N_INP / 64);
    constexpr int I_BR1 = (1024 / 64) * (2048 / 64);
    constexpr int I_DD = (D / 64) * (D / 64);
    constexpr int I_GU1 = (D / 64) * (2 * FF / 64);
    constexpr int I_DN1 = (FF / 64) * (D / 64);
    constexpr int I_PP1 = (256 / 64) * (D / 64);
    constexpr int S0 = 0, S1 = S0 + NL * I_WIN1, S2 = S1 + NL * 4 * I_BR1, S3 = S2 + NL * I_DD, S4 = S3 + I_GU1, S5 = S4 + I_DN1, S6 = S5 + NE * I_GU1, S7 = S6 + NE * I_DN1,
                  S8 = S7 + NL * I_DD, S9 = S8 + NL * I_PP1;
    for (int it = gw; it < S9; it += NGW) {
        if (it < S1) { const int l = it / I_WIN1, r = it % I_WIN1, nb = r % (N_INP / 64), kb = r / (N_INP / 64); int s0, nv; win_map(nb, s0, nv);
            conv_tile(INF32(I_WIN) + (size_t)l * D * N_IN, N_IN, 64 * kb, s0, nv, WSP(bf16_t, WS_WIN + l * SZ_WIN1), D, 64 * nb, scr, lane); }
        else if (it < S2) { const int q = (it - S1) / I_BR1, r = (it - S1) % I_BR1, nb = r % 32, kb = r / 32;
            conv_tile(INF32(I_WBR) + (size_t)q * 1024 * 2048, 2048, 64 * kb, 64 * nb, 64, WSP(bf16_t, WS_WBR) + (size_t)q * 2048 * 1024, 1024, 64 * nb, scr, lane); }
        else if (it < S3) { const int l = (it - S2) / I_DD, r = (it - S2) % I_DD, nb = r % 32, kb = r / 32;
            conv_tile(INF32(I_WOUT) + (size_t)l * D * D, D, 64 * kb, 64 * nb, 64, WSP(bf16_t, WS_WOUT + l * SZ_DD), D, 64 * nb, scr, lane); }
        else if (it < S4) {
            const int r = it - S3, nb = r % (2 * FF / 64), kb = r / (2 * FF / 64);
            const int tile = nb >> 2, q = nb & 3; const int sc = 128 * tile + 64 * (q & 1);
            conv_tile((q < 2) ? INF32(I_FG) : INF32(I_FU), FF, 64 * kb, sc, 64, WSP(bf16_t, WS_WGU), D, 64 * nb, scr, lane); }
        else if (it < S5) { const int r = it - S4, nb = r % 32, kb = r / 32;
            conv_tile(INF32(I_FD), D, 64 * kb, 64 * nb, 64, WSP(bf16_t, WS_WD), FF, 64 * nb, scr, lane); }
        else if (it < S7) { if (MOE_CONV_IN_PROLOGUE || it - S5 >= 2 * 1024 * MOE_SCAN_TILES) conv_moe_item(C, it - S5, scr, lane); }
        else if (it < S8) { const int l = (it - S7) / I_DD, r = (it - S7) % I_DD, nb = r % 32, kb = r / 32;
            conv_tile(INF32(I_PG) + (size_t)l * D * D, D, 64 * kb, 64 * nb, 64, WSP(bf16_t, WS_WPG + l * SZ_DD), D, 64 * nb, scr, lane); }
        else { const int l = (it - S8) / I_PP1, r = (it - S8) % I_PP1, nb = r % 32, kb = r / 32;
            conv_tile(INF32(I_PP) + (size_t)l * 256 * D, D, 64 * kb, 64 * nb, 64, WSP(bf16_t, WS_WPP) + (size_t)l * D * 256, 256, 64 * nb, scr, lane); }
    }
    for (int idx = gw * 64 + lane; idx < NL * 3072 * 256; idx += NGW * 64) {
        const int k = idx & 255, n = (idx >> 8) % 3072, l = idx / (3072 * 256);
        float v = 0.f;
        if (n < 1024) { if (k < 96) v = INF32(I_RWW2)[((size_t)l * 96 + k) * 1024 + n]; }
        else if (n < 2048) { if (k >= 96 && k < 192) v = INF32(I_RWA2)[((size_t)l * 96 + (k - 96)) * 1024 + (n - 1024)]; }
        else { if (k >= 192) v = INF32(I_RWG2)[((size_t)l * 64 + (k - 192)) * 1024 + (n - 2048)]; }
        WSP(bf16_t, WS_WLORA)[idx] = (bf16_t)f2bf(v);
    }
    for (int idx = gw * 64 + lane; idx < NL * T * 64; idx += NGW * 64) {
        const int c4 = idx & 63, t = (idx >> 6) % T, l = idx / (T * 64);
        const f32x4 v = *(const GLB f32x4*)(INF32(I_P) + ((size_t)l * T + t) * 256 + 4 * c4);
        u32x2 o; o.x = pk2(v[0], v[1]); o.y = pk2(v[2], v[3]);
        *(GLB u32x2*)(WSP(bf16_t, WS_PCAT) + (size_t)t * 512 + l * 256 + 4 * c4) = o;
    }
}

template <int MODE, bool XBF = true>
__device__ __forceinline__ void ph_norm(const Ctx& C, const GLB void* xin, GLB void* xout, const GLB float* gain, const GLB float* router, int moeS = 1) {
    int lane = C.lane; asm volatile("" : "+v"(lane)); lane &= 63;
    for (int m = C.gw; m < T; m += C.NGW) {
        f32x4 v[8]; float s = 0.f;
        if (XBF) { const GLB u32x2* xr = (const GLB u32x2*)((const GLB bf16_t*)xin + (size_t)m * D) + lane;
#pragma unroll
            for (int j = 0; j < 8; ++j) { const u32x2 w = xr[64 * j]; v[j] = (f32x4){bflo(w.x), bfhi(w.x), bflo(w.y), bfhi(w.y)}; }
        } else { const GLB f32x4* xr = (const GLB f32x4*)((const GLB float*)xin + (size_t)m * D) + lane;
#pragma unroll
            for (int j = 0; j < 8; ++j) v[j] = xr[64 * j]; }
        if (MODE == 2) {
            const GLB int* ts = WSP(int, WS_TOKSLOT) + 2 * m;
#pragma unroll
            for (int q = 0; q < 2; ++q) {
                const int sl = ts[q];
                if (sl < 64 * 256 || moeS <= 1) {
                    const GLB u32x2* o0 = (const GLB u32x2*)(WSP(bf16_t, WS_OS) + (size_t)sl * D) + lane;
#pragma unroll
                    for (int j = 0; j < 8; ++j) { const u32x2 w = o0[64 * j]; v[j] = v[j] + (f32x4){bflo(w.x), bfhi(w.x), bflo(w.y), bfhi(w.y)}; }
                } else {
                    const int tu0 = ((sl >> 8) - 64) * 8, rl = sl & 255;
#pragma unroll
                    for (int j = 0; j < 8; ++j)
                        for (int k = 0; k < moeS; ++k) v[j] = v[j] + *((const GLB f32x4*)(WSP(float, WS_OSP) + ((size_t)((tu0 + j) * moeS + k) << 16) + rl * 256) + lane);
                }
            }
#pragma unroll
            for (int j = 0; j < 8; ++j) { u32x2 o; o.x = pk2(v[j][0], v[j][1]); o.y = pk2(v[j][2], v[j][3]); ((GLB u32x2*)((GLB bf16_t*)xout + (size_t)m * D) + lane)[64 * j] = o;
                v[j] = (f32x4){bflo(o.x), bfhi(o.x), bflo(o.y), bfhi(o.y)}; }
        }
#pragma unroll
        for (int j = 0; j < 8; ++j) s += (v[j][0] * v[j][0] + v[j][1] * v[j][1]) + (v[j][2] * v[j][2] + v[j][3] * v[j][3]);
        const float rstd = 1.0f / sqrtf(wave_sum(s) * (1.0f / D) + 1e-6f);
        GLB u32x2* o8 = (GLB u32x2*)(WSP(bf16_t, WS_H) + (size_t)m * D) + lane;
        float lg[NE];
        if (MODE == 1) {
#pragma unroll
            for (int e = 0; e < NE; ++e) lg[e] = 0.f;
        }
#pragma unroll
        for (int j = 0; j < 8; ++j) { const f32x4 g = ((const GLB f32x4*)gain)[lane + 64 * j]; const f32x4 hv = v[j] * rstd * g; v[j] = hv;
            u32x2 o; o.x = pk2(hv[0], hv[1]); o.y = pk2(hv[2], hv[3]); o8[64 * j] = o; }
        if (MODE == 1) {
#pragma unroll 2
            for (int j = 0; j < 8; ++j) {
#pragma unroll
                for (int q = 0; q < 4; ++q) { const GLB f32x4* rr = (const GLB f32x4*)(router + (size_t)(4 * (lane + 64 * j) + q) * NE); const f32x4 r0 = rr[0], r1 = rr[1]; const float hq = v[j][q];
                    lg[0] += hq * r0[0]; lg[1] += hq * r0[1]; lg[2] += hq * r0[2]; lg[3] += hq * r0[3]; lg[4] += hq * r1[0]; lg[5] += hq * r1[1]; lg[6] += hq * r1[2]; lg[7] += hq * r1[3]; }
            }
        }
        if (MODE == 1) {
#pragma unroll
            for (int e = 0; e < NE; ++e) lg[e] = wave_sum(lg[e]);
            if (lane == 0) {
                int e1 = 0; float v1 = lg[0];
#pragma unroll
                for (int e = 1; e < NE; ++e) if (lg[e] > v1) { v1 = lg[e]; e1 = e; }
                int e2 = -1; float v2 = -3.0e38f;
#pragma unroll
                for (int e = 0; e < NE; ++e) if (e != e1 && lg[e] > v2) { v2 = lg[e]; e2 = e; }
                const float ex = __expf(v2 - v1), w1 = 1.0f / (1.0f + ex), w2 = ex / (1.0f + ex);
                GLB unsigned* cnt = WSP(unsigned, WS_CTL) + CW_MOECNT;
                const unsigned p1 = atomicAdd((unsigned*)cnt + 64 * e1, 1u), p2 = atomicAdd((unsigned*)cnt + 64 * e2, 1u);
                GLB unsigned* rt = WSP(unsigned, WS_ROUTE) + (size_t)m * 8;
                rt[0] = (unsigned)e1; rt[1] = p1; rt[2] = __builtin_bit_cast(unsigned, w1); rt[3] = (unsigned)e2; rt[4] = p2; rt[5] = __builtin_bit_cast(unsigned, w2);
            }
        }
    }
}
__device__ __forceinline__ void moe_offsets(const Ctx& C, int (&toff)[NE + 1]) {
    const GLB unsigned* cnt = WSP(unsigned, WS_CTL) + CW_MOECNT; int acc = 0;
#pragma unroll
    for (int e = 0; e < NE; ++e) { toff[e] = acc; const unsigned c = __hip_atomic_load(cnt + 64 * e, __ATOMIC_RELAXED, __HIP_MEMORY_SCOPE_AGENT); acc += (int)((c + 255u) >> 8); }
    toff[NE] = acc;
}
constexpr int MOETAB_OFF = MISC_OFF + 2048;
__device__ __forceinline__ void moe_tile_table(const Ctx& C) {
    int toff[NE + 1]; moe_offsets(C, toff);
    LAS int* tab = (LAS int*)(C.lds + MOETAB_OFF);
    if (C.tid <= MOE_MAXRT) { int e = 0;
#pragma unroll
        for (int j = 1; j < NE; ++j) e += (C.tid >= toff[j]) ? 1 : 0;
        tab[C.tid] = (C.tid == MOE_MAXRT) ? toff[NE] : e; }
    LDS_WAIT(); __syncthreads();
}
__device__ __forceinline__ void ph_moe_gather(const Ctx& C) {
    int toff[NE + 1]; moe_offsets(C, toff);
    int lane = C.lane; asm volatile("" : "+v"(lane)); lane &= 63;
    for (int m = C.gw; m < T; m += C.NGW) {
        const GLB unsigned* rt = WSP(unsigned, WS_ROUTE) + (size_t)m * 8;
        const int e1 = (int)rt[0], p1 = (int)rt[1], e2 = (int)rt[3], p2 = (int)rt[4];
        int o1 = 0, o2 = 0;
#pragma unroll
        for (int e = 0; e < NE; ++e) { o1 = (e == e1) ? toff[e] : o1; o2 = (e == e2) ? toff[e] : o2; }
        const int s1 = o1 * 256 + p1, s2 = o2 * 256 + p2;
        const GLB u32x4* src = (const GLB u32x4*)(WSP(bf16_t, WS_H) + (size_t)m * D) + lane;
        GLB u32x4* d1 = (GLB u32x4*)(WSP(bf16_t, WS_HS) + (size_t)s1 * D) + lane; GLB u32x4* d2 = (GLB u32x4*)(WSP(bf16_t, WS_HS) + (size_t)s2 * D) + lane;
#pragma unroll
        for (int j = 0; j < 4; ++j) { const u32x4 v = src[64 * j]; d1[64 * j] = v; d2[64 * j] = v; }
        if (lane == 0) { WSP(int, WS_TOKSLOT)[2 * m] = s1; WSP(int, WS_TOKSLOT)[2 * m + 1] = s2;
            WSP(unsigned, WS_WSLOT)[s1] = rt[2]; WSP(unsigned, WS_WSLOT)[s2] = rt[5]; }
    }
}

__device__ __forceinline__ float rope_inv_freq(int i, int half) { return exp2f(-13.287712379549449f * (float)i / (float)half); }
__device__ __forceinline__ void ph_prep(const Ctx& C, int l) {
    int lane = C.lane; asm volatile("" : "+v"(lane)); lane &= 63;
    const GLB bf16_t* UF = WSP(bf16_t, WS_UF);
    const int d = lane & 31, hh = lane >> 5;
    for (int m = C.gw; m < T; m += C.NGW) {
        const int t = m % SEQ;
        const GLB bf16_t* u = UF + (size_t)m * UFW;
        const float posf = (float)((const GLB int*)inptr(C.lds, I_POS))[m];
        float qa[8], qb[8], ia[8], ib[8], sa[8], sb[8];
#pragma unroll
        for (int h = 0; h < 8; ++h) { qa[h] = bf1(u[UF_DQ + h * 128 + lane]); qb[h] = bf1(u[UF_DQ + h * 128 + 64 + lane]); }
#pragma unroll
        for (int hp = 0; hp < 8; ++hp) { const int h = 2 * hp + hh; ia[hp] = bf1(u[UF_IQ + h * 64 + d]); ib[hp] = bf1(u[UF_IQ + h * 64 + 32 + d]); sa[hp] = bf1(u[UF_SQ + h * 64 + d]); sb[hp] = bf1(u[UF_SQ + h * 64 + 32 + d]); }
        const float ika = bf1(u[UF_IK + d]), ikb = bf1(u[UF_IK + 32 + d]), iwv = bf1(u[UF_IW + (lane & 15)]);
        const float ska = bf1(u[UF_SK + hh * 64 + d]), skb = bf1(u[UF_SK + hh * 64 + 32 + d]), sv0 = bf1(u[UF_SV + lane]), sv1 = bf1(u[UF_SV + 64 + lane]);
        {
            const GLB float* mu = INF32(I_RWMU) + (size_t)l * 3328;
#pragma unroll
            for (int half = 0; half < 2; ++half) {
                constexpr int J0[2] = {0, 7}, J1[2] = {7, 13};
                f32x4 cur[7], prv[7], mm[7];
#pragma unroll
                for (int j = J0[half]; j < J1[half]; ++j) { const int c = 4 * (lane + 64 * j), q = j - J0[half];
                    { const u32x2 w = *(const GLB u32x2*)(u + UF_RW + c); cur[q] = (f32x4){bflo(w.x), bfhi(w.x), bflo(w.y), bfhi(w.y)}; }
                    if (t > 0) { const u32x2 w = *(const GLB u32x2*)(u - UFW + UF_RW + c); prv[q] = (f32x4){bflo(w.x), bfhi(w.x), bflo(w.y), bfhi(w.y)}; } else prv[q] = (f32x4){0.f, 0.f, 0.f, 0.f};
                    mm[q] = *(const GLB f32x4*)(mu + c); }
#pragma unroll
                for (int j = J0[half]; j < J1[half]; ++j) { const int c = 4 * (lane + 64 * j), q = j - J0[half];
                    const f32x4 o = cur[q] + mm[q] * (prv[q] - cur[q]);
                    if (j < 12) { GLB bf16_t* dst = WSP(bf16_t, (j < 4 ? WS_R : (j < 8 ? WS_K : WS_V))) + (size_t)m * 1024 + (c & 1023); u32x2 w; w.x = pk2(o[0], o[1]); w.y = pk2(o[2], o[3]); *(GLB u32x2*)dst = w; }
                    else { const int k = c - 3072; f32x4 a;
                        if (k < 96) a = (f32x4){tanhf(o[0]), tanhf(o[1]), tanhf(o[2]), tanhf(o[3])};
                        else if (k < 192) a = o;
                        else a = pg8::sig4(o);
                        u32x2 w; w.x = pk2(a[0], a[1]); w.y = pk2(a[2], a[3]);
                        *(GLB u32x2*)(WSP(bf16_t, WS_ALORA) + (size_t)m * 256 + k) = w; }
                }
            }
        }
        {
            const float invf = rope_inv_freq(lane, 64); float sn, cn; sincosf(posf * invf, &sn, &cn);
            const float g1 = INF32(I_DQN)[l * 128 + lane], g2 = INF32(I_DQN)[l * 128 + 64 + lane];
#pragma unroll
            for (int h = 0; h < 8; ++h) {
                const float a = qa[h], b = qb[h];
                const float rs = 1.0f / sqrtf(wave_sum(a * a + b * b) * (1.0f / 128.f) + 1e-6f);
                const float x1 = a * rs * g1, x2 = b * rs * g2;
                GLB bf16_t* q = WSP(bf16_t, WS_QD) + (size_t)m * 1024 + h * 128;
                q[lane] = (bf16_t)f2bf(x1 * cn - x2 * sn); q[64 + lane] = (bf16_t)f2bf(x2 * cn + x1 * sn);
            }
        }
        {
            const float invf = rope_inv_freq(d, 32); float sn, cn; sincosf(posf * invf, &sn, &cn);
#pragma unroll
            for (int hp = 0; hp < 8; ++hp) { const int h = 2 * hp + hh; const float a = ia[hp], b = ib[hp];
                GLB bf16_t* q = WSP(bf16_t, WS_QI) + (size_t)m * 1024 + h * 64; q[d] = (bf16_t)f2bf(a * cn - b * sn); q[32 + d] = (bf16_t)f2bf(b * cn + a * sn); }
            if (hh == 0) { GLB bf16_t* q = WSP(bf16_t, WS_KI) + (size_t)m * 64; q[d] = (bf16_t)f2bf(ika * cn - ikb * sn); q[32 + d] = (bf16_t)f2bf(ikb * cn + ika * sn); }
            if (lane < 16) WSP(float, WS_WI)[(size_t)m * 16 + lane] = iwv * 0.03125f;
            const float sg1 = INF32(I_SQN)[l * 64 + d], sg2 = INF32(I_SQN)[l * 64 + 32 + d];
#pragma unroll
            for (int hp = 0; hp < 8; ++hp) { const int h = 2 * hp + hh; const float a = sa[hp], b = sb[hp];
                float s2 = a * a + b * b;
#pragma unroll
                for (int o = 1; o < 32; o <<= 1) s2 += __shfl_xor(s2, o);
                const float rs = 1.0f / sqrtf(s2 * (1.0f / 64.f) + 1e-6f); const float x1 = a * rs * sg1, x2 = b * rs * sg2;
                GLB bf16_t* q = WSP(bf16_t, WS_QS) + (size_t)m * 1024 + h * 64; q[d] = (bf16_t)f2bf(x1 * cn - x2 * sn); q[32 + d] = (bf16_t)f2bf(x2 * cn + x1 * sn); }
            { const float kg1 = INF32(I_SKN)[l * 64 + d], kg2 = INF32(I_SKN)[l * 64 + 32 + d];
              float s2 = ska * ska + skb * skb;
#pragma unroll
              for (int o = 1; o < 32; o <<= 1) s2 += __shfl_xor(s2, o);
              const float rs = 1.0f / sqrtf(s2 * (1.0f / 64.f) + 1e-6f); const float x1 = ska * rs * kg1, x2 = skb * rs * kg2;
              GLB bf16_t* q = WSP(bf16_t, WS_KS) + (size_t)m * 128 + hh * 64; q[d] = (bf16_t)f2bf(x1 * cn - x2 * sn); q[32 + d] = (bf16_t)f2bf(x2 * cn + x1 * sn);
              GLB bf16_t* vv = WSP(bf16_t, WS_VS) + (size_t)m * 128; vv[lane] = (bf16_t)f2bf(sv0); vv[64 + lane] = (bf16_t)f2bf(sv1); }
        }
    }
}

__device__ __forceinline__ void ph_latent(const Ctx& C, int l) {
    int lane = C.lane; asm volatile("" : "+v"(lane)); lane &= 63;
    LAS float* cs = (LAS float*)(C.lds + C.wave * 8192);
    const GLB bf16_t* UF = WSP(bf16_t, WS_UF);
    const GLB float* wuk = INF32(I_DWUK) + (size_t)l * 256 * 128; const GLB float* wuv = INF32(I_DWUV) + (size_t)l * 256 * 128;
    for (int g8 = C.gw; g8 < T / 8; g8 += C.NGW) {
        const int m0 = 8 * g8;
        float cv[8][4];
#pragma unroll
        for (int tk = 0; tk < 8; ++tk)
#pragma unroll
            for (int j = 0; j < 4; ++j) cv[tk][j] = bf1(UF[(size_t)(m0 + tk) * UFW + UF_CKV + lane + 64 * j]);
#pragma unroll
        for (int tk = 0; tk < 8; ++tk) {
            float ss = 0.f;
#pragma unroll
            for (int j = 0; j < 4; ++j) ss += cv[tk][j] * cv[tk][j];
            const float rc = 1.0f / sqrtf(wave_sum(ss) * (1.0f / 256.f) + 1e-6f);
#pragma unroll
            for (int j = 0; j < 4; ++j) cs[(lane + 64 * j) * 8 + tk] = cv[tk][j] * rc * INF32(I_DKVN)[l * 256 + lane + 64 * j];
        }
        LDS_WAIT();
        float acc[8][4];
#pragma unroll
        for (int tk = 0; tk < 8; ++tk) { acc[tk][0] = 0.f; acc[tk][1] = 0.f; acc[tk][2] = 0.f; acc[tk][3] = 0.f; }
#pragma unroll 8
        for (int k = 0; k < 256; ++k) {
            const float w0 = wuk[k * 128 + lane], w1 = wuk[k * 128 + 64 + lane], w2 = wuv[k * 128 + lane], w3 = wuv[k * 128 + 64 + lane];
            const f32x4 ca = *(const LAS f32x4*)(cs + k * 8), cb = *(const LAS f32x4*)(cs + k * 8 + 4);
#pragma unroll
            for (int tk = 0; tk < 8; ++tk) { const float c = (tk < 4) ? ca[tk & 3] : cb[tk & 3]; acc[tk][0] += c * w0; acc[tk][1] += c * w1; acc[tk][2] += c * w2; acc[tk][3] += c * w3; }
        }
        const float invf = rope_inv_freq(lane, 64);
        const float g1 = INF32(I_DKN)[l * 128 + lane], g2 = INF32(I_DKN)[l * 128 + 64 + lane];
#pragma unroll
        for (int tk = 0; tk < 8; ++tk) {
            const int m = m0 + tk;
            const float posf = (float)((const GLB int*)inptr(C.lds, I_POS))[m];
            float sn, cn; sincosf(posf * invf, &sn, &cn);
            const float k1 = acc[tk][0], k2 = acc[tk][1];
            const float rk = 1.0f / sqrtf(wave_sum(k1 * k1 + k2 * k2) * (1.0f / 128.f) + 1e-6f);
            const float y1 = k1 * rk * g1, y2 = k2 * rk * g2;
            GLB bf16_t* kd = WSP(bf16_t, WS_KD) + (size_t)m * 128; GLB bf16_t* vd = WSP(bf16_t, WS_VD) + (size_t)m * 128;
            kd[lane] = (bf16_t)f2bf(y1 * cn - y2 * sn); kd[64 + lane] = (bf16_t)f2bf(y2 * cn + y1 * sn);
            vd[lane] = (bf16_t)f2bf(acc[tk][2]); vd[64 + lane] = (bf16_t)f2bf(acc[tk][3]);
        }
        LDS_WAIT();
    }
}

__device__ __forceinline__ void ph_rwkv_kk(const Ctx& C, int l) {
    int lane = C.lane; asm volatile("" : "+v"(lane)); lane &= 63;
    for (int m = C.gw; m < T; m += C.NGW) {
#pragma unroll
        for (int i = 0; i < 4; ++i) {
            const int c = 256 * i + 4 * lane; const size_t o = (size_t)m * 1024 + c;
            const f32x4 k = *(const GLB f32x4*)(WSP(float, WS_K) + o), a = *(const GLB f32x4*)(WSP(float, WS_AA) + o);
            const f32x4 kkw = *(const GLB f32x4*)(INF32(I_RWKK) + l * 1024 + c), ka = *(const GLB f32x4*)(INF32(I_RWKA) + l * 1024 + c);
            f32x4 kk = k * kkw; float s = (kk[0] * kk[0] + kk[1] * kk[1]) + (kk[2] * kk[2] + kk[3] * kk[3]);
#pragma unroll
            for (int q = 1; q < 16; q <<= 1) s += __shfl_xor(s, q);
            const float inv = 1.0f / fmaxf(sqrtf(s), 1e-12f); kk = kk * inv;
            *(GLB f32x4*)(WSP(float, WS_KK) + o) = kk;
            *(GLB f32x4*)(WSP(float, WS_K) + o) = k * (1.0f + (a - 1.0f) * ka);
            *(GLB f32x4*)(WSP(float, WS_AA) + o) = kk * a;
        }
    }
}
__device__ __forceinline__ void ph_rwkv_scan_naive(const Ctx& C) {
    if (C.wave != 0) return;
    int lane = C.lane; asm volatile("" : "+v"(lane)); lane &= 63;
    LAS float* buf = (LAS float*)C.lds;
    for (int it = blockIdx.x; it < NB * 16; it += C.G) {
        const int b = it >> 4, h = it & 15;
        float S[64];
#pragma unroll
        for (int k = 0; k < 64; ++k) S[k] = 0.f;
        const size_t base = (size_t)b * SEQ * 1024 + h * 64 + lane;
        for (int t0 = 0; t0 < SEQ; t0 += 16) {
#pragma unroll
            for (int st = 0; st < 16; ++st) { const size_t o = base + (size_t)(t0 + st) * 1024; LAS float* d = buf + st * 384 + lane;
                d[0] = WSP(float, WS_R)[o]; d[64] = WSP(float, WS_DEC)[o]; d[128] = WSP(float, WS_K)[o]; d[192] = WSP(float, WS_KK)[o]; d[256] = WSP(float, WS_AA)[o]; d[320] = WSP(float, WS_V)[o]; }
            LDS_WAIT();
            for (int st = 0; st < 16; ++st) {
                const LAS float* rb = buf + st * 384;
                float p = 0.f;
#pragma unroll
                for (int k = 0; k < 64; k += 4) { const f32x4 q = *(const LAS f32x4*)(rb + 192 + k); p += S[k] * q[0] + S[k + 1] * q[1] + S[k + 2] * q[2] + S[k + 3] * q[3]; }
                const float vv = rb[320 + lane]; float y = 0.f;
#pragma unroll
                for (int k = 0; k < 64; k += 4) { const f32x4 w = *(const LAS f32x4*)(rb + 64 + k), bb = *(const LAS f32x4*)(rb + 256 + k), kq = *(const LAS f32x4*)(rb + 128 + k), r = *(const LAS f32x4*)(rb + k);
#pragma unroll
                    for (int j = 0; j < 4; ++j) { S[k + j] = S[k + j] * w[j] - p * bb[j] + vv * kq[j]; y += S[k + j] * r[j]; } }
                WSP(float, WS_YRAW)[base + (size_t)(t0 + st) * 1024] = y;
            }
            LDS_WAIT();
        }
    }
}
__device__ __forceinline__ f32x4 ld4bf(const GLB bf16_t* q) { const u32x2 w = *(const GLB u32x2*)q; return (f32x4){bflo(w.x), bfhi(w.x), bflo(w.y), bfhi(w.y)}; }
__device__ __forceinline__ void ph_rwkv_post(const Ctx& C, int l) {
    int lane = C.lane; asm volatile("" : "+v"(lane)); lane &= 63;
    if (C.wave >= 4) return;
    for (int m = blockIdx.x * 4 + C.wave; m < T; m += C.G * 4) {
#pragma unroll
        for (int i = 0; i < 4; ++i) {
            const int c = 256 * i + 4 * lane; const size_t o = (size_t)m * 1024 + c;
            const f32x4 y = *(const GLB f32x4*)(WSP(float, WS_YRAW) + o);
            float s = (y[0] + y[1]) + (y[2] + y[3]);
#pragma unroll
            for (int q = 1; q < 16; q <<= 1) s += __shfl_xor(s, q);
            const float mean = s * (1.0f / 64.f); const f32x4 dlt = y - mean;
            float s2 = (dlt[0] * dlt[0] + dlt[1] * dlt[1]) + (dlt[2] * dlt[2] + dlt[3] * dlt[3]);
#pragma unroll
            for (int q = 1; q < 16; q <<= 1) s2 += __shfl_xor(s2, q);
            const float rstd = 1.0f / sqrtf(s2 * (1.0f / 64.f) + 64e-5f);
            const f32x4 r = ld4bf(WSP(bf16_t, WS_R) + o), kraw = ld4bf(WSP(bf16_t, WS_K) + o), av = ld4bf(WSP(bf16_t, WS_AA) + o), v = ld4bf(WSP(bf16_t, WS_V) + o), g = ld4bf(WSP(bf16_t, WS_GG) + o);
            const f32x4 k = kraw * (1.0f + (av - 1.0f) * *(const GLB f32x4*)(INF32(I_RWKA) + l * 1024 + c));
            const f32x4 rk = *(const GLB f32x4*)(INF32(I_RWRK) + l * 1024 + c), lg = *(const GLB f32x4*)(INF32(I_RWLNG) + l * 1024 + c), lb = *(const GLB f32x4*)(INF32(I_RWLNB) + l * 1024 + c);
            const f32x4 pr = r * k * rk; float bs = (pr[0] + pr[1]) + (pr[2] + pr[3]);
#pragma unroll
            for (int q = 1; q < 16; q <<= 1) bs += __shfl_xor(bs, q);
            const f32x4 res = (dlt * rstd * lg + lb + bs * v) * g;
            u32x2 w; w.x = pk2(res[0], res[1]); w.y = pk2(res[2], res[3]);
            *(GLB u32x2*)(WSP(bf16_t, WS_Y) + (size_t)m * 4096 + 1024 + c) = w;
        }
    }
}
__device__ __forceinline__ float dot8(u32x4 kv, f32x4 qa, f32x4 qb) {
    return bflo(kv.x) * qa[0] + bfhi(kv.x) * qa[1] + bflo(kv.y) * qa[2] + bfhi(kv.y) * qa[3] + bflo(kv.z) * qb[0] + bfhi(kv.z) * qb[1] + bflo(kv.w) * qb[2] + bfhi(kv.w) * qb[3];
}
__device__ __forceinline__ void ph_sb_naive(const Ctx& C) {
    int lane = C.lane; asm volatile("" : "+v"(lane));
    LAS float* qs = (LAS float*)(C.lds + C.wave * 512);
    const GLB bf16_t* QKV = WSP(bf16_t, WS_SBQKV); GLB bf16_t* Y = WSP(bf16_t, WS_Y);
    for (int it = C.gw; it < NB * 8 * SEQ; it += C.NGW) {
        const int t = it % SEQ, bh = it / SEQ, h = bh & 7, b = bh >> 3;
        const size_t m = (size_t)b * SEQ + t;
        { const unsigned qq = *(const GLB unsigned*)(QKV + m * 3072 + h * 128 + 2 * lane); qs[2 * lane] = bflo(qq); qs[2 * lane + 1] = bfhi(qq); }
        LDS_WAIT();
        float o0 = 0.f, o1 = 0.f, carry = 0.f;
        const int nch = (t + 63) >> 6;
        for (int c = nch - 1; c >= 0; --c) {
            const int s = c * 64 + lane; const bool valid = s < t; const int sc = valid ? s : 0;
            const GLB u32x4* kp = (const GLB u32x4*)(QKV + ((size_t)b * SEQ + sc) * 3072 + 1024 + h * 128);
            float dot = 0.f;
#pragma unroll
            for (int j = 0; j < 16; ++j) dot += dot8(kp[j], *(const LAS f32x4*)(qs + 8 * j), *(const LAS f32x4*)(qs + 8 * j + 4));
            const float z = dot * 0.08838834764831845f;
            const float lk = valid ? logsigf_(-z) : 0.f, lb = logsigf_(z);
            float inc = lk;
#pragma unroll
            for (int off = 1; off < 64; off <<= 1) { const float o = __shfl_down(inc, off); if (lane + off < 64) inc += o; }
            const float w = valid ? __expf(lb + carry + inc - lk) : 0.f;
            carry += rdlane(inc, 0);
            const int nk = (t - c * 64) < 64 ? (t - c * 64) : 64;
            const GLB bf16_t* vp = QKV + ((size_t)b * SEQ + c * 64) * 3072 + 2048 + h * 128 + 2 * lane;
            for (int j = 0; j < nk; ++j) { const float wj = rdlane(w, j); const unsigned vv = *(const GLB unsigned*)(vp + (size_t)j * 3072); o0 += wj * bflo(vv); o1 += wj * bfhi(vv); }
        }
        *(GLB unsigned*)(Y + m * 4096 + h * 128 + 2 * lane) = pk2(o0, o1);
        LDS_WAIT();
    }
}
__device__ __forceinline__ void ph_swa_naive(const Ctx& C, int l) {
    int lane = C.lane; asm volatile("" : "+v"(lane));
    LAS float* qs = (LAS float*)(C.lds + C.wave * 512);
    const GLB bf16_t* QS = WSP(bf16_t, WS_QS); const GLB bf16_t* KS = WSP(bf16_t, WS_KS); const GLB bf16_t* VS = WSP(bf16_t, WS_VS); GLB bf16_t* Y = WSP(bf16_t, WS_Y);
    for (int it = C.gw; it < T * 16; it += C.NGW) {
        const int h = it & 15, m = it >> 4, t = m % SEQ, b = m / SEQ, kvh = h >> 3;
        qs[lane] = bf1(QS[(size_t)m * 1024 + h * 64 + lane]);
        LDS_WAIT();
        float lg[2];
#pragma unroll
        for (int i = 0; i < 2; ++i) { const int s = t - 127 + lane + 64 * i; const bool valid = s >= 0;
            const GLB u32x4* kp = (const GLB u32x4*)(KS + ((size_t)b * SEQ + (valid ? s : 0)) * 128 + kvh * 64);
            float dot = 0.f;
#pragma unroll
            for (int j = 0; j < 8; ++j) dot += dot8(kp[j], *(const LAS f32x4*)(qs + 8 * j), *(const LAS f32x4*)(qs + 8 * j + 4));
            lg[i] = valid ? dot * 0.125f : -3.0e38f; }
        const float sink = INF32(I_SSINK)[l * 16 + h];
        const float mx = fmaxf(wave_max(fmaxf(lg[0], lg[1])), sink);
        const float e0 = (lg[0] > -1.0e38f) ? __expf(lg[0] - mx) : 0.f, e1 = (lg[1] > -1.0e38f) ? __expf(lg[1] - mx) : 0.f;
        const float den = wave_sum(e0 + e1) + __expf(sink - mx);
        const float p0 = e0 / den, p1 = e1 / den;
        float o = 0.f;
        const int j0 = (t >= 127) ? 0 : 127 - t;
        for (int j = j0; j < 128; ++j) { const float pj = (j < 64) ? rdlane(p0, j) : rdlane(p1, j - 64); const int s = t - 127 + j;
            o += pj * bf1(VS[((size_t)b * SEQ + s) * 128 + kvh * 64 + lane]); }
        Y[(size_t)m * 4096 + 3072 + h * 64 + lane] = (bf16_t)f2bf(o);
        LDS_WAIT();
    }
}
__device__ __forceinline__ unsigned ordkey(float f) { const unsigned u = __builtin_bit_cast(unsigned, f); return (u & 0x80000000u) ? ~u : (u | 0x80000000u); }
__device__ __forceinline__ void ph_dsa_naive(const Ctx& C) {
    int lane = C.lane; asm volatile("" : "+v"(lane));
    LAS float* A = (LAS float*)(C.lds + C.wave * 13312);
    LAS float* Bs = A + 1024;
    LAS int* Cs = (LAS int*)(Bs + 2048);
    const GLB bf16_t* QI = WSP(bf16_t, WS_QI); const GLB bf16_t* KI = WSP(bf16_t, WS_KI); const GLB float* WI = WSP(float, WS_WI);
    const GLB bf16_t* QD = WSP(bf16_t, WS_QD); const GLB bf16_t* KD = WSP(bf16_t, WS_KD); const GLB bf16_t* VD = WSP(bf16_t, WS_VD); GLB bf16_t* Y = WSP(bf16_t, WS_Y);
    for (int m = C.gw; m < T; m += C.NGW) {
        const int t = m % SEQ, b = m / SEQ, n = t + 1;
        const size_t bm = (size_t)b * SEQ;
#pragma unroll
        for (int i = 0; i < 2; ++i) { const int e = 8 * (lane + 64 * i); const u32x4 q = *(const GLB u32x4*)(QI + (size_t)m * 1024 + e);
            *(LAS f32x4*)(A + e) = (f32x4){bflo(q.x), bfhi(q.x), bflo(q.y), bfhi(q.y)}; *(LAS f32x4*)(A + e + 4) = (f32x4){bflo(q.z), bfhi(q.z), bflo(q.w), bfhi(q.w)}; }
        const float wl = WI[(size_t)m * 16 + (lane & 15)];
        LDS_WAIT();
        const int nch = (n + 63) >> 6;
        for (int c = 0; c < nch; ++c) {
            const int s = c * 64 + lane; const bool valid = s < n;
            const GLB u32x4* kp = (const GLB u32x4*)(KI + (bm + (valid ? s : 0)) * 64);
            u32x4 kv[8];
#pragma unroll
            for (int j = 0; j < 8; ++j) kv[j] = kp[j];
            float sc = 0.f;
#pragma unroll 1
            for (int h = 0; h < 16; ++h) { float dot = 0.f;
#pragma unroll
                for (int j = 0; j < 8; ++j) dot += dot8(kv[j], *(const LAS f32x4*)(A + h * 64 + 8 * j), *(const LAS f32x4*)(A + h * 64 + 8 * j + 4));
                sc += rdlane(wl, h) * fmaxf(dot, 0.f); }
            Bs[s] = sc;
        }
        LDS_WAIT();
        int nsel;
        if (n <= 256) { nsel = n;
#pragma unroll
            for (int i = 0; i < 4; ++i) if (lane + 64 * i < n) Cs[lane + 64 * i] = lane + 64 * i;
        } else {
            nsel = 256;
            unsigned key[32];
#pragma unroll
            for (int i = 0; i < 32; ++i) { const int s = lane + 64 * i; key[i] = (s < n) ? ordkey(Bs[s]) : 0u; }
            unsigned tau = 0u;
            for (int bit = 31; bit >= 0; --bit) {
                const unsigned cand = tau | (1u << bit); int cnt = 0;
#pragma unroll
                for (int i = 0; i < 32; ++i) cnt += (key[i] >= cand) ? 1 : 0;
#pragma unroll
                for (int o = 1; o < 64; o <<= 1) cnt += __shfl_xor(cnt, o);
                if (cnt >= 256) tau = cand;
            }
            int cgt = 0;
#pragma unroll
            for (int i = 0; i < 32; ++i) cgt += (key[i] > tau) ? 1 : 0;
#pragma unroll
            for (int o = 1; o < 64; o <<= 1) cgt += __shfl_xor(cgt, o);
            const int need = 256 - cgt;
            int base = 0, eqbase = 0;
            const unsigned long long lt = (1ull << lane) - 1ull;
#pragma unroll
            for (int i = 0; i < 32; ++i) {
                const bool gt = key[i] > tau, eq = key[i] == tau;
                const unsigned long long beq = __ballot(eq);
                const int eqrank = eqbase + __popcll(beq & lt);
                const bool sel = gt || (eq && eqrank < need);
                const unsigned long long bs = __ballot(sel);
                if (sel) Cs[base + __popcll(bs & lt)] = lane + 64 * i;
                base += __popcll(bs); eqbase += __popcll(beq);
            }
        }
        LDS_WAIT();
#pragma unroll
        for (int i = 0; i < 2; ++i) { const int e = 8 * (lane + 64 * i); const u32x4 q = *(const GLB u32x4*)(QD + (size_t)m * 1024 + e);
            *(LAS f32x4*)(A + e) = (f32x4){bflo(q.x), bfhi(q.x), bflo(q.y), bfhi(q.y)}; *(LAS f32x4*)(A + e + 4) = (f32x4){bflo(q.z), bfhi(q.z), bflo(q.w), bfhi(q.w)}; }
        LDS_WAIT();
        float lg[8][4];
#pragma unroll
        for (int i = 0; i < 4; ++i) { const int j = lane + 64 * i; const bool valid = j < nsel; const int s = valid ? Cs[j] : 0;
            const GLB u32x4* kp = (const GLB u32x4*)(KD + (bm + s) * 128);
            float a8[8];
#pragma unroll
            for (int h = 0; h < 8; ++h) a8[h] = 0.f;
#pragma unroll 1
            for (int pc = 0; pc < 16; ++pc) { const u32x4 kv = kp[pc];
#pragma unroll
                for (int h = 0; h < 8; ++h) a8[h] += dot8(kv, *(const LAS f32x4*)(A + h * 128 + 8 * pc), *(const LAS f32x4*)(A + h * 128 + 8 * pc + 4)); }
#pragma unroll
            for (int h = 0; h < 8; ++h) lg[h][i] = valid ? a8[h] * 0.08838834764831845f : -3.0e38f; }
#pragma unroll
        for (int h = 0; h < 8; ++h) {
            const float mx = wave_max(fmaxf(fmaxf(lg[h][0], lg[h][1]), fmaxf(lg[h][2], lg[h][3])));
            float e[4]; float sm = 0.f;
#pragma unroll
            for (int i = 0; i < 4; ++i) { e[i] = (lg[h][i] > -1.0e38f) ? __expf(lg[h][i] - mx) : 0.f; sm += e[i]; }
            const float inv = 1.0f / wave_sum(sm);
#pragma unroll
            for (int i = 0; i < 4; ++i) Bs[(lane + 64 * i) * 8 + h] = e[i] * inv;
        }
        LDS_WAIT();
        float o[8][2];
#pragma unroll
        for (int h = 0; h < 8; ++h) { o[h][0] = 0.f; o[h][1] = 0.f; }
        for (int j = 0; j < nsel; ++j) { const int s = Cs[j]; const unsigned vv = *(const GLB unsigned*)(VD + (bm + s) * 128 + 2 * lane); const float v0 = bflo(vv), v1 = bfhi(vv);
            const f32x4 pa = *(const LAS f32x4*)(Bs + j * 8), pb = *(const LAS f32x4*)(Bs + j * 8 + 4);
#pragma unroll
            for (int h = 0; h < 4; ++h) { o[h][0] += pa[h] * v0; o[h][1] += pa[h] * v1; o[4 + h][0] += pb[h] * v0; o[4 + h][1] += pb[h] * v1; } }
#pragma unroll
        for (int h = 0; h < 8; ++h) *(GLB unsigned*)(Y + (size_t)m * 4096 + 2048 + h * 128 + 2 * lane) = pk2(o[h][0], o[h][1]);
        LDS_WAIT();
    }
}
typedef float f32x16 __attribute__((ext_vector_type(16)));
__device__ __forceinline__ int wave_isum(int x) {
    x += __builtin_amdgcn_mov_dpp(x, 0x128, 0xf, 0xf, true); x += __builtin_amdgcn_mov_dpp(x, 0x124, 0xf, 0xf, true);
    x += __builtin_amdgcn_mov_dpp(x, 0x122, 0xf, 0xf, true); x += __builtin_amdgcn_mov_dpp(x, 0x121, 0xf, 0xf, true);
    return __builtin_amdgcn_readlane(x, 0) + __builtin_amdgcn_readlane(x, 16) + __builtin_amdgcn_readlane(x, 32) + __builtin_amdgcn_readlane(x, 48);
}
constexpr size_t WS_SBVT = WS_MIX_END;
constexpr size_t WS_SWVT = WS_SBVT + (size_t)32 * 128 * SEQ * 2;
constexpr size_t WS_VDT = WS_SWVT + (size_t)NB * 2 * 64 * SEQ * 2;
constexpr size_t WS_SC = WS_VDT + (size_t)NB * 128 * SEQ * 2;
constexpr size_t WS_SELB = WS_SC + (size_t)T * SEQ * 4;
constexpr size_t WS_END2 = WS_SELB + (size_t)T * 32 * 8;
constexpr size_t WS_XB = (WS_END2 + 255) & ~(size_t)255;
constexpr size_t WS_END3 = WS_XB + (size_t)T * D * 2;
static_assert(WS_END3 < (size_t)2000 * 1000 * 1000, "workspace budget");

__device__ __forceinline__ void vt_tile(const GLB bf16_t* src, int src_ld, GLB bf16_t* dst, LAS bf16_t* scr, int lane) {
    const int cq = lane & 7, rq = lane >> 3;
    u32x4 v[8];
#pragma unroll
    for (int j = 0; j < 8; ++j) v[j] = *(const GLB u32x4*)(src + (size_t)(rq + 8 * j) * src_ld + 8 * cq);
#pragma unroll
    for (int j = 0; j < 8; ++j) { LAS unsigned* d = (LAS unsigned*)(scr + (rq + 8 * j) * 66 + 8 * cq); d[0] = v[j].x; d[1] = v[j].y; d[2] = v[j].z; d[3] = v[j].w; }
    LDS_WAIT();
#pragma unroll
    for (int j = 0; j < 8; ++j) { const int d = rq + 8 * j; const LAS bf16_t* s = scr + (8 * cq) * 66 + d;
        u32x4 o; o.x = (unsigned)s[0] | ((unsigned)s[66] << 16); o.y = (unsigned)s[2 * 66] | ((unsigned)s[3 * 66] << 16);
        o.z = (unsigned)s[4 * 66] | ((unsigned)s[5 * 66] << 16); o.w = (unsigned)s[6 * 66] | ((unsigned)s[7 * 66] << 16);
        *(GLB u32x4*)(dst + (size_t)d * SEQ + 8 * cq) = o; }
    LDS_WAIT();
}
__device__ __forceinline__ void ph_vt(const Ctx& C) {
    int lane = C.lane; asm volatile("" : "+v"(lane)); lane &= 63;
    LAS bf16_t* scr = (LAS bf16_t*)(C.lds + 65536 + C.wave * 8448);
    for (int it = C.gw; it < 32 * 2 * 32; it += C.NGW) {
        const int sb = it & 31, db = (it >> 5) & 1, bh = it >> 6, b = bh >> 3, h = bh & 7;
        vt_tile(WSP(bf16_t, WS_SBQKV) + ((size_t)b * SEQ + 64 * sb) * 3072 + 2048 + h * 128 + 64 * db, 3072,
                WSP(bf16_t, WS_SBVT) + ((size_t)bh * 128 + 64 * db) * SEQ + 64 * sb, scr, lane);
    }
}

__device__ __forceinline__ void ph_vt_small(const Ctx& C) {
    int lane = C.lane; asm volatile("" : "+v"(lane)); lane &= 63;
    LAS bf16_t* scr = (LAS bf16_t*)(C.lds + C.wave * 8448);
    for (int it = C.gw; it < 512; it += C.NGW) {
        const int sb = it & 31, hd = (it >> 5) & 1, b = (it >> 6) & 3, which = it >> 8;
        if (which == 0) vt_tile(WSP(bf16_t, WS_VS) + ((size_t)b * SEQ + 64 * sb) * 128 + 64 * hd, 128, WSP(bf16_t, WS_SWVT) + ((size_t)(b * 2 + hd) * 64) * SEQ + 64 * sb, scr, lane);
        else vt_tile(WSP(bf16_t, WS_VD) + ((size_t)b * SEQ + 64 * sb) * 128 + 64 * hd, 128, WSP(bf16_t, WS_VDT) + ((size_t)b * 128 + 64 * hd) * SEQ + 64 * sb, scr, lane);
    }
}

__device__ __forceinline__ void sb_item(const Ctx& C, int lane, int bh, int qb) {
    const int c = lane & 31, hh = lane >> 5, b = bh >> 3, h = bh & 7, q0 = 32 * qb;
    const GLB bf16_t* QKV = WSP(bf16_t, WS_SBQKV); const GLB bf16_t* VT = WSP(bf16_t, WS_SBVT);
    const GLB bf16_t* qp = QKV + ((size_t)b * SEQ + q0 + c) * 3072 + h * 128 + 8 * hh;
    bf16x8 qf[8];
#pragma unroll
    for (int ks = 0; ks < 8; ++ks) qf[ks] = *(const GLB bf16x8*)(qp + 16 * ks);
    f32x16 O[4];
#pragma unroll
    for (int db = 0; db < 4; ++db)
#pragma unroll
        for (int r = 0; r < 16; ++r) O[db][r] = 0.f;
    float carry = 1.0f;
    const int km = 16 * ((c >> 2) & 1) + 4 * (c >> 3) + (c & 3);
    const GLB bf16_t* kbase = QKV + ((size_t)b * SEQ + km) * 3072 + 1024 + h * 128 + 8 * hh;
    const GLB bf16_t* vbase = VT + ((size_t)bh * 128 + c) * SEQ + 16 * hh;
    bf16x8 kf[8];
#pragma unroll
    for (int ks = 0; ks < 8; ++ks) kf[ks] = *(const GLB bf16x8*)(kbase + (size_t)q0 * 3072 + 16 * ks);
    for (int kt = qb; kt >= 0; --kt) {
        const int k0 = 32 * kt;
        bf16x8 vf[2][4];
#pragma unroll
        for (int s = 0; s < 2; ++s)
#pragma unroll
            for (int db = 0; db < 4; ++db) vf[s][db] = *(const GLB bf16x8*)(vbase + (size_t)(32 * db) * SEQ + k0 + 8 * s);
        f32x16 S;
#pragma unroll
        for (int r = 0; r < 16; ++r) S[r] = 0.f;
#pragma unroll
        for (int ks = 0; ks < 8; ++ks) S = __builtin_amdgcn_mfma_f32_32x32x16_bf16(kf[ks], qf[ks], S, 0, 0, 0);
        if (kt > 0) {
#pragma unroll
            for (int ks = 0; ks < 8; ++ks) kf[ks] = *(const GLB bf16x8*)(kbase + (size_t)(k0 - 32) * 3072 + 16 * ks);
        }
        const bool diag = (kt == qb);
        float w[16]; float sp = 1.0f;
#pragma unroll
        for (int r = 15; r >= 0; --r) {
            const float z = S[r] * 0.08838834764831845f;
            const float e = __expf(-fabsf(z)), rr = __builtin_amdgcn_rcpf(1.0f + e), er = e * rr;
            const bool pos = z >= 0.f;
            const bool valid = !diag || (16 * hh + r < c);
            const float beta = valid ? (pos ? rr : er) : 0.f, om = valid ? (pos ? er : rr) : 1.0f;
            w[r] = beta * sp; sp *= om;
        }
        const float tot_other = __shfl_xor(sp, 32);
        const float pre = carry * (hh == 0 ? tot_other : 1.0f);
        carry *= sp * tot_other;
        const bool live = __ballot(carry >= 1.0e-30f) != 0ull;
        bf16x8 pw[2];
#pragma unroll
        for (int s = 0; s < 2; ++s) { u32x4 t; t.x = pk2(w[8 * s] * pre, w[8 * s + 1] * pre); t.y = pk2(w[8 * s + 2] * pre, w[8 * s + 3] * pre);
            t.z = pk2(w[8 * s + 4] * pre, w[8 * s + 5] * pre); t.w = pk2(w[8 * s + 6] * pre, w[8 * s + 7] * pre); pw[s] = __builtin_bit_cast(bf16x8, t); }
#pragma unroll
        for (int s = 0; s < 2; ++s)
#pragma unroll
            for (int db = 0; db < 4; ++db) O[db] = __builtin_amdgcn_mfma_f32_32x32x16_bf16(vf[s][db], pw[s], O[db], 0, 0, 0);
        if (!live) break;
    }
    GLB bf16_t* yp = WSP(bf16_t, WS_Y) + ((size_t)b * SEQ + q0 + c) * 4096 + h * 128 + 4 * hh;
#pragma unroll
    for (int db = 0; db < 4; ++db)
#pragma unroll
        for (int a = 0; a < 4; ++a) { u32x2 o; o.x = pk2(O[db][4 * a], O[db][4 * a + 1]); o.y = pk2(O[db][4 * a + 2], O[db][4 * a + 3]);
            *(GLB u32x2*)(yp + 32 * db + 8 * a) = o; }
}
__device__ __forceinline__ void ph_sb_fast(const Ctx& C) {
    int lane = C.lane; asm volatile("" : "+v"(lane)); lane &= 63;
    const int pi = blockIdx.x * 4 + (C.wave & 3);
    if (pi < 1024) { const int bh = pi >> 5, j = pi & 31; sb_item(C, lane, bh, (C.wave >> 2) ? 63 - j : j); }
}

#ifndef SWA_OUT_OFF
#define SWA_OUT_OFF WS_Y
#endif
__device__ __forceinline__ void swa_item(const Ctx& C, int lane, int l, int b, int h, int tb) {
    const int c = lane & 31, hh = lane >> 5, t0 = 32 * tb, kvh = h >> 3;
    const GLB bf16_t* qp = WSP(bf16_t, WS_QS) + ((size_t)b * SEQ + t0 + c) * 1024 + h * 64 + 8 * hh;
    bf16x8 qf[4];
#pragma unroll
    for (int ks = 0; ks < 4; ++ks) qf[ks] = *(const GLB bf16x8*)(qp + 16 * ks);
    const int km = 16 * ((c >> 2) & 1) + 4 * (c >> 3) + (c & 3);
    const GLB bf16_t* kbase = WSP(bf16_t, WS_KS) + ((size_t)b * SEQ + km) * 128 + kvh * 64 + 8 * hh;
    const GLB bf16_t* vbase = WSP(bf16_t, WS_SWVT) + ((size_t)(b * 2 + kvh) * 64 + c) * SEQ + 16 * hh;
    float mrun = INF32(I_SSINK)[l * 16 + h], lrun = 1.0f;
    f32x16 O[2];
#pragma unroll
    for (int db = 0; db < 2; ++db)
#pragma unroll
        for (int r = 0; r < 16; ++r) O[db][r] = 0.f;
    const int i0 = (tb >= 4) ? 0 : 4 - tb;
    for (int i = i0; i < 5; ++i) {
        const int k0 = t0 - 128 + 32 * i;
        bf16x8 kf[4], vf[2][2];
#pragma unroll
        for (int ks = 0; ks < 4; ++ks) kf[ks] = *(const GLB bf16x8*)(kbase + (size_t)k0 * 128 + 16 * ks);
#pragma unroll
        for (int s = 0; s < 2; ++s)
#pragma unroll
            for (int db = 0; db < 2; ++db) vf[s][db] = *(const GLB bf16x8*)(vbase + (size_t)(32 * db) * SEQ + k0 + 8 * s);
        f32x16 a;
#pragma unroll
        for (int r = 0; r < 16; ++r) a[r] = 0.f;
#pragma unroll
        for (int ks = 0; ks < 4; ++ks) a = __builtin_amdgcn_mfma_f32_32x32x16_bf16(kf[ks], qf[ks], a, 0, 0, 0);
        float tmax = -1.0e30f;
#pragma unroll
        for (int r = 0; r < 16; ++r) { const int kr = 16 * hh + r; const bool valid = (i == 0) ? (kr > c) : ((i == 4) ? (kr <= c) : true); a[r] = valid ? a[r] * 0.125f : -1.0e30f; tmax = fmaxf(tmax, a[r]); }
        tmax = fmaxf(tmax, __shfl_xor(tmax, 32));
        const float mnew = fmaxf(mrun, tmax), alpha = __expf(mrun - mnew);
        float psum = 0.f;
#pragma unroll
        for (int r = 0; r < 16; ++r) { a[r] = __expf(a[r] - mnew); psum += a[r]; }
        psum += __shfl_xor(psum, 32);
        lrun = lrun * alpha + psum; mrun = mnew;
#pragma unroll
        for (int db = 0; db < 2; ++db)
#pragma unroll
            for (int r = 0; r < 16; ++r) O[db][r] *= alpha;
#pragma unroll
        for (int s = 0; s < 2; ++s) {
            u32x4 t; t.x = pk2(a[8 * s], a[8 * s + 1]); t.y = pk2(a[8 * s + 2], a[8 * s + 3]); t.z = pk2(a[8 * s + 4], a[8 * s + 5]); t.w = pk2(a[8 * s + 6], a[8 * s + 7]);
            const bf16x8 pw = __builtin_bit_cast(bf16x8, t);
#pragma unroll
            for (int db = 0; db < 2; ++db) O[db] = __builtin_amdgcn_mfma_f32_32x32x16_bf16(vf[s][db], pw, O[db], 0, 0, 0);
        }
    }
    const float inv = 1.0f / lrun;
    GLB bf16_t* yp = WSP(bf16_t, SWA_OUT_OFF) + ((size_t)b * SEQ + t0 + c) * 4096 + 3072 + h * 64 + 4 * hh;
#pragma unroll
    for (int db = 0; db < 2; ++db)
#pragma unroll
        for (int a4 = 0; a4 < 4; ++a4) { u32x2 o; o.x = pk2(O[db][4 * a4] * inv, O[db][4 * a4 + 1] * inv); o.y = pk2(O[db][4 * a4 + 2] * inv, O[db][4 * a4 + 3] * inv);
            *(GLB u32x2*)(yp + 32 * db + 8 * a4) = o; }
}
__device__ __forceinline__ void ph_swa_fast(const Ctx& C, int l) {
    int lane = C.lane; asm volatile("" : "+v"(lane)); lane &= 63;
    if (C.wave >= 4) return;
    for (int it = blockIdx.x * 4 + C.wave; it < NB * 64 * 16; it += C.G * 4) { const int h = it & 15, tb = (it >> 4) & 63, b = it >> 10; swa_item(C, lane, l, b, h, tb); }
}

__device__ __forceinline__ float row16_sum(float x) {
    x += __builtin_bit_cast(float, __builtin_amdgcn_mov_dpp(__builtin_bit_cast(int, x), 0x128, 0xf, 0xf, true));
    x += __builtin_bit_cast(float, __builtin_amdgcn_mov_dpp(__builtin_bit_cast(int, x), 0x124, 0xf, 0xf, true));
    x += __builtin_bit_cast(float, __builtin_amdgcn_mov_dpp(__builtin_bit_cast(int, x), 0x122, 0xf, 0xf, true));
    x += __builtin_bit_cast(float, __builtin_amdgcn_mov_dpp(__builtin_bit_cast(int, x), 0x121, 0xf, 0xf, true));
    return x;
}
__device__ __forceinline__ void ph_rwkv_scan_fast(const Ctx& C) {
    int tid = C.tid; asm volatile("" : "+v"(tid));
    const int lane = tid & 63, wave = C.wave;
    LAS float* buf = (LAS float*)C.lds;
    constexpr int CH = 32, CHF = CH * 384;
    for (int it = blockIdx.x; it < NB * 16 * 4; it += C.G) {
        const int qr = it & 3, h = (it >> 2) & 15, b = it >> 6;
        const size_t gbase = (size_t)b * SEQ * 1024 + h * 64;
        const int ro = lane >> 4, kq = lane & 15, row = 16 * qr + 4 * (wave & 3) + ro;
        float S0 = 0.f, S1 = 0.f, S2 = 0.f, S3 = 0.f;
        const int lj = tid - 256;
        auto load_chunk = [&](int cidx) {
            f32x4 v[12];
#pragma unroll
            for (int i = 0; i < 12; ++i) { const int idx = lj + 256 * i, step = idx / 96, rem = idx - step * 96, vec = rem >> 4, e4 = rem & 15;
                const size_t off = (vec == 0) ? WS_R : (vec == 1) ? WS_DEC : (vec == 2) ? WS_K : (vec == 3) ? WS_KK : (vec == 4) ? WS_AA : WS_V;
                v[i] = *(const GLB f32x4*)(WSP(float, off) + gbase + (size_t)(cidx * CH + step) * 1024 + 4 * e4); }
            LAS float* d = buf + (cidx & 1) * CHF;
#pragma unroll
            for (int i = 0; i < 12; ++i) { const int idx = lj + 256 * i, step = idx / 96, rem = idx - step * 96; *(LAS f32x4*)(d + step * 384 + rem * 4) = v[i]; }
        };
        if (wave >= 4) load_chunk(0);
        LDS_WAIT(); __syncthreads();
        for (int cidx = 0; cidx < SEQ / CH; ++cidx) {
            if (wave >= 4) { if (cidx + 1 < SEQ / CH) load_chunk(cidx + 1); }
            else {
                const LAS float* cb = buf + (cidx & 1) * CHF;
#pragma unroll 4
                for (int st = 0; st < CH; ++st) {
                    const LAS float* rb = cb + st * 384;
                    const f32x4 kk4 = *(const LAS f32x4*)(rb + 192 + 4 * kq);
                    const float p = row16_sum(S0 * kk4[0] + S1 * kk4[1] + S2 * kk4[2] + S3 * kk4[3]);
                    const f32x4 w4 = *(const LAS f32x4*)(rb + 64 + 4 * kq), b4 = *(const LAS f32x4*)(rb + 256 + 4 * kq), k4 = *(const LAS f32x4*)(rb + 128 + 4 * kq), r4 = *(const LAS f32x4*)(rb + 4 * kq);
                    const float vv = rb[320 + row];
                    S0 = S0 * w4[0] - p * b4[0] + vv * k4[0]; S1 = S1 * w4[1] - p * b4[1] + vv * k4[1]; S2 = S2 * w4[2] - p * b4[2] + vv * k4[2]; S3 = S3 * w4[3] - p * b4[3] + vv * k4[3];
                    const float y = row16_sum(S0 * r4[0] + S1 * r4[1] + S2 * r4[2] + S3 * r4[3]);
                    if (kq == 0) WSP(float, WS_YRAW)[gbase + (size_t)(cidx * CH + st) * 1024 + row] = y;
                }
            }
            LDS_WAIT(); __syncthreads();
        }
    }
}

__device__ __forceinline__ void dsa_item(const Ctx& C, int lane, int wave, int b, int g) {
    const int c = lane & 31, hh = lane >> 5, t0 = 4 * g;
    LAS float* sc = (LAS float*)(C.lds + wave * 17408);
    LAS unsigned* bm = (LAS unsigned*)(C.lds + wave * 17408 + 16384);
    const size_t bm0 = (size_t)b * SEQ;
    const int ntile = (t0 + 3) / 32 + 1;
#pragma unroll 1
    for (int p = 0; p < 2; ++p) {
        {
            const int qq = t0 + 2 * p + ((c >> 2) & 1), hd = (c & 3) + 4 * (c >> 3);
            const GLB bf16_t* qp = WSP(bf16_t, WS_QI) + (bm0 + qq) * 1024 + hd * 64 + 8 * hh;
            bf16x8 qf[4];
#pragma unroll
            for (int ks = 0; ks < 4; ++ks) qf[ks] = *(const GLB bf16x8*)(qp + 16 * ks);
            const GLB float* wp = WSP(float, WS_WI) + (bm0 + t0 + 2 * p + hh) * 16;
            f32x4 w4[4];
#pragma unroll
            for (int j = 0; j < 4; ++j) w4[j] = *(const GLB f32x4*)(wp + 4 * j);
            const GLB bf16_t* kp = WSP(bf16_t, WS_KI) + (bm0 + c) * 64 + 8 * hh;
            bf16x8 kf[4];
#pragma unroll
            for (int ks = 0; ks < 4; ++ks) kf[ks] = *(const GLB bf16x8*)(kp + 16 * ks);
            for (int kt = 0; kt < ntile; ++kt) {
                f32x16 a;
#pragma unroll
                for (int r = 0; r < 16; ++r) a[r] = 0.f;
#pragma unroll
                for (int ks = 0; ks < 4; ++ks) a = __builtin_amdgcn_mfma_f32_32x32x16_bf16(qf[ks], kf[ks], a, 0, 0, 0);
                if (kt + 1 < ntile) {
#pragma unroll
                    for (int ks = 0; ks < 4; ++ks) kf[ks] = *(const GLB bf16x8*)(kp + (size_t)(32 * (kt + 1)) * 64 + 16 * ks);
                }
                float s = 0.f;
#pragma unroll
                for (int r = 0; r < 16; ++r) s += w4[r >> 2][r & 3] * fmaxf(a[r], 0.f);
                sc[hh * 2048 + 32 * kt + c] = s;
            }
        }
        LDS_WAIT();
#pragma unroll 1
        for (int qs = 0; qs < 2; ++qs) {
            const int t = t0 + 2 * p + qs, n = t + 1;
            const LAS float* sq = sc + qs * 2048;
            unsigned myword_lo = 0u, myword_hi = 0u;
            if (n <= 256) {
#pragma unroll
                for (int i = 0; i < 4; ++i) { const unsigned long long bal = __ballot(lane + 64 * i < n); if (lane == i) { myword_lo = (unsigned)bal; myword_hi = (unsigned)(bal >> 32); } }
            } else {
                unsigned key[32];
#pragma unroll
                for (int i = 0; i < 32; ++i) { const int s = lane + 64 * i; key[i] = (s < n) ? ordkey(sq[s]) : 0u; }
                unsigned tau = 0u;
                for (int bit = 31; bit >= 0; --bit) {
                    const unsigned cand = tau | (1u << bit); int cl = 0;
#pragma unroll
                    for (int i = 0; i < 32; ++i) cl += (key[i] >= cand) ? 1 : 0;
                    const int cnt = wave_isum(cl);
                    if (cnt >= 256) { tau = cand; if (cnt == 256) break; }
                }
                int cgl = 0;
#pragma unroll
                for (int i = 0; i < 32; ++i) cgl += (key[i] > tau) ? 1 : 0;
                const int cgt = wave_isum(cgl);
                const int need = 256 - cgt; int eqbase = 0;
                const unsigned long long lt = (1ull << lane) - 1ull;
#pragma unroll
                for (int i = 0; i < 32; ++i) {
                    const bool gt = key[i] > tau, eq = key[i] == tau;
                    const unsigned long long beq = __ballot(eq);
                    const bool sel = gt || (eq && (eqbase + __popcll(beq & lt)) < need);
                    const unsigned long long bal = __ballot(sel);
                    if (lane == i) { myword_lo = (unsigned)bal; myword_hi = (unsigned)(bal >> 32); }
                    eqbase += __popcll(beq);
                }
            }
            if (lane < 32) { bm[(2 * p + qs) * 64 + 2 * lane] = myword_lo; bm[(2 * p + qs) * 64 + 2 * lane + 1] = myword_hi; }
        }
        LDS_WAIT();
    }
    const int cq = c >> 3, ch = c & 7;
    const GLB bf16_t* qp = WSP(bf16_t, WS_QD) + (bm0 + t0 + cq) * 1024 + ch * 128 + 8 * hh;
    bf16x8 qf[8];
#pragma unroll
    for (int ks = 0; ks < 8; ++ks) qf[ks] = *(const GLB bf16x8*)(qp + 16 * ks);
    const int km = 16 * ((c >> 2) & 1) + 4 * (c >> 3) + (c & 3);
    const GLB bf16_t* kbase = WSP(bf16_t, WS_KD) + (bm0 + km) * 128 + 8 * hh;
    const GLB bf16_t* vbase = WSP(bf16_t, WS_VDT) + ((size_t)b * 128 + c) * SEQ + 16 * hh;
    const LAS unsigned short* bmh = (const LAS unsigned short*)(bm + cq * 64) + hh;
    float mrun = -1.0e20f, lrun = 0.f;
    f32x16 O[4];
#pragma unroll
    for (int db = 0; db < 4; ++db)
#pragma unroll
        for (int r = 0; r < 16; ++r) O[db][r] = 0.f;
    bf16x8 kf[8];
#pragma unroll
    for (int ks = 0; ks < 8; ++ks) kf[ks] = *(const GLB bf16x8*)(kbase + 16 * ks);
    for (int kt = 0; kt < ntile; ++kt) {
        const int k0 = 32 * kt;
        bf16x8 vf[2][4];
#pragma unroll
        for (int s = 0; s < 2; ++s)
#pragma unroll
            for (int db = 0; db < 4; ++db) vf[s][db] = *(const GLB bf16x8*)(vbase + (size_t)(32 * db) * SEQ + k0 + 8 * s);
        const unsigned bits = bmh[2 * kt];
        f32x16 a;
#pragma unroll
        for (int r = 0; r < 16; ++r) a[r] = 0.f;
#pragma unroll
        for (int ks = 0; ks < 8; ++ks) a = __builtin_amdgcn_mfma_f32_32x32x16_bf16(kf[ks], qf[ks], a, 0, 0, 0);
        if (kt + 1 < ntile) {
#pragma unroll
            for (int ks = 0; ks < 8; ++ks) kf[ks] = *(const GLB bf16x8*)(kbase + (size_t)(k0 + 32) * 128 + 16 * ks);
        }
        float tmax = -1.0e30f;
#pragma unroll
        for (int r = 0; r < 16; ++r) { a[r] = ((bits >> r) & 1u) ? a[r] * 0.08838834764831845f : -1.0e30f; tmax = fmaxf(tmax, a[r]); }
        tmax = fmaxf(tmax, __shfl_xor(tmax, 32));
        if (__ballot(tmax > mrun + 8.0f) != 0ull) {
            const float mnew = fmaxf(mrun, tmax), alpha = __expf(mrun - mnew);
            lrun *= alpha; mrun = mnew;
#pragma unroll
            for (int db = 0; db < 4; ++db)
#pragma unroll
                for (int r = 0; r < 16; ++r) O[db][r] *= alpha;
        }
        float psum = 0.f;
#pragma unroll
        for (int r = 0; r < 16; ++r) { a[r] = __expf(a[r] - mrun); psum += a[r]; }
        psum += __shfl_xor(psum, 32);
        lrun += psum;
#pragma unroll
        for (int s = 0; s < 2; ++s) {
            u32x4 t; t.x = pk2(a[8 * s], a[8 * s + 1]); t.y = pk2(a[8 * s + 2], a[8 * s + 3]); t.z = pk2(a[8 * s + 4], a[8 * s + 5]); t.w = pk2(a[8 * s + 6], a[8 * s + 7]);
            const bf16x8 pw = __builtin_bit_cast(bf16x8, t);
#pragma unroll
            for (int db = 0; db < 4; ++db) O[db] = __builtin_amdgcn_mfma_f32_32x32x16_bf16(vf[s][db], pw, O[db], 0, 0, 0);
        }
    }
    const float inv = 1.0f / lrun;
    GLB bf16_t* yp = WSP(bf16_t, WS_Y) + (bm0 + t0 + cq) * 4096 + 2048 + ch * 128 + 4 * hh;
#pragma unroll
    for (int db = 0; db < 4; ++db)
#pragma unroll
        for (int a4 = 0; a4 < 4; ++a4) { u32x2 o; o.x = pk2(O[db][4 * a4] * inv, O[db][4 * a4 + 1] * inv); o.y = pk2(O[db][4 * a4 + 2] * inv, O[db][4 * a4 + 3] * inv);
            *(GLB u32x2*)(yp + 32 * db + 8 * a4) = o; }
    LDS_WAIT();
}
__device__ __forceinline__ void ph_dsa_fast(const Ctx& C) {
    int lane = C.lane; asm volatile("" : "+v"(lane)); lane &= 63;
    const int pi = blockIdx.x * 4 + (C.wave & 3);
    if (pi < 1024) { const int b = pi >> 8, j = pi & 255; dsa_item(C, lane, C.wave, b, (C.wave >> 2) ? 511 - j : j); }
}

constexpr int SCAN_CNT_OFF = MISC_OFF + 64;
__device__ __forceinline__ void ph_rwkv_scan_conv(const Ctx& C, int l) {
    int tid = C.tid; asm volatile("" : "+v"(tid));
    const int lane = tid & 63, wave = C.wave;
    if (wave >= 4) {
        LAS float* scr = (LAS float*)(C.lds + 65536 + (wave - 4) * 16640);
        constexpr int PER = MOE_CONV_ITEMS / 2 / 1024;
        const int first = l * (MOE_CONV_ITEMS / 2) + (blockIdx.x * 4 + (wave - 4)) * PER;
        if (!MOE_CONV_IN_PROLOGUE && blockIdx.x < 256)
            for (int i = 0; i < PER; ++i) conv_moe_item(C, first + i, scr, lane);
        return;
    }
    constexpr int CH = 16, CHF = CH * 384, NCH = SEQ / CH;
    LAS float* buf = (LAS float*)C.lds;
    volatile LAS unsigned* cnt = (volatile LAS unsigned*)(C.lds + SCAN_CNT_OFF);
    const int it = blockIdx.x;
    if (it >= NB * 16 * 4) return;
    const int qr = it & 3, h = (it >> 2) & 15, b = it >> 6;
    const size_t gbase = (size_t)b * SEQ * 1024 + h * 64;
    const int ro = lane >> 4, kq = lane & 15, row = 16 * qr + 4 * wave + ro;
    unsigned target = (unsigned)l * 4u * (NCH + 1);
    auto issue = [&](int cidx) {
#pragma unroll
        for (int j = 0; j < 6; ++j) { const int i = wave + 4 * j, rho = 4 * i + ro, step = rho / 6, vec = rho - 6 * step;
            const size_t off = (vec == 0) ? WS_R : (vec == 1) ? WS_DEC : (vec == 2) ? WS_K : (vec == 3) ? WS_KK : (vec == 4) ? WS_AA : WS_V;
            const GLB float* src = WSP(float, off) + gbase + (size_t)(cidx * CH + step) * 1024 + 4 * kq;
            __builtin_amdgcn_global_load_lds((const GLB unsigned*)src, (LAS unsigned*)(buf + (cidx & 1) * CHF + i * 256), 16, 0, 0); }
    };
    auto arrive_wait = [&]() {
        asm volatile("s_waitcnt vmcnt(0)" ::: "memory");
        target += 4u;
        if (lane == 0) (void)__hip_atomic_fetch_add((LAS unsigned*)(C.lds + SCAN_CNT_OFF), 1u, __ATOMIC_RELAXED, __HIP_MEMORY_SCOPE_WORKGROUP);
        while ((int)(*cnt - target) < 0) __builtin_amdgcn_s_sleep(1);
        asm volatile("" ::: "memory");
    };
    float S0 = 0.f, S1 = 0.f, S2 = 0.f, S3 = 0.f;
    issue(0); arrive_wait();
    for (int cidx = 0; cidx < NCH; ++cidx) {
        if (cidx + 1 < NCH) issue(cidx + 1);
        const LAS float* cb = buf + (cidx & 1) * CHF;
#pragma unroll 4
        for (int st = 0; st < CH; ++st) {
            const LAS float* rb = cb + st * 384;
            const f32x4 kk4 = *(const LAS f32x4*)(rb + 192 + 4 * kq);
            const float p = row16_sum(S0 * kk4[0] + S1 * kk4[1] + S2 * kk4[2] + S3 * kk4[3]);
            const f32x4 w4 = *(const LAS f32x4*)(rb + 64 + 4 * kq), b4 = *(const LAS f32x4*)(rb + 256 + 4 * kq), k4 = *(const LAS f32x4*)(rb + 128 + 4 * kq), r4 = *(const LAS f32x4*)(rb + 4 * kq);
            const float vv = rb[320 + row];
            S0 = S0 * w4[0] - p * b4[0] + vv * k4[0]; S1 = S1 * w4[1] - p * b4[1] + vv * k4[1]; S2 = S2 * w4[2] - p * b4[2] + vv * k4[2]; S3 = S3 * w4[3] - p * b4[3] + vv * k4[3];
            const float y = row16_sum(S0 * r4[0] + S1 * r4[1] + S2 * r4[2] + S3 * r4[3]);
            if (kq == 0) WSP(float, WS_YRAW)[gbase + (size_t)(cidx * CH + st) * 1024 + row] = y;
        }
        asm volatile("s_waitcnt lgkmcnt(0)" ::: "memory");
        arrive_wait();
    }
}

#ifndef SCAN3_CONV_MODE
#define SCAN3_CONV_MODE 0
#endif
#ifndef CONV_NT
#define CONV_NT 0
#endif
__device__ __forceinline__ void conv_tile_load(const GLB float* W, int ldw, int k0, int s0, f32x4 (&v)[16], int lane) {
    const int cq = lane & 15, rq = lane >> 4;
    const unsigned loff = (unsigned)(rq * ldw + 4 * cq);
    const GLB float* base = W + (size_t)k0 * ldw + s0;
#pragma unroll
    for (int i = 0; i < 16; ++i) { const GLB float* rowp = base + (size_t)(4 * i) * ldw; v[i] = CONV_NT ? __builtin_nontemporal_load((const GLB f32x4*)(rowp + loff)) : *(const GLB f32x4*)(rowp + loff); }
}
__device__ __forceinline__ void conv_tile_to_lds(const f32x4 (&v)[16], LAS float* scr, int lane) {
    const int cq = lane & 15, rq = lane >> 4;
#pragma unroll
    for (int i = 0; i < 16; ++i) { const int kk = 4 * i + rq; LAS float* d = scr + kk * 65 + 4 * cq; d[0] = v[i][0]; d[1] = v[i][1]; d[2] = v[i][2]; d[3] = v[i][3]; }
}
__device__ __forceinline__ void conv_tile_from_lds(GLB bf16_t* Bt, int K, int n0, int k0, LAS float* scr, int lane) {
    const int c = lane & 7;
#pragma unroll
    for (int j = 0; j < 8; ++j) { const int n = (lane >> 3) + 8 * j; const LAS float* s = scr + (8 * c) * 65 + n;
        u32x4 o; o.x = pk2(s[0 * 65], s[1 * 65]); o.y = pk2(s[2 * 65], s[3 * 65]); o.z = pk2(s[4 * 65], s[5 * 65]); o.w = pk2(s[6 * 65], s[7 * 65]);
        if (CONV_NT & 2) __builtin_nontemporal_store(o, (GLB u32x4*)(Bt + (size_t)(n0 + n) * K + k0 + 8 * c)); else *(GLB u32x4*)(Bt + (size_t)(n0 + n) * K + k0 + 8 * c) = o; }
}
__device__ __forceinline__ void conv_tile_finish(const f32x4 (&v)[16], GLB bf16_t* Bt, int K, int n0, int k0, LAS float* scr, int lane) {
    conv_tile_to_lds(v, scr, lane); LDS_WAIT(); conv_tile_from_lds(Bt, K, n0, k0, scr, lane); LDS_WAIT();
}
struct MoeTile { const GLB float* W; GLB bf16_t* Bt; int ldw, K, k0, s0, n0; };
__device__ __forceinline__ MoeTile moe_tile_desc(const Ctx& C, int idx) {
    constexpr int I_GU1 = (D / 64) * (2 * FF / 64), I_DN1 = (FF / 64) * (D / 64);
    MoeTile t;
    if (idx < NE * I_GU1) {
        const int e = idx / I_GU1, r = idx % I_GU1, nb = r % (2 * FF / 64), kb = r / (2 * FF / 64), tile = nb >> 2, q = nb & 3;
        t.W = ((q < 2) ? INF32(I_MG) : INF32(I_MU)) + (size_t)e * D * FF; t.ldw = FF; t.k0 = 64 * kb; t.s0 = 128 * tile + 64 * (q & 1);
        t.Bt = WSP(bf16_t, WS_MWGU) + (size_t)e * 2 * FF * D; t.K = D; t.n0 = 64 * nb;
    } else {
        const int r0 = idx - NE * I_GU1, e = r0 / I_DN1, r = r0 % I_DN1, nb = r % 32, kb = r / 32;
        t.W = INF32(I_MD) + (size_t)e * FF * D; t.ldw = D; t.k0 = 64 * kb; t.s0 = 64 * nb; t.Bt = WSP(bf16_t, WS_MWD) + (size_t)e * D * FF; t.K = FF; t.n0 = 64 * nb;
    }
    return t;
}
__device__ __forceinline__ void ph_rwkv_scan4(const Ctx& C, int l) {
    int tid = C.tid; asm volatile("" : "+v"(tid));
    const int lane = tid & 63, wave = C.wave;
    if (wave >= 4) {
        if (MOE_CONV_IN_PROLOGUE || blockIdx.x >= 256) return;
        LAS float* scr = (LAS float*)(C.lds + 65536 + (wave - 4) * 16640);
        constexpr int PER = MOE_CONV_ITEMS / 2 / 1024;
        const int first = l * (MOE_CONV_ITEMS / 2) + (blockIdx.x * 4 + (wave - 4)) * PER;
        f32x4 va[16], vb[16];
        MoeTile ta = moe_tile_desc(C, first), tb;
        conv_tile_load(ta.W, ta.ldw, ta.k0, ta.s0, va, lane);
        for (int i = 0; i < PER; i += 2) {
            tb = moe_tile_desc(C, first + i + 1);
            conv_tile_load(tb.W, tb.ldw, tb.k0, tb.s0, vb, lane);
            conv_tile_finish(va, ta.Bt, ta.K, ta.n0, ta.k0, scr, lane);
            if (i + 2 < PER) { ta = moe_tile_desc(C, first + i + 2); conv_tile_load(ta.W, ta.ldw, ta.k0, ta.s0, va, lane); }
            conv_tile_finish(vb, tb.Bt, tb.K, tb.n0, tb.k0, scr, lane);
        }
        return;
    }
    constexpr int CH = 16, CHF = CH * 384, NCH = SEQ / CH;
    LAS float* buf = (LAS float*)C.lds;
    LAS float* ybuf = (LAS float*)(C.lds + 49152);
    volatile LAS unsigned* cnt = (volatile LAS unsigned*)(C.lds + SCAN_CNT_OFF);
    const int it = blockIdx.x;
    if (it >= NB * 16 * 4) return;
    const int qr = it & 3, h = (it >> 2) & 15, b = it >> 6;
    const size_t gbase = (size_t)b * SEQ * 1024 + h * 64;
    const int ro = lane >> 4, kq = lane & 15, rloc = 4 * wave + ro;
    unsigned target = (unsigned)l * 4u * (NCH + 1);
    auto issue = [&](int cidx) {
#pragma unroll
        for (int j = 0; j < 6; ++j) { const int i = wave + 4 * j, rho = 4 * i + ro, step = rho / 6, vec = rho - 6 * step;
            const size_t off = (vec == 0) ? WS_R : (vec == 1) ? WS_DEC : (vec == 2) ? WS_K : (vec == 3) ? WS_KK : (vec == 4) ? WS_AA : WS_V;
            const GLB float* src = WSP(float, off) + gbase + (size_t)(cidx * CH + step) * 1024 + 4 * kq;
            __builtin_amdgcn_global_load_lds((const GLB unsigned*)src, (LAS unsigned*)(buf + (cidx & 1) * CHF + i * 256), 16, 0, 0); }
    };
    auto arrive_wait = [&]() {
        asm volatile("s_waitcnt vmcnt(0) lgkmcnt(0)" ::: "memory");
        target += 4u;
        if (lane == 0) (void)__hip_atomic_fetch_add((LAS unsigned*)(C.lds + SCAN_CNT_OFF), 1u, __ATOMIC_RELAXED, __HIP_MEMORY_SCOPE_WORKGROUP);
        while ((int)(*cnt - target) < 0) __builtin_amdgcn_s_sleep(1);
        asm volatile("" ::: "memory");
    };
    auto flush_y = [&](int cidx) {
        const int st = lane >> 2, r = lane & 3;
        WSP(float, WS_YRAW)[gbase + (size_t)(cidx * CH + st) * 1024 + 16 * qr + 4 * wave + r] = ybuf[(cidx & 1) * 256 + st * 16 + 4 * wave + r];
    };
    f32x2 Sa = {0.f, 0.f}, Sb = {0.f, 0.f};
    issue(0); arrive_wait();
    for (int cidx = 0; cidx < NCH; ++cidx) {
        if (cidx > 0) flush_y(cidx - 1);
        if (cidx + 1 < NCH) issue(cidx + 1);
        const LAS float* cb = buf + (cidx & 1) * CHF;
        LAS float* yb = ybuf + (cidx & 1) * 256;
#pragma unroll 4
        for (int st = 0; st < CH; ++st) {
            const LAS float* rb = cb + st * 384;
            const f32x4 kk4 = *(const LAS f32x4*)(rb + 192 + 4 * kq);
            const f32x2 tp = Sa * (f32x2){kk4[0], kk4[1]} + Sb * (f32x2){kk4[2], kk4[3]};
            const float p = row16_sum(tp[0] + tp[1]);
            const f32x4 w4 = *(const LAS f32x4*)(rb + 64 + 4 * kq), b4 = *(const LAS f32x4*)(rb + 256 + 4 * kq), k4 = *(const LAS f32x4*)(rb + 128 + 4 * kq), r4 = *(const LAS f32x4*)(rb + 4 * kq);
            const float vv = rb[320 + 16 * qr + rloc];
            const f32x2 pp = {p, p}, vv2 = {vv, vv};
            Sa = Sa * (f32x2){w4[0], w4[1]} - pp * (f32x2){b4[0], b4[1]} + vv2 * (f32x2){k4[0], k4[1]};
            Sb = Sb * (f32x2){w4[2], w4[3]} - pp * (f32x2){b4[2], b4[3]} + vv2 * (f32x2){k4[2], k4[3]};
            const f32x2 ty = Sa * (f32x2){r4[0], r4[1]} + Sb * (f32x2){r4[2], r4[3]};
            const float y = row16_sum(ty[0] + ty[1]);
            if (kq == 0) yb[st * 16 + rloc] = y;
        }
        arrive_wait();
    }
    flush_y(NCH - 1);
}

#ifndef SCAN_TOUCH
#define SCAN_TOUCH 1
#endif
#ifndef SCAN_SCHED
#define SCAN_SCHED 1
#endif
#ifndef SCAN_UNROLL
#define SCAN_UNROLL 4
#endif
__device__ __forceinline__ void ph_rwkv_scan3(const Ctx& C, int l) {
    int tid = C.tid; asm volatile("" : "+v"(tid));
    const int lane = tid & 63, wave = C.wave;
    constexpr int CH = 16, CHF = CH * 384, NCH = SEQ / CH;
    LAS float* buf = (LAS float*)C.lds;
    LAS float* ybuf = (LAS float*)(C.lds + 49152);
    LAS float* scr = (LAS float*)(C.lds + 65536 + (wave & 3) * 16640);
    const int it = blockIdx.x;
    if (it >= NB * 16 * 4) return;
    const int qr = it & 3, h = (it >> 2) & 15, b = it >> 6;
    const size_t gbase = (size_t)b * SEQ * 1024 + h * 64;
    const int ro = lane >> 4, kq = lane & 15, rloc = 4 * (wave & 3) + ro;
    const int lj = tid - 256;
    constexpr int PER = MOE_CONV_ITEMS / 2 / 1024;
    static_assert(PER * 1024 * 2 == MOE_CONV_ITEMS && PER * 3 <= NCH, "conversion slots");
    const int cfirst = l * (MOE_CONV_ITEMS / 2) + (blockIdx.x * 4 + (wave & 3)) * PER;
    auto load_chunk = [&](int cidx) {
        f32x4 v[6];
#pragma unroll
        for (int i = 0; i < 6; ++i) { const int idx = lj + 256 * i, step = idx / 96, rem = idx - step * 96, vec = rem >> 4, e4 = rem & 15;
            const size_t off = (vec == 0) ? WS_R : (vec == 1) ? WS_DEC : (vec == 2) ? WS_K : (vec == 3) ? WS_KK : (vec == 4) ? WS_AA : WS_V;
            v[i] = *(const GLB f32x4*)(WSP(float, off) + gbase + (size_t)(cidx * CH + step) * 1024 + 4 * e4); }
        LAS float* d = buf + (cidx & 1) * CHF;
#pragma unroll
        for (int i = 0; i < 6; ++i) { const int idx = lj + 256 * i, step = idx / 96, rem = idx - step * 96; *(LAS f32x4*)(d + step * 384 + rem * 4) = v[i]; }
    };
    auto flush_y = [&](int cidx) {
        const int st = lj >> 4, r = lj & 15;
        WSP(float, WS_YRAW)[gbase + (size_t)(cidx * CH + st) * 1024 + 16 * qr + r] = ybuf[(cidx & 1) * 256 + lj];
    };
    f32x2 Sa = {0.f, 0.f}, Sb = {0.f, 0.f};
    f32x4 cv[16]; MoeTile ct; ct.W = nullptr; ct.Bt = nullptr; ct.ldw = 0; ct.K = 0; ct.k0 = 0; ct.s0 = 0; ct.n0 = 0;
#pragma unroll
    for (int i = 0; i < 16; ++i) cv[i] = (f32x4){0.f, 0.f, 0.f, 0.f};
    if (wave >= 4) load_chunk(0);
    LDS_WAIT(); __syncthreads();
    for (int cidx = 0; cidx < NCH; ++cidx) {
        if (wave >= 4) {
            if (cidx + 1 < NCH) load_chunk(cidx + 1);
            if (cidx > 0) flush_y(cidx - 1);
            if (!MOE_CONV_IN_PROLOGUE) {
                const int q3 = cidx / 3, r3 = cidx - 3 * q3;
                if (r3 == 0 && q3 < PER) { ct = moe_tile_desc(C, cfirst + q3); conv_tile_load(ct.W, ct.ldw, ct.k0, ct.s0, cv, lane); }
                else if (r3 == 1 && q3 < PER) conv_tile_finish(cv, ct.Bt, ct.K, ct.n0, ct.k0, scr, lane);
            }
        } else {
            const LAS float* cb = buf + (cidx & 1) * CHF;
            LAS float* yb = ybuf + (cidx & 1) * 256;
            __builtin_amdgcn_s_setprio(3);
#pragma unroll SCAN_UNROLL
            for (int st = 0; st < CH; ++st) {
                const LAS float* rb = cb + st * 384;
                const f32x4 kk4 = *(const LAS f32x4*)(rb + 192 + 4 * kq);
                const f32x2 tp = Sa * (f32x2){kk4[0], kk4[1]} + Sb * (f32x2){kk4[2], kk4[3]};
                const float p = row16_sum(tp[0] + tp[1]);
                const f32x4 w4 = *(const LAS f32x4*)(rb + 64 + 4 * kq), b4 = *(const LAS f32x4*)(rb + 256 + 4 * kq), k4 = *(const LAS f32x4*)(rb + 128 + 4 * kq), r4 = *(const LAS f32x4*)(rb + 4 * kq);
                const float vv = rb[320 + 16 * qr + rloc];
                const f32x2 pp = {p, p}, vv2 = {vv, vv};
                Sa = Sa * (f32x2){w4[0], w4[1]} - pp * (f32x2){b4[0], b4[1]} + vv2 * (f32x2){k4[0], k4[1]};
                Sb = Sb * (f32x2){w4[2], w4[3]} - pp * (f32x2){b4[2], b4[3]} + vv2 * (f32x2){k4[2], k4[3]};
                const f32x2 ty = Sa * (f32x2){r4[0], r4[1]} + Sb * (f32x2){r4[2], r4[3]};
                const float y = row16_sum(ty[0] + ty[1]);
                if (kq == 0) yb[st * 16 + rloc] = y;
            }
            __builtin_amdgcn_s_setprio(0);
        }
        LDS_WAIT(); __builtin_amdgcn_s_barrier(); asm volatile("" ::: "memory");
    }
    if (wave >= 4) flush_y(NCH - 1);
}


template <int CONV>
__device__ __forceinline__ void ph_rwkv_scan5(const Ctx& C, int l) {
    int tid = C.tid; asm volatile("" : "+v"(tid));
    const int lane = tid & 63, wave = C.wave;
    constexpr int CH = 16, CHF = CH * 384, NCH = SEQ / CH;
    LAS float* buf = (LAS float*)C.lds;
    LAS float* ybuf = (LAS float*)(C.lds + 49152);
    const int it = blockIdx.x;
    if (it >= NB * 16 * 4) return;
    const int qr = it & 3, h = (it >> 2) & 15, b = it >> 6;
    const size_t gbase = (size_t)b * SEQ * 1024 + h * 64;
#define SCAN5_BAR() do { LDS_WAIT(); __builtin_amdgcn_s_barrier(); asm volatile("" ::: "memory"); } while (0)
    if (wave >= 4) {
        LAS float* scr = (LAS float*)(C.lds + 65536 + (wave & 3) * 16640);
        const int lj = tid - 256;
        constexpr int PER = MOE_SCAN_TILES;
        static_assert(PER * 1024 * 2 <= MOE_CONV_ITEMS && PER * 3 + 2 <= NCH && PER % 2 == 0, "conversion slots");
        const int cfirst = ((CONV >= 2) ? 1 : l) * (1024 * PER) + (blockIdx.x * 4 + (wave & 3));
        f32x4 nx[5];
        const unsigned lo_g = (unsigned)((lj >> 4) * 1024 + 4 * (lj & 15));
        const int lo_l = (lj >> 4) * 384 + 4 * (lj & 15);
        const f32x4 kkw = *(const GLB f32x4*)(INF32(I_RWKK) + l * 1024 + h * 64 + 4 * (lj & 15)), kaw = *(const GLB f32x4*)(INF32(I_RWKA) + l * 1024 + h * 64 + 4 * (lj & 15));
        u32x2 nb[4];
        auto fetch_chunk = [&](int cidx) {
            nx[1] = *(const GLB f32x4*)(WSP(float, WS_DEC) + gbase + (size_t)(cidx * CH) * 1024 + lo_g);
#pragma unroll
            for (int i = 0; i < 4; ++i) { const size_t off = (i == 0) ? WS_R : (i == 1) ? WS_K : (i == 2) ? WS_AA : WS_V;
                nb[i] = *(const GLB u32x2*)(WSP(bf16_t, off) + gbase + (size_t)(cidx * CH) * 1024 + lo_g); }
        };
        auto put_chunk = [&](int cidx) {
            LAS float* d = buf + (cidx & 1) * CHF + lo_l;
            asm volatile("" : "+v"(nx[1]), "+v"(nb[0]), "+v"(nb[1]), "+v"(nb[2]), "+v"(nb[3]));
            nx[0] = (f32x4){bflo(nb[0].x), bfhi(nb[0].x), bflo(nb[0].y), bfhi(nb[0].y)}; nx[4] = (f32x4){bflo(nb[3].x), bfhi(nb[3].x), bflo(nb[3].y), bfhi(nb[3].y)};
            const f32x4 kr = (f32x4){bflo(nb[1].x), bfhi(nb[1].x), bflo(nb[1].y), bfhi(nb[1].y)}, av = (f32x4){bflo(nb[2].x), bfhi(nb[2].x), bflo(nb[2].y), bfhi(nb[2].y)};
            f32x4 kk = kr * kkw;
            const float ss = row16_sum((kk[0] * kk[0] + kk[1] * kk[1]) + (kk[2] * kk[2] + kk[3] * kk[3]));
            kk = kk * (1.0f / fmaxf(sqrtf(ss), 1e-12f));
            *(LAS f32x4*)(d) = nx[0]; *(LAS f32x4*)(d + 64) = nx[1]; *(LAS f32x4*)(d + 128) = kr * (1.0f + (av - 1.0f) * kaw);
            *(LAS f32x4*)(d + 192) = kk; *(LAS f32x4*)(d + 256) = kk * av; *(LAS f32x4*)(d + 320) = nx[4];
        };
        auto flush_y = [&](int cidx) {
            const int st = lj >> 4, r = lj & 15;
            WSP(float, WS_YRAW)[gbase + (size_t)(cidx * CH + st) * 1024 + 16 * qr + r] = ybuf[(cidx & 1) * 256 + lj];
        };
#if SCAN_SCHED == 4
        struct FS { f32x4 dec; u32x2 nb[4]; };
        FS fs[6];
        auto fetch2 = [&](int cidx, FS& f) {
            f.dec = *(const GLB f32x4*)(WSP(float, WS_DEC) + gbase + (size_t)(cidx * CH) * 1024 + lo_g);
#pragma unroll
            for (int i = 0; i < 4; ++i) { const size_t off = (i == 0) ? WS_R : (i == 1) ? WS_K : (i == 2) ? WS_AA : WS_V;
                f.nb[i] = *(const GLB u32x2*)(WSP(bf16_t, off) + gbase + (size_t)(cidx * CH) * 1024 + lo_g); }
        };
        auto put2 = [&](int cidx, FS& f) {
            LAS float* d = buf + (cidx & 1) * CHF + lo_l;
            asm volatile("" : "+v"(f.dec), "+v"(f.nb[0]), "+v"(f.nb[1]), "+v"(f.nb[2]), "+v"(f.nb[3]));
            const f32x4 rr = (f32x4){bflo(f.nb[0].x), bfhi(f.nb[0].x), bflo(f.nb[0].y), bfhi(f.nb[0].y)}, vv = (f32x4){bflo(f.nb[3].x), bfhi(f.nb[3].x), bflo(f.nb[3].y), bfhi(f.nb[3].y)};
            const f32x4 kr = (f32x4){bflo(f.nb[1].x), bfhi(f.nb[1].x), bflo(f.nb[1].y), bfhi(f.nb[1].y)}, av = (f32x4){bflo(f.nb[2].x), bfhi(f.nb[2].x), bflo(f.nb[2].y), bfhi(f.nb[2].y)};
            f32x4 kk = kr * kkw;
            const float ss = row16_sum((kk[0] * kk[0] + kk[1] * kk[1]) + (kk[2] * kk[2] + kk[3] * kk[3]));
            kk = kk * (1.0f / fmaxf(sqrtf(ss), 1e-12f));
            *(LAS f32x4*)(d) = rr; *(LAS f32x4*)(d + 64) = f.dec; *(LAS f32x4*)(d + 128) = kr * (1.0f + (av - 1.0f) * kaw);
            *(LAS f32x4*)(d + 192) = kk; *(LAS f32x4*)(d + 256) = kk * av; *(LAS f32x4*)(d + 320) = vv;
        };
        f32x4 cv[16]; MoeTile ct; ct.W = nullptr; ct.Bt = nullptr; ct.ldw = 0; ct.K = 0; ct.k0 = 0; ct.s0 = 0; ct.n0 = 0;
#pragma unroll
        for (int i = 0; i < 16; ++i) cv[i] = (f32x4){0.f, 0.f, 0.f, 0.f};
        {
            const int vit = blockIdx.x * 4 + (wave & 3);
            if (vit < 512) { const int sb = vit & 31, hd = (vit >> 5) & 1, vb = (vit >> 6) & 3;
                if ((vit >> 8) == 0) vt_tile(WSP(bf16_t, WS_VS) + ((size_t)vb * SEQ + 64 * sb) * 128 + 64 * hd, 128, WSP(bf16_t, WS_SWVT) + ((size_t)(vb * 2 + hd) * 64) * SEQ + 64 * sb, (LAS bf16_t*)scr, lane);
                else vt_tile(WSP(bf16_t, WS_VD) + ((size_t)vb * SEQ + 64 * sb) * 128 + 64 * hd, 128, WSP(bf16_t, WS_VDT) + ((size_t)vb * 128 + 64 * hd) * SEQ + 64 * sb, (LAS bf16_t*)scr, lane); }
        }
        static_assert(PER * 3 + 2 == NCH && PER % 2 == 0, "period schedule");
        const int off = (int)((blockIdx.x * 4u + (unsigned)(wave & 3)) & 1u);
        fetch2(0, fs[0]); put2(0, fs[0]); fetch2(1, fs[0]);
        SCAN5_BAR();
        int c = 0;
        for (; c < 1 + off; ++c) { put2(c + 1, fs[0]); fetch2(c + 2, fs[0]); if (c > 0) flush_y(c - 1); SCAN5_BAR(); }
#pragma unroll
        for (int i = 1; i < 6; ++i) fetch2(c + 1 + i, fs[i]);
        asm volatile("; MARK scan5 periodic begin");
        auto period = [&](int j6, bool first) {
#pragma unroll
            for (int m6 = 0; m6 < 6; ++m6) {
                asm volatile("; MARK m6 iter");
                put2(c + 1, fs[m6]); fetch2(c + 7 < NCH ? c + 7 : NCH - 1, fs[m6]); flush_y(c - 1);
                if (!MOE_CONV_IN_PROLOGUE && CONV) {
                    if (m6 == 0) { if (!first) conv_tile_finish(cv, ct.Bt, ct.K, ct.n0, ct.k0, scr, lane);
                        ct = moe_tile_desc(C, cfirst + 1024 * (2 * j6)); conv_tile_load(ct.W, ct.ldw, ct.k0, ct.s0, cv, lane); }
                    if (m6 == 3 && !first) { const MoeTile cb = moe_tile_desc(C, cfirst + 1024 * (2 * j6 - 1)); conv_tile_from_lds(cb.Bt, cb.K, cb.n0, cb.k0, scr, lane); }
                }
                SCAN5_BAR(); ++c;
            }
        };
        period(0, true);
        for (int j6 = 1; j6 < PER / 2; ++j6) period(j6, false);
        asm volatile("; MARK scan5 periodic end");
        for (; c < NCH; ++c) { flush_y(c - 1); SCAN5_BAR(); }
        if (!MOE_CONV_IN_PROLOGUE && CONV) {
            conv_tile_finish(cv, ct.Bt, ct.K, ct.n0, ct.k0, scr, lane);
            SCAN5_BAR();
            SCAN5_BAR();
            { const MoeTile cb = moe_tile_desc(C, cfirst + 1024 * (PER - 1)); conv_tile_from_lds(cb.Bt, cb.K, cb.n0, cb.k0, scr, lane); }
        }
#elif SCAN_SCHED == 3
        struct FS { f32x4 dec; u32x2 nb[4]; };
        FS fs[6];
        auto fetch2 = [&](int cidx, FS& f) {
            f.dec = *(const GLB f32x4*)(WSP(float, WS_DEC) + gbase + (size_t)(cidx * CH) * 1024 + lo_g);
#pragma unroll
            for (int i = 0; i < 4; ++i) { const size_t off = (i == 0) ? WS_R : (i == 1) ? WS_K : (i == 2) ? WS_AA : WS_V;
                f.nb[i] = *(const GLB u32x2*)(WSP(bf16_t, off) + gbase + (size_t)(cidx * CH) * 1024 + lo_g); }
        };
        auto put2 = [&](int cidx, FS& f) {
            LAS float* d = buf + (cidx & 1) * CHF + lo_l;
            asm volatile("" : "+v"(f.dec), "+v"(f.nb[0]), "+v"(f.nb[1]), "+v"(f.nb[2]), "+v"(f.nb[3]));
            const f32x4 rr = (f32x4){bflo(f.nb[0].x), bfhi(f.nb[0].x), bflo(f.nb[0].y), bfhi(f.nb[0].y)}, vv = (f32x4){bflo(f.nb[3].x), bfhi(f.nb[3].x), bflo(f.nb[3].y), bfhi(f.nb[3].y)};
            const f32x4 kr = (f32x4){bflo(f.nb[1].x), bfhi(f.nb[1].x), bflo(f.nb[1].y), bfhi(f.nb[1].y)}, av = (f32x4){bflo(f.nb[2].x), bfhi(f.nb[2].x), bflo(f.nb[2].y), bfhi(f.nb[2].y)};
            f32x4 kk = kr * kkw;
            const float ss = row16_sum((kk[0] * kk[0] + kk[1] * kk[1]) + (kk[2] * kk[2] + kk[3] * kk[3]));
            kk = kk * (1.0f / fmaxf(sqrtf(ss), 1e-12f));
            *(LAS f32x4*)(d) = rr; *(LAS f32x4*)(d + 64) = f.dec; *(LAS f32x4*)(d + 128) = kr * (1.0f + (av - 1.0f) * kaw);
            *(LAS f32x4*)(d + 192) = kk; *(LAS f32x4*)(d + 256) = kk * av; *(LAS f32x4*)(d + 320) = vv;
        };
        f32x4 cv[16]; MoeTile ct; ct.W = nullptr; ct.Bt = nullptr; ct.ldw = 0; ct.K = 0; ct.k0 = 0; ct.s0 = 0; ct.n0 = 0;
#pragma unroll
        for (int i = 0; i < 16; ++i) cv[i] = (f32x4){0.f, 0.f, 0.f, 0.f};
        {
            const int vit = blockIdx.x * 4 + (wave & 3);
            if (vit < 512) { const int sb = vit & 31, hd = (vit >> 5) & 1, vb = (vit >> 6) & 3;
                if ((vit >> 8) == 0) vt_tile(WSP(bf16_t, WS_VS) + ((size_t)vb * SEQ + 64 * sb) * 128 + 64 * hd, 128, WSP(bf16_t, WS_SWVT) + ((size_t)(vb * 2 + hd) * 64) * SEQ + 64 * sb, (LAS bf16_t*)scr, lane);
                else vt_tile(WSP(bf16_t, WS_VD) + ((size_t)vb * SEQ + 64 * sb) * 128 + 64 * hd, 128, WSP(bf16_t, WS_VDT) + ((size_t)vb * 128 + 64 * hd) * SEQ + 64 * sb, (LAS bf16_t*)scr, lane); }
        }
        static_assert(PER * 3 + 2 == NCH && PER % 2 == 0, "period schedule");
        const int off = (int)((blockIdx.x * 4u + (unsigned)(wave & 3)) & 1u);
        fetch2(0, fs[0]); put2(0, fs[0]); fetch2(1, fs[0]);
        SCAN5_BAR();
        int c = 0;
        for (; c < 1 + off; ++c) { put2(c + 1, fs[0]); fetch2(c + 2, fs[0]); if (c > 0) flush_y(c - 1); SCAN5_BAR(); }
#pragma unroll
        for (int i = 1; i < 6; ++i) fetch2(c + 1 + i, fs[i]);
        asm volatile("; MARK scan5 periodic begin");
        auto period = [&](int j6, bool first) {
#pragma unroll
            for (int m6 = 0; m6 < 6; ++m6) {
                asm volatile("; MARK m6 iter");
                put2(c + 1, fs[m6]); fetch2(c + 7 < NCH ? c + 7 : NCH - 1, fs[m6]); flush_y(c - 1);
                if (!MOE_CONV_IN_PROLOGUE && CONV && (m6 == 0 || (m6 == 3 && CONV != 5))) {
                    if (!(first && m6 == 0)) { if (CONV == 1) conv_tile_finish(cv, ct.Bt, ct.K, ct.n0, ct.k0, scr, lane);
                        else { asm volatile("" :: "v"(cv[0]), "v"(cv[1]), "v"(cv[2]), "v"(cv[3]), "v"(cv[4]), "v"(cv[5]), "v"(cv[6]), "v"(cv[7])); asm volatile("" :: "v"(cv[8]), "v"(cv[9]), "v"(cv[10]), "v"(cv[11]), "v"(cv[12]), "v"(cv[13]), "v"(cv[14]), "v"(cv[15])); } }
                    ct = moe_tile_desc(C, cfirst + 1024 * (2 * j6 + (m6 == 3 ? 1 : 0))); conv_tile_load(ct.W, ct.ldw, ct.k0, ct.s0, cv, lane);
                }
                SCAN5_BAR(); ++c;
            }
        };
        period(0, true);
        for (int j6 = 1; j6 < PER / 2; ++j6) period(j6, false);
        asm volatile("; MARK scan5 periodic end");
        for (; c < NCH; ++c) { flush_y(c - 1); SCAN5_BAR(); }
        if (!MOE_CONV_IN_PROLOGUE && CONV == 1) conv_tile_finish(cv, ct.Bt, ct.K, ct.n0, ct.k0, scr, lane);
#elif SCAN_SCHED == 2
        struct FS { f32x4 dec; u32x2 nb[4]; };
        FS fs[2];
        auto fetch2 = [&](int cidx, FS& f) {
            f.dec = *(const GLB f32x4*)(WSP(float, WS_DEC) + gbase + (size_t)(cidx * CH) * 1024 + lo_g);
#pragma unroll
            for (int i = 0; i < 4; ++i) { const size_t off = (i == 0) ? WS_R : (i == 1) ? WS_K : (i == 2) ? WS_AA : WS_V;
                f.nb[i] = *(const GLB u32x2*)(WSP(bf16_t, off) + gbase + (size_t)(cidx * CH) * 1024 + lo_g); }
        };
        auto put2 = [&](int cidx, FS& f) {
            LAS float* d = buf + (cidx & 1) * CHF + lo_l;
            asm volatile("" : "+v"(f.dec), "+v"(f.nb[0]), "+v"(f.nb[1]), "+v"(f.nb[2]), "+v"(f.nb[3]));
            const f32x4 rr = (f32x4){bflo(f.nb[0].x), bfhi(f.nb[0].x), bflo(f.nb[0].y), bfhi(f.nb[0].y)}, vv = (f32x4){bflo(f.nb[3].x), bfhi(f.nb[3].x), bflo(f.nb[3].y), bfhi(f.nb[3].y)};
            const f32x4 kr = (f32x4){bflo(f.nb[1].x), bfhi(f.nb[1].x), bflo(f.nb[1].y), bfhi(f.nb[1].y)}, av = (f32x4){bflo(f.nb[2].x), bfhi(f.nb[2].x), bflo(f.nb[2].y), bfhi(f.nb[2].y)};
            f32x4 kk = kr * kkw;
            const float ss = row16_sum((kk[0] * kk[0] + kk[1] * kk[1]) + (kk[2] * kk[2] + kk[3] * kk[3]));
            kk = kk * (1.0f / fmaxf(sqrtf(ss), 1e-12f));
            *(LAS f32x4*)(d) = rr; *(LAS f32x4*)(d + 64) = f.dec; *(LAS f32x4*)(d + 128) = kr * (1.0f + (av - 1.0f) * kaw);
            *(LAS f32x4*)(d + 192) = kk; *(LAS f32x4*)(d + 256) = kk * av; *(LAS f32x4*)(d + 320) = vv;
        };
        f32x4 cv[16]; MoeTile ct; ct.W = nullptr; ct.Bt = nullptr; ct.ldw = 0; ct.K = 0; ct.k0 = 0; ct.s0 = 0; ct.n0 = 0;
#pragma unroll
        for (int i = 0; i < 16; ++i) cv[i] = (f32x4){0.f, 0.f, 0.f, 0.f};
        {
            const int vit = blockIdx.x * 4 + (wave & 3);
            if (vit < 512) { const int sb = vit & 31, hd = (vit >> 5) & 1, vb = (vit >> 6) & 3;
                if ((vit >> 8) == 0) vt_tile(WSP(bf16_t, WS_VS) + ((size_t)vb * SEQ + 64 * sb) * 128 + 64 * hd, 128, WSP(bf16_t, WS_SWVT) + ((size_t)(vb * 2 + hd) * 64) * SEQ + 64 * sb, (LAS bf16_t*)scr, lane);
                else vt_tile(WSP(bf16_t, WS_VD) + ((size_t)vb * SEQ + 64 * sb) * 128 + 64 * hd, 128, WSP(bf16_t, WS_VDT) + ((size_t)vb * 128 + 64 * hd) * SEQ + 64 * sb, (LAS bf16_t*)scr, lane); }
        }
        static_assert(PER * 3 + 2 == NCH && PER % 2 == 0, "period schedule");
        const int off = (int)((blockIdx.x * 4u + (unsigned)(wave & 3)) & 1u);
        fetch2(0, fs[0]); put2(0, fs[0]); fetch2(1, fs[0]);
        SCAN5_BAR();
        int c = 0;
        for (; c < 1 + off; ++c) { put2(c + 1, fs[0]); fetch2(c + 2, fs[0]); if (c > 0) flush_y(c - 1); SCAN5_BAR(); }
        fetch2(c + 2, fs[1]);
        asm volatile("; MARK scan5 periodic begin");
        auto period = [&](int j6, bool first) {
#pragma unroll
            for (int m6 = 0; m6 < 6; ++m6) {
                asm volatile("; MARK m6 iter");
                put2(c + 1, fs[m6 & 1]); fetch2(c + 3 < NCH ? c + 3 : NCH - 1, fs[m6 & 1]); flush_y(c - 1);
                if (!MOE_CONV_IN_PROLOGUE && CONV && (m6 == 0 || (m6 == 3 && CONV != 5))) {
                    if (!(first && m6 == 0)) {
                        if (CONV == 1 || CONV == 4) conv_tile_finish(cv, ct.Bt, ct.K, ct.n0, ct.k0, scr, lane);
                        else if (CONV == 3) { const int cc = lane & 7;
#pragma unroll
                            for (int j = 0; j < 8; ++j) { const int n = (lane >> 3) + 8 * j; u32x4 o; o.x = pk2(cv[2 * j][0], cv[2 * j][1]); o.y = pk2(cv[2 * j][2], cv[2 * j][3]); o.z = pk2(cv[2 * j + 1][0], cv[2 * j + 1][1]); o.w = pk2(cv[2 * j + 1][2], cv[2 * j + 1][3]);
                                *(GLB u32x4*)(ct.Bt + (size_t)(ct.n0 + n) * ct.K + ct.k0 + 8 * cc) = o; } }
                        else { asm volatile("" :: "v"(cv[0]), "v"(cv[1]), "v"(cv[2]), "v"(cv[3]), "v"(cv[4]), "v"(cv[5]), "v"(cv[6]), "v"(cv[7])); asm volatile("" :: "v"(cv[8]), "v"(cv[9]), "v"(cv[10]), "v"(cv[11]), "v"(cv[12]), "v"(cv[13]), "v"(cv[14]), "v"(cv[15])); }
                    }
                    ct = moe_tile_desc(C, cfirst + 1024 * (2 * j6 + (m6 == 3 ? 1 : 0))); conv_tile_load(ct.W, ct.ldw, ct.k0, ct.s0, cv, lane);
                }
                SCAN5_BAR(); ++c;
            }
        };
        period(0, true);
        for (int j6 = 1; j6 < PER / 2; ++j6) period(j6, false);
        asm volatile("; MARK scan5 periodic end");
        for (; c < NCH; ++c) { flush_y(c - 1); SCAN5_BAR(); }
        if (!MOE_CONV_IN_PROLOGUE && (CONV == 1 || CONV == 4)) conv_tile_finish(cv, ct.Bt, ct.K, ct.n0, ct.k0, scr, lane);
#elif SCAN_SCHED == 1
        f32x4 cv[16]; MoeTile ct; ct.W = nullptr; ct.Bt = nullptr; ct.ldw = 0; ct.K = 0; ct.k0 = 0; ct.s0 = 0; ct.n0 = 0;
#pragma unroll
        for (int i = 0; i < 16; ++i) cv[i] = (f32x4){0.f, 0.f, 0.f, 0.f};
        {
            const int vit = blockIdx.x * 4 + (wave & 3);
            if (vit < 512) { const int sb = vit & 31, hd = (vit >> 5) & 1, vb = (vit >> 6) & 3;
                if ((vit >> 8) == 0) vt_tile(WSP(bf16_t, WS_VS) + ((size_t)vb * SEQ + 64 * sb) * 128 + 64 * hd, 128, WSP(bf16_t, WS_SWVT) + ((size_t)(vb * 2 + hd) * 64) * SEQ + 64 * sb, (LAS bf16_t*)scr, lane);
                else vt_tile(WSP(bf16_t, WS_VD) + ((size_t)vb * SEQ + 64 * sb) * 128 + 64 * hd, 128, WSP(bf16_t, WS_VDT) + ((size_t)vb * 128 + 64 * hd) * SEQ + 64 * sb, (LAS bf16_t*)scr, lane); }
        }
        static_assert(PER * 3 + 2 == NCH && PER % 2 == 0, "period schedule");
        const int off = (int)((blockIdx.x * 4u + (unsigned)(wave & 3)) & 1u);
        auto plain = [&](int c) { if (c + 1 < NCH) put_chunk(c + 1); if (c + 2 < NCH) fetch_chunk(c + 2); if (c > 0) flush_y(c - 1); };
        auto plain_nc = [&](int c) { put_chunk(c + 1); fetch_chunk(c + 2 < NCH ? c + 2 : NCH - 1); flush_y(c - 1); };
        fetch_chunk(0); put_chunk(0); fetch_chunk(1);
        SCAN5_BAR();
        int c = 0;
        for (; c < 1 + off; ++c) { plain(c); SCAN5_BAR(); }
        asm volatile("; MARK scan5 periodic begin");
        auto period = [&](int j6) {
#pragma unroll
            for (int m6 = 0; m6 < 6; ++m6) {
                asm volatile("; MARK m6 iter");
                plain_nc(c);
                if (!MOE_CONV_IN_PROLOGUE && CONV) {
                    if (m6 == 0 || m6 == 3) { ct = moe_tile_desc(C, cfirst + 1024 * (2 * j6 + (m6 == 3 ? 1 : 0))); conv_tile_load(ct.W, ct.ldw, ct.k0, ct.s0, cv, lane); }
                    if (m6 == 2 || m6 == 5) conv_tile_finish(cv, ct.Bt, ct.K, ct.n0, ct.k0, scr, lane);
                }
                SCAN5_BAR(); ++c;
            }
        };
        period(0);
        for (int j6 = 1; j6 < PER / 2; ++j6) period(j6);
        asm volatile("; MARK scan5 periodic end");
        for (; c < NCH; ++c) { plain(c); SCAN5_BAR(); }
#else
        f32x4 cv[16], cv2[16]; MoeTile ct; ct.W = nullptr; ct.Bt = nullptr; ct.ldw = 0; ct.K = 0; ct.k0 = 0; ct.s0 = 0; ct.n0 = 0; MoeTile ct2 = ct;
#pragma unroll
        for (int i = 0; i < 16; ++i) { cv[i] = (f32x4){0.f, 0.f, 0.f, 0.f}; cv2[i] = cv[i]; }
        {
            const int vit = blockIdx.x * 4 + (wave & 3);
            if (vit < 512) { const int sb = vit & 31, hd = (vit >> 5) & 1, vb = (vit >> 6) & 3;
                if ((vit >> 8) == 0) vt_tile(WSP(bf16_t, WS_VS) + ((size_t)vb * SEQ + 64 * sb) * 128 + 64 * hd, 128, WSP(bf16_t, WS_SWVT) + ((size_t)(vb * 2 + hd) * 64) * SEQ + 64 * sb, (LAS bf16_t*)scr, lane);
                else vt_tile(WSP(bf16_t, WS_VD) + ((size_t)vb * SEQ + 64 * sb) * 128 + 64 * hd, 128, WSP(bf16_t, WS_VDT) + ((size_t)vb * 128 + 64 * hd) * SEQ + 64 * sb, (LAS bf16_t*)scr, lane); }
        }
        fetch_chunk(0); put_chunk(0); fetch_chunk(1);
        SCAN5_BAR();
        for (int cidx = 0; cidx < NCH; ++cidx) {
            if (cidx + 1 < NCH) put_chunk(cidx + 1);
            if (cidx + 2 < NCH) fetch_chunk(cidx + 2);
            if (cidx > 0) flush_y(cidx - 1);
            if (!MOE_CONV_IN_PROLOGUE) {
                const int j6 = cidx / 6, m6 = cidx - 6 * j6;
                if (m6 == 0 && 2 * j6 < PER) { ct = moe_tile_desc(C, cfirst + 1024 * (2 * j6)); conv_tile_load(ct.W, ct.ldw, ct.k0, ct.s0, cv, lane); }
                else if (m6 == 4 && 2 * j6 < PER) conv_tile_finish(cv, ct.Bt, ct.K, ct.n0, ct.k0, scr, lane);
                else if (m6 == 3 && 2 * j6 + 1 < PER) { ct2 = moe_tile_desc(C, cfirst + 1024 * (2 * j6 + 1)); conv_tile_load(ct2.W, ct2.ldw, ct2.k0, ct2.s0, cv2, lane); }
                else if (m6 == 1 && j6 >= 1 && 2 * j6 - 1 < PER) conv_tile_finish(cv2, ct2.Bt, ct2.K, ct2.n0, ct2.k0, scr, lane);
            }
            SCAN5_BAR();
        }
#endif
        flush_y(NCH - 1);
    } else {
        const int ro = lane >> 4, kq = lane & 15, rloc = 4 * wave + ro;
        f32x2 Sa = {0.f, 0.f}, Sb = {0.f, 0.f};
        constexpr bool CONVB = SCAN_SCHED == 4 && CONV == 1 && !MOE_CONV_IN_PROLOGUE;
        f32x4 cvB[16];
#pragma unroll
        for (int i = 0; i < 16; ++i) cvB[i] = (f32x4){0.f, 0.f, 0.f, 0.f};
        LAS float* scrp = (LAS float*)(C.lds + 65536 + wave * 16640);
        const int cfirstc = l * (1024 * MOE_SCAN_TILES) + (blockIdx.x * 4 + wave);
        int bj = 0, bnext = 2 + (int)((blockIdx.x * 4u + (unsigned)wave) & 1u);
        SCAN5_BAR();
        for (int cidx = 0; cidx < NCH; ++cidx) {
            if (CONVB && cidx == bnext) {
                if (bj >= 1) conv_tile_to_lds(cvB, scrp, lane);
                if (bj < MOE_SCAN_TILES / 2) { const MoeTile tb = moe_tile_desc(C, cfirstc + 1024 * (2 * bj + 1)); conv_tile_load(tb.W, tb.ldw, tb.k0, tb.s0, cvB, lane); }
                ++bj; bnext += 6;
            }
            const LAS float* cb = buf + (cidx & 1) * CHF + 4 * kq;
            const LAS float* vb = buf + (cidx & 1) * CHF + 320 + 16 * qr + rloc;
            float ykeep = 0.f;
            f32x4 kk4 = *(const LAS f32x4*)(cb + 192), w4 = *(const LAS f32x4*)(cb + 64), b4 = *(const LAS f32x4*)(cb + 256), k4 = *(const LAS f32x4*)(cb + 128), r4 = *(const LAS f32x4*)(cb);
            float vv = vb[0];
#pragma unroll
            for (int st = 0; st < CH; ++st) {
                f32x4 kk4n = kk4, w4n = w4, b4n = b4, k4n = k4, r4n = r4; float vvn = vv;
                if (st + 1 < CH) { const LAS float* nb = cb + (st + 1) * 384;
                    kk4n = *(const LAS f32x4*)(nb + 192); w4n = *(const LAS f32x4*)(nb + 64); b4n = *(const LAS f32x4*)(nb + 256); k4n = *(const LAS f32x4*)(nb + 128); r4n = *(const LAS f32x4*)(nb); vvn = vb[(st + 1) * 384]; }
                const f32x2 tp = Sa * (f32x2){kk4[0], kk4[1]} + Sb * (f32x2){kk4[2], kk4[3]};
                const float p = row16_sum(tp[0] + tp[1]);
                const f32x2 pp = {p, p}, vv2 = {vv, vv};
                Sa = Sa * (f32x2){w4[0], w4[1]} - pp * (f32x2){b4[0], b4[1]} + vv2 * (f32x2){k4[0], k4[1]};
                Sb = Sb * (f32x2){w4[2], w4[3]} - pp * (f32x2){b4[2], b4[3]} + vv2 * (f32x2){k4[2], k4[3]};
                const f32x2 ty = Sa * (f32x2){r4[0], r4[1]} + Sb * (f32x2){r4[2], r4[3]};
                const float y = row16_sum(ty[0] + ty[1]);
                ykeep = (kq == st) ? y : ykeep;
                kk4 = kk4n; w4 = w4n; b4 = b4n; k4 = k4n; r4 = r4n; vv = vvn;
            }
            ybuf[(cidx & 1) * 256 + kq * 16 + rloc] = ykeep;
            SCAN5_BAR();
        }
        if (CONVB) { SCAN5_BAR(); conv_tile_to_lds(cvB, scrp, lane); SCAN5_BAR(); }
    }
#undef SCAN5_BAR
}
struct Args { const void* in[N_INPUTS]; float* out; unsigned char* ws; int ph_lo, ph_hi; };
static_assert(sizeof(Args) == N_INPUTS * 8 + 24, "Args has no padding");

constexpr int N_PHASES = 2 + 12 + 14;

#ifndef USE_FAST
#define USE_FAST 271
#endif
#ifndef PROBE_CONV
#define PROBE_CONV 3
#endif
#ifndef PROBE_MASK
#define PROBE_MASK 0
#endif
#ifndef DBG_SKIP_MASK
#define DBG_SKIP_MASK 0
#endif

__global__ void __launch_bounds__(NTHR, 2) fwd_kernel(Args args) {
    extern __shared__ __attribute__((aligned(16))) unsigned char lds_raw[];
    LAS unsigned char* const lds = (LAS unsigned char*)lds_raw;
    {
        const int tid0 = threadIdx.x;
        volatile LAS unsigned* MISC0 = (volatile LAS unsigned*)(lds + MISC_OFF);
        for (int u = tid0; u < (LDS_BYTES - MISC_OFF) / 4; u += NTHR) MISC0[u] = 0u;
        __syncthreads();
        LAS unsigned long long* tab = (LAS unsigned long long*)(lds + INTAB_OFF);
        if (tid0 < N_INPUTS) tab[tid0] = (unsigned long long)args.in[tid0];
        if (tid0 == 64) { tab[TAB_WS] = (unsigned long long)args.ws; tab[TAB_OUT] = (unsigned long long)args.out;
            tab[TAB_RANGE] = ((unsigned long long)(unsigned)args.ph_hi << 32) | (unsigned)args.ph_lo; }
        __syncthreads();
        if (args.ph_hi - args.ph_lo > 1) (void)xcd_barrier_post((unsigned*)(args.ws + WS_CTL) + CW_BAR, MISC0 + 8);
    }
    LAS unsigned char* ring = lds;
    int ph = 0;
#define PH_BEGIN { const int lo = (int)__builtin_amdgcn_readfirstlane(((const LAS unsigned*)(lds + INTAB_OFF))[2 * TAB_RANGE]), hi = (int)__builtin_amdgcn_readfirstlane(((const LAS unsigned*)(lds + INTAB_OFF))[2 * TAB_RANGE + 1]); \
    if (ph >= lo && ph < hi) { const Ctx C = make_ctx(lds);
#define PH_END if (ph + 1 < hi) { XcdBarrier bar; bar.bar = (unsigned*)WSP(unsigned, WS_CTL) + CW_BAR; bar.x = xb_xcc_id(); bar.st = (volatile LAS unsigned*)(lds + MISC_OFF) + 8; xcd_barrier(bar); } \
    else { VM_WAIT(); __syncthreads(); } } } ++ph;
#define REP(g, ...) { GLB float* XOUT = C.out; (void)XOUT; __VA_ARGS__ } if (PROBE_MASK & (g)) { GLB float* XOUT = WSP(float, WS_SC); (void)XOUT; __VA_ARGS__ }

    PH_BEGIN REP(1,  ph_prologue(C); ph_norm<0, false>(C, INF32(I_X), nullptr, INF32(I_MIXN), nullptr); ) PH_END
    PH_BEGIN REP(256,  { pg8::Gemm g{WSP(bf16_t, WS_PCAT), WSP(bf16_t, WS_WPP), 512, 256}; pg8::ProjOrder S; S.init(C.G, (int)blockIdx.x); pg8::EpiProj E{WSP(bf16_t, WS_PROJ)};
        pg8::gemm_phase<pg8::EpiProj, pg8::ProjOrder>(ring, g, S, E); } ) PH_END

    { constexpr int l = 0;
        if (l > 0) { PH_BEGIN REP(32768,  ph_norm<0>(C, WSP(bf16_t, WS_XB), nullptr, INF32(I_MIXN) + l * D, nullptr); ) PH_END }
        PH_BEGIN REP(4096,  { pg8::Gemm g{WSP(bf16_t, WS_H), WSP(bf16_t, WS_WIN + l * SZ_WIN1), D, D}; pg8::StaticOrder S; S.init(T, N_INP, C.G, (int)blockIdx.x);
            pg8::EpiWin E{WSP(bf16_t, WS_SBQKV), WSP(bf16_t, WS_UF), WSP(bf16_t, WS_GATE)};
            pg8::gemm_phase<pg8::EpiWin, pg8::StaticOrder>(ring, g, S, E); } ) PH_END
        PH_BEGIN REP(16384,  ph_prep(C, l); ph_vt(C); ph_latent(C, l); ) PH_END
        PH_BEGIN REP(256,  { pg8::Gemm g{WSP(bf16_t, WS_ALORA), WSP(bf16_t, WS_WLORA + l * SZ_WLORA1), 256, 256}; pg8::StaticOrder S; S.init(T, 3072, C.G, (int)blockIdx.x);
            pg8::EpiLora E{WSP(float, WS_DEC), WSP(bf16_t, WS_AA), WSP(bf16_t, WS_GG), INF32(I_RWW0) + l * 1024, INF32(I_RWA0) + l * 1024};
            pg8::gemm_phase<pg8::EpiLora, pg8::StaticOrder>(ring, g, S, E); } ) PH_END
        PH_BEGIN REP(32,  if (!(DBG_SKIP_MASK & 2)) { if (USE_FAST & 256) { ph_rwkv_scan5<1>(C, l); if (PROBE_MASK & 2097152) ph_rwkv_scan5<0>(C, l); if ((PROBE_MASK & 4194304) && l == 0) ph_rwkv_scan5<PROBE_CONV>(C, l); } else if (USE_FAST & 128) ph_rwkv_scan4(C, l); else if (USE_FAST & 64) ph_rwkv_scan3(C, l); else if (USE_FAST & 32) ph_rwkv_scan_conv(C, l); else if (USE_FAST & 2) ph_rwkv_scan_fast(C); else ph_rwkv_scan_naive(C); } ) PH_END
        PH_BEGIN REP(8,  ph_sb_fast(C); ) REP(64,  ph_dsa_fast(C); ) REP(128,  ph_swa_fast(C, l); ) REP(65536,  ph_rwkv_post(C, l); ) PH_END
        PH_BEGIN REP(512,  { pg8::Gemm g{WSP(bf16_t, WS_Y), WSP(bf16_t, WS_WBR + l * SZ_WBR1), 4096, 1024}; pg8::BranchOrder S; S.init(C.G, (int)blockIdx.x);
            pg8::EpiBranch E{WSP(bf16_t, WS_GATE), WSP(bf16_t, WS_G)};
            pg8::gemm_phase<pg8::EpiBranch, pg8::BranchOrder>(ring, g, S, E); } ) PH_END
        PH_BEGIN { pg8::Gemm g{WSP(bf16_t, WS_G), WSP(bf16_t, WS_WOUT + l * SZ_DD), D, D}; pg8::StaticOrder S; S.init(T, D, C.G, (int)blockIdx.x);
            if (l == 0) { pg8::EpiResid<false, true> E{INF32(I_X), WSP(bf16_t, WS_XB)}; pg8::gemm_phase<pg8::EpiResid<false, true>, pg8::StaticOrder>(ring, g, S, E); }
            else { pg8::EpiResid<true, true> E{WSP(bf16_t, WS_XB), WSP(bf16_t, WS_XB)}; pg8::gemm_phase<pg8::EpiResid<true, true>, pg8::StaticOrder>(ring, g, S, E); } } PH_END
        PH_BEGIN if (l == 0) ph_norm<0>(C, WSP(bf16_t, WS_XB), nullptr, INF32(I_FFNN) + l * D, nullptr); else ph_norm<1>(C, WSP(bf16_t, WS_XB), nullptr, INF32(I_FFNN) + l * D, INF32(I_MR)); PH_END
        if (l == 0) {
            PH_BEGIN REP(2,  { pg8::Gemm g{WSP(bf16_t, WS_H), WSP(bf16_t, WS_WGU), D, D}; pg8::StaticOrder S; S.init(T, 2 * FF, C.G, (int)blockIdx.x); pg8::EpiUp E{WSP(bf16_t, WS_ACT)};
                pg8::gemm_phase<pg8::EpiUp, pg8::StaticOrder>(ring, g, S, E); } ) PH_END
            PH_BEGIN REP(2048,  { pg8::Gemm g{WSP(bf16_t, WS_ACT), WSP(bf16_t, WS_WD), FF, FF}; pg8::StaticOrder S; S.init(T, D, C.G, (int)blockIdx.x); pg8::EpiResid<true, true> E{WSP(bf16_t, WS_XB), WSP(bf16_t, WS_XB)};
                pg8::gemm_phase<pg8::EpiResid<true, true>, pg8::StaticOrder>(ring, g, S, E); } ) PH_END
            PH_BEGIN REP(32768,  ph_norm<0>(C, WSP(bf16_t, WS_XB), nullptr, INF32(I_PLEN) + l * D, nullptr); ) PH_END
        } else {
            PH_BEGIN REP(131072,  ph_moe_gather(C); ) PH_END
            PH_BEGIN REP(8192,  { moe_tile_table(C); pg8::MoeOrder S; S.tab = (const LAS int*)(C.lds + MOETAB_OFF); S.NT = __builtin_amdgcn_readfirstlane(S.tab[MOE_MAXRT]); S.nct = NCT_UP; S.G = C.G; S.c = (int)blockIdx.x;
                pg8::Gemm g{WSP(bf16_t, WS_HS), WSP(bf16_t, WS_MWGU), D, D}; pg8::EpiUp E{WSP(bf16_t, WS_ACTS)};
                pg8::gemm_phase<pg8::EpiUp, pg8::MoeOrder>(ring, g, S, E); } ) PH_END
            PH_BEGIN REP(2048,  { moe_tile_table(C); const LAS int* mtab = (const LAS int*)(C.lds + MOETAB_OFF);
                pg8::MoeDownOrder S; S.init(mtab, __builtin_amdgcn_readfirstlane(mtab[MOE_MAXRT]), C.G, (int)blockIdx.x);
                pg8::Gemm g{WSP(bf16_t, WS_ACTS), WSP(bf16_t, WS_MWD), FF, FF}; pg8::EpiMoeDown E{WSP(bf16_t, WS_OS), WSP(float, WS_WSLOT), WSP(float, WS_OSP), S.S};
                pg8::gemm_phase<pg8::EpiMoeDown, pg8::MoeDownOrder>(ring, g, S, E); } ) PH_END
            PH_BEGIN REP(16,  { int toff[NE + 1]; moe_offsets(C, toff); pg8::MoeDownOrder S; S.init(nullptr, toff[NE], C.G, 0); ph_norm<2>(C, WSP(bf16_t, WS_XB), WSP(bf16_t, WS_XB), INF32(I_PLEN) + l * D, nullptr, S.S); } ) PH_END
        }
        PH_BEGIN REP(262144,  { pg8::Gemm g{WSP(bf16_t, WS_H), WSP(bf16_t, WS_WPG + l * SZ_DD), D, D}; pg8::StaticOrder S; S.init(T, D, C.G, (int)blockIdx.x);
            if (l == NL - 1) { pg8::EpiPle<false> E{WSP(bf16_t, WS_XB), C.out, WSP(bf16_t, WS_PROJ) + (size_t)l * T * D}; pg8::gemm_phase<pg8::EpiPle<false>, pg8::StaticOrder>(ring, g, S, E); }
            else { pg8::EpiPle<true> E{WSP(bf16_t, WS_XB), WSP(bf16_t, WS_XB), WSP(bf16_t, WS_PROJ) + (size_t)l * T * D}; pg8::gemm_phase<pg8::EpiPle<true>, pg8::StaticOrder>(ring, g, S, E); } } ) PH_END
    }
    { constexpr int l = 1;
        if (l > 0) { PH_BEGIN REP(32768,  ph_norm<0>(C, WSP(bf16_t, WS_XB), nullptr, INF32(I_MIXN) + l * D, nullptr); ) PH_END }
        PH_BEGIN REP(4096,  { pg8::Gemm g{WSP(bf16_t, WS_H), WSP(bf16_t, WS_WIN + l * SZ_WIN1), D, D}; pg8::StaticOrder S; S.init(T, N_INP, C.G, (int)blockIdx.x);
            pg8::EpiWin E{WSP(bf16_t, WS_SBQKV), WSP(bf16_t, WS_UF), WSP(bf16_t, WS_GATE)};
            pg8::gemm_phase<pg8::EpiWin, pg8::StaticOrder>(ring, g, S, E); } ) PH_END
        PH_BEGIN REP(16384,  ph_prep(C, l); ph_vt(C); ph_latent(C, l); ) PH_END
        PH_BEGIN REP(256,  { pg8::Gemm g{WSP(bf16_t, WS_ALORA), WSP(bf16_t, WS_WLORA + l * SZ_WLORA1), 256, 256}; pg8::StaticOrder S; S.init(T, 3072, C.G, (int)blockIdx.x);
            pg8::EpiLora E{WSP(float, WS_DEC), WSP(bf16_t, WS_AA), WSP(bf16_t, WS_GG), INF32(I_RWW0) + l * 1024, INF32(I_RWA0) + l * 1024};
            pg8::gemm_phase<pg8::EpiLora, pg8::StaticOrder>(ring, g, S, E); } ) PH_END
        PH_BEGIN REP(32,  if (!(DBG_SKIP_MASK & 2)) { if (USE_FAST & 256) { ph_rwkv_scan5<1>(C, l); if (PROBE_MASK & 2097152) ph_rwkv_scan5<0>(C, l); if ((PROBE_MASK & 4194304) && l == 0) ph_rwkv_scan5<PROBE_CONV>(C, l); } else if (USE_FAST & 128) ph_rwkv_scan4(C, l); else if (USE_FAST & 64) ph_rwkv_scan3(C, l); else if (USE_FAST & 32) ph_rwkv_scan_conv(C, l); else if (USE_FAST & 2) ph_rwkv_scan_fast(C); else ph_rwkv_scan_naive(C); } ) PH_END
        PH_BEGIN REP(8,  ph_sb_fast(C); ) REP(64,  ph_dsa_fast(C); ) REP(128,  ph_swa_fast(C, l); ) REP(65536,  ph_rwkv_post(C, l); ) PH_END
        PH_BEGIN REP(512,  { pg8::Gemm g{WSP(bf16_t, WS_Y), WSP(bf16_t, WS_WBR + l * SZ_WBR1), 4096, 1024}; pg8::BranchOrder S; S.init(C.G, (int)blockIdx.x);
            pg8::EpiBranch E{WSP(bf16_t, WS_GATE), WSP(bf16_t, WS_G)};
            pg8::gemm_phase<pg8::EpiBranch, pg8::BranchOrder>(ring, g, S, E); } ) PH_END
        PH_BEGIN { pg8::Gemm g{WSP(bf16_t, WS_G), WSP(bf16_t, WS_WOUT + l * SZ_DD), D, D}; pg8::StaticOrder S; S.init(T, D, C.G, (int)blockIdx.x);
            if (l == 0) { pg8::EpiResid<false, true> E{INF32(I_X), WSP(bf16_t, WS_XB)}; pg8::gemm_phase<pg8::EpiResid<false, true>, pg8::StaticOrder>(ring, g, S, E); }
            else { pg8::EpiResid<true, true> E{WSP(bf16_t, WS_XB), WSP(bf16_t, WS_XB)}; pg8::gemm_phase<pg8::EpiResid<true, true>, pg8::StaticOrder>(ring, g, S, E); } } PH_END
        PH_BEGIN if (l == 0) ph_norm<0>(C, WSP(bf16_t, WS_XB), nullptr, INF32(I_FFNN) + l * D, nullptr); else ph_norm<1>(C, WSP(bf16_t, WS_XB), nullptr, INF32(I_FFNN) + l * D, INF32(I_MR)); PH_END
        if (l == 0) {
            PH_BEGIN REP(2,  { pg8::Gemm g{WSP(bf16_t, WS_H), WSP(bf16_t, WS_WGU), D, D}; pg8::StaticOrder S; S.init(T, 2 * FF, C.G, (int)blockIdx.x); pg8::EpiUp E{WSP(bf16_t, WS_ACT)};
                pg8::gemm_phase<pg8::EpiUp, pg8::StaticOrder>(ring, g, S, E); } ) PH_END
            PH_BEGIN REP(2048,  { pg8::Gemm g{WSP(bf16_t, WS_ACT), WSP(bf16_t, WS_WD), FF, FF}; pg8::StaticOrder S; S.init(T, D, C.G, (int)blockIdx.x); pg8::EpiResid<true, true> E{WSP(bf16_t, WS_XB), WSP(bf16_t, WS_XB)};
                pg8::gemm_phase<pg8::EpiResid<true, true>, pg8::StaticOrder>(ring, g, S, E); } ) PH_END
            PH_BEGIN REP(32768,  ph_norm<0>(C, WSP(bf16_t, WS_XB), nullptr, INF32(I_PLEN) + l * D, nullptr); ) PH_END
        } else {
            PH_BEGIN REP(131072,  ph_moe_gather(C); ) PH_END
            PH_BEGIN REP(8192,  { moe_tile_table(C); pg8::MoeOrder S; S.tab = (const LAS int*)(C.lds + MOETAB_OFF); S.NT = __builtin_amdgcn_readfirstlane(S.tab[MOE_MAXRT]); S.nct = NCT_UP; S.G = C.G; S.c = (int)blockIdx.x;
                pg8::Gemm g{WSP(bf16_t, WS_HS), WSP(bf16_t, WS_MWGU), D, D}; pg8::EpiUp E{WSP(bf16_t, WS_ACTS)};
                pg8::gemm_phase<pg8::EpiUp, pg8::MoeOrder>(ring, g, S, E); } ) PH_END
            PH_BEGIN REP(2048,  { moe_tile_table(C); const LAS int* mtab = (const LAS int*)(C.lds + MOETAB_OFF);
                pg8::MoeDownOrder S; S.init(mtab, __builtin_amdgcn_readfirstlane(mtab[MOE_MAXRT]), C.G, (int)blockIdx.x);
                pg8::Gemm g{WSP(bf16_t, WS_ACTS), WSP(bf16_t, WS_MWD), FF, FF}; pg8::EpiMoeDown E{WSP(bf16_t, WS_OS), WSP(float, WS_WSLOT), WSP(float, WS_OSP), S.S};
                pg8::gemm_phase<pg8::EpiMoeDown, pg8::MoeDownOrder>(ring, g, S, E); } ) PH_END
            PH_BEGIN REP(16,  { int toff[NE + 1]; moe_offsets(C, toff); pg8::MoeDownOrder S; S.init(nullptr, toff[NE], C.G, 0); ph_norm<2>(C, WSP(bf16_t, WS_XB), WSP(bf16_t, WS_XB), INF32(I_PLEN) + l * D, nullptr, S.S); } ) PH_END
        }
        PH_BEGIN REP(262144,  { pg8::Gemm g{WSP(bf16_t, WS_H), WSP(bf16_t, WS_WPG + l * SZ_DD), D, D}; pg8::StaticOrder S; S.init(T, D, C.G, (int)blockIdx.x);
            if (l == NL - 1) { pg8::EpiPle<false> E{WSP(bf16_t, WS_XB), C.out, WSP(bf16_t, WS_PROJ) + (size_t)l * T * D}; pg8::gemm_phase<pg8::EpiPle<false>, pg8::StaticOrder>(ring, g, S, E); }
            else { pg8::EpiPle<true> E{WSP(bf16_t, WS_XB), WSP(bf16_t, WS_XB), WSP(bf16_t, WS_PROJ) + (size_t)l * T * D}; pg8::gemm_phase<pg8::EpiPle<true>, pg8::StaticOrder>(ring, g, S, E); } } ) PH_END
    }
#undef PH_BEGIN
#undef PH_END
}

#ifndef MK_ONE_LAUNCH
#define MK_ONE_LAUNCH 0
#endif
extern "C" void kernel_launch(void* const* d_in, const int* in_sizes, int n_in, void* d_out, int out_size, void* d_ws, size_t ws_size, hipStream_t stream) {
    static int grid = 0;
    if (grid == 0) {
        if (n_in != N_INPUTS || out_size != T * D || ws_size < WS_END3) { fprintf(stderr, "kernel_launch: unexpected problem (n_in %d, out %d, ws %zu < %zu)\n", n_in, out_size, ws_size, (size_t)WS_END3); grid = -1; return; }
        int dev = 0, cus = 0, per_cu = 0;
        if (hipGetDevice(&dev) != hipSuccess || hipDeviceGetAttribute(&cus, hipDeviceAttributeMultiprocessorCount, dev) != hipSuccess) { grid = -1; return; }
        if (hipFuncSetAttribute((const void*)fwd_kernel, hipFuncAttributeMaxDynamicSharedMemorySize, LDS_BYTES) != hipSuccess) { fprintf(stderr, "kernel_launch: hipFuncSetAttribute failed\n"); grid = -1; return; }
        if (hipOccupancyMaxActiveBlocksPerMultiprocessor(&per_cu, (const void*)fwd_kernel, NTHR, LDS_BYTES) != hipSuccess || per_cu < 1) fprintf(stderr, "kernel_launch: occupancy query reports %d\n", per_cu);
        (void)hipGetLastError();
        grid = cus;
    }
    if (grid < 0) return;
    (void)hipMemsetAsync((char*)d_ws + WS_CTL, 0, CTL_BYTES, stream);
    Args a{};
    for (int i = 0; i < N_INPUTS; ++i) a.in[i] = d_in[i];
    a.out = (float*)d_out; a.ws = (unsigned char*)d_ws;
#if MK_ONE_LAUNCH
    a.ph_lo = 0; a.ph_hi = N_PHASES;
    hipLaunchKernelGGL(fwd_kernel, dim3(grid), dim3(NTHR), LDS_BYTES, stream, a);
#else
    for (int p = 0; p < N_PHASES; ++p) { a.ph_lo = p; a.ph_hi = p + 1; hipLaunchKernelGGL(fwd_kernel, dim3(grid), dim3(NTHR), LDS_BYTES, stream, a); }
#endif
}
```

```cpp
#define MK_ONE_LAUNCH 1
#include <hip/hip_runtime.h>
#include <cstdio>
#include <cstdint>

#define LAS __attribute__((address_space(3)))
#define GAS __attribute__((address_space(1)))
#define GLB __attribute__((address_space(1)))
typedef unsigned short bf16_t;
typedef short bf16x8 __attribute__((ext_vector_type(8)));
typedef float f32x4 __attribute__((ext_vector_type(4)));
typedef float f32x2 __attribute__((ext_vector_type(2)));
typedef unsigned u32x4 __attribute__((ext_vector_type(4)));
typedef unsigned u32x2 __attribute__((ext_vector_type(2)));

constexpr int NB = 4, SEQ = 2048, T = NB * SEQ, D = 2048, NL = 2;
constexpr int N_IN = 18256, N_INP = 18432, FF = 7168, NE = 8;
constexpr int UFW = 7168;
constexpr int UF_RW = 0, UF_DQ = 3328, UF_CKV = 4352, UF_IQ = 4608, UF_SQ = 5632, UF_SK = 6656, UF_SV = 6784, UF_IK = 6912, UF_IW = 6976;
constexpr int MOE_ROWS = 18432, MOE_MAXRT = 72, NCT_UP = 56, NCT_DN = 8;
constexpr int NWAVES = 8, NTHR = 512;

constexpr size_t WS_CTL = 0, CTL_BYTES = 1u << 20;
constexpr size_t SZ_WIN1 = (size_t)N_INP * D * 2, SZ_WBR1 = (size_t)4 * 2048 * 1024 * 2, SZ_DD = (size_t)D * D * 2;
constexpr size_t SZ_WGU1 = (size_t)2 * FF * D * 2, SZ_WD1 = (size_t)D * FF * 2, SZ_WLORA1 = (size_t)3072 * 256 * 2;
constexpr size_t WS_WIN = CTL_BYTES;
constexpr size_t WS_WBR = WS_WIN + NL * SZ_WIN1;
constexpr size_t WS_WOUT = WS_WBR + NL * SZ_WBR1;
constexpr size_t WS_WGU = WS_WOUT + NL * SZ_DD;
constexpr size_t WS_WD = WS_WGU + SZ_WGU1;
constexpr size_t WS_MWGU = WS_WD + SZ_WD1;
constexpr size_t WS_MWD = WS_MWGU + NE * SZ_WGU1;
constexpr size_t WS_WPG = WS_MWD + NE * SZ_WD1;
constexpr size_t WS_WPP = WS_WPG + NL * SZ_DD;
constexpr size_t WS_WLORA = WS_WPP + (size_t)NL * D * 256 * 2;
constexpr size_t WS_H = WS_WLORA + NL * SZ_WLORA1;
constexpr size_t WS_PCAT = WS_H + (size_t)T * D * 2;
constexpr size_t WS_PROJ = WS_PCAT + (size_t)T * 512 * 2;
constexpr size_t WS_ROUTE = WS_PROJ + (size_t)NL * T * D * 2;
constexpr size_t WS_TOKSLOT = WS_ROUTE + (size_t)T * 32;
constexpr size_t WS_WSLOT = WS_TOKSLOT + (size_t)T * 8;
constexpr size_t WS_ACT0 = WS_WSLOT + (size_t)MOE_ROWS * 4 + 256 * 30;
constexpr size_t SZ_T1K = (size_t)T * 1024 * 4;
constexpr size_t WS_SBQKV = (WS_ACT0 + 255) & ~(size_t)255;
constexpr size_t WS_GATE = WS_SBQKV + (size_t)T * 3072 * 2;
constexpr size_t WS_UF = WS_GATE + (size_t)T * 8192 * 2;
constexpr size_t WS_Y = WS_UF;
constexpr size_t WS_GSUM = WS_Y + (size_t)T * 4096 * 2;
constexpr size_t WS_G = WS_GSUM + (size_t)T * 2048 * 4;
constexpr size_t WS_YRAW = WS_G + (size_t)T * 2048 * 2;
constexpr size_t WS_RW = WS_UF + (size_t)T * UFW * 4;
static_assert(WS_YRAW + SZ_T1K <= WS_RW, "UF aliases");
constexpr size_t WS_R = WS_RW, WS_K = WS_RW + SZ_T1K, WS_V = WS_RW + 2 * SZ_T1K, WS_DEC = WS_RW + 3 * SZ_T1K, WS_AA = WS_RW + 4 * SZ_T1K, WS_KK = WS_RW + 5 * SZ_T1K, WS_GG = WS_RW + 6 * SZ_T1K;
constexpr size_t WS_ALORA = WS_RW + 7 * SZ_T1K;
constexpr size_t WS_QD = WS_ALORA + (size_t)T * 256 * 2;
constexpr size_t WS_KD = WS_QD + (size_t)T * 1024 * 2;
constexpr size_t WS_VD = WS_KD + (size_t)T * 128 * 2;
constexpr size_t WS_QI = WS_VD + (size_t)T * 128 * 2;
constexpr size_t WS_KI = WS_QI + (size_t)T * 1024 * 2;
constexpr size_t WS_WI = WS_KI + (size_t)T * 64 * 2;
constexpr size_t WS_QS = WS_WI + (size_t)T * 16 * 4;
constexpr size_t WS_KS = WS_QS + (size_t)T * 1024 * 2;
constexpr size_t WS_VS = WS_KS + (size_t)T * 128 * 2;
constexpr size_t WS_MIX_END = WS_VS + (size_t)T * 128 * 2;
constexpr size_t WS_ACT = WS_SBQKV;
constexpr size_t WS_HS = WS_SBQKV;
constexpr size_t WS_ACTS = WS_HS + (size_t)MOE_ROWS * D * 2;
constexpr size_t WS_OS = WS_ACTS + (size_t)MOE_ROWS * FF * 2;
constexpr size_t WS_OSP = WS_OS + (size_t)MOE_ROWS * D * 4;
constexpr size_t WS_FFN_END = WS_OSP + (size_t)256 * 65536 * 4;
constexpr size_t WS_END = WS_MIX_END > WS_FFN_END ? WS_MIX_END : WS_FFN_END;
static_assert(WS_END < (size_t)2000 * 1000 * 1000, "workspace budget");

constexpr int CW_BAR = 4096;
constexpr int CW_MOECNT = 8192;

constexpr int RING_BYTES = 131072;
constexpr int MISC_OFF = 143360;
constexpr int LDS_BYTES = 147456;

#define LDS_WAIT() asm volatile("s_waitcnt lgkmcnt(0)" ::: "memory")
#define VM_WAIT() asm volatile("s_waitcnt vmcnt(0)" ::: "memory")
__device__ __forceinline__ float bflo(unsigned u) { return __builtin_bit_cast(float, u << 16); }
__device__ __forceinline__ float bfhi(unsigned u) { return __builtin_bit_cast(float, u & 0xffff0000u); }
__device__ __forceinline__ float bf1(bf16_t u) { return __builtin_bit_cast(float, (unsigned)u << 16); }
__device__ __forceinline__ unsigned f2bf(float f) { unsigned u = __builtin_bit_cast(unsigned, f); return (u + 0x7fffu + ((u >> 16) & 1u)) >> 16; }
typedef __bf16 bf16x2v __attribute__((ext_vector_type(2)));
__device__ __forceinline__ unsigned pk2(float lo, float hi) { const f32x2 v = {lo, hi}; return __builtin_bit_cast(unsigned, __builtin_convertvector(v, bf16x2v)); }
__device__ __forceinline__ float wave_sum(float v) {
#pragma unroll
    for (int o = 1; o < 64; o <<= 1) v += __shfl_xor(v, o);
    return v;
}
__device__ __forceinline__ float wave_max(float v) {
#pragma unroll
    for (int o = 1; o < 64; o <<= 1) v = fmaxf(v, __shfl_xor(v, o));
    return v;
}
__device__ __forceinline__ float sigmoidf_(float x) { return __builtin_amdgcn_rcpf(1.0f + __builtin_amdgcn_exp2f(-1.4426950408889634f * x)); }
__device__ __forceinline__ float logsigf_(float x) { return fminf(x, 0.f) - __logf(1.0f + __expf(-fabsf(x))); }
__device__ __forceinline__ float rdlane(float v, int l) { return __builtin_bit_cast(float, __builtin_amdgcn_readlane(__builtin_bit_cast(int, v), l)); }

#define XB_TMO      128
#define XB_XCNT(j)  (256  + 64 * (j))
#define XB_XSUB(j)  (1280 + 64 * (j))
#define XB_XGEN(j)  (2304 + 64 * (j))
#define XB_TOP      3328
#define XB_TOPGEN   3392
#define XCD_BAR_WORDS 3456
#define XB_SPIN_CAP (1u << 18)
__device__ __forceinline__ unsigned xb_ld(unsigned* p)              { return __hip_atomic_load(p, __ATOMIC_RELAXED, __HIP_MEMORY_SCOPE_AGENT); }
__device__ __forceinline__ unsigned xb_add(unsigned* p, unsigned v) { return __hip_atomic_fetch_add(p, v, __ATOMIC_RELAXED, __HIP_MEMORY_SCOPE_AGENT); }
__device__ __forceinline__ unsigned xb_xcc_id() { return (unsigned)__builtin_amdgcn_s_getreg((3 << 11) | 20) & 0xFu; }
#define XB_SPIN(cond, bar) do { unsigned _sp = 0; while (cond) { __builtin_amdgcn_s_sleep(1); \
    if ((++_sp & 255u) == 0u) { if (xb_ld(&(bar)[XB_TMO])) break; if (_sp > XB_SPIN_CAP) { atomicAdd(&(bar)[XB_TMO], 1u); break; } } } } while (0)
struct XcdBarrier { unsigned* bar; unsigned x; volatile LAS unsigned* st; };
__device__ __forceinline__ XcdBarrier xcd_barrier_post(unsigned* bar, volatile LAS unsigned* st) {
    XcdBarrier b; b.bar = bar; b.x = xb_xcc_id(); b.st = st;
    if (threadIdx.x == 0) (void)xb_add(&bar[XB_XCNT(b.x)], 1u);
    return b;
}
__device__ __forceinline__ void xcd_barrier_complete(unsigned* bar, unsigned x, unsigned& nloc, unsigned& nx) {
    const unsigned G = gridDim.x * gridDim.y * gridDim.z;
    unsigned sum, cnt, mine, sp = 0u;
    for (;;) {
        sum = 0u; cnt = 0u; mine = 0u;
#pragma unroll
        for (unsigned j = 0; j < 16; ++j) { const unsigned c = xb_ld(&bar[XB_XCNT(j)]); sum += c; cnt += (c > 0u) ? 1u : 0u; mine = (j == x) ? c : mine; }
        if (sum == G) break;
        __builtin_amdgcn_s_sleep(1);
        if ((++sp & 255u) == 0u) { if (xb_ld(&bar[XB_TMO])) break; if (sp > XB_SPIN_CAP) { atomicAdd(&bar[XB_TMO], 1u); break; } }
    }
    nloc = mine > 0u ? mine : 1u; nx = cnt > 0u ? cnt : 1u;
}
__device__ __forceinline__ void xcd_barrier(const XcdBarrier& b) {
    asm volatile("s_waitcnt vmcnt(0)" ::: "memory");
    __syncthreads();
    if (threadIdx.x == 0) {
        unsigned* bar = b.bar;
        __builtin_amdgcn_s_waitcnt(0);
        unsigned nloc = b.st[0], nx = b.st[1];
        if (nloc == 0u) { xcd_barrier_complete(bar, b.x, nloc, nx); b.st[0] = nloc; b.st[1] = nx; }
        const unsigned old = xb_add(&bar[XB_XSUB(b.x)], 1u);
        const unsigned gen = old / nloc;
        if (old + 1u == (gen + 1u) * nloc) {
            __builtin_amdgcn_fence(__ATOMIC_RELEASE, "agent");
            asm volatile("s_waitcnt vmcnt(0)" ::: "memory");
            const unsigned og = xb_add(&bar[XB_TOP], 1u);
            const unsigned tg = og / nx;
            if (og + 1u == (tg + 1u) * nx) xb_add(&bar[XB_TOPGEN], 1u);
            else XB_SPIN(xb_ld(&bar[XB_TOPGEN]) == tg, bar);
            __builtin_amdgcn_fence(__ATOMIC_ACQUIRE, "agent");
            xb_add(&bar[XB_XGEN(b.x)], 1u);
            asm volatile("s_waitcnt vmcnt(0)" ::: "memory");
        } else {
            XB_SPIN(xb_ld(&bar[XB_XGEN(b.x)]) == gen, bar);
            __builtin_amdgcn_fence(__ATOMIC_ACQUIRE, "agent");
            asm volatile("s_waitcnt vmcnt(0)" ::: "memory");
        }
    }
    __syncthreads();
}
namespace pg8 {
#define PG8_LAS __attribute__((address_space(3)))
#ifndef PG8_WGM
#define PG8_WGM 4
#endif
constexpr int BM = 256, BK = 64, HALF = 128, HTB = HALF * BK * 2, STAGE_BYTES = 8 * HTB, NXCD = 8, WGM = PG8_WGM;
__host__ __device__ __forceinline__ int lds_byte(int r, int c) { const int st = (r >> 4) * 2 + (c >> 5), rr = r & 15, cc = c & 31, ob = rr * 64 + cc * 2; return st * 1024 + (ob ^ (((ob >> 9) & 1) << 5)); }
__host__ __device__ __forceinline__ void stage_rc(int b, int& R, int& C) { const int st = b / 1024, sb = b % 1024, swz = sb ^ (((sb >> 9) & 1) << 5); R = (st >> 1) * 16 + swz / 64; C = (st & 1) * 32 + (swz % 64) / 2; }
__host__ __device__ __forceinline__ int perm32(int rho) { const int n = rho >> 4, i = rho & 15; return 8 * (i >> 2) + 4 * n + (i & 3); }

struct Unit { int pm, pn, ka, kb, nt, aux; };
struct Gemm { const GLB bf16_t* A; const GLB bf16_t* Bt; int lda, K; };

struct StaticOrder {
    int nM, nN, nwg, G, c;
    __device__ __forceinline__ void init(int M, int N, int G_, int c_) { nM = M / BM; nN = N / BM; nwg = nM * nN; G = G_; c = c_; }
    __device__ __forceinline__ bool tile(long L, Unit& u) const {
        if (L >= nwg) return false;
        int wgid = (int)L; { const int q = nwg / NXCD, r = nwg % NXCD, xcd = wgid % NXCD, off = wgid / NXCD; wgid = (xcd < r ? xcd * (q + 1) : r * (q + 1) + (xcd - r) * q) + off; }
        const int nig = WGM * nN, gid = wgid / nig, fm = gid * WGM, gsz = (nM - fm) < WGM ? (nM - fm) : WGM;
        u.pm = fm + ((wgid % nig) % gsz); u.pn = (wgid % nig) / gsz; u.ka = 0; u.kb = 0; u.nt = 0; u.aux = 0; return true;
    }
    __device__ __forceinline__ bool next(int i, Unit& u) const { return tile((long)i * G + c, u); }
};
struct BranchOrder {
    int G, c, cnt;
    __device__ __forceinline__ void init(int G_, int c_) { G = G_; c = c_; cnt = (c_ < 256) ? (255 - c_) / G_ + 1 : 0; }
    __device__ __forceinline__ bool next(int i, Unit& u) const {
        if (cnt == 0) return false;
        const int n = i / cnt, r = i - n * cnt; if (n >= 4) return false;
        StaticOrder so; so.init(T, 2048, G, c); so.tile((long)r * G + c, u);
        u.pn += n * 8; u.ka = n * 1024; return true;
    }
};
struct ProjOrder {
    StaticOrder so;
    __device__ __forceinline__ void init(int G_, int c_) { so.init(T, 4096, G_, c_); }
    __device__ __forceinline__ bool next(int i, Unit& u) const { if (!so.next(i, u)) return false; u.ka = (u.pn >> 3) * 256; return true; }
};
struct MoeOrder {
    const PG8_LAS int* tab; int NT, nct, G, c;
    __device__ __forceinline__ bool next(int i, Unit& u) const {
        StaticOrder so; so.nM = NT; so.nN = nct; so.nwg = NT * nct; so.G = G; so.c = c;
        if (!so.tile((long)i * G + c, u)) return false;
        const int e = __builtin_amdgcn_readfirstlane(tab[u.pm]);
        u.pn += e * nct; u.ka = 0; return true;
    }
};

struct MoeDownOrder {
    const PG8_LAS int* tab; int NT, G, c, S;
    __device__ __forceinline__ void init(const PG8_LAS int* tab_, int NT_, int G_, int c_) { tab = tab_; NT = NT_; G = G_; c = c_;
        const int tu = (NT_ - 64) * 8; S = (tu <= 0) ? 1 : ((tu * 8 <= G_) ? 8 : ((tu * 4 <= G_) ? 4 : ((tu * 2 <= G_) ? 2 : 1))); }
    __device__ __forceinline__ bool next(int i, Unit& u) const {
        const int F = (NT < 64) ? NT : 64, nfull = F * 8, rf = (nfull + G - 1) / G;
        if (i < rf) {
            StaticOrder so; so.nM = F; so.nN = 8; so.nwg = nfull; so.G = G; so.c = c;
            if (so.tile((long)i * G + c, u)) { const int e = __builtin_amdgcn_readfirstlane(tab[u.pm]); u.pn += e * 8; return true; }
            i = rf;
        }
        const int q = (i - rf) * G + c, ntail = (NT - F) * 8 * S;
        if (q >= ntail) return false;
        const int tu = q / S, sl = q - tu * S, rt = F + (tu >> 3), pl = tu & 7;
        const int e = __builtin_amdgcn_readfirstlane(tab[rt]);
        u.pm = rt; u.pn = e * 8 + pl; u.ka = sl * (FF / S); u.kb = u.ka; u.nt = (FF / 64) / S; u.aux = 1 + sl; return true;
    }
};

template <class Epi, class Sched>
__device__ __forceinline__ void gemm_phase(PG8_LAS unsigned char* lds, const Gemm g, const Sched& S, const Epi& E) {
    int tid = threadIdx.x; asm volatile("" : "+v"(tid));
    const int wid = __builtin_amdgcn_readfirstlane(tid >> 6), lane = tid & 63, wr = wid >> 2, wc = wid & 3, fr = lane & 15, fq = lane >> 4;
    int K = g.K, lda = g.lda; asm volatile("" : "+s"(K), "+s"(lda));
    const int nt = K / BK;
    unsigned voffA[2], voffB[2];
#pragma unroll
    for (int i = 0; i < 2; ++i) { int R, C; stage_rc(tid * 16 + i * 8192, R, C); const int Rb = Epi::PERM ? ((R & ~31) + perm32(R & 31)) : R;
        voffA[i] = (unsigned)(R * lda + C) * 2u; voffB[i] = (unsigned)(Rb * K + C) * 2u; }
    const size_t kstep = (size_t)(BK * 2);
    const size_t hstepA = (size_t)HALF * lda * 2, hstepB = (size_t)HALF * K * 2;
    const size_t tstepA = 2 * hstepA, tstepB = 2 * hstepB;
    const unsigned ldsw = (unsigned)wid * 1024u;
    const int aoff = lds_byte(wr * 64 + fr, fq * 8), boff = lds_byte(wc * 32 + fr, fq * 8);
#define PG8_SA(b, h) (((b) * 2 + (h)) * HTB)
#define PG8_SB(b, h) ((4 + (b) * 2 + (h)) * HTB)
#define PG8_STAGE(bufoff, gbase, voff) do { _Pragma("unroll") for (int _i = 0; _i < 2; ++_i) \
        __builtin_amdgcn_global_load_lds((const GLB unsigned*)((const char*)(gbase) + (voff)[_i]), (PG8_LAS unsigned*)(lds + (bufoff) + ldsw + _i * 8192), 16, 0, 0); } while (0)
#define PG8_LDA(dst, b, h) do { _Pragma("unroll") for (int m = 0; m < 4; ++m) _Pragma("unroll") for (int k = 0; k < 2; ++k) dst[m][k] = *(const PG8_LAS bf16x8*)(lds + PG8_SA(b, h) + aoff + m * 2048 + k * 1024); } while (0)
#define PG8_LDB(dst, b, h) do { _Pragma("unroll") for (int n = 0; n < 2; ++n) _Pragma("unroll") for (int k = 0; k < 2; ++k) dst[n][k] = *(const PG8_LAS bf16x8*)(lds + PG8_SB(b, h) + boff + n * 2048 + k * 1024); } while (0)
#define PG8_MMA(ai, bj, At, Bt) do { __builtin_amdgcn_s_setprio(1); _Pragma("unroll") for (int m = 0; m < 4; ++m) _Pragma("unroll") for (int n = 0; n < 2; ++n) _Pragma("unroll") for (int k = 0; k < 2; ++k) \
        acc[ai][bj][m][n] = __builtin_amdgcn_mfma_f32_16x16x32_bf16(Bt[n][k], At[m][k], acc[ai][bj][m][n], 0, 0, 0); __builtin_amdgcn_s_setprio(0); } while (0)
#define PG8_WAIT_V(n) asm volatile("s_waitcnt vmcnt(" #n ")" ::: "memory")
#define PG8_WAIT_L(n) asm volatile("s_waitcnt lgkmcnt(" #n ")" ::: "memory")
#define PG8_BAR __builtin_amdgcn_s_barrier()
#define PG8_SCHED __builtin_amdgcn_sched_barrier(0)
    Unit cur, nxt; int ui = 0;
    if (!S.next(0, cur)) return;
    f32x4 acc[2][2][4][2];
#pragma unroll
    for (int a = 0; a < 2; ++a)
#pragma unroll
        for (int b = 0; b < 2; ++b)
#pragma unroll
            for (int m = 0; m < 4; ++m)
#pragma unroll
                for (int n = 0; n < 2; ++n) acc[a][b][m][n] = (f32x4){0.f, 0.f, 0.f, 0.f};
    bf16x8 At[4][2], B0[2][2], B1[2][2];
    const char* cA = (const char*)g.A + (size_t)cur.pm * tstepA + (size_t)cur.ka * 2; const char* cB = (const char*)g.Bt + (size_t)cur.pn * tstepB + (size_t)cur.kb * 2;
    PG8_STAGE(PG8_SB(0, 0), cB, voffB); PG8_STAGE(PG8_SB(0, 1), cB + hstepB, voffB); PG8_STAGE(PG8_SA(0, 0), cA, voffA); PG8_STAGE(PG8_SA(0, 1), cA + hstepA, voffA);
    if (wr == 1) PG8_BAR;
    PG8_WAIT_V(2); PG8_BAR;
    PG8_STAGE(PG8_SB(1, 0), cB + kstep, voffB); PG8_STAGE(PG8_SA(1, 0), cA + kstep, voffA); PG8_STAGE(PG8_SB(1, 1), cB + hstepB + kstep, voffB);
    PG8_WAIT_V(6); PG8_BAR;
    for (;;) {
        const bool has_next = S.next(ui + 1, nxt);
        const char* nA = has_next ? (const char*)g.A + (size_t)nxt.pm * tstepA + (size_t)nxt.ka * 2 : cA; const char* nB = has_next ? (const char*)g.Bt + (size_t)nxt.pn * tstepB + (size_t)nxt.kb * 2 : cB;
        const int ntu = cur.nt ? cur.nt : nt;
        for (int t = 0; t < ntu; t += 2) {
            const bool last = (t == ntu - 2);
            const char* a1 = cA + (size_t)(t + 1) * kstep;
            const char* a2 = last ? nA : cA + (size_t)(t + 2) * kstep; const char* b2 = last ? nB : cB + (size_t)(t + 2) * kstep;
            const char* a3 = a2 + kstep; const char* b3 = b2 + kstep;
            PG8_LDB(B0, 0, 0); PG8_LDB(B1, 0, 1); PG8_SCHED; PG8_LDA(At, 0, 0); PG8_STAGE(PG8_SA(1, 1), a1 + hstepA, voffA);
            PG8_WAIT_V(8); PG8_WAIT_L(0); PG8_BAR; PG8_MMA(0, 0, At, B0); PG8_MMA(0, 1, At, B1); PG8_BAR; PG8_SCHED;
            PG8_LDA(At, 0, 1); PG8_STAGE(PG8_SB(0, 0), b2, voffB); PG8_STAGE(PG8_SB(0, 1), b2 + hstepB, voffB); PG8_STAGE(PG8_SA(0, 0), a2, voffA);
            PG8_WAIT_V(8); PG8_WAIT_L(0); PG8_BAR; PG8_MMA(1, 0, At, B0); PG8_MMA(1, 1, At, B1); PG8_BAR; PG8_SCHED;
            PG8_LDB(B0, 1, 0); PG8_LDB(B1, 1, 1); PG8_SCHED; PG8_LDA(At, 1, 0); PG8_STAGE(PG8_SA(0, 1), a2 + hstepA, voffA);
            PG8_WAIT_V(8); PG8_WAIT_L(0); PG8_BAR; PG8_MMA(0, 0, At, B0); PG8_MMA(0, 1, At, B1); PG8_BAR; PG8_SCHED;
            PG8_LDA(At, 1, 1); PG8_STAGE(PG8_SB(1, 0), b3, voffB); PG8_STAGE(PG8_SB(1, 1), b3 + hstepB, voffB); PG8_STAGE(PG8_SA(1, 0), a3, voffA);
            PG8_WAIT_V(8); PG8_WAIT_L(0); PG8_BAR; PG8_MMA(1, 0, At, B0); PG8_MMA(1, 1, At, B1); PG8_BAR; PG8_SCHED;
        }
        if (wr == 0) PG8_BAR;
        E(acc, cur, wr, wc, fr, fq);
        if (!has_next) break;
#pragma unroll
        for (int a = 0; a < 2; ++a)
#pragma unroll
            for (int b = 0; b < 2; ++b)
#pragma unroll
                for (int m = 0; m < 4; ++m)
#pragma unroll
                    for (int n = 0; n < 2; ++n) acc[a][b][m][n] = (f32x4){0.f, 0.f, 0.f, 0.f};
        cur = nxt; cA = nA; cB = nB; ++ui;
        if (wr == 1) PG8_BAR;
    }
    PG8_WAIT_V(0);
    PG8_BAR;
#undef PG8_SA
#undef PG8_SB
#undef PG8_STAGE
#undef PG8_LDA
#undef PG8_LDB
#undef PG8_MMA
#undef PG8_WAIT_V
#undef PG8_WAIT_L
#undef PG8_BAR
#undef PG8_SCHED
}

#define EPI_ROWS(u) const int row0 = (u).pm * BM + wr * 64 + fr; const int ct0 = wc * 32 + 8 * fq
#define EPI_FOR_ROWS _Pragma("unroll") for (int ai = 0; ai < 2; ++ai) _Pragma("unroll") for (int m = 0; m < 4; ++m)
__device__ __forceinline__ u32x4 pack8(f32x4 v0, f32x4 v1) { u32x4 w; w.x = pk2(v0[0], v0[1]); w.y = pk2(v0[2], v0[3]); w.z = pk2(v1[0], v1[1]); w.w = pk2(v1[2], v1[3]); return w; }
__device__ __forceinline__ void unpack8(u32x4 w, f32x4& v0, f32x4& v1) { v0 = (f32x4){bflo(w.x), bfhi(w.x), bflo(w.y), bfhi(w.y)}; v1 = (f32x4){bflo(w.z), bfhi(w.z), bflo(w.w), bfhi(w.w)}; }
__device__ __forceinline__ f32x4 sig4(f32x4 v) { return (f32x4){sigmoidf_(v[0]), sigmoidf_(v[1]), sigmoidf_(v[2]), sigmoidf_(v[3])}; }

struct EpiWin { static constexpr bool PERM = true;
    GLB bf16_t* sbqkv; GLB bf16_t* uf; GLB bf16_t* gate;
    __device__ __forceinline__ void operator()(const f32x4 (&acc)[2][2][4][2], const Unit& u, int wr, int wc, int fr, int fq) const {
        EPI_ROWS(u); const int pn = u.pn;
        if (pn < 40) {
            GLB bf16_t* base = (pn < 12) ? sbqkv + pn * 256 : uf + (pn - 12) * 256; const int ld = (pn < 12) ? 3072 : UFW;
            EPI_FOR_ROWS { GLB bf16_t* rp = base + (size_t)(row0 + ai * HALF + m * 16) * ld + ct0;
#pragma unroll
                for (int bj = 0; bj < 2; ++bj) *(GLB u32x4*)(rp + bj * HALF) = pack8(acc[ai][bj][m][0], acc[ai][bj][m][1]); }
        } else {
            EPI_FOR_ROWS { GLB bf16_t* rp = gate + (size_t)(row0 + ai * HALF + m * 16) * 8192 + (pn - 40) * 256 + ct0;
#pragma unroll
                for (int bj = 0; bj < 2; ++bj) *(GLB u32x4*)(rp + bj * HALF) = pack8(sig4(acc[ai][bj][m][0]), sig4(acc[ai][bj][m][1])); }
        }
    }
};
struct EpiNull { static constexpr bool PERM = true;
    __device__ __forceinline__ void operator()(const f32x4 (&acc)[2][2][4][2], const Unit& u, int wr, int wc, int fr, int fq) const {
#pragma unroll
        for (int ai = 0; ai < 2; ++ai)
#pragma unroll
            for (int bj = 0; bj < 2; ++bj) asm volatile("" :: "v"(acc[ai][bj][0][0]), "v"(acc[ai][bj][0][1]), "v"(acc[ai][bj][1][0]), "v"(acc[ai][bj][1][1]), "v"(acc[ai][bj][2][0]), "v"(acc[ai][bj][2][1]), "v"(acc[ai][bj][3][0]), "v"(acc[ai][bj][3][1]));
    }
};
struct EpiLora { static constexpr bool PERM = true;
    GLB float* dec; GLB bf16_t* aa; GLB bf16_t* gg; const GLB float* w0; const GLB float* a0;
    __device__ __forceinline__ void operator()(const f32x4 (&acc)[2][2][4][2], const Unit& u, int wr, int wc, int fr, int fq) const {
        EPI_ROWS(u); const int kind = u.pn >> 2, cb = (u.pn & 3) * 256 + ct0;
        EPI_FOR_ROWS { const size_t ro = (size_t)(row0 + ai * HALF + m * 16) * 1024 + cb;
#pragma unroll
            for (int bj = 0; bj < 2; ++bj) { const int co = bj * HALF;
                if (kind == 0) {
#pragma unroll
                    for (int n = 0; n < 2; ++n) { const f32x4 v = acc[ai][bj][m][n]; const f32x4 b = *(const GLB f32x4*)(w0 + cb + co + 4 * n); f32x4 o;
#pragma unroll
                        for (int j = 0; j < 4; ++j) { const float pre = v[j] + b[j]; const float y = -pre; const float sp = fmaxf(y, 0.f) + __logf(1.0f + __expf(-fabsf(y)));
                            o[j] = __expf(-__expf(-sp - 0.5f)); }
                        *(GLB f32x4*)(dec + ro + co + 4 * n) = o; }
                } else if (kind == 1) { const f32x4 b0 = *(const GLB f32x4*)(a0 + cb + co), b1 = *(const GLB f32x4*)(a0 + cb + co + 4);
                    *(GLB u32x4*)(aa + ro + co) = pack8(sig4(acc[ai][bj][m][0] + b0), sig4(acc[ai][bj][m][1] + b1)); }
                else *(GLB u32x4*)(gg + ro + co) = pack8(acc[ai][bj][m][0], acc[ai][bj][m][1]); } }
    }
};
struct EpiBranch { static constexpr bool PERM = true;
    const GLB bf16_t* gate; GLB bf16_t* gout;
    __device__ __forceinline__ void operator()(const f32x4 (&acc)[2][2][4][2], const Unit& u, int wr, int wc, int fr, int fq) const {
        EPI_ROWS(u); const int n = u.pn >> 3, cb = (u.pn & 7) * 256 + ct0;
        EPI_FOR_ROWS { const size_t r = (size_t)(row0 + ai * HALF + m * 16);
#pragma unroll
            for (int bj = 0; bj < 2; ++bj) { const int c = cb + bj * HALF; f32x4 g0, g1; unpack8(*(const GLB u32x4*)(gate + r * 8192 + n * 2048 + c), g0, g1);
                f32x4 s0 = g0 * acc[ai][bj][m][0], s1 = g1 * acc[ai][bj][m][1];
                GLB u32x4* gp = (GLB u32x4*)(gout + r * 2048 + c);
                if (n > 0) { f32x4 p0, p1; unpack8(*gp, p0, p1); s0 += p0; s1 += p1; }
                *gp = pack8(s0, s1); } }
    }
};
template <bool RB, bool OB>
struct EpiResid { static constexpr bool PERM = true;
    const GLB void* resid; GLB void* out;
    __device__ __forceinline__ void operator()(const f32x4 (&acc)[2][2][4][2], const Unit& u, int wr, int wc, int fr, int fq) const {
        EPI_ROWS(u); const int cb = u.pn * 256 + ct0;
        EPI_FOR_ROWS { const size_t ro = (size_t)(row0 + ai * HALF + m * 16) * D + cb;
#pragma unroll
            for (int bj = 0; bj < 2; ++bj) { f32x4 r0, r1;
                if (RB) unpack8(*(const GLB u32x4*)((const GLB bf16_t*)resid + ro + bj * HALF), r0, r1);
                else { r0 = *(const GLB f32x4*)((const GLB float*)resid + ro + bj * HALF); r1 = *(const GLB f32x4*)((const GLB float*)resid + ro + bj * HALF + 4); }
                r0 = r0 + acc[ai][bj][m][0]; r1 = r1 + acc[ai][bj][m][1];
                if (OB) *(GLB u32x4*)((GLB bf16_t*)out + ro + bj * HALF) = pack8(r0, r1);
                else { *(GLB f32x4*)((GLB float*)out + ro + bj * HALF) = r0; *(GLB f32x4*)((GLB float*)out + ro + bj * HALF + 4) = r1; } } }
    }
};
struct EpiUp { static constexpr bool PERM = true;
    GLB bf16_t* act;
    __device__ __forceinline__ void operator()(const f32x4 (&acc)[2][2][4][2], const Unit& u, int wr, int wc, int fr, int fq) const {
        EPI_ROWS(u); const int cb = (u.pn % NCT_UP) * 128 + ct0;
        EPI_FOR_ROWS { f32x4 o[2];
#pragma unroll
            for (int n = 0; n < 2; ++n) { const f32x4 g = acc[ai][0][m][n], up = acc[ai][1][m][n];
#pragma unroll
                for (int j = 0; j < 4; ++j) o[n][j] = g[j] * sigmoidf_(g[j]) * up[j]; }
            *(GLB u32x4*)(act + (size_t)(row0 + ai * HALF + m * 16) * FF + cb) = pack8(o[0], o[1]); }
    }
};
struct EpiMoeDown { static constexpr bool PERM = true;
    GLB bf16_t* os; const GLB float* wslot; GLB float* osp; int S;
    __device__ __forceinline__ void operator()(const f32x4 (&acc)[2][2][4][2], const Unit& u, int wr, int wc, int fr, int fq) const {
        EPI_ROWS(u); const int pl = u.pn % NCT_DN;
        if (u.aux == 0) {
            const int cb = pl * 256 + ct0;
            EPI_FOR_ROWS { const int r = row0 + ai * HALF + m * 16; const float w = wslot[r]; GLB bf16_t* rp = os + (size_t)r * D + cb;
#pragma unroll
                for (int bj = 0; bj < 2; ++bj) *(GLB u32x4*)(rp + bj * HALF) = pack8(acc[ai][bj][m][0] * w, acc[ai][bj][m][1] * w); }
        } else {
            GLB float* tp = osp + ((size_t)(((u.pm - 64) * 8 + pl) * S + (u.aux - 1)) << 16);
            EPI_FOR_ROWS { const int rl = wr * 64 + fr + ai * HALF + m * 16; const float w = wslot[u.pm * BM + rl]; GLB float* rp = tp + rl * 256 + ct0;
#pragma unroll
                for (int bj = 0; bj < 2; ++bj) { *(GLB f32x4*)(rp + bj * HALF) = acc[ai][bj][m][0] * w; *(GLB f32x4*)(rp + bj * HALF + 4) = acc[ai][bj][m][1] * w; } }
        }
    }
};
template <bool OB>
struct EpiPle { static constexpr bool PERM = true;
    const GLB bf16_t* resid; GLB void* out; const GLB bf16_t* proj;
    __device__ __forceinline__ void operator()(const f32x4 (&acc)[2][2][4][2], const Unit& u, int wr, int wc, int fr, int fq) const {
        EPI_ROWS(u); const int cb = u.pn * 256 + ct0;
        EPI_FOR_ROWS { const size_t ro = (size_t)(row0 + ai * HALF + m * 16) * D + cb;
#pragma unroll
            for (int bj = 0; bj < 2; ++bj) { f32x4 p0, p1, r0, r1; unpack8(*(const GLB u32x4*)(proj + ro + bj * HALF), p0, p1); unpack8(*(const GLB u32x4*)(resid + ro + bj * HALF), r0, r1);
                r0 = r0 + sig4(acc[ai][bj][m][0]) * p0; r1 = r1 + sig4(acc[ai][bj][m][1]) * p1;
                if (OB) *(GLB u32x4*)((GLB bf16_t*)out + ro + bj * HALF) = pack8(r0, r1);
                else { *(GLB f32x4*)((GLB float*)out + ro + bj * HALF) = r0; *(GLB f32x4*)((GLB float*)out + ro + bj * HALF + 4) = r1; } } }
    }
};
struct EpiProj { static constexpr bool PERM = true;
    GLB bf16_t* proj;
    __device__ __forceinline__ void operator()(const f32x4 (&acc)[2][2][4][2], const Unit& u, int wr, int wc, int fr, int fq) const {
        EPI_ROWS(u); GLB bf16_t* base = proj + (size_t)(u.pn >> 3) * T * D + (u.pn & 7) * 256 + ct0;
        EPI_FOR_ROWS { GLB bf16_t* rp = base + (size_t)(row0 + ai * HALF + m * 16) * D;
#pragma unroll
            for (int bj = 0; bj < 2; ++bj) *(GLB u32x4*)(rp + bj * HALF) = pack8(acc[ai][bj][m][0], acc[ai][bj][m][1]); }
    }
};
}
struct Ctx {
    LAS unsigned char* lds;
    GLB unsigned char* ws;
    GLB float* out;
    int tid, lane, wave, gw, NGW, G;
};
#define WSP(type, off) ((GLB type*)(C.ws + (off)))
constexpr int INTAB_OFF = MISC_OFF + 1024;
constexpr int TAB_WS = 37, TAB_OUT = 38, TAB_RANGE = 39;
__device__ __forceinline__ const GLB void* inptr(LAS unsigned char* lds, int i) {
    const LAS unsigned* t = (const LAS unsigned*)(lds + INTAB_OFF) + 2 * i;
    const unsigned lo = __builtin_amdgcn_readfirstlane(t[0]), hi = __builtin_amdgcn_readfirstlane(t[1]);
    return (const GLB void*)(((unsigned long long)hi << 32) | lo);
}
#define INF32(i) ((const GLB float*)inptr(C.lds, (i)))
__device__ __forceinline__ Ctx make_ctx(LAS unsigned char* lds) {
    Ctx C; C.lds = lds;
    int tid = threadIdx.x; asm volatile("" : "+v"(tid));
    C.tid = tid; C.lane = tid & 63; C.wave = __builtin_amdgcn_readfirstlane(tid >> 6);
    C.G = gridDim.x; C.gw = blockIdx.x * NWAVES + C.wave; C.NGW = C.G * NWAVES;
    C.ws = (GLB unsigned char*)inptr(lds, TAB_WS); C.out = (GLB float*)inptr(lds, TAB_OUT);
    return C;
}
enum { I_X = 0, I_P, I_POS, I_WIN, I_MIXN, I_FFNN, I_PLEN, I_RWMU, I_RWW0, I_RWW2, I_RWA0, I_RWA2, I_RWG2, I_RWKK, I_RWKA, I_RWRK, I_RWLNG, I_RWLNB,
       I_DQN, I_DKN, I_DKVN, I_DWUK, I_DWUV, I_SQN, I_SKN, I_SSINK, I_WBR, I_WOUT, I_FG, I_FU, I_FD, I_MR, I_MG, I_MU, I_MD, I_PG, I_PP, N_INPUTS };

__device__ __forceinline__ void conv_tile(const GLB float* W, int ldw, int k0, int s0, int nv, GLB bf16_t* Bt, int K, int n0, LAS float* scr, int lane) {
    const int cq = lane & 15, rq = lane >> 4;
    f32x4 v[16];
#pragma unroll
    for (int i = 0; i < 16; ++i) {
        const int kk = 4 * i + rq;
        v[i] = (4 * cq < nv) ? *(const GLB f32x4*)(W + (size_t)(k0 + kk) * ldw + s0 + 4 * cq) : (f32x4){0.f, 0.f, 0.f, 0.f};
    }
#pragma unroll
    for (int i = 0; i < 16; ++i) { const int kk = 4 * i + rq; LAS float* d = scr + kk * 65 + 4 * cq; d[0] = v[i][0]; d[1] = v[i][1]; d[2] = v[i][2]; d[3] = v[i][3]; }
    LDS_WAIT();
    const int c = lane & 7;
#pragma unroll
    for (int j = 0; j < 8; ++j) { const int n = (lane >> 3) + 8 * j; const LAS float* s = scr + (8 * c) * 65 + n;
        u32x4 o; o.x = pk2(s[0 * 65], s[1 * 65]); o.y = pk2(s[2 * 65], s[3 * 65]); o.z = pk2(s[4 * 65], s[5 * 65]); o.w = pk2(s[6 * 65], s[7 * 65]);
        *(GLB u32x4*)(Bt + (size_t)(n0 + n) * K + k0 + 8 * c) = o; }
    LDS_WAIT();
}
__device__ __forceinline__ void win_map(int g, int& s0, int& nv) {
    const int d0 = 64 * g; nv = 64;
    if (d0 < 8704) s0 = d0;
    else if (d0 < 9728) s0 = 8784 + (d0 - 8704);
    else if (d0 < 9984) s0 = 9808 + (d0 - 9728);
    else if (d0 < 10240) { const int off = d0 - 9984; if (off == 0) s0 = 8704; else if (off == 64) { s0 = 8768; nv = 16; } else { s0 = 0; nv = 0; } }
    else s0 = 10064 + (d0 - 10240);
}
#ifndef MOE_SCAN_TILES
#define MOE_SCAN_TILES 42
#endif
#ifndef MOE_CONV_IN_PROLOGUE
#define MOE_CONV_IN_PROLOGUE 0
#endif
constexpr int MOE_CONV_ITEMS = NE * ((D / 64) * (2 * FF / 64) + (FF / 64) * (D / 64));
__device__ __forceinline__ void conv_moe_item(const Ctx& C, int idx, LAS float* scr, int lane) {
    constexpr int I_GU1 = (D / 64) * (2 * FF / 64), I_DN1 = (FF / 64) * (D / 64);
    if (idx < NE * I_GU1) {
        const int e = idx / I_GU1, r = idx % I_GU1, nb = r % (2 * FF / 64), kb = r / (2 * FF / 64);
        const int tile = nb >> 2, q = nb & 3; const int sc = 128 * tile + 64 * (q & 1);
        conv_tile(((q < 2) ? INF32(I_MG) : INF32(I_MU)) + (size_t)e * D * FF, FF, 64 * kb, sc, 64, WSP(bf16_t, WS_MWGU) + (size_t)e * 2 * FF * D, D, 64 * nb, scr, lane);
    } else {
        const int r0 = idx - NE * I_GU1, e = r0 / I_DN1, r = r0 % I_DN1, nb = r % 32, kb = r / 32;
        conv_tile(INF32(I_MD) + (size_t)e * FF * D, D, 64 * kb, 64 * nb, 64, WSP(bf16_t, WS_MWD) + (size_t)e * D * FF, FF, 64 * nb, scr, lane);
    }
}
__device__ __forceinline__ void ph_prologue(const Ctx& C) {
    LAS float* scr = (LAS float*)(C.lds + C.wave * 16640);
    const int gw = C.gw, NGW = C.NGW; int lane = C.lane; asm volatile("" : "+v"(lane)); lane &= 63;
    constexpr int I_WIN1 = (D / 64) * (N_INP / 64);
    constexpr int I_BR1 = (1024 / 64) * (2048 / 64);
    constexpr int I_DD = (D / 64) * (D / 64);
    constexpr int I_GU1 = (D / 64) * (2 * FF / 64);
    constexpr int I_DN1 = (FF / 64) * (D / 64);
    constexpr int I_PP1 = (256 / 64) * (D / 64);
    constexpr int S0 = 0, S1 = S0 + NL * I_WIN1, S2 = S1 + NL * 4 * I_BR1, S3 = S2 + NL * I_DD, S4 = S3 + I_GU1, S5 = S4 + I_DN1, S6 = S5 + NE * I_GU1, S7 = S6 + NE * I_DN1,
                  S8 = S7 + NL * I_DD, S9 = S8 + NL * I_PP1;
    for (int it = gw; it < S9; it += NGW) {
        if (it < S1) { const int l = it / I_WIN1, r = it % I_WIN1, nb = r % (N_INP / 64), kb = r / (N_INP / 64); int s0, nv; win_map(nb, s0, nv);
            conv_tile(INF32(I_WIN) + (size_t)l * D * N_IN, N_IN, 64 * kb, s0, nv, WSP(bf16_t, WS_WIN + l * SZ_WIN1), D, 64 * nb, scr, lane); }
        else if (it < S2) { const int q = (it - S1) / I_BR1, r = (it - S1) % I_BR1, nb = r % 32, kb = r / 32;
            conv_tile(INF32(I_WBR) + (size_t)q * 1024 * 2048, 2048, 64 * kb, 64 * nb, 64, WSP(bf16_t, WS_WBR) + (size_t)q * 2048 * 1024, 1024, 64 * nb, scr, lane); }
        else if (it < S3) { const int l = (it - S2) / I_DD, r = (it - S2) % I_DD, nb = r % 32, kb = r / 32;
            conv_tile(INF32(I_WOUT) + (size_t)l * D * D, D, 64 * kb, 64 * nb, 64, WSP(bf16_t, WS_WOUT + l * SZ_DD), D, 64 * nb, scr, lane); }
        else if (it < S4) {
            const int r = it - S3, nb = r % (2 * FF / 64), kb = r / (2 * FF / 64);
            const int tile = nb >> 2, q = nb & 3; const int sc = 128 * tile + 64 * (q & 1);
            conv_tile((q < 2) ? INF32(I_FG) : INF32(I_FU), FF, 64 * kb, sc, 64, WSP(bf16_t, WS_WGU), D, 64 * nb, scr, lane); }
        else if (it < S5) { const int r = it - S4, nb = r % 32, kb = r / 32;
            conv_tile(INF32(I_FD), D, 64 * kb, 64 * nb, 64, WSP(bf16_t, WS_WD), FF, 64 * nb, scr, lane); }
        else if (it < S7) { if (MOE_CONV_IN_PROLOGUE || it - S5 >= 2 * 1024 * MOE_SCAN_TILES) conv_moe_item(C, it - S5, scr, lane); }
        else if (it < S8) { const int l = (it - S7) / I_DD, r = (it - S7) % I_DD, nb = r % 32, kb = r / 32;
            conv_tile(INF32(I_PG) + (size_t)l * D * D, D, 64 * kb, 64 * nb, 64, WSP(bf16_t, WS_WPG + l * SZ_DD), D, 64 * nb, scr, lane); }
        else { const int l = (it - S8) / I_PP1, r = (it - S8) % I_PP1, nb = r % 32, kb = r / 32;
            conv_tile(INF32(I_PP) + (size_t)l * 256 * D, D, 64 * kb, 64 * nb, 64, WSP(bf16_t, WS_WPP) + (size_t)l * D * 256, 256, 64 * nb, scr, lane); }
    }
    for (int idx = gw * 64 + lane; idx < NL * 3072 * 256; idx += NGW * 64) {
        const int k = idx & 255, n = (idx >> 8) % 3072, l = idx / (3072 * 256);
        float v = 0.f;
        if (n < 1024) { if (k < 96) v = INF32(I_RWW2)[((size_t)l * 96 + k) * 1024 + n]; }
        else if (n < 2048) { if (k >= 96 && k < 192) v = INF32(I_RWA2)[((size_t)l * 96 + (k - 96)) * 1024 + (n - 1024)]; }
        else { if (k >= 192) v = INF32(I_RWG2)[((size_t)l * 64 + (k - 192)) * 1024 + (n - 2048)]; }
        WSP(bf16_t, WS_WLORA)[idx] = (bf16_t)f2bf(v);
    }
    for (int idx = gw * 64 + lane; idx < NL * T * 64; idx += NGW * 64) {
        const int c4 = idx & 63, t = (idx >> 6) % T, l = idx / (T * 64);
        const f32x4 v = *(const GLB f32x4*)(INF32(I_P) + ((size_t)l * T + t) * 256 + 4 * c4);
        u32x2 o; o.x = pk2(v[0], v[1]); o.y = pk2(v[2], v[3]);
        *(GLB u32x2*)(WSP(bf16_t, WS_PCAT) + (size_t)t * 512 + l * 256 + 4 * c4) = o;
    }
}

template <int MODE, bool XBF = true>
__device__ __forceinline__ void ph_norm(const Ctx& C, const GLB void* xin, GLB void* xout, const GLB float* gain, const GLB float* router, int moeS = 1) {
    int lane = C.lane; asm volatile("" : "+v"(lane)); lane &= 63;
    for (int m = C.gw; m < T; m += C.NGW) {
        f32x4 v[8]; float s = 0.f;
        if (XBF) { const GLB u32x2* xr = (const GLB u32x2*)((const GLB bf16_t*)xin + (size_t)m * D) + lane;
#pragma unroll
            for (int j = 0; j < 8; ++j) { const u32x2 w = xr[64 * j]; v[j] = (f32x4){bflo(w.x), bfhi(w.x), bflo(w.y), bfhi(w.y)}; }
        } else { const GLB f32x4* xr = (const GLB f32x4*)((const GLB float*)xin + (size_t)m * D) + lane;
#pragma unroll
            for (int j = 0; j < 8; ++j) v[j] = xr[64 * j]; }
        if (MODE == 2) {
            const GLB int* ts = WSP(int, WS_TOKSLOT) + 2 * m;
#pragma unroll
            for (int q = 0; q < 2; ++q) {
                const int sl = ts[q];
                if (sl < 64 * 256 || moeS <= 1) {
                    const GLB u32x2* o0 = (const GLB u32x2*)(WSP(bf16_t, WS_OS) + (size_t)sl * D) + lane;
#pragma unroll
                    for (int j = 0; j < 8; ++j) { const u32x2 w = o0[64 * j]; v[j] = v[j] + (f32x4){bflo(w.x), bfhi(w.x), bflo(w.y), bfhi(w.y)}; }
                } else {
                    const int tu0 = ((sl >> 8) - 64) * 8, rl = sl & 255;
#pragma unroll
                    for (int j = 0; j < 8; ++j)
                        for (int k = 0; k < moeS; ++k) v[j] = v[j] + *((const GLB f32x4*)(WSP(float, WS_OSP) + ((size_t)((tu0 + j) * moeS + k) << 16) + rl * 256) + lane);
                }
            }
#pragma unroll
            for (int j = 0; j < 8; ++j) { u32x2 o; o.x = pk2(v[j][0], v[j][1]); o.y = pk2(v[j][2], v[j][3]); ((GLB u32x2*)((GLB bf16_t*)xout + (size_t)m * D) + lane)[64 * j] = o;
                v[j] = (f32x4){bflo(o.x), bfhi(o.x), bflo(o.y), bfhi(o.y)}; }
        }
#pragma unroll
        for (int j = 0; j < 8; ++j) s += (v[j][0] * v[j][0] + v[j][1] * v[j][1]) + (v[j][2] * v[j][2] + v[j][3] * v[j][3]);
        const float rstd = 1.0f / sqrtf(wave_sum(s) * (1.0f / D) + 1e-6f);
        GLB u32x2* o8 = (GLB u32x2*)(WSP(bf16_t, WS_H) + (size_t)m * D) + lane;
        float lg[NE];
        if (MODE == 1) {
#pragma unroll
            for (int e = 0; e < NE; ++e) lg[e] = 0.f;
        }
#pragma unroll
        for (int j = 0; j < 8; ++j) { const f32x4 g = ((const GLB f32x4*)gain)[lane + 64 * j]; const f32x4 hv = v[j] * rstd * g; v[j] = hv;
            u32x2 o; o.x = pk2(hv[0], hv[1]); o.y = pk2(hv[2], hv[3]); o8[64 * j] = o; }
        if (MODE == 1) {
#pragma unroll 2
            for (int j = 0; j < 8; ++j) {
#pragma unroll
                for (int q = 0; q < 4; ++q) { const GLB f32x4* rr = (const GLB f32x4*)(router + (size_t)(4 * (lane + 64 * j) + q) * NE); const f32x4 r0 = rr[0], r1 = rr[1]; const float hq = v[j][q];
                    lg[0] += hq * r0[0]; lg[1] += hq * r0[1]; lg[2] += hq * r0[2]; lg[3] += hq * r0[3]; lg[4] += hq * r1[0]; lg[5] += hq * r1[1]; lg[6] += hq * r1[2]; lg[7] += hq * r1[3]; }
            }
        }
        if (MODE == 1) {
#pragma unroll
            for (int e = 0; e < NE; ++e) lg[e] = wave_sum(lg[e]);
            if (lane == 0) {
                int e1 = 0; float v1 = lg[0];
#pragma unroll
                for (int e = 1; e < NE; ++e) if (lg[e] > v1) { v1 = lg[e]; e1 = e; }
                int e2 = -1; float v2 = -3.0e38f;
#pragma unroll
                for (int e = 0; e < NE; ++e) if (e != e1 && lg[e] > v2) { v2 = lg[e]; e2 = e; }
                const float ex = __expf(v2 - v1), w1 = 1.0f / (1.0f + ex), w2 = ex / (1.0f + ex);
                GLB unsigned* cnt = WSP(unsigned, WS_CTL) + CW_MOECNT;
                const unsigned p1 = atomicAdd((unsigned*)cnt + 64 * e1, 1u), p2 = atomicAdd((unsigned*)cnt + 64 * e2, 1u);
                GLB unsigned* rt = WSP(unsigned, WS_ROUTE) + (size_t)m * 8;
                rt[0] = (unsigned)e1; rt[1] = p1; rt[2] = __builtin_bit_cast(unsigned, w1); rt[3] = (unsigned)e2; rt[4] = p2; rt[5] = __builtin_bit_cast(unsigned, w2);
            }
        }
    }
}
__device__ __forceinline__ void moe_offsets(const Ctx& C, int (&toff)[NE + 1]) {
    const GLB unsigned* cnt = WSP(unsigned, WS_CTL) + CW_MOECNT; int acc = 0;
#pragma unroll
    for (int e = 0; e < NE; ++e) { toff[e] = acc; const unsigned c = __hip_atomic_load(cnt + 64 * e, __ATOMIC_RELAXED, __HIP_MEMORY_SCOPE_AGENT); acc += (int)((c + 255u) >> 8); }
    toff[NE] = acc;
}
constexpr int MOETAB_OFF = MISC_OFF + 2048;
__device__ __forceinline__ void moe_tile_table(const Ctx& C) {
    int toff[NE + 1]; moe_offsets(C, toff);
    LAS int* tab = (LAS int*)(C.lds + MOETAB_OFF);
    if (C.tid <= MOE_MAXRT) { int e = 0;
#pragma unroll
        for (int j = 1; j < NE; ++j) e += (C.tid >= toff[j]) ? 1 : 0;
        tab[C.tid] = (C.tid == MOE_MAXRT) ? toff[NE] : e; }
    LDS_WAIT(); __syncthreads();
}
__device__ __forceinline__ void ph_moe_gather(const Ctx& C) {
    int toff[NE + 1]; moe_offsets(C, toff);
    int lane = C.lane; asm volatile("" : "+v"(lane)); lane &= 63;
    for (int m = C.gw; m < T; m += C.NGW) {
        const GLB unsigned* rt = WSP(unsigned, WS_ROUTE) + (size_t)m * 8;
        const int e1 = (int)rt[0], p1 = (int)rt[1], e2 = (int)rt[3], p2 = (int)rt[4];
        int o1 = 0, o2 = 0;
#pragma unroll
        for (int e = 0; e < NE; ++e) { o1 = (e == e1) ? toff[e] : o1; o2 = (e == e2) ? toff[e] : o2; }
        const int s1 = o1 * 256 + p1, s2 = o2 * 256 + p2;
        const GLB u32x4* src = (const GLB u32x4*)(WSP(bf16_t, WS_H) + (size_t)m * D) + lane;
        GLB u32x4* d1 = (GLB u32x4*)(WSP(bf16_t, WS_HS) + (size_t)s1 * D) + lane; GLB u32x4* d2 = (GLB u32x4*)(WSP(bf16_t, WS_HS) + (size_t)s2 * D) + lane;
#pragma unroll
        for (int j = 0; j < 4; ++j) { const u32x4 v = src[64 * j]; d1[64 * j] = v; d2[64 * j] = v; }
        if (lane == 0) { WSP(int, WS_TOKSLOT)[2 * m] = s1; WSP(int, WS_TOKSLOT)[2 * m + 1] = s2;
            WSP(unsigned, WS_WSLOT)[s1] = rt[2]; WSP(unsigned, WS_WSLOT)[s2] = rt[5]; }
    }
}

__device__ __forceinline__ float rope_inv_freq(int i, int half) { return exp2f(-13.287712379549449f * (float)i / (float)half); }
__device__ __forceinline__ void ph_prep(const Ctx& C, int l) {
    int lane = C.lane; asm volatile("" : "+v"(lane)); lane &= 63;
    const GLB bf16_t* UF = WSP(bf16_t, WS_UF);
    const int d = lane & 31, hh = lane >> 5;
    for (int m = C.gw; m < T; m += C.NGW) {
        const int t = m % SEQ;
        const GLB bf16_t* u = UF + (size_t)m * UFW;
        const float posf = (float)((const GLB int*)inptr(C.lds, I_POS))[m];
        float qa[8], qb[8], ia[8], ib[8], sa[8], sb[8];
#pragma unroll
        for (int h = 0; h < 8; ++h) { qa[h] = bf1(u[UF_DQ + h * 128 + lane]); qb[h] = bf1(u[UF_DQ + h * 128 + 64 + lane]); }
#pragma unroll
        for (int hp = 0; hp < 8; ++hp) { const int h = 2 * hp + hh; ia[hp] = bf1(u[UF_IQ + h * 64 + d]); ib[hp] = bf1(u[UF_IQ + h * 64 + 32 + d]); sa[hp] = bf1(u[UF_SQ + h * 64 + d]); sb[hp] = bf1(u[UF_SQ + h * 64 + 32 + d]); }
        const float ika = bf1(u[UF_IK + d]), ikb = bf1(u[UF_IK + 32 + d]), iwv = bf1(u[UF_IW + (lane & 15)]);
        const float ska = bf1(u[UF_SK + hh * 64 + d]), skb = bf1(u[UF_SK + hh * 64 + 32 + d]), sv0 = bf1(u[UF_SV + lane]), sv1 = bf1(u[UF_SV + 64 + lane]);
        {
            const GLB float* mu = INF32(I_RWMU) + (size_t)l * 3328;
#pragma unroll
            for (int half = 0; half < 2; ++half) {
                constexpr int J0[2] = {0, 7}, J1[2] = {7, 13};
                f32x4 cur[7], prv[7], mm[7];
#pragma unroll
                for (int j = J0[half]; j < J1[half]; ++j) { const int c = 4 * (lane + 64 * j), q = j - J0[half];
                    { const u32x2 w = *(const GLB u32x2*)(u + UF_RW + c); cur[q] = (f32x4){bflo(w.x), bfhi(w.x), bflo(w.y), bfhi(w.y)}; }
                    if (t > 0) { const u32x2 w = *(const GLB u32x2*)(u - UFW + UF_RW + c); prv[q] = (f32x4){bflo(w.x), bfhi(w.x), bflo(w.y), bfhi(w.y)}; } else prv[q] = (f32x4){0.f, 0.f, 0.f, 0.f};
                    mm[q] = *(const GLB f32x4*)(mu + c); }
#pragma unroll
                for (int j = J0[half]; j < J1[half]; ++j) { const int c = 4 * (lane + 64 * j), q = j - J0[half];
                    const f32x4 o = cur[q] + mm[q] * (prv[q] - cur[q]);
                    if (j < 12) { GLB bf16_t* dst = WSP(bf16_t, (j < 4 ? WS_R : (j < 8 ? WS_K : WS_V))) + (size_t)m * 1024 + (c & 1023); u32x2 w; w.x = pk2(o[0], o[1]); w.y = pk2(o[2], o[3]); *(GLB u32x2*)dst = w; }
                    else { const int k = c - 3072; f32x4 a;
                        if (k < 96) a = (f32x4){tanhf(o[0]), tanhf(o[1]), tanhf(o[2]), tanhf(o[3])};
                        else if (k < 192) a = o;
                        else a = pg8::sig4(o);
                        u32x2 w; w.x = pk2(a[0], a[1]); w.y = pk2(a[2], a[3]);
                        *(GLB u32x2*)(WSP(bf16_t, WS_ALORA) + (size_t)m * 256 + k) = w; }
                }
            }
        }
        {
            const float invf = rope_inv_freq(lane, 64); float sn, cn; sincosf(posf * invf, &sn, &cn);
            const float g1 = INF32(I_DQN)[l * 128 + lane], g2 = INF32(I_DQN)[l * 128 + 64 + lane];
#pragma unroll
            for (int h = 0; h < 8; ++h) {
                const float a = qa[h], b = qb[h];
                const float rs = 1.0f / sqrtf(wave_sum(a * a + b * b) * (1.0f / 128.f) + 1e-6f);
                const float x1 = a * rs * g1, x2 = b * rs * g2;
                GLB bf16_t* q = WSP(bf16_t, WS_QD) + (size_t)m * 1024 + h * 128;
                q[lane] = (bf16_t)f2bf(x1 * cn - x2 * sn); q[64 + lane] = (bf16_t)f2bf(x2 * cn + x1 * sn);
            }
        }
        {
            const float invf = rope_inv_freq(d, 32); float sn, cn; sincosf(posf * invf, &sn, &cn);
#pragma unroll
            for (int hp = 0; hp < 8; ++hp) { const int h = 2 * hp + hh; const float a = ia[hp], b = ib[hp];
                GLB bf16_t* q = WSP(bf16_t, WS_QI) + (size_t)m * 1024 + h * 64; q[d] = (bf16_t)f2bf(a * cn - b * sn); q[32 + d] = (bf16_t)f2bf(b * cn + a * sn); }
            if (hh == 0) { GLB bf16_t* q = WSP(bf16_t, WS_KI) + (size_t)m * 64; q[d] = (bf16_t)f2bf(ika * cn - ikb * sn); q[32 + d] = (bf16_t)f2bf(ikb * cn + ika * sn); }
            if (lane < 16) WSP(float, WS_WI)[(size_t)m * 16 + lane] = iwv * 0.03125f;
            const float sg1 = INF32(I_SQN)[l * 64 + d], sg2 = INF32(I_SQN)[l * 64 + 32 + d];
#pragma unroll
            for (int hp = 0; hp < 8; ++hp) { const int h = 2 * hp + hh; const float a = sa[hp], b = sb[hp];
                float s2 = a * a + b * b;
#pragma unroll
                for (int o = 1; o < 32; o <<= 1) s2 += __shfl_xor(s2, o);
                const float rs = 1.0f / sqrtf(s2 * (1.0f / 64.f) + 1e-6f); const float x1 = a * rs * sg1, x2 = b * rs * sg2;
                GLB bf16_t* q = WSP(bf16_t, WS_QS) + (size_t)m * 1024 + h * 64; q[d] = (bf16_t)f2bf(x1 * cn - x2 * sn); q[32 + d] = (bf16_t)f2bf(x2 * cn + x1 * sn); }
            { const float kg1 = INF32(I_SKN)[l * 64 + d], kg2 = INF32(I_SKN)[l * 64 + 32 + d];
              float s2 = ska * ska + skb * skb;
#pragma unroll
              for (int o = 1; o < 32; o <<= 1) s2 += __shfl_xor(s2, o);
              const float rs = 1.0f / sqrtf(s2 * (1.0f / 64.f) + 1e-6f); const float x1 = ska * rs * kg1, x2 = skb * rs * kg2;
              GLB bf16_t* q = WSP(bf16_t, WS_KS) + (size_t)m * 128 + hh * 64; q[d] = (bf16_t)f2bf(x1 * cn - x2 * sn); q[32 + d] = (bf16_t)f2bf(x2 * cn + x1 * sn);
              GLB bf16_t* vv = WSP(bf16_t, WS_VS) + (size_t)m * 128; vv[lane] = (bf16_t)f2bf(sv0); vv[64 + lane] = (bf16_t)f2bf(sv1); }
        }
    }
}

__device__ __forceinline__ void ph_latent(const Ctx& C, int l) {
    int lane = C.lane; asm volatile("" : "+v"(lane)); lane &= 63;
    LAS float* cs = (LAS float*)(C.lds + C.wave * 8192);
    const GLB bf16_t* UF = WSP(bf16_t, WS_UF);
    const GLB float* wuk = INF32(I_DWUK) + (size_t)l * 256 * 128; const GLB float* wuv = INF32(I_DWUV) + (size_t)l * 256 * 128;
    for (int g8 = C.gw; g8 < T / 8; g8 += C.NGW) {
        const int m0 = 8 * g8;
        float cv[8][4];
#pragma unroll
        for (int tk = 0; tk < 8; ++tk)
#pragma unroll
            for (int j = 0; j < 4; ++j) cv[tk][j] = bf1(UF[(size_t)(m0 + tk) * UFW + UF_CKV + lane + 64 * j]);
#pragma unroll
        for (int tk = 0; tk < 8; ++tk) {
            float ss = 0.f;
#pragma unroll
            for (int j = 0; j < 4; ++j) ss += cv[tk][j] * cv[tk][j];
            const float rc = 1.0f / sqrtf(wave_sum(ss) * (1.0f / 256.f) + 1e-6f);
#pragma unroll
            for (int j = 0; j < 4; ++j) cs[(lane + 64 * j) * 8 + tk] = cv[tk][j] * rc * INF32(I_DKVN)[l * 256 + lane + 64 * j];
        }
        LDS_WAIT();
        float acc[8][4];
#pragma unroll
        for (int tk = 0; tk < 8; ++tk) { acc[tk][0] = 0.f; acc[tk][1] = 0.f; acc[tk][2] = 0.f; acc[tk][3] = 0.f; }
#pragma unroll 8
        for (int k = 0; k < 256; ++k) {
            const float w0 = wuk[k * 128 + lane], w1 = wuk[k * 128 + 64 + lane], w2 = wuv[k * 128 + lane], w3 = wuv[k * 128 + 64 + lane];
            const f32x4 ca = *(const LAS f32x4*)(cs + k * 8), cb = *(const LAS f32x4*)(cs + k * 8 + 4);
#pragma unroll
            for (int tk = 0; tk < 8; ++tk) { const float c = (tk < 4) ? ca[tk & 3] : cb[tk & 3]; acc[tk][0] += c * w0; acc[tk][1] += c * w1; acc[tk][2] += c * w2; acc[tk][3] += c * w3; }
        }
        const float invf = rope_inv_freq(lane, 64);
        const float g1 = INF32(I_DKN)[l * 128 + lane], g2 = INF32(I_DKN)[l * 128 + 64 + lane];
#pragma unroll
        for (int tk = 0; tk < 8; ++tk) {
            const int m = m0 + tk;
            const float posf = (float)((const GLB int*)inptr(C.lds, I_POS))[m];
            float sn, cn; sincosf(posf * invf, &sn, &cn);
            const float k1 = acc[tk][0], k2 = acc[tk][1];
            const float rk = 1.0f / sqrtf(wave_sum(k1 * k1 + k2 * k2) * (1.0f / 128.f) + 1e-6f);
            const float y1 = k1 * rk * g1, y2 = k2 * rk * g2;
            GLB bf16_t* kd = WSP(bf16_t, WS_KD) + (size_t)m * 128; GLB bf16_t* vd = WSP(bf16_t, WS_VD) + (size_t)m * 128;
            kd[lane] = (bf16_t)f2bf(y1 * cn - y2 * sn); kd[64 + lane] = (bf16_t)f2bf(y2 * cn + y1 * sn);
            vd[lane] = (bf16_t)f2bf(acc[tk][2]); vd[64 + lane] = (bf16_t)f2bf(acc[tk][3]);
        }
        LDS_WAIT();
    }
}

__device__ __forceinline__ void ph_rwkv_kk(const Ctx& C, int l) {
    int lane = C.lane; asm volatile("" : "+v"(lane)); lane &= 63;
    for (int m = C.gw; m < T; m += C.NGW) {
#pragma unroll
        for (int i = 0; i < 4; ++i) {
            const int c = 256 * i + 4 * lane; const size_t o = (size_t)m * 1024 + c;
            const f32x4 k = *(const GLB f32x4*)(WSP(float, WS_K) + o), a = *(const GLB f32x4*)(WSP(float, WS_AA) + o);
            const f32x4 kkw = *(const GLB f32x4*)(INF32(I_RWKK) + l * 1024 + c), ka = *(const GLB f32x4*)(INF32(I_RWKA) + l * 1024 + c);
            f32x4 kk = k * kkw; float s = (kk[0] * kk[0] + kk[1] * kk[1]) + (kk[2] * kk[2] + kk[3] * kk[3]);
#pragma unroll
            for (int q = 1; q < 16; q <<= 1) s += __shfl_xor(s, q);
            const float inv = 1.0f / fmaxf(sqrtf(s), 1e-12f); kk = kk * inv;
            *(GLB f32x4*)(WSP(float, WS_KK) + o) = kk;
            *(GLB f32x4*)(WSP(float, WS_K) + o) = k * (1.0f + (a - 1.0f) * ka);
            *(GLB f32x4*)(WSP(float, WS_AA) + o) = kk * a;
        }
    }
}
__device__ __forceinline__ void ph_rwkv_scan_naive(const Ctx& C) {
    if (C.wave != 0) return;
    int lane = C.lane; asm volatile("" : "+v"(lane)); lane &= 63;
    LAS float* buf = (LAS float*)C.lds;
    for (int it = blockIdx.x; it < NB * 16; it += C.G) {
        const int b = it >> 4, h = it & 15;
        float S[64];
#pragma unroll
        for (int k = 0; k < 64; ++k) S[k] = 0.f;
        const size_t base = (size_t)b * SEQ * 1024 + h * 64 + lane;
        for (int t0 = 0; t0 < SEQ; t0 += 16) {
#pragma unroll
            for (int st = 0; st < 16; ++st) { const size_t o = base + (size_t)(t0 + st) * 1024; LAS float* d = buf + st * 384 + lane;
                d[0] = WSP(float, WS_R)[o]; d[64] = WSP(float, WS_DEC)[o]; d[128] = WSP(float, WS_K)[o]; d[192] = WSP(float, WS_KK)[o]; d[256] = WSP(float, WS_AA)[o]; d[320] = WSP(float, WS_V)[o]; }
            LDS_WAIT();
            for (int st = 0; st < 16; ++st) {
                const LAS float* rb = buf + st * 384;
                float p = 0.f;
#pragma unroll
                for (int k = 0; k < 64; k += 4) { const f32x4 q = *(const LAS f32x4*)(rb + 192 + k); p += S[k] * q[0] + S[k + 1] * q[1] + S[k + 2] * q[2] + S[k + 3] * q[3]; }
                const float vv = rb[320 + lane]; float y = 0.f;
#pragma unroll
                for (int k = 0; k < 64; k += 4) { const f32x4 w = *(const LAS f32x4*)(rb + 64 + k), bb = *(const LAS f32x4*)(rb + 256 + k), kq = *(const LAS f32x4*)(rb + 128 + k), r = *(const LAS f32x4*)(rb + k);
#pragma unroll
                    for (int j = 0; j < 4; ++j) { S[k + j] = S[k + j] * w[j] - p * bb[j] + vv * kq[j]; y += S[k + j] * r[j]; } }
                WSP(float, WS_YRAW)[base + (size_t)(t0 + st) * 1024] = y;
            }
            LDS_WAIT();
        }
    }
}
__device__ __forceinline__ f32x4 ld4bf(const GLB bf16_t* q) { const u32x2 w = *(const GLB u32x2*)q; return (f32x4){bflo(w.x), bfhi(w.x), bflo(w.y), bfhi(w.y)}; }
__device__ __forceinline__ void ph_rwkv_post(const Ctx& C, int l) {
    int lane = C.lane; asm volatile("" : "+v"(lane)); lane &= 63;
    if (C.wave >= 4) return;
    for (int m = blockIdx.x * 4 + C.wave; m < T; m += C.G * 4) {
#pragma unroll
        for (int i = 0; i < 4; ++i) {
            const int c = 256 * i + 4 * lane; const size_t o = (size_t)m * 1024 + c;
            const f32x4 y = *(const GLB f32x4*)(WSP(float, WS_YRAW) + o);
            float s = (y[0] + y[1]) + (y[2] + y[3]);
#pragma unroll
            for (int q = 1; q < 16; q <<= 1) s += __shfl_xor(s, q);
            const float mean = s * (1.0f / 64.f); const f32x4 dlt = y - mean;
            float s2 = (dlt[0] * dlt[0] + dlt[1] * dlt[1]) + (dlt[2] * dlt[2] + dlt[3] * dlt[3]);
#pragma unroll
            for (int q = 1; q < 16; q <<= 1) s2 += __shfl_xor(s2, q);
            const float rstd = 1.0f / sqrtf(s2 * (1.0f / 64.f) + 64e-5f);
            const f32x4 r = ld4bf(WSP(bf16_t, WS_R) + o), kraw = ld4bf(WSP(bf16_t, WS_K) + o), av = ld4bf(WSP(bf16_t, WS_AA) + o), v = ld4bf(WSP(bf16_t, WS_V) + o), g = ld4bf(WSP(bf16_t, WS_GG) + o);
            const f32x4 k = kraw * (1.0f + (av - 1.0f) * *(const GLB f32x4*)(INF32(I_RWKA) + l * 1024 + c));
            const f32x4 rk = *(const GLB f32x4*)(INF32(I_RWRK) + l * 1024 + c), lg = *(const GLB f32x4*)(INF32(I_RWLNG) + l * 1024 + c), lb = *(const GLB f32x4*)(INF32(I_RWLNB) + l * 1024 + c);
            const f32x4 pr = r * k * rk; float bs = (pr[0] + pr[1]) + (pr[2] + pr[3]);
#pragma unroll
            for (int q = 1; q < 16; q <<= 1) bs += __shfl_xor(bs, q);
            const f32x4 res = (dlt * rstd * lg + lb + bs * v) * g;
            u32x2 w; w.x = pk2(res[0], res[1]); w.y = pk2(res[2], res[3]);
            *(GLB u32x2*)(WSP(bf16_t, WS_Y) + (size_t)m * 4096 + 1024 + c) = w;
        }
    }
}
__device__ __forceinline__ float dot8(u32x4 kv, f32x4 qa, f32x4 qb) {
    return bflo(kv.x) * qa[0] + bfhi(kv.x) * qa[1] + bflo(kv.y) * qa[2] + bfhi(kv.y) * qa[3] + bflo(kv.z) * qb[0] + bfhi(kv.z) * qb[1] + bflo(kv.w) * qb[2] + bfhi(kv.w) * qb[3];
}
__device__ __forceinline__ void ph_sb_naive(const Ctx& C) {
    int lane = C.lane; asm volatile("" : "+v"(lane));
    LAS float* qs = (LAS float*)(C.lds + C.wave * 512);
    const GLB bf16_t* QKV = WSP(bf16_t, WS_SBQKV); GLB bf16_t* Y = WSP(bf16_t, WS_Y);
    for (int it = C.gw; it < NB * 8 * SEQ; it += C.NGW) {
        const int t = it % SEQ, bh = it / SEQ, h = bh & 7, b = bh >> 3;
        const size_t m = (size_t)b * SEQ + t;
        { const unsigned qq = *(const GLB unsigned*)(QKV + m * 3072 + h * 128 + 2 * lane); qs[2 * lane] = bflo(qq); qs[2 * lane + 1] = bfhi(qq); }
        LDS_WAIT();
        float o0 = 0.f, o1 = 0.f, carry = 0.f;
        const int nch = (t + 63) >> 6;
        for (int c = nch - 1; c >= 0; --c) {
            const int s = c * 64 + lane; const bool valid = s < t; const int sc = valid ? s : 0;
            const GLB u32x4* kp = (const GLB u32x4*)(QKV + ((size_t)b * SEQ + sc) * 3072 + 1024 + h * 128);
            float dot = 0.f;
#pragma unroll
            for (int j = 0; j < 16; ++j) dot += dot8(kp[j], *(const LAS f32x4*)(qs + 8 * j), *(const LAS f32x4*)(qs + 8 * j + 4));
            const float z = dot * 0.08838834764831845f;
            const float lk = valid ? logsigf_(-z) : 0.f, lb = logsigf_(z);
            float inc = lk;
#pragma unroll
            for (int off = 1; off < 64; off <<= 1) { const float o = __shfl_down(inc, off); if (lane + off < 64) inc += o; }
            const float w = valid ? __expf(lb + carry + inc - lk) : 0.f;
            carry += rdlane(inc, 0);
            const int nk = (t - c * 64) < 64 ? (t - c * 64) : 64;
            const GLB bf16_t* vp = QKV + ((size_t)b * SEQ + c * 64) * 3072 + 2048 + h * 128 + 2 * lane;
            for (int j = 0; j < nk; ++j) { const float wj = rdlane(w, j); const unsigned vv = *(const GLB unsigned*)(vp + (size_t)j * 3072); o0 += wj * bflo(vv); o1 += wj * bfhi(vv); }
        }
        *(GLB unsigned*)(Y + m * 4096 + h * 128 + 2 * lane) = pk2(o0, o1);
        LDS_WAIT();
    }
}
__device__ __forceinline__ void ph_swa_naive(const Ctx& C, int l) {
    int lane = C.lane; asm volatile("" : "+v"(lane));
    LAS float* qs = (LAS float*)(C.lds + C.wave * 512);
    const GLB bf16_t* QS = WSP(bf16_t, WS_QS); const GLB bf16_t* KS = WSP(bf16_t, WS_KS); const GLB bf16_t* VS = WSP(bf16_t, WS_VS); GLB bf16_t* Y = WSP(bf16_t, WS_Y);
    for (int it = C.gw; it < T * 16; it += C.NGW) {
        const int h = it & 15, m = it >> 4, t = m % SEQ, b = m / SEQ, kvh = h >> 3;
        qs[lane] = bf1(QS[(size_t)m * 1024 + h * 64 + lane]);
        LDS_WAIT();
        float lg[2];
#pragma unroll
        for (int i = 0; i < 2; ++i) { const int s = t - 127 + lane + 64 * i; const bool valid = s >= 0;
            const GLB u32x4* kp = (const GLB u32x4*)(KS + ((size_t)b * SEQ + (valid ? s : 0)) * 128 + kvh * 64);
            float dot = 0.f;
#pragma unroll
            for (int j = 0; j < 8; ++j) dot += dot8(kp[j], *(const LAS f32x4*)(qs + 8 * j), *(const LAS f32x4*)(qs + 8 * j + 4));
            lg[i] = valid ? dot * 0.125f : -3.0e38f; }
        const float sink = INF32(I_SSINK)[l * 16 + h];
        const float mx = fmaxf(wave_max(fmaxf(lg[0], lg[1])), sink);
        const float e0 = (lg[0] > -1.0e38f) ? __expf(lg[0] - mx) : 0.f, e1 = (lg[1] > -1.0e38f) ? __expf(lg[1] - mx) : 0.f;
        const float den = wave_sum(e0 + e1) + __expf(sink - mx);
        const float p0 = e0 / den, p1 = e1 / den;
        float o = 0.f;
        const int j0 = (t >= 127) ? 0 : 127 - t;
        for (int j = j0; j < 128; ++j) { const float pj = (j < 64) ? rdlane(p0, j) : rdlane(p1, j - 64); const int s = t - 127 + j;
            o += pj * bf1(VS[((size_t)b * SEQ + s) * 128 + kvh * 64 + lane]); }
        Y[(size_t)m * 4096 + 3072 + h * 64 + lane] = (bf16_t)f2bf(o);
        LDS_WAIT();
    }
}
__device__ __forceinline__ unsigned ordkey(float f) { const unsigned u = __builtin_bit_cast(unsigned, f); return (u & 0x80000000u) ? ~u : (u | 0x80000000u); }
__device__ __forceinline__ void ph_dsa_naive(const Ctx& C) {
    int lane = C.lane; asm volatile("" : "+v"(lane));
    LAS float* A = (LAS float*)(C.lds + C.wave * 13312);
    LAS float* Bs = A + 1024;
    LAS int* Cs = (LAS int*)(Bs + 2048);
    const GLB bf16_t* QI = WSP(bf16_t, WS_QI); const GLB bf16_t* KI = WSP(bf16_t, WS_KI); const GLB float* WI = WSP(float, WS_WI);
    const GLB bf16_t* QD = WSP(bf16_t, WS_QD); const GLB bf16_t* KD = WSP(bf16_t, WS_KD); const GLB bf16_t* VD = WSP(bf16_t, WS_VD); GLB bf16_t* Y = WSP(bf16_t, WS_Y);
    for (int m = C.gw; m < T; m += C.NGW) {
        const int t = m % SEQ, b = m / SEQ, n = t + 1;
        const size_t bm = (size_t)b * SEQ;
#pragma unroll
        for (int i = 0; i < 2; ++i) { const int e = 8 * (lane + 64 * i); const u32x4 q = *(const GLB u32x4*)(QI + (size_t)m * 1024 + e);
            *(LAS f32x4*)(A + e) = (f32x4){bflo(q.x), bfhi(q.x), bflo(q.y), bfhi(q.y)}; *(LAS f32x4*)(A + e + 4) = (f32x4){bflo(q.z), bfhi(q.z), bflo(q.w), bfhi(q.w)}; }
        const float wl = WI[(size_t)m * 16 + (lane & 15)];
        LDS_WAIT();
        const int nch = (n + 63) >> 6;
        for (int c = 0; c < nch; ++c) {
            const int s = c * 64 + lane; const bool valid = s < n;
            const GLB u32x4* kp = (const GLB u32x4*)(KI + (bm + (valid ? s : 0)) * 64);
            u32x4 kv[8];
#pragma unroll
            for (int j = 0; j < 8; ++j) kv[j] = kp[j];
            float sc = 0.f;
#pragma unroll 1
            for (int h = 0; h < 16; ++h) { float dot = 0.f;
#pragma unroll
                for (int j = 0; j < 8; ++j) dot += dot8(kv[j], *(const LAS f32x4*)(A + h * 64 + 8 * j), *(const LAS f32x4*)(A + h * 64 + 8 * j + 4));
                sc += rdlane(wl, h) * fmaxf(dot, 0.f); }
            Bs[s] = sc;
        }
        LDS_WAIT();
        int nsel;
        if (n <= 256) { nsel = n;
#pragma unroll
            for (int i = 0; i < 4; ++i) if (lane + 64 * i < n) Cs[lane + 64 * i] = lane + 64 * i;
        } else {
            nsel = 256;
            unsigned key[32];
#pragma unroll
            for (int i = 0; i < 32; ++i) { const int s = lane + 64 * i; key[i] = (s < n) ? ordkey(Bs[s]) : 0u; }
            unsigned tau = 0u;
            for (int bit = 31; bit >= 0; --bit) {
                const unsigned cand = tau | (1u << bit); int cnt = 0;
#pragma unroll
                for (int i = 0; i < 32; ++i) cnt += (key[i] >= cand) ? 1 : 0;
#pragma unroll
                for (int o = 1; o < 64; o <<= 1) cnt += __shfl_xor(cnt, o);
                if (cnt >= 256) tau = cand;
            }
            int cgt = 0;
#pragma unroll
            for (int i = 0; i < 32; ++i) cgt += (key[i] > tau) ? 1 : 0;
#pragma unroll
            for (int o = 1; o < 64; o <<= 1) cgt += __shfl_xor(cgt, o);
            const int need = 256 - cgt;
            int base = 0, eqbase = 0;
            const unsigned long long lt = (1ull << lane) - 1ull;
#pragma unroll
            for (int i = 0; i < 32; ++i) {
                const bool gt = key[i] > tau, eq = key[i] == tau;
                const unsigned long long beq = __ballot(eq);
                const int eqrank = eqbase + __popcll(beq & lt);
                const bool sel = gt || (eq && eqrank < need);
                const unsigned long long bs = __ballot(sel);
                if (sel) Cs[base + __popcll(bs & lt)] = lane + 64 * i;
                base += __popcll(bs); eqbase += __popcll(beq);
            }
        }
        LDS_WAIT();
#pragma unroll
        for (int i = 0; i < 2; ++i) { const int e = 8 * (lane + 64 * i); const u32x4 q = *(const GLB u32x4*)(QD + (size_t)m * 1024 + e);
            *(LAS f32x4*)(A + e) = (f32x4){bflo(q.x), bfhi(q.x), bflo(q.y), bfhi(q.y)}; *(LAS f32x4*)(A + e + 4) = (f32x4){bflo(q.z), bfhi(q.z), bflo(q.w), bfhi(q.w)}; }
        LDS_WAIT();
        float lg[8][4];
#pragma unroll
        for (int i = 0; i < 4; ++i) { const int j = lane + 64 * i; const bool valid = j < nsel; const int s = valid ? Cs[j] : 0;
            const GLB u32x4* kp = (const GLB u32x4*)(KD + (bm + s) * 128);
            float a8[8];
#pragma unroll
            for (int h = 0; h < 8; ++h) a8[h] = 0.f;
#pragma unroll 1
            for (int pc = 0; pc < 16; ++pc) { const u32x4 kv = kp[pc];
#pragma unroll
                for (int h = 0; h < 8; ++h) a8[h] += dot8(kv, *(const LAS f32x4*)(A + h * 128 + 8 * pc), *(const LAS f32x4*)(A + h * 128 + 8 * pc + 4)); }
#pragma unroll
            for (int h = 0; h < 8; ++h) lg[h][i] = valid ? a8[h] * 0.08838834764831845f : -3.0e38f; }
#pragma unroll
        for (int h = 0; h < 8; ++h) {
            const float mx = wave_max(fmaxf(fmaxf(lg[h][0], lg[h][1]), fmaxf(lg[h][2], lg[h][3])));
            float e[4]; float sm = 0.f;
#pragma unroll
            for (int i = 0; i < 4; ++i) { e[i] = (lg[h][i] > -1.0e38f) ? __expf(lg[h][i] - mx) : 0.f; sm += e[i]; }
            const float inv = 1.0f / wave_sum(sm);
#pragma unroll
            for (int i = 0; i < 4; ++i) Bs[(lane + 64 * i) * 8 + h] = e[i] * inv;
        }
        LDS_WAIT();
        float o[8][2];
#pragma unroll
        for (int h = 0; h < 8; ++h) { o[h][0] = 0.f; o[h][1] = 0.f; }
        for (int j = 0; j < nsel; ++j) { const int s = Cs[j]; const unsigned vv = *(const GLB unsigned*)(VD + (bm + s) * 128 + 2 * lane); const float v0 = bflo(vv), v1 = bfhi(vv);
            const f32x4 pa = *(const LAS f32x4*)(Bs + j * 8), pb = *(const LAS f32x4*)(Bs + j * 8 + 4);
#pragma unroll
            for (int h = 0; h < 4; ++h) { o[h][0] += pa[h] * v0; o[h][1] += pa[h] * v1; o[4 + h][0] += pb[h] * v0; o[4 + h][1] += pb[h] * v1; } }
#pragma unroll
        for (int h = 0; h < 8; ++h) *(GLB unsigned*)(Y + (size_t)m * 4096 + 2048 + h * 128 + 2 * lane) = pk2(o[h][0], o[h][1]);
        LDS_WAIT();
    }
}
typedef float f32x16 __attribute__((ext_vector_type(16)));
__device__ __forceinline__ int wave_isum(int x) {
    x += __builtin_amdgcn_mov_dpp(x, 0x128, 0xf, 0xf, true); x += __builtin_amdgcn_mov_dpp(x, 0x124, 0xf, 0xf, true);
    x += __builtin_amdgcn_mov_dpp(x, 0x122, 0xf, 0xf, true); x += __builtin_amdgcn_mov_dpp(x, 0x121, 0xf, 0xf, true);
    return __builtin_amdgcn_readlane(x, 0) + __builtin_amdgcn_readlane(x, 16) + __builtin_amdgcn_readlane(x, 32) + __builtin_amdgcn_readlane(x, 48);
}
constexpr size_t WS_SBVT = WS_MIX_END;
constexpr size_t WS_SWVT = WS_SBVT + (size_t)32 * 128 * SEQ * 2;
constexpr size_t WS_VDT = WS_SWVT + (size_t)NB * 2 * 64 * SEQ * 2;
constexpr size_t WS_SC = WS_VDT + (size_t)NB * 128 * SEQ * 2;
constexpr size_t WS_SELB = WS_SC + (size_t)T * SEQ * 4;
constexpr size_t WS_END2 = WS_SELB + (size_t)T * 32 * 8;
constexpr size_t WS_XB = (WS_END2 + 255) & ~(size_t)255;
constexpr size_t WS_END3 = WS_XB + (size_t)T * D * 2;
static_assert(WS_END3 < (size_t)2000 * 1000 * 1000, "workspace budget");

__device__ __forceinline__ void vt_tile(const GLB bf16_t* src, int src_ld, GLB bf16_t* dst, LAS bf16_t* scr, int lane) {
    const int cq = lane & 7, rq = lane >> 3;
    u32x4 v[8];
#pragma unroll
    for (int j = 0; j < 8; ++j) v[j] = *(const GLB u32x4*)(src + (size_t)(rq + 8 * j) * src_ld + 8 * cq);
#pragma unroll
    for (int j = 0; j < 8; ++j) { LAS unsigned* d = (LAS unsigned*)(scr + (rq + 8 * j) * 66 + 8 * cq); d[0] = v[j].x; d[1] = v[j].y; d[2] = v[j].z; d[3] = v[j].w; }
    LDS_WAIT();
#pragma unroll
    for (int j = 0; j < 8; ++j) { const int d = rq + 8 * j; const LAS bf16_t* s = scr + (8 * cq) * 66 + d;
        u32x4 o; o.x = (unsigned)s[0] | ((unsigned)s[66] << 16); o.y = (unsigned)s[2 * 66] | ((unsigned)s[3 * 66] << 16);
        o.z = (unsigned)s[4 * 66] | ((unsigned)s[5 * 66] << 16); o.w = (unsigned)s[6 * 66] | ((unsigned)s[7 * 66] << 16);
        *(GLB u32x4*)(dst + (size_t)d * SEQ + 8 * cq) = o; }
    LDS_WAIT();
}
__device__ __forceinline__ void ph_vt(const Ctx& C) {
    int lane = C.lane; asm volatile("" : "+v"(lane)); lane &= 63;
    LAS bf16_t* scr = (LAS bf16_t*)(C.lds + 65536 + C.wave * 8448);
    for (int it = C.gw; it < 32 * 2 * 32; it += C.NGW) {
        const int sb = it & 31, db = (it >> 5) & 1, bh = it >> 6, b = bh >> 3, h = bh & 7;
        vt_tile(WSP(bf16_t, WS_SBQKV) + ((size_t)b * SEQ + 64 * sb) * 3072 + 2048 + h * 128 + 64 * db, 3072,
                WSP(bf16_t, WS_SBVT) + ((size_t)bh * 128 + 64 * db) * SEQ + 64 * sb, scr, lane);
    }
}

__device__ __forceinline__ void ph_vt_small(const Ctx& C) {
    int lane = C.lane; asm volatile("" : "+v"(lane)); lane &= 63;
    LAS bf16_t* scr = (LAS bf16_t*)(C.lds + C.wave * 8448);
    for (int it = C.gw; it < 512; it += C.NGW) {
        const int sb = it & 31, hd = (it >> 5) & 1, b = (it >> 6) & 3, which = it >> 8;
        if (which == 0) vt_tile(WSP(bf16_t, WS_VS) + ((size_t)b * SEQ + 64 * sb) * 128 + 64 * hd, 128, WSP(bf16_t, WS_SWVT) + ((size_t)(b * 2 + hd) * 64) * SEQ + 64 * sb, scr, lane);
        else vt_tile(WSP(bf16_t, WS_VD) + ((size_t)b * SEQ + 64 * sb) * 128 + 64 * hd, 128, WSP(bf16_t, WS_VDT) + ((size_t)b * 128 + 64 * hd) * SEQ + 64 * sb, scr, lane);
    }
}

__device__ __forceinline__ void sb_item(const Ctx& C, int lane, int bh, int qb) {
    const int c = lane & 31, hh = lane >> 5, b = bh >> 3, h = bh & 7, q0 = 32 * qb;
    const GLB bf16_t* QKV = WSP(bf16_t, WS_SBQKV); const GLB bf16_t* VT = WSP(bf16_t, WS_SBVT);
    const GLB bf16_t* qp = QKV + ((size_t)b * SEQ + q0 + c) * 3072 + h * 128 + 8 * hh;
    bf16x8 qf[8];
#pragma unroll
    for (int ks = 0; ks < 8; ++ks) qf[ks] = *(const GLB bf16x8*)(qp + 16 * ks);
    f32x16 O[4];
#pragma unroll
    for (int db = 0; db < 4; ++db)
#pragma unroll
        for (int r = 0; r < 16; ++r) O[db][r] = 0.f;
    float carry = 1.0f;
    const int km = 16 * ((c >> 2) & 1) + 4 * (c >> 3) + (c & 3);
    const GLB bf16_t* kbase = QKV + ((size_t)b * SEQ + km) * 3072 + 1024 + h * 128 + 8 * hh;
    const GLB bf16_t* vbase = VT + ((size_t)bh * 128 + c) * SEQ + 16 * hh;
    bf16x8 kf[8];
#pragma unroll
    for (int ks = 0; ks < 8; ++ks) kf[ks] = *(const GLB bf16x8*)(kbase + (size_t)q0 * 3072 + 16 * ks);
    for (int kt = qb; kt >= 0; --kt) {
        const int k0 = 32 * kt;
        bf16x8 vf[2][4];
#pragma unroll
        for (int s = 0; s < 2; ++s)
#pragma unroll
            for (int db = 0; db < 4; ++db) vf[s][db] = *(const GLB bf16x8*)(vbase + (size_t)(32 * db) * SEQ + k0 + 8 * s);
        f32x16 S;
#pragma unroll
        for (int r = 0; r < 16; ++r) S[r] = 0.f;
#pragma unroll
        for (int ks = 0; ks < 8; ++ks) S = __builtin_amdgcn_mfma_f32_32x32x16_bf16(kf[ks], qf[ks], S, 0, 0, 0);
        if (kt > 0) {
#pragma unroll
            for (int ks = 0; ks < 8; ++ks) kf[ks] = *(const GLB bf16x8*)(kbase + (size_t)(k0 - 32) * 3072 + 16 * ks);
        }
        const bool diag = (kt == qb);
        float w[16]; float sp = 1.0f;
#pragma unroll
        for (int r = 15; r >= 0; --r) {
            const float e = __builtin_amdgcn_exp2f(fminf(S[r] * -0.12751743074602535f, 115.0f)), rr = __builtin_amdgcn_rcpf(1.0f + e), er = e * rr;
            const bool valid = !diag || (16 * hh + r < c);
            const float beta = valid ? rr : 0.f, om = valid ? er : 1.0f;
            w[r] = beta * sp; sp *= om;
        }
        const float tot_other = __shfl_xor(sp, 32);
        const float pre = carry * (hh == 0 ? tot_other : 1.0f);
        carry *= sp * tot_other;
        const bool live = __ballot(carry >= 1.0e-30f) != 0ull;
        bf16x8 pw[2];
#pragma unroll
        for (int s = 0; s < 2; ++s) { u32x4 t; t.x = pk2(w[8 * s] * pre, w[8 * s + 1] * pre); t.y = pk2(w[8 * s + 2] * pre, w[8 * s + 3] * pre);
            t.z = pk2(w[8 * s + 4] * pre, w[8 * s + 5] * pre); t.w = pk2(w[8 * s + 6] * pre, w[8 * s + 7] * pre); pw[s] = __builtin_bit_cast(bf16x8, t); }
#pragma unroll
        for (int s = 0; s < 2; ++s)
#pragma unroll
            for (int db = 0; db < 4; ++db) O[db] = __builtin_amdgcn_mfma_f32_32x32x16_bf16(vf[s][db], pw[s], O[db], 0, 0, 0);
        if (!live) break;
    }
    GLB bf16_t* yp = WSP(bf16_t, WS_Y) + ((size_t)b * SEQ + q0 + c) * 4096 + h * 128 + 4 * hh;
#pragma unroll
    for (int db = 0; db < 4; ++db)
#pragma unroll
        for (int a = 0; a < 4; ++a) { u32x2 o; o.x = pk2(O[db][4 * a], O[db][4 * a + 1]); o.y = pk2(O[db][4 * a + 2], O[db][4 * a + 3]);
            *(GLB u32x2*)(yp + 32 * db + 8 * a) = o; }
}
__device__ __forceinline__ void ph_sb_fast(const Ctx& C) {
    int lane = C.lane; asm volatile("" : "+v"(lane)); lane &= 63;
    const int pi = blockIdx.x * 4 + (C.wave & 3);
    if (pi < 1024) { const int bh = pi >> 5, j = pi & 31; sb_item(C, lane, bh, (C.wave >> 2) ? 63 - j : j); }
}

#ifndef SWA_OUT_OFF
#define SWA_OUT_OFF WS_Y
#endif
__device__ __forceinline__ void swa_item(const Ctx& C, int lane, int l, int b, int h, int tb) {
    const int c = lane & 31, hh = lane >> 5, t0 = 32 * tb, kvh = h >> 3;
    const GLB bf16_t* qp = WSP(bf16_t, WS_QS) + ((size_t)b * SEQ + t0 + c) * 1024 + h * 64 + 8 * hh;
    bf16x8 qf[4];
#pragma unroll
    for (int ks = 0; ks < 4; ++ks) qf[ks] = *(const GLB bf16x8*)(qp + 16 * ks);
    const int km = 16 * ((c >> 2) & 1) + 4 * (c >> 3) + (c & 3);
    const GLB bf16_t* kbase = WSP(bf16_t, WS_KS) + ((size_t)b * SEQ + km) * 128 + kvh * 64 + 8 * hh;
    const GLB bf16_t* vbase = WSP(bf16_t, WS_SWVT) + ((size_t)(b * 2 + kvh) * 64 + c) * SEQ + 16 * hh;
    float mrun = INF32(I_SSINK)[l * 16 + h], lrun = 1.0f;
    f32x16 O[2];
#pragma unroll
    for (int db = 0; db < 2; ++db)
#pragma unroll
        for (int r = 0; r < 16; ++r) O[db][r] = 0.f;
    const int i0 = (tb >= 4) ? 0 : 4 - tb;
    for (int i = i0; i < 5; ++i) {
        const int k0 = t0 - 128 + 32 * i;
        bf16x8 kf[4], vf[2][2];
#pragma unroll
        for (int ks = 0; ks < 4; ++ks) kf[ks] = *(const GLB bf16x8*)(kbase + (size_t)k0 * 128 + 16 * ks);
#pragma unroll
        for (int s = 0; s < 2; ++s)
#pragma unroll
            for (int db = 0; db < 2; ++db) vf[s][db] = *(const GLB bf16x8*)(vbase + (size_t)(32 * db) * SEQ + k0 + 8 * s);
        f32x16 a;
#pragma unroll
        for (int r = 0; r < 16; ++r) a[r] = 0.f;
#pragma unroll
        for (int ks = 0; ks < 4; ++ks) a = __builtin_amdgcn_mfma_f32_32x32x16_bf16(kf[ks], qf[ks], a, 0, 0, 0);
        float tmax = -1.0e30f;
#pragma unroll
        for (int r = 0; r < 16; ++r) { const int kr = 16 * hh + r; const bool valid = (i == 0) ? (kr > c) : ((i == 4) ? (kr <= c) : true); a[r] = valid ? a[r] * 0.125f : -1.0e30f; tmax = fmaxf(tmax, a[r]); }
        tmax = fmaxf(tmax, __shfl_xor(tmax, 32));
        const float mnew = fmaxf(mrun, tmax), alpha = __expf(mrun - mnew);
        float psum = 0.f;
#pragma unroll
        for (int r = 0; r < 16; ++r) { a[r] = __expf(a[r] - mnew); psum += a[r]; }
        psum += __shfl_xor(psum, 32);
        lrun = lrun * alpha + psum; mrun = mnew;
#pragma unroll
        for (int db = 0; db < 2; ++db)
#pragma unroll
            for (int r = 0; r < 16; ++r) O[db][r] *= alpha;
#pragma unroll
        for (int s = 0; s < 2; ++s) {
            u32x4 t; t.x = pk2(a[8 * s], a[8 * s + 1]); t.y = pk2(a[8 * s + 2], a[8 * s + 3]); t.z = pk2(a[8 * s + 4], a[8 * s + 5]); t.w = pk2(a[8 * s + 6], a[8 * s + 7]);
            const bf16x8 pw = __builtin_bit_cast(bf16x8, t);
#pragma unroll
            for (int db = 0; db < 2; ++db) O[db] = __builtin_amdgcn_mfma_f32_32x32x16_bf16(vf[s][db], pw, O[db], 0, 0, 0);
        }
    }
    const float inv = 1.0f / lrun;
    GLB bf16_t* yp = WSP(bf16_t, SWA_OUT_OFF) + ((size_t)b * SEQ + t0 + c) * 4096 + 3072 + h * 64 + 4 * hh;
#pragma unroll
    for (int db = 0; db < 2; ++db)
#pragma unroll
        for (int a4 = 0; a4 < 4; ++a4) { u32x2 o; o.x = pk2(O[db][4 * a4] * inv, O[db][4 * a4 + 1] * inv); o.y = pk2(O[db][4 * a4 + 2] * inv, O[db][4 * a4 + 3] * inv);
            *(GLB u32x2*)(yp + 32 * db + 8 * a4) = o; }
}
__device__ __forceinline__ void ph_swa_fast(const Ctx& C, int l) {
    int lane = C.lane; asm volatile("" : "+v"(lane)); lane &= 63;
    if (C.wave >= 4) return;
    for (int it = blockIdx.x * 4 + C.wave; it < NB * 64 * 16; it += C.G * 4) { const int h = it & 15, tb = (it >> 4) & 63, b = it >> 10; swa_item(C, lane, l, b, h, tb); }
}

__device__ __forceinline__ float row16_sum(float x) {
    x += __builtin_bit_cast(float, __builtin_amdgcn_mov_dpp(__builtin_bit_cast(int, x), 0x128, 0xf, 0xf, true));
    x += __builtin_bit_cast(float, __builtin_amdgcn_mov_dpp(__builtin_bit_cast(int, x), 0x124, 0xf, 0xf, true));
    x += __builtin_bit_cast(float, __builtin_amdgcn_mov_dpp(__builtin_bit_cast(int, x), 0x122, 0xf, 0xf, true));
    x += __builtin_bit_cast(float, __builtin_amdgcn_mov_dpp(__builtin_bit_cast(int, x), 0x121, 0xf, 0xf, true));
    return x;
}
__device__ __forceinline__ void ph_rwkv_scan_fast(const Ctx& C) {
    int tid = C.tid; asm volatile("" : "+v"(tid));
    const int lane = tid & 63, wave = C.wave;
    LAS float* buf = (LAS float*)C.lds;
    constexpr int CH = 32, CHF = CH * 384;
    for (int it = blockIdx.x; it < NB * 16 * 4; it += C.G) {
        const int qr = it & 3, h = (it >> 2) & 15, b = it >> 6;
        const size_t gbase = (size_t)b * SEQ * 1024 + h * 64;
        const int ro = lane >> 4, kq = lane & 15, row = 16 * qr + 4 * (wave & 3) + ro;
        float S0 = 0.f, S1 = 0.f, S2 = 0.f, S3 = 0.f;
        const int lj = tid - 256;
        auto load_chunk = [&](int cidx) {
            f32x4 v[12];
#pragma unroll
            for (int i = 0; i < 12; ++i) { const int idx = lj + 256 * i, step = idx / 96, rem = idx - step * 96, vec = rem >> 4, e4 = rem & 15;
                const size_t off = (vec == 0) ? WS_R : (vec == 1) ? WS_DEC : (vec == 2) ? WS_K : (vec == 3) ? WS_KK : (vec == 4) ? WS_AA : WS_V;
                v[i] = *(const GLB f32x4*)(WSP(float, off) + gbase + (size_t)(cidx * CH + step) * 1024 + 4 * e4); }
            LAS float* d = buf + (cidx & 1) * CHF;
#pragma unroll
            for (int i = 0; i < 12; ++i) { const int idx = lj + 256 * i, step = idx / 96, rem = idx - step * 96; *(LAS f32x4*)(d + step * 384 + rem * 4) = v[i]; }
        };
        if (wave >= 4) load_chunk(0);
        LDS_WAIT(); __syncthreads();
        for (int cidx = 0; cidx < SEQ / CH; ++cidx) {
            if (wave >= 4) { if (cidx + 1 < SEQ / CH) load_chunk(cidx + 1); }
            else {
                const LAS float* cb = buf + (cidx & 1) * CHF;
#pragma unroll 4
                for (int st = 0; st < CH; ++st) {
                    const LAS float* rb = cb + st * 384;
                    const f32x4 kk4 = *(const LAS f32x4*)(rb + 192 + 4 * kq);
                    const float p = row16_sum(S0 * kk4[0] + S1 * kk4[1] + S2 * kk4[2] + S3 * kk4[3]);
                    const f32x4 w4 = *(const LAS f32x4*)(rb + 64 + 4 * kq), b4 = *(const LAS f32x4*)(rb + 256 + 4 * kq), k4 = *(const LAS f32x4*)(rb + 128 + 4 * kq), r4 = *(const LAS f32x4*)(rb + 4 * kq);
                    const float vv = rb[320 + row];
                    S0 = S0 * w4[0] - p * b4[0] + vv * k4[0]; S1 = S1 * w4[1] - p * b4[1] + vv * k4[1]; S2 = S2 * w4[2] - p * b4[2] + vv * k4[2]; S3 = S3 * w4[3] - p * b4[3] + vv * k4[3];
                    const float y = row16_sum(S0 * r4[0] + S1 * r4[1] + S2 * r4[2] + S3 * r4[3]);
                    if (kq == 0) WSP(float, WS_YRAW)[gbase + (size_t)(cidx * CH + st) * 1024 + row] = y;
                }
            }
            LDS_WAIT(); __syncthreads();
        }
    }
}

__device__ __forceinline__ void dsa_item(const Ctx& C, int lane, int wave, int b, int g) {
    const int c = lane & 31, hh = lane >> 5, t0 = 4 * g;
    LAS float* sc = (LAS float*)(C.lds + wave * 17408);
    LAS unsigned* bm = (LAS unsigned*)(C.lds + wave * 17408 + 16384);
    const size_t bm0 = (size_t)b * SEQ;
    const int ntile = (t0 + 3) / 32 + 1;
#pragma unroll 1
    for (int p = 0; p < 2; ++p) {
        {
            const int qq = t0 + 2 * p + ((c >> 2) & 1), hd = (c & 3) + 4 * (c >> 3);
            const GLB bf16_t* qp = WSP(bf16_t, WS_QI) + (bm0 + qq) * 1024 + hd * 64 + 8 * hh;
            bf16x8 qf[4];
#pragma unroll
            for (int ks = 0; ks < 4; ++ks) qf[ks] = *(const GLB bf16x8*)(qp + 16 * ks);
            const GLB float* wp = WSP(float, WS_WI) + (bm0 + t0 + 2 * p + hh) * 16;
            f32x4 w4[4];
#pragma unroll
            for (int j = 0; j < 4; ++j) w4[j] = *(const GLB f32x4*)(wp + 4 * j);
            const GLB bf16_t* kp = WSP(bf16_t, WS_KI) + (bm0 + c) * 64 + 8 * hh;
            bf16x8 kf[4];
#pragma unroll
            for (int ks = 0; ks < 4; ++ks) kf[ks] = *(const GLB bf16x8*)(kp + 16 * ks);
            for (int kt = 0; kt < ntile; ++kt) {
                f32x16 a;
#pragma unroll
                for (int r = 0; r < 16; ++r) a[r] = 0.f;
#pragma unroll
                for (int ks = 0; ks < 4; ++ks) a = __builtin_amdgcn_mfma_f32_32x32x16_bf16(qf[ks], kf[ks], a, 0, 0, 0);
                if (kt + 1 < ntile) {
#pragma unroll
                    for (int ks = 0; ks < 4; ++ks) kf[ks] = *(const GLB bf16x8*)(kp + (size_t)(32 * (kt + 1)) * 64 + 16 * ks);
                }
                float s = 0.f;
#pragma unroll
                for (int r = 0; r < 16; ++r) s += w4[r >> 2][r & 3] * fmaxf(a[r], 0.f);
                sc[hh * 2048 + 32 * kt + c] = s;
            }
        }
        LDS_WAIT();
#pragma unroll 1
        for (int qs = 0; qs < 2; ++qs) {
            const int t = t0 + 2 * p + qs, n = t + 1;
            const LAS float* sq = sc + qs * 2048;
            unsigned myword_lo = 0u, myword_hi = 0u;
            if (n <= 256) {
#pragma unroll
                for (int i = 0; i < 4; ++i) { const unsigned long long bal = __ballot(lane + 64 * i < n); if (lane == i) { myword_lo = (unsigned)bal; myword_hi = (unsigned)(bal >> 32); } }
            } else {
                unsigned key[32];
#pragma unroll
                for (int i = 0; i < 32; ++i) { const int s = lane + 64 * i; key[i] = (s < n) ? ordkey(sq[s]) : 0u; }
                unsigned tau = 0u;
                for (int bit = 31; bit >= 0; --bit) {
                    const unsigned cand = tau | (1u << bit); int cl = 0;
#pragma unroll
                    for (int i = 0; i < 32; ++i) cl += (key[i] >= cand) ? 1 : 0;
                    const int cnt = wave_isum(cl);
                    if (cnt >= 256) { tau = cand; if (cnt == 256) break; }
                }
                int cgl = 0;
#pragma unroll
                for (int i = 0; i < 32; ++i) cgl += (key[i] > tau) ? 1 : 0;
                const int cgt = wave_isum(cgl);
                const int need = 256 - cgt; int eqbase = 0;
                const unsigned long long lt = (1ull << lane) - 1ull;
#pragma unroll
                for (int i = 0; i < 32; ++i) {
                    const bool gt = key[i] > tau, eq = key[i] == tau;
                    const unsigned long long beq = __ballot(eq);
                    const bool sel = gt || (eq && (eqbase + __popcll(beq & lt)) < need);
                    const unsigned long long bal = __ballot(sel);
                    if (lane == i) { myword_lo = (unsigned)bal; myword_hi = (unsigned)(bal >> 32); }
                    eqbase += __popcll(beq);
                }
            }
            if (lane < 32) { bm[(2 * p + qs) * 64 + 2 * lane] = myword_lo; bm[(2 * p + qs) * 64 + 2 * lane + 1] = myword_hi; }
        }
        LDS_WAIT();
    }
    const int cq = c >> 3, ch = c & 7;
    const GLB bf16_t* qp = WSP(bf16_t, WS_QD) + (bm0 + t0 + cq) * 1024 + ch * 128 + 8 * hh;
    bf16x8 qf[8];
#pragma unroll
    for (int ks = 0; ks < 8; ++ks) qf[ks] = *(const GLB bf16x8*)(qp + 16 * ks);
    const int km = 16 * ((c >> 2) & 1) + 4 * (c >> 3) + (c & 3);
    const GLB bf16_t* kbase = WSP(bf16_t, WS_KD) + (bm0 + km) * 128 + 8 * hh;
    const GLB bf16_t* vbase = WSP(bf16_t, WS_VDT) + ((size_t)b * 128 + c) * SEQ + 16 * hh;
    const LAS unsigned short* bmh = (const LAS unsigned short*)(bm + cq * 64) + hh;
    float mrun = -1.0e20f, lrun = 0.f;
    f32x16 O[4];
#pragma unroll
    for (int db = 0; db < 4; ++db)
#pragma unroll
        for (int r = 0; r < 16; ++r) O[db][r] = 0.f;
    bf16x8 kf[8];
#pragma unroll
    for (int ks = 0; ks < 8; ++ks) kf[ks] = *(const GLB bf16x8*)(kbase + 16 * ks);
    for (int kt = 0; kt < ntile; ++kt) {
        const int k0 = 32 * kt;
        bf16x8 vf[2][4];
#pragma unroll
        for (int s = 0; s < 2; ++s)
#pragma unroll
            for (int db = 0; db < 4; ++db) vf[s][db] = *(const GLB bf16x8*)(vbase + (size_t)(32 * db) * SEQ + k0 + 8 * s);
        const unsigned bits = bmh[2 * kt];
        f32x16 a;
#pragma unroll
        for (int r = 0; r < 16; ++r) a[r] = 0.f;
#pragma unroll
        for (int ks = 0; ks < 8; ++ks) a = __builtin_amdgcn_mfma_f32_32x32x16_bf16(kf[ks], qf[ks], a, 0, 0, 0);
        if (kt + 1 < ntile) {
#pragma unroll
            for (int ks = 0; ks < 8; ++ks) kf[ks] = *(const GLB bf16x8*)(kbase + (size_t)(k0 + 32) * 128 + 16 * ks);
        }
        float tmax = -1.0e30f;
#pragma unroll
        for (int r = 0; r < 16; ++r) { a[r] = ((bits >> r) & 1u) ? a[r] * 0.08838834764831845f : -1.0e30f; tmax = fmaxf(tmax, a[r]); }
        tmax = fmaxf(tmax, __shfl_xor(tmax, 32));
        if (__ballot(tmax > mrun + 8.0f) != 0ull) {
            const float mnew = fmaxf(mrun, tmax), alpha = __expf(mrun - mnew);
            lrun *= alpha; mrun = mnew;
#pragma unroll
            for (int db = 0; db < 4; ++db)
#pragma unroll
                for (int r = 0; r < 16; ++r) O[db][r] *= alpha;
        }
        float psum = 0.f;
#pragma unroll
        for (int r = 0; r < 16; ++r) { a[r] = __expf(a[r] - mrun); psum += a[r]; }
        psum += __shfl_xor(psum, 32);
        lrun += psum;
#pragma unroll
        for (int s = 0; s < 2; ++s) {
            u32x4 t; t.x = pk2(a[8 * s], a[8 * s + 1]); t.y = pk2(a[8 * s + 2], a[8 * s + 3]); t.z = pk2(a[8 * s + 4], a[8 * s + 5]); t.w = pk2(a[8 * s + 6], a[8 * s + 7]);
            const bf16x8 pw = __builtin_bit_cast(bf16x8, t);
#pragma unroll
            for (int db = 0; db < 4; ++db) O[db] = __builtin_amdgcn_mfma_f32_32x32x16_bf16(vf[s][db], pw, O[db], 0, 0, 0);
        }
    }
    const float inv = 1.0f / lrun;
    GLB bf16_t* yp = WSP(bf16_t, WS_Y) + (bm0 + t0 + cq) * 4096 + 2048 + ch * 128 + 4 * hh;
#pragma unroll
    for (int db = 0; db < 4; ++db)
#pragma unroll
        for (int a4 = 0; a4 < 4; ++a4) { u32x2 o; o.x = pk2(O[db][4 * a4] * inv, O[db][4 * a4 + 1] * inv); o.y = pk2(O[db][4 * a4 + 2] * inv, O[db][4 * a4 + 3] * inv);
            *(GLB u32x2*)(yp + 32 * db + 8 * a4) = o; }
    LDS_WAIT();
}
__device__ __forceinline__ void ph_dsa_fast(const Ctx& C) {
    int lane = C.lane; asm volatile("" : "+v"(lane)); lane &= 63;
    const int pi = blockIdx.x * 4 + (C.wave & 3);
    if (pi < 1024) { const int b = pi >> 8, j = pi & 255; dsa_item(C, lane, C.wave, b, (C.wave >> 2) ? 511 - j : j); }
}

constexpr int SCAN_CNT_OFF = MISC_OFF + 64;
__device__ __forceinline__ void ph_rwkv_scan_conv(const Ctx& C, int l) {
    int tid = C.tid; asm volatile("" : "+v"(tid));
    const int lane = tid & 63, wave = C.wave;
    if (wave >= 4) {
        LAS float* scr = (LAS float*)(C.lds + 65536 + (wave - 4) * 16640);
        constexpr int PER = MOE_CONV_ITEMS / 2 / 1024;
        const int first = l * (MOE_CONV_ITEMS / 2) + (blockIdx.x * 4 + (wave - 4)) * PER;
        if (!MOE_CONV_IN_PROLOGUE && blockIdx.x < 256)
            for (int i = 0; i < PER; ++i) conv_moe_item(C, first + i, scr, lane);
        return;
    }
    constexpr int CH = 16, CHF = CH * 384, NCH = SEQ / CH;
    LAS float* buf = (LAS float*)C.lds;
    volatile LAS unsigned* cnt = (volatile LAS unsigned*)(C.lds + SCAN_CNT_OFF);
    const int it = blockIdx.x;
    if (it >= NB * 16 * 4) return;
    const int qr = it & 3, h = (it >> 2) & 15, b = it >> 6;
    const size_t gbase = (size_t)b * SEQ * 1024 + h * 64;
    const int ro = lane >> 4, kq = lane & 15, row = 16 * qr + 4 * wave + ro;
    unsigned target = (unsigned)l * 4u * (NCH + 1);
    auto issue = [&](int cidx) {
#pragma unroll
        for (int j = 0; j < 6; ++j) { const int i = wave + 4 * j, rho = 4 * i + ro, step = rho / 6, vec = rho - 6 * step;
            const size_t off = (vec == 0) ? WS_R : (vec == 1) ? WS_DEC : (vec == 2) ? WS_K : (vec == 3) ? WS_KK : (vec == 4) ? WS_AA : WS_V;
            const GLB float* src = WSP(float, off) + gbase + (size_t)(cidx * CH + step) * 1024 + 4 * kq;
            __builtin_amdgcn_global_load_lds((const GLB unsigned*)src, (LAS unsigned*)(buf + (cidx & 1) * CHF + i * 256), 16, 0, 0); }
    };
    auto arrive_wait = [&]() {
        asm volatile("s_waitcnt vmcnt(0)" ::: "memory");
        target += 4u;
        if (lane == 0) (void)__hip_atomic_fetch_add((LAS unsigned*)(C.lds + SCAN_CNT_OFF), 1u, __ATOMIC_RELAXED, __HIP_MEMORY_SCOPE_WORKGROUP);
        while ((int)(*cnt - target) < 0) __builtin_amdgcn_s_sleep(1);
        asm volatile("" ::: "memory");
    };
    float S0 = 0.f, S1 = 0.f, S2 = 0.f, S3 = 0.f;
    issue(0); arrive_wait();
    for (int cidx = 0; cidx < NCH; ++cidx) {
        if (cidx + 1 < NCH) issue(cidx + 1);
        const LAS float* cb = buf + (cidx & 1) * CHF;
#pragma unroll 4
        for (int st = 0; st < CH; ++st) {
            const LAS float* rb = cb + st * 384;
            const f32x4 kk4 = *(const LAS f32x4*)(rb + 192 + 4 * kq);
            const float p = row16_sum(S0 * kk4[0] + S1 * kk4[1] + S2 * kk4[2] + S3 * kk4[3]);
            const f32x4 w4 = *(const LAS f32x4*)(rb + 64 + 4 * kq), b4 = *(const LAS f32x4*)(rb + 256 + 4 * kq), k4 = *(const LAS f32x4*)(rb + 128 + 4 * kq), r4 = *(const LAS f32x4*)(rb + 4 * kq);
            const float vv = rb[320 + row];
            S0 = S0 * w4[0] - p * b4[0] + vv * k4[0]; S1 = S1 * w4[1] - p * b4[1] + vv * k4[1]; S2 = S2 * w4[2] - p * b4[2] + vv * k4[2]; S3 = S3 * w4[3] - p * b4[3] + vv * k4[3];
            const float y = row16_sum(S0 * r4[0] + S1 * r4[1] + S2 * r4[2] + S3 * r4[3]);
            if (kq == 0) WSP(float, WS_YRAW)[gbase + (size_t)(cidx * CH + st) * 1024 + row] = y;
        }
        asm volatile("s_waitcnt lgkmcnt(0)" ::: "memory");
        arrive_wait();
    }
}

#ifndef SCAN3_CONV_MODE
#define SCAN3_CONV_MODE 0
#endif
#ifndef CONV_NT
#define CONV_NT 0
#endif
__device__ __forceinline__ void conv_tile_load(const GLB float* W, int ldw, int k0, int s0, f32x4 (&v)[16], int lane) {
    const int cq = lane & 15, rq = lane >> 4;
    const unsigned loff = (unsigned)(rq * ldw + 4 * cq);
    const GLB float* base = W + (size_t)k0 * ldw + s0;
#pragma unroll
    for (int i = 0; i < 16; ++i) { const GLB float* rowp = base + (size_t)(4 * i) * ldw; v[i] = CONV_NT ? __builtin_nontemporal_load((const GLB f32x4*)(rowp + loff)) : *(const GLB f32x4*)(rowp + loff); }
}
__device__ __forceinline__ void conv_tile_to_lds(const f32x4 (&v)[16], LAS float* scr, int lane) {
    const int cq = lane & 15, rq = lane >> 4;
#pragma unroll
    for (int i = 0; i < 16; ++i) { const int kk = 4 * i + rq; LAS float* d = scr + kk * 65 + 4 * cq; d[0] = v[i][0]; d[1] = v[i][1]; d[2] = v[i][2]; d[3] = v[i][3]; }
}
__device__ __forceinline__ void conv_tile_from_lds(GLB bf16_t* Bt, int K, int n0, int k0, LAS float* scr, int lane) {
    const int c = lane & 7;
#pragma unroll
    for (int j = 0; j < 8; ++j) { const int n = (lane >> 3) + 8 * j; const LAS float* s = scr + (8 * c) * 65 + n;
        u32x4 o; o.x = pk2(s[0 * 65], s[1 * 65]); o.y = pk2(s[2 * 65], s[3 * 65]); o.z = pk2(s[4 * 65], s[5 * 65]); o.w = pk2(s[6 * 65], s[7 * 65]);
        if (CONV_NT & 2) __builtin_nontemporal_store(o, (GLB u32x4*)(Bt + (size_t)(n0 + n) * K + k0 + 8 * c)); else *(GLB u32x4*)(Bt + (size_t)(n0 + n) * K + k0 + 8 * c) = o; }
}
__device__ __forceinline__ void conv_tile_finish(const f32x4 (&v)[16], GLB bf16_t* Bt, int K, int n0, int k0, LAS float* scr, int lane) {
    conv_tile_to_lds(v, scr, lane); LDS_WAIT(); conv_tile_from_lds(Bt, K, n0, k0, scr, lane); LDS_WAIT();
}
struct MoeTile { const GLB float* W; GLB bf16_t* Bt; int ldw, K, k0, s0, n0; };
__device__ __forceinline__ MoeTile moe_tile_desc(const Ctx& C, int idx) {
    constexpr int I_GU1 = (D / 64) * (2 * FF / 64), I_DN1 = (FF / 64) * (D / 64);
    MoeTile t;
    if (idx < NE * I_GU1) {
        const int e = idx / I_GU1, r = idx % I_GU1, nb = r % (2 * FF / 64), kb = r / (2 * FF / 64), tile = nb >> 2, q = nb & 3;
        t.W = ((q < 2) ? INF32(I_MG) : INF32(I_MU)) + (size_t)e * D * FF; t.ldw = FF; t.k0 = 64 * kb; t.s0 = 128 * tile + 64 * (q & 1);
        t.Bt = WSP(bf16_t, WS_MWGU) + (size_t)e * 2 * FF * D; t.K = D; t.n0 = 64 * nb;
    } else {
        const int r0 = idx - NE * I_GU1, e = r0 / I_DN1, r = r0 % I_DN1, nb = r % 32, kb = r / 32;
        t.W = INF32(I_MD) + (size_t)e * FF * D; t.ldw = D; t.k0 = 64 * kb; t.s0 = 64 * nb; t.Bt = WSP(bf16_t, WS_MWD) + (size_t)e * D * FF; t.K = FF; t.n0 = 64 * nb;
    }
    return t;
}
__device__ __forceinline__ void ph_rwkv_scan4(const Ctx& C, int l) {
    int tid = C.tid; asm volatile("" : "+v"(tid));
    const int lane = tid & 63, wave = C.wave;
    if (wave >= 4) {
        if (MOE_CONV_IN_PROLOGUE || blockIdx.x >= 256) return;
        LAS float* scr = (LAS float*)(C.lds + 65536 + (wave - 4) * 16640);
        constexpr int PER = MOE_CONV_ITEMS / 2 / 1024;
        const int first = l * (MOE_CONV_ITEMS / 2) + (blockIdx.x * 4 + (wave - 4)) * PER;
        f32x4 va[16], vb[16];
        MoeTile ta = moe_tile_desc(C, first), tb;
        conv_tile_load(ta.W, ta.ldw, ta.k0, ta.s0, va, lane);
        for (int i = 0; i < PER; i += 2) {
            tb = moe_tile_desc(C, first + i + 1);
            conv_tile_load(tb.W, tb.ldw, tb.k0, tb.s0, vb, lane);
            conv_tile_finish(va, ta.Bt, ta.K, ta.n0, ta.k0, scr, lane);
            if (i + 2 < PER) { ta = moe_tile_desc(C, first + i + 2); conv_tile_load(ta.W, ta.ldw, ta.k0, ta.s0, va, lane); }
            conv_tile_finish(vb, tb.Bt, tb.K, tb.n0, tb.k0, scr, lane);
        }
        return;
    }
    constexpr int CH = 16, CHF = CH * 384, NCH = SEQ / CH;
    LAS float* buf = (LAS float*)C.lds;
    LAS float* ybuf = (LAS float*)(C.lds + 49152);
    volatile LAS unsigned* cnt = (volatile LAS unsigned*)(C.lds + SCAN_CNT_OFF);
    const int it = blockIdx.x;
    if (it >= NB * 16 * 4) return;
    const int qr = it & 3, h = (it >> 2) & 15, b = it >> 6;
    const size_t gbase = (size_t)b * SEQ * 1024 + h * 64;
    const int ro = lane >> 4, kq = lane & 15, rloc = 4 * wave + ro;
    unsigned target = (unsigned)l * 4u * (NCH + 1);
    auto issue = [&](int cidx) {
#pragma unroll
        for (int j = 0; j < 6; ++j) { const int i = wave + 4 * j, rho = 4 * i + ro, step = rho / 6, vec = rho - 6 * step;
            const size_t off = (vec == 0) ? WS_R : (vec == 1) ? WS_DEC : (vec == 2) ? WS_K : (vec == 3) ? WS_KK : (vec == 4) ? WS_AA : WS_V;
            const GLB float* src = WSP(float, off) + gbase + (size_t)(cidx * CH + step) * 1024 + 4 * kq;
            __builtin_amdgcn_global_load_lds((const GLB unsigned*)src, (LAS unsigned*)(buf + (cidx & 1) * CHF + i * 256), 16, 0, 0); }
    };
    auto arrive_wait = [&]() {
        asm volatile("s_waitcnt vmcnt(0) lgkmcnt(0)" ::: "memory");
        target += 4u;
        if (lane == 0) (void)__hip_atomic_fetch_add((LAS unsigned*)(C.lds + SCAN_CNT_OFF), 1u, __ATOMIC_RELAXED, __HIP_MEMORY_SCOPE_WORKGROUP);
        while ((int)(*cnt - target) < 0) __builtin_amdgcn_s_sleep(1);
        asm volatile("" ::: "memory");
    };
    auto flush_y = [&](int cidx) {
        const int st = lane >> 2, r = lane & 3;
        WSP(float, WS_YRAW)[gbase + (size_t)(cidx * CH + st) * 1024 + 16 * qr + 4 * wave + r] = ybuf[(cidx & 1) * 256 + st * 16 + 4 * wave + r];
    };
    f32x2 Sa = {0.f, 0.f}, Sb = {0.f, 0.f};
    issue(0); arrive_wait();
    for (int cidx = 0; cidx < NCH; ++cidx) {
        if (cidx > 0) flush_y(cidx - 1);
        if (cidx + 1 < NCH) issue(cidx + 1);
        const LAS float* cb = buf + (cidx & 1) * CHF;
        LAS float* yb = ybuf + (cidx & 1) * 256;
#pragma unroll 4
        for (int st = 0; st < CH; ++st) {
            const LAS float* rb = cb + st * 384;
            const f32x4 kk4 = *(const LAS f32x4*)(rb + 192 + 4 * kq);
            const f32x2 tp = Sa * (f32x2){kk4[0], kk4[1]} + Sb * (f32x2){kk4[2], kk4[3]};
            const float p = row16_sum(tp[0] + tp[1]);
            const f32x4 w4 = *(const LAS f32x4*)(rb + 64 + 4 * kq), b4 = *(const LAS f32x4*)(rb + 256 + 4 * kq), k4 = *(const LAS f32x4*)(rb + 128 + 4 * kq), r4 = *(const LAS f32x4*)(rb + 4 * kq);
            const float vv = rb[320 + 16 * qr + rloc];
            const f32x2 pp = {p, p}, vv2 = {vv, vv};
            Sa = Sa * (f32x2){w4[0], w4[1]} - pp * (f32x2){b4[0], b4[1]} + vv2 * (f32x2){k4[0], k4[1]};
            Sb = Sb * (f32x2){w4[2], w4[3]} - pp * (f32x2){b4[2], b4[3]} + vv2 * (f32x2){k4[2], k4[3]};
            const f32x2 ty = Sa * (f32x2){r4[0], r4[1]} + Sb * (f32x2){r4[2], r4[3]};
            const float y = row16_sum(ty[0] + ty[1]);
            if (kq == 0) yb[st * 16 + rloc] = y;
        }
        arrive_wait();
    }
    flush_y(NCH - 1);
}

#ifndef SCAN_TOUCH
#define SCAN_TOUCH 1
#endif
#ifndef SCAN_SCHED
#define SCAN_SCHED 1
#endif
#ifndef SCAN_UNROLL
#define SCAN_UNROLL 4
#endif
__device__ __forceinline__ void ph_rwkv_scan3(const Ctx& C, int l) {
    int tid = C.tid; asm volatile("" : "+v"(tid));
    const int lane = tid & 63, wave = C.wave;
    constexpr int CH = 16, CHF = CH * 384, NCH = SEQ / CH;
    LAS float* buf = (LAS float*)C.lds;
    LAS float* ybuf = (LAS float*)(C.lds + 49152);
    LAS float* scr = (LAS float*)(C.lds + 65536 + (wave & 3) * 16640);
    const int it = blockIdx.x;
    if (it >= NB * 16 * 4) return;
    const int qr = it & 3, h = (it >> 2) & 15, b = it >> 6;
    const size_t gbase = (size_t)b * SEQ * 1024 + h * 64;
    const int ro = lane >> 4, kq = lane & 15, rloc = 4 * (wave & 3) + ro;
    const int lj = tid - 256;
    constexpr int PER = MOE_CONV_ITEMS / 2 / 1024;
    static_assert(PER * 1024 * 2 == MOE_CONV_ITEMS && PER * 3 <= NCH, "conversion slots");
    const int cfirst = l * (MOE_CONV_ITEMS / 2) + (blockIdx.x * 4 + (wave & 3)) * PER;
    auto load_chunk = [&](int cidx) {
        f32x4 v[6];
#pragma unroll
        for (int i = 0; i < 6; ++i) { const int idx = lj + 256 * i, step = idx / 96, rem = idx - step * 96, vec = rem >> 4, e4 = rem & 15;
            const size_t off = (vec == 0) ? WS_R : (vec == 1) ? WS_DEC : (vec == 2) ? WS_K : (vec == 3) ? WS_KK : (vec == 4) ? WS_AA : WS_V;
            v[i] = *(const GLB f32x4*)(WSP(float, off) + gbase + (size_t)(cidx * CH + step) * 1024 + 4 * e4); }
        LAS float* d = buf + (cidx & 1) * CHF;
#pragma unroll
        for (int i = 0; i < 6; ++i) { const int idx = lj + 256 * i, step = idx / 96, rem = idx - step * 96; *(LAS f32x4*)(d + step * 384 + rem * 4) = v[i]; }
    };
    auto flush_y = [&](int cidx) {
        const int st = lj >> 4, r = lj & 15;
        WSP(float, WS_YRAW)[gbase + (size_t)(cidx * CH + st) * 1024 + 16 * qr + r] = ybuf[(cidx & 1) * 256 + lj];
    };
    f32x2 Sa = {0.f, 0.f}, Sb = {0.f, 0.f};
    f32x4 cv[16]; MoeTile ct; ct.W = nullptr; ct.Bt = nullptr; ct.ldw = 0; ct.K = 0; ct.k0 = 0; ct.s0 = 0; ct.n0 = 0;
#pragma unroll
    for (int i = 0; i < 16; ++i) cv[i] = (f32x4){0.f, 0.f, 0.f, 0.f};
    if (wave >= 4) load_chunk(0);
    LDS_WAIT(); __syncthreads();
    for (int cidx = 0; cidx < NCH; ++cidx) {
        if (wave >= 4) {
            if (cidx + 1 < NCH) load_chunk(cidx + 1);
            if (cidx > 0) flush_y(cidx - 1);
            if (!MOE_CONV_IN_PROLOGUE) {
                const int q3 = cidx / 3, r3 = cidx - 3 * q3;
                if (r3 == 0 && q3 < PER) { ct = moe_tile_desc(C, cfirst + q3); conv_tile_load(ct.W, ct.ldw, ct.k0, ct.s0, cv, lane); }
                else if (r3 == 1 && q3 < PER) conv_tile_finish(cv, ct.Bt, ct.K, ct.n0, ct.k0, scr, lane);
            }
        } else {
            const LAS float* cb = buf + (cidx & 1) * CHF;
            LAS float* yb = ybuf + (cidx & 1) * 256;
            __builtin_amdgcn_s_setprio(3);
#pragma unroll SCAN_UNROLL
            for (int st = 0; st < CH; ++st) {
                const LAS float* rb = cb + st * 384;
                const f32x4 kk4 = *(const LAS f32x4*)(rb + 192 + 4 * kq);
                const f32x2 tp = Sa * (f32x2){kk4[0], kk4[1]} + Sb * (f32x2){kk4[2], kk4[3]};
                const float p = row16_sum(tp[0] + tp[1]);
                const f32x4 w4 = *(const LAS f32x4*)(rb + 64 + 4 * kq), b4 = *(const LAS f32x4*)(rb + 256 + 4 * kq), k4 = *(const LAS f32x4*)(rb + 128 + 4 * kq), r4 = *(const LAS f32x4*)(rb + 4 * kq);
                const float vv = rb[320 + 16 * qr + rloc];
                const f32x2 pp = {p, p}, vv2 = {vv, vv};
                Sa = Sa * (f32x2){w4[0], w4[1]} - pp * (f32x2){b4[0], b4[1]} + vv2 * (f32x2){k4[0], k4[1]};
                Sb = Sb * (f32x2){w4[2], w4[3]} - pp * (f32x2){b4[2], b4[3]} + vv2 * (f32x2){k4[2], k4[3]};
                const f32x2 ty = Sa * (f32x2){r4[0], r4[1]} + Sb * (f32x2){r4[2], r4[3]};
                const float y = row16_sum(ty[0] + ty[1]);
                if (kq == 0) yb[st * 16 + rloc] = y;
            }
            __builtin_amdgcn_s_setprio(0);
        }
        LDS_WAIT(); __builtin_amdgcn_s_barrier(); asm volatile("" ::: "memory");
    }
    if (wave >= 4) flush_y(NCH - 1);
}


template <int CONV>
__device__ __forceinline__ void ph_rwkv_scan5(const Ctx& C, int l) {
    int tid = C.tid; asm volatile("" : "+v"(tid));
    const int lane = tid & 63, wave = C.wave;
    constexpr int CH = 16, CHF = CH * 384, NCH = SEQ / CH;
    LAS float* buf = (LAS float*)C.lds;
    LAS float* ybuf = (LAS float*)(C.lds + 49152);
    const int it = blockIdx.x;
    if (it >= NB * 16 * 4) return;
    const int qr = it & 3, h = (it >> 2) & 15, b = it >> 6;
    const size_t gbase = (size_t)b * SEQ * 1024 + h * 64;
#define SCAN5_BAR() do { LDS_WAIT(); __builtin_amdgcn_s_barrier(); asm volatile("" ::: "memory"); } while (0)
    if (wave >= 4) {
        LAS float* scr = (LAS float*)(C.lds + 65536 + (wave & 3) * 16640);
        const int lj = tid - 256;
        constexpr int PER = MOE_SCAN_TILES;
        static_assert(PER * 1024 * 2 <= MOE_CONV_ITEMS && PER * 3 + 2 <= NCH && PER % 2 == 0, "conversion slots");
        const int cfirst = ((CONV >= 2) ? 1 : l) * (1024 * PER) + (blockIdx.x * 4 + (wave & 3));
        f32x4 nx[5];
        const unsigned lo_g = (unsigned)((lj >> 4) * 1024 + 4 * (lj & 15));
        const int lo_l = (lj >> 4) * 384 + 4 * (lj & 15);
        const f32x4 kkw = *(const GLB f32x4*)(INF32(I_RWKK) + l * 1024 + h * 64 + 4 * (lj & 15)), kaw = *(const GLB f32x4*)(INF32(I_RWKA) + l * 1024 + h * 64 + 4 * (lj & 15));
        u32x2 nb[4];
        auto fetch_chunk = [&](int cidx) {
            nx[1] = *(const GLB f32x4*)(WSP(float, WS_DEC) + gbase + (size_t)(cidx * CH) * 1024 + lo_g);
#pragma unroll
            for (int i = 0; i < 4; ++i) { const size_t off = (i == 0) ? WS_R : (i == 1) ? WS_K : (i == 2) ? WS_AA : WS_V;
                nb[i] = *(const GLB u32x2*)(WSP(bf16_t, off) + gbase + (size_t)(cidx * CH) * 1024 + lo_g); }
        };
        auto put_chunk = [&](int cidx) {
            LAS float* d = buf + (cidx & 1) * CHF + lo_l;
            asm volatile("" : "+v"(nx[1]), "+v"(nb[0]), "+v"(nb[1]), "+v"(nb[2]), "+v"(nb[3]));
            nx[0] = (f32x4){bflo(nb[0].x), bfhi(nb[0].x), bflo(nb[0].y), bfhi(nb[0].y)}; nx[4] = (f32x4){bflo(nb[3].x), bfhi(nb[3].x), bflo(nb[3].y), bfhi(nb[3].y)};
            const f32x4 kr = (f32x4){bflo(nb[1].x), bfhi(nb[1].x), bflo(nb[1].y), bfhi(nb[1].y)}, av = (f32x4){bflo(nb[2].x), bfhi(nb[2].x), bflo(nb[2].y), bfhi(nb[2].y)};
            f32x4 kk = kr * kkw;
            const float ss = row16_sum((kk[0] * kk[0] + kk[1] * kk[1]) + (kk[2] * kk[2] + kk[3] * kk[3]));
            kk = kk * (1.0f / fmaxf(sqrtf(ss), 1e-12f));
            *(LAS f32x4*)(d) = nx[0]; *(LAS f32x4*)(d + 64) = nx[1]; *(LAS f32x4*)(d + 128) = kr * (1.0f + (av - 1.0f) * kaw);
            *(LAS f32x4*)(d + 192) = kk; *(LAS f32x4*)(d + 256) = kk * av; *(LAS f32x4*)(d + 320) = nx[4];
        };
        auto flush_y = [&](int cidx) {
            const int st = lj >> 4, r = lj & 15;
            WSP(float, WS_YRAW)[gbase + (size_t)(cidx * CH + st) * 1024 + 16 * qr + r] = ybuf[(cidx & 1) * 256 + lj];
        };
#if SCAN_SCHED == 4
        struct FS { f32x4 dec; u32x2 nb[4]; };
        FS fs[6];
        auto fetch2 = [&](int cidx, FS& f) {
            f.dec = *(const GLB f32x4*)(WSP(float, WS_DEC) + gbase + (size_t)(cidx * CH) * 1024 + lo_g);
#pragma unroll
            for (int i = 0; i < 4; ++i) { const size_t off = (i == 0) ? WS_R : (i == 1) ? WS_K : (i == 2) ? WS_AA : WS_V;
                f.nb[i] = *(const GLB u32x2*)(WSP(bf16_t, off) + gbase + (size_t)(cidx * CH) * 1024 + lo_g); }
        };
        auto put2 = [&](int cidx, FS& f) {
            LAS float* d = buf + (cidx & 1) * CHF + lo_l;
            asm volatile("" : "+v"(f.dec), "+v"(f.nb[0]), "+v"(f.nb[1]), "+v"(f.nb[2]), "+v"(f.nb[3]));
            const f32x4 rr = (f32x4){bflo(f.nb[0].x), bfhi(f.nb[0].x), bflo(f.nb[0].y), bfhi(f.nb[0].y)}, vv = (f32x4){bflo(f.nb[3].x), bfhi(f.nb[3].x), bflo(f.nb[3].y), bfhi(f.nb[3].y)};
            const f32x4 kr = (f32x4){bflo(f.nb[1].x), bfhi(f.nb[1].x), bflo(f.nb[1].y), bfhi(f.nb[1].y)}, av = (f32x4){bflo(f.nb[2].x), bfhi(f.nb[2].x), bflo(f.nb[2].y), bfhi(f.nb[2].y)};
            f32x4 kk = kr * kkw;
            const float ss = row16_sum((kk[0] * kk[0] + kk[1] * kk[1]) + (kk[2] * kk[2] + kk[3] * kk[3]));
            kk = kk * (1.0f / fmaxf(sqrtf(ss), 1e-12f));
            *(LAS f32x4*)(d) = rr; *(LAS f32x4*)(d + 64) = f.dec; *(LAS f32x4*)(d + 128) = kr * (1.0f + (av - 1.0f) * kaw);
            *(LAS f32x4*)(d + 192) = kk; *(LAS f32x4*)(d + 256) = kk * av; *(LAS f32x4*)(d + 320) = vv;
        };
        f32x4 cv[16]; MoeTile ct; ct.W = nullptr; ct.Bt = nullptr; ct.ldw = 0; ct.K = 0; ct.k0 = 0; ct.s0 = 0; ct.n0 = 0;
#pragma unroll
        for (int i = 0; i < 16; ++i) cv[i] = (f32x4){0.f, 0.f, 0.f, 0.f};
        {
            const int vit = blockIdx.x * 4 + (wave & 3);
            if (vit < 512) { const int sb = vit & 31, hd = (vit >> 5) & 1, vb = (vit >> 6) & 3;
                if ((vit >> 8) == 0) vt_tile(WSP(bf16_t, WS_VS) + ((size_t)vb * SEQ + 64 * sb) * 128 + 64 * hd, 128, WSP(bf16_t, WS_SWVT) + ((size_t)(vb * 2 + hd) * 64) * SEQ + 64 * sb, (LAS bf16_t*)scr, lane);
                else vt_tile(WSP(bf16_t, WS_VD) + ((size_t)vb * SEQ + 64 * sb) * 128 + 64 * hd, 128, WSP(bf16_t, WS_VDT) + ((size_t)vb * 128 + 64 * hd) * SEQ + 64 * sb, (LAS bf16_t*)scr, lane); }
        }
        static_assert(PER * 3 + 2 == NCH && PER % 2 == 0, "period schedule");
        const int off = (int)((blockIdx.x * 4u + (unsigned)(wave & 3)) & 1u);
        fetch2(0, fs[0]); put2(0, fs[0]); fetch2(1, fs[0]);
        SCAN5_BAR();
        int c = 0;
        for (; c < 1 + off; ++c) { put2(c + 1, fs[0]); fetch2(c + 2, fs[0]); if (c > 0) flush_y(c - 1); SCAN5_BAR(); }
#pragma unroll
        for (int i = 1; i < 6; ++i) fetch2(c + 1 + i, fs[i]);
        asm volatile("; MARK scan5 periodic begin");
        auto period = [&](int j6, bool first) {
#pragma unroll
            for (int m6 = 0; m6 < 6; ++m6) {
                asm volatile("; MARK m6 iter");
                put2(c + 1, fs[m6]); fetch2(c + 7 < NCH ? c + 7 : NCH - 1, fs[m6]); flush_y(c - 1);
                if (!MOE_CONV_IN_PROLOGUE && CONV) {
                    if (m6 == 0) { if (!first) conv_tile_finish(cv, ct.Bt, ct.K, ct.n0, ct.k0, scr, lane);
                        ct = moe_tile_desc(C, cfirst + 1024 * (2 * j6)); conv_tile_load(ct.W, ct.ldw, ct.k0, ct.s0, cv, lane); }
                    if (m6 == 3 && !first) { const MoeTile cb = moe_tile_desc(C, cfirst + 1024 * (2 * j6 - 1)); conv_tile_from_lds(cb.Bt, cb.K, cb.n0, cb.k0, scr, lane); }
                }
                SCAN5_BAR(); ++c;
            }
        };
        period(0, true);
        for (int j6 = 1; j6 < PER / 2; ++j6) period(j6, false);
        asm volatile("; MARK scan5 periodic end");
        for (; c < NCH; ++c) { flush_y(c - 1); SCAN5_BAR(); }
        if (!MOE_CONV_IN_PROLOGUE && CONV) {
            conv_tile_finish(cv, ct.Bt, ct.K, ct.n0, ct.k0, scr, lane);
            SCAN5_BAR();
            SCAN5_BAR();
            { const MoeTile cb = moe_tile_desc(C, cfirst + 1024 * (PER - 1)); conv_tile_from_lds(cb.Bt, cb.K, cb.n0, cb.k0, scr, lane); }
        }
#elif SCAN_SCHED == 3
        struct FS { f32x4 dec; u32x2 nb[4]; };
        FS fs[6];
        auto fetch2 = [&](int cidx, FS& f) {
            f.dec = *(const GLB f32x4*)(WSP(float, WS_DEC) + gbase + (size_t)(cidx * CH) * 1024 + lo_g);
#pragma unroll
            for (int i = 0; i < 4; ++i) { const size_t off = (i == 0) ? WS_R : (i == 1) ? WS_K : (i == 2) ? WS_AA : WS_V;
                f.nb[i] = *(const GLB u32x2*)(WSP(bf16_t, off) + gbase + (size_t)(cidx * CH) * 1024 + lo_g); }
        };
        auto put2 = [&](int cidx, FS& f) {
            LAS float* d = buf + (cidx & 1) * CHF + lo_l;
            asm volatile("" : "+v"(f.dec), "+v"(f.nb[0]), "+v"(f.nb[1]), "+v"(f.nb[2]), "+v"(f.nb[3]));
            const f32x4 rr = (f32x4){bflo(f.nb[0].x), bfhi(f.nb[0].x), bflo(f.nb[0].y), bfhi(f.nb[0].y)}, vv = (f32x4){bflo(f.nb[3].x), bfhi(f.nb[3].x), bflo(f.nb[3].y), bfhi(f.nb[3].y)};
            const f32x4 kr = (f32x4){bflo(f.nb[1].x), bfhi(f.nb[1].x), bflo(f.nb[1].y), bfhi(f.nb[1].y)}, av = (f32x4){bflo(f.nb[2].x), bfhi(f.nb[2].x), bflo(f.nb[2].y), bfhi(f.nb[2].y)};
            f32x4 kk = kr * kkw;
            const float ss = row16_sum((kk[0] * kk[0] + kk[1] * kk[1]) + (kk[2] * kk[2] + kk[3] * kk[3]));
            kk = kk * (1.0f / fmaxf(sqrtf(ss), 1e-12f));
            *(LAS f32x4*)(d) = rr; *(LAS f32x4*)(d + 64) = f.dec; *(LAS f32x4*)(d + 128) = kr * (1.0f + (av - 1.0f) * kaw);
            *(LAS f32x4*)(d + 192) = kk; *(LAS f32x4*)(d + 256) = kk * av; *(LAS f32x4*)(d + 320) = vv;
        };
        f32x4 cv[16]; MoeTile ct; ct.W = nullptr; ct.Bt = nullptr; ct.ldw = 0; ct.K = 0; ct.k0 = 0; ct.s0 = 0; ct.n0 = 0;
#pragma unroll
        for (int i = 0; i < 16; ++i) cv[i] = (f32x4){0.f, 0.f, 0.f, 0.f};
        {
            const int vit = blockIdx.x * 4 + (wave & 3);
            if (vit < 512) { const int sb = vit & 31, hd = (vit >> 5) & 1, vb = (vit >> 6) & 3;
                if ((vit >> 8) == 0) vt_tile(WSP(bf16_t, WS_VS) + ((size_t)vb * SEQ + 64 * sb) * 128 + 64 * hd, 128, WSP(bf16_t, WS_SWVT) + ((size_t)(vb * 2 + hd) * 64) * SEQ + 64 * sb, (LAS bf16_t*)scr, lane);
                else vt_tile(WSP(bf16_t, WS_VD) + ((size_t)vb * SEQ + 64 * sb) * 128 + 64 * hd, 128, WSP(bf16_t, WS_VDT) + ((size_t)vb * 128 + 64 * hd) * SEQ + 64 * sb, (LAS bf16_t*)scr, lane); }
        }
        static_assert(PER * 3 + 2 == NCH && PER % 2 == 0, "period schedule");
        const int off = (int)((blockIdx.x * 4u + (unsigned)(wave & 3)) & 1u);
        fetch2(0, fs[0]); put2(0, fs[0]); fetch2(1, fs[0]);
        SCAN5_BAR();
        int c = 0;
        for (; c < 1 + off; ++c) { put2(c + 1, fs[0]); fetch2(c + 2, fs[0]); if (c > 0) flush_y(c - 1); SCAN5_BAR(); }
#pragma unroll
        for (int i = 1; i < 6; ++i) fetch2(c + 1 + i, fs[i]);
        asm volatile("; MARK scan5 periodic begin");
        auto period = [&](int j6, bool first) {
#pragma unroll
            for (int m6 = 0; m6 < 6; ++m6) {
                asm volatile("; MARK m6 iter");
                put2(c + 1, fs[m6]); fetch2(c + 7 < NCH ? c + 7 : NCH - 1, fs[m6]); flush_y(c - 1);
                if (!MOE_CONV_IN_PROLOGUE && CONV && (m6 == 0 || (m6 == 3 && CONV != 5))) {
                    if (!(first && m6 == 0)) { if (CONV == 1) conv_tile_finish(cv, ct.Bt, ct.K, ct.n0, ct.k0, scr, lane);
                        else { asm volatile("" :: "v"(cv[0]), "v"(cv[1]), "v"(cv[2]), "v"(cv[3]), "v"(cv[4]), "v"(cv[5]), "v"(cv[6]), "v"(cv[7])); asm volatile("" :: "v"(cv[8]), "v"(cv[9]), "v"(cv[10]), "v"(cv[11]), "v"(cv[12]), "v"(cv[13]), "v"(cv[14]), "v"(cv[15])); } }
                    ct = moe_tile_desc(C, cfirst + 1024 * (2 * j6 + (m6 == 3 ? 1 : 0))); conv_tile_load(ct.W, ct.ldw, ct.k0, ct.s0, cv, lane);
                }
                SCAN5_BAR(); ++c;
            }
        };
        period(0, true);
        for (int j6 = 1; j6 < PER / 2; ++j6) period(j6, false);
        asm volatile("; MARK scan5 periodic end");
        for (; c < NCH; ++c) { flush_y(c - 1); SCAN5_BAR(); }
        if (!MOE_CONV_IN_PROLOGUE && CONV == 1) conv_tile_finish(cv, ct.Bt, ct.K, ct.n0, ct.k0, scr, lane);
#elif SCAN_SCHED == 2
        struct FS { f32x4 dec; u32x2 nb[4]; };
        FS fs[2];
        auto fetch2 = [&](int cidx, FS& f) {
            f.dec = *(const GLB f32x4*)(WSP(float, WS_DEC) + gbase + (size_t)(cidx * CH) * 1024 + lo_g);
#pragma unroll
            for (int i = 0; i < 4; ++i) { const size_t off = (i == 0) ? WS_R : (i == 1) ? WS_K : (i == 2) ? WS_AA : WS_V;
                f.nb[i] = *(const GLB u32x2*)(WSP(bf16_t, off) + gbase + (size_t)(cidx * CH) * 1024 + lo_g); }
        };
        auto put2 = [&](int cidx, FS& f) {
            LAS float* d = buf + (cidx & 1) * CHF + lo_l;
            asm volatile("" : "+v"(f.dec), "+v"(f.nb[0]), "+v"(f.nb[1]), "+v"(f.nb[2]), "+v"(f.nb[3]));
            const f32x4 rr = (f32x4){bflo(f.nb[0].x), bfhi(f.nb[0].x), bflo(f.nb[0].y), bfhi(f.nb[0].y)}, vv = (f32x4){bflo(f.nb[3].x), bfhi(f.nb[3].x), bflo(f.nb[3].y), bfhi(f.nb[3].y)};
            const f32x4 kr = (f32x4){bflo(f.nb[1].x), bfhi(f.nb[1].x), bflo(f.nb[1].y), bfhi(f.nb[1].y)}, av = (f32x4){bflo(f.nb[2].x), bfhi(f.nb[2].x), bflo(f.nb[2].y), bfhi(f.nb[2].y)};
            f32x4 kk = kr * kkw;
            const float ss = row16_sum((kk[0] * kk[0] + kk[1] * kk[1]) + (kk[2] * kk[2] + kk[3] * kk[3]));
            kk = kk * (1.0f / fmaxf(sqrtf(ss), 1e-12f));
            *(LAS f32x4*)(d) = rr; *(LAS f32x4*)(d + 64) = f.dec; *(LAS f32x4*)(d + 128) = kr * (1.0f + (av - 1.0f) * kaw);
            *(LAS f32x4*)(d + 192) = kk; *(LAS f32x4*)(d + 256) = kk * av; *(LAS f32x4*)(d + 320) = vv;
        };
        f32x4 cv[16]; MoeTile ct; ct.W = nullptr; ct.Bt = nullptr; ct.ldw = 0; ct.K = 0; ct.k0 = 0; ct.s0 = 0; ct.n0 = 0;
#pragma unroll
        for (int i = 0; i < 16; ++i) cv[i] = (f32x4){0.f, 0.f, 0.f, 0.f};
        {
            const int vit = blockIdx.x * 4 + (wave & 3);
            if (vit < 512) { const int sb = vit & 31, hd = (vit >> 5) & 1, vb = (vit >> 6) & 3;
                if ((vit >> 8) == 0) vt_tile(WSP(bf16_t, WS_VS) + ((size_t)vb * SEQ + 64 * sb) * 128 + 64 * hd, 128, WSP(bf16_t, WS_SWVT) + ((size_t)(vb * 2 + hd) * 64) * SEQ + 64 * sb, (LAS bf16_t*)scr, lane);
                else vt_tile(WSP(bf16_t, WS_VD) + ((size_t)vb * SEQ + 64 * sb) * 128 + 64 * hd, 128, WSP(bf16_t, WS_VDT) + ((size_t)vb * 128 + 64 * hd) * SEQ + 64 * sb, (LAS bf16_t*)scr, lane); }
        }
        static_assert(PER * 3 + 2 == NCH && PER % 2 == 0, "period schedule");
        const int off = (int)((blockIdx.x * 4u + (unsigned)(wave & 3)) & 1u);
        fetch2(0, fs[0]); put2(0, fs[0]); fetch2(1, fs[0]);
        SCAN5_BAR();
        int c = 0;
        for (; c < 1 + off; ++c) { put2(c + 1, fs[0]); fetch2(c + 2, fs[0]); if (c > 0) flush_y(c - 1); SCAN5_BAR(); }
        fetch2(c + 2, fs[1]);
        asm volatile("; MARK scan5 periodic begin");
        auto period = [&](int j6, bool first) {
#pragma unroll
            for (int m6 = 0; m6 < 6; ++m6) {
                asm volatile("; MARK m6 iter");
                put2(c + 1, fs[m6 & 1]); fetch2(c + 3 < NCH ? c + 3 : NCH - 1, fs[m6 & 1]); flush_y(c - 1);
                if (!MOE_CONV_IN_PROLOGUE && CONV && (m6 == 0 || (m6 == 3 && CONV != 5))) {
                    if (!(first && m6 == 0)) {
                        if (CONV == 1 || CONV == 4) conv_tile_finish(cv, ct.Bt, ct.K, ct.n0, ct.k0, scr, lane);
                        else if (CONV == 3) { const int cc = lane & 7;
#pragma unroll
                            for (int j = 0; j < 8; ++j) { const int n = (lane >> 3) + 8 * j; u32x4 o; o.x = pk2(cv[2 * j][0], cv[2 * j][1]); o.y = pk2(cv[2 * j][2], cv[2 * j][3]); o.z = pk2(cv[2 * j + 1][0], cv[2 * j + 1][1]); o.w = pk2(cv[2 * j + 1][2], cv[2 * j + 1][3]);
                                *(GLB u32x4*)(ct.Bt + (size_t)(ct.n0 + n) * ct.K + ct.k0 + 8 * cc) = o; } }
                        else { asm volatile("" :: "v"(cv[0]), "v"(cv[1]), "v"(cv[2]), "v"(cv[3]), "v"(cv[4]), "v"(cv[5]), "v"(cv[6]), "v"(cv[7])); asm volatile("" :: "v"(cv[8]), "v"(cv[9]), "v"(cv[10]), "v"(cv[11]), "v"(cv[12]), "v"(cv[13]), "v"(cv[14]), "v"(cv[15])); }
                    }
                    ct = moe_tile_desc(C, cfirst + 1024 * (2 * j6 + (m6 == 3 ? 1 : 0))); conv_tile_load(ct.W, ct.ldw, ct.k0, ct.s0, cv, lane);
                }
                SCAN5_BAR(); ++c;
            }
        };
        period(0, true);
        for (int j6 = 1; j6 < PER / 2; ++j6) period(j6, false);
        asm volatile("; MARK scan5 periodic end");
        for (; c < NCH; ++c) { flush_y(c - 1); SCAN5_BAR(); }
        if (!MOE_CONV_IN_PROLOGUE && (CONV == 1 || CONV == 4)) conv_tile_finish(cv, ct.Bt, ct.K, ct.n0, ct.k0, scr, lane);
#elif SCAN_SCHED == 1
        f32x4 cv[16]; MoeTile ct; ct.W = nullptr; ct.Bt = nullptr; ct.ldw = 0; ct.K = 0; ct.k0 = 0; ct.s0 = 0; ct.n0 = 0;
#pragma unroll
        for (int i = 0; i < 16; ++i) cv[i] = (f32x4){0.f, 0.f, 0.f, 0.f};
        {
            const int vit = blockIdx.x * 4 + (wave & 3);
            if (vit < 512) { const int sb = vit & 31, hd = (vit >> 5) & 1, vb = (vit >> 6) & 3;
                if ((vit >> 8) == 0) vt_tile(WSP(bf16_t, WS_VS) + ((size_t)vb * SEQ + 64 * sb) * 128 + 64 * hd, 128, WSP(bf16_t, WS_SWVT) + ((size_t)(vb * 2 + hd) * 64) * SEQ + 64 * sb, (LAS bf16_t*)scr, lane);
                else vt_tile(WSP(bf16_t, WS_VD) + ((size_t)vb * SEQ + 64 * sb) * 128 + 64 * hd, 128, WSP(bf16_t, WS_VDT) + ((size_t)vb * 128 + 64 * hd) * SEQ + 64 * sb, (LAS bf16_t*)scr, lane); }
        }
        static_assert(PER * 3 + 2 == NCH && PER % 2 == 0, "period schedule");
        const int off = (int)((blockIdx.x * 4u + (unsigned)(wave & 3)) & 1u);
        auto plain = [&](int c) { if (c + 1 < NCH) put_chunk(c + 1); if (c + 2 < NCH) fetch_chunk(c + 2); if (c > 0) flush_y(c - 1); };
        auto plain_nc = [&](int c) { put_chunk(c + 1); fetch_chunk(c + 2 < NCH ? c + 2 : NCH - 1); flush_y(c - 1); };
        fetch_chunk(0); put_chunk(0); fetch_chunk(1);
        SCAN5_BAR();
        int c = 0;
        for (; c < 1 + off; ++c) { plain(c); SCAN5_BAR(); }
        asm volatile("; MARK scan5 periodic begin");
        auto period = [&](int j6) {
#pragma unroll
            for (int m6 = 0; m6 < 6; ++m6) {
                asm volatile("; MARK m6 iter");
                plain_nc(c);
                if (!MOE_CONV_IN_PROLOGUE && CONV) {
                    if (m6 == 0 || m6 == 3) { ct = moe_tile_desc(C, cfirst + 1024 * (2 * j6 + (m6 == 3 ? 1 : 0))); conv_tile_load(ct.W, ct.ldw, ct.k0, ct.s0, cv, lane); }
                    if (m6 == 2 || m6 == 5) conv_tile_finish(cv, ct.Bt, ct.K, ct.n0, ct.k0, scr, lane);
                }
                SCAN5_BAR(); ++c;
            }
        };
        period(0);
        for (int j6 = 1; j6 < PER / 2; ++j6) period(j6);
        asm volatile("; MARK scan5 periodic end");
        for (; c < NCH; ++c) { plain(c); SCAN5_BAR(); }
#else
        f32x4 cv[16], cv2[16]; MoeTile ct; ct.W = nullptr; ct.Bt = nullptr; ct.ldw = 0; ct.K = 0; ct.k0 = 0; ct.s0 = 0; ct.n0 = 0; MoeTile ct2 = ct;
#pragma unroll
        for (int i = 0; i < 16; ++i) { cv[i] = (f32x4){0.f, 0.f, 0.f, 0.f}; cv2[i] = cv[i]; }
        {
            const int vit = blockIdx.x * 4 + (wave & 3);
            if (vit < 512) { const int sb = vit & 31, hd = (vit >> 5) & 1, vb = (vit >> 6) & 3;
                if ((vit >> 8) == 0) vt_tile(WSP(bf16_t, WS_VS) + ((size_t)vb * SEQ + 64 * sb) * 128 + 64 * hd, 128, WSP(bf16_t, WS_SWVT) + ((size_t)(vb * 2 + hd) * 64) * SEQ + 64 * sb, (LAS bf16_t*)scr, lane);
                else vt_tile(WSP(bf16_t, WS_VD) + ((size_t)vb * SEQ + 64 * sb) * 128 + 64 * hd, 128, WSP(bf16_t, WS_VDT) + ((size_t)vb * 128 + 64 * hd) * SEQ + 64 * sb, (LAS bf16_t*)scr, lane); }
        }
        fetch_chunk(0); put_chunk(0); fetch_chunk(1);
        SCAN5_BAR();
        for (int cidx = 0; cidx < NCH; ++cidx) {
            if (cidx + 1 < NCH) put_chunk(cidx + 1);
            if (cidx + 2 < NCH) fetch_chunk(cidx + 2);
            if (cidx > 0) flush_y(cidx - 1);
            if (!MOE_CONV_IN_PROLOGUE) {
                const int j6 = cidx / 6, m6 = cidx - 6 * j6;
                if (m6 == 0 && 2 * j6 < PER) { ct = moe_tile_desc(C, cfirst + 1024 * (2 * j6)); conv_tile_load(ct.W, ct.ldw, ct.k0, ct.s0, cv, lane); }
                else if (m6 == 4 && 2 * j6 < PER) conv_tile_finish(cv, ct.Bt, ct.K, ct.n0, ct.k0, scr, lane);
                else if (m6 == 3 && 2 * j6 + 1 < PER) { ct2 = moe_tile_desc(C, cfirst + 1024 * (2 * j6 + 1)); conv_tile_load(ct2.W, ct2.ldw, ct2.k0, ct2.s0, cv2, lane); }
                else if (m6 == 1 && j6 >= 1 && 2 * j6 - 1 < PER) conv_tile_finish(cv2, ct2.Bt, ct2.K, ct2.n0, ct2.k0, scr, lane);
            }
            SCAN5_BAR();
        }
#endif
        flush_y(NCH - 1);
    } else {
        const int ro = lane >> 4, kq = lane & 15, rloc = 4 * wave + ro;
        f32x2 Sa = {0.f, 0.f}, Sb = {0.f, 0.f};
        constexpr bool CONVB = SCAN_SCHED == 4 && CONV == 1 && !MOE_CONV_IN_PROLOGUE;
        f32x4 cvB[16];
#pragma unroll
        for (int i = 0; i < 16; ++i) cvB[i] = (f32x4){0.f, 0.f, 0.f, 0.f};
        LAS float* scrp = (LAS float*)(C.lds + 65536 + wave * 16640);
        const int cfirstc = l * (1024 * MOE_SCAN_TILES) + (blockIdx.x * 4 + wave);
        int bj = 0, bnext = 2 + (int)((blockIdx.x * 4u + (unsigned)wave) & 1u);
        SCAN5_BAR();
        for (int cidx = 0; cidx < NCH; ++cidx) {
            if (CONVB && cidx == bnext) {
                if (bj >= 1) conv_tile_to_lds(cvB, scrp, lane);
                if (bj < MOE_SCAN_TILES / 2) { const MoeTile tb = moe_tile_desc(C, cfirstc + 1024 * (2 * bj + 1)); conv_tile_load(tb.W, tb.ldw, tb.k0, tb.s0, cvB, lane); }
                ++bj; bnext += 6;
            }
            const LAS float* cb = buf + (cidx & 1) * CHF + 4 * kq;
            const LAS float* vb = buf + (cidx & 1) * CHF + 320 + 16 * qr + rloc;
            float ykeep = 0.f;
            f32x4 kk4 = *(const LAS f32x4*)(cb + 192), w4 = *(const LAS f32x4*)(cb + 64), b4 = *(const LAS f32x4*)(cb + 256), k4 = *(const LAS f32x4*)(cb + 128), r4 = *(const LAS f32x4*)(cb);
            float vv = vb[0];
#pragma unroll
            for (int st = 0; st < CH; ++st) {
                f32x4 kk4n = kk4, w4n = w4, b4n = b4, k4n = k4, r4n = r4; float vvn = vv;
                if (st + 1 < CH) { const LAS float* nb = cb + (st + 1) * 384;
                    kk4n = *(const LAS f32x4*)(nb + 192); w4n = *(const LAS f32x4*)(nb + 64); b4n = *(const LAS f32x4*)(nb + 256); k4n = *(const LAS f32x4*)(nb + 128); r4n = *(const LAS f32x4*)(nb); vvn = vb[(st + 1) * 384]; }
                const f32x2 tp = Sa * (f32x2){kk4[0], kk4[1]} + Sb * (f32x2){kk4[2], kk4[3]};
                const float p = row16_sum(tp[0] + tp[1]);
                const f32x2 pp = {p, p}, vv2 = {vv, vv};
                Sa = Sa * (f32x2){w4[0], w4[1]} - pp * (f32x2){b4[0], b4[1]} + vv2 * (f32x2){k4[0], k4[1]};
                Sb = Sb * (f32x2){w4[2], w4[3]} - pp * (f32x2){b4[2], b4[3]} + vv2 * (f32x2){k4[2], k4[3]};
                const f32x2 ty = Sa * (f32x2){r4[0], r4[1]} + Sb * (f32x2){r4[2], r4[3]};
                const float y = row16_sum(ty[0] + ty[1]);
                ykeep = (kq == st) ? y : ykeep;
                kk4 = kk4n; w4 = w4n; b4 = b4n; k4 = k4n; r4 = r4n; vv = vvn;
            }
            ybuf[(cidx & 1) * 256 + kq * 16 + rloc] = ykeep;
            SCAN5_BAR();
        }
        if (CONVB) { SCAN5_BAR(); conv_tile_to_lds(cvB, scrp, lane); SCAN5_BAR(); }
    }
#undef SCAN5_BAR
}
struct Args { const void* in[N_INPUTS]; float* out; unsigned char* ws; int ph_lo, ph_hi; };
static_assert(sizeof(Args) == N_INPUTS * 8 + 24, "Args has no padding");

constexpr int N_PHASES = 2 + 12 + 14;

#ifndef USE_FAST
#define USE_FAST 271
#endif
#ifndef PROBE_CONV
#define PROBE_CONV 3
#endif
#ifndef PROBE_MASK
#define PROBE_MASK 0
#endif
#ifndef DBG_SKIP_MASK
#define DBG_SKIP_MASK 0
#endif

__global__ void __launch_bounds__(NTHR, 2) fwd_kernel(Args args) {
    extern __shared__ __attribute__((aligned(16))) unsigned char lds_raw[];
    LAS unsigned char* const lds = (LAS unsigned char*)lds_raw;
    {
        const int tid0 = threadIdx.x;
        volatile LAS unsigned* MISC0 = (volatile LAS unsigned*)(lds + MISC_OFF);
        for (int u = tid0; u < (LDS_BYTES - MISC_OFF) / 4; u += NTHR) MISC0[u] = 0u;
        __syncthreads();
        LAS unsigned long long* tab = (LAS unsigned long long*)(lds + INTAB_OFF);
        if (tid0 < N_INPUTS) tab[tid0] = (unsigned long long)args.in[tid0];
        if (tid0 == 64) { tab[TAB_WS] = (unsigned long long)args.ws; tab[TAB_OUT] = (unsigned long long)args.out;
            tab[TAB_RANGE] = ((unsigned long long)(unsigned)args.ph_hi << 32) | (unsigned)args.ph_lo; }
        __syncthreads();
        if (args.ph_hi - args.ph_lo > 1) (void)xcd_barrier_post((unsigned*)(args.ws + WS_CTL) + CW_BAR, MISC0 + 8);
    }
    LAS unsigned char* ring = lds;
    int ph = 0;
#define PH_BEGIN { const int lo = (int)__builtin_amdgcn_readfirstlane(((const LAS unsigned*)(lds + INTAB_OFF))[2 * TAB_RANGE]), hi = (int)__builtin_amdgcn_readfirstlane(((const LAS unsigned*)(lds + INTAB_OFF))[2 * TAB_RANGE + 1]); \
    if (ph >= lo && ph < hi) { const Ctx C = make_ctx(lds);
#define PH_END if (ph + 1 < hi) { XcdBarrier bar; bar.bar = (unsigned*)WSP(unsigned, WS_CTL) + CW_BAR; bar.x = xb_xcc_id(); bar.st = (volatile LAS unsigned*)(lds + MISC_OFF) + 8; xcd_barrier(bar); } \
    else { VM_WAIT(); __syncthreads(); } } } ++ph;
#define REP(g, ...) { GLB float* XOUT = C.out; (void)XOUT; __VA_ARGS__ } if (PROBE_MASK & (g)) { GLB float* XOUT = WSP(float, WS_SC); (void)XOUT; __VA_ARGS__ }

    PH_BEGIN REP(1,  ph_prologue(C); ph_norm<0, false>(C, INF32(I_X), nullptr, INF32(I_MIXN), nullptr); ) PH_END
    PH_BEGIN REP(256,  { pg8::Gemm g{WSP(bf16_t, WS_PCAT), WSP(bf16_t, WS_WPP), 512, 256}; pg8::ProjOrder S; S.init(C.G, (int)blockIdx.x); pg8::EpiProj E{WSP(bf16_t, WS_PROJ)};
        pg8::gemm_phase<pg8::EpiProj, pg8::ProjOrder>(ring, g, S, E); } ) PH_END

    { constexpr int l = 0;
        if (l > 0) { PH_BEGIN REP(32768,  ph_norm<0>(C, WSP(bf16_t, WS_XB), nullptr, INF32(I_MIXN) + l * D, nullptr); ) PH_END }
        PH_BEGIN REP(4096,  { pg8::Gemm g{WSP(bf16_t, WS_H), WSP(bf16_t, WS_WIN + l * SZ_WIN1), D, D}; pg8::StaticOrder S; S.init(T, N_INP, C.G, (int)blockIdx.x);
            pg8::EpiWin E{WSP(bf16_t, WS_SBQKV), WSP(bf16_t, WS_UF), WSP(bf16_t, WS_GATE)};
            pg8::gemm_phase<pg8::EpiWin, pg8::StaticOrder>(ring, g, S, E); } ) PH_END
        PH_BEGIN REP(16384,  ph_prep(C, l); ph_vt(C); ph_latent(C, l); ) PH_END
        PH_BEGIN REP(256,  { pg8::Gemm g{WSP(bf16_t, WS_ALORA), WSP(bf16_t, WS_WLORA + l * SZ_WLORA1), 256, 256}; pg8::StaticOrder S; S.init(T, 3072, C.G, (int)blockIdx.x);
            pg8::EpiLora E{WSP(float, WS_DEC), WSP(bf16_t, WS_AA), WSP(bf16_t, WS_GG), INF32(I_RWW0) + l * 1024, INF32(I_RWA0) + l * 1024};
            pg8::gemm_phase<pg8::EpiLora, pg8::StaticOrder>(ring, g, S, E); } ) PH_END
        PH_BEGIN REP(32,  if (!(DBG_SKIP_MASK & 2)) { if (USE_FAST & 256) { ph_rwkv_scan5<1>(C, l); if (PROBE_MASK & 2097152) ph_rwkv_scan5<0>(C, l); if ((PROBE_MASK & 4194304) && l == 0) ph_rwkv_scan5<PROBE_CONV>(C, l); } else if (USE_FAST & 128) ph_rwkv_scan4(C, l); else if (USE_FAST & 64) ph_rwkv_scan3(C, l); else if (USE_FAST & 32) ph_rwkv_scan_conv(C, l); else if (USE_FAST & 2) ph_rwkv_scan_fast(C); else ph_rwkv_scan_naive(C); } ) PH_END
        PH_BEGIN REP(8,  ph_sb_fast(C); ) REP(64,  ph_dsa_fast(C); ) REP(128,  ph_swa_fast(C, l); ) REP(65536,  ph_rwkv_post(C, l); ) PH_END
        PH_BEGIN REP(512,  { pg8::Gemm g{WSP(bf16_t, WS_Y), WSP(bf16_t, WS_WBR + l * SZ_WBR1), 4096, 1024}; pg8::BranchOrder S; S.init(C.G, (int)blockIdx.x);
            pg8::EpiBranch E{WSP(bf16_t, WS_GATE), WSP(bf16_t, WS_G)};
            pg8::gemm_phase<pg8::EpiBranch, pg8::BranchOrder>(ring, g, S, E); } ) PH_END
        PH_BEGIN { pg8::Gemm g{WSP(bf16_t, WS_G), WSP(bf16_t, WS_WOUT + l * SZ_DD), D, D}; pg8::StaticOrder S; S.init(T, D, C.G, (int)blockIdx.x);
            if (l == 0) { pg8::EpiResid<false, true> E{INF32(I_X), WSP(bf16_t, WS_XB)}; pg8::gemm_phase<pg8::EpiResid<false, true>, pg8::StaticOrder>(ring, g, S, E); }
            else { pg8::EpiResid<true, true> E{WSP(bf16_t, WS_XB), WSP(bf16_t, WS_XB)}; pg8::gemm_phase<pg8::EpiResid<true, true>, pg8::StaticOrder>(ring, g, S, E); } } PH_END
        PH_BEGIN if (l == 0) ph_norm<0>(C, WSP(bf16_t, WS_XB), nullptr, INF32(I_FFNN) + l * D, nullptr); else ph_norm<1>(C, WSP(bf16_t, WS_XB), nullptr, INF32(I_FFNN) + l * D, INF32(I_MR)); PH_END
        if (l == 0) {
            PH_BEGIN REP(2,  { pg8::Gemm g{WSP(bf16_t, WS_H), WSP(bf16_t, WS_WGU), D, D}; pg8::StaticOrder S; S.init(T, 2 * FF, C.G, (int)blockIdx.x); pg8::EpiUp E{WSP(bf16_t, WS_ACT)};
                pg8::gemm_phase<pg8::EpiUp, pg8::StaticOrder>(ring, g, S, E); } ) PH_END
            PH_BEGIN REP(2048,  { pg8::Gemm g{WSP(bf16_t, WS_ACT), WSP(bf16_t, WS_WD), FF, FF}; pg8::StaticOrder S; S.init(T, D, C.G, (int)blockIdx.x); pg8::EpiResid<true, true> E{WSP(bf16_t, WS_XB), WSP(bf16_t, WS_XB)};
                pg8::gemm_phase<pg8::EpiResid<true, true>, pg8::StaticOrder>(ring, g, S, E); } ) PH_END
            PH_BEGIN REP(32768,  ph_norm<0>(C, WSP(bf16_t, WS_XB), nullptr, INF32(I_PLEN) + l * D, nullptr); ) PH_END
        } else {
            PH_BEGIN REP(131072,  ph_moe_gather(C); ) PH_END
            PH_BEGIN REP(8192,  { moe_tile_table(C); pg8::MoeOrder S; S.tab = (const LAS int*)(C.lds + MOETAB_OFF); S.NT = __builtin_amdgcn_readfirstlane(S.tab[MOE_MAXRT]); S.nct = NCT_UP; S.G = C.G; S.c = (int)blockIdx.x;
                pg8::Gemm g{WSP(bf16_t, WS_HS), WSP(bf16_t, WS_MWGU), D, D}; pg8::EpiUp E{WSP(bf16_t, WS_ACTS)};
                pg8::gemm_phase<pg8::EpiUp, pg8::MoeOrder>(ring, g, S, E); } ) PH_END
            PH_BEGIN REP(2048,  { moe_tile_table(C); const LAS int* mtab = (const LAS int*)(C.lds + MOETAB_OFF);
                pg8::MoeDownOrder S; S.init(mtab, __builtin_amdgcn_readfirstlane(mtab[MOE_MAXRT]), C.G, (int)blockIdx.x);
                pg8::Gemm g{WSP(bf16_t, WS_ACTS), WSP(bf16_t, WS_MWD), FF, FF}; pg8::EpiMoeDown E{WSP(bf16_t, WS_OS), WSP(float, WS_WSLOT), WSP(float, WS_OSP), S.S};
                pg8::gemm_phase<pg8::EpiMoeDown, pg8::MoeDownOrder>(ring, g, S, E); } ) PH_END
            PH_BEGIN REP(16,  { int toff[NE + 1]; moe_offsets(C, toff); pg8::MoeDownOrder S; S.init(nullptr, toff[NE], C.G, 0); ph_norm<2>(C, WSP(bf16_t, WS_XB), WSP(bf16_t, WS_XB), INF32(I_PLEN) + l * D, nullptr, S.S); } ) PH_END
        }
        PH_BEGIN REP(262144,  { pg8::Gemm g{WSP(bf16_t, WS_H), WSP(bf16_t, WS_WPG + l * SZ_DD), D, D}; pg8::StaticOrder S; S.init(T, D, C.G, (int)blockIdx.x);
            if (l == NL - 1) { pg8::EpiPle<false> E{WSP(bf16_t, WS_XB), C.out, WSP(bf16_t, WS_PROJ) + (size_t)l * T * D}; pg8::gemm_phase<pg8::EpiPle<false>, pg8::StaticOrder>(ring, g, S, E); }
            else { pg8::EpiPle<true> E{WSP(bf16_t, WS_XB), WSP(bf16_t, WS_XB), WSP(bf16_t, WS_PROJ) + (size_t)l * T * D}; pg8::gemm_phase<pg8::EpiPle<true>, pg8::StaticOrder>(ring, g, S, E); } } ) PH_END
    }
    { constexpr int l = 1;
        if (l > 0) { PH_BEGIN REP(32768,  ph_norm<0>(C, WSP(bf16_t, WS_XB), nullptr, INF32(I_MIXN) + l * D, nullptr); ) PH_END }
        PH_BEGIN REP(4096,  { pg8::Gemm g{WSP(bf16_t, WS_H), WSP(bf16_t, WS_WIN + l * SZ_WIN1), D, D}; pg8::StaticOrder S; S.init(T, N_INP, C.G, (int)blockIdx.x);
            pg8::EpiWin E{WSP(bf16_t, WS_SBQKV), WSP(bf16_t, WS_UF), WSP(bf16_t, WS_GATE)};
            pg8::gemm_phase<pg8::EpiWin, pg8::StaticOrder>(ring, g, S, E); } ) PH_END
        PH_BEGIN REP(16384,  ph_prep(C, l); ph_vt(C); ph_latent(C, l); ) PH_END
        PH_BEGIN REP(256,  { pg8::Gemm g{WSP(bf16_t, WS_ALORA), WSP(bf16_t, WS_WLORA + l * SZ_WLORA1), 256, 256}; pg8::StaticOrder S; S.init(T, 3072, C.G, (int)blockIdx.x);
            pg8::EpiLora E{WSP(float, WS_DEC), WSP(bf16_t, WS_AA), WSP(bf16_t, WS_GG), INF32(I_RWW0) + l * 1024, INF32(I_RWA0) + l * 1024};
            pg8::gemm_phase<pg8::EpiLora, pg8::StaticOrder>(ring, g, S, E); } ) PH_END
        PH_BEGIN REP(32,  if (!(DBG_SKIP_MASK & 2)) { if (USE_FAST & 256) { ph_rwkv_scan5<1>(C, l); if (PROBE_MASK & 2097152) ph_rwkv_scan5<0>(C, l); if ((PROBE_MASK & 4194304) && l == 0) ph_rwkv_scan5<PROBE_CONV>(C, l); } else if (USE_FAST & 128) ph_rwkv_scan4(C, l); else if (USE_FAST & 64) ph_rwkv_scan3(C, l); else if (USE_FAST & 32) ph_rwkv_scan_conv(C, l); else if (USE_FAST & 2) ph_rwkv_scan_fast(C); else ph_rwkv_scan_naive(C); } ) PH_END
        PH_BEGIN REP(8,  ph_sb_fast(C); ) REP(64,  ph_dsa_fast(C); ) REP(128,  ph_swa_fast(C, l); ) REP(65536,  ph_rwkv_post(C, l); ) PH_END
        PH_BEGIN REP(512,  { pg8::Gemm g{WSP(bf16_t, WS_Y), WSP(bf16_t, WS_WBR + l * SZ_WBR1), 4096, 1024}; pg8::BranchOrder S; S.init(C.G, (int)blockIdx.x);
            pg8::EpiBranch E{WSP(bf16_t, WS_GATE), WSP(bf16_t, WS_G)};
            pg8::gemm_phase<pg8::EpiBranch, pg8::BranchOrder>(ring, g, S, E); } ) PH_END
        PH_BEGIN { pg8::Gemm g{WSP(bf16_t, WS_G), WSP(bf16_t, WS_WOUT + l * SZ_DD), D, D}; pg8::StaticOrder S; S.init(T, D, C.G, (int)blockIdx.x);
            if (l == 0) { pg8::EpiResid<false, true> E{INF32(I_X), WSP(bf16_t, WS_XB)}; pg8::gemm_phase<pg8::EpiResid<false, true>, pg8::StaticOrder>(ring, g, S, E); }
            else { pg8::EpiResid<true, true> E{WSP(bf16_t, WS_XB), WSP(bf16_t, WS_XB)}; pg8::gemm_phase<pg8::EpiResid<true, true>, pg8::StaticOrder>(ring, g, S, E); } } PH_END
        PH_BEGIN if (l == 0) ph_norm<0>(C, WSP(bf16_t, WS_XB), nullptr, INF32(I_FFNN) + l * D, nullptr); else ph_norm<1>(C, WSP(bf16_t, WS_XB), nullptr, INF32(I_FFNN) + l * D, INF32(I_MR)); PH_END
        if (l == 0) {
            PH_BEGIN REP(2,  { pg8::Gemm g{WSP(bf16_t, WS_H), WSP(bf16_t, WS_WGU), D, D}; pg8::StaticOrder S; S.init(T, 2 * FF, C.G, (int)blockIdx.x); pg8::EpiUp E{WSP(bf16_t, WS_ACT)};
                pg8::gemm_phase<pg8::EpiUp, pg8::StaticOrder>(ring, g, S, E); } ) PH_END
            PH_BEGIN REP(2048,  { pg8::Gemm g{WSP(bf16_t, WS_ACT), WSP(bf16_t, WS_WD), FF, FF}; pg8::StaticOrder S; S.init(T, D, C.G, (int)blockIdx.x); pg8::EpiResid<true, true> E{WSP(bf16_t, WS_XB), WSP(bf16_t, WS_XB)};
                pg8::gemm_phase<pg8::EpiResid<true, true>, pg8::StaticOrder>(ring, g, S, E); } ) PH_END
            PH_BEGIN REP(32768,  ph_norm<0>(C, WSP(bf16_t, WS_XB), nullptr, INF32(I_PLEN) + l * D, nullptr); ) PH_END
        } else {
            PH_BEGIN REP(131072,  ph_moe_gather(C); ) PH_END
            PH_BEGIN REP(8192,  { moe_tile_table(C); pg8::MoeOrder S; S.tab = (const LAS int*)(C.lds + MOETAB_OFF); S.NT = __builtin_amdgcn_readfirstlane(S.tab[MOE_MAXRT]); S.nct = NCT_UP; S.G = C.G; S.c = (int)blockIdx.x;
                pg8::Gemm g{WSP(bf16_t, WS_HS), WSP(bf16_t, WS_MWGU), D, D}; pg8::EpiUp E{WSP(bf16_t, WS_ACTS)};
                pg8::gemm_phase<pg8::EpiUp, pg8::MoeOrder>(ring, g, S, E); } ) PH_END
            PH_BEGIN REP(2048,  { moe_tile_table(C); const LAS int* mtab = (const LAS int*)(C.lds + MOETAB_OFF);
                pg8::MoeDownOrder S; S.init(mtab, __builtin_amdgcn_readfirstlane(mtab[MOE_MAXRT]), C.G, (int)blockIdx.x);
                pg8::Gemm g{WSP(bf16_t, WS_ACTS), WSP(bf16_t, WS_MWD), FF, FF}; pg8::EpiMoeDown E{WSP(bf16_t, WS_OS), WSP(float, WS_WSLOT), WSP(float, WS_OSP), S.S};
                pg8::gemm_phase<pg8::EpiMoeDown, pg8::MoeDownOrder>(ring, g, S, E); } ) PH_END
            PH_BEGIN REP(16,  { int toff[NE + 1]; moe_offsets(C, toff); pg8::MoeDownOrder S; S.init(nullptr, toff[NE], C.G, 0); ph_norm<2>(C, WSP(bf16_t, WS_XB), WSP(bf16_t, WS_XB), INF32(I_PLEN) + l * D, nullptr, S.S); } ) PH_END
        }
        PH_BEGIN REP(262144,  { pg8::Gemm g{WSP(bf16_t, WS_H), WSP(bf16_t, WS_WPG + l * SZ_DD), D, D}; pg8::StaticOrder S; S.init(T, D, C.G, (int)blockIdx.x);
            if (l == NL - 1) { pg8::EpiPle<false> E{WSP(bf16_t, WS_XB), C.out, WSP(bf16_t, WS_PROJ) + (size_t)l * T * D}; pg8::gemm_phase<pg8::EpiPle<false>, pg8::StaticOrder>(ring, g, S, E); }
            else { pg8::EpiPle<true> E{WSP(bf16_t, WS_XB), WSP(bf16_t, WS_XB), WSP(bf16_t, WS_PROJ) + (size_t)l * T * D}; pg8::gemm_phase<pg8::EpiPle<true>, pg8::StaticOrder>(ring, g, S, E); } } ) PH_END
    }
#undef PH_BEGIN
#undef PH_END
}

#ifndef MK_ONE_LAUNCH
#define MK_ONE_LAUNCH 0
#endif
extern "C" void kernel_launch(void* const* d_in, const int* in_sizes, int n_in, void* d_out, int out_size, void* d_ws, size_t ws_size, hipStream_t stream) {
    static int grid = 0;
    if (grid == 0) {
        if (n_in != N_INPUTS || out_size != T * D || ws_size < WS_END3) { fprintf(stderr, "kernel_launch: unexpected problem (n_in %d, out %d, ws %zu < %zu)\n", n_in, out_size, ws_size, (size_t)WS_END3); grid = -1; return; }
        int dev = 0, cus = 0, per_cu = 0;
        if (hipGetDevice(&dev) != hipSuccess || hipDeviceGetAttribute(&cus, hipDeviceAttributeMultiprocessorCount, dev) != hipSuccess) { grid = -1; return; }
        if (hipFuncSetAttribute((const void*)fwd_kernel, hipFuncAttributeMaxDynamicSharedMemorySize, LDS_BYTES) != hipSuccess) { fprintf(stderr, "kernel_launch: hipFuncSetAttribute failed\n"); grid = -1; return; }
        if (hipOccupancyMaxActiveBlocksPerMultiprocessor(&per_cu, (const void*)fwd_kernel, NTHR, LDS_BYTES) != hipSuccess || per_cu < 1) fprintf(stderr, "kernel_launch: occupancy query reports %d\n", per_cu);
        (void)hipGetLastError();
        grid = cus;
    }
    if (grid < 0) return;
    (void)hipMemsetAsync((char*)d_ws + WS_CTL, 0, CTL_BYTES, stream);
    Args a{};
    for (int i = 0; i < N_INPUTS; ++i) a.in[i] = d_in[i];
    a.out = (float*)d_out; a.ws = (unsigned char*)d_ws;
#if MK_ONE_LAUNCH
    a.ph_lo = 0; a.ph_hi = N_PHASES;
    hipLaunchKernelGGL(fwd_kernel, dim3(grid), dim3(NTHR), LDS_BYTES, stream, a);
#else
    for (int p = 0; p < N_PHASES; ++p) { a.ph_lo = p; a.ph_hi = p + 1; hipLaunchKernelGGL(fwd_kernel, dim3(grid), dim3(NTHR), LDS_BYTES, stream, a); }
#endif
}
```

```cpp
#define MK_ONE_LAUNCH 1
#include <hip/hip_runtime.h>
#include <cstdio>
#include <cstdint>

#define LAS __attribute__((address_space(3)))
#define GAS __attribute__((address_space(1)))
#define GLB __attribute__((address_space(1)))
typedef unsigned short bf16_t;
typedef short bf16x8 __attribute__((ext_vector_type(8)));
typedef float f32x4 __attribute__((ext_vector_type(4)));
typedef float f32x2 __attribute__((ext_vector_type(2)));
typedef unsigned u32x4 __attribute__((ext_vector_type(4)));
typedef unsigned u32x2 __attribute__((ext_vector_type(2)));

constexpr int NB = 4, SEQ = 2048, T = NB * SEQ, D = 2048, NL = 2;
constexpr int N_IN = 18256, N_INP = 18432, FF = 7168, NE = 8;
constexpr int UFW = 7168;
constexpr int UF_RW = 0, UF_DQ = 3328, UF_CKV = 4352, UF_IQ = 4608, UF_SQ = 5632, UF_SK = 6656, UF_SV = 6784, UF_IK = 6912, UF_IW = 6976;
constexpr int MOE_ROWS = 18432, MOE_MAXRT = 72, NCT_UP = 56, NCT_DN = 8;
constexpr int NWAVES = 8, NTHR = 512;

constexpr size_t WS_CTL = 0, CTL_BYTES = 1u << 20;
constexpr size_t SZ_WIN1 = (size_t)N_INP * D * 2, SZ_WBR1 = (size_t)4 * 2048 * 1024 * 2, SZ_DD = (size_t)D * D * 2;
constexpr size_t SZ_WGU1 = (size_t)2 * FF * D * 2, SZ_WD1 = (size_t)D * FF * 2, SZ_WLORA1 = (size_t)3072 * 256 * 2;
constexpr size_t WS_WIN = CTL_BYTES;
constexpr size_t WS_WBR = WS_WIN + NL * SZ_WIN1;
constexpr size_t WS_WOUT = WS_WBR + NL * SZ_WBR1;
constexpr size_t WS_WGU = WS_WOUT + NL * SZ_DD;
constexpr size_t WS_WD = WS_WGU + SZ_WGU1;
constexpr size_t WS_MWGU = WS_WD + SZ_WD1;
constexpr size_t WS_MWD = WS_MWGU + NE * SZ_WGU1;
constexpr size_t WS_WPG = WS_MWD + NE * SZ_WD1;
constexpr size_t WS_WPP = WS_WPG + NL * SZ_DD;
constexpr size_t WS_WLORA = WS_WPP + (size_t)NL * D * 256 * 2;
constexpr size_t WS_H = WS_WLORA + NL * SZ_WLORA1;
constexpr size_t WS_PCAT = WS_H + (size_t)T * D * 2;
constexpr size_t WS_PROJ = WS_PCAT + (size_t)T * 512 * 2;
constexpr size_t WS_ROUTE = WS_PROJ + (size_t)NL * T * D * 2;
constexpr size_t WS_TOKSLOT = WS_ROUTE + (size_t)T * 32;
constexpr size_t WS_WSLOT = WS_TOKSLOT + (size_t)T * 8;
constexpr size_t WS_ACT0 = WS_WSLOT + (size_t)MOE_ROWS * 4 + 256 * 30;
constexpr size_t SZ_T1K = (size_t)T * 1024 * 4;
constexpr size_t WS_SBQKV = (WS_ACT0 + 255) & ~(size_t)255;
constexpr size_t WS_GATE = WS_SBQKV + (size_t)T * 3072 * 2;
constexpr size_t WS_UF = WS_GATE + (size_t)T * 8192 * 2;
constexpr size_t WS_Y = WS_UF;
constexpr size_t WS_GSUM = WS_Y + (size_t)T * 4096 * 2;
constexpr size_t WS_G = WS_GSUM + (size_t)T * 2048 * 4;
constexpr size_t WS_YRAW = WS_G + (size_t)T * 2048 * 2;
constexpr size_t WS_RW = WS_UF + (size_t)T * UFW * 4;
static_assert(WS_YRAW + SZ_T1K <= WS_RW, "UF aliases");
constexpr size_t WS_R = WS_RW, WS_K = WS_RW + SZ_T1K, WS_V = WS_RW + 2 * SZ_T1K, WS_DEC = WS_RW + 3 * SZ_T1K, WS_AA = WS_RW + 4 * SZ_T1K, WS_KK = WS_RW + 5 * SZ_T1K, WS_GG = WS_RW + 6 * SZ_T1K;
constexpr size_t WS_ALORA = WS_RW + 7 * SZ_T1K;
constexpr size_t WS_QD = WS_ALORA + (size_t)T * 256 * 2;
constexpr size_t WS_KD = WS_QD + (size_t)T * 1024 * 2;
constexpr size_t WS_VD = WS_KD + (size_t)T * 128 * 2;
constexpr size_t WS_QI = WS_VD + (size_t)T * 128 * 2;
constexpr size_t WS_KI = WS_QI + (size_t)T * 1024 * 2;
constexpr size_t WS_WI = WS_KI + (size_t)T * 64 * 2;
constexpr size_t WS_QS = WS_WI + (size_t)T * 16 * 4;
constexpr size_t WS_KS = WS_QS + (size_t)T * 1024 * 2;
constexpr size_t WS_VS = WS_KS + (size_t)T * 128 * 2;
constexpr size_t WS_MIX_END = WS_VS + (size_t)T * 128 * 2;
constexpr size_t WS_ACT = WS_SBQKV;
constexpr size_t WS_HS = WS_SBQKV;
constexpr size_t WS_ACTS = WS_HS + (size_t)MOE_ROWS * D * 2;
constexpr size_t WS_OS = WS_ACTS + (size_t)MOE_ROWS * FF * 2;
constexpr size_t WS_OSP = WS_OS + (size_t)MOE_ROWS * D * 4;
constexpr size_t WS_FFN_END = WS_OSP + (size_t)256 * 65536 * 4;
constexpr size_t WS_END = WS_MIX_END > WS_FFN_END ? WS_MIX_END : WS_FFN_END;
static_assert(WS_END < (size_t)2000 * 1000 * 1000, "workspace budget");

constexpr int CW_BAR = 4096;
constexpr int CW_MOECNT = 8192;

constexpr int RING_BYTES = 131072;
constexpr int MISC_OFF = 143360;
constexpr int LDS_BYTES = 147456;

#define LDS_WAIT() asm volatile("s_waitcnt lgkmcnt(0)" ::: "memory")
#define VM_WAIT() asm volatile("s_waitcnt vmcnt(0)" ::: "memory")
__device__ __forceinline__ float bflo(unsigned u) { return __builtin_bit_cast(float, u << 16); }
__device__ __forceinline__ float bfhi(unsigned u) { return __builtin_bit_cast(float, u & 0xffff0000u); }
__device__ __forceinline__ float bf1(bf16_t u) { return __builtin_bit_cast(float, (unsigned)u << 16); }
__device__ __forceinline__ unsigned f2bf(float f) { unsigned u = __builtin_bit_cast(unsigned, f); return (u + 0x7fffu + ((u >> 16) & 1u)) >> 16; }
typedef __bf16 bf16x2v __attribute__((ext_vector_type(2)));
__device__ __forceinline__ unsigned pk2(float lo, float hi) { const f32x2 v = {lo, hi}; return __builtin_bit_cast(unsigned, __builtin_convertvector(v, bf16x2v)); }
__device__ __forceinline__ float wave_sum(float v) {
#pragma unroll
    for (int o = 1; o < 64; o <<= 1) v += __shfl_xor(v, o);
    return v;
}
__device__ __forceinline__ float wave_max(float v) {
#pragma unroll
    for (int o = 1; o < 64; o <<= 1) v = fmaxf(v, __shfl_xor(v, o));
    return v;
}
__device__ __forceinline__ float sigmoidf_(float x) { return __builtin_amdgcn_rcpf(1.0f + __builtin_amdgcn_exp2f(-1.4426950408889634f * x)); }
__device__ __forceinline__ float logsigf_(float x) { return fminf(x, 0.f) - __logf(1.0f + __expf(-fabsf(x))); }
__device__ __forceinline__ float rdlane(float v, int l) { return __builtin_bit_cast(float, __builtin_amdgcn_readlane(__builtin_bit_cast(int, v), l)); }

#define XB_TMO      128
#define XB_XCNT(j)  (256  + 64 * (j))
#define XB_XSUB(j)  (1280 + 64 * (j))
#define XB_XGEN(j)  (2304 + 64 * (j))
#define XB_TOP      3328
#define XB_TOPGEN   3392
#define XCD_BAR_WORDS 3456
#define XB_SPIN_CAP (1u << 18)
__device__ __forceinline__ unsigned xb_ld(unsigned* p)              { return __hip_atomic_load(p, __ATOMIC_RELAXED, __HIP_MEMORY_SCOPE_AGENT); }
__device__ __forceinline__ unsigned xb_add(unsigned* p, unsigned v) { return __hip_atomic_fetch_add(p, v, __ATOMIC_RELAXED, __HIP_MEMORY_SCOPE_AGENT); }
__device__ __forceinline__ unsigned xb_xcc_id() { return (unsigned)__builtin_amdgcn_s_getreg((3 << 11) | 20) & 0xFu; }
#define XB_SPIN(cond, bar) do { unsigned _sp = 0; while (cond) { __builtin_amdgcn_s_sleep(1); \
    if ((++_sp & 255u) == 0u) { if (xb_ld(&(bar)[XB_TMO])) break; if (_sp > XB_SPIN_CAP) { atomicAdd(&(bar)[XB_TMO], 1u); break; } } } } while (0)
struct XcdBarrier { unsigned* bar; unsigned x; volatile LAS unsigned* st; };
__device__ __forceinline__ XcdBarrier xcd_barrier_post(unsigned* bar, volatile LAS unsigned* st) {
    XcdBarrier b; b.bar = bar; b.x = xb_xcc_id(); b.st = st;
    if (threadIdx.x == 0) (void)xb_add(&bar[XB_XCNT(b.x)], 1u);
    return b;
}
__device__ __forceinline__ void xcd_barrier_complete(unsigned* bar, unsigned x, unsigned& nloc, unsigned& nx) {
    const unsigned G = gridDim.x * gridDim.y * gridDim.z;
    unsigned sum, cnt, mine, sp = 0u;
    for (;;) {
        sum = 0u; cnt = 0u; mine = 0u;
#pragma unroll
        for (unsigned j = 0; j < 16; ++j) { const unsigned c = xb_ld(&bar[XB_XCNT(j)]); sum += c; cnt += (c > 0u) ? 1u : 0u; mine = (j == x) ? c : mine; }
        if (sum == G) break;
        __builtin_amdgcn_s_sleep(1);
        if ((++sp & 255u) == 0u) { if (xb_ld(&bar[XB_TMO])) break; if (sp > XB_SPIN_CAP) { atomicAdd(&bar[XB_TMO], 1u); break; } }
    }
    nloc = mine > 0u ? mine : 1u; nx = cnt > 0u ? cnt : 1u;
}
__device__ __forceinline__ void xcd_barrier(const XcdBarrier& b) {
    asm volatile("s_waitcnt vmcnt(0)" ::: "memory");
    __syncthreads();
    if (threadIdx.x == 0) {
        unsigned* bar = b.bar;
        __builtin_amdgcn_s_waitcnt(0);
        unsigned nloc = b.st[0], nx = b.st[1];
        if (nloc == 0u) { xcd_barrier_complete(bar, b.x, nloc, nx); b.st[0] = nloc; b.st[1] = nx; }
        const unsigned old = xb_add(&bar[XB_XSUB(b.x)], 1u);
        const unsigned gen = old / nloc;
        if (old + 1u == (gen + 1u) * nloc) {
            __builtin_amdgcn_fence(__ATOMIC_RELEASE, "agent");
            asm volatile("s_waitcnt vmcnt(0)" ::: "memory");
            const unsigned og = xb_add(&bar[XB_TOP], 1u);
            const unsigned tg = og / nx;
            if (og + 1u == (tg + 1u) * nx) xb_add(&bar[XB_TOPGEN], 1u);
            else XB_SPIN(xb_ld(&bar[XB_TOPGEN]) == tg, bar);
            __builtin_amdgcn_fence(__ATOMIC_ACQUIRE, "agent");
            xb_add(&bar[XB_XGEN(b.x)], 1u);
            asm volatile("s_waitcnt vmcnt(0)" ::: "memory");
        } else {
            XB_SPIN(xb_ld(&bar[XB_XGEN(b.x)]) == gen, bar);
            __builtin_amdgcn_fence(__ATOMIC_ACQUIRE, "agent");
            asm volatile("s_waitcnt vmcnt(0)" ::: "memory");
        }
    }
    __syncthreads();
}
namespace pg8 {
#define PG8_LAS __attribute__((address_space(3)))
#ifndef PG8_WGM
#define PG8_WGM 4
#endif
constexpr int BM = 256, BK = 64, HALF = 128, HTB = HALF * BK * 2, STAGE_BYTES = 8 * HTB, NXCD = 8, WGM = PG8_WGM;
__host__ __device__ __forceinline__ int lds_byte(int r, int c) { const int st = (r >> 4) * 2 + (c >> 5), rr = r & 15, cc = c & 31, ob = rr * 64 + cc * 2; return st * 1024 + (ob ^ (((ob >> 9) & 1) << 5)); }
__host__ __device__ __forceinline__ void stage_rc(int b, int& R, int& C) { const int st = b / 1024, sb = b % 1024, swz = sb ^ (((sb >> 9) & 1) << 5); R = (st >> 1) * 16 + swz / 64; C = (st & 1) * 32 + (swz % 64) / 2; }
__host__ __device__ __forceinline__ int perm32(int rho) { const int n = rho >> 4, i = rho & 15; return 8 * (i >> 2) + 4 * n + (i & 3); }

struct Unit { int pm, pn, ka, kb, nt, aux; };
struct Gemm { const GLB bf16_t* A; const GLB bf16_t* Bt; int lda, K; };

struct StaticOrder {
    int nM, nN, nwg, G, c;
    __device__ __forceinline__ void init(int M, int N, int G_, int c_) { nM = M / BM; nN = N / BM; nwg = nM * nN; G = G_; c = c_; }
    __device__ __forceinline__ bool tile(long L, Unit& u) const {
        if (L >= nwg) return false;
        int wgid = (int)L; { const int q = nwg / NXCD, r = nwg % NXCD, xcd = wgid % NXCD, off = wgid / NXCD; wgid = (xcd < r ? xcd * (q + 1) : r * (q + 1) + (xcd - r) * q) + off; }
        const int nig = WGM * nN, gid = wgid / nig, fm = gid * WGM, gsz = (nM - fm) < WGM ? (nM - fm) : WGM;
        u.pm = fm + ((wgid % nig) % gsz); u.pn = (wgid % nig) / gsz; u.ka = 0; u.kb = 0; u.nt = 0; u.aux = 0; return true;
    }
    __device__ __forceinline__ bool next(int i, Unit& u) const { return tile((long)i * G + c, u); }
};
struct BranchOrder {
    int G, c, cnt;
    __device__ __forceinline__ void init(int G_, int c_) { G = G_; c = c_; cnt = (c_ < 256) ? (255 - c_) / G_ + 1 : 0; }
    __device__ __forceinline__ bool next(int i, Unit& u) const {
        if (cnt == 0) return false;
        const int n = i / cnt, r = i - n * cnt; if (n >= 4) return false;
        StaticOrder so; so.init(T, 2048, G, c); so.tile((long)r * G + c, u);
        u.pn += n * 8; u.ka = n * 1024; return true;
    }
};
struct ProjOrder {
    StaticOrder so;
    __device__ __forceinline__ void init(int G_, int c_) { so.init(T, 4096, G_, c_); }
    __device__ __forceinline__ bool next(int i, Unit& u) const { if (!so.next(i, u)) return false; u.ka = (u.pn >> 3) * 256; return true; }
};
struct MoeOrder {
    const PG8_LAS int* tab; int NT, nct, G, c;
    __device__ __forceinline__ bool next(int i, Unit& u) const {
        StaticOrder so; so.nM = NT; so.nN = nct; so.nwg = NT * nct; so.G = G; so.c = c;
        if (!so.tile((long)i * G + c, u)) return false;
        const int e = __builtin_amdgcn_readfirstlane(tab[u.pm]);
        u.pn += e * nct; u.ka = 0; return true;
    }
};

struct MoeDownOrder {
    const PG8_LAS int* tab; int NT, G, c, S;
    __device__ __forceinline__ void init(const PG8_LAS int* tab_, int NT_, int G_, int c_) { tab = tab_; NT = NT_; G = G_; c = c_;
        const int tu = (NT_ - 64) * 8; S = (tu <= 0) ? 1 : ((tu * 8 <= G_) ? 8 : ((tu * 4 <= G_) ? 4 : ((tu * 2 <= G_) ? 2 : 1))); }
    __device__ __forceinline__ bool next(int i, Unit& u) const {
        const int F = (NT < 64) ? NT : 64, nfull = F * 8, rf = (nfull + G - 1) / G;
        if (i < rf) {
            StaticOrder so; so.nM = F; so.nN = 8; so.nwg = nfull; so.G = G; so.c = c;
            if (so.tile((long)i * G + c, u)) { const int e = __builtin_amdgcn_readfirstlane(tab[u.pm]); u.pn += e * 8; return true; }
            i = rf;
        }
        const int q = (i - rf) * G + c, ntail = (NT - F) * 8 * S;
        if (q >= ntail) return false;
        const int tu = q / S, sl = q - tu * S, rt = F + (tu >> 3), pl = tu & 7;
        const int e = __builtin_amdgcn_readfirstlane(tab[rt]);
        u.pm = rt; u.pn = e * 8 + pl; u.ka = sl * (FF / S); u.kb = u.ka; u.nt = (FF / 64) / S; u.aux = 1 + sl; return true;
    }
};

template <class Epi, class Sched>
__device__ __forceinline__ void gemm_phase(PG8_LAS unsigned char* lds, const Gemm g, const Sched& S, const Epi& E) {
    int tid = threadIdx.x; asm volatile("" : "+v"(tid));
    const int wid = __builtin_amdgcn_readfirstlane(tid >> 6), lane = tid & 63, wr = wid >> 2, wc = wid & 3, fr = lane & 15, fq = lane >> 4;
    int K = g.K, lda = g.lda; asm volatile("" : "+s"(K), "+s"(lda));
    const int nt = K / BK;
    unsigned voffA[2], voffB[2];
#pragma unroll
    for (int i = 0; i < 2; ++i) { int R, C; stage_rc(tid * 16 + i * 8192, R, C); const int Rb = Epi::PERM ? ((R & ~31) + perm32(R & 31)) : R;
        voffA[i] = (unsigned)(R * lda + C) * 2u; voffB[i] = (unsigned)(Rb * K + C) * 2u; }
    const size_t kstep = (size_t)(BK * 2);
    const size_t hstepA = (size_t)HALF * lda * 2, hstepB = (size_t)HALF * K * 2;
    const size_t tstepA = 2 * hstepA, tstepB = 2 * hstepB;
    const unsigned ldsw = (unsigned)wid * 1024u;
    const int aoff = lds_byte(wr * 64 + fr, fq * 8), boff = lds_byte(wc * 32 + fr, fq * 8);
#define PG8_SA(b, h) (((b) * 2 + (h)) * HTB)
#define PG8_SB(b, h) ((4 + (b) * 2 + (h)) * HTB)
#define PG8_STAGE(bufoff, gbase, voff) do { _Pragma("unroll") for (int _i = 0; _i < 2; ++_i) \
        __builtin_amdgcn_global_load_lds((const GLB unsigned*)((const char*)(gbase) + (voff)[_i]), (PG8_LAS unsigned*)(lds + (bufoff) + ldsw + _i * 8192), 16, 0, 0); } while (0)
#define PG8_LDA(dst, b, h) do { _Pragma("unroll") for (int m = 0; m < 4; ++m) _Pragma("unroll") for (int k = 0; k < 2; ++k) dst[m][k] = *(const PG8_LAS bf16x8*)(lds + PG8_SA(b, h) + aoff + m * 2048 + k * 1024); } while (0)
#define PG8_LDB(dst, b, h) do { _Pragma("unroll") for (int n = 0; n < 2; ++n) _Pragma("unroll") for (int k = 0; k < 2; ++k) dst[n][k] = *(const PG8_LAS bf16x8*)(lds + PG8_SB(b, h) + boff + n * 2048 + k * 1024); } while (0)
#define PG8_MMA(ai, bj, At, Bt) do { __builtin_amdgcn_s_setprio(1); _Pragma("unroll") for (int m = 0; m < 4; ++m) _Pragma("unroll") for (int n = 0; n < 2; ++n) _Pragma("unroll") for (int k = 0; k < 2; ++k) \
        acc[ai][bj][m][n] = __builtin_amdgcn_mfma_f32_16x16x32_bf16(Bt[n][k], At[m][k], acc[ai][bj][m][n], 0, 0, 0); __builtin_amdgcn_s_setprio(0); } while (0)
#define PG8_WAIT_V(n) asm volatile("s_waitcnt vmcnt(" #n ")" ::: "memory")
#define PG8_WAIT_L(n) asm volatile("s_waitcnt lgkmcnt(" #n ")" ::: "memory")
#define PG8_BAR __builtin_amdgcn_s_barrier()
#define PG8_SCHED __builtin_amdgcn_sched_barrier(0)
    Unit cur, nxt; int ui = 0;
    if (!S.next(0, cur)) return;
    f32x4 acc[2][2][4][2];
#pragma unroll
    for (int a = 0; a < 2; ++a)
#pragma unroll
        for (int b = 0; b < 2; ++b)
#pragma unroll
            for (int m = 0; m < 4; ++m)
#pragma unroll
                for (int n = 0; n < 2; ++n) acc[a][b][m][n] = (f32x4){0.f, 0.f, 0.f, 0.f};
    bf16x8 At[4][2], B0[2][2], B1[2][2];
    const char* cA = (const char*)g.A + (size_t)cur.pm * tstepA + (size_t)cur.ka * 2; const char* cB = (const char*)g.Bt + (size_t)cur.pn * tstepB + (size_t)cur.kb * 2;
    PG8_STAGE(PG8_SB(0, 0), cB, voffB); PG8_STAGE(PG8_SB(0, 1), cB + hstepB, voffB); PG8_STAGE(PG8_SA(0, 0), cA, voffA); PG8_STAGE(PG8_SA(0, 1), cA + hstepA, voffA);
    if (wr == 1) PG8_BAR;
    PG8_WAIT_V(2); PG8_BAR;
    PG8_STAGE(PG8_SB(1, 0), cB + kstep, voffB); PG8_STAGE(PG8_SA(1, 0), cA + kstep, voffA); PG8_STAGE(PG8_SB(1, 1), cB + hstepB + kstep, voffB);
    PG8_WAIT_V(6); PG8_BAR;
    for (;;) {
        const bool has_next = S.next(ui + 1, nxt);
        const char* nA = has_next ? (const char*)g.A + (size_t)nxt.pm * tstepA + (size_t)nxt.ka * 2 : cA; const char* nB = has_next ? (const char*)g.Bt + (size_t)nxt.pn * tstepB + (size_t)nxt.kb * 2 : cB;
        const int ntu = cur.nt ? cur.nt : nt;
        for (int t = 0; t < ntu; t += 2) {
            const bool last = (t == ntu - 2);
            const char* a1 = cA + (size_t)(t + 1) * kstep;
            const char* a2 = last ? nA : cA + (size_t)(t + 2) * kstep; const char* b2 = last ? nB : cB + (size_t)(t + 2) * kstep;
            const char* a3 = a2 + kstep; const char* b3 = b2 + kstep;
            PG8_LDB(B0, 0, 0); PG8_LDB(B1, 0, 1); PG8_SCHED; PG8_LDA(At, 0, 0); PG8_STAGE(PG8_SA(1, 1), a1 + hstepA, voffA);
            PG8_WAIT_V(8); PG8_WAIT_L(0); PG8_BAR; PG8_MMA(0, 0, At, B0); PG8_MMA(0, 1, At, B1); PG8_BAR; PG8_SCHED;
            PG8_LDA(At, 0, 1); PG8_STAGE(PG8_SB(0, 0), b2, voffB); PG8_STAGE(PG8_SB(0, 1), b2 + hstepB, voffB); PG8_STAGE(PG8_SA(0, 0), a2, voffA);
            PG8_WAIT_V(8); PG8_WAIT_L(0); PG8_BAR; PG8_MMA(1, 0, At, B0); PG8_MMA(1, 1, At, B1); PG8_BAR; PG8_SCHED;
            PG8_LDB(B0, 1, 0); PG8_LDB(B1, 1, 1); PG8_SCHED; PG8_LDA(At, 1, 0); PG8_STAGE(PG8_SA(0, 1), a2 + hstepA, voffA);
            PG8_WAIT_V(8); PG8_WAIT_L(0); PG8_BAR; PG8_MMA(0, 0, At, B0); PG8_MMA(0, 1, At, B1); PG8_BAR; PG8_SCHED;
            PG8_LDA(At, 1, 1); PG8_STAGE(PG8_SB(1, 0), b3, voffB); PG8_STAGE(PG8_SB(1, 1), b3 + hstepB, voffB); PG8_STAGE(PG8_SA(1, 0), a3, voffA);
            PG8_WAIT_V(8); PG8_WAIT_L(0); PG8_BAR; PG8_MMA(1, 0, At, B0); PG8_MMA(1, 1, At, B1); PG8_BAR; PG8_SCHED;
        }
        if (wr == 0) PG8_BAR;
        E(acc, cur, wr, wc, fr, fq);
        if (!has_next) break;
#pragma unroll
        for (int a = 0; a < 2; ++a)
#pragma unroll
            for (int b = 0; b < 2; ++b)
#pragma unroll
                for (int m = 0; m < 4; ++m)
#pragma unroll
                    for (int n = 0; n < 2; ++n) acc[a][b][m][n] = (f32x4){0.f, 0.f, 0.f, 0.f};
        cur = nxt; cA = nA; cB = nB; ++ui;
        if (wr == 1) PG8_BAR;
    }
    PG8_WAIT_V(0);
    PG8_BAR;
#undef PG8_SA
#undef PG8_SB
#undef PG8_STAGE
#undef PG8_LDA
#undef PG8_LDB
#undef PG8_MMA
#undef PG8_WAIT_V
#undef PG8_WAIT_L
#undef PG8_BAR
#undef PG8_SCHED
}

#define EPI_ROWS(u) const int row0 = (u).pm * BM + wr * 64 + fr; const int ct0 = wc * 32 + 8 * fq
#define EPI_FOR_ROWS _Pragma("unroll") for (int ai = 0; ai < 2; ++ai) _Pragma("unroll") for (int m = 0; m < 4; ++m)
__device__ __forceinline__ u32x4 pack8(f32x4 v0, f32x4 v1) { u32x4 w; w.x = pk2(v0[0], v0[1]); w.y = pk2(v0[2], v0[3]); w.z = pk2(v1[0], v1[1]); w.w = pk2(v1[2], v1[3]); return w; }
__device__ __forceinline__ void unpack8(u32x4 w, f32x4& v0, f32x4& v1) { v0 = (f32x4){bflo(w.x), bfhi(w.x), bflo(w.y), bfhi(w.y)}; v1 = (f32x4){bflo(w.z), bfhi(w.z), bflo(w.w), bfhi(w.w)}; }
__device__ __forceinline__ f32x4 sig4(f32x4 v) { return (f32x4){sigmoidf_(v[0]), sigmoidf_(v[1]), sigmoidf_(v[2]), sigmoidf_(v[3])}; }

struct EpiWin { static constexpr bool PERM = true;
    GLB bf16_t* sbqkv; GLB bf16_t* uf; GLB bf16_t* gate;
    __device__ __forceinline__ void operator()(const f32x4 (&acc)[2][2][4][2], const Unit& u, int wr, int wc, int fr, int fq) const {
        EPI_ROWS(u); const int pn = u.pn;
        if (pn < 40) {
            GLB bf16_t* base = (pn < 12) ? sbqkv + pn * 256 : uf + (pn - 12) * 256; const int ld = (pn < 12) ? 3072 : UFW;
            EPI_FOR_ROWS { GLB bf16_t* rp = base + (size_t)(row0 + ai * HALF + m * 16) * ld + ct0;
#pragma unroll
                for (int bj = 0; bj < 2; ++bj) *(GLB u32x4*)(rp + bj * HALF) = pack8(acc[ai][bj][m][0], acc[ai][bj][m][1]); }
        } else {
            EPI_FOR_ROWS { GLB bf16_t* rp = gate + (size_t)(row0 + ai * HALF + m * 16) * 8192 + (pn - 40) * 256 + ct0;
#pragma unroll
                for (int bj = 0; bj < 2; ++bj) *(GLB u32x4*)(rp + bj * HALF) = pack8(sig4(acc[ai][bj][m][0]), sig4(acc[ai][bj][m][1])); }
        }
    }
};
struct EpiNull { static constexpr bool PERM = true;
    __device__ __forceinline__ void operator()(const f32x4 (&acc)[2][2][4][2], const Unit& u, int wr, int wc, int fr, int fq) const {
#pragma unroll
        for (int ai = 0; ai < 2; ++ai)
#pragma unroll
            for (int bj = 0; bj < 2; ++bj) asm volatile("" :: "v"(acc[ai][bj][0][0]), "v"(acc[ai][bj][0][1]), "v"(acc[ai][bj][1][0]), "v"(acc[ai][bj][1][1]), "v"(acc[ai][bj][2][0]), "v"(acc[ai][bj][2][1]), "v"(acc[ai][bj][3][0]), "v"(acc[ai][bj][3][1]));
    }
};
struct EpiLora { static constexpr bool PERM = true;
    GLB float* dec; GLB bf16_t* aa; GLB bf16_t* gg; const GLB float* w0; const GLB float* a0;
    __device__ __forceinline__ void operator()(const f32x4 (&acc)[2][2][4][2], const Unit& u, int wr, int wc, int fr, int fq) const {
        EPI_ROWS(u); const int kind = u.pn >> 2, cb = (u.pn & 3) * 256 + ct0;
        EPI_FOR_ROWS { const size_t ro = (size_t)(row0 + ai * HALF + m * 16) * 1024 + cb;
#pragma unroll
            for (int bj = 0; bj < 2; ++bj) { const int co = bj * HALF;
                if (kind == 0) {
#pragma unroll
                    for (int n = 0; n < 2; ++n) { const f32x4 v = acc[ai][bj][m][n]; const f32x4 b = *(const GLB f32x4*)(w0 + cb + co + 4 * n); f32x4 o;
#pragma unroll
                        for (int j = 0; j < 4; ++j) { const float pre = v[j] + b[j]; const float y = -pre; const float sp = fmaxf(y, 0.f) + __logf(1.0f + __expf(-fabsf(y)));
                            o[j] = __expf(-__expf(-sp - 0.5f)); }
                        *(GLB f32x4*)(dec + ro + co + 4 * n) = o; }
                } else if (kind == 1) { const f32x4 b0 = *(const GLB f32x4*)(a0 + cb + co), b1 = *(const GLB f32x4*)(a0 + cb + co + 4);
                    *(GLB u32x4*)(aa + ro + co) = pack8(sig4(acc[ai][bj][m][0] + b0), sig4(acc[ai][bj][m][1] + b1)); }
                else *(GLB u32x4*)(gg + ro + co) = pack8(acc[ai][bj][m][0], acc[ai][bj][m][1]); } }
    }
};
struct EpiBranch { static constexpr bool PERM = true;
    const GLB bf16_t* gate; GLB bf16_t* gout;
    __device__ __forceinline__ void operator()(const f32x4 (&acc)[2][2][4][2], const Unit& u, int wr, int wc, int fr, int fq) const {
        EPI_ROWS(u); const int n = u.pn >> 3, cb = (u.pn & 7) * 256 + ct0;
        EPI_FOR_ROWS { const size_t r = (size_t)(row0 + ai * HALF + m * 16);
#pragma unroll
            for (int bj = 0; bj < 2; ++bj) { const int c = cb + bj * HALF; f32x4 g0, g1; unpack8(*(const GLB u32x4*)(gate + r * 8192 + n * 2048 + c), g0, g1);
                f32x4 s0 = g0 * acc[ai][bj][m][0], s1 = g1 * acc[ai][bj][m][1];
                GLB u32x4* gp = (GLB u32x4*)(gout + r * 2048 + c);
                if (n > 0) { f32x4 p0, p1; unpack8(*gp, p0, p1); s0 += p0; s1 += p1; }
                *gp = pack8(s0, s1); } }
    }
};
template <bool RB, bool OB>
struct EpiResid { static constexpr bool PERM = true;
    const GLB void* resid; GLB void* out;
    __device__ __forceinline__ void operator()(const f32x4 (&acc)[2][2][4][2], const Unit& u, int wr, int wc, int fr, int fq) const {
        EPI_ROWS(u); const int cb = u.pn * 256 + ct0;
        EPI_FOR_ROWS { const size_t ro = (size_t)(row0 + ai * HALF + m * 16) * D + cb;
#pragma unroll
            for (int bj = 0; bj < 2; ++bj) { f32x4 r0, r1;
                if (RB) unpack8(*(const GLB u32x4*)((const GLB bf16_t*)resid + ro + bj * HALF), r0, r1);
                else { r0 = *(const GLB f32x4*)((const GLB float*)resid + ro + bj * HALF); r1 = *(const GLB f32x4*)((const GLB float*)resid + ro + bj * HALF + 4); }
                r0 = r0 + acc[ai][bj][m][0]; r1 = r1 + acc[ai][bj][m][1];
                if (OB) *(GLB u32x4*)((GLB bf16_t*)out + ro + bj * HALF) = pack8(r0, r1);
                else { *(GLB f32x4*)((GLB float*)out + ro + bj * HALF) = r0; *(GLB f32x4*)((GLB float*)out + ro + bj * HALF + 4) = r1; } } }
    }
};
struct EpiUp { static constexpr bool PERM = true;
    GLB bf16_t* act;
    __device__ __forceinline__ void operator()(const f32x4 (&acc)[2][2][4][2], const Unit& u, int wr, int wc, int fr, int fq) const {
        EPI_ROWS(u); const int cb = (u.pn % NCT_UP) * 128 + ct0;
        EPI_FOR_ROWS { f32x4 o[2];
#pragma unroll
            for (int n = 0; n < 2; ++n) { const f32x4 g = acc[ai][0][m][n], up = acc[ai][1][m][n];
#pragma unroll
                for (int j = 0; j < 4; ++j) o[n][j] = g[j] * sigmoidf_(g[j]) * up[j]; }
            *(GLB u32x4*)(act + (size_t)(row0 + ai * HALF + m * 16) * FF + cb) = pack8(o[0], o[1]); }
    }
};
struct EpiMoeDown { static constexpr bool PERM = true;
    GLB bf16_t* os; const GLB float* wslot; GLB float* osp; int S;
    __device__ __forceinline__ void operator()(const f32x4 (&acc)[2][2][4][2], const Unit& u, int wr, int wc, int fr, int fq) const {
        EPI_ROWS(u); const int pl = u.pn % NCT_DN;
        if (u.aux == 0) {
            const int cb = pl * 256 + ct0;
            EPI_FOR_ROWS { const int r = row0 + ai * HALF + m * 16; const float w = wslot[r]; GLB bf16_t* rp = os + (size_t)r * D + cb;
#pragma unroll
                for (int bj = 0; bj < 2; ++bj) *(GLB u32x4*)(rp + bj * HALF) = pack8(acc[ai][bj][m][0] * w, acc[ai][bj][m][1] * w); }
        } else {
            GLB float* tp = osp + ((size_t)(((u.pm - 64) * 8 + pl) * S + (u.aux - 1)) << 16);
            EPI_FOR_ROWS { const int rl = wr * 64 + fr + ai * HALF + m * 16; const float w = wslot[u.pm * BM + rl]; GLB float* rp = tp + rl * 256 + ct0;
#pragma unroll
                for (int bj = 0; bj < 2; ++bj) { *(GLB f32x4*)(rp + bj * HALF) = acc[ai][bj][m][0] * w; *(GLB f32x4*)(rp + bj * HALF + 4) = acc[ai][bj][m][1] * w; } }
        }
    }
};
template <bool OB>
struct EpiPle { static constexpr bool PERM = true;
    const GLB bf16_t* resid; GLB void* out; const GLB bf16_t* proj;
    __device__ __forceinline__ void operator()(const f32x4 (&acc)[2][2][4][2], const Unit& u, int wr, int wc, int fr, int fq) const {
        EPI_ROWS(u); const int cb = u.pn * 256 + ct0;
        EPI_FOR_ROWS { const size_t ro = (size_t)(row0 + ai * HALF + m * 16) * D + cb;
#pragma unroll
            for (int bj = 0; bj < 2; ++bj) { f32x4 p0, p1, r0, r1; unpack8(*(const GLB u32x4*)(proj + ro + bj * HALF), p0, p1); unpack8(*(const GLB u32x4*)(resid + ro + bj * HALF), r0, r1);
                r0 = r0 + sig4(acc[ai][bj][m][0]) * p0; r1 = r1 + sig4(acc[ai][bj][m][1]) * p1;
                if (OB) *(GLB u32x4*)((GLB bf16_t*)out + ro + bj * HALF) = pack8(r0, r1);
                else { *(GLB f32x4*)((GLB float*)out + ro + bj * HALF) = r0; *(GLB f32x4*)((GLB float*)out + ro + bj * HALF + 4) = r1; } } }
    }
};
struct EpiProj { static constexpr bool PERM = true;
    GLB bf16_t* proj;
    __device__ __forceinline__ void operator()(const f32x4 (&acc)[2][2][4][2], const Unit& u, int wr, int wc, int fr, int fq) const {
        EPI_ROWS(u); GLB bf16_t* base = proj + (size_t)(u.pn >> 3) * T * D + (u.pn & 7) * 256 + ct0;
        EPI_FOR_ROWS { GLB bf16_t* rp = base + (size_t)(row0 + ai * HALF + m * 16) * D;
#pragma unroll
            for (int bj = 0; bj < 2; ++bj) *(GLB u32x4*)(rp + bj * HALF) = pack8(acc[ai][bj][m][0], acc[ai][bj][m][1]); }
    }
};
}
struct Ctx {
    LAS unsigned char* lds;
    GLB unsigned char* ws;
    GLB float* out;
    int tid, lane, wave, gw, NGW, G;
};
#define WSP(type, off) ((GLB type*)(C.ws + (off)))
constexpr int INTAB_OFF = MISC_OFF + 1024;
constexpr int TAB_WS = 37, TAB_OUT = 38, TAB_RANGE = 39;
__device__ __forceinline__ const GLB void* inptr(LAS unsigned char* lds, int i) {
    const LAS unsigned* t = (const LAS unsigned*)(lds + INTAB_OFF) + 2 * i;
    const unsigned lo = __builtin_amdgcn_readfirstlane(t[0]), hi = __builtin_amdgcn_readfirstlane(t[1]);
    return (const GLB void*)(((unsigned long long)hi << 32) | lo);
}
#define INF32(i) ((const GLB float*)inptr(C.lds, (i)))
__device__ __forceinline__ Ctx make_ctx(LAS unsigned char* lds) {
    Ctx C; C.lds = lds;
    int tid = threadIdx.x; asm volatile("" : "+v"(tid));
    C.tid = tid; C.lane = tid & 63; C.wave = __builtin_amdgcn_readfirstlane(tid >> 6);
    C.G = gridDim.x; C.gw = blockIdx.x * NWAVES + C.wave; C.NGW = C.G * NWAVES;
    C.ws = (GLB unsigned char*)inptr(lds, TAB_WS); C.out = (GLB float*)inptr(lds, TAB_OUT);
    return C;
}
enum { I_X = 0, I_P, I_POS, I_WIN, I_MIXN, I_FFNN, I_PLEN, I_RWMU, I_RWW0, I_RWW2, I_RWA0, I_RWA2, I_RWG2, I_RWKK, I_RWKA, I_RWRK, I_RWLNG, I_RWLNB,
       I_DQN, I_DKN, I_DKVN, I_DWUK, I_DWUV, I_SQN, I_SKN, I_SSINK, I_WBR, I_WOUT, I_FG, I_FU, I_FD, I_MR, I_MG, I_MU, I_MD, I_PG, I_PP, N_INPUTS };

__device__ __forceinline__ void conv_tile(const GLB float* W, int ldw, int k0, int s0, int nv, GLB bf16_t* Bt, int K, int n0, LAS float* scr, int lane) {
    const int cq = lane & 15, rq = lane >> 4;
    f32x4 v[16];
#pragma unroll
    for (int i = 0; i < 16; ++i) {
        const int kk = 4 * i + rq;
        v[i] = (4 * cq < nv) ? *(const GLB f32x4*)(W + (size_t)(k0 + kk) * ldw + s0 + 4 * cq) : (f32x4){0.f, 0.f, 0.f, 0.f};
    }
#pragma unroll
    for (int i = 0; i < 16; ++i) { const int kk = 4 * i + rq; LAS float* d = scr + kk * 65 + 4 * cq; d[0] = v[i][0]; d[1] = v[i][1]; d[2] = v[i][2]; d[3] = v[i][3]; }
    LDS_WAIT();
    const int c = lane & 7;
#pragma unroll
    for (int j = 0; j < 8; ++j) { const int n = (lane >> 3) + 8 * j; const LAS float* s = scr + (8 * c) * 65 + n;
        u32x4 o; o.x = pk2(s[0 * 65], s[1 * 65]); o.y = pk2(s[2 * 65], s[3 * 65]); o.z = pk2(s[4 * 65], s[5 * 65]); o.w = pk2(s[6 * 65], s[7 * 65]);
        *(GLB u32x4*)(Bt + (size_t)(n0 + n) * K + k0 + 8 * c) = o; }
    LDS_WAIT();
}
__device__ __forceinline__ void win_map(int g, int& s0, int& nv) {
    const int d0 = 64 * g; nv = 64;
    if (d0 < 8704) s0 = d0;
    else if (d0 < 9728) s0 = 8784 + (d0 - 8704);
    else if (d0 < 9984) s0 = 9808 + (d0 - 9728);
    else if (d0 < 10240) { const int off = d0 - 9984; if (off == 0) s0 = 8704; else if (off == 64) { s0 = 8768; nv = 16; } else { s0 = 0; nv = 0; } }
    else s0 = 10064 + (d0 - 10240);
}
#ifndef MOE_SCAN_TILES
#define MOE_SCAN_TILES 42
#endif
#ifndef MOE_CONV_IN_PROLOGUE
#define MOE_CONV_IN_PROLOGUE 0
#endif
constexpr int MOE_CONV_ITEMS = NE * ((D / 64) * (2 * FF / 64) + (FF / 64) * (D / 64));
__device__ __forceinline__ void conv_moe_item(const Ctx& C, int idx, LAS float* scr, int lane) {
    constexpr int I_GU1 = (D / 64) * (2 * FF / 64), I_DN1 = (FF / 64) * (D / 64);
    if (idx < NE * I_GU1) {
        const int e = idx / I_GU1, r = idx % I_GU1, nb = r % (2 * FF / 64), kb = r / (2 * FF / 64);
        const int tile = nb >> 2, q = nb & 3; const int sc = 128 * tile + 64 * (q & 1);
        conv_tile(((q < 2) ? INF32(I_MG) : INF32(I_MU)) + (size_t)e * D * FF, FF, 64 * kb, sc, 64, WSP(bf16_t, WS_MWGU) + (size_t)e * 2 * FF * D, D, 64 * nb, scr, lane);
    } else {
        const int r0 = idx - NE * I_GU1, e = r0 / I_DN1, r = r0 % I_DN1, nb = r % 32, kb = r / 32;
        conv_tile(INF32(I_MD) + (size_t)e * FF * D, D, 64 * kb, 64 * nb, 64, WSP(bf16_t, WS_MWD) + (size_t)e * D * FF, FF, 64 * nb, scr, lane);
    }
}
__device__ __forceinline__ void ph_prologue(const Ctx& C) {
    LAS float* scr = (LAS float*)(C.lds + C.wave * 16640);
    const int gw = C.gw, NGW = C.NGW; int lane = C.lane; asm volatile("" : "+v"(lane)); lane &= 63;
    constexpr int I_WIN1 = (D / 64) * (N_INP / 64);
    constexpr int I_BR1 = (1024 / 64) * (2048 / 64);
    constexpr int I_DD = (D / 64) * (D / 64);
    constexpr int I_GU1 = (D / 64) * (2 * FF / 64);
    constexpr int I_DN1 = (FF / 64) * (D / 64);
    constexpr int I_PP1 = (256 / 64) * (D / 64);
    constexpr int S0 = 0, S1 = S0 + NL * I_WIN1, S2 = S1 + NL * 4 * I_BR1, S3 = S2 + NL * I_DD, S4 = S3 + I_GU1, S5 = S4 + I_DN1, S6 = S5 + NE * I_GU1, S7 = S6 + NE * I_DN1,
                  S8 = S7 + NL * I_DD, S9 = S8 + NL * I_PP1;
    for (int it = gw; it < S9; it += NGW) {
        if (it < S1) { const int l = it / I_WIN1, r = it % I_WIN1, nb = r % (N_INP / 64), kb = r / (N_INP / 64); int s0, nv; win_map(nb, s0, nv);
            conv_tile(INF32(I_WIN) + (size_t)l * D * N_IN, N_IN, 64 * kb, s0, nv, WSP(bf16_t, WS_WIN + l * SZ_WIN1), D, 64 * nb, scr, lane); }
        else if (it < S2) { const int q = (it - S1) / I_BR1, r = (it - S1) % I_BR1, nb = r % 32, kb = r / 32;
            conv_tile(INF32(I_WBR) + (size_t)q * 1024 * 2048, 2048, 64 * kb, 64 * nb, 64, WSP(bf16_t, WS_WBR) + (size_t)q * 2048 * 1024, 1024, 64 * nb, scr, lane); }
        else if (it < S3) { const int l = (it - S2) / I_DD, r = (it - S2) % I_DD, nb = r % 32, kb = r / 32;
            conv_tile(INF32(I_WOUT) + (size_t)l * D * D, D, 64 * kb, 64 * nb, 64, WSP(bf16_t, WS_WOUT + l * SZ_DD), D, 64 * nb, scr, lane); }
        else if (it < S4) {
            const int r = it - S3, nb = r % (2 * FF / 64), kb = r / (2 * FF / 64);
            const int tile = nb >> 2, q = nb & 3; const int sc = 128 * tile + 64 * (q & 1);
            conv_tile((q < 2) ? INF32(I_FG) : INF32(I_FU), FF, 64 * kb, sc, 64, WSP(bf16_t, WS_WGU), D, 64 * nb, scr, lane); }
        else if (it < S5) { const int r = it - S4, nb = r % 32, kb = r / 32;
            conv_tile(INF32(I_FD), D, 64 * kb, 64 * nb, 64, WSP(bf16_t, WS_WD), FF, 64 * nb, scr, lane); }
        else if (it < S7) { if (MOE_CONV_IN_PROLOGUE || it - S5 >= 2 * 1024 * MOE_SCAN_TILES) conv_moe_item(C, it - S5, scr, lane); }
        else if (it < S8) { const int l = (it - S7) / I_DD, r = (it - S7) % I_DD, nb = r % 32, kb = r / 32;
            conv_tile(INF32(I_PG) + (size_t)l * D * D, D, 64 * kb, 64 * nb, 64, WSP(bf16_t, WS_WPG + l * SZ_DD), D, 64 * nb, scr, lane); }
        else { const int l = (it - S8) / I_PP1, r = (it - S8) % I_PP1, nb = r % 32, kb = r / 32;
            conv_tile(INF32(I_PP) + (size_t)l * 256 * D, D, 64 * kb, 64 * nb, 64, WSP(bf16_t, WS_WPP) + (size_t)l * D * 256, 256, 64 * nb, scr, lane); }
    }
    for (int idx = gw * 64 + lane; idx < NL * 3072 * 256; idx += NGW * 64) {
        const int k = idx & 255, n = (idx >> 8) % 3072, l = idx / (3072 * 256);
        float v = 0.f;
        if (n < 1024) { if (k < 96) v = INF32(I_RWW2)[((size_t)l * 96 + k) * 1024 + n]; }
        else if (n < 2048) { if (k >= 96 && k < 192) v = INF32(I_RWA2)[((size_t)l * 96 + (k - 96)) * 1024 + (n - 1024)]; }
        else { if (k >= 192) v = INF32(I_RWG2)[((size_t)l * 64 + (k - 192)) * 1024 + (n - 2048)]; }
        WSP(bf16_t, WS_WLORA)[idx] = (bf16_t)f2bf(v);
    }
    for (int idx = gw * 64 + lane; idx < NL * T * 64; idx += NGW * 64) {
        const int c4 = idx & 63, t = (idx >> 6) % T, l = idx / (T * 64);
        const f32x4 v = *(const GLB f32x4*)(INF32(I_P) + ((size_t)l * T + t) * 256 + 4 * c4);
        u32x2 o; o.x = pk2(v[0], v[1]); o.y = pk2(v[2], v[3]);
        *(GLB u32x2*)(WSP(bf16_t, WS_PCAT) + (size_t)t * 512 + l * 256 + 4 * c4) = o;
    }
}

template <int MODE, bool XBF = true>
__device__ __forceinline__ void ph_norm(const Ctx& C, const GLB void* xin, GLB void* xout, const GLB float* gain, const GLB float* router, int moeS = 1) {
    int lane = C.lane; asm volatile("" : "+v"(lane)); lane &= 63;
    for (int m = C.gw; m < T; m += C.NGW) {
        f32x4 v[8]; float s = 0.f;
        if (XBF) { const GLB u32x2* xr = (const GLB u32x2*)((const GLB bf16_t*)xin + (size_t)m * D) + lane;
#pragma unroll
            for (int j = 0; j < 8; ++j) { const u32x2 w = xr[64 * j]; v[j] = (f32x4){bflo(w.x), bfhi(w.x), bflo(w.y), bfhi(w.y)}; }
        } else { const GLB f32x4* xr = (const GLB f32x4*)((const GLB float*)xin + (size_t)m * D) + lane;
#pragma unroll
            for (int j = 0; j < 8; ++j) v[j] = xr[64 * j]; }
        if (MODE == 2) {
            const GLB int* ts = WSP(int, WS_TOKSLOT) + 2 * m;
#pragma unroll
            for (int q = 0; q < 2; ++q) {
                const int sl = ts[q];
                if (sl < 64 * 256 || moeS <= 1) {
                    const GLB u32x2* o0 = (const GLB u32x2*)(WSP(bf16_t, WS_OS) + (size_t)sl * D) + lane;
#pragma unroll
                    for (int j = 0; j < 8; ++j) { const u32x2 w = o0[64 * j]; v[j] = v[j] + (f32x4){bflo(w.x), bfhi(w.x), bflo(w.y), bfhi(w.y)}; }
                } else {
                    const int tu0 = ((sl >> 8) - 64) * 8, rl = sl & 255;
#pragma unroll
                    for (int j = 0; j < 8; ++j)
                        for (int k = 0; k < moeS; ++k) v[j] = v[j] + *((const GLB f32x4*)(WSP(float, WS_OSP) + ((size_t)((tu0 + j) * moeS + k) << 16) + rl * 256) + lane);
                }
            }
#pragma unroll
            for (int j = 0; j < 8; ++j) { u32x2 o; o.x = pk2(v[j][0], v[j][1]); o.y = pk2(v[j][2], v[j][3]); ((GLB u32x2*)((GLB bf16_t*)xout + (size_t)m * D) + lane)[64 * j] = o;
                v[j] = (f32x4){bflo(o.x), bfhi(o.x), bflo(o.y), bfhi(o.y)}; }
        }
#pragma unroll
        for (int j = 0; j < 8; ++j) s += (v[j][0] * v[j][0] + v[j][1] * v[j][1]) + (v[j][2] * v[j][2] + v[j][3] * v[j][3]);
        const float rstd = 1.0f / sqrtf(wave_sum(s) * (1.0f / D) + 1e-6f);
        GLB u32x2* o8 = (GLB u32x2*)(WSP(bf16_t, WS_H) + (size_t)m * D) + lane;
        float lg[NE];
        if (MODE == 1) {
#pragma unroll
            for (int e = 0; e < NE; ++e) lg[e] = 0.f;
        }
#pragma unroll
        for (int j = 0; j < 8; ++j) { const f32x4 g = ((const GLB f32x4*)gain)[lane + 64 * j]; const f32x4 hv = v[j] * rstd * g; v[j] = hv;
            u32x2 o; o.x = pk2(hv[0], hv[1]); o.y = pk2(hv[2], hv[3]); o8[64 * j] = o; }
        if (MODE == 1) {
#pragma unroll 2
            for (int j = 0; j < 8; ++j) {
#pragma unroll
                for (int q = 0; q < 4; ++q) { const GLB f32x4* rr = (const GLB f32x4*)(router + (size_t)(4 * (lane + 64 * j) + q) * NE); const f32x4 r0 = rr[0], r1 = rr[1]; const float hq = v[j][q];
                    lg[0] += hq * r0[0]; lg[1] += hq * r0[1]; lg[2] += hq * r0[2]; lg[3] += hq * r0[3]; lg[4] += hq * r1[0]; lg[5] += hq * r1[1]; lg[6] += hq * r1[2]; lg[7] += hq * r1[3]; }
            }
        }
        if (MODE == 1) {
#pragma unroll
            for (int e = 0; e < NE; ++e) lg[e] = wave_sum(lg[e]);
            if (lane == 0) {
                int e1 = 0; float v1 = lg[0];
#pragma unroll
                for (int e = 1; e < NE; ++e) if (lg[e] > v1) { v1 = lg[e]; e1 = e; }
                int e2 = -1; float v2 = -3.0e38f;
#pragma unroll
                for (int e = 0; e < NE; ++e) if (e != e1 && lg[e] > v2) { v2 = lg[e]; e2 = e; }
                const float ex = __expf(v2 - v1), w1 = 1.0f / (1.0f + ex), w2 = ex / (1.0f + ex);
                GLB unsigned* cnt = WSP(unsigned, WS_CTL) + CW_MOECNT;
                const unsigned p1 = atomicAdd((unsigned*)cnt + 64 * e1, 1u), p2 = atomicAdd((unsigned*)cnt + 64 * e2, 1u);
                GLB unsigned* rt = WSP(unsigned, WS_ROUTE) + (size_t)m * 8;
                rt[0] = (unsigned)e1; rt[1] = p1; rt[2] = __builtin_bit_cast(unsigned, w1); rt[3] = (unsigned)e2; rt[4] = p2; rt[5] = __builtin_bit_cast(unsigned, w2);
            }
        }
    }
}
__device__ __forceinline__ void moe_offsets(const Ctx& C, int (&toff)[NE + 1]) {
    const GLB unsigned* cnt = WSP(unsigned, WS_CTL) + CW_MOECNT; int acc = 0;
#pragma unroll
    for (int e = 0; e < NE; ++e) { toff[e] = acc; const unsigned c = __hip_atomic_load(cnt + 64 * e, __ATOMIC_RELAXED, __HIP_MEMORY_SCOPE_AGENT); acc += (int)((c + 255u) >> 8); }
    toff[NE] = acc;
}
constexpr int MOETAB_OFF = MISC_OFF + 2048;
__device__ __forceinline__ void moe_tile_table(const Ctx& C) {
    int toff[NE + 1]; moe_offsets(C, toff);
    LAS int* tab = (LAS int*)(C.lds + MOETAB_OFF);
    if (C.tid <= MOE_MAXRT) { int e = 0;
#pragma unroll
        for (int j = 1; j < NE; ++j) e += (C.tid >= toff[j]) ? 1 : 0;
        tab[C.tid] = (C.tid == MOE_MAXRT) ? toff[NE] : e; }
    LDS_WAIT(); __syncthreads();
}
__device__ __forceinline__ void ph_moe_gather(const Ctx& C) {
    int toff[NE + 1]; moe_offsets(C, toff);
    int lane = C.lane; asm volatile("" : "+v"(lane)); lane &= 63;
    for (int m = C.gw; m < T; m += C.NGW) {
        const GLB unsigned* rt = WSP(unsigned, WS_ROUTE) + (size_t)m * 8;
        const int e1 = (int)rt[0], p1 = (int)rt[1], e2 = (int)rt[3], p2 = (int)rt[4];
        int o1 = 0, o2 = 0;
#pragma unroll
        for (int e = 0; e < NE; ++e) { o1 = (e == e1) ? toff[e] : o1; o2 = (e == e2) ? toff[e] : o2; }
        const int s1 = o1 * 256 + p1, s2 = o2 * 256 + p2;
        const GLB u32x4* src = (const GLB u32x4*)(WSP(bf16_t, WS_H) + (size_t)m * D) + lane;
        GLB u32x4* d1 = (GLB u32x4*)(WSP(bf16_t, WS_HS) + (size_t)s1 * D) + lane; GLB u32x4* d2 = (GLB u32x4*)(WSP(bf16_t, WS_HS) + (size_t)s2 * D) + lane;
#pragma unroll
        for (int j = 0; j < 4; ++j) { const u32x4 v = src[64 * j]; d1[64 * j] = v; d2[64 * j] = v; }
        if (lane == 0) { WSP(int, WS_TOKSLOT)[2 * m] = s1; WSP(int, WS_TOKSLOT)[2 * m + 1] = s2;
            WSP(unsigned, WS_WSLOT)[s1] = rt[2]; WSP(unsigned, WS_WSLOT)[s2] = rt[5]; }
    }
}

__device__ __forceinline__ float rope_inv_freq(int i, int half) { return exp2f(-13.287712379549449f * (float)i / (float)half); }
__device__ __forceinline__ void ph_prep(const Ctx& C, int l) {
    int lane = C.lane; asm volatile("" : "+v"(lane)); lane &= 63;
    const GLB bf16_t* UF = WSP(bf16_t, WS_UF);
    const int d = lane & 31, hh = lane >> 5;
    for (int m = C.gw; m < T; m += C.NGW) {
        const int t = m % SEQ;
        const GLB bf16_t* u = UF + (size_t)m * UFW;
        const float posf = (float)((const GLB int*)inptr(C.lds, I_POS))[m];
        float qa[8], qb[8], ia[8], ib[8], sa[8], sb[8];
#pragma unroll
        for (int h = 0; h < 8; ++h) { qa[h] = bf1(u[UF_DQ + h * 128 + lane]); qb[h] = bf1(u[UF_DQ + h * 128 + 64 + lane]); }
#pragma unroll
        for (int hp = 0; hp < 8; ++hp) { const int h = 2 * hp + hh; ia[hp] = bf1(u[UF_IQ + h * 64 + d]); ib[hp] = bf1(u[UF_IQ + h * 64 + 32 + d]); sa[hp] = bf1(u[UF_SQ + h * 64 + d]); sb[hp] = bf1(u[UF_SQ + h * 64 + 32 + d]); }
        const float ika = bf1(u[UF_IK + d]), ikb = bf1(u[UF_IK + 32 + d]), iwv = bf1(u[UF_IW + (lane & 15)]);
        const float ska = bf1(u[UF_SK + hh * 64 + d]), skb = bf1(u[UF_SK + hh * 64 + 32 + d]), sv0 = bf1(u[UF_SV + lane]), sv1 = bf1(u[UF_SV + 64 + lane]);
        {
            const GLB float* mu = INF32(I_RWMU) + (size_t)l * 3328;
#pragma unroll
            for (int half = 0; half < 2; ++half) {
                constexpr int J0[2] = {0, 7}, J1[2] = {7, 13};
                f32x4 cur[7], prv[7], mm[7];
#pragma unroll
                for (int j = J0[half]; j < J1[half]; ++j) { const int c = 4 * (lane + 64 * j), q = j - J0[half];
                    { const u32x2 w = *(const GLB u32x2*)(u + UF_RW + c); cur[q] = (f32x4){bflo(w.x), bfhi(w.x), bflo(w.y), bfhi(w.y)}; }
                    if (t > 0) { const u32x2 w = *(const GLB u32x2*)(u - UFW + UF_RW + c); prv[q] = (f32x4){bflo(w.x), bfhi(w.x), bflo(w.y), bfhi(w.y)}; } else prv[q] = (f32x4){0.f, 0.f, 0.f, 0.f};
                    mm[q] = *(const GLB f32x4*)(mu + c); }
#pragma unroll
                for (int j = J0[half]; j < J1[half]; ++j) { const int c = 4 * (lane + 64 * j), q = j - J0[half];
                    const f32x4 o = cur[q] + mm[q] * (prv[q] - cur[q]);
                    if (j < 12) { GLB bf16_t* dst = WSP(bf16_t, (j < 4 ? WS_R : (j < 8 ? WS_K : WS_V))) + (size_t)m * 1024 + (c & 1023); u32x2 w; w.x = pk2(o[0], o[1]); w.y = pk2(o[2], o[3]); *(GLB u32x2*)dst = w; }
                    else { const int k = c - 3072; f32x4 a;
                        if (k < 96) a = (f32x4){tanhf(o[0]), tanhf(o[1]), tanhf(o[2]), tanhf(o[3])};
                        else if (k < 192) a = o;
                        else a = pg8::sig4(o);
                        u32x2 w; w.x = pk2(a[0], a[1]); w.y = pk2(a[2], a[3]);
                        *(GLB u32x2*)(WSP(bf16_t, WS_ALORA) + (size_t)m * 256 + k) = w; }
                }
            }
        }
        {
            const float invf = rope_inv_freq(lane, 64); float sn, cn; sincosf(posf * invf, &sn, &cn);
            const float g1 = INF32(I_DQN)[l * 128 + lane], g2 = INF32(I_DQN)[l * 128 + 64 + lane];
#pragma unroll
            for (int h = 0; h < 8; ++h) {
                const float a = qa[h], b = qb[h];
                const float rs = 1.0f / sqrtf(wave_sum(a * a + b * b) * (1.0f / 128.f) + 1e-6f);
                const float x1 = a * rs * g1, x2 = b * rs * g2;
                GLB bf16_t* q = WSP(bf16_t, WS_QD) + (size_t)m * 1024 + h * 128;
                q[lane] = (bf16_t)f2bf(x1 * cn - x2 * sn); q[64 + lane] = (bf16_t)f2bf(x2 * cn + x1 * sn);
            }
        }
        {
            const float invf = rope_inv_freq(d, 32); float sn, cn; sincosf(posf * invf, &sn, &cn);
#pragma unroll
            for (int hp = 0; hp < 8; ++hp) { const int h = 2 * hp + hh; const float a = ia[hp], b = ib[hp];
                GLB bf16_t* q = WSP(bf16_t, WS_QI) + (size_t)m * 1024 + h * 64; q[d] = (bf16_t)f2bf(a * cn - b * sn); q[32 + d] = (bf16_t)f2bf(b * cn + a * sn); }
            if (hh == 0) { GLB bf16_t* q = WSP(bf16_t, WS_KI) + (size_t)m * 64; q[d] = (bf16_t)f2bf(ika * cn - ikb * sn); q[32 + d] = (bf16_t)f2bf(ikb * cn + ika * sn); }
            if (lane < 16) WSP(float, WS_WI)[(size_t)m * 16 + lane] = iwv * 0.03125f;
            const float sg1 = INF32(I_SQN)[l * 64 + d], sg2 = INF32(I_SQN)[l * 64 + 32 + d];
#pragma unroll
            for (int hp = 0; hp < 8; ++hp) { const int h = 2 * hp + hh; const float a = sa[hp], b = sb[hp];
                float s2 = a * a + b * b;
#pragma unroll
                for (int o = 1; o < 32; o <<= 1) s2 += __shfl_xor(s2, o);
                const float rs = 1.0f / sqrtf(s2 * (1.0f / 64.f) + 1e-6f); const float x1 = a * rs * sg1, x2 = b * rs * sg2;
                GLB bf16_t* q = WSP(bf16_t, WS_QS) + (size_t)m * 1024 + h * 64; q[d] = (bf16_t)f2bf(x1 * cn - x2 * sn); q[32 + d] = (bf16_t)f2bf(x2 * cn + x1 * sn); }
            { const float kg1 = INF32(I_SKN)[l * 64 + d], kg2 = INF32(I_SKN)[l * 64 + 32 + d];
              float s2 = ska * ska + skb * skb;
#pragma unroll
              for (int o = 1; o < 32; o <<= 1) s2 += __shfl_xor(s2, o);
              const float rs = 1.0f / sqrtf(s2 * (1.0f / 64.f) + 1e-6f); const float x1 = ska * rs * kg1, x2 = skb * rs * kg2;
              GLB bf16_t* q = WSP(bf16_t, WS_KS) + (size_t)m * 128 + hh * 64; q[d] = (bf16_t)f2bf(x1 * cn - x2 * sn); q[32 + d] = (bf16_t)f2bf(x2 * cn + x1 * sn);
              GLB bf16_t* vv = WSP(bf16_t, WS_VS) + (size_t)m * 128; vv[lane] = (bf16_t)f2bf(sv0); vv[64 + lane] = (bf16_t)f2bf(sv1); }
        }
    }
}

__device__ __forceinline__ void ph_latent(const Ctx& C, int l) {
    int lane = C.lane; asm volatile("" : "+v"(lane)); lane &= 63;
    LAS float* cs = (LAS float*)(C.lds + C.wave * 8192);
    const GLB bf16_t* UF = WSP(bf16_t, WS_UF);
    const GLB float* wuk = INF32(I_DWUK) + (size_t)l * 256 * 128; const GLB float* wuv = INF32(I_DWUV) + (size_t)l * 256 * 128;
    for (int g8 = C.gw; g8 < T / 8; g8 += C.NGW) {
        const int m0 = 8 * g8;
        float cv[8][4];
#pragma unroll
        for (int tk = 0; tk < 8; ++tk)
#pragma unroll
            for (int j = 0; j < 4; ++j) cv[tk][j] = bf1(UF[(size_t)(m0 + tk) * UFW + UF_CKV + lane + 64 * j]);
#pragma unroll
        for (int tk = 0; tk < 8; ++tk) {
            float ss = 0.f;
#pragma unroll
            for (int j = 0; j < 4; ++j) ss += cv[tk][j] * cv[tk][j];
            const float rc = 1.0f / sqrtf(wave_sum(ss) * (1.0f / 256.f) + 1e-6f);
#pragma unroll
            for (int j = 0; j < 4; ++j) cs[(lane + 64 * j) * 8 + tk] = cv[tk][j] * rc * INF32(I_DKVN)[l * 256 + lane + 64 * j];
        }
        LDS_WAIT();
        float acc[8][4];
#pragma unroll
        for (int tk = 0; tk < 8; ++tk) { acc[tk][0] = 0.f; acc[tk][1] = 0.f; acc[tk][2] = 0.f; acc[tk][3] = 0.f; }
#pragma unroll 8
        for (int k = 0; k < 256; ++k) {
            const float w0 = wuk[k * 128 + lane], w1 = wuk[k * 128 + 64 + lane], w2 = wuv[k * 128 + lane], w3 = wuv[k * 128 + 64 + lane];
            const f32x4 ca = *(const LAS f32x4*)(cs + k * 8), cb = *(const LAS f32x4*)(cs + k * 8 + 4);
#pragma unroll
            for (int tk = 0; tk < 8; ++tk) { const float c = (tk < 4) ? ca[tk & 3] : cb[tk & 3]; acc[tk][0] += c * w0; acc[tk][1] += c * w1; acc[tk][2] += c * w2; acc[tk][3] += c * w3; }
        }
        const float invf = rope_inv_freq(lane, 64);
        const float g1 = INF32(I_DKN)[l * 128 + lane], g2 = INF32(I_DKN)[l * 128 + 64 + lane];
#pragma unroll
        for (int tk = 0; tk < 8; ++tk) {
            const int m = m0 + tk;
            const float posf = (float)((const GLB int*)inptr(C.lds, I_POS))[m];
            float sn, cn; sincosf(posf * invf, &sn, &cn);
            const float k1 = acc[tk][0], k2 = acc[tk][1];
            const float rk = 1.0f / sqrtf(wave_sum(k1 * k1 + k2 * k2) * (1.0f / 128.f) + 1e-6f);
            const float y1 = k1 * rk * g1, y2 = k2 * rk * g2;
            GLB bf16_t* kd = WSP(bf16_t, WS_KD) + (size_t)m * 128; GLB bf16_t* vd = WSP(bf16_t, WS_VD) + (size_t)m * 128;
            kd[lane] = (bf16_t)f2bf(y1 * cn - y2 * sn); kd[64 + lane] = (bf16_t)f2bf(y2 * cn + y1 * sn);
            vd[lane] = (bf16_t)f2bf(acc[tk][2]); vd[64 + lane] = (bf16_t)f2bf(acc[tk][3]);
        }
        LDS_WAIT();
    }
}

__device__ __forceinline__ void ph_rwkv_kk(const Ctx& C, int l) {
    int lane = C.lane; asm volatile("" : "+v"(lane)); lane &= 63;
    for (int m = C.gw; m < T; m += C.NGW) {
#pragma unroll
        for (int i = 0; i < 4; ++i) {
            const int c = 256 * i + 4 * lane; const size_t o = (size_t)m * 1024 + c;
            const f32x4 k = *(const GLB f32x4*)(WSP(float, WS_K) + o), a = *(const GLB f32x4*)(WSP(float, WS_AA) + o);
            const f32x4 kkw = *(const GLB f32x4*)(INF32(I_RWKK) + l * 1024 + c), ka = *(const GLB f32x4*)(INF32(I_RWKA) + l * 1024 + c);
            f32x4 kk = k * kkw; float s = (kk[0] * kk[0] + kk[1] * kk[1]) + (kk[2] * kk[2] + kk[3] * kk[3]);
#pragma unroll
            for (int q = 1; q < 16; q <<= 1) s += __shfl_xor(s, q);
            const float inv = 1.0f / fmaxf(sqrtf(s), 1e-12f); kk = kk * inv;
            *(GLB f32x4*)(WSP(float, WS_KK) + o) = kk;
            *(GLB f32x4*)(WSP(float, WS_K) + o) = k * (1.0f + (a - 1.0f) * ka);
            *(GLB f32x4*)(WSP(float, WS_AA) + o) = kk * a;
        }
    }
}
__device__ __forceinline__ void ph_rwkv_scan_naive(const Ctx& C) {
    if (C.wave != 0) return;
    int lane = C.lane; asm volatile("" : "+v"(lane)); lane &= 63;
    LAS float* buf = (LAS float*)C.lds;
    for (int it = blockIdx.x; it < NB * 16; it += C.G) {
        const int b = it >> 4, h = it & 15;
        float S[64];
#pragma unroll
        for (int k = 0; k < 64; ++k) S[k] = 0.f;
        const size_t base = (size_t)b * SEQ * 1024 + h * 64 + lane;
        for (int t0 = 0; t0 < SEQ; t0 += 16) {
#pragma unroll
            for (int st = 0; st < 16; ++st) { const size_t o = base + (size_t)(t0 + st) * 1024; LAS float* d = buf + st * 384 + lane;
                d[0] = WSP(float, WS_R)[o]; d[64] = WSP(float, WS_DEC)[o]; d[128] = WSP(float, WS_K)[o]; d[192] = WSP(float, WS_KK)[o]; d[256] = WSP(float, WS_AA)[o]; d[320] = WSP(float, WS_V)[o]; }
            LDS_WAIT();
            for (int st = 0; st < 16; ++st) {
                const LAS float* rb = buf + st * 384;
                float p = 0.f;
#pragma unroll
                for (int k = 0; k < 64; k += 4) { const f32x4 q = *(const LAS f32x4*)(rb + 192 + k); p += S[k] * q[0] + S[k + 1] * q[1] + S[k + 2] * q[2] + S[k + 3] * q[3]; }
                const float vv = rb[320 + lane]; float y = 0.f;
#pragma unroll
                for (int k = 0; k < 64; k += 4) { const f32x4 w = *(const LAS f32x4*)(rb + 64 + k), bb = *(const LAS f32x4*)(rb + 256 + k), kq = *(const LAS f32x4*)(rb + 128 + k), r = *(const LAS f32x4*)(rb + k);
#pragma unroll
                    for (int j = 0; j < 4; ++j) { S[k + j] = S[k + j] * w[j] - p * bb[j] + vv * kq[j]; y += S[k + j] * r[j]; } }
                WSP(float, WS_YRAW)[base + (size_t)(t0 + st) * 1024] = y;
            }
            LDS_WAIT();
        }
    }
}
__device__ __forceinline__ f32x4 ld4bf(const GLB bf16_t* q) { const u32x2 w = *(const GLB u32x2*)q; return (f32x4){bflo(w.x), bfhi(w.x), bflo(w.y), bfhi(w.y)}; }
__device__ __forceinline__ void ph_rwkv_post(const Ctx& C, int l) {
    int lane = C.lane; asm volatile("" : "+v"(lane)); lane &= 63;
    if (C.wave >= 4) return;
    for (int m = blockIdx.x * 4 + C.wave; m < T; m += C.G * 4) {
#pragma unroll
        for (int i = 0; i < 4; ++i) {
            const int c = 256 * i + 4 * lane; const size_t o = (size_t)m * 1024 + c;
            const f32x4 y = *(const GLB f32x4*)(WSP(float, WS_YRAW) + o);
            float s = (y[0] + y[1]) + (y[2] + y[3]);
#pragma unroll
            for (int q = 1; q < 16; q <<= 1) s += __shfl_xor(s, q);
            const float mean = s * (1.0f / 64.f); const f32x4 dlt = y - mean;
            float s2 = (dlt[0] * dlt[0] + dlt[1] * dlt[1]) + (dlt[2] * dlt[2] + dlt[3] * dlt[3]);
#pragma unroll
            for (int q = 1; q < 16; q <<= 1) s2 += __shfl_xor(s2, q);
            const float rstd = 1.0f / sqrtf(s2 * (1.0f / 64.f) + 64e-5f);
            const f32x4 r = ld4bf(WSP(bf16_t, WS_R) + o), kraw = ld4bf(WSP(bf16_t, WS_K) + o), av = ld4bf(WSP(bf16_t, WS_AA) + o), v = ld4bf(WSP(bf16_t, WS_V) + o), g = ld4bf(WSP(bf16_t, WS_GG) + o);
            const f32x4 k = kraw * (1.0f + (av - 1.0f) * *(const GLB f32x4*)(INF32(I_RWKA) + l * 1024 + c));
            const f32x4 rk = *(const GLB f32x4*)(INF32(I_RWRK) + l * 1024 + c), lg = *(const GLB f32x4*)(INF32(I_RWLNG) + l * 1024 + c), lb = *(const GLB f32x4*)(INF32(I_RWLNB) + l * 1024 + c);
            const f32x4 pr = r * k * rk; float bs = (pr[0] + pr[1]) + (pr[2] + pr[3]);
#pragma unroll
            for (int q = 1; q < 16; q <<= 1) bs += __shfl_xor(bs, q);
            const f32x4 res = (dlt * rstd * lg + lb + bs * v) * g;
            u32x2 w; w.x = pk2(res[0], res[1]); w.y = pk2(res[2], res[3]);
            *(GLB u32x2*)(WSP(bf16_t, WS_Y) + (size_t)m * 4096 + 1024 + c) = w;
        }
    }
}
__device__ __forceinline__ float dot8(u32x4 kv, f32x4 qa, f32x4 qb) {
    return bflo(kv.x) * qa[0] + bfhi(kv.x) * qa[1] + bflo(kv.y) * qa[2] + bfhi(kv.y) * qa[3] + bflo(kv.z) * qb[0] + bfhi(kv.z) * qb[1] + bflo(kv.w) * qb[2] + bfhi(kv.w) * qb[3];
}
__device__ __forceinline__ void ph_sb_naive(const Ctx& C) {
    int lane = C.lane; asm volatile("" : "+v"(lane));
    LAS float* qs = (LAS float*)(C.lds + C.wave * 512);
    const GLB bf16_t* QKV = WSP(bf16_t, WS_SBQKV); GLB bf16_t* Y = WSP(bf16_t, WS_Y);
    for (int it = C.gw; it < NB * 8 * SEQ; it += C.NGW) {
        const int t = it % SEQ, bh = it / SEQ, h = bh & 7, b = bh >> 3;
        const size_t m = (size_t)b * SEQ + t;
        { const unsigned qq = *(const GLB unsigned*)(QKV + m * 3072 + h * 128 + 2 * lane); qs[2 * lane] = bflo(qq); qs[2 * lane + 1] = bfhi(qq); }
        LDS_WAIT();
        float o0 = 0.f, o1 = 0.f, carry = 0.f;
        const int nch = (t + 63) >> 6;
        for (int c = nch - 1; c >= 0; --c) {
            const int s = c * 64 + lane; const bool valid = s < t; const int sc = valid ? s : 0;
            const GLB u32x4* kp = (const GLB u32x4*)(QKV + ((size_t)b * SEQ + sc) * 3072 + 1024 + h * 128);
            float dot = 0.f;
#pragma unroll
            for (int j = 0; j < 16; ++j) dot += dot8(kp[j], *(const LAS f32x4*)(qs + 8 * j), *(const LAS f32x4*)(qs + 8 * j + 4));
            const float z = dot * 0.08838834764831845f;
            const float lk = valid ? logsigf_(-z) : 0.f, lb = logsigf_(z);
            float inc = lk;
#pragma unroll
            for (int off = 1; off < 64; off <<= 1) { const float o = __shfl_down(inc, off); if (lane + off < 64) inc += o; }
            const float w = valid ? __expf(lb + carry + inc - lk) : 0.f;
            carry += rdlane(inc, 0);
            const int nk = (t - c * 64) < 64 ? (t - c * 64) : 64;
            const GLB bf16_t* vp = QKV + ((size_t)b * SEQ + c * 64) * 3072 + 2048 + h * 128 + 2 * lane;
            for (int j = 0; j < nk; ++j) { const float wj = rdlane(w, j); const unsigned vv = *(const GLB unsigned*)(vp + (size_t)j * 3072); o0 += wj * bflo(vv); o1 += wj * bfhi(vv); }
        }
        *(GLB unsigned*)(Y + m * 4096 + h * 128 + 2 * lane) = pk2(o0, o1);
        LDS_WAIT();
    }
}
__device__ __forceinline__ void ph_swa_naive(const Ctx& C, int l) {
    int lane = C.lane; asm volatile("" : "+v"(lane));
    LAS float* qs = (LAS float*)(C.lds + C.wave * 512);
    const GLB bf16_t* QS = WSP(bf16_t, WS_QS); const GLB bf16_t* KS = WSP(bf16_t, WS_KS); const GLB bf16_t* VS = WSP(bf16_t, WS_VS); GLB bf16_t* Y = WSP(bf16_t, WS_Y);
    for (int it = C.gw; it < T * 16; it += C.NGW) {
        const int h = it & 15, m = it >> 4, t = m % SEQ, b = m / SEQ, kvh = h >> 3;
        qs[lane] = bf1(QS[(size_t)m * 1024 + h * 64 + lane]);
        LDS_WAIT();
        float lg[2];
#pragma unroll
        for (int i = 0; i < 2; ++i) { const int s = t - 127 + lane + 64 * i; const bool valid = s >= 0;
            const GLB u32x4* kp = (const GLB u32x4*)(KS + ((size_t)b * SEQ + (valid ? s : 0)) * 128 + kvh * 64);
            float dot = 0.f;
#pragma unroll
            for (int j = 0; j < 8; ++j) dot += dot8(kp[j], *(const LAS f32x4*)(qs + 8 * j), *(const LAS f32x4*)(qs + 8 * j + 4));
            lg[i] = valid ? dot * 0.125f : -3.0e38f; }
        const float sink = INF32(I_SSINK)[l * 16 + h];
        const float mx = fmaxf(wave_max(fmaxf(lg[0], lg[1])), sink);
        const float e0 = (lg[0] > -1.0e38f) ? __expf(lg[0] - mx) : 0.f, e1 = (lg[1] > -1.0e38f) ? __expf(lg[1] - mx) : 0.f;
        const float den = wave_sum(e0 + e1) + __expf(sink - mx);
        const float p0 = e0 / den, p1 = e1 / den;
        float o = 0.f;
        const int j0 = (t >= 127) ? 0 : 127 - t;
        for (int j = j0; j < 128; ++j) { const float pj = (j < 64) ? rdlane(p0, j) : rdlane(p1, j - 64); const int s = t - 127 + j;
            o += pj * bf1(VS[((size_t)b * SEQ + s) * 128 + kvh * 64 + lane]); }
        Y[(size_t)m * 4096 + 3072 + h * 64 + lane] = (bf16_t)f2bf(o);
        LDS_WAIT();
    }
}
__device__ __forceinline__ unsigned ordkey(float f) { const unsigned u = __builtin_bit_cast(unsigned, f); return (u & 0x80000000u) ? ~u : (u | 0x80000000u); }
__device__ __forceinline__ void ph_dsa_naive(const Ctx& C) {
    int lane = C.lane; asm volatile("" : "+v"(lane));
    LAS float* A = (LAS float*)(C.lds + C.wave * 13312);
    LAS float* Bs = A + 1024;
    LAS int* Cs = (LAS int*)(Bs + 2048);
    const GLB bf16_t* QI = WSP(bf16_t, WS_QI); const GLB bf16_t* KI = WSP(bf16_t, WS_KI); const GLB float* WI = WSP(float, WS_WI);
    const GLB bf16_t* QD = WSP(bf16_t, WS_QD); const GLB bf16_t* KD = WSP(bf16_t, WS_KD); const GLB bf16_t* VD = WSP(bf16_t, WS_VD); GLB bf16_t* Y = WSP(bf16_t, WS_Y);
    for (int m = C.gw; m < T; m += C.NGW) {
        const int t = m % SEQ, b = m / SEQ, n = t + 1;
        const size_t bm = (size_t)b * SEQ;
#pragma unroll
        for (int i = 0; i < 2; ++i) { const int e = 8 * (lane + 64 * i); const u32x4 q = *(const GLB u32x4*)(QI + (size_t)m * 1024 + e);
            *(LAS f32x4*)(A + e) = (f32x4){bflo(q.x), bfhi(q.x), bflo(q.y), bfhi(q.y)}; *(LAS f32x4*)(A + e + 4) = (f32x4){bflo(q.z), bfhi(q.z), bflo(q.w), bfhi(q.w)}; }
        const float wl = WI[(size_t)m * 16 + (lane & 15)];
        LDS_WAIT();
        const int nch = (n + 63) >> 6;
        for (int c = 0; c < nch; ++c) {
            const int s = c * 64 + lane; const bool valid = s < n;
            const GLB u32x4* kp = (const GLB u32x4*)(KI + (bm + (valid ? s : 0)) * 64);
            u32x4 kv[8];
#pragma unroll
            for (int j = 0; j < 8; ++j) kv[j] = kp[j];
            float sc = 0.f;
#pragma unroll 1
            for (int h = 0; h < 16; ++h) { float dot = 0.f;
#pragma unroll
                for (int j = 0; j < 8; ++j) dot += dot8(kv[j], *(const LAS f32x4*)(A + h * 64 + 8 * j), *(const LAS f32x4*)(A + h * 64 + 8 * j + 4));
                sc += rdlane(wl, h) * fmaxf(dot, 0.f); }
            Bs[s] = sc;
        }
        LDS_WAIT();
        int nsel;
        if (n <= 256) { nsel = n;
#pragma unroll
            for (int i = 0; i < 4; ++i) if (lane + 64 * i < n) Cs[lane + 64 * i] = lane + 64 * i;
        } else {
            nsel = 256;
            unsigned key[32];
#pragma unroll
            for (int i = 0; i < 32; ++i) { const int s = lane + 64 * i; key[i] = (s < n) ? ordkey(Bs[s]) : 0u; }
            unsigned tau = 0u;
            for (int bit = 31; bit >= 0; --bit) {
                const unsigned cand = tau | (1u << bit); int cnt = 0;
#pragma unroll
                for (int i = 0; i < 32; ++i) cnt += (key[i] >= cand) ? 1 : 0;
#pragma unroll
                for (int o = 1; o < 64; o <<= 1) cnt += __shfl_xor(cnt, o);
                if (cnt >= 256) tau = cand;
            }
            int cgt = 0;
#pragma unroll
            for (int i = 0; i < 32; ++i) cgt += (key[i] > tau) ? 1 : 0;
#pragma unroll
            for (int o = 1; o < 64; o <<= 1) cgt += __shfl_xor(cgt, o);
            const int need = 256 - cgt;
            int base = 0, eqbase = 0;
            const unsigned long long lt = (1ull << lane) - 1ull;
#pragma unroll
            for (int i = 0; i < 32; ++i) {
                const bool gt = key[i] > tau, eq = key[i] == tau;
                const unsigned long long beq = __ballot(eq);
                const int eqrank = eqbase + __popcll(beq & lt);
                const bool sel = gt || (eq && eqrank < need);
                const unsigned long long bs = __ballot(sel);
                if (sel) Cs[base + __popcll(bs & lt)] = lane + 64 * i;
                base += __popcll(bs); eqbase += __popcll(beq);
            }
        }
        LDS_WAIT();
#pragma unroll
        for (int i = 0; i < 2; ++i) { const int e = 8 * (lane + 64 * i); const u32x4 q = *(const GLB u32x4*)(QD + (size_t)m * 1024 + e);
            *(LAS f32x4*)(A + e) = (f32x4){bflo(q.x), bfhi(q.x), bflo(q.y), bfhi(q.y)}; *(LAS f32x4*)(A + e + 4) = (f32x4){bflo(q.z), bfhi(q.z), bflo(q.w), bfhi(q.w)}; }
        LDS_WAIT();
        float lg[8][4];
#pragma unroll
        for (int i = 0; i < 4; ++i) { const int j = lane + 64 * i; const bool valid = j < nsel; const int s = valid ? Cs[j] : 0;
            const GLB u32x4* kp = (const GLB u32x4*)(KD + (bm + s) * 128);
            float a8[8];
#pragma unroll
            for (int h = 0; h < 8; ++h) a8[h] = 0.f;
#pragma unroll 1
            for (int pc = 0; pc < 16; ++pc) { const u32x4 kv = kp[pc];
#pragma unroll
                for (int h = 0; h < 8; ++h) a8[h] += dot8(kv, *(const LAS f32x4*)(A + h * 128 + 8 * pc), *(const LAS f32x4*)(A + h * 128 + 8 * pc + 4)); }
#pragma unroll
            for (int h = 0; h < 8; ++h) lg[h][i] = valid ? a8[h] * 0.08838834764831845f : -3.0e38f; }
#pragma unroll
        for (int h = 0; h < 8; ++h) {
            const float mx = wave_max(fmaxf(fmaxf(lg[h][0], lg[h][1]), fmaxf(lg[h][2], lg[h][3])));
            float e[4]; float sm = 0.f;
#pragma unroll
            for (int i = 0; i < 4; ++i) { e[i] = (lg[h][i] > -1.0e38f) ? __expf(lg[h][i] - mx) : 0.f; sm += e[i]; }
            const float inv = 1.0f / wave_sum(sm);
#pragma unroll
            for (int i = 0; i < 4; ++i) Bs[(lane + 64 * i) * 8 + h] = e[i] * inv;
        }
        LDS_WAIT();
        float o[8][2];
#pragma unroll
        for (int h = 0; h < 8; ++h) { o[h][0] = 0.f; o[h][1] = 0.f; }
        for (int j = 0; j < nsel; ++j) { const int s = Cs[j]; const unsigned vv = *(const GLB unsigned*)(VD + (bm + s) * 128 + 2 * lane); const float v0 = bflo(vv), v1 = bfhi(vv);
            const f32x4 pa = *(const LAS f32x4*)(Bs + j * 8), pb = *(const LAS f32x4*)(Bs + j * 8 + 4);
#pragma unroll
            for (int h = 0; h < 4; ++h) { o[h][0] += pa[h] * v0; o[h][1] += pa[h] * v1; o[4 + h][0] += pb[h] * v0; o[4 + h][1] += pb[h] * v1; } }
#pragma unroll
        for (int h = 0; h < 8; ++h) *(GLB unsigned*)(Y + (size_t)m * 4096 + 2048 + h * 128 + 2 * lane) = pk2(o[h][0], o[h][1]);
        LDS_WAIT();
    }
}
typedef float f32x16 __attribute__((ext_vector_type(16)));
__device__ __forceinline__ int wave_isum(int x) {
    x += __builtin_amdgcn_mov_dpp(x, 0x128, 0xf, 0xf, true); x += __builtin_amdgcn_mov_dpp(x, 0x124, 0xf, 0xf, true);
    x += __builtin_amdgcn_mov_dpp(x, 0x122, 0xf, 0xf, true); x += __builtin_amdgcn_mov_dpp(x, 0x121, 0xf, 0xf, true);
    return __builtin_amdgcn_readlane(x, 0) + __builtin_amdgcn_readlane(x, 16) + __builtin_amdgcn_readlane(x, 32) + __builtin_amdgcn_readlane(x, 48);
}
constexpr size_t WS_SBVT = WS_MIX_END;
constexpr size_t WS_SWVT = WS_SBVT + (size_t)32 * 128 * SEQ * 2;
constexpr size_t WS_VDT = WS_SWVT + (size_t)NB * 2 * 64 * SEQ * 2;
constexpr size_t WS_SC = WS_VDT + (size_t)NB * 128 * SEQ * 2;
constexpr size_t WS_SELB = WS_SC + (size_t)T * SEQ * 4;
constexpr size_t WS_END2 = WS_SELB + (size_t)T * 32 * 8;
constexpr size_t WS_XB = (WS_END2 + 255) & ~(size_t)255;
constexpr size_t WS_END3 = WS_XB + (size_t)T * D * 2;
static_assert(WS_END3 < (size_t)2000 * 1000 * 1000, "workspace budget");

__device__ __forceinline__ void vt_tile(const GLB bf16_t* src, int src_ld, GLB bf16_t* dst, LAS bf16_t* scr, int lane) {
    const int cq = lane & 7, rq = lane >> 3;
    u32x4 v[8];
#pragma unroll
    for (int j = 0; j < 8; ++j) v[j] = *(const GLB u32x4*)(src + (size_t)(rq + 8 * j) * src_ld + 8 * cq);
#pragma unroll
    for (int j = 0; j < 8; ++j) { LAS unsigned* d = (LAS unsigned*)(scr + (rq + 8 * j) * 66 + 8 * cq); d[0] = v[j].x; d[1] = v[j].y; d[2] = v[j].z; d[3] = v[j].w; }
    LDS_WAIT();
#pragma unroll
    for (int j = 0; j < 8; ++j) { const int d = rq + 8 * j; const LAS bf16_t* s = scr + (8 * cq) * 66 + d;
        u32x4 o; o.x = (unsigned)s[0] | ((unsigned)s[66] << 16); o.y = (unsigned)s[2 * 66] | ((unsigned)s[3 * 66] << 16);
        o.z = (unsigned)s[4 * 66] | ((unsigned)s[5 * 66] << 16); o.w = (unsigned)s[6 * 66] | ((unsigned)s[7 * 66] << 16);
        *(GLB u32x4*)(dst + (size_t)d * SEQ + 8 * cq) = o; }
    LDS_WAIT();
}
__device__ __forceinline__ void ph_vt(const Ctx& C) {
    int lane = C.lane; asm volatile("" : "+v"(lane)); lane &= 63;
    LAS bf16_t* scr = (LAS bf16_t*)(C.lds + 65536 + C.wave * 8448);
    for (int it = C.gw; it < 32 * 2 * 32; it += C.NGW) {
        const int sb = it & 31, db = (it >> 5) & 1, bh = it >> 6, b = bh >> 3, h = bh & 7;
        vt_tile(WSP(bf16_t, WS_SBQKV) + ((size_t)b * SEQ + 64 * sb) * 3072 + 2048 + h * 128 + 64 * db, 3072,
                WSP(bf16_t, WS_SBVT) + ((size_t)bh * 128 + 64 * db) * SEQ + 64 * sb, scr, lane);
    }
}

__device__ __forceinline__ void ph_vt_small(const Ctx& C) {
    int lane = C.lane; asm volatile("" : "+v"(lane)); lane &= 63;
    LAS bf16_t* scr = (LAS bf16_t*)(C.lds + C.wave * 8448);
    for (int it = C.gw; it < 512; it += C.NGW) {
        const int sb = it & 31, hd = (it >> 5) & 1, b = (it >> 6) & 3, which = it >> 8;
        if (which == 0) vt_tile(WSP(bf16_t, WS_VS) + ((size_t)b * SEQ + 64 * sb) * 128 + 64 * hd, 128, WSP(bf16_t, WS_SWVT) + ((size_t)(b * 2 + hd) * 64) * SEQ + 64 * sb, scr, lane);
        else vt_tile(WSP(bf16_t, WS_VD) + ((size_t)b * SEQ + 64 * sb) * 128 + 64 * hd, 128, WSP(bf16_t, WS_VDT) + ((size_t)b * 128 + 64 * hd) * SEQ + 64 * sb, scr, lane);
    }
}

__device__ __forceinline__ void sb_item(const Ctx& C, int lane, int bh, int qb) {
    const int c = lane & 31, hh = lane >> 5, b = bh >> 3, h = bh & 7, q0 = 32 * qb;
    const GLB bf16_t* QKV = WSP(bf16_t, WS_SBQKV); const GLB bf16_t* VT = WSP(bf16_t, WS_SBVT);
    const GLB bf16_t* qp = QKV + ((size_t)b * SEQ + q0 + c) * 3072 + h * 128 + 8 * hh;
    bf16x8 qf[8];
#pragma unroll
    for (int ks = 0; ks < 8; ++ks) qf[ks] = *(const GLB bf16x8*)(qp + 16 * ks);
    f32x16 O[4];
#pragma unroll
    for (int db = 0; db < 4; ++db)
#pragma unroll
        for (int r = 0; r < 16; ++r) O[db][r] = 0.f;
    float carry = 1.0f;
    const int km = 16 * ((c >> 2) & 1) + 4 * (c >> 3) + (c & 3);
    const GLB bf16_t* kbase = QKV + ((size_t)b * SEQ + km) * 3072 + 1024 + h * 128 + 8 * hh;
    const GLB bf16_t* vbase = VT + ((size_t)bh * 128 + c) * SEQ + 16 * hh;
    bf16x8 kf[8];
#pragma unroll
    for (int ks = 0; ks < 8; ++ks) kf[ks] = *(const GLB bf16x8*)(kbase + (size_t)q0 * 3072 + 16 * ks);
    for (int kt = qb; kt >= 0; --kt) {
        const int k0 = 32 * kt;
        bf16x8 vf[2][4];
#pragma unroll
        for (int s = 0; s < 2; ++s)
#pragma unroll
            for (int db = 0; db < 4; ++db) vf[s][db] = *(const GLB bf16x8*)(vbase + (size_t)(32 * db) * SEQ + k0 + 8 * s);
        f32x16 S;
#pragma unroll
        for (int r = 0; r < 16; ++r) S[r] = 0.f;
#pragma unroll
        for (int ks = 0; ks < 8; ++ks) S = __builtin_amdgcn_mfma_f32_32x32x16_bf16(kf[ks], qf[ks], S, 0, 0, 0);
        if (kt > 0) {
#pragma unroll
            for (int ks = 0; ks < 8; ++ks) kf[ks] = *(const GLB bf16x8*)(kbase + (size_t)(k0 - 32) * 3072 + 16 * ks);
        }
        const bool diag = (kt == qb);
        float w[16]; float sp = 1.0f;
#pragma unroll
        for (int r = 15; r >= 0; --r) {
            const float e = __builtin_amdgcn_exp2f(fminf(S[r] * -0.12751743074602535f, 115.0f)), rr = __builtin_amdgcn_rcpf(1.0f + e), er = e * rr;
            const bool valid = !diag || (16 * hh + r < c);
            const float beta = valid ? rr : 0.f, om = valid ? er : 1.0f;
            w[r] = beta * sp; sp *= om;
        }
        const float tot_other = __shfl_xor(sp, 32);
        const float pre = carry * (hh == 0 ? tot_other : 1.0f);
        carry *= sp * tot_other;
        const bool live = __ballot(carry >= 1.0e-30f) != 0ull;
        bf16x8 pw[2];
#pragma unroll
        for (int s = 0; s < 2; ++s) { u32x4 t; t.x = pk2(w[8 * s] * pre, w[8 * s + 1] * pre); t.y = pk2(w[8 * s + 2] * pre, w[8 * s + 3] * pre);
            t.z = pk2(w[8 * s + 4] * pre, w[8 * s + 5] * pre); t.w = pk2(w[8 * s + 6] * pre, w[8 * s + 7] * pre); pw[s] = __builtin_bit_cast(bf16x8, t); }
#pragma unroll
        for (int s = 0; s < 2; ++s)
#pragma unroll
            for (int db = 0; db < 4; ++db) O[db] = __builtin_amdgcn_mfma_f32_32x32x16_bf16(vf[s][db], pw[s], O[db], 0, 0, 0);
        if (!live) break;
    }
    GLB bf16_t* yp = WSP(bf16_t, WS_Y) + ((size_t)b * SEQ + q0 + c) * 4096 + h * 128 + 4 * hh;
#pragma unroll
    for (int db = 0; db < 4; ++db)
#pragma unroll
        for (int a = 0; a < 4; ++a) { u32x2 o; o.x = pk2(O[db][4 * a], O[db][4 * a + 1]); o.y = pk2(O[db][4 * a + 2], O[db][4 * a + 3]);
            *(GLB u32x2*)(yp + 32 * db + 8 * a) = o; }
}
__device__ __forceinline__ void ph_sb_fast(const Ctx& C) {
    int lane = C.lane; asm volatile("" : "+v"(lane)); lane &= 63;
    const int pi = blockIdx.x * 4 + (C.wave & 3);
    if (pi < 1024) { const int bh = pi >> 5, j = pi & 31; sb_item(C, lane, bh, (C.wave >> 2) ? 63 - j : j); }
}

#ifndef SWA_OUT_OFF
#define SWA_OUT_OFF WS_Y
#endif
__device__ __forceinline__ void swa_item(const Ctx& C, int lane, int l, int b, int h, int tb) {
    const int c = lane & 31, hh = lane >> 5, t0 = 32 * tb, kvh = h >> 3;
    const GLB bf16_t* qp = WSP(bf16_t, WS_QS) + ((size_t)b * SEQ + t0 + c) * 1024 + h * 64 + 8 * hh;
    bf16x8 qf[4];
#pragma unroll
    for (int ks = 0; ks < 4; ++ks) qf[ks] = *(const GLB bf16x8*)(qp + 16 * ks);
    const int km = 16 * ((c >> 2) & 1) + 4 * (c >> 3) + (c & 3);
    const GLB bf16_t* kbase = WSP(bf16_t, WS_KS) + ((size_t)b * SEQ + km) * 128 + kvh * 64 + 8 * hh;
    const GLB bf16_t* vbase = WSP(bf16_t, WS_SWVT) + ((size_t)(b * 2 + kvh) * 64 + c) * SEQ + 16 * hh;
    float mrun = INF32(I_SSINK)[l * 16 + h], lrun = 1.0f;
    f32x16 O[2];
#pragma unroll
    for (int db = 0; db < 2; ++db)
#pragma unroll
        for (int r = 0; r < 16; ++r) O[db][r] = 0.f;
    const int i0 = (tb >= 4) ? 0 : 4 - tb;
    for (int i = i0; i < 5; ++i) {
        const int k0 = t0 - 128 + 32 * i;
        bf16x8 kf[4], vf[2][2];
#pragma unroll
        for (int ks = 0; ks < 4; ++ks) kf[ks] = *(const GLB bf16x8*)(kbase + (size_t)k0 * 128 + 16 * ks);
#pragma unroll
        for (int s = 0; s < 2; ++s)
#pragma unroll
            for (int db = 0; db < 2; ++db) vf[s][db] = *(const GLB bf16x8*)(vbase + (size_t)(32 * db) * SEQ + k0 + 8 * s);
        f32x16 a;
#pragma unroll
        for (int r = 0; r < 16; ++r) a[r] = 0.f;
#pragma unroll
        for (int ks = 0; ks < 4; ++ks) a = __builtin_amdgcn_mfma_f32_32x32x16_bf16(kf[ks], qf[ks], a, 0, 0, 0);
        float tmax = -1.0e30f;
#pragma unroll
        for (int r = 0; r < 16; ++r) { const int kr = 16 * hh + r; const bool valid = (i == 0) ? (kr > c) : ((i == 4) ? (kr <= c) : true); a[r] = valid ? a[r] * 0.125f : -1.0e30f; tmax = fmaxf(tmax, a[r]); }
        tmax = fmaxf(tmax, __shfl_xor(tmax, 32));
        const float mnew = fmaxf(mrun, tmax), alpha = __expf(mrun - mnew);
        float psum = 0.f;
#pragma unroll
        for (int r = 0; r < 16; ++r) { a[r] = __expf(a[r] - mnew); psum += a[r]; }
        psum += __shfl_xor(psum, 32);
        lrun = lrun * alpha + psum; mrun = mnew;
#pragma unroll
        for (int db = 0; db < 2; ++db)
#pragma unroll
            for (int r = 0; r < 16; ++r) O[db][r] *= alpha;
#pragma unroll
        for (int s = 0; s < 2; ++s) {
            u32x4 t; t.x = pk2(a[8 * s], a[8 * s + 1]); t.y = pk2(a[8 * s + 2], a[8 * s + 3]); t.z = pk2(a[8 * s + 4], a[8 * s + 5]); t.w = pk2(a[8 * s + 6], a[8 * s + 7]);
            const bf16x8 pw = __builtin_bit_cast(bf16x8, t);
#pragma unroll
            for (int db = 0; db < 2; ++db) O[db] = __builtin_amdgcn_mfma_f32_32x32x16_bf16(vf[s][db], pw, O[db], 0, 0, 0);
        }
    }
    const float inv = 1.0f / lrun;
    GLB bf16_t* yp = WSP(bf16_t, SWA_OUT_OFF) + ((size_t)b * SEQ + t0 + c) * 4096 + 3072 + h * 64 + 4 * hh;
#pragma unroll
    for (int db = 0; db < 2; ++db)
#pragma unroll
        for (int a4 = 0; a4 < 4; ++a4) { u32x2 o; o.x = pk2(O[db][4 * a4] * inv, O[db][4 * a4 + 1] * inv); o.y = pk2(O[db][4 * a4 + 2] * inv, O[db][4 * a4 + 3] * inv);
            *(GLB u32x2*)(yp + 32 * db + 8 * a4) = o; }
}
__device__ __forceinline__ void ph_swa_fast(const Ctx& C, int l) {
    int lane = C.lane; asm volatile("" : "+v"(lane)); lane &= 63;
    if (C.wave >= 4) return;
    for (int it = blockIdx.x * 4 + C.wave; it < NB * 64 * 16; it += C.G * 4) { const int h = it & 15, tb = (it >> 4) & 63, b = it >> 10; swa_item(C, lane, l, b, h, tb); }
}

__device__ __forceinline__ float row16_sum(float x) {
    x += __builtin_bit_cast(float, __builtin_amdgcn_mov_dpp(__builtin_bit_cast(int, x), 0x128, 0xf, 0xf, true));
    x += __builtin_bit_cast(float, __builtin_amdgcn_mov_dpp(__builtin_bit_cast(int, x), 0x124, 0xf, 0xf, true));
    x += __builtin_bit_cast(float, __builtin_amdgcn_mov_dpp(__builtin_bit_cast(int, x), 0x122, 0xf, 0xf, true));
    x += __builtin_bit_cast(float, __builtin_amdgcn_mov_dpp(__builtin_bit_cast(int, x), 0x121, 0xf, 0xf, true));
    return x;
}
__device__ __forceinline__ void ph_rwkv_scan_fast(const Ctx& C) {
    int tid = C.tid; asm volatile("" : "+v"(tid));
    const int lane = tid & 63, wave = C.wave;
    LAS float* buf = (LAS float*)C.lds;
    constexpr int CH = 32, CHF = CH * 384;
    for (int it = blockIdx.x; it < NB * 16 * 4; it += C.G) {
        const int qr = it & 3, h = (it >> 2) & 15, b = it >> 6;
        const size_t gbase = (size_t)b * SEQ * 1024 + h * 64;
        const int ro = lane >> 4, kq = lane & 15, row = 16 * qr + 4 * (wave & 3) + ro;
        float S0 = 0.f, S1 = 0.f, S2 = 0.f, S3 = 0.f;
        const int lj = tid - 256;
        auto load_chunk = [&](int cidx) {
            f32x4 v[12];
#pragma unroll
            for (int i = 0; i < 12; ++i) { const int idx = lj + 256 * i, step = idx / 96, rem = idx - step * 96, vec = rem >> 4, e4 = rem & 15;
                const size_t off = (vec == 0) ? WS_R : (vec == 1) ? WS_DEC : (vec == 2) ? WS_K : (vec == 3) ? WS_KK : (vec == 4) ? WS_AA : WS_V;
                v[i] = *(const GLB f32x4*)(WSP(float, off) + gbase + (size_t)(cidx * CH + step) * 1024 + 4 * e4); }
            LAS float* d = buf + (cidx & 1) * CHF;
#pragma unroll
            for (int i = 0; i < 12; ++i) { const int idx = lj + 256 * i, step = idx / 96, rem = idx - step * 96; *(LAS f32x4*)(d + step * 384 + rem * 4) = v[i]; }
        };
        if (wave >= 4) load_chunk(0);
        LDS_WAIT(); __syncthreads();
        for (int cidx = 0; cidx < SEQ / CH; ++cidx) {
            if (wave >= 4) { if (cidx + 1 < SEQ / CH) load_chunk(cidx + 1); }
            else {
                const LAS float* cb = buf + (cidx & 1) * CHF;
#pragma unroll 4
                for (int st = 0; st < CH; ++st) {
                    const LAS float* rb = cb + st * 384;
                    const f32x4 kk4 = *(const LAS f32x4*)(rb + 192 + 4 * kq);
                    const float p = row16_sum(S0 * kk4[0] + S1 * kk4[1] + S2 * kk4[2] + S3 * kk4[3]);
                    const f32x4 w4 = *(const LAS f32x4*)(rb + 64 + 4 * kq), b4 = *(const LAS f32x4*)(rb + 256 + 4 * kq), k4 = *(const LAS f32x4*)(rb + 128 + 4 * kq), r4 = *(const LAS f32x4*)(rb + 4 * kq);
                    const float vv = rb[320 + row];
                    S0 = S0 * w4[0] - p * b4[0] + vv * k4[0]; S1 = S1 * w4[1] - p * b4[1] + vv * k4[1]; S2 = S2 * w4[2] - p * b4[2] + vv * k4[2]; S3 = S3 * w4[3] - p * b4[3] + vv * k4[3];
                    const float y = row16_sum(S0 * r4[0] + S1 * r4[1] + S2 * r4[2] + S3 * r4[3]);
                    if (kq == 0) WSP(float, WS_YRAW)[gbase + (size_t)(cidx * CH + st) * 1024 + row] = y;
                }
            }
            LDS_WAIT(); __syncthreads();
        }
    }
}

__device__ __forceinline__ void dsa_item(const Ctx& C, int lane, int wave, int b, int g, int layer) {
    const int c = lane & 31, hh = lane >> 5, t0 = 4 * g;
    LAS float* sc = (LAS float*)(C.lds + wave * 17408);
    LAS unsigned* bm = (LAS unsigned*)(C.lds + wave * 17408 + 16384);
    const size_t bm0 = (size_t)b * SEQ;
    const int ntile = (t0 + 3) / 32 + 1;
#pragma unroll 1
    for (int p = 0; p < 2; ++p) {
        {
            const int qq = t0 + 2 * p + ((c >> 2) & 1), hd = (c & 3) + 4 * (c >> 3);
            const GLB bf16_t* qp = WSP(bf16_t, WS_QI) + (bm0 + qq) * 1024 + hd * 64 + 8 * hh;
            bf16x8 qf[4];
#pragma unroll
            for (int ks = 0; ks < 4; ++ks) qf[ks] = *(const GLB bf16x8*)(qp + 16 * ks);
            const GLB float* wp = WSP(float, WS_WI) + (bm0 + t0 + 2 * p + hh) * 16;
            f32x4 w4[4];
#pragma unroll
            for (int j = 0; j < 4; ++j) w4[j] = *(const GLB f32x4*)(wp + 4 * j);
            const GLB bf16_t* kp = WSP(bf16_t, WS_KI) + (bm0 + c) * 64 + 8 * hh;
            bf16x8 kf[4];
#pragma unroll
            for (int ks = 0; ks < 4; ++ks) kf[ks] = *(const GLB bf16x8*)(kp + 16 * ks);
            for (int kt = 0; kt < ntile; ++kt) {
                f32x16 a;
#pragma unroll
                for (int r = 0; r < 16; ++r) a[r] = 0.f;
#pragma unroll
                for (int ks = 0; ks < 4; ++ks) a = __builtin_amdgcn_mfma_f32_32x32x16_bf16(qf[ks], kf[ks], a, 0, 0, 0);
                if (kt + 1 < ntile) {
#pragma unroll
                    for (int ks = 0; ks < 4; ++ks) kf[ks] = *(const GLB bf16x8*)(kp + (size_t)(32 * (kt + 1)) * 64 + 16 * ks);
                }
                float s = 0.f;
#pragma unroll
                for (int r = 0; r < 16; ++r) s += w4[r >> 2][r & 3] * fmaxf(a[r], 0.f);
                sc[hh * 2048 + 32 * kt + c] = s;
            }
        }
        LDS_WAIT();
#pragma unroll 1
        for (int qs = 0; qs < 2; ++qs) {
            const int t = t0 + 2 * p + qs, n = t + 1;
            const LAS float* sq = sc + qs * 2048;
            unsigned myword_lo = 0u, myword_hi = 0u;
            if (n <= 256) {
#pragma unroll
                for (int i = 0; i < 4; ++i) { const unsigned long long bal = __ballot(lane + 64 * i < n); if (lane == i) { myword_lo = (unsigned)bal; myword_hi = (unsigned)(bal >> 32); } }
            } else {
                unsigned key[32];
#pragma unroll
                for (int i = 0; i < 32; ++i) { const int s = lane + 64 * i; key[i] = (s < n) ? ordkey(sq[s]) : 0u; }
                unsigned tau = 0u;
                for (int bit = 31; bit >= 0; --bit) {
                    const unsigned cand = tau | (1u << bit); int cl = 0;
#pragma unroll
                    for (int i = 0; i < 32; ++i) cl += (key[i] >= cand) ? 1 : 0;
                    const int cnt = wave_isum(cl);
                    if (cnt >= 256) { tau = cand; if (cnt == 256) break; }
                }
                int cgl = 0;
#pragma unroll
                for (int i = 0; i < 32; ++i) cgl += (key[i] > tau) ? 1 : 0;
                const int cgt = wave_isum(cgl);
                const int need = 256 - cgt; int eqbase = 0;
                const unsigned long long lt = (1ull << lane) - 1ull;
#pragma unroll
                for (int i = 0; i < 32; ++i) {
                    const bool gt = key[i] > tau, eq = key[i] == tau;
                    const unsigned long long beq = __ballot(eq);
                    const bool sel = gt || (eq && (eqbase + __popcll(beq & lt)) < need);
                    const unsigned long long bal = __ballot(sel);
                    if (lane == i) { myword_lo = (unsigned)bal; myword_hi = (unsigned)(bal >> 32); }
                    eqbase += __popcll(beq);
                }
            }
            if (lane < 32) { bm[(2 * p + qs) * 64 + 2 * lane] = myword_lo; bm[(2 * p + qs) * 64 + 2 * lane + 1] = myword_hi; }
        }
        LDS_WAIT();
    }
    const int cq = c >> 3, ch = c & 7;
    const GLB bf16_t* qp = WSP(bf16_t, WS_QD) + (bm0 + t0 + cq) * 1024 + ch * 128 + 8 * hh;
    bf16x8 qf[8];
#pragma unroll
    for (int ks = 0; ks < 8; ++ks) qf[ks] = *(const GLB bf16x8*)(qp + 16 * ks);
    const int km = 16 * ((c >> 2) & 1) + 4 * (c >> 3) + (c & 3);
    const GLB bf16_t* kbase = WSP(bf16_t, WS_KD) + (bm0 + km) * 128 + 8 * hh;
    const GLB bf16_t* vbase = WSP(bf16_t, WS_VDT) + ((size_t)b * 128 + c) * SEQ + 16 * hh;
    const LAS unsigned short* bmh = (const LAS unsigned short*)(bm + cq * 64) + hh;
    float mrun = -1.0e20f, lrun = 0.f;
    f32x16 O[4];
#pragma unroll
    for (int db = 0; db < 4; ++db)
#pragma unroll
        for (int r = 0; r < 16; ++r) O[db][r] = 0.f;
    const int hw = wave >> 2, wq = wave & 3;
    volatile LAS unsigned* cnt = (volatile LAS unsigned*)(C.lds + MISC_OFF + 128 + 4 * hw);
    unsigned target = (unsigned)layer * 4u * (unsigned)(ntile + 2);
    auto arrive = [&]() { asm volatile("s_waitcnt vmcnt(0) lgkmcnt(0)" ::: "memory"); if (lane == 0) (void)__hip_atomic_fetch_add((LAS unsigned*)(C.lds + MISC_OFF + 128 + 4 * hw), 1u, __ATOMIC_RELAXED, __HIP_MEMORY_SCOPE_WORKGROUP); };
    auto wait_all = [&]() { target += 4u; while ((int)(*cnt - target) < 0) __builtin_amdgcn_s_sleep(1); asm volatile("" ::: "memory"); };
    const GLB char* kg = (const GLB char*)(WSP(bf16_t, WS_KD) + bm0 * 128);
    const GLB char* vg = (const GLB char*)(WSP(bf16_t, WS_VDT) + (size_t)b * 128 * SEQ);
    auto stage = [&](int kt) {
        LAS char* tb = (LAS char*)(C.lds + (4 * hw + kt % 3) * 17408);
#pragma unroll
        for (int i = 0; i < 2; ++i) { const int r = 8 * wq + 4 * i + (lane >> 4), pch = lane & 15, key = (r & 7) + 8 * (r >> 4);
            __builtin_amdgcn_global_load_lds((const GLB unsigned*)(kg + ((size_t)(32 * kt + r) * 256 + 16 * (pch ^ key))), (LAS unsigned*)(tb + (8 * wq + 4 * i) * 256), 16, 0, 0); }
#pragma unroll
        for (int i = 0; i < 2; ++i) { const int d = 32 * wq + 16 * i + (lane >> 2), pch = lane & 3, key = (d >> 2) & 3;
            __builtin_amdgcn_global_load_lds((const GLB unsigned*)(vg + ((size_t)d * (SEQ * 2) + 64 * kt + 16 * (pch ^ key))), (LAS unsigned*)(tb + 8192 + (32 * wq + 16 * i) * 64), 16, 0, 0); }
    };
    arrive(); wait_all();
    stage(0); if (ntile > 1) stage(1);
    arrive();
    const int kkey = (km & 7) + 8 * (km >> 4);
    for (int kt = 0; kt < ntile; ++kt) {
        wait_all();
        const LAS char* tb = (const LAS char*)(C.lds + (4 * hw + kt % 3) * 17408);
        bf16x8 kf[8], vf[2][4];
#pragma unroll
        for (int ks = 0; ks < 8; ++ks) kf[ks] = *(const LAS bf16x8*)(tb + km * 256 + 16 * ((hh + 2 * ks) ^ kkey));
#pragma unroll
        for (int s = 0; s < 2; ++s)
#pragma unroll
            for (int db = 0; db < 4; ++db) { const int d = c + 32 * db; vf[s][db] = *(const LAS bf16x8*)(tb + 8192 + d * 64 + 16 * ((2 * hh + s) ^ ((d >> 2) & 3))); }
        const unsigned bits = bmh[2 * kt];
        asm volatile("s_waitcnt lgkmcnt(0)" ::: "memory");
        if (kt + 2 < ntile) stage(kt + 2);
        f32x16 a;
#pragma unroll
        for (int r = 0; r < 16; ++r) a[r] = 0.f;
#pragma unroll
        for (int ks = 0; ks < 8; ++ks) a = __builtin_amdgcn_mfma_f32_32x32x16_bf16(kf[ks], qf[ks], a, 0, 0, 0);
        float tmax = -1.0e30f;
#pragma unroll
        for (int r = 0; r < 16; ++r) { a[r] = ((bits >> r) & 1u) ? a[r] * 0.08838834764831845f : -1.0e30f; tmax = fmaxf(tmax, a[r]); }
        tmax = fmaxf(tmax, __shfl_xor(tmax, 32));
        if (__ballot(tmax > mrun + 8.0f) != 0ull) {
            const float mnew = fmaxf(mrun, tmax), alpha = __expf(mrun - mnew);
            lrun *= alpha; mrun = mnew;
#pragma unroll
            for (int db = 0; db < 4; ++db)
#pragma unroll
                for (int r = 0; r < 16; ++r) O[db][r] *= alpha;
        }
        float psum = 0.f;
#pragma unroll
        for (int r = 0; r < 16; ++r) { a[r] = __expf(a[r] - mrun); psum += a[r]; }
        psum += __shfl_xor(psum, 32);
        lrun += psum;
#pragma unroll
        for (int s = 0; s < 2; ++s) {
            u32x4 t; t.x = pk2(a[8 * s], a[8 * s + 1]); t.y = pk2(a[8 * s + 2], a[8 * s + 3]); t.z = pk2(a[8 * s + 4], a[8 * s + 5]); t.w = pk2(a[8 * s + 6], a[8 * s + 7]);
            const bf16x8 pw = __builtin_bit_cast(bf16x8, t);
#pragma unroll
            for (int db = 0; db < 4; ++db) O[db] = __builtin_amdgcn_mfma_f32_32x32x16_bf16(vf[s][db], pw, O[db], 0, 0, 0);
        }
        arrive();
    }
    const float inv = 1.0f / lrun;
    GLB bf16_t* yp = WSP(bf16_t, WS_Y) + (bm0 + t0 + cq) * 4096 + 2048 + ch * 128 + 4 * hh;
#pragma unroll
    for (int db = 0; db < 4; ++db)
#pragma unroll
        for (int a4 = 0; a4 < 4; ++a4) { u32x2 o; o.x = pk2(O[db][4 * a4] * inv, O[db][4 * a4 + 1] * inv); o.y = pk2(O[db][4 * a4 + 2] * inv, O[db][4 * a4 + 3] * inv);
            *(GLB u32x2*)(yp + 32 * db + 8 * a4) = o; }
    LDS_WAIT();
}
__device__ __forceinline__ void ph_dsa_fast(const Ctx& C, int l) {
    int lane = C.lane; asm volatile("" : "+v"(lane)); lane &= 63;
    const int pi = blockIdx.x * 4 + (C.wave & 3);
    if (pi < 1024) { const int b = pi >> 8, j = pi & 255; dsa_item(C, lane, C.wave, b, (C.wave >> 2) ? 511 - j : j, l); }
}

constexpr int SCAN_CNT_OFF = MISC_OFF + 64;
__device__ __forceinline__ void ph_rwkv_scan_conv(const Ctx& C, int l) {
    int tid = C.tid; asm volatile("" : "+v"(tid));
    const int lane = tid & 63, wave = C.wave;
    if (wave >= 4) {
        LAS float* scr = (LAS float*)(C.lds + 65536 + (wave - 4) * 16640);
        constexpr int PER = MOE_CONV_ITEMS / 2 / 1024;
        const int first = l * (MOE_CONV_ITEMS / 2) + (blockIdx.x * 4 + (wave - 4)) * PER;
        if (!MOE_CONV_IN_PROLOGUE && blockIdx.x < 256)
            for (int i = 0; i < PER; ++i) conv_moe_item(C, first + i, scr, lane);
        return;
    }
    constexpr int CH = 16, CHF = CH * 384, NCH = SEQ / CH;
    LAS float* buf = (LAS float*)C.lds;
    volatile LAS unsigned* cnt = (volatile LAS unsigned*)(C.lds + SCAN_CNT_OFF);
    const int it = blockIdx.x;
    if (it >= NB * 16 * 4) return;
    const int qr = it & 3, h = (it >> 2) & 15, b = it >> 6;
    const size_t gbase = (size_t)b * SEQ * 1024 + h * 64;
    const int ro = lane >> 4, kq = lane & 15, row = 16 * qr + 4 * wave + ro;
    unsigned target = (unsigned)l * 4u * (NCH + 1);
    auto issue = [&](int cidx) {
#pragma unroll
        for (int j = 0; j < 6; ++j) { const int i = wave + 4 * j, rho = 4 * i + ro, step = rho / 6, vec = rho - 6 * step;
            const size_t off = (vec == 0) ? WS_R : (vec == 1) ? WS_DEC : (vec == 2) ? WS_K : (vec == 3) ? WS_KK : (vec == 4) ? WS_AA : WS_V;
            const GLB float* src = WSP(float, off) + gbase + (size_t)(cidx * CH + step) * 1024 + 4 * kq;
            __builtin_amdgcn_global_load_lds((const GLB unsigned*)src, (LAS unsigned*)(buf + (cidx & 1) * CHF + i * 256), 16, 0, 0); }
    };
    auto arrive_wait = [&]() {
        asm volatile("s_waitcnt vmcnt(0)" ::: "memory");
        target += 4u;
        if (lane == 0) (void)__hip_atomic_fetch_add((LAS unsigned*)(C.lds + SCAN_CNT_OFF), 1u, __ATOMIC_RELAXED, __HIP_MEMORY_SCOPE_WORKGROUP);
        while ((int)(*cnt - target) < 0) __builtin_amdgcn_s_sleep(1);
        asm volatile("" ::: "memory");
    };
    float S0 = 0.f, S1 = 0.f, S2 = 0.f, S3 = 0.f;
    issue(0); arrive_wait();
    for (int cidx = 0; cidx < NCH; ++cidx) {
        if (cidx + 1 < NCH) issue(cidx + 1);
        const LAS float* cb = buf + (cidx & 1) * CHF;
#pragma unroll 4
        for (int st = 0; st < CH; ++st) {
            const LAS float* rb = cb + st * 384;
            const f32x4 kk4 = *(const LAS f32x4*)(rb + 192 + 4 * kq);
            const float p = row16_sum(S0 * kk4[0] + S1 * kk4[1] + S2 * kk4[2] + S3 * kk4[3]);
            const f32x4 w4 = *(const LAS f32x4*)(rb + 64 + 4 * kq), b4 = *(const LAS f32x4*)(rb + 256 + 4 * kq), k4 = *(const LAS f32x4*)(rb + 128 + 4 * kq), r4 = *(const LAS f32x4*)(rb + 4 * kq);
            const float vv = rb[320 + row];
            S0 = S0 * w4[0] - p * b4[0] + vv * k4[0]; S1 = S1 * w4[1] - p * b4[1] + vv * k4[1]; S2 = S2 * w4[2] - p * b4[2] + vv * k4[2]; S3 = S3 * w4[3] - p * b4[3] + vv * k4[3];
            const float y = row16_sum(S0 * r4[0] + S1 * r4[1] + S2 * r4[2] + S3 * r4[3]);
            if (kq == 0) WSP(float, WS_YRAW)[gbase + (size_t)(cidx * CH + st) * 1024 + row] = y;
        }
        asm volatile("s_waitcnt lgkmcnt(0)" ::: "memory");
        arrive_wait();
    }
}

#ifndef SCAN3_CONV_MODE
#define SCAN3_CONV_MODE 0
#endif
#ifndef CONV_NT
#define CONV_NT 0
#endif
__device__ __forceinline__ void conv_tile_load(const GLB float* W, int ldw, int k0, int s0, f32x4 (&v)[16], int lane) {
    const int cq = lane & 15, rq = lane >> 4;
    const unsigned loff = (unsigned)(rq * ldw + 4 * cq);
    const GLB float* base = W + (size_t)k0 * ldw + s0;
#pragma unroll
    for (int i = 0; i < 16; ++i) { const GLB float* rowp = base + (size_t)(4 * i) * ldw; v[i] = CONV_NT ? __builtin_nontemporal_load((const GLB f32x4*)(rowp + loff)) : *(const GLB f32x4*)(rowp + loff); }
}
__device__ __forceinline__ void conv_tile_to_lds(const f32x4 (&v)[16], LAS float* scr, int lane) {
    const int cq = lane & 15, rq = lane >> 4;
#pragma unroll
    for (int i = 0; i < 16; ++i) { const int kk = 4 * i + rq; LAS float* d = scr + kk * 65 + 4 * cq; d[0] = v[i][0]; d[1] = v[i][1]; d[2] = v[i][2]; d[3] = v[i][3]; }
}
__device__ __forceinline__ void conv_tile_from_lds(GLB bf16_t* Bt, int K, int n0, int k0, LAS float* scr, int lane) {
    const int c = lane & 7;
#pragma unroll
    for (int j = 0; j < 8; ++j) { const int n = (lane >> 3) + 8 * j; const LAS float* s = scr + (8 * c) * 65 + n;
        u32x4 o; o.x = pk2(s[0 * 65], s[1 * 65]); o.y = pk2(s[2 * 65], s[3 * 65]); o.z = pk2(s[4 * 65], s[5 * 65]); o.w = pk2(s[6 * 65], s[7 * 65]);
        if (CONV_NT & 2) __builtin_nontemporal_store(o, (GLB u32x4*)(Bt + (size_t)(n0 + n) * K + k0 + 8 * c)); else *(GLB u32x4*)(Bt + (size_t)(n0 + n) * K + k0 + 8 * c) = o; }
}
__device__ __forceinline__ void conv_tile_finish(const f32x4 (&v)[16], GLB bf16_t* Bt, int K, int n0, int k0, LAS float* scr, int lane) {
    conv_tile_to_lds(v, scr, lane); LDS_WAIT(); conv_tile_from_lds(Bt, K, n0, k0, scr, lane); LDS_WAIT();
}
struct MoeTile { const GLB float* W; GLB bf16_t* Bt; int ldw, K, k0, s0, n0; };
__device__ __forceinline__ MoeTile moe_tile_desc(const Ctx& C, int idx) {
    constexpr int I_GU1 = (D / 64) * (2 * FF / 64), I_DN1 = (FF / 64) * (D / 64);
    MoeTile t;
    if (idx < NE * I_GU1) {
        const int e = idx / I_GU1, r = idx % I_GU1, nb = r % (2 * FF / 64), kb = r / (2 * FF / 64), tile = nb >> 2, q = nb & 3;
        t.W = ((q < 2) ? INF32(I_MG) : INF32(I_MU)) + (size_t)e * D * FF; t.ldw = FF; t.k0 = 64 * kb; t.s0 = 128 * tile + 64 * (q & 1);
        t.Bt = WSP(bf16_t, WS_MWGU) + (size_t)e * 2 * FF * D; t.K = D; t.n0 = 64 * nb;
    } else {
        const int r0 = idx - NE * I_GU1, e = r0 / I_DN1, r = r0 % I_DN1, nb = r % 32, kb = r / 32;
        t.W = INF32(I_MD) + (size_t)e * FF * D; t.ldw = D; t.k0 = 64 * kb; t.s0 = 64 * nb; t.Bt = WSP(bf16_t, WS_MWD) + (size_t)e * D * FF; t.K = FF; t.n0 = 64 * nb;
    }
    return t;
}
__device__ __forceinline__ void ph_rwkv_scan4(const Ctx& C, int l) {
    int tid = C.tid; asm volatile("" : "+v"(tid));
    const int lane = tid & 63, wave = C.wave;
    if (wave >= 4) {
        if (MOE_CONV_IN_PROLOGUE || blockIdx.x >= 256) return;
        LAS float* scr = (LAS float*)(C.lds + 65536 + (wave - 4) * 16640);
        constexpr int PER = MOE_CONV_ITEMS / 2 / 1024;
        const int first = l * (MOE_CONV_ITEMS / 2) + (blockIdx.x * 4 + (wave - 4)) * PER;
        f32x4 va[16], vb[16];
        MoeTile ta = moe_tile_desc(C, first), tb;
        conv_tile_load(ta.W, ta.ldw, ta.k0, ta.s0, va, lane);
        for (int i = 0; i < PER; i += 2) {
            tb = moe_tile_desc(C, first + i + 1);
            conv_tile_load(tb.W, tb.ldw, tb.k0, tb.s0, vb, lane);
            conv_tile_finish(va, ta.Bt, ta.K, ta.n0, ta.k0, scr, lane);
            if (i + 2 < PER) { ta = moe_tile_desc(C, first + i + 2); conv_tile_load(ta.W, ta.ldw, ta.k0, ta.s0, va, lane); }
            conv_tile_finish(vb, tb.Bt, tb.K, tb.n0, tb.k0, scr, lane);
        }
        return;
    }
    constexpr int CH = 16, CHF = CH * 384, NCH = SEQ / CH;
    LAS float* buf = (LAS float*)C.lds;
    LAS float* ybuf = (LAS float*)(C.lds + 49152);
    volatile LAS unsigned* cnt = (volatile LAS unsigned*)(C.lds + SCAN_CNT_OFF);
    const int it = blockIdx.x;
    if (it >= NB * 16 * 4) return;
    const int qr = it & 3, h = (it >> 2) & 15, b = it >> 6;
    const size_t gbase = (size_t)b * SEQ * 1024 + h * 64;
    const int ro = lane >> 4, kq = lane & 15, rloc = 4 * wave + ro;
    unsigned target = (unsigned)l * 4u * (NCH + 1);
    auto issue = [&](int cidx) {
#pragma unroll
        for (int j = 0; j < 6; ++j) { const int i = wave + 4 * j, rho = 4 * i + ro, step = rho / 6, vec = rho - 6 * step;
            const size_t off = (vec == 0) ? WS_R : (vec == 1) ? WS_DEC : (vec == 2) ? WS_K : (vec == 3) ? WS_KK : (vec == 4) ? WS_AA : WS_V;
            const GLB float* src = WSP(float, off) + gbase + (size_t)(cidx * CH + step) * 1024 + 4 * kq;
            __builtin_amdgcn_global_load_lds((const GLB unsigned*)src, (LAS unsigned*)(buf + (cidx & 1) * CHF + i * 256), 16, 0, 0); }
    };
    auto arrive_wait = [&]() {
        asm volatile("s_waitcnt vmcnt(0) lgkmcnt(0)" ::: "memory");
        target += 4u;
        if (lane == 0) (void)__hip_atomic_fetch_add((LAS unsigned*)(C.lds + SCAN_CNT_OFF), 1u, __ATOMIC_RELAXED, __HIP_MEMORY_SCOPE_WORKGROUP);
        while ((int)(*cnt - target) < 0) __builtin_amdgcn_s_sleep(1);
        asm volatile("" ::: "memory");
    };
    auto flush_y = [&](int cidx) {
        const int st = lane >> 2, r = lane & 3;
        WSP(float, WS_YRAW)[gbase + (size_t)(cidx * CH + st) * 1024 + 16 * qr + 4 * wave + r] = ybuf[(cidx & 1) * 256 + st * 16 + 4 * wave + r];
    };
    f32x2 Sa = {0.f, 0.f}, Sb = {0.f, 0.f};
    issue(0); arrive_wait();
    for (int cidx = 0; cidx < NCH; ++cidx) {
        if (cidx > 0) flush_y(cidx - 1);
        if (cidx + 1 < NCH) issue(cidx + 1);
        const LAS float* cb = buf + (cidx & 1) * CHF;
        LAS float* yb = ybuf + (cidx & 1) * 256;
#pragma unroll 4
        for (int st = 0; st < CH; ++st) {
            const LAS float* rb = cb + st * 384;
            const f32x4 kk4 = *(const LAS f32x4*)(rb + 192 + 4 * kq);
            const f32x2 tp = Sa * (f32x2){kk4[0], kk4[1]} + Sb * (f32x2){kk4[2], kk4[3]};
            const float p = row16_sum(tp[0] + tp[1]);
            const f32x4 w4 = *(const LAS f32x4*)(rb + 64 + 4 * kq), b4 = *(const LAS f32x4*)(rb + 256 + 4 * kq), k4 = *(const LAS f32x4*)(rb + 128 + 4 * kq), r4 = *(const LAS f32x4*)(rb + 4 * kq);
            const float vv = rb[320 + 16 * qr + rloc];
            const f32x2 pp = {p, p}, vv2 = {vv, vv};
            Sa = Sa * (f32x2){w4[0], w4[1]} - pp * (f32x2){b4[0], b4[1]} + vv2 * (f32x2){k4[0], k4[1]};
            Sb = Sb * (f32x2){w4[2], w4[3]} - pp * (f32x2){b4[2], b4[3]} + vv2 * (f32x2){k4[2], k4[3]};
            const f32x2 ty = Sa * (f32x2){r4[0], r4[1]} + Sb * (f32x2){r4[2], r4[3]};
            const float y = row16_sum(ty[0] + ty[1]);
            if (kq == 0) yb[st * 16 + rloc] = y;
        }
        arrive_wait();
    }
    flush_y(NCH - 1);
}

#ifndef SCAN_TOUCH
#define SCAN_TOUCH 1
#endif
#ifndef SCAN_SCHED
#define SCAN_SCHED 1
#endif
#ifndef SCAN_UNROLL
#define SCAN_UNROLL 4
#endif
__device__ __forceinline__ void ph_rwkv_scan3(const Ctx& C, int l) {
    int tid = C.tid; asm volatile("" : "+v"(tid));
    const int lane = tid & 63, wave = C.wave;
    constexpr int CH = 16, CHF = CH * 384, NCH = SEQ / CH;
    LAS float* buf = (LAS float*)C.lds;
    LAS float* ybuf = (LAS float*)(C.lds + 49152);
    LAS float* scr = (LAS float*)(C.lds + 65536 + (wave & 3) * 16640);
    const int it = blockIdx.x;
    if (it >= NB * 16 * 4) return;
    const int qr = it & 3, h = (it >> 2) & 15, b = it >> 6;
    const size_t gbase = (size_t)b * SEQ * 1024 + h * 64;
    const int ro = lane >> 4, kq = lane & 15, rloc = 4 * (wave & 3) + ro;
    const int lj = tid - 256;
    constexpr int PER = MOE_CONV_ITEMS / 2 / 1024;
    static_assert(PER * 1024 * 2 == MOE_CONV_ITEMS && PER * 3 <= NCH, "conversion slots");
    const int cfirst = l * (MOE_CONV_ITEMS / 2) + (blockIdx.x * 4 + (wave & 3)) * PER;
    auto load_chunk = [&](int cidx) {
        f32x4 v[6];
#pragma unroll
        for (int i = 0; i < 6; ++i) { const int idx = lj + 256 * i, step = idx / 96, rem = idx - step * 96, vec = rem >> 4, e4 = rem & 15;
            const size_t off = (vec == 0) ? WS_R : (vec == 1) ? WS_DEC : (vec == 2) ? WS_K : (vec == 3) ? WS_KK : (vec == 4) ? WS_AA : WS_V;
            v[i] = *(const GLB f32x4*)(WSP(float, off) + gbase + (size_t)(cidx * CH + step) * 1024 + 4 * e4); }
        LAS float* d = buf + (cidx & 1) * CHF;
#pragma unroll
        for (int i = 0; i < 6; ++i) { const int idx = lj + 256 * i, step = idx / 96, rem = idx - step * 96; *(LAS f32x4*)(d + step * 384 + rem * 4) = v[i]; }
    };
    auto flush_y = [&](int cidx) {
        const int st = lj >> 4, r = lj & 15;
        WSP(float, WS_YRAW)[gbase + (size_t)(cidx * CH + st) * 1024 + 16 * qr + r] = ybuf[(cidx & 1) * 256 + lj];
    };
    f32x2 Sa = {0.f, 0.f}, Sb = {0.f, 0.f};
    f32x4 cv[16]; MoeTile ct; ct.W = nullptr; ct.Bt = nullptr; ct.ldw = 0; ct.K = 0; ct.k0 = 0; ct.s0 = 0; ct.n0 = 0;
#pragma unroll
    for (int i = 0; i < 16; ++i) cv[i] = (f32x4){0.f, 0.f, 0.f, 0.f};
    if (wave >= 4) load_chunk(0);
    LDS_WAIT(); __syncthreads();
    for (int cidx = 0; cidx < NCH; ++cidx) {
        if (wave >= 4) {
            if (cidx + 1 < NCH) load_chunk(cidx + 1);
            if (cidx > 0) flush_y(cidx - 1);
            if (!MOE_CONV_IN_PROLOGUE) {
                const int q3 = cidx / 3, r3 = cidx - 3 * q3;
                if (r3 == 0 && q3 < PER) { ct = moe_tile_desc(C, cfirst + q3); conv_tile_load(ct.W, ct.ldw, ct.k0, ct.s0, cv, lane); }
                else if (r3 == 1 && q3 < PER) conv_tile_finish(cv, ct.Bt, ct.K, ct.n0, ct.k0, scr, lane);
            }
        } else {
            const LAS float* cb = buf + (cidx & 1) * CHF;
            LAS float* yb = ybuf + (cidx & 1) * 256;
            __builtin_amdgcn_s_setprio(3);
#pragma unroll SCAN_UNROLL
            for (int st = 0; st < CH; ++st) {
                const LAS float* rb = cb + st * 384;
                const f32x4 kk4 = *(const LAS f32x4*)(rb + 192 + 4 * kq);
                const f32x2 tp = Sa * (f32x2){kk4[0], kk4[1]} + Sb * (f32x2){kk4[2], kk4[3]};
                const float p = row16_sum(tp[0] + tp[1]);
                const f32x4 w4 = *(const LAS f32x4*)(rb + 64 + 4 * kq), b4 = *(const LAS f32x4*)(rb + 256 + 4 * kq), k4 = *(const LAS f32x4*)(rb + 128 + 4 * kq), r4 = *(const LAS f32x4*)(rb + 4 * kq);
                const float vv = rb[320 + 16 * qr + rloc];
                const f32x2 pp = {p, p}, vv2 = {vv, vv};
                Sa = Sa * (f32x2){w4[0], w4[1]} - pp * (f32x2){b4[0], b4[1]} + vv2 * (f32x2){k4[0], k4[1]};
                Sb = Sb * (f32x2){w4[2], w4[3]} - pp * (f32x2){b4[2], b4[3]} + vv2 * (f32x2){k4[2], k4[3]};
                const f32x2 ty = Sa * (f32x2){r4[0], r4[1]} + Sb * (f32x2){r4[2], r4[3]};
                const float y = row16_sum(ty[0] + ty[1]);
                if (kq == 0) yb[st * 16 + rloc] = y;
            }
            __builtin_amdgcn_s_setprio(0);
        }
        LDS_WAIT(); __builtin_amdgcn_s_barrier(); asm volatile("" ::: "memory");
    }
    if (wave >= 4) flush_y(NCH - 1);
}


template <int CONV>
__device__ __forceinline__ void ph_rwkv_scan5(const Ctx& C, int l) {
    int tid = C.tid; asm volatile("" : "+v"(tid));
    const int lane = tid & 63, wave = C.wave;
    constexpr int CH = 16, CHF = CH * 384, NCH = SEQ / CH;
    LAS float* buf = (LAS float*)C.lds;
    LAS float* ybuf = (LAS float*)(C.lds + 49152);
    const int it = blockIdx.x;
    if (it >= NB * 16 * 4) return;
    const int qr = it & 3, h = (it >> 2) & 15, b = it >> 6;
    const size_t gbase = (size_t)b * SEQ * 1024 + h * 64;
#define SCAN5_BAR() do { LDS_WAIT(); __builtin_amdgcn_s_barrier(); asm volatile("" ::: "memory"); } while (0)
    if (wave >= 4) {
        LAS float* scr = (LAS float*)(C.lds + 65536 + (wave & 3) * 16640);
        const int lj = tid - 256;
        constexpr int PER = MOE_SCAN_TILES;
        static_assert(PER * 1024 * 2 <= MOE_CONV_ITEMS && PER * 3 + 2 <= NCH && PER % 2 == 0, "conversion slots");
        const int cfirst = ((CONV >= 2) ? 1 : l) * (1024 * PER) + (blockIdx.x * 4 + (wave & 3));
        f32x4 nx[5];
        const unsigned lo_g = (unsigned)((lj >> 4) * 1024 + 4 * (lj & 15));
        const int lo_l = (lj >> 4) * 384 + 4 * (lj & 15);
        const f32x4 kkw = *(const GLB f32x4*)(INF32(I_RWKK) + l * 1024 + h * 64 + 4 * (lj & 15)), kaw = *(const GLB f32x4*)(INF32(I_RWKA) + l * 1024 + h * 64 + 4 * (lj & 15));
        u32x2 nb[4];
        auto fetch_chunk = [&](int cidx) {
            nx[1] = *(const GLB f32x4*)(WSP(float, WS_DEC) + gbase + (size_t)(cidx * CH) * 1024 + lo_g);
#pragma unroll
            for (int i = 0; i < 4; ++i) { const size_t off = (i == 0) ? WS_R : (i == 1) ? WS_K : (i == 2) ? WS_AA : WS_V;
                nb[i] = *(const GLB u32x2*)(WSP(bf16_t, off) + gbase + (size_t)(cidx * CH) * 1024 + lo_g); }
        };
        auto put_chunk = [&](int cidx) {
            LAS float* d = buf + (cidx & 1) * CHF + lo_l;
            asm volatile("" : "+v"(nx[1]), "+v"(nb[0]), "+v"(nb[1]), "+v"(nb[2]), "+v"(nb[3]));
            nx[0] = (f32x4){bflo(nb[0].x), bfhi(nb[0].x), bflo(nb[0].y), bfhi(nb[0].y)}; nx[4] = (f32x4){bflo(nb[3].x), bfhi(nb[3].x), bflo(nb[3].y), bfhi(nb[3].y)};
            const f32x4 kr = (f32x4){bflo(nb[1].x), bfhi(nb[1].x), bflo(nb[1].y), bfhi(nb[1].y)}, av = (f32x4){bflo(nb[2].x), bfhi(nb[2].x), bflo(nb[2].y), bfhi(nb[2].y)};
            f32x4 kk = kr * kkw;
            const float ss = row16_sum((kk[0] * kk[0] + kk[1] * kk[1]) + (kk[2] * kk[2] + kk[3] * kk[3]));
            kk = kk * (1.0f / fmaxf(sqrtf(ss), 1e-12f));
            *(LAS f32x4*)(d) = nx[0]; *(LAS f32x4*)(d + 64) = nx[1]; *(LAS f32x4*)(d + 128) = kr * (1.0f + (av - 1.0f) * kaw);
            *(LAS f32x4*)(d + 192) = kk; *(LAS f32x4*)(d + 256) = kk * av; *(LAS f32x4*)(d + 320) = nx[4];
        };
        auto flush_y = [&](int cidx) {
            const int st = lj >> 4, r = lj & 15;
            WSP(float, WS_YRAW)[gbase + (size_t)(cidx * CH + st) * 1024 + 16 * qr + r] = ybuf[(cidx & 1) * 256 + lj];
        };
#if SCAN_SCHED == 4
        struct FS { f32x4 dec; u32x2 nb[4]; };
        FS fs[6];
        auto fetch2 = [&](int cidx, FS& f) {
            f.dec = *(const GLB f32x4*)(WSP(float, WS_DEC) + gbase + (size_t)(cidx * CH) * 1024 + lo_g);
#pragma unroll
            for (int i = 0; i < 4; ++i) { const size_t off = (i == 0) ? WS_R : (i == 1) ? WS_K : (i == 2) ? WS_AA : WS_V;
                f.nb[i] = *(const GLB u32x2*)(WSP(bf16_t, off) + gbase + (size_t)(cidx * CH) * 1024 + lo_g); }
        };
        auto put2 = [&](int cidx, FS& f) {
            LAS float* d = buf + (cidx & 1) * CHF + lo_l;
            asm volatile("" : "+v"(f.dec), "+v"(f.nb[0]), "+v"(f.nb[1]), "+v"(f.nb[2]), "+v"(f.nb[3]));
            const f32x4 rr = (f32x4){bflo(f.nb[0].x), bfhi(f.nb[0].x), bflo(f.nb[0].y), bfhi(f.nb[0].y)}, vv = (f32x4){bflo(f.nb[3].x), bfhi(f.nb[3].x), bflo(f.nb[3].y), bfhi(f.nb[3].y)};
            const f32x4 kr = (f32x4){bflo(f.nb[1].x), bfhi(f.nb[1].x), bflo(f.nb[1].y), bfhi(f.nb[1].y)}, av = (f32x4){bflo(f.nb[2].x), bfhi(f.nb[2].x), bflo(f.nb[2].y), bfhi(f.nb[2].y)};
            f32x4 kk = kr * kkw;
            const float ss = row16_sum((kk[0] * kk[0] + kk[1] * kk[1]) + (kk[2] * kk[2] + kk[3] * kk[3]));
            kk = kk * (1.0f / fmaxf(sqrtf(ss), 1e-12f));
            *(LAS f32x4*)(d) = rr; *(LAS f32x4*)(d + 64) = f.dec; *(LAS f32x4*)(d + 128) = kr * (1.0f + (av - 1.0f) * kaw);
            *(LAS f32x4*)(d + 192) = kk; *(LAS f32x4*)(d + 256) = kk * av; *(LAS f32x4*)(d + 320) = vv;
        };
        f32x4 cv[16]; MoeTile ct; ct.W = nullptr; ct.Bt = nullptr; ct.ldw = 0; ct.K = 0; ct.k0 = 0; ct.s0 = 0; ct.n0 = 0;
#pragma unroll
        for (int i = 0; i < 16; ++i) cv[i] = (f32x4){0.f, 0.f, 0.f, 0.f};
        {
            const int vit = blockIdx.x * 4 + (wave & 3);
            if (vit < 512) { const int sb = vit & 31, hd = (vit >> 5) & 1, vb = (vit >> 6) & 3;
                if ((vit >> 8) == 0) vt_tile(WSP(bf16_t, WS_VS) + ((size_t)vb * SEQ + 64 * sb) * 128 + 64 * hd, 128, WSP(bf16_t, WS_SWVT) + ((size_t)(vb * 2 + hd) * 64) * SEQ + 64 * sb, (LAS bf16_t*)scr, lane);
                else vt_tile(WSP(bf16_t, WS_VD) + ((size_t)vb * SEQ + 64 * sb) * 128 + 64 * hd, 128, WSP(bf16_t, WS_VDT) + ((size_t)vb * 128 + 64 * hd) * SEQ + 64 * sb, (LAS bf16_t*)scr, lane); }
        }
        static_assert(PER * 3 + 2 == NCH && PER % 2 == 0, "period schedule");
        const int off = (int)((blockIdx.x * 4u + (unsigned)(wave & 3)) & 1u);
        fetch2(0, fs[0]); put2(0, fs[0]); fetch2(1, fs[0]);
        SCAN5_BAR();
        int c = 0;
        for (; c < 1 + off; ++c) { put2(c + 1, fs[0]); fetch2(c + 2, fs[0]); if (c > 0) flush_y(c - 1); SCAN5_BAR(); }
#pragma unroll
        for (int i = 1; i < 6; ++i) fetch2(c + 1 + i, fs[i]);
        asm volatile("; MARK scan5 periodic begin");
        auto period = [&](int j6, bool first) {
#pragma unroll
            for (int m6 = 0; m6 < 6; ++m6) {
                asm volatile("; MARK m6 iter");
                put2(c + 1, fs[m6]); fetch2(c + 7 < NCH ? c + 7 : NCH - 1, fs[m6]); flush_y(c - 1);
                if (!MOE_CONV_IN_PROLOGUE && CONV) {
                    if (m6 == 0) { if (!first) conv_tile_finish(cv, ct.Bt, ct.K, ct.n0, ct.k0, scr, lane);
                        ct = moe_tile_desc(C, cfirst + 1024 * (2 * j6)); conv_tile_load(ct.W, ct.ldw, ct.k0, ct.s0, cv, lane); }
                    if (m6 == 3 && !first) { const MoeTile cb = moe_tile_desc(C, cfirst + 1024 * (2 * j6 - 1)); conv_tile_from_lds(cb.Bt, cb.K, cb.n0, cb.k0, scr, lane); }
                }
                SCAN5_BAR(); ++c;
            }
        };
        period(0, true);
        for (int j6 = 1; j6 < PER / 2; ++j6) period(j6, false);
        asm volatile("; MARK scan5 periodic end");
        for (; c < NCH; ++c) { flush_y(c - 1); SCAN5_BAR(); }
        if (!MOE_CONV_IN_PROLOGUE && CONV) {
            conv_tile_finish(cv, ct.Bt, ct.K, ct.n0, ct.k0, scr, lane);
            SCAN5_BAR();
            SCAN5_BAR();
            { const MoeTile cb = moe_tile_desc(C, cfirst + 1024 * (PER - 1)); conv_tile_from_lds(cb.Bt, cb.K, cb.n0, cb.k0, scr, lane); }
        }
#elif SCAN_SCHED == 3
        struct FS { f32x4 dec; u32x2 nb[4]; };
        FS fs[6];
        auto fetch2 = [&](int cidx, FS& f) {
            f.dec = *(const GLB f32x4*)(WSP(float, WS_DEC) + gbase + (size_t)(cidx * CH) * 1024 + lo_g);
#pragma unroll
            for (int i = 0; i < 4; ++i) { const size_t off = (i == 0) ? WS_R : (i == 1) ? WS_K : (i == 2) ? WS_AA : WS_V;
                f.nb[i] = *(const GLB u32x2*)(WSP(bf16_t, off) + gbase + (size_t)(cidx * CH) * 1024 + lo_g); }
        };
        auto put2 = [&](int cidx, FS& f) {
            LAS float* d = buf + (cidx & 1) * CHF + lo_l;
            asm volatile("" : "+v"(f.dec), "+v"(f.nb[0]), "+v"(f.nb[1]), "+v"(f.nb[2]), "+v"(f.nb[3]));
            const f32x4 rr = (f32x4){bflo(f.nb[0].x), bfhi(f.nb[0].x), bflo(f.nb[0].y), bfhi(f.nb[0].y)}, vv = (f32x4){bflo(f.nb[3].x), bfhi(f.nb[3].x), bflo(f.nb[3].y), bfhi(f.nb[3].y)};
            const f32x4 kr = (f32x4){bflo(f.nb[1].x), bfhi(f.nb[1].x), bflo(f.nb[1].y), bfhi(f.nb[1].y)}, av = (f32x4){bflo(f.nb[2].x), bfhi(f.nb[2].x), bflo(f.nb[2].y), bfhi(f.nb[2].y)};
            f32x4 kk = kr * kkw;
            const float ss = row16_sum((kk[0] * kk[0] + kk[1] * kk[1]) + (kk[2] * kk[2] + kk[3] * kk[3]));
            kk = kk * (1.0f / fmaxf(sqrtf(ss), 1e-12f));
            *(LAS f32x4*)(d) = rr; *(LAS f32x4*)(d + 64) = f.dec; *(LAS f32x4*)(d + 128) = kr * (1.0f + (av - 1.0f) * kaw);
            *(LAS f32x4*)(d + 192) = kk; *(LAS f32x4*)(d + 256) = kk * av; *(LAS f32x4*)(d + 320) = vv;
        };
        f32x4 cv[16]; MoeTile ct; ct.W = nullptr; ct.Bt = nullptr; ct.ldw = 0; ct.K = 0; ct.k0 = 0; ct.s0 = 0; ct.n0 = 0;
#pragma unroll
        for (int i = 0; i < 16; ++i) cv[i] = (f32x4){0.f, 0.f, 0.f, 0.f};
        {
            const int vit = blockIdx.x * 4 + (wave & 3);
            if (vit < 512) { const int sb = vit & 31, hd = (vit >> 5) & 1, vb = (vit >> 6) & 3;
                if ((vit >> 8) == 0) vt_tile(WSP(bf16_t, WS_VS) + ((size_t)vb * SEQ + 64 * sb) * 128 + 64 * hd, 128, WSP(bf16_t, WS_SWVT) + ((size_t)(vb * 2 + hd) * 64) * SEQ + 64 * sb, (LAS bf16_t*)scr, lane);
                else vt_tile(WSP(bf16_t, WS_VD) + ((size_t)vb * SEQ + 64 * sb) * 128 + 64 * hd, 128, WSP(bf16_t, WS_VDT) + ((size_t)vb * 128 + 64 * hd) * SEQ + 64 * sb, (LAS bf16_t*)scr, lane); }
        }
        static_assert(PER * 3 + 2 == NCH && PER % 2 == 0, "period schedule");
        const int off = (int)((blockIdx.x * 4u + (unsigned)(wave & 3)) & 1u);
        fetch2(0, fs[0]); put2(0, fs[0]); fetch2(1, fs[0]);
        SCAN5_BAR();
        int c = 0;
        for (; c < 1 + off; ++c) { put2(c + 1, fs[0]); fetch2(c + 2, fs[0]); if (c > 0) flush_y(c - 1); SCAN5_BAR(); }
#pragma unroll
        for (int i = 1; i < 6; ++i) fetch2(c + 1 + i, fs[i]);
        asm volatile("; MARK scan5 periodic begin");
        auto period = [&](int j6, bool first) {
#pragma unroll
            for (int m6 = 0; m6 < 6; ++m6) {
                asm volatile("; MARK m6 iter");
                put2(c + 1, fs[m6]); fetch2(c + 7 < NCH ? c + 7 : NCH - 1, fs[m6]); flush_y(c - 1);
                if (!MOE_CONV_IN_PROLOGUE && CONV && (m6 == 0 || (m6 == 3 && CONV != 5))) {
                    if (!(first && m6 == 0)) { if (CONV == 1) conv_tile_finish(cv, ct.Bt, ct.K, ct.n0, ct.k0, scr, lane);
                        else { asm volatile("" :: "v"(cv[0]), "v"(cv[1]), "v"(cv[2]), "v"(cv[3]), "v"(cv[4]), "v"(cv[5]), "v"(cv[6]), "v"(cv[7])); asm volatile("" :: "v"(cv[8]), "v"(cv[9]), "v"(cv[10]), "v"(cv[11]), "v"(cv[12]), "v"(cv[13]), "v"(cv[14]), "v"(cv[15])); } }
                    ct = moe_tile_desc(C, cfirst + 1024 * (2 * j6 + (m6 == 3 ? 1 : 0))); conv_tile_load(ct.W, ct.ldw, ct.k0, ct.s0, cv, lane);
                }
                SCAN5_BAR(); ++c;
            }
        };
        period(0, true);
        for (int j6 = 1; j6 < PER / 2; ++j6) period(j6, false);
        asm volatile("; MARK scan5 periodic end");
        for (; c < NCH; ++c) { flush_y(c - 1); SCAN5_BAR(); }
        if (!MOE_CONV_IN_PROLOGUE && CONV == 1) conv_tile_finish(cv, ct.Bt, ct.K, ct.n0, ct.k0, scr, lane);
#elif SCAN_SCHED == 2
        struct FS { f32x4 dec; u32x2 nb[4]; };
        FS fs[2];
        auto fetch2 = [&](int cidx, FS& f) {
            f.dec = *(const GLB f32x4*)(WSP(float, WS_DEC) + gbase + (size_t)(cidx * CH) * 1024 + lo_g);
#pragma unroll
            for (int i = 0; i < 4; ++i) { const size_t off = (i == 0) ? WS_R : (i == 1) ? WS_K : (i == 2) ? WS_AA : WS_V;
                f.nb[i] = *(const GLB u32x2*)(WSP(bf16_t, off) + gbase + (size_t)(cidx * CH) * 1024 + lo_g); }
        };
        auto put2 = [&](int cidx, FS& f) {
            LAS float* d = buf + (cidx & 1) * CHF + lo_l;
            asm volatile("" : "+v"(f.dec), "+v"(f.nb[0]), "+v"(f.nb[1]), "+v"(f.nb[2]), "+v"(f.nb[3]));
            const f32x4 rr = (f32x4){bflo(f.nb[0].x), bfhi(f.nb[0].x), bflo(f.nb[0].y), bfhi(f.nb[0].y)}, vv = (f32x4){bflo(f.nb[3].x), bfhi(f.nb[3].x), bflo(f.nb[3].y), bfhi(f.nb[3].y)};
            const f32x4 kr = (f32x4){bflo(f.nb[1].x), bfhi(f.nb[1].x), bflo(f.nb[1].y), bfhi(f.nb[1].y)}, av = (f32x4){bflo(f.nb[2].x), bfhi(f.nb[2].x), bflo(f.nb[2].y), bfhi(f.nb[2].y)};
            f32x4 kk = kr * kkw;
            const float ss = row16_sum((kk[0] * kk[0] + kk[1] * kk[1]) + (kk[2] * kk[2] + kk[3] * kk[3]));
            kk = kk * (1.0f / fmaxf(sqrtf(ss), 1e-12f));
            *(LAS f32x4*)(d) = rr; *(LAS f32x4*)(d + 64) = f.dec; *(LAS f32x4*)(d + 128) = kr * (1.0f + (av - 1.0f) * kaw);
            *(LAS f32x4*)(d + 192) = kk; *(LAS f32x4*)(d + 256) = kk * av; *(LAS f32x4*)(d + 320) = vv;
        };
        f32x4 cv[16]; MoeTile ct; ct.W = nullptr; ct.Bt = nullptr; ct.ldw = 0; ct.K = 0; ct.k0 = 0; ct.s0 = 0; ct.n0 = 0;
#pragma unroll
        for (int i = 0; i < 16; ++i) cv[i] = (f32x4){0.f, 0.f, 0.f, 0.f};
        {
            const int vit = blockIdx.x * 4 + (wave & 3);
            if (vit < 512) { const int sb = vit & 31, hd = (vit >> 5) & 1, vb = (vit >> 6) & 3;
                if ((vit >> 8) == 0) vt_tile(WSP(bf16_t, WS_VS) + ((size_t)vb * SEQ + 64 * sb) * 128 + 64 * hd, 128, WSP(bf16_t, WS_SWVT) + ((size_t)(vb * 2 + hd) * 64) * SEQ + 64 * sb, (LAS bf16_t*)scr, lane);
                else vt_tile(WSP(bf16_t, WS_VD) + ((size_t)vb * SEQ + 64 * sb) * 128 + 64 * hd, 128, WSP(bf16_t, WS_VDT) + ((size_t)vb * 128 + 64 * hd) * SEQ + 64 * sb, (LAS bf16_t*)scr, lane); }
        }
        static_assert(PER * 3 + 2 == NCH && PER % 2 == 0, "period schedule");
        const int off = (int)((blockIdx.x * 4u + (unsigned)(wave & 3)) & 1u);
        fetch2(0, fs[0]); put2(0, fs[0]); fetch2(1, fs[0]);
        SCAN5_BAR();
        int c = 0;
        for (; c < 1 + off; ++c) { put2(c + 1, fs[0]); fetch2(c + 2, fs[0]); if (c > 0) flush_y(c - 1); SCAN5_BAR(); }
        fetch2(c + 2, fs[1]);
        asm volatile("; MARK scan5 periodic begin");
        auto period = [&](int j6, bool first) {
#pragma unroll
            for (int m6 = 0; m6 < 6; ++m6) {
                asm volatile("; MARK m6 iter");
                put2(c + 1, fs[m6 & 1]); fetch2(c + 3 < NCH ? c + 3 : NCH - 1, fs[m6 & 1]); flush_y(c - 1);
                if (!MOE_CONV_IN_PROLOGUE && CONV && (m6 == 0 || (m6 == 3 && CONV != 5))) {
                    if (!(first && m6 == 0)) {
                        if (CONV == 1 || CONV == 4) conv_tile_finish(cv, ct.Bt, ct.K, ct.n0, ct.k0, scr, lane);
                        else if (CONV == 3) { const int cc = lane & 7;
#pragma unroll
                            for (int j = 0; j < 8; ++j) { const int n = (lane >> 3) + 8 * j; u32x4 o; o.x = pk2(cv[2 * j][0], cv[2 * j][1]); o.y = pk2(cv[2 * j][2], cv[2 * j][3]); o.z = pk2(cv[2 * j + 1][0], cv[2 * j + 1][1]); o.w = pk2(cv[2 * j + 1][2], cv[2 * j + 1][3]);
                                *(GLB u32x4*)(ct.Bt + (size_t)(ct.n0 + n) * ct.K + ct.k0 + 8 * cc) = o; } }
                        else { asm volatile("" :: "v"(cv[0]), "v"(cv[1]), "v"(cv[2]), "v"(cv[3]), "v"(cv[4]), "v"(cv[5]), "v"(cv[6]), "v"(cv[7])); asm volatile("" :: "v"(cv[8]), "v"(cv[9]), "v"(cv[10]), "v"(cv[11]), "v"(cv[12]), "v"(cv[13]), "v"(cv[14]), "v"(cv[15])); }
                    }
                    ct = moe_tile_desc(C, cfirst + 1024 * (2 * j6 + (m6 == 3 ? 1 : 0))); conv_tile_load(ct.W, ct.ldw, ct.k0, ct.s0, cv, lane);
                }
                SCAN5_BAR(); ++c;
            }
        };
        period(0, true);
        for (int j6 = 1; j6 < PER / 2; ++j6) period(j6, false);
        asm volatile("; MARK scan5 periodic end");
        for (; c < NCH; ++c) { flush_y(c - 1); SCAN5_BAR(); }
        if (!MOE_CONV_IN_PROLOGUE && (CONV == 1 || CONV == 4)) conv_tile_finish(cv, ct.Bt, ct.K, ct.n0, ct.k0, scr, lane);
#elif SCAN_SCHED == 1
        f32x4 cv[16]; MoeTile ct; ct.W = nullptr; ct.Bt = nullptr; ct.ldw = 0; ct.K = 0; ct.k0 = 0; ct.s0 = 0; ct.n0 = 0;
#pragma unroll
        for (int i = 0; i < 16; ++i) cv[i] = (f32x4){0.f, 0.f, 0.f, 0.f};
        {
            const int vit = blockIdx.x * 4 + (wave & 3);
            if (vit < 512) { const int sb = vit & 31, hd = (vit >> 5) & 1, vb = (vit >> 6) & 3;
                if ((vit >> 8) == 0) vt_tile(WSP(bf16_t, WS_VS) + ((size_t)vb * SEQ + 64 * sb) * 128 + 64 * hd, 128, WSP(bf16_t, WS_SWVT) + ((size_t)(vb * 2 + hd) * 64) * SEQ + 64 * sb, (LAS bf16_t*)scr, lane);
                else vt_tile(WSP(bf16_t, WS_VD) + ((size_t)vb * SEQ + 64 * sb) * 128 + 64 * hd, 128, WSP(bf16_t, WS_VDT) + ((size_t)vb * 128 + 64 * hd) * SEQ + 64 * sb, (LAS bf16_t*)scr, lane); }
        }
        static_assert(PER * 3 + 2 == NCH && PER % 2 == 0, "period schedule");
        const int off = (int)((blockIdx.x * 4u + (unsigned)(wave & 3)) & 1u);
        auto plain = [&](int c) { if (c + 1 < NCH) put_chunk(c + 1); if (c + 2 < NCH) fetch_chunk(c + 2); if (c > 0) flush_y(c - 1); };
        auto plain_nc = [&](int c) { put_chunk(c + 1); fetch_chunk(c + 2 < NCH ? c + 2 : NCH - 1); flush_y(c - 1); };
        fetch_chunk(0); put_chunk(0); fetch_chunk(1);
        SCAN5_BAR();
        int c = 0;
        for (; c < 1 + off; ++c) { plain(c); SCAN5_BAR(); }
        asm volatile("; MARK scan5 periodic begin");
        auto period = [&](int j6) {
#pragma unroll
            for (int m6 = 0; m6 < 6; ++m6) {
                asm volatile("; MARK m6 iter");
                plain_nc(c);
                if (!MOE_CONV_IN_PROLOGUE && CONV) {
                    if (m6 == 0 || m6 == 3) { ct = moe_tile_desc(C, cfirst + 1024 * (2 * j6 + (m6 == 3 ? 1 : 0))); conv_tile_load(ct.W, ct.ldw, ct.k0, ct.s0, cv, lane); }
                    if (m6 == 2 || m6 == 5) conv_tile_finish(cv, ct.Bt, ct.K, ct.n0, ct.k0, scr, lane);
                }
                SCAN5_BAR(); ++c;
            }
        };
        period(0);
        for (int j6 = 1; j6 < PER / 2; ++j6) period(j6);
        asm volatile("; MARK scan5 periodic end");
        for (; c < NCH; ++c) { plain(c); SCAN5_BAR(); }
#else
        f32x4 cv[16], cv2[16]; MoeTile ct; ct.W = nullptr; ct.Bt = nullptr; ct.ldw = 0; ct.K = 0; ct.k0 = 0; ct.s0 = 0; ct.n0 = 0; MoeTile ct2 = ct;
#pragma unroll
        for (int i = 0; i < 16; ++i) { cv[i] = (f32x4){0.f, 0.f, 0.f, 0.f}; cv2[i] = cv[i]; }
        {
            const int vit = blockIdx.x * 4 + (wave & 3);
            if (vit < 512) { const int sb = vit & 31, hd = (vit >> 5) & 1, vb = (vit >> 6) & 3;
                if ((vit >> 8) == 0) vt_tile(WSP(bf16_t, WS_VS) + ((size_t)vb * SEQ + 64 * sb) * 128 + 64 * hd, 128, WSP(bf16_t, WS_SWVT) + ((size_t)(vb * 2 + hd) * 64) * SEQ + 64 * sb, (LAS bf16_t*)scr, lane);
                else vt_tile(WSP(bf16_t, WS_VD) + ((size_t)vb * SEQ + 64 * sb) * 128 + 64 * hd, 128, WSP(bf16_t, WS_VDT) + ((size_t)vb * 128 + 64 * hd) * SEQ + 64 * sb, (LAS bf16_t*)scr, lane); }
        }
        fetch_chunk(0); put_chunk(0); fetch_chunk(1);
        SCAN5_BAR();
        for (int cidx = 0; cidx < NCH; ++cidx) {
            if (cidx + 1 < NCH) put_chunk(cidx + 1);
            if (cidx + 2 < NCH) fetch_chunk(cidx + 2);
            if (cidx > 0) flush_y(cidx - 1);
            if (!MOE_CONV_IN_PROLOGUE) {
                const int j6 = cidx / 6, m6 = cidx - 6 * j6;
                if (m6 == 0 && 2 * j6 < PER) { ct = moe_tile_desc(C, cfirst + 1024 * (2 * j6)); conv_tile_load(ct.W, ct.ldw, ct.k0, ct.s0, cv, lane); }
                else if (m6 == 4 && 2 * j6 < PER) conv_tile_finish(cv, ct.Bt, ct.K, ct.n0, ct.k0, scr, lane);
                else if (m6 == 3 && 2 * j6 + 1 < PER) { ct2 = moe_tile_desc(C, cfirst + 1024 * (2 * j6 + 1)); conv_tile_load(ct2.W, ct2.ldw, ct2.k0, ct2.s0, cv2, lane); }
                else if (m6 == 1 && j6 >= 1 && 2 * j6 - 1 < PER) conv_tile_finish(cv2, ct2.Bt, ct2.K, ct2.n0, ct2.k0, scr, lane);
            }
            SCAN5_BAR();
        }
#endif
        flush_y(NCH - 1);
    } else {
        const int ro = lane >> 4, kq = lane & 15, rloc = 4 * wave + ro;
        f32x2 Sa = {0.f, 0.f}, Sb = {0.f, 0.f};
        constexpr bool CONVB = SCAN_SCHED == 4 && CONV == 1 && !MOE_CONV_IN_PROLOGUE;
        f32x4 cvB[16];
#pragma unroll
        for (int i = 0; i < 16; ++i) cvB[i] = (f32x4){0.f, 0.f, 0.f, 0.f};
        LAS float* scrp = (LAS float*)(C.lds + 65536 + wave * 16640);
        const int cfirstc = l * (1024 * MOE_SCAN_TILES) + (blockIdx.x * 4 + wave);
        int bj = 0, bnext = 2 + (int)((blockIdx.x * 4u + (unsigned)wave) & 1u);
        SCAN5_BAR();
        for (int cidx = 0; cidx < NCH; ++cidx) {
            if (CONVB && cidx == bnext) {
                if (bj >= 1) conv_tile_to_lds(cvB, scrp, lane);
                if (bj < MOE_SCAN_TILES / 2) { const MoeTile tb = moe_tile_desc(C, cfirstc + 1024 * (2 * bj + 1)); conv_tile_load(tb.W, tb.ldw, tb.k0, tb.s0, cvB, lane); }
                ++bj; bnext += 6;
            }
            const LAS float* cb = buf + (cidx & 1) * CHF + 4 * kq;
            const LAS float* vb = buf + (cidx & 1) * CHF + 320 + 16 * qr + rloc;
            float ykeep = 0.f;
            f32x4 kk4 = *(const LAS f32x4*)(cb + 192), w4 = *(const LAS f32x4*)(cb + 64), b4 = *(const LAS f32x4*)(cb + 256), k4 = *(const LAS f32x4*)(cb + 128), r4 = *(const LAS f32x4*)(cb);
            float vv = vb[0];
#pragma unroll
            for (int st = 0; st < CH; ++st) {
                f32x4 kk4n = kk4, w4n = w4, b4n = b4, k4n = k4, r4n = r4; float vvn = vv;
                if (st + 1 < CH) { const LAS float* nb = cb + (st + 1) * 384;
                    kk4n = *(const LAS f32x4*)(nb + 192); w4n = *(const LAS f32x4*)(nb + 64); b4n = *(const LAS f32x4*)(nb + 256); k4n = *(const LAS f32x4*)(nb + 128); r4n = *(const LAS f32x4*)(nb); vvn = vb[(st + 1) * 384]; }
                const f32x2 tp = Sa * (f32x2){kk4[0], kk4[1]} + Sb * (f32x2){kk4[2], kk4[3]};
                const float p = row16_sum(tp[0] + tp[1]);
                const f32x2 pp = {p, p}, vv2 = {vv, vv};
                Sa = Sa * (f32x2){w4[0], w4[1]} - pp * (f32x2){b4[0], b4[1]} + vv2 * (f32x2){k4[0], k4[1]};
                Sb = Sb * (f32x2){w4[2], w4[3]} - pp * (f32x2){b4[2], b4[3]} + vv2 * (f32x2){k4[2], k4[3]};
                const f32x2 ty = Sa * (f32x2){r4[0], r4[1]} + Sb * (f32x2){r4[2], r4[3]};
                const float y = row16_sum(ty[0] + ty[1]);
                ykeep = (kq == st) ? y : ykeep;
                kk4 = kk4n; w4 = w4n; b4 = b4n; k4 = k4n; r4 = r4n; vv = vvn;
            }
            ybuf[(cidx & 1) * 256 + kq * 16 + rloc] = ykeep;
            SCAN5_BAR();
        }
        if (CONVB) { SCAN5_BAR(); conv_tile_to_lds(cvB, scrp, lane); SCAN5_BAR(); }
    }
#undef SCAN5_BAR
}
struct Args { const void* in[N_INPUTS]; float* out; unsigned char* ws; int ph_lo, ph_hi; };
static_assert(sizeof(Args) == N_INPUTS * 8 + 24, "Args has no padding");

constexpr int N_PHASES = 2 + 12 + 14;

#ifndef USE_FAST
#define USE_FAST 271
#endif
#ifndef PROBE_CONV
#define PROBE_CONV 3
#endif
#ifndef PROBE_MASK
#define PROBE_MASK 0
#endif
#ifndef DBG_SKIP_MASK
#define DBG_SKIP_MASK 0
#endif

__global__ void __launch_bounds__(NTHR, 2) fwd_kernel(Args args) {
    extern __shared__ __attribute__((aligned(16))) unsigned char lds_raw[];
    LAS unsigned char* const lds = (LAS unsigned char*)lds_raw;
    {
        const int tid0 = threadIdx.x;
        volatile LAS unsigned* MISC0 = (volatile LAS unsigned*)(lds + MISC_OFF);
        for (int u = tid0; u < (LDS_BYTES - MISC_OFF) / 4; u += NTHR) MISC0[u] = 0u;
        __syncthreads();
        LAS unsigned long long* tab = (LAS unsigned long long*)(lds + INTAB_OFF);
        if (tid0 < N_INPUTS) tab[tid0] = (unsigned long long)args.in[tid0];
        if (tid0 == 64) { tab[TAB_WS] = (unsigned long long)args.ws; tab[TAB_OUT] = (unsigned long long)args.out;
            tab[TAB_RANGE] = ((unsigned long long)(unsigned)args.ph_hi << 32) | (unsigned)args.ph_lo; }
        __syncthreads();
        if (args.ph_hi - args.ph_lo > 1) (void)xcd_barrier_post((unsigned*)(args.ws + WS_CTL) + CW_BAR, MISC0 + 8);
    }
    LAS unsigned char* ring = lds;
    int ph = 0;
#define PH_BEGIN { const int lo = (int)__builtin_amdgcn_readfirstlane(((const LAS unsigned*)(lds + INTAB_OFF))[2 * TAB_RANGE]), hi = (int)__builtin_amdgcn_readfirstlane(((const LAS unsigned*)(lds + INTAB_OFF))[2 * TAB_RANGE + 1]); \
    if (ph >= lo && ph < hi) { const Ctx C = make_ctx(lds);
#define PH_END if (ph + 1 < hi) { XcdBarrier bar; bar.bar = (unsigned*)WSP(unsigned, WS_CTL) + CW_BAR; bar.x = xb_xcc_id(); bar.st = (volatile LAS unsigned*)(lds + MISC_OFF) + 8; xcd_barrier(bar); } \
    else { VM_WAIT(); __syncthreads(); } } } ++ph;
#define REP(g, ...) { GLB float* XOUT = C.out; (void)XOUT; __VA_ARGS__ } if (PROBE_MASK & (g)) { GLB float* XOUT = WSP(float, WS_SC); (void)XOUT; __VA_ARGS__ }

    PH_BEGIN REP(1,  ph_prologue(C); ph_norm<0, false>(C, INF32(I_X), nullptr, INF32(I_MIXN), nullptr); ) PH_END
    PH_BEGIN REP(256,  { pg8::Gemm g{WSP(bf16_t, WS_PCAT), WSP(bf16_t, WS_WPP), 512, 256}; pg8::ProjOrder S; S.init(C.G, (int)blockIdx.x); pg8::EpiProj E{WSP(bf16_t, WS_PROJ)};
        pg8::gemm_phase<pg8::EpiProj, pg8::ProjOrder>(ring, g, S, E); } ) PH_END

    { constexpr int l = 0;
        if (l > 0) { PH_BEGIN REP(32768,  ph_norm<0>(C, WSP(bf16_t, WS_XB), nullptr, INF32(I_MIXN) + l * D, nullptr); ) PH_END }
        PH_BEGIN REP(4096,  { pg8::Gemm g{WSP(bf16_t, WS_H), WSP(bf16_t, WS_WIN + l * SZ_WIN1), D, D}; pg8::StaticOrder S; S.init(T, N_INP, C.G, (int)blockIdx.x);
            pg8::EpiWin E{WSP(bf16_t, WS_SBQKV), WSP(bf16_t, WS_UF), WSP(bf16_t, WS_GATE)};
            pg8::gemm_phase<pg8::EpiWin, pg8::StaticOrder>(ring, g, S, E); } ) PH_END
        PH_BEGIN REP(16384,  ph_prep(C, l); ph_vt(C); ph_latent(C, l); ) PH_END
        PH_BEGIN REP(256,  { pg8::Gemm g{WSP(bf16_t, WS_ALORA), WSP(bf16_t, WS_WLORA + l * SZ_WLORA1), 256, 256}; pg8::StaticOrder S; S.init(T, 3072, C.G, (int)blockIdx.x);
            pg8::EpiLora E{WSP(float, WS_DEC), WSP(bf16_t, WS_AA), WSP(bf16_t, WS_GG), INF32(I_RWW0) + l * 1024, INF32(I_RWA0) + l * 1024};
            pg8::gemm_phase<pg8::EpiLora, pg8::StaticOrder>(ring, g, S, E); } ) PH_END
        PH_BEGIN REP(32,  if (!(DBG_SKIP_MASK & 2)) { if (USE_FAST & 256) { ph_rwkv_scan5<1>(C, l); if (PROBE_MASK & 2097152) ph_rwkv_scan5<0>(C, l); if ((PROBE_MASK & 4194304) && l == 0) ph_rwkv_scan5<PROBE_CONV>(C, l); } else if (USE_FAST & 128) ph_rwkv_scan4(C, l); else if (USE_FAST & 64) ph_rwkv_scan3(C, l); else if (USE_FAST & 32) ph_rwkv_scan_conv(C, l); else if (USE_FAST & 2) ph_rwkv_scan_fast(C); else ph_rwkv_scan_naive(C); } ) PH_END
        PH_BEGIN REP(8,  ph_sb_fast(C); ) REP(64,  ph_dsa_fast(C, l); ) REP(128,  ph_swa_fast(C, l); ) REP(65536,  ph_rwkv_post(C, l); ) PH_END
        PH_BEGIN REP(512,  { pg8::Gemm g{WSP(bf16_t, WS_Y), WSP(bf16_t, WS_WBR + l * SZ_WBR1), 4096, 1024}; pg8::BranchOrder S; S.init(C.G, (int)blockIdx.x);
            pg8::EpiBranch E{WSP(bf16_t, WS_GATE), WSP(bf16_t, WS_G)};
            pg8::gemm_phase<pg8::EpiBranch, pg8::BranchOrder>(ring, g, S, E); } ) PH_END
        PH_BEGIN { pg8::Gemm g{WSP(bf16_t, WS_G), WSP(bf16_t, WS_WOUT + l * SZ_DD), D, D}; pg8::StaticOrder S; S.init(T, D, C.G, (int)blockIdx.x);
            if (l == 0) { pg8::EpiResid<false, true> E{INF32(I_X), WSP(bf16_t, WS_XB)}; pg8::gemm_phase<pg8::EpiResid<false, true>, pg8::StaticOrder>(ring, g, S, E); }
            else { pg8::EpiResid<true, true> E{WSP(bf16_t, WS_XB), WSP(bf16_t, WS_XB)}; pg8::gemm_phase<pg8::EpiResid<true, true>, pg8::StaticOrder>(ring, g, S, E); } } PH_END
        PH_BEGIN if (l == 0) ph_norm<0>(C, WSP(bf16_t, WS_XB), nullptr, INF32(I_FFNN) + l * D, nullptr); else ph_norm<1>(C, WSP(bf16_t, WS_XB), nullptr, INF32(I_FFNN) + l * D, INF32(I_MR)); PH_END
        if (l == 0) {
            PH_BEGIN REP(2,  { pg8::Gemm g{WSP(bf16_t, WS_H), WSP(bf16_t, WS_WGU), D, D}; pg8::StaticOrder S; S.init(T, 2 * FF, C.G, (int)blockIdx.x); pg8::EpiUp E{WSP(bf16_t, WS_ACT)};
                pg8::gemm_phase<pg8::EpiUp, pg8::StaticOrder>(ring, g, S, E); } ) PH_END
            PH_BEGIN REP(2048,  { pg8::Gemm g{WSP(bf16_t, WS_ACT), WSP(bf16_t, WS_WD), FF, FF}; pg8::StaticOrder S; S.init(T, D, C.G, (int)blockIdx.x); pg8::EpiResid<true, true> E{WSP(bf16_t, WS_XB), WSP(bf16_t, WS_XB)};
                pg8::gemm_phase<pg8::EpiResid<true, true>, pg8::StaticOrder>(ring, g, S, E); } ) PH_END
            PH_BEGIN REP(32768,  ph_norm<0>(C, WSP(bf16_t, WS_XB), nullptr, INF32(I_PLEN) + l * D, nullptr); ) PH_END
        } else {
            PH_BEGIN REP(131072,  ph_moe_gather(C); ) PH_END
            PH_BEGIN REP(8192,  { moe_tile_table(C); pg8::MoeOrder S; S.tab = (const LAS int*)(C.lds + MOETAB_OFF); S.NT = __builtin_amdgcn_readfirstlane(S.tab[MOE_MAXRT]); S.nct = NCT_UP; S.G = C.G; S.c = (int)blockIdx.x;
                pg8::Gemm g{WSP(bf16_t, WS_HS), WSP(bf16_t, WS_MWGU), D, D}; pg8::EpiUp E{WSP(bf16_t, WS_ACTS)};
                pg8::gemm_phase<pg8::EpiUp, pg8::MoeOrder>(ring, g, S, E); } ) PH_END
            PH_BEGIN REP(2048,  { moe_tile_table(C); const LAS int* mtab = (const LAS int*)(C.lds + MOETAB_OFF);
                pg8::MoeDownOrder S; S.init(mtab, __builtin_amdgcn_readfirstlane(mtab[MOE_MAXRT]), C.G, (int)blockIdx.x);
                pg8::Gemm g{WSP(bf16_t, WS_ACTS), WSP(bf16_t, WS_MWD), FF, FF}; pg8::EpiMoeDown E{WSP(bf16_t, WS_OS), WSP(float, WS_WSLOT), WSP(float, WS_OSP), S.S};
                pg8::gemm_phase<pg8::EpiMoeDown, pg8::MoeDownOrder>(ring, g, S, E); } ) PH_END
            PH_BEGIN REP(16,  { int toff[NE + 1]; moe_offsets(C, toff); pg8::MoeDownOrder S; S.init(nullptr, toff[NE], C.G, 0); ph_norm<2>(C, WSP(bf16_t, WS_XB), WSP(bf16_t, WS_XB), INF32(I_PLEN) + l * D, nullptr, S.S); } ) PH_END
        }
        PH_BEGIN REP(262144,  { pg8::Gemm g{WSP(bf16_t, WS_H), WSP(bf16_t, WS_WPG + l * SZ_DD), D, D}; pg8::StaticOrder S; S.init(T, D, C.G, (int)blockIdx.x);
            if (l == NL - 1) { pg8::EpiPle<false> E{WSP(bf16_t, WS_XB), C.out, WSP(bf16_t, WS_PROJ) + (size_t)l * T * D}; pg8::gemm_phase<pg8::EpiPle<false>, pg8::StaticOrder>(ring, g, S, E); }
            else { pg8::EpiPle<true> E{WSP(bf16_t, WS_XB), WSP(bf16_t, WS_XB), WSP(bf16_t, WS_PROJ) + (size_t)l * T * D}; pg8::gemm_phase<pg8::EpiPle<true>, pg8::StaticOrder>(ring, g, S, E); } } ) PH_END
    }
    { constexpr int l = 1;
        if (l > 0) { PH_BEGIN REP(32768,  ph_norm<0>(C, WSP(bf16_t, WS_XB), nullptr, INF32(I_MIXN) + l * D, nullptr); ) PH_END }
        PH_BEGIN REP(4096,  { pg8::Gemm g{WSP(bf16_t, WS_H), WSP(bf16_t, WS_WIN + l * SZ_WIN1), D, D}; pg8::StaticOrder S; S.init(T, N_INP, C.G, (int)blockIdx.x);
            pg8::EpiWin E{WSP(bf16_t, WS_SBQKV), WSP(bf16_t, WS_UF), WSP(bf16_t, WS_GATE)};
            pg8::gemm_phase<pg8::EpiWin, pg8::StaticOrder>(ring, g, S, E); } ) PH_END
        PH_BEGIN REP(16384,  ph_prep(C, l); ph_vt(C); ph_latent(C, l); ) PH_END
        PH_BEGIN REP(256,  { pg8::Gemm g{WSP(bf16_t, WS_ALORA), WSP(bf16_t, WS_WLORA + l * SZ_WLORA1), 256, 256}; pg8::StaticOrder S; S.init(T, 3072, C.G, (int)blockIdx.x);
            pg8::EpiLora E{WSP(float, WS_DEC), WSP(bf16_t, WS_AA), WSP(bf16_t, WS_GG), INF32(I_RWW0) + l * 1024, INF32(I_RWA0) + l * 1024};
            pg8::gemm_phase<pg8::EpiLora, pg8::StaticOrder>(ring, g, S, E); } ) PH_END
        PH_BEGIN REP(32,  if (!(DBG_SKIP_MASK & 2)) { if (USE_FAST & 256) { ph_rwkv_scan5<1>(C, l); if (PROBE_MASK & 2097152) ph_rwkv_scan5<0>(C, l); if ((PROBE_MASK & 4194304) && l == 0) ph_rwkv_scan5<PROBE_CONV>(C, l); } else if (USE_FAST & 128) ph_rwkv_scan4(C, l); else if (USE_FAST & 64) ph_rwkv_scan3(C, l); else if (USE_FAST & 32) ph_rwkv_scan_conv(C, l); else if (USE_FAST & 2) ph_rwkv_scan_fast(C); else ph_rwkv_scan_naive(C); } ) PH_END
        PH_BEGIN REP(8,  ph_sb_fast(C); ) REP(64,  ph_dsa_fast(C, l); ) REP(128,  ph_swa_fast(C, l); ) REP(65536,  ph_rwkv_post(C, l); ) PH_END
        PH_BEGIN REP(512,  { pg8::Gemm g{WSP(bf16_t, WS_Y), WSP(bf16_t, WS_WBR + l * SZ_WBR1), 4096, 1024}; pg8::BranchOrder S; S.init(C.G, (int)blockIdx.x);
            pg8::EpiBranch E{WSP(bf16_t, WS_GATE), WSP(bf16_t, WS_G)};
            pg8::gemm_phase<pg8::EpiBranch, pg8::BranchOrder>(ring, g, S, E); } ) PH_END
        PH_BEGIN { pg8::Gemm g{WSP(bf16_t, WS_G), WSP(bf16_t, WS_WOUT + l * SZ_DD), D, D}; pg8::StaticOrder S; S.init(T, D, C.G, (int)blockIdx.x);
            if (l == 0) { pg8::EpiResid<false, true> E{INF32(I_X), WSP(bf16_t, WS_XB)}; pg8::gemm_phase<pg8::EpiResid<false, true>, pg8::StaticOrder>(ring, g, S, E); }
            else { pg8::EpiResid<true, true> E{WSP(bf16_t, WS_XB), WSP(bf16_t, WS_XB)}; pg8::gemm_phase<pg8::EpiResid<true, true>, pg8::StaticOrder>(ring, g, S, E); } } PH_END
        PH_BEGIN if (l == 0) ph_norm<0>(C, WSP(bf16_t, WS_XB), nullptr, INF32(I_FFNN) + l * D, nullptr); else ph_norm<1>(C, WSP(bf16_t, WS_XB), nullptr, INF32(I_FFNN) + l * D, INF32(I_MR)); PH_END
        if (l == 0) {
            PH_BEGIN REP(2,  { pg8::Gemm g{WSP(bf16_t, WS_H), WSP(bf16_t, WS_WGU), D, D}; pg8::StaticOrder S; S.init(T, 2 * FF, C.G, (int)blockIdx.x); pg8::EpiUp E{WSP(bf16_t, WS_ACT)};
                pg8::gemm_phase<pg8::EpiUp, pg8::StaticOrder>(ring, g, S, E); } ) PH_END
            PH_BEGIN REP(2048,  { pg8::Gemm g{WSP(bf16_t, WS_ACT), WSP(bf16_t, WS_WD), FF, FF}; pg8::StaticOrder S; S.init(T, D, C.G, (int)blockIdx.x); pg8::EpiResid<true, true> E{WSP(bf16_t, WS_XB), WSP(bf16_t, WS_XB)};
                pg8::gemm_phase<pg8::EpiResid<true, true>, pg8::StaticOrder>(ring, g, S, E); } ) PH_END
            PH_BEGIN REP(32768,  ph_norm<0>(C, WSP(bf16_t, WS_XB), nullptr, INF32(I_PLEN) + l * D, nullptr); ) PH_END
        } else {
            PH_BEGIN REP(131072,  ph_moe_gather(C); ) PH_END
            PH_BEGIN REP(8192,  { moe_tile_table(C); pg8::MoeOrder S; S.tab = (const LAS int*)(C.lds + MOETAB_OFF); S.NT = __builtin_amdgcn_readfirstlane(S.tab[MOE_MAXRT]); S.nct = NCT_UP; S.G = C.G; S.c = (int)blockIdx.x;
                pg8::Gemm g{WSP(bf16_t, WS_HS), WSP(bf16_t, WS_MWGU), D, D}; pg8::EpiUp E{WSP(bf16_t, WS_ACTS)};
                pg8::gemm_phase<pg8::EpiUp, pg8::MoeOrder>(ring, g, S, E); } ) PH_END
            PH_BEGIN REP(2048,  { moe_tile_table(C); const LAS int* mtab = (const LAS int*)(C.lds + MOETAB_OFF);
                pg8::MoeDownOrder S; S.init(mtab, __builtin_amdgcn_readfirstlane(mtab[MOE_MAXRT]), C.G, (int)blockIdx.x);
                pg8::Gemm g{WSP(bf16_t, WS_ACTS), WSP(bf16_t, WS_MWD), FF, FF}; pg8::EpiMoeDown E{WSP(bf16_t, WS_OS), WSP(float, WS_WSLOT), WSP(float, WS_OSP), S.S};
                pg8::gemm_phase<pg8::EpiMoeDown, pg8::MoeDownOrder>(ring, g, S, E); } ) PH_END
            PH_BEGIN REP(16,  { int toff[NE + 1]; moe_offsets(C, toff); pg8::MoeDownOrder S; S.init(nullptr, toff[NE], C.G, 0); ph_norm<2>(C, WSP(bf16_t, WS_XB), WSP(bf16_t, WS_XB), INF32(I_PLEN) + l * D, nullptr, S.S); } ) PH_END
        }
        PH_BEGIN REP(262144,  { pg8::Gemm g{WSP(bf16_t, WS_H), WSP(bf16_t, WS_WPG + l * SZ_DD), D, D}; pg8::StaticOrder S; S.init(T, D, C.G, (int)blockIdx.x);
            if (l == NL - 1) { pg8::EpiPle<false> E{WSP(bf16_t, WS_XB), C.out, WSP(bf16_t, WS_PROJ) + (size_t)l * T * D}; pg8::gemm_phase<pg8::EpiPle<false>, pg8::StaticOrder>(ring, g, S, E); }
            else { pg8::EpiPle<true> E{WSP(bf16_t, WS_XB), WSP(bf16_t, WS_XB), WSP(bf16_t, WS_PROJ) + (size_t)l * T * D}; pg8::gemm_phase<pg8::EpiPle<true>, pg8::StaticOrder>(ring, g, S, E); } } ) PH_END
    }
#undef PH_BEGIN
#undef PH_END
}

#ifndef MK_ONE_LAUNCH
#define MK_ONE_LAUNCH 0
#endif
extern "C" void kernel_launch(void* const* d_in, const int* in_sizes, int n_in, void* d_out, int out_size, void* d_ws, size_t ws_size, hipStream_t stream) {
    static int grid = 0;
    if (grid == 0) {
        if (n_in != N_INPUTS || out_size != T * D || ws_size < WS_END3) { fprintf(stderr, "kernel_launch: unexpected problem (n_in %d, out %d, ws %zu < %zu)\n", n_in, out_size, ws_size, (size_t)WS_END3); grid = -1; return; }
        int dev = 0, cus = 0, per_cu = 0;
        if (hipGetDevice(&dev) != hipSuccess || hipDeviceGetAttribute(&cus, hipDeviceAttributeMultiprocessorCount, dev) != hipSuccess) { grid = -1; return; }
        if (hipFuncSetAttribute((const void*)fwd_kernel, hipFuncAttributeMaxDynamicSharedMemorySize, LDS_BYTES) != hipSuccess) { fprintf(stderr, "kernel_launch: hipFuncSetAttribute failed\n"); grid = -1; return; }
        if (hipOccupancyMaxActiveBlocksPerMultiprocessor(&per_cu, (const void*)fwd_kernel, NTHR, LDS_BYTES) != hipSuccess || per_cu < 1) fprintf(stderr, "kernel_launch: occupancy query reports %d\n", per_cu);
        (void)hipGetLastError();
        grid = cus;
    }
    if (grid < 0) return;
    (void)hipMemsetAsync((char*)d_ws + WS_CTL, 0, CTL_BYTES, stream);
    Args a{};
    for (int i = 0; i < N_INPUTS; ++i) a.in[i] = d_in[i];
    a.out = (float*)d_out; a.ws = (unsigned char*)d_ws;
#if MK_ONE_LAUNCH
    a.ph_lo = 0; a.ph_hi = N_PHASES;
    hipLaunchKernelGGL(fwd_kernel, dim3(grid), dim3(NTHR), LDS_BYTES, stream, a);
#else
    for (int p = 0; p < N_PHASES; ++p) { a.ph_lo = p; a.ph_hi = p + 1; hipLaunchKernelGGL(fwd_kernel, dim3(grid), dim3(NTHR), LDS_BYTES, stream, a); }
#endif
}
```

```cpp
#define MK_ONE_LAUNCH 1
#include <hip/hip_runtime.h>
#include <cstdio>
#include <cstdint>

#define LAS __attribute__((address_space(3)))
#define GAS __attribute__((address_space(1)))
#define GLB __attribute__((address_space(1)))
typedef unsigned short bf16_t;
typedef short bf16x8 __attribute__((ext_vector_type(8)));
typedef float f32x4 __attribute__((ext_vector_type(4)));
typedef float f32x2 __attribute__((ext_vector_type(2)));
typedef unsigned u32x4 __attribute__((ext_vector_type(4)));
typedef unsigned u32x2 __attribute__((ext_vector_type(2)));

constexpr int NB = 4, SEQ = 2048, T = NB * SEQ, D = 2048, NL = 2;
constexpr int N_IN = 18256, N_INP = 18432, FF = 7168, NE = 8;
constexpr int UFW = 7168;
constexpr int UF_RW = 0, UF_DQ = 3328, UF_CKV = 4352, UF_IQ = 4608, UF_SQ = 5632, UF_SK = 6656, UF_SV = 6784, UF_IK = 6912, UF_IW = 6976;
constexpr int MOE_ROWS = 18432, MOE_MAXRT = 72, NCT_UP = 56, NCT_DN = 8;
constexpr int NWAVES = 8, NTHR = 512;

constexpr size_t WS_CTL = 0, CTL_BYTES = 1u << 20;
constexpr size_t SZ_WIN1 = (size_t)N_INP * D * 2, SZ_WBR1 = (size_t)4 * 2048 * 1024 * 2, SZ_DD = (size_t)D * D * 2;
constexpr size_t SZ_WGU1 = (size_t)2 * FF * D * 2, SZ_WD1 = (size_t)D * FF * 2, SZ_WLORA1 = (size_t)3072 * 256 * 2;
constexpr size_t WS_WIN = CTL_BYTES;
constexpr size_t WS_WBR = WS_WIN + NL * SZ_WIN1;
constexpr size_t WS_WOUT = WS_WBR + NL * SZ_WBR1;
constexpr size_t WS_WGU = WS_WOUT + NL * SZ_DD;
constexpr size_t WS_WD = WS_WGU + SZ_WGU1;
constexpr size_t WS_MWGU = WS_WD + SZ_WD1;
constexpr size_t WS_MWD = WS_MWGU + NE * SZ_WGU1;
constexpr size_t WS_WPG = WS_MWD + NE * SZ_WD1;
constexpr size_t WS_WPP = WS_WPG + NL * SZ_DD;
constexpr size_t WS_WLORA = WS_WPP + (size_t)NL * D * 256 * 2;
constexpr size_t WS_H = WS_WLORA + NL * SZ_WLORA1;
constexpr size_t WS_PCAT = WS_H + (size_t)T * D * 2;
constexpr size_t WS_PROJ = WS_PCAT + (size_t)T * 512 * 2;
constexpr size_t WS_ROUTE = WS_PROJ + (size_t)NL * T * D * 2;
constexpr size_t WS_TOKSLOT = WS_ROUTE + (size_t)T * 32;
constexpr size_t WS_WSLOT = WS_TOKSLOT + (size_t)T * 8;
constexpr size_t WS_ACT0 = WS_WSLOT + (size_t)MOE_ROWS * 4 + 256 * 30;
constexpr size_t SZ_T1K = (size_t)T * 1024 * 4;
constexpr size_t WS_SBQKV = (WS_ACT0 + 255) & ~(size_t)255;
constexpr size_t WS_GATE = WS_SBQKV + (size_t)T * 3072 * 2;
constexpr size_t WS_UF = WS_GATE + (size_t)T * 8192 * 2;
constexpr size_t WS_Y = WS_UF;
constexpr size_t WS_GSUM = WS_Y + (size_t)T * 4096 * 2;
constexpr size_t WS_G = WS_GSUM + (size_t)T * 2048 * 4;
constexpr size_t WS_YRAW = WS_G + (size_t)T * 2048 * 2;
constexpr size_t WS_RW = WS_UF + (size_t)T * UFW * 4;
static_assert(WS_YRAW + SZ_T1K <= WS_RW, "UF aliases");
constexpr size_t WS_R = WS_RW, WS_K = WS_RW + SZ_T1K, WS_V = WS_RW + 2 * SZ_T1K, WS_DEC = WS_RW + 3 * SZ_T1K, WS_AA = WS_RW + 4 * SZ_T1K, WS_KK = WS_RW + 5 * SZ_T1K, WS_GG = WS_RW + 6 * SZ_T1K;
constexpr size_t WS_ALORA = WS_RW + 7 * SZ_T1K;
constexpr size_t WS_QD = WS_ALORA + (size_t)T * 256 * 2;
constexpr size_t WS_KD = WS_QD + (size_t)T * 1024 * 2;
constexpr size_t WS_VD = WS_KD + (size_t)T * 128 * 2;
constexpr size_t WS_QI = WS_VD + (size_t)T * 128 * 2;
constexpr size_t WS_KI = WS_QI + (size_t)T * 1024 * 2;
constexpr size_t WS_WI = WS_KI + (size_t)T * 64 * 2;
constexpr size_t WS_QS = WS_WI + (size_t)T * 16 * 4;
constexpr size_t WS_KS = WS_QS + (size_t)T * 1024 * 2;
constexpr size_t WS_VS = WS_KS + (size_t)T * 128 * 2;
constexpr size_t WS_MIX_END = WS_VS + (size_t)T * 128 * 2;
constexpr size_t WS_ACT = WS_SBQKV;
constexpr size_t WS_HS = WS_SBQKV;
constexpr size_t WS_ACTS = WS_HS + (size_t)MOE_ROWS * D * 2;
constexpr size_t WS_OS = WS_ACTS + (size_t)MOE_ROWS * FF * 2;
constexpr size_t WS_OSP = WS_OS + (size_t)MOE_ROWS * D * 4;
constexpr size_t WS_FFN_END = WS_OSP + (size_t)256 * 65536 * 4;
constexpr size_t WS_END = WS_MIX_END > WS_FFN_END ? WS_MIX_END : WS_FFN_END;
static_assert(WS_END < (size_t)2000 * 1000 * 1000, "workspace budget");

constexpr int CW_BAR = 4096;
constexpr int CW_MOECNT = 8192;

constexpr int RING_BYTES = 131072;
constexpr int MISC_OFF = 143360;
constexpr int LDS_BYTES = 147456;

#define LDS_WAIT() asm volatile("s_waitcnt lgkmcnt(0)" ::: "memory")
#define VM_WAIT() asm volatile("s_waitcnt vmcnt(0)" ::: "memory")
__device__ __forceinline__ float bflo(unsigned u) { return __builtin_bit_cast(float, u << 16); }
__device__ __forceinline__ float bfhi(unsigned u) { return __builtin_bit_cast(float, u & 0xffff0000u); }
__device__ __forceinline__ float bf1(bf16_t u) { return __builtin_bit_cast(float, (unsigned)u << 16); }
__device__ __forceinline__ unsigned f2bf(float f) { unsigned u = __builtin_bit_cast(unsigned, f); return (u + 0x7fffu + ((u >> 16) & 1u)) >> 16; }
typedef __bf16 bf16x2v __attribute__((ext_vector_type(2)));
__device__ __forceinline__ unsigned pk2(float lo, float hi) { const f32x2 v = {lo, hi}; return __builtin_bit_cast(unsigned, __builtin_convertvector(v, bf16x2v)); }
__device__ __forceinline__ float wave_sum(float v) {
#pragma unroll
    for (int o = 1; o < 64; o <<= 1) v += __shfl_xor(v, o);
    return v;
}
__device__ __forceinline__ float wave_max(float v) {
#pragma unroll
    for (int o = 1; o < 64; o <<= 1) v = fmaxf(v, __shfl_xor(v, o));
    return v;
}
__device__ __forceinline__ float sigmoidf_(float x) { return __builtin_amdgcn_rcpf(1.0f + __builtin_amdgcn_exp2f(-1.4426950408889634f * x)); }
__device__ __forceinline__ float logsigf_(float x) { return fminf(x, 0.f) - __logf(1.0f + __expf(-fabsf(x))); }
__device__ __forceinline__ float rdlane(float v, int l) { return __builtin_bit_cast(float, __builtin_amdgcn_readlane(__builtin_bit_cast(int, v), l)); }

#define XB_TMO      128
#define XB_XCNT(j)  (256  + 64 * (j))
#define XB_XSUB(j)  (1280 + 64 * (j))
#define XB_XGEN(j)  (2304 + 64 * (j))
#define XB_TOP      3328
#define XB_TOPGEN   3392
#define XCD_BAR_WORDS 3456
#define XB_SPIN_CAP (1u << 18)
__device__ __forceinline__ unsigned xb_ld(unsigned* p)              { return __hip_atomic_load(p, __ATOMIC_RELAXED, __HIP_MEMORY_SCOPE_AGENT); }
__device__ __forceinline__ unsigned xb_add(unsigned* p, unsigned v) { return __hip_atomic_fetch_add(p, v, __ATOMIC_RELAXED, __HIP_MEMORY_SCOPE_AGENT); }
__device__ __forceinline__ unsigned xb_xcc_id() { return (unsigned)__builtin_amdgcn_s_getreg((3 << 11) | 20) & 0xFu; }
#define XB_SPIN(cond, bar) do { unsigned _sp = 0; while (cond) { __builtin_amdgcn_s_sleep(1); \
    if ((++_sp & 255u) == 0u) { if (xb_ld(&(bar)[XB_TMO])) break; if (_sp > XB_SPIN_CAP) { atomicAdd(&(bar)[XB_TMO], 1u); break; } } } } while (0)
struct XcdBarrier { unsigned* bar; unsigned x; volatile LAS unsigned* st; };
__device__ __forceinline__ XcdBarrier xcd_barrier_post(unsigned* bar, volatile LAS unsigned* st) {
    XcdBarrier b; b.bar = bar; b.x = xb_xcc_id(); b.st = st;
    if (threadIdx.x == 0) (void)xb_add(&bar[XB_XCNT(b.x)], 1u);
    return b;
}
__device__ __forceinline__ void xcd_barrier_complete(unsigned* bar, unsigned x, unsigned& nloc, unsigned& nx) {
    const unsigned G = gridDim.x * gridDim.y * gridDim.z;
    unsigned sum, cnt, mine, sp = 0u;
    for (;;) {
        sum = 0u; cnt = 0u; mine = 0u;
#pragma unroll
        for (unsigned j = 0; j < 16; ++j) { const unsigned c = xb_ld(&bar[XB_XCNT(j)]); sum += c; cnt += (c > 0u) ? 1u : 0u; mine = (j == x) ? c : mine; }
        if (sum == G) break;
        __builtin_amdgcn_s_sleep(1);
        if ((++sp & 255u) == 0u) { if (xb_ld(&bar[XB_TMO])) break; if (sp > XB_SPIN_CAP) { atomicAdd(&bar[XB_TMO], 1u); break; } }
    }
    nloc = mine > 0u ? mine : 1u; nx = cnt > 0u ? cnt : 1u;
}
__device__ __forceinline__ void xcd_barrier(const XcdBarrier& b) {
    asm volatile("s_waitcnt vmcnt(0)" ::: "memory");
    __syncthreads();
    if (threadIdx.x == 0) {
        unsigned* bar = b.bar;
        __builtin_amdgcn_s_waitcnt(0);
        unsigned nloc = b.st[0], nx = b.st[1];
        if (nloc == 0u) { xcd_barrier_complete(bar, b.x, nloc, nx); b.st[0] = nloc; b.st[1] = nx; }
        const unsigned old = xb_add(&bar[XB_XSUB(b.x)], 1u);
        const unsigned gen = old / nloc;
        if (old + 1u == (gen + 1u) * nloc) {
            __builtin_amdgcn_fence(__ATOMIC_RELEASE, "agent");
            asm volatile("s_waitcnt vmcnt(0)" ::: "memory");
            const unsigned og = xb_add(&bar[XB_TOP], 1u);
            const unsigned tg = og / nx;
            if (og + 1u == (tg + 1u) * nx) xb_add(&bar[XB_TOPGEN], 1u);
            else XB_SPIN(xb_ld(&bar[XB_TOPGEN]) == tg, bar);
            __builtin_amdgcn_fence(__ATOMIC_ACQUIRE, "agent");
            xb_add(&bar[XB_XGEN(b.x)], 1u);
            asm volatile("s_waitcnt vmcnt(0)" ::: "memory");
        } else {
            XB_SPIN(xb_ld(&bar[XB_XGEN(b.x)]) == gen, bar);
            __builtin_amdgcn_fence(__ATOMIC_ACQUIRE, "agent");
            asm volatile("s_waitcnt vmcnt(0)" ::: "memory");
        }
    }
    __syncthreads();
}
namespace pg8 {
#define PG8_LAS __attribute__((address_space(3)))
#ifndef PG8_WGM
#define PG8_WGM 4
#endif
constexpr int BM = 256, BK = 64, HALF = 128, HTB = HALF * BK * 2, STAGE_BYTES = 8 * HTB, NXCD = 8, WGM = PG8_WGM;
__host__ __device__ __forceinline__ int lds_byte(int r, int c) { const int st = (r >> 4) * 2 + (c >> 5), rr = r & 15, cc = c & 31, ob = rr * 64 + cc * 2; return st * 1024 + (ob ^ (((ob >> 9) & 1) << 5)); }
__host__ __device__ __forceinline__ void stage_rc(int b, int& R, int& C) { const int st = b / 1024, sb = b % 1024, swz = sb ^ (((sb >> 9) & 1) << 5); R = (st >> 1) * 16 + swz / 64; C = (st & 1) * 32 + (swz % 64) / 2; }
__host__ __device__ __forceinline__ int perm32(int rho) { const int n = rho >> 4, i = rho & 15; return 8 * (i >> 2) + 4 * n + (i & 3); }

struct Unit { int pm, pn, ka, kb, nt, aux; };
struct Gemm { const GLB bf16_t* A; const GLB bf16_t* Bt; int lda, K; };

struct StaticOrder {
    int nM, nN, nwg, G, c;
    __device__ __forceinline__ void init(int M, int N, int G_, int c_) { nM = M / BM; nN = N / BM; nwg = nM * nN; G = G_; c = c_; }
    __device__ __forceinline__ bool tile(long L, Unit& u) const {
        if (L >= nwg) return false;
        int wgid = (int)L; { const int q = nwg / NXCD, r = nwg % NXCD, xcd = wgid % NXCD, off = wgid / NXCD; wgid = (xcd < r ? xcd * (q + 1) : r * (q + 1) + (xcd - r) * q) + off; }
        const int nig = WGM * nN, gid = wgid / nig, fm = gid * WGM, gsz = (nM - fm) < WGM ? (nM - fm) : WGM;
        u.pm = fm + ((wgid % nig) % gsz); u.pn = (wgid % nig) / gsz; u.ka = 0; u.kb = 0; u.nt = 0; u.aux = 0; return true;
    }
    __device__ __forceinline__ bool next(int i, Unit& u) const { return tile((long)i * G + c, u); }
};
struct BranchOrder {
    int G, c, cnt;
    __device__ __forceinline__ void init(int G_, int c_) { G = G_; c = c_; cnt = (c_ < 256) ? (255 - c_) / G_ + 1 : 0; }
    __device__ __forceinline__ bool next(int i, Unit& u) const {
        if (cnt == 0) return false;
        const int n = i / cnt, r = i - n * cnt; if (n >= 4) return false;
        StaticOrder so; so.init(T, 2048, G, c); so.tile((long)r * G + c, u);
        u.pn += n * 8; u.ka = n * 1024; return true;
    }
};
struct ProjOrder {
    StaticOrder so;
    __device__ __forceinline__ void init(int G_, int c_) { so.init(T, 4096, G_, c_); }
    __device__ __forceinline__ bool next(int i, Unit& u) const { if (!so.next(i, u)) return false; u.ka = (u.pn >> 3) * 256; return true; }
};
struct MoeOrder {
    const PG8_LAS int* tab; int NT, nct, G, c;
    __device__ __forceinline__ bool next(int i, Unit& u) const {
        StaticOrder so; so.nM = NT; so.nN = nct; so.nwg = NT * nct; so.G = G; so.c = c;
        if (!so.tile((long)i * G + c, u)) return false;
        const int e = __builtin_amdgcn_readfirstlane(tab[u.pm]);
        u.pn += e * nct; u.ka = 0; return true;
    }
};

struct MoeDownOrder {
    const PG8_LAS int* tab; int NT, G, c, S;
    __device__ __forceinline__ void init(const PG8_LAS int* tab_, int NT_, int G_, int c_) { tab = tab_; NT = NT_; G = G_; c = c_;
        const int tu = (NT_ - 64) * 8; S = (tu <= 0) ? 1 : ((tu * 8 <= G_) ? 8 : ((tu * 4 <= G_) ? 4 : ((tu * 2 <= G_) ? 2 : 1))); }
    __device__ __forceinline__ bool next(int i, Unit& u) const {
        const int F = (NT < 64) ? NT : 64, nfull = F * 8, rf = (nfull + G - 1) / G;
        if (i < rf) {
            StaticOrder so; so.nM = F; so.nN = 8; so.nwg = nfull; so.G = G; so.c = c;
            if (so.tile((long)i * G + c, u)) { const int e = __builtin_amdgcn_readfirstlane(tab[u.pm]); u.pn += e * 8; return true; }
            i = rf;
        }
        const int q = (i - rf) * G + c, ntail = (NT - F) * 8 * S;
        if (q >= ntail) return false;
        const int tu = q / S, sl = q - tu * S, rt = F + (tu >> 3), pl = tu & 7;
        const int e = __builtin_amdgcn_readfirstlane(tab[rt]);
        u.pm = rt; u.pn = e * 8 + pl; u.ka = sl * (FF / S); u.kb = u.ka; u.nt = (FF / 64) / S; u.aux = 1 + sl; return true;
    }
};

template <class Epi, class Sched>
__device__ __forceinline__ void gemm_phase(PG8_LAS unsigned char* lds, const Gemm g, const Sched& S, const Epi& E) {
    int tid = threadIdx.x; asm volatile("" : "+v"(tid));
    const int wid = __builtin_amdgcn_readfirstlane(tid >> 6), lane = tid & 63, wr = wid >> 2, wc = wid & 3, fr = lane & 15, fq = lane >> 4;
    int K = g.K, lda = g.lda; asm volatile("" : "+s"(K), "+s"(lda));
    const int nt = K / BK;
    unsigned voffA[2], voffB[2];
#pragma unroll
    for (int i = 0; i < 2; ++i) { int R, C; stage_rc(tid * 16 + i * 8192, R, C); const int Rb = Epi::PERM ? ((R & ~31) + perm32(R & 31)) : R;
        voffA[i] = (unsigned)(R * lda + C) * 2u; voffB[i] = (unsigned)(Rb * K + C) * 2u; }
    const size_t kstep = (size_t)(BK * 2);
    const size_t hstepA = (size_t)HALF * lda * 2, hstepB = (size_t)HALF * K * 2;
    const size_t tstepA = 2 * hstepA, tstepB = 2 * hstepB;
    const unsigned ldsw = (unsigned)wid * 1024u;
    const int aoff = lds_byte(wr * 64 + fr, fq * 8), boff = lds_byte(wc * 32 + fr, fq * 8);
#define PG8_SA(b, h) (((b) * 2 + (h)) * HTB)
#define PG8_SB(b, h) ((4 + (b) * 2 + (h)) * HTB)
#define PG8_STAGE(bufoff, gbase, voff) do { _Pragma("unroll") for (int _i = 0; _i < 2; ++_i) \
        __builtin_amdgcn_global_load_lds((const GLB unsigned*)((const char*)(gbase) + (voff)[_i]), (PG8_LAS unsigned*)(lds + (bufoff) + ldsw + _i * 8192), 16, 0, 0); } while (0)
#define PG8_LDA(dst, b, h) do { _Pragma("unroll") for (int m = 0; m < 4; ++m) _Pragma("unroll") for (int k = 0; k < 2; ++k) dst[m][k] = *(const PG8_LAS bf16x8*)(lds + PG8_SA(b, h) + aoff + m * 2048 + k * 1024); } while (0)
#define PG8_LDB(dst, b, h) do { _Pragma("unroll") for (int n = 0; n < 2; ++n) _Pragma("unroll") for (int k = 0; k < 2; ++k) dst[n][k] = *(const PG8_LAS bf16x8*)(lds + PG8_SB(b, h) + boff + n * 2048 + k * 1024); } while (0)
#define PG8_MMA(ai, bj, At, Bt) do { __builtin_amdgcn_s_setprio(1); _Pragma("unroll") for (int m = 0; m < 4; ++m) _Pragma("unroll") for (int n = 0; n < 2; ++n) _Pragma("unroll") for (int k = 0; k < 2; ++k) \
        acc[ai][bj][m][n] = __builtin_amdgcn_mfma_f32_16x16x32_bf16(Bt[n][k], At[m][k], acc[ai][bj][m][n], 0, 0, 0); __builtin_amdgcn_s_setprio(0); } while (0)
#define PG8_WAIT_V(n) asm volatile("s_waitcnt vmcnt(" #n ")" ::: "memory")
#define PG8_WAIT_L(n) asm volatile("s_waitcnt lgkmcnt(" #n ")" ::: "memory")
#define PG8_BAR __builtin_amdgcn_s_barrier()
#define PG8_SCHED __builtin_amdgcn_sched_barrier(0)
    Unit cur, nxt; int ui = 0;
    if (!S.next(0, cur)) return;
    f32x4 acc[2][2][4][2];
#pragma unroll
    for (int a = 0; a < 2; ++a)
#pragma unroll
        for (int b = 0; b < 2; ++b)
#pragma unroll
            for (int m = 0; m < 4; ++m)
#pragma unroll
                for (int n = 0; n < 2; ++n) acc[a][b][m][n] = (f32x4){0.f, 0.f, 0.f, 0.f};
    bf16x8 At[4][2], B0[2][2], B1[2][2];
    const char* cA = (const char*)g.A + (size_t)cur.pm * tstepA + (size_t)cur.ka * 2; const char* cB = (const char*)g.Bt + (size_t)cur.pn * tstepB + (size_t)cur.kb * 2;
    PG8_STAGE(PG8_SB(0, 0), cB, voffB); PG8_STAGE(PG8_SB(0, 1), cB + hstepB, voffB); PG8_STAGE(PG8_SA(0, 0), cA, voffA); PG8_STAGE(PG8_SA(0, 1), cA + hstepA, voffA);
    if (wr == 1) PG8_BAR;
    PG8_WAIT_V(2); PG8_BAR;
    PG8_STAGE(PG8_SB(1, 0), cB + kstep, voffB); PG8_STAGE(PG8_SA(1, 0), cA + kstep, voffA); PG8_STAGE(PG8_SB(1, 1), cB + hstepB + kstep, voffB);
    PG8_WAIT_V(6); PG8_BAR;
    for (;;) {
        const bool has_next = S.next(ui + 1, nxt);
        const char* nA = has_next ? (const char*)g.A + (size_t)nxt.pm * tstepA + (size_t)nxt.ka * 2 : cA; const char* nB = has_next ? (const char*)g.Bt + (size_t)nxt.pn * tstepB + (size_t)nxt.kb * 2 : cB;
        const int ntu = cur.nt ? cur.nt : nt;
        for (int t = 0; t < ntu; t += 2) {
            const bool last = (t == ntu - 2);
            const char* a1 = cA + (size_t)(t + 1) * kstep;
            const char* a2 = last ? nA : cA + (size_t)(t + 2) * kstep; const char* b2 = last ? nB : cB + (size_t)(t + 2) * kstep;
            const char* a3 = a2 + kstep; const char* b3 = b2 + kstep;
            PG8_LDB(B0, 0, 0); PG8_LDB(B1, 0, 1); PG8_SCHED; PG8_LDA(At, 0, 0); PG8_STAGE(PG8_SA(1, 1), a1 + hstepA, voffA);
            PG8_WAIT_V(8); PG8_WAIT_L(0); PG8_BAR; PG8_MMA(0, 0, At, B0); PG8_MMA(0, 1, At, B1); PG8_BAR; PG8_SCHED;
            PG8_LDA(At, 0, 1); PG8_STAGE(PG8_SB(0, 0), b2, voffB); PG8_STAGE(PG8_SB(0, 1), b2 + hstepB, voffB); PG8_STAGE(PG8_SA(0, 0), a2, voffA);
            PG8_WAIT_V(8); PG8_WAIT_L(0); PG8_BAR; PG8_MMA(1, 0, At, B0); PG8_MMA(1, 1, At, B1); PG8_BAR; PG8_SCHED;
            PG8_LDB(B0, 1, 0); PG8_LDB(B1, 1, 1); PG8_SCHED; PG8_LDA(At, 1, 0); PG8_STAGE(PG8_SA(0, 1), a2 + hstepA, voffA);
            PG8_WAIT_V(8); PG8_WAIT_L(0); PG8_BAR; PG8_MMA(0, 0, At, B0); PG8_MMA(0, 1, At, B1); PG8_BAR; PG8_SCHED;
            PG8_LDA(At, 1, 1); PG8_STAGE(PG8_SB(1, 0), b3, voffB); PG8_STAGE(PG8_SB(1, 1), b3 + hstepB, voffB); PG8_STAGE(PG8_SA(1, 0), a3, voffA);
            PG8_WAIT_V(8); PG8_WAIT_L(0); PG8_BAR; PG8_MMA(1, 0, At, B0); PG8_MMA(1, 1, At, B1); PG8_BAR; PG8_SCHED;
        }
        if (wr == 0) PG8_BAR;
        E(acc, cur, wr, wc, fr, fq);
        if (!has_next) break;
#pragma unroll
        for (int a = 0; a < 2; ++a)
#pragma unroll
            for (int b = 0; b < 2; ++b)
#pragma unroll
                for (int m = 0; m < 4; ++m)
#pragma unroll
                    for (int n = 0; n < 2; ++n) acc[a][b][m][n] = (f32x4){0.f, 0.f, 0.f, 0.f};
        cur = nxt; cA = nA; cB = nB; ++ui;
        if (wr == 1) PG8_BAR;
    }
    PG8_WAIT_V(0);
    PG8_BAR;
#undef PG8_SA
#undef PG8_SB
#undef PG8_STAGE
#undef PG8_LDA
#undef PG8_LDB
#undef PG8_MMA
#undef PG8_WAIT_V
#undef PG8_WAIT_L
#undef PG8_BAR
#undef PG8_SCHED
}

#define EPI_ROWS(u) const int row0 = (u).pm * BM + wr * 64 + fr; const int ct0 = wc * 32 + 8 * fq
#define EPI_FOR_ROWS _Pragma("unroll") for (int ai = 0; ai < 2; ++ai) _Pragma("unroll") for (int m = 0; m < 4; ++m)
__device__ __forceinline__ u32x4 pack8(f32x4 v0, f32x4 v1) { u32x4 w; w.x = pk2(v0[0], v0[1]); w.y = pk2(v0[2], v0[3]); w.z = pk2(v1[0], v1[1]); w.w = pk2(v1[2], v1[3]); return w; }
__device__ __forceinline__ void unpack8(u32x4 w, f32x4& v0, f32x4& v1) { v0 = (f32x4){bflo(w.x), bfhi(w.x), bflo(w.y), bfhi(w.y)}; v1 = (f32x4){bflo(w.z), bfhi(w.z), bflo(w.w), bfhi(w.w)}; }
__device__ __forceinline__ f32x4 sig4(f32x4 v) { return (f32x4){sigmoidf_(v[0]), sigmoidf_(v[1]), sigmoidf_(v[2]), sigmoidf_(v[3])}; }

struct EpiWin { static constexpr bool PERM = true;
    GLB bf16_t* sbqkv; GLB bf16_t* uf; GLB bf16_t* gate;
    __device__ __forceinline__ void operator()(const f32x4 (&acc)[2][2][4][2], const Unit& u, int wr, int wc, int fr, int fq) const {
        EPI_ROWS(u); const int pn = u.pn;
        if (pn < 40) {
            GLB bf16_t* base = (pn < 12) ? sbqkv + pn * 256 : uf + (pn - 12) * 256; const int ld = (pn < 12) ? 3072 : UFW;
            EPI_FOR_ROWS { GLB bf16_t* rp = base + (size_t)(row0 + ai * HALF + m * 16) * ld + ct0;
#pragma unroll
                for (int bj = 0; bj < 2; ++bj) *(GLB u32x4*)(rp + bj * HALF) = pack8(acc[ai][bj][m][0], acc[ai][bj][m][1]); }
        } else {
            EPI_FOR_ROWS { GLB bf16_t* rp = gate + (size_t)(row0 + ai * HALF + m * 16) * 8192 + (pn - 40) * 256 + ct0;
#pragma unroll
                for (int bj = 0; bj < 2; ++bj) *(GLB u32x4*)(rp + bj * HALF) = pack8(sig4(acc[ai][bj][m][0]), sig4(acc[ai][bj][m][1])); }
        }
    }
};
struct EpiNull { static constexpr bool PERM = true;
    __device__ __forceinline__ void operator()(const f32x4 (&acc)[2][2][4][2], const Unit& u, int wr, int wc, int fr, int fq) const {
#pragma unroll
        for (int ai = 0; ai < 2; ++ai)
#pragma unroll
            for (int bj = 0; bj < 2; ++bj) asm volatile("" :: "v"(acc[ai][bj][0][0]), "v"(acc[ai][bj][0][1]), "v"(acc[ai][bj][1][0]), "v"(acc[ai][bj][1][1]), "v"(acc[ai][bj][2][0]), "v"(acc[ai][bj][2][1]), "v"(acc[ai][bj][3][0]), "v"(acc[ai][bj][3][1]));
    }
};
struct EpiLora { static constexpr bool PERM = true;
    GLB float* dec; GLB bf16_t* aa; GLB bf16_t* gg; const GLB float* w0; const GLB float* a0;
    __device__ __forceinline__ void operator()(const f32x4 (&acc)[2][2][4][2], const Unit& u, int wr, int wc, int fr, int fq) const {
        EPI_ROWS(u); const int kind = u.pn >> 2, cb = (u.pn & 3) * 256 + ct0;
        EPI_FOR_ROWS { const size_t ro = (size_t)(row0 + ai * HALF + m * 16) * 1024 + cb;
#pragma unroll
            for (int bj = 0; bj < 2; ++bj) { const int co = bj * HALF;
                if (kind == 0) {
#pragma unroll
                    for (int n = 0; n < 2; ++n) { const f32x4 v = acc[ai][bj][m][n]; const f32x4 b = *(const GLB f32x4*)(w0 + cb + co + 4 * n); f32x4 o;
#pragma unroll
                        for (int j = 0; j < 4; ++j) { const float pre = v[j] + b[j]; const float y = -pre; const float sp = fmaxf(y, 0.f) + __logf(1.0f + __expf(-fabsf(y)));
                            o[j] = __expf(-__expf(-sp - 0.5f)); }
                        *(GLB f32x4*)(dec + ro + co + 4 * n) = o; }
                } else if (kind == 1) { const f32x4 b0 = *(const GLB f32x4*)(a0 + cb + co), b1 = *(const GLB f32x4*)(a0 + cb + co + 4);
                    *(GLB u32x4*)(aa + ro + co) = pack8(sig4(acc[ai][bj][m][0] + b0), sig4(acc[ai][bj][m][1] + b1)); }
                else *(GLB u32x4*)(gg + ro + co) = pack8(acc[ai][bj][m][0], acc[ai][bj][m][1]); } }
    }
};
struct EpiBranch { static constexpr bool PERM = true;
    const GLB bf16_t* gate; GLB bf16_t* gout;
    __device__ __forceinline__ void operator()(const f32x4 (&acc)[2][2][4][2], const Unit& u, int wr, int wc, int fr, int fq) const {
        EPI_ROWS(u); const int n = u.pn >> 3, cb = (u.pn & 7) * 256 + ct0;
        EPI_FOR_ROWS { const size_t r = (size_t)(row0 + ai * HALF + m * 16);
#pragma unroll
            for (int bj = 0; bj < 2; ++bj) { const int c = cb + bj * HALF; f32x4 g0, g1; unpack8(*(const GLB u32x4*)(gate + r * 8192 + n * 2048 + c), g0, g1);
                f32x4 s0 = g0 * acc[ai][bj][m][0], s1 = g1 * acc[ai][bj][m][1];
                GLB u32x4* gp = (GLB u32x4*)(gout + r * 2048 + c);
                if (n > 0) { f32x4 p0, p1; unpack8(*gp, p0, p1); s0 += p0; s1 += p1; }
                *gp = pack8(s0, s1); } }
    }
};
template <bool RB, bool OB>
struct EpiResid { static constexpr bool PERM = true;
    const GLB void* resid; GLB void* out;
    __device__ __forceinline__ void operator()(const f32x4 (&acc)[2][2][4][2], const Unit& u, int wr, int wc, int fr, int fq) const {
        EPI_ROWS(u); const int cb = u.pn * 256 + ct0;
        EPI_FOR_ROWS { const size_t ro = (size_t)(row0 + ai * HALF + m * 16) * D + cb;
#pragma unroll
            for (int bj = 0; bj < 2; ++bj) { f32x4 r0, r1;
                if (RB) unpack8(*(const GLB u32x4*)((const GLB bf16_t*)resid + ro + bj * HALF), r0, r1);
                else { r0 = *(const GLB f32x4*)((const GLB float*)resid + ro + bj * HALF); r1 = *(const GLB f32x4*)((const GLB float*)resid + ro + bj * HALF + 4); }
                r0 = r0 + acc[ai][bj][m][0]; r1 = r1 + acc[ai][bj][m][1];
                if (OB) *(GLB u32x4*)((GLB bf16_t*)out + ro + bj * HALF) = pack8(r0, r1);
                else { *(GLB f32x4*)((GLB float*)out + ro + bj * HALF) = r0; *(GLB f32x4*)((GLB float*)out + ro + bj * HALF + 4) = r1; } } }
    }
};
struct EpiUp { static constexpr bool PERM = true;
    GLB bf16_t* act;
    __device__ __forceinline__ void operator()(const f32x4 (&acc)[2][2][4][2], const Unit& u, int wr, int wc, int fr, int fq) const {
        EPI_ROWS(u); const int cb = (u.pn % NCT_UP) * 128 + ct0;
        EPI_FOR_ROWS { f32x4 o[2];
#pragma unroll
            for (int n = 0; n < 2; ++n) { const f32x4 g = acc[ai][0][m][n], up = acc[ai][1][m][n];
#pragma unroll
                for (int j = 0; j < 4; ++j) o[n][j] = g[j] * sigmoidf_(g[j]) * up[j]; }
            *(GLB u32x4*)(act + (size_t)(row0 + ai * HALF + m * 16) * FF + cb) = pack8(o[0], o[1]); }
    }
};
struct EpiMoeDown { static constexpr bool PERM = true;
    GLB bf16_t* os; const GLB float* wslot; GLB float* osp; int S;
    __device__ __forceinline__ void operator()(const f32x4 (&acc)[2][2][4][2], const Unit& u, int wr, int wc, int fr, int fq) const {
        EPI_ROWS(u); const int pl = u.pn % NCT_DN;
        if (u.aux == 0) {
            const int cb = pl * 256 + ct0;
            EPI_FOR_ROWS { const int r = row0 + ai * HALF + m * 16; const float w = wslot[r]; GLB bf16_t* rp = os + (size_t)r * D + cb;
#pragma unroll
                for (int bj = 0; bj < 2; ++bj) *(GLB u32x4*)(rp + bj * HALF) = pack8(acc[ai][bj][m][0] * w, acc[ai][bj][m][1] * w); }
        } else {
            GLB float* tp = osp + ((size_t)(((u.pm - 64) * 8 + pl) * S + (u.aux - 1)) << 16);
            EPI_FOR_ROWS { const int rl = wr * 64 + fr + ai * HALF + m * 16; const float w = wslot[u.pm * BM + rl]; GLB float* rp = tp + rl * 256 + ct0;
#pragma unroll
                for (int bj = 0; bj < 2; ++bj) { *(GLB f32x4*)(rp + bj * HALF) = acc[ai][bj][m][0] * w; *(GLB f32x4*)(rp + bj * HALF + 4) = acc[ai][bj][m][1] * w; } }
        }
    }
};
template <bool OB>
struct EpiPle { static constexpr bool PERM = true;
    const GLB bf16_t* resid; GLB void* out; const GLB bf16_t* proj;
    __device__ __forceinline__ void operator()(const f32x4 (&acc)[2][2][4][2], const Unit& u, int wr, int wc, int fr, int fq) const {
        EPI_ROWS(u); const int cb = u.pn * 256 + ct0;
        EPI_FOR_ROWS { const size_t ro = (size_t)(row0 + ai * HALF + m * 16) * D + cb;
#pragma unroll
            for (int bj = 0; bj < 2; ++bj) { f32x4 p0, p1, r0, r1; unpack8(*(const GLB u32x4*)(proj + ro + bj * HALF), p0, p1); unpack8(*(const GLB u32x4*)(resid + ro + bj * HALF), r0, r1);
                r0 = r0 + sig4(acc[ai][bj][m][0]) * p0; r1 = r1 + sig4(acc[ai][bj][m][1]) * p1;
                if (OB) *(GLB u32x4*)((GLB bf16_t*)out + ro + bj * HALF) = pack8(r0, r1);
                else { *(GLB f32x4*)((GLB float*)out + ro + bj * HALF) = r0; *(GLB f32x4*)((GLB float*)out + ro + bj * HALF + 4) = r1; } } }
    }
};
struct EpiProj { static constexpr bool PERM = true;
    GLB bf16_t* proj;
    __device__ __forceinline__ void operator()(const f32x4 (&acc)[2][2][4][2], const Unit& u, int wr, int wc, int fr, int fq) const {
        EPI_ROWS(u); GLB bf16_t* base = proj + (size_t)(u.pn >> 3) * T * D + (u.pn & 7) * 256 + ct0;
        EPI_FOR_ROWS { GLB bf16_t* rp = base + (size_t)(row0 + ai * HALF + m * 16) * D;
#pragma unroll
            for (int bj = 0; bj < 2; ++bj) *(GLB u32x4*)(rp + bj * HALF) = pack8(acc[ai][bj][m][0], acc[ai][bj][m][1]); }
    }
};
}
struct Ctx {
    LAS unsigned char* lds;
    GLB unsigned char* ws;
    GLB float* out;
    int tid, lane, wave, gw, NGW, G;
};
#define WSP(type, off) ((GLB type*)(C.ws + (off)))
constexpr int INTAB_OFF = MISC_OFF + 1024;
constexpr int TAB_WS = 37, TAB_OUT = 38, TAB_RANGE = 39;
__device__ __forceinline__ const GLB void* inptr(LAS unsigned char* lds, int i) {
    const LAS unsigned* t = (const LAS unsigned*)(lds + INTAB_OFF) + 2 * i;
    const unsigned lo = __builtin_amdgcn_readfirstlane(t[0]), hi = __builtin_amdgcn_readfirstlane(t[1]);
    return (const GLB void*)(((unsigned long long)hi << 32) | lo);
}
#define INF32(i) ((const GLB float*)inptr(C.lds, (i)))
__device__ __forceinline__ Ctx make_ctx(LAS unsigned char* lds) {
    Ctx C; C.lds = lds;
    int tid = threadIdx.x; asm volatile("" : "+v"(tid));
    C.tid = tid; C.lane = tid & 63; C.wave = __builtin_amdgcn_readfirstlane(tid >> 6);
    C.G = gridDim.x; C.gw = blockIdx.x * NWAVES + C.wave; C.NGW = C.G * NWAVES;
    C.ws = (GLB unsigned char*)inptr(lds, TAB_WS); C.out = (GLB float*)inptr(lds, TAB_OUT);
    return C;
}
enum { I_X = 0, I_P, I_POS, I_WIN, I_MIXN, I_FFNN, I_PLEN, I_RWMU, I_RWW0, I_RWW2, I_RWA0, I_RWA2, I_RWG2, I_RWKK, I_RWKA, I_RWRK, I_RWLNG, I_RWLNB,
       I_DQN, I_DKN, I_DKVN, I_DWUK, I_DWUV, I_SQN, I_SKN, I_SSINK, I_WBR, I_WOUT, I_FG, I_FU, I_FD, I_MR, I_MG, I_MU, I_MD, I_PG, I_PP, N_INPUTS };

__device__ __forceinline__ void conv_tile(const GLB float* W, int ldw, int k0, int s0, int nv, GLB bf16_t* Bt, int K, int n0, LAS float* scr, int lane) {
    const int cq = lane & 15, rq = lane >> 4;
    f32x4 v[16];
#pragma unroll
    for (int i = 0; i < 16; ++i) {
        const int kk = 4 * i + rq;
        v[i] = (4 * cq < nv) ? *(const GLB f32x4*)(W + (size_t)(k0 + kk) * ldw + s0 + 4 * cq) : (f32x4){0.f, 0.f, 0.f, 0.f};
    }
#pragma unroll
    for (int i = 0; i < 16; ++i) { const int kk = 4 * i + rq; LAS float* d = scr + kk * 65 + 4 * cq; d[0] = v[i][0]; d[1] = v[i][1]; d[2] = v[i][2]; d[3] = v[i][3]; }
    LDS_WAIT();
    const int c = lane & 7;
#pragma unroll
    for (int j = 0; j < 8; ++j) { const int n = (lane >> 3) + 8 * j; const LAS float* s = scr + (8 * c) * 65 + n;
        u32x4 o; o.x = pk2(s[0 * 65], s[1 * 65]); o.y = pk2(s[2 * 65], s[3 * 65]); o.z = pk2(s[4 * 65], s[5 * 65]); o.w = pk2(s[6 * 65], s[7 * 65]);
        *(GLB u32x4*)(Bt + (size_t)(n0 + n) * K + k0 + 8 * c) = o; }
    LDS_WAIT();
}
__device__ __forceinline__ void win_map(int g, int& s0, int& nv) {
    const int d0 = 64 * g; nv = 64;
    if (d0 < 8704) s0 = d0;
    else if (d0 < 9728) s0 = 8784 + (d0 - 8704);
    else if (d0 < 9984) s0 = 9808 + (d0 - 9728);
    else if (d0 < 10240) { const int off = d0 - 9984; if (off == 0) s0 = 8704; else if (off == 64) { s0 = 8768; nv = 16; } else { s0 = 0; nv = 0; } }
    else s0 = 10064 + (d0 - 10240);
}
#ifndef MOE_SCAN_TILES
#define MOE_SCAN_TILES 42
#endif
#ifndef MOE_CONV_IN_PROLOGUE
#define MOE_CONV_IN_PROLOGUE 0
#endif
constexpr int MOE_CONV_ITEMS = NE * ((D / 64) * (2 * FF / 64) + (FF / 64) * (D / 64));
__device__ __forceinline__ void conv_moe_item(const Ctx& C, int idx, LAS float* scr, int lane) {
    constexpr int I_GU1 = (D / 64) * (2 * FF / 64), I_DN1 = (FF / 64) * (D / 64);
    if (idx < NE * I_GU1) {
        const int e = idx / I_GU1, r = idx % I_GU1, nb = r % (2 * FF / 64), kb = r / (2 * FF / 64);
        const int tile = nb >> 2, q = nb & 3; const int sc = 128 * tile + 64 * (q & 1);
        conv_tile(((q < 2) ? INF32(I_MG) : INF32(I_MU)) + (size_t)e * D * FF, FF, 64 * kb, sc, 64, WSP(bf16_t, WS_MWGU) + (size_t)e * 2 * FF * D, D, 64 * nb, scr, lane);
    } else {
        const int r0 = idx - NE * I_GU1, e = r0 / I_DN1, r = r0 % I_DN1, nb = r % 32, kb = r / 32;
        conv_tile(INF32(I_MD) + (size_t)e * FF * D, D, 64 * kb, 64 * nb, 64, WSP(bf16_t, WS_MWD) + (size_t)e * D * FF, FF, 64 * nb, scr, lane);
    }
}
__device__ __forceinline__ void ph_prologue(const Ctx& C) {
    LAS float* scr = (LAS float*)(C.lds + C.wave * 16640);
    const int gw = C.gw, NGW = C.NGW; int lane = C.lane; asm volatile("" : "+v"(lane)); lane &= 63;
    constexpr int I_WIN1 = (D / 64) * (N_INP / 64);
    constexpr int I_BR1 = (1024 / 64) * (2048 / 64);
    constexpr int I_DD = (D / 64) * (D / 64);
    constexpr int I_GU1 = (D / 64) * (2 * FF / 64);
    constexpr int I_DN1 = (FF / 64) * (D / 64);
    constexpr int I_PP1 = (256 / 64) * (D / 64);
    constexpr int S0 = 0, S1 = S0 + NL * I_WIN1, S2 = S1 + NL * 4 * I_BR1, S3 = S2 + NL * I_DD, S4 = S3 + I_GU1, S5 = S4 + I_DN1, S6 = S5 + NE * I_GU1, S7 = S6 + NE * I_DN1,
                  S8 = S7 + NL * I_DD, S9 = S8 + NL * I_PP1;
    for (int it = gw; it < S9; it += NGW) {
        if (it < S1) { const int l = it / I_WIN1, r = it % I_WIN1, nb = r % (N_INP / 64), kb = r / (N_INP / 64); int s0, nv; win_map(nb, s0, nv);
            conv_tile(INF32(I_WIN) + (size_t)l * D * N_IN, N_IN, 64 * kb, s0, nv, WSP(bf16_t, WS_WIN + l * SZ_WIN1), D, 64 * nb, scr, lane); }
        else if (it < S2) { const int q = (it - S1) / I_BR1, r = (it - S1) % I_BR1, nb = r % 32, kb = r / 32;
            conv_tile(INF32(I_WBR) + (size_t)q * 1024 * 2048, 2048, 64 * kb, 64 * nb, 64, WSP(bf16_t, WS_WBR) + (size_t)q * 2048 * 1024, 1024, 64 * nb, scr, lane); }
        else if (it < S3) { const int l = (it - S2) / I_DD, r = (it - S2) % I_DD, nb = r % 32, kb = r / 32;
            conv_tile(INF32(I_WOUT) + (size_t)l * D * D, D, 64 * kb, 64 * nb, 64, WSP(bf16_t, WS_WOUT + l * SZ_DD), D, 64 * nb, scr, lane); }
        else if (it < S4) {
            const int r = it - S3, nb = r % (2 * FF / 64), kb = r / (2 * FF / 64);
            const int tile = nb >> 2, q = nb & 3; const int sc = 128 * tile + 64 * (q & 1);
            conv_tile((q < 2) ? INF32(I_FG) : INF32(I_FU), FF, 64 * kb, sc, 64, WSP(bf16_t, WS_WGU), D, 64 * nb, scr, lane); }
        else if (it < S5) { const int r = it - S4, nb = r % 32, kb = r / 32;
            conv_tile(INF32(I_FD), D, 64 * kb, 64 * nb, 64, WSP(bf16_t, WS_WD), FF, 64 * nb, scr, lane); }
        else if (it < S7) { if (MOE_CONV_IN_PROLOGUE || it - S5 >= 2 * 1024 * MOE_SCAN_TILES) conv_moe_item(C, it - S5, scr, lane); }
        else if (it < S8) { const int l = (it - S7) / I_DD, r = (it - S7) % I_DD, nb = r % 32, kb = r / 32;
            conv_tile(INF32(I_PG) + (size_t)l * D * D, D, 64 * kb, 64 * nb, 64, WSP(bf16_t, WS_WPG + l * SZ_DD), D, 64 * nb, scr, lane); }
        else { const int l = (it - S8) / I_PP1, r = (it - S8) % I_PP1, nb = r % 32, kb = r / 32;
            conv_tile(INF32(I_PP) + (size_t)l * 256 * D, D, 64 * kb, 64 * nb, 64, WSP(bf16_t, WS_WPP) + (size_t)l * D * 256, 256, 64 * nb, scr, lane); }
    }
    for (int idx = gw * 64 + lane; idx < NL * 3072 * 256; idx += NGW * 64) {
        const int k = idx & 255, n = (idx >> 8) % 3072, l = idx / (3072 * 256);
        float v = 0.f;
        if (n < 1024) { if (k < 96) v = INF32(I_RWW2)[((size_t)l * 96 + k) * 1024 + n]; }
        else if (n < 2048) { if (k >= 96 && k < 192) v = INF32(I_RWA2)[((size_t)l * 96 + (k - 96)) * 1024 + (n - 1024)]; }
        else { if (k >= 192) v = INF32(I_RWG2)[((size_t)l * 64 + (k - 192)) * 1024 + (n - 2048)]; }
        WSP(bf16_t, WS_WLORA)[idx] = (bf16_t)f2bf(v);
    }
    for (int idx = gw * 64 + lane; idx < NL * T * 64; idx += NGW * 64) {
        const int c4 = idx & 63, t = (idx >> 6) % T, l = idx / (T * 64);
        const f32x4 v = *(const GLB f32x4*)(INF32(I_P) + ((size_t)l * T + t) * 256 + 4 * c4);
        u32x2 o; o.x = pk2(v[0], v[1]); o.y = pk2(v[2], v[3]);
        *(GLB u32x2*)(WSP(bf16_t, WS_PCAT) + (size_t)t * 512 + l * 256 + 4 * c4) = o;
    }
}

template <int MODE, bool XBF = true>
__device__ __forceinline__ void ph_norm(const Ctx& C, const GLB void* xin, GLB void* xout, const GLB float* gain, const GLB float* router, int moeS = 1) {
    int lane = C.lane; asm volatile("" : "+v"(lane)); lane &= 63;
    for (int m = C.gw; m < T; m += C.NGW) {
        f32x4 v[8]; float s = 0.f;
        if (XBF) { const GLB u32x2* xr = (const GLB u32x2*)((const GLB bf16_t*)xin + (size_t)m * D) + lane;
#pragma unroll
            for (int j = 0; j < 8; ++j) { const u32x2 w = xr[64 * j]; v[j] = (f32x4){bflo(w.x), bfhi(w.x), bflo(w.y), bfhi(w.y)}; }
        } else { const GLB f32x4* xr = (const GLB f32x4*)((const GLB float*)xin + (size_t)m * D) + lane;
#pragma unroll
            for (int j = 0; j < 8; ++j) v[j] = xr[64 * j]; }
        if (MODE == 2) {
            const GLB int* ts = WSP(int, WS_TOKSLOT) + 2 * m;
#pragma unroll
            for (int q = 0; q < 2; ++q) {
                const int sl = ts[q];
                if (sl < 64 * 256 || moeS <= 1) {
                    const GLB u32x2* o0 = (const GLB u32x2*)(WSP(bf16_t, WS_OS) + (size_t)sl * D) + lane;
#pragma unroll
                    for (int j = 0; j < 8; ++j) { const u32x2 w = o0[64 * j]; v[j] = v[j] + (f32x4){bflo(w.x), bfhi(w.x), bflo(w.y), bfhi(w.y)}; }
                } else {
                    const int tu0 = ((sl >> 8) - 64) * 8, rl = sl & 255;
#pragma unroll
                    for (int j = 0; j < 8; ++j)
                        for (int k = 0; k < moeS; ++k) v[j] = v[j] + *((const GLB f32x4*)(WSP(float, WS_OSP) + ((size_t)((tu0 + j) * moeS + k) << 16) + rl * 256) + lane);
                }
            }
#pragma unroll
            for (int j = 0; j < 8; ++j) { u32x2 o; o.x = pk2(v[j][0], v[j][1]); o.y = pk2(v[j][2], v[j][3]); ((GLB u32x2*)((GLB bf16_t*)xout + (size_t)m * D) + lane)[64 * j] = o;
                v[j] = (f32x4){bflo(o.x), bfhi(o.x), bflo(o.y), bfhi(o.y)}; }
        }
#pragma unroll
        for (int j = 0; j < 8; ++j) s += (v[j][0] * v[j][0] + v[j][1] * v[j][1]) + (v[j][2] * v[j][2] + v[j][3] * v[j][3]);
        const float rstd = 1.0f / sqrtf(wave_sum(s) * (1.0f / D) + 1e-6f);
        GLB u32x2* o8 = (GLB u32x2*)(WSP(bf16_t, WS_H) + (size_t)m * D) + lane;
        float lg[NE];
        if (MODE == 1) {
#pragma unroll
            for (int e = 0; e < NE; ++e) lg[e] = 0.f;
        }
#pragma unroll
        for (int j = 0; j < 8; ++j) { const f32x4 g = ((const GLB f32x4*)gain)[lane + 64 * j]; const f32x4 hv = v[j] * rstd * g; v[j] = hv;
            u32x2 o; o.x = pk2(hv[0], hv[1]); o.y = pk2(hv[2], hv[3]); o8[64 * j] = o; }
        if (MODE == 1) {
#pragma unroll 2
            for (int j = 0; j < 8; ++j) {
#pragma unroll
                for (int q = 0; q < 4; ++q) { const GLB f32x4* rr = (const GLB f32x4*)(router + (size_t)(4 * (lane + 64 * j) + q) * NE); const f32x4 r0 = rr[0], r1 = rr[1]; const float hq = v[j][q];
                    lg[0] += hq * r0[0]; lg[1] += hq * r0[1]; lg[2] += hq * r0[2]; lg[3] += hq * r0[3]; lg[4] += hq * r1[0]; lg[5] += hq * r1[1]; lg[6] += hq * r1[2]; lg[7] += hq * r1[3]; }
            }
        }
        if (MODE == 1) {
#pragma unroll
            for (int e = 0; e < NE; ++e) lg[e] = wave_sum(lg[e]);
            if (lane == 0) {
                int e1 = 0; float v1 = lg[0];
#pragma unroll
                for (int e = 1; e < NE; ++e) if (lg[e] > v1) { v1 = lg[e]; e1 = e; }
                int e2 = -1; float v2 = -3.0e38f;
#pragma unroll
                for (int e = 0; e < NE; ++e) if (e != e1 && lg[e] > v2) { v2 = lg[e]; e2 = e; }
                const float ex = __expf(v2 - v1), w1 = 1.0f / (1.0f + ex), w2 = ex / (1.0f + ex);
                GLB unsigned* cnt = WSP(unsigned, WS_CTL) + CW_MOECNT;
                const unsigned p1 = atomicAdd((unsigned*)cnt + 64 * e1, 1u), p2 = atomicAdd((unsigned*)cnt + 64 * e2, 1u);
                GLB unsigned* rt = WSP(unsigned, WS_ROUTE) + (size_t)m * 8;
                rt[0] = (unsigned)e1; rt[1] = p1; rt[2] = __builtin_bit_cast(unsigned, w1); rt[3] = (unsigned)e2; rt[4] = p2; rt[5] = __builtin_bit_cast(unsigned, w2);
            }
        }
    }
}
__device__ __forceinline__ void moe_offsets(const Ctx& C, int (&toff)[NE + 1]) {
    const GLB unsigned* cnt = WSP(unsigned, WS_CTL) + CW_MOECNT; int acc = 0;
#pragma unroll
    for (int e = 0; e < NE; ++e) { toff[e] = acc; const unsigned c = __hip_atomic_load(cnt + 64 * e, __ATOMIC_RELAXED, __HIP_MEMORY_SCOPE_AGENT); acc += (int)((c + 255u) >> 8); }
    toff[NE] = acc;
}
constexpr int MOETAB_OFF = MISC_OFF + 2048;
__device__ __forceinline__ void moe_tile_table(const Ctx& C) {
    int toff[NE + 1]; moe_offsets(C, toff);
    LAS int* tab = (LAS int*)(C.lds + MOETAB_OFF);
    if (C.tid <= MOE_MAXRT) { int e = 0;
#pragma unroll
        for (int j = 1; j < NE; ++j) e += (C.tid >= toff[j]) ? 1 : 0;
        tab[C.tid] = (C.tid == MOE_MAXRT) ? toff[NE] : e; }
    LDS_WAIT(); __syncthreads();
}
__device__ __forceinline__ void ph_moe_gather(const Ctx& C) {
    int toff[NE + 1]; moe_offsets(C, toff);
    int lane = C.lane; asm volatile("" : "+v"(lane)); lane &= 63;
    for (int m = C.gw; m < T; m += C.NGW) {
        const GLB unsigned* rt = WSP(unsigned, WS_ROUTE) + (size_t)m * 8;
        const int e1 = (int)rt[0], p1 = (int)rt[1], e2 = (int)rt[3], p2 = (int)rt[4];
        int o1 = 0, o2 = 0;
#pragma unroll
        for (int e = 0; e < NE; ++e) { o1 = (e == e1) ? toff[e] : o1; o2 = (e == e2) ? toff[e] : o2; }
        const int s1 = o1 * 256 + p1, s2 = o2 * 256 + p2;
        const GLB u32x4* src = (const GLB u32x4*)(WSP(bf16_t, WS_H) + (size_t)m * D) + lane;
        GLB u32x4* d1 = (GLB u32x4*)(WSP(bf16_t, WS_HS) + (size_t)s1 * D) + lane; GLB u32x4* d2 = (GLB u32x4*)(WSP(bf16_t, WS_HS) + (size_t)s2 * D) + lane;
#pragma unroll
        for (int j = 0; j < 4; ++j) { const u32x4 v = src[64 * j]; d1[64 * j] = v; d2[64 * j] = v; }
        if (lane == 0) { WSP(int, WS_TOKSLOT)[2 * m] = s1; WSP(int, WS_TOKSLOT)[2 * m + 1] = s2;
            WSP(unsigned, WS_WSLOT)[s1] = rt[2]; WSP(unsigned, WS_WSLOT)[s2] = rt[5]; }
    }
}

__device__ __forceinline__ float rope_inv_freq(int i, int half) { return exp2f(-13.287712379549449f * (float)i / (float)half); }
__device__ __forceinline__ void ph_prep(const Ctx& C, int l) {
    int lane = C.lane; asm volatile("" : "+v"(lane)); lane &= 63;
    const GLB bf16_t* UF = WSP(bf16_t, WS_UF);
    const int d = lane & 31, hh = lane >> 5;
    for (int m = C.gw; m < T; m += C.NGW) {
        const int t = m % SEQ;
        const GLB bf16_t* u = UF + (size_t)m * UFW;
        const float posf = (float)((const GLB int*)inptr(C.lds, I_POS))[m];
        float qa[8], qb[8], ia[8], ib[8], sa[8], sb[8];
#pragma unroll
        for (int h = 0; h < 8; ++h) { qa[h] = bf1(u[UF_DQ + h * 128 + lane]); qb[h] = bf1(u[UF_DQ + h * 128 + 64 + lane]); }
#pragma unroll
        for (int hp = 0; hp < 8; ++hp) { const int h = 2 * hp + hh; ia[hp] = bf1(u[UF_IQ + h * 64 + d]); ib[hp] = bf1(u[UF_IQ + h * 64 + 32 + d]); sa[hp] = bf1(u[UF_SQ + h * 64 + d]); sb[hp] = bf1(u[UF_SQ + h * 64 + 32 + d]); }
        const float ika = bf1(u[UF_IK + d]), ikb = bf1(u[UF_IK + 32 + d]), iwv = bf1(u[UF_IW + (lane & 15)]);
        const float ska = bf1(u[UF_SK + hh * 64 + d]), skb = bf1(u[UF_SK + hh * 64 + 32 + d]), sv0 = bf1(u[UF_SV + lane]), sv1 = bf1(u[UF_SV + 64 + lane]);
        {
            const GLB float* mu = INF32(I_RWMU) + (size_t)l * 3328;
#pragma unroll
            for (int half = 0; half < 2; ++half) {
                constexpr int J0[2] = {0, 7}, J1[2] = {7, 13};
                f32x4 cur[7], prv[7], mm[7];
#pragma unroll
                for (int j = J0[half]; j < J1[half]; ++j) { const int c = 4 * (lane + 64 * j), q = j - J0[half];
                    { const u32x2 w = *(const GLB u32x2*)(u + UF_RW + c); cur[q] = (f32x4){bflo(w.x), bfhi(w.x), bflo(w.y), bfhi(w.y)}; }
                    if (t > 0) { const u32x2 w = *(const GLB u32x2*)(u - UFW + UF_RW + c); prv[q] = (f32x4){bflo(w.x), bfhi(w.x), bflo(w.y), bfhi(w.y)}; } else prv[q] = (f32x4){0.f, 0.f, 0.f, 0.f};
                    mm[q] = *(const GLB f32x4*)(mu + c); }
#pragma unroll
                for (int j = J0[half]; j < J1[half]; ++j) { const int c = 4 * (lane + 64 * j), q = j - J0[half];
                    const f32x4 o = cur[q] + mm[q] * (prv[q] - cur[q]);
                    if (j < 12) { GLB bf16_t* dst = WSP(bf16_t, (j < 4 ? WS_R : (j < 8 ? WS_K : WS_V))) + (size_t)m * 1024 + (c & 1023); u32x2 w; w.x = pk2(o[0], o[1]); w.y = pk2(o[2], o[3]); *(GLB u32x2*)dst = w; }
                    else { const int k = c - 3072; f32x4 a;
                        if (k < 96) a = (f32x4){tanhf(o[0]), tanhf(o[1]), tanhf(o[2]), tanhf(o[3])};
                        else if (k < 192) a = o;
                        else a = pg8::sig4(o);
                        u32x2 w; w.x = pk2(a[0], a[1]); w.y = pk2(a[2], a[3]);
                        *(GLB u32x2*)(WSP(bf16_t, WS_ALORA) + (size_t)m * 256 + k) = w; }
                }
            }
        }
        {
            const float invf = rope_inv_freq(lane, 64); float sn, cn; sincosf(posf * invf, &sn, &cn);
            const float g1 = INF32(I_DQN)[l * 128 + lane], g2 = INF32(I_DQN)[l * 128 + 64 + lane];
#pragma unroll
            for (int h = 0; h < 8; ++h) {
                const float a = qa[h], b = qb[h];
                const float rs = 1.0f / sqrtf(wave_sum(a * a + b * b) * (1.0f / 128.f) + 1e-6f);
                const float x1 = a * rs * g1, x2 = b * rs * g2;
                GLB bf16_t* q = WSP(bf16_t, WS_QD) + (size_t)m * 1024 + h * 128;
                q[lane] = (bf16_t)f2bf(x1 * cn - x2 * sn); q[64 + lane] = (bf16_t)f2bf(x2 * cn + x1 * sn);
            }
        }
        {
            const float invf = rope_inv_freq(d, 32); float sn, cn; sincosf(posf * invf, &sn, &cn);
#pragma unroll
            for (int hp = 0; hp < 8; ++hp) { const int h = 2 * hp + hh; const float a = ia[hp], b = ib[hp];
                GLB bf16_t* q = WSP(bf16_t, WS_QI) + (size_t)m * 1024 + h * 64; q[d] = (bf16_t)f2bf(a * cn - b * sn); q[32 + d] = (bf16_t)f2bf(b * cn + a * sn); }
            if (hh == 0) { GLB bf16_t* q = WSP(bf16_t, WS_KI) + (size_t)m * 64; q[d] = (bf16_t)f2bf(ika * cn - ikb * sn); q[32 + d] = (bf16_t)f2bf(ikb * cn + ika * sn); }
            if (lane < 16) WSP(float, WS_WI)[(size_t)m * 16 + lane] = iwv * 0.03125f;
            const float sg1 = INF32(I_SQN)[l * 64 + d], sg2 = INF32(I_SQN)[l * 64 + 32 + d];
#pragma unroll
            for (int hp = 0; hp < 8; ++hp) { const int h = 2 * hp + hh; const float a = sa[hp], b = sb[hp];
                float s2 = a * a + b * b;
#pragma unroll
                for (int o = 1; o < 32; o <<= 1) s2 += __shfl_xor(s2, o);
                const float rs = 1.0f / sqrtf(s2 * (1.0f / 64.f) + 1e-6f); const float x1 = a * rs * sg1, x2 = b * rs * sg2;
                GLB bf16_t* q = WSP(bf16_t, WS_QS) + (size_t)m * 1024 + h * 64; q[d] = (bf16_t)f2bf(x1 * cn - x2 * sn); q[32 + d] = (bf16_t)f2bf(x2 * cn + x1 * sn); }
            { const float kg1 = INF32(I_SKN)[l * 64 + d], kg2 = INF32(I_SKN)[l * 64 + 32 + d];
              float s2 = ska * ska + skb * skb;
#pragma unroll
              for (int o = 1; o < 32; o <<= 1) s2 += __shfl_xor(s2, o);
              const float rs = 1.0f / sqrtf(s2 * (1.0f / 64.f) + 1e-6f); const float x1 = ska * rs * kg1, x2 = skb * rs * kg2;
              GLB bf16_t* q = WSP(bf16_t, WS_KS) + (size_t)m * 128 + hh * 64; q[d] = (bf16_t)f2bf(x1 * cn - x2 * sn); q[32 + d] = (bf16_t)f2bf(x2 * cn + x1 * sn);
              GLB bf16_t* vv = WSP(bf16_t, WS_VS) + (size_t)m * 128; vv[lane] = (bf16_t)f2bf(sv0); vv[64 + lane] = (bf16_t)f2bf(sv1); }
        }
    }
}

__device__ __forceinline__ void ph_latent(const Ctx& C, int l) {
    int lane = C.lane; asm volatile("" : "+v"(lane)); lane &= 63;
    LAS float* cs = (LAS float*)(C.lds + C.wave * 8192);
    const GLB bf16_t* UF = WSP(bf16_t, WS_UF);
    const GLB float* wuk = INF32(I_DWUK) + (size_t)l * 256 * 128; const GLB float* wuv = INF32(I_DWUV) + (size_t)l * 256 * 128;
    for (int g8 = C.gw; g8 < T / 8; g8 += C.NGW) {
        const int m0 = 8 * g8;
        float cv[8][4];
#pragma unroll
        for (int tk = 0; tk < 8; ++tk)
#pragma unroll
            for (int j = 0; j < 4; ++j) cv[tk][j] = bf1(UF[(size_t)(m0 + tk) * UFW + UF_CKV + lane + 64 * j]);
#pragma unroll
        for (int tk = 0; tk < 8; ++tk) {
            float ss = 0.f;
#pragma unroll
            for (int j = 0; j < 4; ++j) ss += cv[tk][j] * cv[tk][j];
            const float rc = 1.0f / sqrtf(wave_sum(ss) * (1.0f / 256.f) + 1e-6f);
#pragma unroll
            for (int j = 0; j < 4; ++j) cs[(lane + 64 * j) * 8 + tk] = cv[tk][j] * rc * INF32(I_DKVN)[l * 256 + lane + 64 * j];
        }
        LDS_WAIT();
        float acc[8][4];
#pragma unroll
        for (int tk = 0; tk < 8; ++tk) { acc[tk][0] = 0.f; acc[tk][1] = 0.f; acc[tk][2] = 0.f; acc[tk][3] = 0.f; }
#pragma unroll 8
        for (int k = 0; k < 256; ++k) {
            const float w0 = wuk[k * 128 + lane], w1 = wuk[k * 128 + 64 + lane], w2 = wuv[k * 128 + lane], w3 = wuv[k * 128 + 64 + lane];
            const f32x4 ca = *(const LAS f32x4*)(cs + k * 8), cb = *(const LAS f32x4*)(cs + k * 8 + 4);
#pragma unroll
            for (int tk = 0; tk < 8; ++tk) { const float c = (tk < 4) ? ca[tk & 3] : cb[tk & 3]; acc[tk][0] += c * w0; acc[tk][1] += c * w1; acc[tk][2] += c * w2; acc[tk][3] += c * w3; }
        }
        const float invf = rope_inv_freq(lane, 64);
        const float g1 = INF32(I_DKN)[l * 128 + lane], g2 = INF32(I_DKN)[l * 128 + 64 + lane];
#pragma unroll
        for (int tk = 0; tk < 8; ++tk) {
            const int m = m0 + tk;
            const float posf = (float)((const GLB int*)inptr(C.lds, I_POS))[m];
            float sn, cn; sincosf(posf * invf, &sn, &cn);
            const float k1 = acc[tk][0], k2 = acc[tk][1];
            const float rk = 1.0f / sqrtf(wave_sum(k1 * k1 + k2 * k2) * (1.0f / 128.f) + 1e-6f);
            const float y1 = k1 * rk * g1, y2 = k2 * rk * g2;
            GLB bf16_t* kd = WSP(bf16_t, WS_KD) + (size_t)m * 128; GLB bf16_t* vd = WSP(bf16_t, WS_VD) + (size_t)m * 128;
            kd[lane] = (bf16_t)f2bf(y1 * cn - y2 * sn); kd[64 + lane] = (bf16_t)f2bf(y2 * cn + y1 * sn);
            vd[lane] = (bf16_t)f2bf(acc[tk][2]); vd[64 + lane] = (bf16_t)f2bf(acc[tk][3]);
        }
        LDS_WAIT();
    }
}

__device__ __forceinline__ void ph_rwkv_kk(const Ctx& C, int l) {
    int lane = C.lane; asm volatile("" : "+v"(lane)); lane &= 63;
    for (int m = C.gw; m < T; m += C.NGW) {
#pragma unroll
        for (int i = 0; i < 4; ++i) {
            const int c = 256 * i + 4 * lane; const size_t o = (size_t)m * 1024 + c;
            const f32x4 k = *(const GLB f32x4*)(WSP(float, WS_K) + o), a = *(const GLB f32x4*)(WSP(float, WS_AA) + o);
            const f32x4 kkw = *(const GLB f32x4*)(INF32(I_RWKK) + l * 1024 + c), ka = *(const GLB f32x4*)(INF32(I_RWKA) + l * 1024 + c);
            f32x4 kk = k * kkw; float s = (kk[0] * kk[0] + kk[1] * kk[1]) + (kk[2] * kk[2] + kk[3] * kk[3]);
#pragma unroll
            for (int q = 1; q < 16; q <<= 1) s += __shfl_xor(s, q);
            const float inv = 1.0f / fmaxf(sqrtf(s), 1e-12f); kk = kk * inv;
            *(GLB f32x4*)(WSP(float, WS_KK) + o) = kk;
            *(GLB f32x4*)(WSP(float, WS_K) + o) = k * (1.0f + (a - 1.0f) * ka);
            *(GLB f32x4*)(WSP(float, WS_AA) + o) = kk * a;
        }
    }
}
__device__ __forceinline__ void ph_rwkv_scan_naive(const Ctx& C) {
    if (C.wave != 0) return;
    int lane = C.lane; asm volatile("" : "+v"(lane)); lane &= 63;
    LAS float* buf = (LAS float*)C.lds;
    for (int it = blockIdx.x; it < NB * 16; it += C.G) {
        const int b = it >> 4, h = it & 15;
        float S[64];
#pragma unroll
        for (int k = 0; k < 64; ++k) S[k] = 0.f;
        const size_t base = (size_t)b * SEQ * 1024 + h * 64 + lane;
        for (int t0 = 0; t0 < SEQ; t0 += 16) {
#pragma unroll
            for (int st = 0; st < 16; ++st) { const size_t o = base + (size_t)(t0 + st) * 1024; LAS float* d = buf + st * 384 + lane;
                d[0] = WSP(float, WS_R)[o]; d[64] = WSP(float, WS_DEC)[o]; d[128] = WSP(float, WS_K)[o]; d[192] = WSP(float, WS_KK)[o]; d[256] = WSP(float, WS_AA)[o]; d[320] = WSP(float, WS_V)[o]; }
            LDS_WAIT();
            for (int st = 0; st < 16; ++st) {
                const LAS float* rb = buf + st * 384;
                float p = 0.f;
#pragma unroll
                for (int k = 0; k < 64; k += 4) { const f32x4 q = *(const LAS f32x4*)(rb + 192 + k); p += S[k] * q[0] + S[k + 1] * q[1] + S[k + 2] * q[2] + S[k + 3] * q[3]; }
                const float vv = rb[320 + lane]; float y = 0.f;
#pragma unroll
                for (int k = 0; k < 64; k += 4) { const f32x4 w = *(const LAS f32x4*)(rb + 64 + k), bb = *(const LAS f32x4*)(rb + 256 + k), kq = *(const LAS f32x4*)(rb + 128 + k), r = *(const LAS f32x4*)(rb + k);
#pragma unroll
                    for (int j = 0; j < 4; ++j) { S[k + j] = S[k + j] * w[j] - p * bb[j] + vv * kq[j]; y += S[k + j] * r[j]; } }
                WSP(float, WS_YRAW)[base + (size_t)(t0 + st) * 1024] = y;
            }
            LDS_WAIT();
        }
    }
}
__device__ __forceinline__ f32x4 ld4bf(const GLB bf16_t* q) { const u32x2 w = *(const GLB u32x2*)q; return (f32x4){bflo(w.x), bfhi(w.x), bflo(w.y), bfhi(w.y)}; }
__device__ __forceinline__ void ph_rwkv_post(const Ctx& C, int l) {
    int lane = C.lane; asm volatile("" : "+v"(lane)); lane &= 63;
    if (C.wave >= 4) return;
    for (int m = blockIdx.x * 4 + C.wave; m < T; m += C.G * 4) {
#pragma unroll
        for (int i = 0; i < 4; ++i) {
            const int c = 256 * i + 4 * lane; const size_t o = (size_t)m * 1024 + c;
            const f32x4 y = *(const GLB f32x4*)(WSP(float, WS_YRAW) + o);
            float s = (y[0] + y[1]) + (y[2] + y[3]);
#pragma unroll
            for (int q = 1; q < 16; q <<= 1) s += __shfl_xor(s, q);
            const float mean = s * (1.0f / 64.f); const f32x4 dlt = y - mean;
            float s2 = (dlt[0] * dlt[0] + dlt[1] * dlt[1]) + (dlt[2] * dlt[2] + dlt[3] * dlt[3]);
#pragma unroll
            for (int q = 1; q < 16; q <<= 1) s2 += __shfl_xor(s2, q);
            const float rstd = 1.0f / sqrtf(s2 * (1.0f / 64.f) + 64e-5f);
            const f32x4 r = ld4bf(WSP(bf16_t, WS_R) + o), kraw = ld4bf(WSP(bf16_t, WS_K) + o), av = ld4bf(WSP(bf16_t, WS_AA) + o), v = ld4bf(WSP(bf16_t, WS_V) + o), g = ld4bf(WSP(bf16_t, WS_GG) + o);
            const f32x4 k = kraw * (1.0f + (av - 1.0f) * *(const GLB f32x4*)(INF32(I_RWKA) + l * 1024 + c));
            const f32x4 rk = *(const GLB f32x4*)(INF32(I_RWRK) + l * 1024 + c), lg = *(const GLB f32x4*)(INF32(I_RWLNG) + l * 1024 + c), lb = *(const GLB f32x4*)(INF32(I_RWLNB) + l * 1024 + c);
            const f32x4 pr = r * k * rk; float bs = (pr[0] + pr[1]) + (pr[2] + pr[3]);
#pragma unroll
            for (int q = 1; q < 16; q <<= 1) bs += __shfl_xor(bs, q);
            const f32x4 res = (dlt * rstd * lg + lb + bs * v) * g;
            u32x2 w; w.x = pk2(res[0], res[1]); w.y = pk2(res[2], res[3]);
            *(GLB u32x2*)(WSP(bf16_t, WS_Y) + (size_t)m * 4096 + 1024 + c) = w;
        }
    }
}
__device__ __forceinline__ float dot8(u32x4 kv, f32x4 qa, f32x4 qb) {
    return bflo(kv.x) * qa[0] + bfhi(kv.x) * qa[1] + bflo(kv.y) * qa[2] + bfhi(kv.y) * qa[3] + bflo(kv.z) * qb[0] + bfhi(kv.z) * qb[1] + bflo(kv.w) * qb[2] + bfhi(kv.w) * qb[3];
}
__device__ __forceinline__ void ph_sb_naive(const Ctx& C) {
    int lane = C.lane; asm volatile("" : "+v"(lane));
    LAS float* qs = (LAS float*)(C.lds + C.wave * 512);
    const GLB bf16_t* QKV = WSP(bf16_t, WS_SBQKV); GLB bf16_t* Y = WSP(bf16_t, WS_Y);
    for (int it = C.gw; it < NB * 8 * SEQ; it += C.NGW) {
        const int t = it % SEQ, bh = it / SEQ, h = bh & 7, b = bh >> 3;
        const size_t m = (size_t)b * SEQ + t;
        { const unsigned qq = *(const GLB unsigned*)(QKV + m * 3072 + h * 128 + 2 * lane); qs[2 * lane] = bflo(qq); qs[2 * lane + 1] = bfhi(qq); }
        LDS_WAIT();
        float o0 = 0.f, o1 = 0.f, carry = 0.f;
        const int nch = (t + 63) >> 6;
        for (int c = nch - 1; c >= 0; --c) {
            const int s = c * 64 + lane; const bool valid = s < t; const int sc = valid ? s : 0;
            const GLB u32x4* kp = (const GLB u32x4*)(QKV + ((size_t)b * SEQ + sc) * 3072 + 1024 + h * 128);
            float dot = 0.f;
#pragma unroll
            for (int j = 0; j < 16; ++j) dot += dot8(kp[j], *(const LAS f32x4*)(qs + 8 * j), *(const LAS f32x4*)(qs + 8 * j + 4));
            const float z = dot * 0.08838834764831845f;
            const float lk = valid ? logsigf_(-z) : 0.f, lb = logsigf_(z);
            float inc = lk;
#pragma unroll
            for (int off = 1; off < 64; off <<= 1) { const float o = __shfl_down(inc, off); if (lane + off < 64) inc += o; }
            const float w = valid ? __expf(lb + carry + inc - lk) : 0.f;
            carry += rdlane(inc, 0);
            const int nk = (t - c * 64) < 64 ? (t - c * 64) : 64;
            const GLB bf16_t* vp = QKV + ((size_t)b * SEQ + c * 64) * 3072 + 2048 + h * 128 + 2 * lane;
            for (int j = 0; j < nk; ++j) { const float wj = rdlane(w, j); const unsigned vv = *(const GLB unsigned*)(vp + (size_t)j * 3072); o0 += wj * bflo(vv); o1 += wj * bfhi(vv); }
        }
        *(GLB unsigned*)(Y + m * 4096 + h * 128 + 2 * lane) = pk2(o0, o1);
        LDS_WAIT();
    }
}
__device__ __forceinline__ void ph_swa_naive(const Ctx& C, int l) {
    int lane = C.lane; asm volatile("" : "+v"(lane));
    LAS float* qs = (LAS float*)(C.lds + C.wave * 512);
    const GLB bf16_t* QS = WSP(bf16_t, WS_QS); const GLB bf16_t* KS = WSP(bf16_t, WS_KS); const GLB bf16_t* VS = WSP(bf16_t, WS_VS); GLB bf16_t* Y = WSP(bf16_t, WS_Y);
    for (int it = C.gw; it < T * 16; it += C.NGW) {
        const int h = it & 15, m = it >> 4, t = m % SEQ, b = m / SEQ, kvh = h >> 3;
        qs[lane] = bf1(QS[(size_t)m * 1024 + h * 64 + lane]);
        LDS_WAIT();
        float lg[2];
#pragma unroll
        for (int i = 0; i < 2; ++i) { const int s = t - 127 + lane + 64 * i; const bool valid = s >= 0;
            const GLB u32x4* kp = (const GLB u32x4*)(KS + ((size_t)b * SEQ + (valid ? s : 0)) * 128 + kvh * 64);
            float dot = 0.f;
#pragma unroll
            for (int j = 0; j < 8; ++j) dot += dot8(kp[j], *(const LAS f32x4*)(qs + 8 * j), *(const LAS f32x4*)(qs + 8 * j + 4));
            lg[i] = valid ? dot * 0.125f : -3.0e38f; }
        const float sink = INF32(I_SSINK)[l * 16 + h];
        const float mx = fmaxf(wave_max(fmaxf(lg[0], lg[1])), sink);
        const float e0 = (lg[0] > -1.0e38f) ? __expf(lg[0] - mx) : 0.f, e1 = (lg[1] > -1.0e38f) ? __expf(lg[1] - mx) : 0.f;
        const float den = wave_sum(e0 + e1) + __expf(sink - mx);
        const float p0 = e0 / den, p1 = e1 / den;
        float o = 0.f;
        const int j0 = (t >= 127) ? 0 : 127 - t;
        for (int j = j0; j < 128; ++j) { const float pj = (j < 64) ? rdlane(p0, j) : rdlane(p1, j - 64); const int s = t - 127 + j;
            o += pj * bf1(VS[((size_t)b * SEQ + s) * 128 + kvh * 64 + lane]); }
        Y[(size_t)m * 4096 + 3072 + h * 64 + lane] = (bf16_t)f2bf(o);
        LDS_WAIT();
    }
}
__device__ __forceinline__ unsigned ordkey(float f) { const unsigned u = __builtin_bit_cast(unsigned, f); return (u & 0x80000000u) ? ~u : (u | 0x80000000u); }
__device__ __forceinline__ void ph_dsa_naive(const Ctx& C) {
    int lane = C.lane; asm volatile("" : "+v"(lane));
    LAS float* A = (LAS float*)(C.lds + C.wave * 13312);
    LAS float* Bs = A + 1024;
    LAS int* Cs = (LAS int*)(Bs + 2048);
    const GLB bf16_t* QI = WSP(bf16_t, WS_QI); const GLB bf16_t* KI = WSP(bf16_t, WS_KI); const GLB float* WI = WSP(float, WS_WI);
    const GLB bf16_t* QD = WSP(bf16_t, WS_QD); const GLB bf16_t* KD = WSP(bf16_t, WS_KD); const GLB bf16_t* VD = WSP(bf16_t, WS_VD); GLB bf16_t* Y = WSP(bf16_t, WS_Y);
    for (int m = C.gw; m < T; m += C.NGW) {
        const int t = m % SEQ, b = m / SEQ, n = t + 1;
        const size_t bm = (size_t)b * SEQ;
#pragma unroll
        for (int i = 0; i < 2; ++i) { const int e = 8 * (lane + 64 * i); const u32x4 q = *(const GLB u32x4*)(QI + (size_t)m * 1024 + e);
            *(LAS f32x4*)(A + e) = (f32x4){bflo(q.x), bfhi(q.x), bflo(q.y), bfhi(q.y)}; *(LAS f32x4*)(A + e + 4) = (f32x4){bflo(q.z), bfhi(q.z), bflo(q.w), bfhi(q.w)}; }
        const float wl = WI[(size_t)m * 16 + (lane & 15)];
        LDS_WAIT();
        const int nch = (n + 63) >> 6;
        for (int c = 0; c < nch; ++c) {
            const int s = c * 64 + lane; const bool valid = s < n;
            const GLB u32x4* kp = (const GLB u32x4*)(KI + (bm + (valid ? s : 0)) * 64);
            u32x4 kv[8];
#pragma unroll
            for (int j = 0; j < 8; ++j) kv[j] = kp[j];
            float sc = 0.f;
#pragma unroll 1
            for (int h = 0; h < 16; ++h) { float dot = 0.f;
#pragma unroll
                for (int j = 0; j < 8; ++j) dot += dot8(kv[j], *(const LAS f32x4*)(A + h * 64 + 8 * j), *(const LAS f32x4*)(A + h * 64 + 8 * j + 4));
                sc += rdlane(wl, h) * fmaxf(dot, 0.f); }
            Bs[s] = sc;
        }
        LDS_WAIT();
        int nsel;
        if (n <= 256) { nsel = n;
#pragma unroll
            for (int i = 0; i < 4; ++i) if (lane + 64 * i < n) Cs[lane + 64 * i] = lane + 64 * i;
        } else {
            nsel = 256;
            unsigned key[32];
#pragma unroll
            for (int i = 0; i < 32; ++i) { const int s = lane + 64 * i; key[i] = (s < n) ? ordkey(Bs[s]) : 0u; }
            unsigned tau = 0u;
            for (int bit = 31; bit >= 0; --bit) {
                const unsigned cand = tau | (1u << bit); int cnt = 0;
#pragma unroll
                for (int i = 0; i < 32; ++i) cnt += (key[i] >= cand) ? 1 : 0;
#pragma unroll
                for (int o = 1; o < 64; o <<= 1) cnt += __shfl_xor(cnt, o);
                if (cnt >= 256) tau = cand;
            }
            int cgt = 0;
#pragma unroll
            for (int i = 0; i < 32; ++i) cgt += (key[i] > tau) ? 1 : 0;
#pragma unroll
            for (int o = 1; o < 64; o <<= 1) cgt += __shfl_xor(cgt, o);
            const int need = 256 - cgt;
            int base = 0, eqbase = 0;
            const unsigned long long lt = (1ull << lane) - 1ull;
#pragma unroll
            for (int i = 0; i < 32; ++i) {
                const bool gt = key[i] > tau, eq = key[i] == tau;
                const unsigned long long beq = __ballot(eq);
                const int eqrank = eqbase + __popcll(beq & lt);
                const bool sel = gt || (eq && eqrank < need);
                const unsigned long long bs = __ballot(sel);
                if (sel) Cs[base + __popcll(bs & lt)] = lane + 64 * i;
                base += __popcll(bs); eqbase += __popcll(beq);
            }
        }
        LDS_WAIT();
#pragma unroll
        for (int i = 0; i < 2; ++i) { const int e = 8 * (lane + 64 * i); const u32x4 q = *(const GLB u32x4*)(QD + (size_t)m * 1024 + e);
            *(LAS f32x4*)(A + e) = (f32x4){bflo(q.x), bfhi(q.x), bflo(q.y), bfhi(q.y)}; *(LAS f32x4*)(A + e + 4) = (f32x4){bflo(q.z), bfhi(q.z), bflo(q.w), bfhi(q.w)}; }
        LDS_WAIT();
        float lg[8][4];
#pragma unroll
        for (int i = 0; i < 4; ++i) { const int j = lane + 64 * i; const bool valid = j < nsel; const int s = valid ? Cs[j] : 0;
            const GLB u32x4* kp = (const GLB u32x4*)(KD + (bm + s) * 128);
            float a8[8];
#pragma unroll
            for (int h = 0; h < 8; ++h) a8[h] = 0.f;
#pragma unroll 1
            for (int pc = 0; pc < 16; ++pc) { const u32x4 kv = kp[pc];
#pragma unroll
                for (int h = 0; h < 8; ++h) a8[h] += dot8(kv, *(const LAS f32x4*)(A + h * 128 + 8 * pc), *(const LAS f32x4*)(A + h * 128 + 8 * pc + 4)); }
#pragma unroll
            for (int h = 0; h < 8; ++h) lg[h][i] = valid ? a8[h] * 0.08838834764831845f : -3.0e38f; }
#pragma unroll
        for (int h = 0; h < 8; ++h) {
            const float mx = wave_max(fmaxf(fmaxf(lg[h][0], lg[h][1]), fmaxf(lg[h][2], lg[h][3])));
            float e[4]; float sm = 0.f;
#pragma unroll
            for (int i = 0; i < 4; ++i) { e[i] = (lg[h][i] > -1.0e38f) ? __expf(lg[h][i] - mx) : 0.f; sm += e[i]; }
            const float inv = 1.0f / wave_sum(sm);
#pragma unroll
            for (int i = 0; i < 4; ++i) Bs[(lane + 64 * i) * 8 + h] = e[i] * inv;
        }
        LDS_WAIT();
        float o[8][2];
#pragma unroll
        for (int h = 0; h < 8; ++h) { o[h][0] = 0.f; o[h][1] = 0.f; }
        for (int j = 0; j < nsel; ++j) { const int s = Cs[j]; const unsigned vv = *(const GLB unsigned*)(VD + (bm + s) * 128 + 2 * lane); const float v0 = bflo(vv), v1 = bfhi(vv);
            const f32x4 pa = *(const LAS f32x4*)(Bs + j * 8), pb = *(const LAS f32x4*)(Bs + j * 8 + 4);
#pragma unroll
            for (int h = 0; h < 4; ++h) { o[h][0] += pa[h] * v0; o[h][1] += pa[h] * v1; o[4 + h][0] += pb[h] * v0; o[4 + h][1] += pb[h] * v1; } }
#pragma unroll
        for (int h = 0; h < 8; ++h) *(GLB unsigned*)(Y + (size_t)m * 4096 + 2048 + h * 128 + 2 * lane) = pk2(o[h][0], o[h][1]);
        LDS_WAIT();
    }
}
typedef float f32x16 __attribute__((ext_vector_type(16)));
__device__ __forceinline__ int wave_isum(int x) {
    x += __builtin_amdgcn_mov_dpp(x, 0x128, 0xf, 0xf, true); x += __builtin_amdgcn_mov_dpp(x, 0x124, 0xf, 0xf, true);
    x += __builtin_amdgcn_mov_dpp(x, 0x122, 0xf, 0xf, true); x += __builtin_amdgcn_mov_dpp(x, 0x121, 0xf, 0xf, true);
    return __builtin_amdgcn_readlane(x, 0) + __builtin_amdgcn_readlane(x, 16) + __builtin_amdgcn_readlane(x, 32) + __builtin_amdgcn_readlane(x, 48);
}
constexpr size_t WS_SBVT = WS_MIX_END;
constexpr size_t WS_SWVT = WS_SBVT + (size_t)32 * 128 * SEQ * 2;
constexpr size_t WS_VDT = WS_SWVT + (size_t)NB * 2 * 64 * SEQ * 2;
constexpr size_t WS_SC = WS_VDT + (size_t)NB * 128 * SEQ * 2;
constexpr size_t WS_SELB = WS_SC + (size_t)T * SEQ * 4;
constexpr size_t WS_END2 = WS_SELB + (size_t)T * 32 * 8;
constexpr size_t WS_XB = (WS_END2 + 255) & ~(size_t)255;
constexpr size_t WS_END3 = WS_XB + (size_t)T * D * 2;
static_assert(WS_END3 < (size_t)2000 * 1000 * 1000, "workspace budget");

__device__ __forceinline__ void vt_tile(const GLB bf16_t* src, int src_ld, GLB bf16_t* dst, LAS bf16_t* scr, int lane) {
    const int cq = lane & 7, rq = lane >> 3;
    u32x4 v[8];
#pragma unroll
    for (int j = 0; j < 8; ++j) v[j] = *(const GLB u32x4*)(src + (size_t)(rq + 8 * j) * src_ld + 8 * cq);
#pragma unroll
    for (int j = 0; j < 8; ++j) { LAS unsigned* d = (LAS unsigned*)(scr + (rq + 8 * j) * 66 + 8 * cq); d[0] = v[j].x; d[1] = v[j].y; d[2] = v[j].z; d[3] = v[j].w; }
    LDS_WAIT();
#pragma unroll
    for (int j = 0; j < 8; ++j) { const int d = rq + 8 * j; const LAS bf16_t* s = scr + (8 * cq) * 66 + d;
        u32x4 o; o.x = (unsigned)s[0] | ((unsigned)s[66] << 16); o.y = (unsigned)s[2 * 66] | ((unsigned)s[3 * 66] << 16);
        o.z = (unsigned)s[4 * 66] | ((unsigned)s[5 * 66] << 16); o.w = (unsigned)s[6 * 66] | ((unsigned)s[7 * 66] << 16);
        *(GLB u32x4*)(dst + (size_t)d * SEQ + 8 * cq) = o; }
    LDS_WAIT();
}
__device__ __forceinline__ void ph_vt(const Ctx& C) {
    int lane = C.lane; asm volatile("" : "+v"(lane)); lane &= 63;
    LAS bf16_t* scr = (LAS bf16_t*)(C.lds + 65536 + C.wave * 8448);
    for (int it = C.gw; it < 32 * 2 * 32; it += C.NGW) {
        const int sb = it & 31, db = (it >> 5) & 1, bh = it >> 6, b = bh >> 3, h = bh & 7;
        vt_tile(WSP(bf16_t, WS_SBQKV) + ((size_t)b * SEQ + 64 * sb) * 3072 + 2048 + h * 128 + 64 * db, 3072,
                WSP(bf16_t, WS_SBVT) + ((size_t)bh * 128 + 64 * db) * SEQ + 64 * sb, scr, lane);
    }
}

__device__ __forceinline__ void ph_vt_small(const Ctx& C) {
    int lane = C.lane; asm volatile("" : "+v"(lane)); lane &= 63;
    LAS bf16_t* scr = (LAS bf16_t*)(C.lds + C.wave * 8448);
    for (int it = C.gw; it < 512; it += C.NGW) {
        const int sb = it & 31, hd = (it >> 5) & 1, b = (it >> 6) & 3, which = it >> 8;
        if (which == 0) vt_tile(WSP(bf16_t, WS_VS) + ((size_t)b * SEQ + 64 * sb) * 128 + 64 * hd, 128, WSP(bf16_t, WS_SWVT) + ((size_t)(b * 2 + hd) * 64) * SEQ + 64 * sb, scr, lane);
        else vt_tile(WSP(bf16_t, WS_VD) + ((size_t)b * SEQ + 64 * sb) * 128 + 64 * hd, 128, WSP(bf16_t, WS_VDT) + ((size_t)b * 128 + 64 * hd) * SEQ + 64 * sb, scr, lane);
    }
}

__device__ __forceinline__ void sb_item(const Ctx& C, int lane, int bh, int qb) {
    const int c = lane & 31, hh = lane >> 5, b = bh >> 3, h = bh & 7, q0 = 32 * qb;
    const GLB bf16_t* QKV = WSP(bf16_t, WS_SBQKV); const GLB bf16_t* VT = WSP(bf16_t, WS_SBVT);
    const GLB bf16_t* qp = QKV + ((size_t)b * SEQ + q0 + c) * 3072 + h * 128 + 8 * hh;
    bf16x8 qf[8];
#pragma unroll
    for (int ks = 0; ks < 8; ++ks) qf[ks] = *(const GLB bf16x8*)(qp + 16 * ks);
    f32x16 O[4];
#pragma unroll
    for (int db = 0; db < 4; ++db)
#pragma unroll
        for (int r = 0; r < 16; ++r) O[db][r] = 0.f;
    float carry = 1.0f;
    const int km = 16 * ((c >> 2) & 1) + 4 * (c >> 3) + (c & 3);
    const GLB bf16_t* kbase = QKV + ((size_t)b * SEQ + km) * 3072 + 1024 + h * 128 + 8 * hh;
    const GLB bf16_t* vbase = VT + ((size_t)bh * 128 + c) * SEQ + 16 * hh;
    bf16x8 kf[8];
#pragma unroll
    for (int ks = 0; ks < 8; ++ks) kf[ks] = *(const GLB bf16x8*)(kbase + (size_t)q0 * 3072 + 16 * ks);
    for (int kt = qb; kt >= 0; --kt) {
        const int k0 = 32 * kt;
        bf16x8 vf[2][4];
#pragma unroll
        for (int s = 0; s < 2; ++s)
#pragma unroll
            for (int db = 0; db < 4; ++db) vf[s][db] = *(const GLB bf16x8*)(vbase + (size_t)(32 * db) * SEQ + k0 + 8 * s);
        f32x16 S;
#pragma unroll
        for (int r = 0; r < 16; ++r) S[r] = 0.f;
#pragma unroll
        for (int ks = 0; ks < 8; ++ks) S = __builtin_amdgcn_mfma_f32_32x32x16_bf16(kf[ks], qf[ks], S, 0, 0, 0);
        if (kt > 0) {
#pragma unroll
            for (int ks = 0; ks < 8; ++ks) kf[ks] = *(const GLB bf16x8*)(kbase + (size_t)(k0 - 32) * 3072 + 16 * ks);
        }
        const bool diag = (kt == qb);
        float w[16]; float sp = 1.0f;
#pragma unroll
        for (int r = 15; r >= 0; --r) {
            const float e = __builtin_amdgcn_exp2f(fminf(S[r] * -0.12751743074602535f, 115.0f)), rr = __builtin_amdgcn_rcpf(1.0f + e), er = e * rr;
            const bool valid = !diag || (16 * hh + r < c);
            const float beta = valid ? rr : 0.f, om = valid ? er : 1.0f;
            w[r] = beta * sp; sp *= om;
        }
        const float tot_other = __shfl_xor(sp, 32);
        const float pre = carry * (hh == 0 ? tot_other : 1.0f);
        carry *= sp * tot_other;
        const bool live = __ballot(carry >= 1.0e-30f) != 0ull;
        bf16x8 pw[2];
#pragma unroll
        for (int s = 0; s < 2; ++s) { u32x4 t; t.x = pk2(w[8 * s] * pre, w[8 * s + 1] * pre); t.y = pk2(w[8 * s + 2] * pre, w[8 * s + 3] * pre);
            t.z = pk2(w[8 * s + 4] * pre, w[8 * s + 5] * pre); t.w = pk2(w[8 * s + 6] * pre, w[8 * s + 7] * pre); pw[s] = __builtin_bit_cast(bf16x8, t); }
#pragma unroll
        for (int s = 0; s < 2; ++s)
#pragma unroll
            for (int db = 0; db < 4; ++db) O[db] = __builtin_amdgcn_mfma_f32_32x32x16_bf16(vf[s][db], pw[s], O[db], 0, 0, 0);
        if (!live) break;
    }
    GLB bf16_t* yp = WSP(bf16_t, WS_Y) + ((size_t)b * SEQ + q0 + c) * 4096 + h * 128 + 4 * hh;
#pragma unroll
    for (int db = 0; db < 4; ++db)
#pragma unroll
        for (int a = 0; a < 4; ++a) { u32x2 o; o.x = pk2(O[db][4 * a], O[db][4 * a + 1]); o.y = pk2(O[db][4 * a + 2], O[db][4 * a + 3]);
            *(GLB u32x2*)(yp + 32 * db + 8 * a) = o; }
}
__device__ __forceinline__ void ph_sb_fast(const Ctx& C) {
    int lane = C.lane; asm volatile("" : "+v"(lane)); lane &= 63;
    const int pi = blockIdx.x * 4 + (C.wave & 3);
    if (pi < 1024) { const int bh = pi >> 5, j = pi & 31; sb_item(C, lane, bh, (C.wave >> 2) ? 63 - j : j); }
}

#ifndef SWA_OUT_OFF
#define SWA_OUT_OFF WS_Y
#endif
__device__ __forceinline__ void swa_item(const Ctx& C, int lane, int l, int b, int h, int tb) {
    const int c = lane & 31, hh = lane >> 5, t0 = 32 * tb, kvh = h >> 3;
    const GLB bf16_t* qp = WSP(bf16_t, WS_QS) + ((size_t)b * SEQ + t0 + c) * 1024 + h * 64 + 8 * hh;
    bf16x8 qf[4];
#pragma unroll
    for (int ks = 0; ks < 4; ++ks) qf[ks] = *(const GLB bf16x8*)(qp + 16 * ks);
    const int km = 16 * ((c >> 2) & 1) + 4 * (c >> 3) + (c & 3);
    const GLB bf16_t* kbase = WSP(bf16_t, WS_KS) + ((size_t)b * SEQ + km) * 128 + kvh * 64 + 8 * hh;
    const GLB bf16_t* vbase = WSP(bf16_t, WS_SWVT) + ((size_t)(b * 2 + kvh) * 64 + c) * SEQ + 16 * hh;
    float mrun = INF32(I_SSINK)[l * 16 + h], lrun = 1.0f;
    f32x16 O[2];
#pragma unroll
    for (int db = 0; db < 2; ++db)
#pragma unroll
        for (int r = 0; r < 16; ++r) O[db][r] = 0.f;
    const int i0 = (tb >= 4) ? 0 : 4 - tb;
    for (int i = i0; i < 5; ++i) {
        const int k0 = t0 - 128 + 32 * i;
        bf16x8 kf[4], vf[2][2];
#pragma unroll
        for (int ks = 0; ks < 4; ++ks) kf[ks] = *(const GLB bf16x8*)(kbase + (size_t)k0 * 128 + 16 * ks);
#pragma unroll
        for (int s = 0; s < 2; ++s)
#pragma unroll
            for (int db = 0; db < 2; ++db) vf[s][db] = *(const GLB bf16x8*)(vbase + (size_t)(32 * db) * SEQ + k0 + 8 * s);
        f32x16 a;
#pragma unroll
        for (int r = 0; r < 16; ++r) a[r] = 0.f;
#pragma unroll
        for (int ks = 0; ks < 4; ++ks) a = __builtin_amdgcn_mfma_f32_32x32x16_bf16(kf[ks], qf[ks], a, 0, 0, 0);
        float tmax = -1.0e30f;
#pragma unroll
        for (int r = 0; r < 16; ++r) { const int kr = 16 * hh + r; const bool valid = (i == 0) ? (kr > c) : ((i == 4) ? (kr <= c) : true); a[r] = valid ? a[r] * 0.125f : -1.0e30f; tmax = fmaxf(tmax, a[r]); }
        tmax = fmaxf(tmax, __shfl_xor(tmax, 32));
        const float mnew = fmaxf(mrun, tmax), alpha = __expf(mrun - mnew);
        float psum = 0.f;
#pragma unroll
        for (int r = 0; r < 16; ++r) { a[r] = __expf(a[r] - mnew); psum += a[r]; }
        psum += __shfl_xor(psum, 32);
        lrun = lrun * alpha + psum; mrun = mnew;
#pragma unroll
        for (int db = 0; db < 2; ++db)
#pragma unroll
            for (int r = 0; r < 16; ++r) O[db][r] *= alpha;
#pragma unroll
        for (int s = 0; s < 2; ++s) {
            u32x4 t; t.x = pk2(a[8 * s], a[8 * s + 1]); t.y = pk2(a[8 * s + 2], a[8 * s + 3]); t.z = pk2(a[8 * s + 4], a[8 * s + 5]); t.w = pk2(a[8 * s + 6], a[8 * s + 7]);
            const bf16x8 pw = __builtin_bit_cast(bf16x8, t);
#pragma unroll
            for (int db = 0; db < 2; ++db) O[db] = __builtin_amdgcn_mfma_f32_32x32x16_bf16(vf[s][db], pw, O[db], 0, 0, 0);
        }
    }
    const float inv = 1.0f / lrun;
    GLB bf16_t* yp = WSP(bf16_t, SWA_OUT_OFF) + ((size_t)b * SEQ + t0 + c) * 4096 + 3072 + h * 64 + 4 * hh;
#pragma unroll
    for (int db = 0; db < 2; ++db)
#pragma unroll
        for (int a4 = 0; a4 < 4; ++a4) { u32x2 o; o.x = pk2(O[db][4 * a4] * inv, O[db][4 * a4 + 1] * inv); o.y = pk2(O[db][4 * a4 + 2] * inv, O[db][4 * a4 + 3] * inv);
            *(GLB u32x2*)(yp + 32 * db + 8 * a4) = o; }
}
__device__ __forceinline__ void ph_swa_fast(const Ctx& C, int l) {
    int lane = C.lane; asm volatile("" : "+v"(lane)); lane &= 63;
    if (C.wave >= 4) return;
    for (int it = blockIdx.x * 4 + C.wave; it < NB * 64 * 16; it += C.G * 4) { const int h = it & 15, tb = (it >> 4) & 63, b = it >> 10; swa_item(C, lane, l, b, h, tb); }
}

__device__ __forceinline__ float row16_sum(float x) {
    x += __builtin_bit_cast(float, __builtin_amdgcn_mov_dpp(__builtin_bit_cast(int, x), 0x128, 0xf, 0xf, true));
    x += __builtin_bit_cast(float, __builtin_amdgcn_mov_dpp(__builtin_bit_cast(int, x), 0x124, 0xf, 0xf, true));
    x += __builtin_bit_cast(float, __builtin_amdgcn_mov_dpp(__builtin_bit_cast(int, x), 0x122, 0xf, 0xf, true));
    x += __builtin_bit_cast(float, __builtin_amdgcn_mov_dpp(__builtin_bit_cast(int, x), 0x121, 0xf, 0xf, true));
    return x;
}
__device__ __forceinline__ void ph_rwkv_scan_fast(const Ctx& C) {
    int tid = C.tid; asm volatile("" : "+v"(tid));
    const int lane = tid & 63, wave = C.wave;
    LAS float* buf = (LAS float*)C.lds;
    constexpr int CH = 32, CHF = CH * 384;
    for (int it = blockIdx.x; it < NB * 16 * 4; it += C.G) {
        const int qr = it & 3, h = (it >> 2) & 15, b = it >> 6;
        const size_t gbase = (size_t)b * SEQ * 1024 + h * 64;
        const int ro = lane >> 4, kq = lane & 15, row = 16 * qr + 4 * (wave & 3) + ro;
        float S0 = 0.f, S1 = 0.f, S2 = 0.f, S3 = 0.f;
        const int lj = tid - 256;
        auto load_chunk = [&](int cidx) {
            f32x4 v[12];
#pragma unroll
            for (int i = 0; i < 12; ++i) { const int idx = lj + 256 * i, step = idx / 96, rem = idx - step * 96, vec = rem >> 4, e4 = rem & 15;
                const size_t off = (vec == 0) ? WS_R : (vec == 1) ? WS_DEC : (vec == 2) ? WS_K : (vec == 3) ? WS_KK : (vec == 4) ? WS_AA : WS_V;
                v[i] = *(const GLB f32x4*)(WSP(float, off) + gbase + (size_t)(cidx * CH + step) * 1024 + 4 * e4); }
            LAS float* d = buf + (cidx & 1) * CHF;
#pragma unroll
            for (int i = 0; i < 12; ++i) { const int idx = lj + 256 * i, step = idx / 96, rem = idx - step * 96; *(LAS f32x4*)(d + step * 384 + rem * 4) = v[i]; }
        };
        if (wave >= 4) load_chunk(0);
        LDS_WAIT(); __syncthreads();
        for (int cidx = 0; cidx < SEQ / CH; ++cidx) {
            if (wave >= 4) { if (cidx + 1 < SEQ / CH) load_chunk(cidx + 1); }
            else {
                const LAS float* cb = buf + (cidx & 1) * CHF;
#pragma unroll 4
                for (int st = 0; st < CH; ++st) {
                    const LAS float* rb = cb + st * 384;
                    const f32x4 kk4 = *(const LAS f32x4*)(rb + 192 + 4 * kq);
                    const float p = row16_sum(S0 * kk4[0] + S1 * kk4[1] + S2 * kk4[2] + S3 * kk4[3]);
                    const f32x4 w4 = *(const LAS f32x4*)(rb + 64 + 4 * kq), b4 = *(const LAS f32x4*)(rb + 256 + 4 * kq), k4 = *(const LAS f32x4*)(rb + 128 + 4 * kq), r4 = *(const LAS f32x4*)(rb + 4 * kq);
                    const float vv = rb[320 + row];
                    S0 = S0 * w4[0] - p * b4[0] + vv * k4[0]; S1 = S1 * w4[1] - p * b4[1] + vv * k4[1]; S2 = S2 * w4[2] - p * b4[2] + vv * k4[2]; S3 = S3 * w4[3] - p * b4[3] + vv * k4[3];
                    const float y = row16_sum(S0 * r4[0] + S1 * r4[1] + S2 * r4[2] + S3 * r4[3]);
                    if (kq == 0) WSP(float, WS_YRAW)[gbase + (size_t)(cidx * CH + st) * 1024 + row] = y;
                }
            }
            LDS_WAIT(); __syncthreads();
        }
    }
}

__device__ __forceinline__ void dsa_item(const Ctx& C, int lane, int wave, int b, int g, int layer) {
    const int c = lane & 31, hh = lane >> 5, t0 = 4 * g;
    LAS float* sc = (LAS float*)(C.lds + wave * 17408);
    LAS unsigned* bm = (LAS unsigned*)(C.lds + wave * 17408 + 16384);
    const size_t bm0 = (size_t)b * SEQ;
    const int ntile = (t0 + 3) / 32 + 1;
    const int hw = wave >> 2, wq = wave & 3;
    volatile LAS unsigned* cnt = (volatile LAS unsigned*)(C.lds + MISC_OFF + 128 + 4 * hw);
    unsigned target = (unsigned)layer * 4u * (unsigned)(ntile + 6);
    auto arrive = [&]() { asm volatile("s_waitcnt vmcnt(0) lgkmcnt(0)" ::: "memory"); if (lane == 0) (void)__hip_atomic_fetch_add((LAS unsigned*)(C.lds + MISC_OFF + 128 + 4 * hw), 1u, __ATOMIC_RELAXED, __HIP_MEMORY_SCOPE_WORKGROUP); };
    auto wait_all = [&]() { target += 4u; while ((int)(*cnt - target) < 0) __builtin_amdgcn_s_sleep(1); asm volatile("" ::: "memory"); };
#pragma unroll 1
    for (int p = 0; p < 2; ++p) {
        {
            arrive(); wait_all();
            const int hd = (c & 3) + 4 * (c >> 3);
            bf16x8 qf[4][4]; f32x4 w4[4][4];
#pragma unroll
            for (int j = 0; j < 4; ++j) { const int t0j = t0 + 4 * (hw ? (wq - j) : (j - wq));
                const GLB bf16_t* qp = WSP(bf16_t, WS_QI) + (bm0 + t0j + 2 * p + ((c >> 2) & 1)) * 1024 + hd * 64 + 8 * hh;
                const GLB float* wp = WSP(float, WS_WI) + (bm0 + t0j + 2 * p + hh) * 16;
#pragma unroll
                for (int ks = 0; ks < 4; ++ks) { qf[j][ks] = *(const GLB bf16x8*)(qp + 16 * ks); w4[j][ks] = *(const GLB f32x4*)(wp + 4 * ks); } }
            const GLB bf16_t* kp = WSP(bf16_t, WS_KI) + (bm0 + c) * 64 + 8 * hh;
            bf16x8 kf[4];
            if (wq < ntile) {
#pragma unroll
                for (int ks = 0; ks < 4; ++ks) kf[ks] = *(const GLB bf16x8*)(kp + (size_t)(32 * wq) * 64 + 16 * ks);
            }
            for (int kt = wq; kt < ntile; kt += 4) {
                f32x16 a[4];
#pragma unroll
                for (int j = 0; j < 4; ++j)
#pragma unroll
                    for (int r = 0; r < 16; ++r) a[j][r] = 0.f;
#pragma unroll
                for (int ks = 0; ks < 4; ++ks)
#pragma unroll
                    for (int j = 0; j < 4; ++j) a[j] = __builtin_amdgcn_mfma_f32_32x32x16_bf16(qf[j][ks], kf[ks], a[j], 0, 0, 0);
                if (kt + 4 < ntile) {
#pragma unroll
                    for (int ks = 0; ks < 4; ++ks) kf[ks] = *(const GLB bf16x8*)(kp + (size_t)(32 * (kt + 4)) * 64 + 16 * ks);
                }
#pragma unroll
                for (int j = 0; j < 4; ++j) { float s = 0.f;
#pragma unroll
                    for (int r = 0; r < 16; ++r) s += w4[j][r >> 2][r & 3] * fmaxf(a[j][r], 0.f);
                    ((LAS float*)(C.lds + (4 * hw + j) * 17408))[hh * 2048 + 32 * kt + c] = s; }
            }
            arrive(); wait_all();
        }
        LDS_WAIT();
#pragma unroll 1
        for (int qs = 0; qs < 2; ++qs) {
            const int t = t0 + 2 * p + qs, n = t + 1;
            const LAS float* sq = sc + qs * 2048;
            unsigned myword_lo = 0u, myword_hi = 0u;
            if (n <= 256) {
#pragma unroll
                for (int i = 0; i < 4; ++i) { const unsigned long long bal = __ballot(lane + 64 * i < n); if (lane == i) { myword_lo = (unsigned)bal; myword_hi = (unsigned)(bal >> 32); } }
            } else {
                unsigned key[32];
#pragma unroll
                for (int i = 0; i < 32; ++i) { const int s = lane + 64 * i; key[i] = (s < n) ? ordkey(sq[s]) : 0u; }
                unsigned tau = 0u;
                for (int bit = 31; bit >= 0; --bit) {
                    const unsigned cand = tau | (1u << bit); int cl = 0;
#pragma unroll
                    for (int i = 0; i < 32; ++i) cl += (key[i] >= cand) ? 1 : 0;
                    const int cnt = wave_isum(cl);
                    if (cnt >= 256) { tau = cand; if (cnt == 256) break; }
                }
                int cgl = 0;
#pragma unroll
                for (int i = 0; i < 32; ++i) cgl += (key[i] > tau) ? 1 : 0;
                const int cgt = wave_isum(cgl);
                const int need = 256 - cgt; int eqbase = 0;
                const unsigned long long lt = (1ull << lane) - 1ull;
#pragma unroll
                for (int i = 0; i < 32; ++i) {
                    const bool gt = key[i] > tau, eq = key[i] == tau;
                    const unsigned long long beq = __ballot(eq);
                    const bool sel = gt || (eq && (eqbase + __popcll(beq & lt)) < need);
                    const unsigned long long bal = __ballot(sel);
                    if (lane == i) { myword_lo = (unsigned)bal; myword_hi = (unsigned)(bal >> 32); }
                    eqbase += __popcll(beq);
                }
            }
            if (lane < 32) { bm[(2 * p + qs) * 64 + 2 * lane] = myword_lo; bm[(2 * p + qs) * 64 + 2 * lane + 1] = myword_hi; }
        }
        LDS_WAIT();
    }
    const int cq = c >> 3, ch = c & 7;
    const GLB bf16_t* qp = WSP(bf16_t, WS_QD) + (bm0 + t0 + cq) * 1024 + ch * 128 + 8 * hh;
    bf16x8 qf[8];
#pragma unroll
    for (int ks = 0; ks < 8; ++ks) qf[ks] = *(const GLB bf16x8*)(qp + 16 * ks);
    const int km = 16 * ((c >> 2) & 1) + 4 * (c >> 3) + (c & 3);
    const GLB bf16_t* kbase = WSP(bf16_t, WS_KD) + (bm0 + km) * 128 + 8 * hh;
    const GLB bf16_t* vbase = WSP(bf16_t, WS_VDT) + ((size_t)b * 128 + c) * SEQ + 16 * hh;
    const LAS unsigned short* bmh = (const LAS unsigned short*)(bm + cq * 64) + hh;
    float mrun = -1.0e20f, lrun = 0.f;
    f32x16 O[4];
#pragma unroll
    for (int db = 0; db < 4; ++db)
#pragma unroll
        for (int r = 0; r < 16; ++r) O[db][r] = 0.f;
    const GLB char* kg = (const GLB char*)(WSP(bf16_t, WS_KD) + bm0 * 128);
    const GLB char* vg = (const GLB char*)(WSP(bf16_t, WS_VDT) + (size_t)b * 128 * SEQ);
    auto stage = [&](int kt) {
        LAS char* tb = (LAS char*)(C.lds + (4 * hw + kt % 3) * 17408);
#pragma unroll
        for (int i = 0; i < 2; ++i) { const int r = 8 * wq + 4 * i + (lane >> 4), pch = lane & 15, key = (r & 7) + 8 * (r >> 4);
            __builtin_amdgcn_global_load_lds((const GLB unsigned*)(kg + ((size_t)(32 * kt + r) * 256 + 16 * (pch ^ key))), (LAS unsigned*)(tb + (8 * wq + 4 * i) * 256), 16, 0, 0); }
#pragma unroll
        for (int i = 0; i < 2; ++i) { const int d = 32 * wq + 16 * i + (lane >> 2), pch = lane & 3, key = (d >> 2) & 3;
            __builtin_amdgcn_global_load_lds((const GLB unsigned*)(vg + ((size_t)d * (SEQ * 2) + 64 * kt + 16 * (pch ^ key))), (LAS unsigned*)(tb + 8192 + (32 * wq + 16 * i) * 64), 16, 0, 0); }
    };
    arrive(); wait_all();
    stage(0); if (ntile > 1) stage(1);
    arrive();
    const int kkey = (km & 7) + 8 * (km >> 4);
    for (int kt = 0; kt < ntile; ++kt) {
        wait_all();
        const LAS char* tb = (const LAS char*)(C.lds + (4 * hw + kt % 3) * 17408);
        bf16x8 kf[8], vf[2][4];
#pragma unroll
        for (int ks = 0; ks < 8; ++ks) kf[ks] = *(const LAS bf16x8*)(tb + km * 256 + 16 * ((hh + 2 * ks) ^ kkey));
#pragma unroll
        for (int s = 0; s < 2; ++s)
#pragma unroll
            for (int db = 0; db < 4; ++db) { const int d = c + 32 * db; vf[s][db] = *(const LAS bf16x8*)(tb + 8192 + d * 64 + 16 * ((2 * hh + s) ^ ((d >> 2) & 3))); }
        const unsigned bits = bmh[2 * kt];
        asm volatile("s_waitcnt lgkmcnt(0)" ::: "memory");
        if (kt + 2 < ntile) stage(kt + 2);
        f32x16 a;
#pragma unroll
        for (int r = 0; r < 16; ++r) a[r] = 0.f;
#pragma unroll
        for (int ks = 0; ks < 8; ++ks) a = __builtin_amdgcn_mfma_f32_32x32x16_bf16(kf[ks], qf[ks], a, 0, 0, 0);
        float tmax = -1.0e30f;
#pragma unroll
        for (int r = 0; r < 16; ++r) { a[r] = ((bits >> r) & 1u) ? a[r] * 0.08838834764831845f : -1.0e30f; tmax = fmaxf(tmax, a[r]); }
        tmax = fmaxf(tmax, __shfl_xor(tmax, 32));
        if (__ballot(tmax > mrun + 8.0f) != 0ull) {
            const float mnew = fmaxf(mrun, tmax), alpha = __expf(mrun - mnew);
            lrun *= alpha; mrun = mnew;
#pragma unroll
            for (int db = 0; db < 4; ++db)
#pragma unroll
                for (int r = 0; r < 16; ++r) O[db][r] *= alpha;
        }
        float psum = 0.f;
#pragma unroll
        for (int r = 0; r < 16; ++r) { a[r] = __expf(a[r] - mrun); psum += a[r]; }
        psum += __shfl_xor(psum, 32);
        lrun += psum;
#pragma unroll
        for (int s = 0; s < 2; ++s) {
            u32x4 t; t.x = pk2(a[8 * s], a[8 * s + 1]); t.y = pk2(a[8 * s + 2], a[8 * s + 3]); t.z = pk2(a[8 * s + 4], a[8 * s + 5]); t.w = pk2(a[8 * s + 6], a[8 * s + 7]);
            const bf16x8 pw = __builtin_bit_cast(bf16x8, t);
#pragma unroll
            for (int db = 0; db < 4; ++db) O[db] = __builtin_amdgcn_mfma_f32_32x32x16_bf16(vf[s][db], pw, O[db], 0, 0, 0);
        }
        arrive();
    }
    const float inv = 1.0f / lrun;
    GLB bf16_t* yp = WSP(bf16_t, WS_Y) + (bm0 + t0 + cq) * 4096 + 2048 + ch * 128 + 4 * hh;
#pragma unroll
    for (int db = 0; db < 4; ++db)
#pragma unroll
        for (int a4 = 0; a4 < 4; ++a4) { u32x2 o; o.x = pk2(O[db][4 * a4] * inv, O[db][4 * a4 + 1] * inv); o.y = pk2(O[db][4 * a4 + 2] * inv, O[db][4 * a4 + 3] * inv);
            *(GLB u32x2*)(yp + 32 * db + 8 * a4) = o; }
    LDS_WAIT();
}
__device__ __forceinline__ void ph_dsa_fast(const Ctx& C, int l) {
    int lane = C.lane; asm volatile("" : "+v"(lane)); lane &= 63;
    const int pi = blockIdx.x * 4 + (C.wave & 3);
    if (pi < 1024) { const int b = pi >> 8, j = pi & 255; dsa_item(C, lane, C.wave, b, (C.wave >> 2) ? 511 - j : j, l); }
}

constexpr int SCAN_CNT_OFF = MISC_OFF + 64;
__device__ __forceinline__ void ph_rwkv_scan_conv(const Ctx& C, int l) {
    int tid = C.tid; asm volatile("" : "+v"(tid));
    const int lane = tid & 63, wave = C.wave;
    if (wave >= 4) {
        LAS float* scr = (LAS float*)(C.lds + 65536 + (wave - 4) * 16640);
        constexpr int PER = MOE_CONV_ITEMS / 2 / 1024;
        const int first = l * (MOE_CONV_ITEMS / 2) + (blockIdx.x * 4 + (wave - 4)) * PER;
        if (!MOE_CONV_IN_PROLOGUE && blockIdx.x < 256)
            for (int i = 0; i < PER; ++i) conv_moe_item(C, first + i, scr, lane);
        return;
    }
    constexpr int CH = 16, CHF = CH * 384, NCH = SEQ / CH;
    LAS float* buf = (LAS float*)C.lds;
    volatile LAS unsigned* cnt = (volatile LAS unsigned*)(C.lds + SCAN_CNT_OFF);
    const int it = blockIdx.x;
    if (it >= NB * 16 * 4) return;
    const int qr = it & 3, h = (it >> 2) & 15, b = it >> 6;
    const size_t gbase = (size_t)b * SEQ * 1024 + h * 64;
    const int ro = lane >> 4, kq = lane & 15, row = 16 * qr + 4 * wave + ro;
    unsigned target = (unsigned)l * 4u * (NCH + 1);
    auto issue = [&](int cidx) {
#pragma unroll
        for (int j = 0; j < 6; ++j) { const int i = wave + 4 * j, rho = 4 * i + ro, step = rho / 6, vec = rho - 6 * step;
            const size_t off = (vec == 0) ? WS_R : (vec == 1) ? WS_DEC : (vec == 2) ? WS_K : (vec == 3) ? WS_KK : (vec == 4) ? WS_AA : WS_V;
            const GLB float* src = WSP(float, off) + gbase + (size_t)(cidx * CH + step) * 1024 + 4 * kq;
            __builtin_amdgcn_global_load_lds((const GLB unsigned*)src, (LAS unsigned*)(buf + (cidx & 1) * CHF + i * 256), 16, 0, 0); }
    };
    auto arrive_wait = [&]() {
        asm volatile("s_waitcnt vmcnt(0)" ::: "memory");
        target += 4u;
        if (lane == 0) (void)__hip_atomic_fetch_add((LAS unsigned*)(C.lds + SCAN_CNT_OFF), 1u, __ATOMIC_RELAXED, __HIP_MEMORY_SCOPE_WORKGROUP);
        while ((int)(*cnt - target) < 0) __builtin_amdgcn_s_sleep(1);
        asm volatile("" ::: "memory");
    };
    float S0 = 0.f, S1 = 0.f, S2 = 0.f, S3 = 0.f;
    issue(0); arrive_wait();
    for (int cidx = 0; cidx < NCH; ++cidx) {
        if (cidx + 1 < NCH) issue(cidx + 1);
        const LAS float* cb = buf + (cidx & 1) * CHF;
#pragma unroll 4
        for (int st = 0; st < CH; ++st) {
            const LAS float* rb = cb + st * 384;
            const f32x4 kk4 = *(const LAS f32x4*)(rb + 192 + 4 * kq);
            const float p = row16_sum(S0 * kk4[0] + S1 * kk4[1] + S2 * kk4[2] + S3 * kk4[3]);
            const f32x4 w4 = *(const LAS f32x4*)(rb + 64 + 4 * kq), b4 = *(const LAS f32x4*)(rb + 256 + 4 * kq), k4 = *(const LAS f32x4*)(rb + 128 + 4 * kq), r4 = *(const LAS f32x4*)(rb + 4 * kq);
            const float vv = rb[320 + row];
            S0 = S0 * w4[0] - p * b4[0] + vv * k4[0]; S1 = S1 * w4[1] - p * b4[1] + vv * k4[1]; S2 = S2 * w4[2] - p * b4[2] + vv * k4[2]; S3 = S3 * w4[3] - p * b4[3] + vv * k4[3];
            const float y = row16_sum(S0 * r4[0] + S1 * r4[1] + S2 * r4[2] + S3 * r4[3]);
            if (kq == 0) WSP(float, WS_YRAW)[gbase + (size_t)(cidx * CH + st) * 1024 + row] = y;
        }
        asm volatile("s_waitcnt lgkmcnt(0)" ::: "memory");
        arrive_wait();
    }
}

#ifndef SCAN3_CONV_MODE
#define SCAN3_CONV_MODE 0
#endif
#ifndef CONV_NT
#define CONV_NT 0
#endif
__device__ __forceinline__ void conv_tile_load(const GLB float* W, int ldw, int k0, int s0, f32x4 (&v)[16], int lane) {
    const int cq = lane & 15, rq = lane >> 4;
    const unsigned loff = (unsigned)(rq * ldw + 4 * cq);
    const GLB float* base = W + (size_t)k0 * ldw + s0;
#pragma unroll
    for (int i = 0; i < 16; ++i) { const GLB float* rowp = base + (size_t)(4 * i) * ldw; v[i] = CONV_NT ? __builtin_nontemporal_load((const GLB f32x4*)(rowp + loff)) : *(const GLB f32x4*)(rowp + loff); }
}
__device__ __forceinline__ void conv_tile_to_lds(const f32x4 (&v)[16], LAS float* scr, int lane) {
    const int cq = lane & 15, rq = lane >> 4;
#pragma unroll
    for (int i = 0; i < 16; ++i) { const int kk = 4 * i + rq; LAS float* d = scr + kk * 65 + 4 * cq; d[0] = v[i][0]; d[1] = v[i][1]; d[2] = v[i][2]; d[3] = v[i][3]; }
}
__device__ __forceinline__ void conv_tile_from_lds(GLB bf16_t* Bt, int K, int n0, int k0, LAS float* scr, int lane) {
    const int c = lane & 7;
#pragma unroll
    for (int j = 0; j < 8; ++j) { const int n = (lane >> 3) + 8 * j; const LAS float* s = scr + (8 * c) * 65 + n;
        u32x4 o; o.x = pk2(s[0 * 65], s[1 * 65]); o.y = pk2(s[2 * 65], s[3 * 65]); o.z = pk2(s[4 * 65], s[5 * 65]); o.w = pk2(s[6 * 65], s[7 * 65]);
        if (CONV_NT & 2) __builtin_nontemporal_store(o, (GLB u32x4*)(Bt + (size_t)(n0 + n) * K + k0 + 8 * c)); else *(GLB u32x4*)(Bt + (size_t)(n0 + n) * K + k0 + 8 * c) = o; }
}
__device__ __forceinline__ void conv_tile_finish(const f32x4 (&v)[16], GLB bf16_t* Bt, int K, int n0, int k0, LAS float* scr, int lane) {
    conv_tile_to_lds(v, scr, lane); LDS_WAIT(); conv_tile_from_lds(Bt, K, n0, k0, scr, lane); LDS_WAIT();
}
struct MoeTile { const GLB float* W; GLB bf16_t* Bt; int ldw, K, k0, s0, n0; };
__device__ __forceinline__ MoeTile moe_tile_desc(const Ctx& C, int idx) {
    constexpr int I_GU1 = (D / 64) * (2 * FF / 64), I_DN1 = (FF / 64) * (D / 64);
    MoeTile t;
    if (idx < NE * I_GU1) {
        const int e = idx / I_GU1, r = idx % I_GU1, nb = r % (2 * FF / 64), kb = r / (2 * FF / 64), tile = nb >> 2, q = nb & 3;
        t.W = ((q < 2) ? INF32(I_MG) : INF32(I_MU)) + (size_t)e * D * FF; t.ldw = FF; t.k0 = 64 * kb; t.s0 = 128 * tile + 64 * (q & 1);
        t.Bt = WSP(bf16_t, WS_MWGU) + (size_t)e * 2 * FF * D; t.K = D; t.n0 = 64 * nb;
    } else {
        const int r0 = idx - NE * I_GU1, e = r0 / I_DN1, r = r0 % I_DN1, nb = r % 32, kb = r / 32;
        t.W = INF32(I_MD) + (size_t)e * FF * D; t.ldw = D; t.k0 = 64 * kb; t.s0 = 64 * nb; t.Bt = WSP(bf16_t, WS_MWD) + (size_t)e * D * FF; t.K = FF; t.n0 = 64 * nb;
    }
    return t;
}
__device__ __forceinline__ void ph_rwkv_scan4(const Ctx& C, int l) {
    int tid = C.tid; asm volatile("" : "+v"(tid));
    const int lane = tid & 63, wave = C.wave;
    if (wave >= 4) {
        if (MOE_CONV_IN_PROLOGUE || blockIdx.x >= 256) return;
        LAS float* scr = (LAS float*)(C.lds + 65536 + (wave - 4) * 16640);
        constexpr int PER = MOE_CONV_ITEMS / 2 / 1024;
        const int first = l * (MOE_CONV_ITEMS / 2) + (blockIdx.x * 4 + (wave - 4)) * PER;
        f32x4 va[16], vb[16];
        MoeTile ta = moe_tile_desc(C, first), tb;
        conv_tile_load(ta.W, ta.ldw, ta.k0, ta.s0, va, lane);
        for (int i = 0; i < PER; i += 2) {
            tb = moe_tile_desc(C, first + i + 1);
            conv_tile_load(tb.W, tb.ldw, tb.k0, tb.s0, vb, lane);
            conv_tile_finish(va, ta.Bt, ta.K, ta.n0, ta.k0, scr, lane);
            if (i + 2 < PER) { ta = moe_tile_desc(C, first + i + 2); conv_tile_load(ta.W, ta.ldw, ta.k0, ta.s0, va, lane); }
            conv_tile_finish(vb, tb.Bt, tb.K, tb.n0, tb.k0, scr, lane);
        }
        return;
    }
    constexpr int CH = 16, CHF = CH * 384, NCH = SEQ / CH;
    LAS float* buf = (LAS float*)C.lds;
    LAS float* ybuf = (LAS float*)(C.lds + 49152);
    volatile LAS unsigned* cnt = (volatile LAS unsigned*)(C.lds + SCAN_CNT_OFF);
    const int it = blockIdx.x;
    if (it >= NB * 16 * 4) return;
    const int qr = it & 3, h = (it >> 2) & 15, b = it >> 6;
    const size_t gbase = (size_t)b * SEQ * 1024 + h * 64;
    const int ro = lane >> 4, kq = lane & 15, rloc = 4 * wave + ro;
    unsigned target = (unsigned)l * 4u * (NCH + 1);
    auto issue = [&](int cidx) {
#pragma unroll
        for (int j = 0; j < 6; ++j) { const int i = wave + 4 * j, rho = 4 * i + ro, step = rho / 6, vec = rho - 6 * step;
            const size_t off = (vec == 0) ? WS_R : (vec == 1) ? WS_DEC : (vec == 2) ? WS_K : (vec == 3) ? WS_KK : (vec == 4) ? WS_AA : WS_V;
            const GLB float* src = WSP(float, off) + gbase + (size_t)(cidx * CH + step) * 1024 + 4 * kq;
            __builtin_amdgcn_global_load_lds((const GLB unsigned*)src, (LAS unsigned*)(buf + (cidx & 1) * CHF + i * 256), 16, 0, 0); }
    };
    auto arrive_wait = [&]() {
        asm volatile("s_waitcnt vmcnt(0) lgkmcnt(0)" ::: "memory");
        target += 4u;
        if (lane == 0) (void)__hip_atomic_fetch_add((LAS unsigned*)(C.lds + SCAN_CNT_OFF), 1u, __ATOMIC_RELAXED, __HIP_MEMORY_SCOPE_WORKGROUP);
        while ((int)(*cnt - target) < 0) __builtin_amdgcn_s_sleep(1);
        asm volatile("" ::: "memory");
    };
    auto flush_y = [&](int cidx) {
        const int st = lane >> 2, r = lane & 3;
        WSP(float, WS_YRAW)[gbase + (size_t)(cidx * CH + st) * 1024 + 16 * qr + 4 * wave + r] = ybuf[(cidx & 1) * 256 + st * 16 + 4 * wave + r];
    };
    f32x2 Sa = {0.f, 0.f}, Sb = {0.f, 0.f};
    issue(0); arrive_wait();
    for (int cidx = 0; cidx < NCH; ++cidx) {
        if (cidx > 0) flush_y(cidx - 1);
        if (cidx + 1 < NCH) issue(cidx + 1);
        const LAS float* cb = buf + (cidx & 1) * CHF;
        LAS float* yb = ybuf + (cidx & 1) * 256;
#pragma unroll 4
        for (int st = 0; st < CH; ++st) {
            const LAS float* rb = cb + st * 384;
            const f32x4 kk4 = *(const LAS f32x4*)(rb + 192 + 4 * kq);
            const f32x2 tp = Sa * (f32x2){kk4[0], kk4[1]} + Sb * (f32x2){kk4[2], kk4[3]};
            const float p = row16_sum(tp[0] + tp[1]);
            const f32x4 w4 = *(const LAS f32x4*)(rb + 64 + 4 * kq), b4 = *(const LAS f32x4*)(rb + 256 + 4 * kq), k4 = *(const LAS f32x4*)(rb + 128 + 4 * kq), r4 = *(const LAS f32x4*)(rb + 4 * kq);
            const float vv = rb[320 + 16 * qr + rloc];
            const f32x2 pp = {p, p}, vv2 = {vv, vv};
            Sa = Sa * (f32x2){w4[0], w4[1]} - pp * (f32x2){b4[0], b4[1]} + vv2 * (f32x2){k4[0], k4[1]};
            Sb = Sb * (f32x2){w4[2], w4[3]} - pp * (f32x2){b4[2], b4[3]} + vv2 * (f32x2){k4[2], k4[3]};
            const f32x2 ty = Sa * (f32x2){r4[0], r4[1]} + Sb * (f32x2){r4[2], r4[3]};
            const float y = row16_sum(ty[0] + ty[1]);
            if (kq == 0) yb[st * 16 + rloc] = y;
        }
        arrive_wait();
    }
    flush_y(NCH - 1);
}

#ifndef SCAN_TOUCH
#define SCAN_TOUCH 1
#endif
#ifndef SCAN_SCHED
#define SCAN_SCHED 1
#endif
#ifndef SCAN_UNROLL
#define SCAN_UNROLL 4
#endif
__device__ __forceinline__ void ph_rwkv_scan3(const Ctx& C, int l) {
    int tid = C.tid; asm volatile("" : "+v"(tid));
    const int lane = tid & 63, wave = C.wave;
    constexpr int CH = 16, CHF = CH * 384, NCH = SEQ / CH;
    LAS float* buf = (LAS float*)C.lds;
    LAS float* ybuf = (LAS float*)(C.lds + 49152);
    LAS float* scr = (LAS float*)(C.lds + 65536 + (wave & 3) * 16640);
    const int it = blockIdx.x;
    if (it >= NB * 16 * 4) return;
    const int qr = it & 3, h = (it >> 2) & 15, b = it >> 6;
    const size_t gbase = (size_t)b * SEQ * 1024 + h * 64;
    const int ro = lane >> 4, kq = lane & 15, rloc = 4 * (wave & 3) + ro;
    const int lj = tid - 256;
    constexpr int PER = MOE_CONV_ITEMS / 2 / 1024;
    static_assert(PER * 1024 * 2 == MOE_CONV_ITEMS && PER * 3 <= NCH, "conversion slots");
    const int cfirst = l * (MOE_CONV_ITEMS / 2) + (blockIdx.x * 4 + (wave & 3)) * PER;
    auto load_chunk = [&](int cidx) {
        f32x4 v[6];
#pragma unroll
        for (int i = 0; i < 6; ++i) { const int idx = lj + 256 * i, step = idx / 96, rem = idx - step * 96, vec = rem >> 4, e4 = rem & 15;
            const size_t off = (vec == 0) ? WS_R : (vec == 1) ? WS_DEC : (vec == 2) ? WS_K : (vec == 3) ? WS_KK : (vec == 4) ? WS_AA : WS_V;
            v[i] = *(const GLB f32x4*)(WSP(float, off) + gbase + (size_t)(cidx * CH + step) * 1024 + 4 * e4); }
        LAS float* d = buf + (cidx & 1) * CHF;
#pragma unroll
        for (int i = 0; i < 6; ++i) { const int idx = lj + 256 * i, step = idx / 96, rem = idx - step * 96; *(LAS f32x4*)(d + step * 384 + rem * 4) = v[i]; }
    };
    auto flush_y = [&](int cidx) {
        const int st = lj >> 4, r = lj & 15;
        WSP(float, WS_YRAW)[gbase + (size_t)(cidx * CH + st) * 1024 + 16 * qr + r] = ybuf[(cidx & 1) * 256 + lj];
    };
    f32x2 Sa = {0.f, 0.f}, Sb = {0.f, 0.f};
    f32x4 cv[16]; MoeTile ct; ct.W = nullptr; ct.Bt = nullptr; ct.ldw = 0; ct.K = 0; ct.k0 = 0; ct.s0 = 0; ct.n0 = 0;
#pragma unroll
    for (int i = 0; i < 16; ++i) cv[i] = (f32x4){0.f, 0.f, 0.f, 0.f};
    if (wave >= 4) load_chunk(0);
    LDS_WAIT(); __syncthreads();
    for (int cidx = 0; cidx < NCH; ++cidx) {
        if (wave >= 4) {
            if (cidx + 1 < NCH) load_chunk(cidx + 1);
            if (cidx > 0) flush_y(cidx - 1);
            if (!MOE_CONV_IN_PROLOGUE) {
                const int q3 = cidx / 3, r3 = cidx - 3 * q3;
                if (r3 == 0 && q3 < PER) { ct = moe_tile_desc(C, cfirst + q3); conv_tile_load(ct.W, ct.ldw, ct.k0, ct.s0, cv, lane); }
                else if (r3 == 1 && q3 < PER) conv_tile_finish(cv, ct.Bt, ct.K, ct.n0, ct.k0, scr, lane);
            }
        } else {
            const LAS float* cb = buf + (cidx & 1) * CHF;
            LAS float* yb = ybuf + (cidx & 1) * 256;
            __builtin_amdgcn_s_setprio(3);
#pragma unroll SCAN_UNROLL
            for (int st = 0; st < CH; ++st) {
                const LAS float* rb = cb + st * 384;
                const f32x4 kk4 = *(const LAS f32x4*)(rb + 192 + 4 * kq);
                const f32x2 tp = Sa * (f32x2){kk4[0], kk4[1]} + Sb * (f32x2){kk4[2], kk4[3]};
                const float p = row16_sum(tp[0] + tp[1]);
                const f32x4 w4 = *(const LAS f32x4*)(rb + 64 + 4 * kq), b4 = *(const LAS f32x4*)(rb + 256 + 4 * kq), k4 = *(const LAS f32x4*)(rb + 128 + 4 * kq), r4 = *(const LAS f32x4*)(rb + 4 * kq);
                const float vv = rb[320 + 16 * qr + rloc];
                const f32x2 pp = {p, p}, vv2 = {vv, vv};
                Sa = Sa * (f32x2){w4[0], w4[1]} - pp * (f32x2){b4[0], b4[1]} + vv2 * (f32x2){k4[0], k4[1]};
                Sb = Sb * (f32x2){w4[2], w4[3]} - pp * (f32x2){b4[2], b4[3]} + vv2 * (f32x2){k4[2], k4[3]};
                const f32x2 ty = Sa * (f32x2){r4[0], r4[1]} + Sb * (f32x2){r4[2], r4[3]};
                const float y = row16_sum(ty[0] + ty[1]);
                if (kq == 0) yb[st * 16 + rloc] = y;
            }
            __builtin_amdgcn_s_setprio(0);
        }
        LDS_WAIT(); __builtin_amdgcn_s_barrier(); asm volatile("" ::: "memory");
    }
    if (wave >= 4) flush_y(NCH - 1);
}


template <int CONV>
__device__ __forceinline__ void ph_rwkv_scan5(const Ctx& C, int l) {
    int tid = C.tid; asm volatile("" : "+v"(tid));
    const int lane = tid & 63, wave = C.wave;
    constexpr int CH = 16, CHF = CH * 384, NCH = SEQ / CH;
    LAS float* buf = (LAS float*)C.lds;
    LAS float* ybuf = (LAS float*)(C.lds + 49152);
    const int it = blockIdx.x;
    if (it >= NB * 16 * 4) return;
    const int qr = it & 3, h = (it >> 2) & 15, b = it >> 6;
    const size_t gbase = (size_t)b * SEQ * 1024 + h * 64;
#define SCAN5_BAR() do { LDS_WAIT(); __builtin_amdgcn_s_barrier(); asm volatile("" ::: "memory"); } while (0)
    if (wave >= 4) {
        LAS float* scr = (LAS float*)(C.lds + 65536 + (wave & 3) * 16640);
        const int lj = tid - 256;
        constexpr int PER = MOE_SCAN_TILES;
        static_assert(PER * 1024 * 2 <= MOE_CONV_ITEMS && PER * 3 + 2 <= NCH && PER % 2 == 0, "conversion slots");
        const int cfirst = ((CONV >= 2) ? 1 : l) * (1024 * PER) + (blockIdx.x * 4 + (wave & 3));
        f32x4 nx[5];
        const unsigned lo_g = (unsigned)((lj >> 4) * 1024 + 4 * (lj & 15));
        const int lo_l = (lj >> 4) * 384 + 4 * (lj & 15);
        const f32x4 kkw = *(const GLB f32x4*)(INF32(I_RWKK) + l * 1024 + h * 64 + 4 * (lj & 15)), kaw = *(const GLB f32x4*)(INF32(I_RWKA) + l * 1024 + h * 64 + 4 * (lj & 15));
        u32x2 nb[4];
        auto fetch_chunk = [&](int cidx) {
            nx[1] = *(const GLB f32x4*)(WSP(float, WS_DEC) + gbase + (size_t)(cidx * CH) * 1024 + lo_g);
#pragma unroll
            for (int i = 0; i < 4; ++i) { const size_t off = (i == 0) ? WS_R : (i == 1) ? WS_K : (i == 2) ? WS_AA : WS_V;
                nb[i] = *(const GLB u32x2*)(WSP(bf16_t, off) + gbase + (size_t)(cidx * CH) * 1024 + lo_g); }
        };
        auto put_chunk = [&](int cidx) {
            LAS float* d = buf + (cidx & 1) * CHF + lo_l;
            asm volatile("" : "+v"(nx[1]), "+v"(nb[0]), "+v"(nb[1]), "+v"(nb[2]), "+v"(nb[3]));
            nx[0] = (f32x4){bflo(nb[0].x), bfhi(nb[0].x), bflo(nb[0].y), bfhi(nb[0].y)}; nx[4] = (f32x4){bflo(nb[3].x), bfhi(nb[3].x), bflo(nb[3].y), bfhi(nb[3].y)};
            const f32x4 kr = (f32x4){bflo(nb[1].x), bfhi(nb[1].x), bflo(nb[1].y), bfhi(nb[1].y)}, av = (f32x4){bflo(nb[2].x), bfhi(nb[2].x), bflo(nb[2].y), bfhi(nb[2].y)};
            f32x4 kk = kr * kkw;
            const float ss = row16_sum((kk[0] * kk[0] + kk[1] * kk[1]) + (kk[2] * kk[2] + kk[3] * kk[3]));
            kk = kk * (1.0f / fmaxf(sqrtf(ss), 1e-12f));
            *(LAS f32x4*)(d) = nx[0]; *(LAS f32x4*)(d + 64) = nx[1]; *(LAS f32x4*)(d + 128) = kr * (1.0f + (av - 1.0f) * kaw);
            *(LAS f32x4*)(d + 192) = kk; *(LAS f32x4*)(d + 256) = kk * av; *(LAS f32x4*)(d + 320) = nx[4];
        };
        auto flush_y = [&](int cidx) {
            const int st = lj >> 4, r = lj & 15;
            WSP(float, WS_YRAW)[gbase + (size_t)(cidx * CH + st) * 1024 + 16 * qr + r] = ybuf[(cidx & 1) * 256 + lj];
        };
#if SCAN_SCHED == 4
        struct FS { f32x4 dec; u32x2 nb[4]; };
        FS fs[6];
        auto fetch2 = [&](int cidx, FS& f) {
            f.dec = *(const GLB f32x4*)(WSP(float, WS_DEC) + gbase + (size_t)(cidx * CH) * 1024 + lo_g);
#pragma unroll
            for (int i = 0; i < 4; ++i) { const size_t off = (i == 0) ? WS_R : (i == 1) ? WS_K : (i == 2) ? WS_AA : WS_V;
                f.nb[i] = *(const GLB u32x2*)(WSP(bf16_t, off) + gbase + (size_t)(cidx * CH) * 1024 + lo_g); }
        };
        auto put2 = [&](int cidx, FS& f) {
            LAS float* d = buf + (cidx & 1) * CHF + lo_l;
            asm volatile("" : "+v"(f.dec), "+v"(f.nb[0]), "+v"(f.nb[1]), "+v"(f.nb[2]), "+v"(f.nb[3]));
            const f32x4 rr = (f32x4){bflo(f.nb[0].x), bfhi(f.nb[0].x), bflo(f.nb[0].y), bfhi(f.nb[0].y)}, vv = (f32x4){bflo(f.nb[3].x), bfhi(f.nb[3].x), bflo(f.nb[3].y), bfhi(f.nb[3].y)};
            const f32x4 kr = (f32x4){bflo(f.nb[1].x), bfhi(f.nb[1].x), bflo(f.nb[1].y), bfhi(f.nb[1].y)}, av = (f32x4){bflo(f.nb[2].x), bfhi(f.nb[2].x), bflo(f.nb[2].y), bfhi(f.nb[2].y)};
            f32x4 kk = kr * kkw;
            const float ss = row16_sum((kk[0] * kk[0] + kk[1] * kk[1]) + (kk[2] * kk[2] + kk[3] * kk[3]));
            kk = kk * (1.0f / fmaxf(sqrtf(ss), 1e-12f));
            *(LAS f32x4*)(d) = rr; *(LAS f32x4*)(d + 64) = f.dec; *(LAS f32x4*)(d + 128) = kr * (1.0f + (av - 1.0f) * kaw);
            *(LAS f32x4*)(d + 192) = kk; *(LAS f32x4*)(d + 256) = kk * av; *(LAS f32x4*)(d + 320) = vv;
        };
        f32x4 cv[16]; MoeTile ct; ct.W = nullptr; ct.Bt = nullptr; ct.ldw = 0; ct.K = 0; ct.k0 = 0; ct.s0 = 0; ct.n0 = 0;
#pragma unroll
        for (int i = 0; i < 16; ++i) cv[i] = (f32x4){0.f, 0.f, 0.f, 0.f};
        {
            const int vit = blockIdx.x * 4 + (wave & 3);
            if (vit < 512) { const int sb = vit & 31, hd = (vit >> 5) & 1, vb = (vit >> 6) & 3;
                if ((vit >> 8) == 0) vt_tile(WSP(bf16_t, WS_VS) + ((size_t)vb * SEQ + 64 * sb) * 128 + 64 * hd, 128, WSP(bf16_t, WS_SWVT) + ((size_t)(vb * 2 + hd) * 64) * SEQ + 64 * sb, (LAS bf16_t*)scr, lane);
                else vt_tile(WSP(bf16_t, WS_VD) + ((size_t)vb * SEQ + 64 * sb) * 128 + 64 * hd, 128, WSP(bf16_t, WS_VDT) + ((size_t)vb * 128 + 64 * hd) * SEQ + 64 * sb, (LAS bf16_t*)scr, lane); }
        }
        static_assert(PER * 3 + 2 == NCH && PER % 2 == 0, "period schedule");
        const int off = (int)((blockIdx.x * 4u + (unsigned)(wave & 3)) & 1u);
        fetch2(0, fs[0]); put2(0, fs[0]); fetch2(1, fs[0]);
        SCAN5_BAR();
        int c = 0;
        for (; c < 1 + off; ++c) { put2(c + 1, fs[0]); fetch2(c + 2, fs[0]); if (c > 0) flush_y(c - 1); SCAN5_BAR(); }
#pragma unroll
        for (int i = 1; i < 6; ++i) fetch2(c + 1 + i, fs[i]);
        asm volatile("; MARK scan5 periodic begin");
        auto period = [&](int j6, bool first) {
#pragma unroll
            for (int m6 = 0; m6 < 6; ++m6) {
                asm volatile("; MARK m6 iter");
                put2(c + 1, fs[m6]); fetch2(c + 7 < NCH ? c + 7 : NCH - 1, fs[m6]); flush_y(c - 1);
                if (!MOE_CONV_IN_PROLOGUE && CONV) {
                    if (m6 == 0) { if (!first) conv_tile_finish(cv, ct.Bt, ct.K, ct.n0, ct.k0, scr, lane);
                        ct = moe_tile_desc(C, cfirst + 1024 * (2 * j6)); conv_tile_load(ct.W, ct.ldw, ct.k0, ct.s0, cv, lane); }
                    if (m6 == 3 && !first) { const MoeTile cb = moe_tile_desc(C, cfirst + 1024 * (2 * j6 - 1)); conv_tile_from_lds(cb.Bt, cb.K, cb.n0, cb.k0, scr, lane); }
                }
                SCAN5_BAR(); ++c;
            }
        };
        period(0, true);
        for (int j6 = 1; j6 < PER / 2; ++j6) period(j6, false);
        asm volatile("; MARK scan5 periodic end");
        for (; c < NCH; ++c) { flush_y(c - 1); SCAN5_BAR(); }
        if (!MOE_CONV_IN_PROLOGUE && CONV) {
            conv_tile_finish(cv, ct.Bt, ct.K, ct.n0, ct.k0, scr, lane);
            SCAN5_BAR();
            SCAN5_BAR();
            { const MoeTile cb = moe_tile_desc(C, cfirst + 1024 * (PER - 1)); conv_tile_from_lds(cb.Bt, cb.K, cb.n0, cb.k0, scr, lane); }
        }
#elif SCAN_SCHED == 3
        struct FS { f32x4 dec; u32x2 nb[4]; };
        FS fs[6];
        auto fetch2 = [&](int cidx, FS& f) {
            f.dec = *(const GLB f32x4*)(WSP(float, WS_DEC) + gbase + (size_t)(cidx * CH) * 1024 + lo_g);
#pragma unroll
            for (int i = 0; i < 4; ++i) { const size_t off = (i == 0) ? WS_R : (i == 1) ? WS_K : (i == 2) ? WS_AA : WS_V;
                f.nb[i] = *(const GLB u32x2*)(WSP(bf16_t, off) + gbase + (size_t)(cidx * CH) * 1024 + lo_g); }
        };
        auto put2 = [&](int cidx, FS& f) {
            LAS float* d = buf + (cidx & 1) * CHF + lo_l;
            asm volatile("" : "+v"(f.dec), "+v"(f.nb[0]), "+v"(f.nb[1]), "+v"(f.nb[2]), "+v"(f.nb[3]));
            const f32x4 rr = (f32x4){bflo(f.nb[0].x), bfhi(f.nb[0].x), bflo(f.nb[0].y), bfhi(f.nb[0].y)}, vv = (f32x4){bflo(f.nb[3].x), bfhi(f.nb[3].x), bflo(f.nb[3].y), bfhi(f.nb[3].y)};
            const f32x4 kr = (f32x4){bflo(f.nb[1].x), bfhi(f.nb[1].x), bflo(f.nb[1].y), bfhi(f.nb[1].y)}, av = (f32x4){bflo(f.nb[2].x), bfhi(f.nb[2].x), bflo(f.nb[2].y), bfhi(f.nb[2].y)};
            f32x4 kk = kr * kkw;
            const float ss = row16_sum((kk[0] * kk[0] + kk[1] * kk[1]) + (kk[2] * kk[2] + kk[3] * kk[3]));
            kk = kk * (1.0f / fmaxf(sqrtf(ss), 1e-12f));
            *(LAS f32x4*)(d) = rr; *(LAS f32x4*)(d + 64) = f.dec; *(LAS f32x4*)(d + 128) = kr * (1.0f + (av - 1.0f) * kaw);
            *(LAS f32x4*)(d + 192) = kk; *(LAS f32x4*)(d + 256) = kk * av; *(LAS f32x4*)(d + 320) = vv;
        };
        f32x4 cv[16]; MoeTile ct; ct.W = nullptr; ct.Bt = nullptr; ct.ldw = 0; ct.K = 0; ct.k0 = 0; ct.s0 = 0; ct.n0 = 0;
#pragma unroll
        for (int i = 0; i < 16; ++i) cv[i] = (f32x4){0.f, 0.f, 0.f, 0.f};
        {
            const int vit = blockIdx.x * 4 + (wave & 3);
            if (vit < 512) { const int sb = vit & 31, hd = (vit >> 5) & 1, vb = (vit >> 6) & 3;
                if ((vit >> 8) == 0) vt_tile(WSP(bf16_t, WS_VS) + ((size_t)vb * SEQ + 64 * sb) * 128 + 64 * hd, 128, WSP(bf16_t, WS_SWVT) + ((size_t)(vb * 2 + hd) * 64) * SEQ + 64 * sb, (LAS bf16_t*)scr, lane);
                else vt_tile(WSP(bf16_t, WS_VD) + ((size_t)vb * SEQ + 64 * sb) * 128 + 64 * hd, 128, WSP(bf16_t, WS_VDT) + ((size_t)vb * 128 + 64 * hd) * SEQ + 64 * sb, (LAS bf16_t*)scr, lane); }
        }
        static_assert(PER * 3 + 2 == NCH && PER % 2 == 0, "period schedule");
        const int off = (int)((blockIdx.x * 4u + (unsigned)(wave & 3)) & 1u);
        fetch2(0, fs[0]); put2(0, fs[0]); fetch2(1, fs[0]);
        SCAN5_BAR();
        int c = 0;
        for (; c < 1 + off; ++c) { put2(c + 1, fs[0]); fetch2(c + 2, fs[0]); if (c > 0) flush_y(c - 1); SCAN5_BAR(); }
#pragma unroll
        for (int i = 1; i < 6; ++i) fetch2(c + 1 + i, fs[i]);
        asm volatile("; MARK scan5 periodic begin");
        auto period = [&](int j6, bool first) {
#pragma unroll
            for (int m6 = 0; m6 < 6; ++m6) {
                asm volatile("; MARK m6 iter");
                put2(c + 1, fs[m6]); fetch2(c + 7 < NCH ? c + 7 : NCH - 1, fs[m6]); flush_y(c - 1);
                if (!MOE_CONV_IN_PROLOGUE && CONV && (m6 == 0 || (m6 == 3 && CONV != 5))) {
                    if (!(first && m6 == 0)) { if (CONV == 1) conv_tile_finish(cv, ct.Bt, ct.K, ct.n0, ct.k0, scr, lane);
                        else { asm volatile("" :: "v"(cv[0]), "v"(cv[1]), "v"(cv[2]), "v"(cv[3]), "v"(cv[4]), "v"(cv[5]), "v"(cv[6]), "v"(cv[7])); asm volatile("" :: "v"(cv[8]), "v"(cv[9]), "v"(cv[10]), "v"(cv[11]), "v"(cv[12]), "v"(cv[13]), "v"(cv[14]), "v"(cv[15])); } }
                    ct = moe_tile_desc(C, cfirst + 1024 * (2 * j6 + (m6 == 3 ? 1 : 0))); conv_tile_load(ct.W, ct.ldw, ct.k0, ct.s0, cv, lane);
                }
                SCAN5_BAR(); ++c;
            }
        };
        period(0, true);
        for (int j6 = 1; j6 < PER / 2; ++j6) period(j6, false);
        asm volatile("; MARK scan5 periodic end");
        for (; c < NCH; ++c) { flush_y(c - 1); SCAN5_BAR(); }
        if (!MOE_CONV_IN_PROLOGUE && CONV == 1) conv_tile_finish(cv, ct.Bt, ct.K, ct.n0, ct.k0, scr, lane);
#elif SCAN_SCHED == 2
        struct FS { f32x4 dec; u32x2 nb[4]; };
        FS fs[2];
        auto fetch2 = [&](int cidx, FS& f) {
            f.dec = *(const GLB f32x4*)(WSP(float, WS_DEC) + gbase + (size_t)(cidx * CH) * 1024 + lo_g);
#pragma unroll
            for (int i = 0; i < 4; ++i) { const size_t off = (i == 0) ? WS_R : (i == 1) ? WS_K : (i == 2) ? WS_AA : WS_V;
                f.nb[i] = *(const GLB u32x2*)(WSP(bf16_t, off) + gbase + (size_t)(cidx * CH) * 1024 + lo_g); }
        };
        auto put2 = [&](int cidx, FS& f) {
            LAS float* d = buf + (cidx & 1) * CHF + lo_l;
            asm volatile("" : "+v"(f.dec), "+v"(f.nb[0]), "+v"(f.nb[1]), "+v"(f.nb[2]), "+v"(f.nb[3]));
            const f32x4 rr = (f32x4){bflo(f.nb[0].x), bfhi(f.nb[0].x), bflo(f.nb[0].y), bfhi(f.nb[0].y)}, vv = (f32x4){bflo(f.nb[3].x), bfhi(f.nb[3].x), bflo(f.nb[3].y), bfhi(f.nb[3].y)};
            const f32x4 kr = (f32x4){bflo(f.nb[1].x), bfhi(f.nb[1].x), bflo(f.nb[1].y), bfhi(f.nb[1].y)}, av = (f32x4){bflo(f.nb[2].x), bfhi(f.nb[2].x), bflo(f.nb[2].y), bfhi(f.nb[2].y)};
            f32x4 kk = kr * kkw;
            const float ss = row16_sum((kk[0] * kk[0] + kk[1] * kk[1]) + (kk[2] * kk[2] + kk[3] * kk[3]));
            kk = kk * (1.0f / fmaxf(sqrtf(ss), 1e-12f));
            *(LAS f32x4*)(d) = rr; *(LAS f32x4*)(d + 64) = f.dec; *(LAS f32x4*)(d + 128) = kr * (1.0f + (av - 1.0f) * kaw);
            *(LAS f32x4*)(d + 192) = kk; *(LAS f32x4*)(d + 256) = kk * av; *(LAS f32x4*)(d + 320) = vv;
        };
        f32x4 cv[16]; MoeTile ct; ct.W = nullptr; ct.Bt = nullptr; ct.ldw = 0; ct.K = 0; ct.k0 = 0; ct.s0 = 0; ct.n0 = 0;
#pragma unroll
        for (int i = 0; i < 16; ++i) cv[i] = (f32x4){0.f, 0.f, 0.f, 0.f};
        {
            const int vit = blockIdx.x * 4 + (wave & 3);
            if (vit < 512) { const int sb = vit & 31, hd = (vit >> 5) & 1, vb = (vit >> 6) & 3;
                if ((vit >> 8) == 0) vt_tile(WSP(bf16_t, WS_VS) + ((size_t)vb * SEQ + 64 * sb) * 128 + 64 * hd, 128, WSP(bf16_t, WS_SWVT) + ((size_t)(vb * 2 + hd) * 64) * SEQ + 64 * sb, (LAS bf16_t*)scr, lane);
                else vt_tile(WSP(bf16_t, WS_VD) + ((size_t)vb * SEQ + 64 * sb) * 128 + 64 * hd, 128, WSP(bf16_t, WS_VDT) + ((size_t)vb * 128 + 64 * hd) * SEQ + 64 * sb, (LAS bf16_t*)scr, lane); }
        }
        static_assert(PER * 3 + 2 == NCH && PER % 2 == 0, "period schedule");
        const int off = (int)((blockIdx.x * 4u + (unsigned)(wave & 3)) & 1u);
        fetch2(0, fs[0]); put2(0, fs[0]); fetch2(1, fs[0]);
        SCAN5_BAR();
        int c = 0;
        for (; c < 1 + off; ++c) { put2(c + 1, fs[0]); fetch2(c + 2, fs[0]); if (c > 0) flush_y(c - 1); SCAN5_BAR(); }
        fetch2(c + 2, fs[1]);
        asm volatile("; MARK scan5 periodic begin");
        auto period = [&](int j6, bool first) {
#pragma unroll
            for (int m6 = 0; m6 < 6; ++m6) {
                asm volatile("; MARK m6 iter");
                put2(c + 1, fs[m6 & 1]); fetch2(c + 3 < NCH ? c + 3 : NCH - 1, fs[m6 & 1]); flush_y(c - 1);
                if (!MOE_CONV_IN_PROLOGUE && CONV && (m6 == 0 || (m6 == 3 && CONV != 5))) {
                    if (!(first && m6 == 0)) {
                        if (CONV == 1 || CONV == 4) conv_tile_finish(cv, ct.Bt, ct.K, ct.n0, ct.k0, scr, lane);
                        else if (CONV == 3) { const int cc = lane & 7;
#pragma unroll
                            for (int j = 0; j < 8; ++j) { const int n = (lane >> 3) + 8 * j; u32x4 o; o.x = pk2(cv[2 * j][0], cv[2 * j][1]); o.y = pk2(cv[2 * j][2], cv[2 * j][3]); o.z = pk2(cv[2 * j + 1][0], cv[2 * j + 1][1]); o.w = pk2(cv[2 * j + 1][2], cv[2 * j + 1][3]);
                                *(GLB u32x4*)(ct.Bt + (size_t)(ct.n0 + n) * ct.K + ct.k0 + 8 * cc) = o; } }
                        else { asm volatile("" :: "v"(cv[0]), "v"(cv[1]), "v"(cv[2]), "v"(cv[3]), "v"(cv[4]), "v"(cv[5]), "v"(cv[6]), "v"(cv[7])); asm volatile("" :: "v"(cv[8]), "v"(cv[9]), "v"(cv[10]), "v"(cv[11]), "v"(cv[12]), "v"(cv[13]), "v"(cv[14]), "v"(cv[15])); }
                    }
                    ct = moe_tile_desc(C, cfirst + 1024 * (2 * j6 + (m6 == 3 ? 1 : 0))); conv_tile_load(ct.W, ct.ldw, ct.k0, ct.s0, cv, lane);
                }
                SCAN5_BAR(); ++c;
            }
        };
        period(0, true);
        for (int j6 = 1; j6 < PER / 2; ++j6) period(j6, false);
        asm volatile("; MARK scan5 periodic end");
        for (; c < NCH; ++c) { flush_y(c - 1); SCAN5_BAR(); }
        if (!MOE_CONV_IN_PROLOGUE && (CONV == 1 || CONV == 4)) conv_tile_finish(cv, ct.Bt, ct.K, ct.n0, ct.k0, scr, lane);
#elif SCAN_SCHED == 1
        f32x4 cv[16]; MoeTile ct; ct.W = nullptr; ct.Bt = nullptr; ct.ldw = 0; ct.K = 0; ct.k0 = 0; ct.s0 = 0; ct.n0 = 0;
#pragma unroll
        for (int i = 0; i < 16; ++i) cv[i] = (f32x4){0.f, 0.f, 0.f, 0.f};
        {
            const int vit = blockIdx.x * 4 + (wave & 3);
            if (vit < 512) { const int sb = vit & 31, hd = (vit >> 5) & 1, vb = (vit >> 6) & 3;
                if ((vit >> 8) == 0) vt_tile(WSP(bf16_t, WS_VS) + ((size_t)vb * SEQ + 64 * sb) * 128 + 64 * hd, 128, WSP(bf16_t, WS_SWVT) + ((size_t)(vb * 2 + hd) * 64) * SEQ + 64 * sb, (LAS bf16_t*)scr, lane);
                else vt_tile(WSP(bf16_t, WS_VD) + ((size_t)vb * SEQ + 64 * sb) * 128 + 64 * hd, 128, WSP(bf16_t, WS_VDT) + ((size_t)vb * 128 + 64 * hd) * SEQ + 64 * sb, (LAS bf16_t*)scr, lane); }
        }
        static_assert(PER * 3 + 2 == NCH && PER % 2 == 0, "period schedule");
        const int off = (int)((blockIdx.x * 4u + (unsigned)(wave & 3)) & 1u);
        auto plain = [&](int c) { if (c + 1 < NCH) put_chunk(c + 1); if (c + 2 < NCH) fetch_chunk(c + 2); if (c > 0) flush_y(c - 1); };
        auto plain_nc = [&](int c) { put_chunk(c + 1); fetch_chunk(c + 2 < NCH ? c + 2 : NCH - 1); flush_y(c - 1); };
        fetch_chunk(0); put_chunk(0); fetch_chunk(1);
        SCAN5_BAR();
        int c = 0;
        for (; c < 1 + off; ++c) { plain(c); SCAN5_BAR(); }
        asm volatile("; MARK scan5 periodic begin");
        auto period = [&](int j6) {
#pragma unroll
            for (int m6 = 0; m6 < 6; ++m6) {
                asm volatile("; MARK m6 iter");
                plain_nc(c);
                if (!MOE_CONV_IN_PROLOGUE && CONV) {
                    if (m6 == 0 || m6 == 3) { ct = moe_tile_desc(C, cfirst + 1024 * (2 * j6 + (m6 == 3 ? 1 : 0))); conv_tile_load(ct.W, ct.ldw, ct.k0, ct.s0, cv, lane); }
                    if (m6 == 2 || m6 == 5) conv_tile_finish(cv, ct.Bt, ct.K, ct.n0, ct.k0, scr, lane);
                }
                SCAN5_BAR(); ++c;
            }
        };
        period(0);
        for (int j6 = 1; j6 < PER / 2; ++j6) period(j6);
        asm volatile("; MARK scan5 periodic end");
        for (; c < NCH; ++c) { plain(c); SCAN5_BAR(); }
#else
        f32x4 cv[16], cv2[16]; MoeTile ct; ct.W = nullptr; ct.Bt = nullptr; ct.ldw = 0; ct.K = 0; ct.k0 = 0; ct.s0 = 0; ct.n0 = 0; MoeTile ct2 = ct;
#pragma unroll
        for (int i = 0; i < 16; ++i) { cv[i] = (f32x4){0.f, 0.f, 0.f, 0.f}; cv2[i] = cv[i]; }
        {
            const int vit = blockIdx.x * 4 + (wave & 3);
            if (vit < 512) { const int sb = vit & 31, hd = (vit >> 5) & 1, vb = (vit >> 6) & 3;
                if ((vit >> 8) == 0) vt_tile(WSP(bf16_t, WS_VS) + ((size_t)vb * SEQ + 64 * sb) * 128 + 64 * hd, 128, WSP(bf16_t, WS_SWVT) + ((size_t)(vb * 2 + hd) * 64) * SEQ + 64 * sb, (LAS bf16_t*)scr, lane);
                else vt_tile(WSP(bf16_t, WS_VD) + ((size_t)vb * SEQ + 64 * sb) * 128 + 64 * hd, 128, WSP(bf16_t, WS_VDT) + ((size_t)vb * 128 + 64 * hd) * SEQ + 64 * sb, (LAS bf16_t*)scr, lane); }
        }
        fetch_chunk(0); put_chunk(0); fetch_chunk(1);
        SCAN5_BAR();
        for (int cidx = 0; cidx < NCH; ++cidx) {
            if (cidx + 1 < NCH) put_chunk(cidx + 1);
            if (cidx + 2 < NCH) fetch_chunk(cidx + 2);
            if (cidx > 0) flush_y(cidx - 1);
            if (!MOE_CONV_IN_PROLOGUE) {
                const int j6 = cidx / 6, m6 = cidx - 6 * j6;
                if (m6 == 0 && 2 * j6 < PER) { ct = moe_tile_desc(C, cfirst + 1024 * (2 * j6)); conv_tile_load(ct.W, ct.ldw, ct.k0, ct.s0, cv, lane); }
                else if (m6 == 4 && 2 * j6 < PER) conv_tile_finish(cv, ct.Bt, ct.K, ct.n0, ct.k0, scr, lane);
                else if (m6 == 3 && 2 * j6 + 1 < PER) { ct2 = moe_tile_desc(C, cfirst + 1024 * (2 * j6 + 1)); conv_tile_load(ct2.W, ct2.ldw, ct2.k0, ct2.s0, cv2, lane); }
                else if (m6 == 1 && j6 >= 1 && 2 * j6 - 1 < PER) conv_tile_finish(cv2, ct2.Bt, ct2.K, ct2.n0, ct2.k0, scr, lane);
            }
            SCAN5_BAR();
        }
#endif
        flush_y(NCH - 1);
    } else {
        const int ro = lane >> 4, kq = lane & 15, rloc = 4 * wave + ro;
        f32x2 Sa = {0.f, 0.f}, Sb = {0.f, 0.f};
        constexpr bool CONVB = SCAN_SCHED == 4 && CONV == 1 && !MOE_CONV_IN_PROLOGUE;
        f32x4 cvB[16];
#pragma unroll
        for (int i = 0; i < 16; ++i) cvB[i] = (f32x4){0.f, 0.f, 0.f, 0.f};
        LAS float* scrp = (LAS float*)(C.lds + 65536 + wave * 16640);
        const int cfirstc = l * (1024 * MOE_SCAN_TILES) + (blockIdx.x * 4 + wave);
        int bj = 0, bnext = 2 + (int)((blockIdx.x * 4u + (unsigned)wave) & 1u);
        SCAN5_BAR();
        for (int cidx = 0; cidx < NCH; ++cidx) {
            if (CONVB && cidx == bnext) {
                if (bj >= 1) conv_tile_to_lds(cvB, scrp, lane);
                if (bj < MOE_SCAN_TILES / 2) { const MoeTile tb = moe_tile_desc(C, cfirstc + 1024 * (2 * bj + 1)); conv_tile_load(tb.W, tb.ldw, tb.k0, tb.s0, cvB, lane); }
                ++bj; bnext += 6;
            }
            const LAS float* cb = buf + (cidx & 1) * CHF + 4 * kq;
            const LAS float* vb = buf + (cidx & 1) * CHF + 320 + 16 * qr + rloc;
            float ykeep = 0.f;
            f32x4 kk4 = *(const LAS f32x4*)(cb + 192), w4 = *(const LAS f32x4*)(cb + 64), b4 = *(const LAS f32x4*)(cb + 256), k4 = *(const LAS f32x4*)(cb + 128), r4 = *(const LAS f32x4*)(cb);
            float vv = vb[0];
#pragma unroll
            for (int st = 0; st < CH; ++st) {
                f32x4 kk4n = kk4, w4n = w4, b4n = b4, k4n = k4, r4n = r4; float vvn = vv;
                if (st + 1 < CH) { const LAS float* nb = cb + (st + 1) * 384;
                    kk4n = *(const LAS f32x4*)(nb + 192); w4n = *(const LAS f32x4*)(nb + 64); b4n = *(const LAS f32x4*)(nb + 256); k4n = *(const LAS f32x4*)(nb + 128); r4n = *(const LAS f32x4*)(nb); vvn = vb[(st + 1) * 384]; }
                const f32x2 tp = Sa * (f32x2){kk4[0], kk4[1]} + Sb * (f32x2){kk4[2], kk4[3]};
                const float p = row16_sum(tp[0] + tp[1]);
                const f32x2 pp = {p, p}, vv2 = {vv, vv};
                Sa = Sa * (f32x2){w4[0], w4[1]} - pp * (f32x2){b4[0], b4[1]} + vv2 * (f32x2){k4[0], k4[1]};
                Sb = Sb * (f32x2){w4[2], w4[3]} - pp * (f32x2){b4[2], b4[3]} + vv2 * (f32x2){k4[2], k4[3]};
                const f32x2 ty = Sa * (f32x2){r4[0], r4[1]} + Sb * (f32x2){r4[2], r4[3]};
                const float y = row16_sum(ty[0] + ty[1]);
                ykeep = (kq == st) ? y : ykeep;
                kk4 = kk4n; w4 = w4n; b4 = b4n; k4 = k4n; r4 = r4n; vv = vvn;
            }
            ybuf[(cidx & 1) * 256 + kq * 16 + rloc] = ykeep;
            SCAN5_BAR();
        }
        if (CONVB) { SCAN5_BAR(); conv_tile_to_lds(cvB, scrp, lane); SCAN5_BAR(); }
    }
#undef SCAN5_BAR
}
struct Args { const void* in[N_INPUTS]; float* out; unsigned char* ws; int ph_lo, ph_hi; };
static_assert(sizeof(Args) == N_INPUTS * 8 + 24, "Args has no padding");

constexpr int N_PHASES = 2 + 12 + 14;

#ifndef USE_FAST
#define USE_FAST 271
#endif
#ifndef PROBE_CONV
#define PROBE_CONV 3
#endif
#ifndef PROBE_MASK
#define PROBE_MASK 0
#endif
#ifndef DBG_SKIP_MASK
#define DBG_SKIP_MASK 0
#endif

__global__ void __launch_bounds__(NTHR, 2) fwd_kernel(Args args) {
    extern __shared__ __attribute__((aligned(16))) unsigned char lds_raw[];
    LAS unsigned char* const lds = (LAS unsigned char*)lds_raw;
    {
        const int tid0 = threadIdx.x;
        volatile LAS unsigned* MISC0 = (volatile LAS unsigned*)(lds + MISC_OFF);
        for (int u = tid0; u < (LDS_BYTES - MISC_OFF) / 4; u += NTHR) MISC0[u] = 0u;
        __syncthreads();
        LAS unsigned long long* tab = (LAS unsigned long long*)(lds + INTAB_OFF);
        if (tid0 < N_INPUTS) tab[tid0] = (unsigned long long)args.in[tid0];
        if (tid0 == 64) { tab[TAB_WS] = (unsigned long long)args.ws; tab[TAB_OUT] = (unsigned long long)args.out;
            tab[TAB_RANGE] = ((unsigned long long)(unsigned)args.ph_hi << 32) | (unsigned)args.ph_lo; }
        __syncthreads();
        if (args.ph_hi - args.ph_lo > 1) (void)xcd_barrier_post((unsigned*)(args.ws + WS_CTL) + CW_BAR, MISC0 + 8);
    }
    LAS unsigned char* ring = lds;
    int ph = 0;
#define PH_BEGIN { const int lo = (int)__builtin_amdgcn_readfirstlane(((const LAS unsigned*)(lds + INTAB_OFF))[2 * TAB_RANGE]), hi = (int)__builtin_amdgcn_readfirstlane(((const LAS unsigned*)(lds + INTAB_OFF))[2 * TAB_RANGE + 1]); \
    if (ph >= lo && ph < hi) { const Ctx C = make_ctx(lds);
#define PH_END if (ph + 1 < hi) { XcdBarrier bar; bar.bar = (unsigned*)WSP(unsigned, WS_CTL) + CW_BAR; bar.x = xb_xcc_id(); bar.st = (volatile LAS unsigned*)(lds + MISC_OFF) + 8; xcd_barrier(bar); } \
    else { VM_WAIT(); __syncthreads(); } } } ++ph;
#define REP(g, ...) { GLB float* XOUT = C.out; (void)XOUT; __VA_ARGS__ } if (PROBE_MASK & (g)) { GLB float* XOUT = WSP(float, WS_SC); (void)XOUT; __VA_ARGS__ }

    PH_BEGIN REP(1,  ph_prologue(C); ph_norm<0, false>(C, INF32(I_X), nullptr, INF32(I_MIXN), nullptr); ) PH_END
    PH_BEGIN REP(256,  { pg8::Gemm g{WSP(bf16_t, WS_PCAT), WSP(bf16_t, WS_WPP), 512, 256}; pg8::ProjOrder S; S.init(C.G, (int)blockIdx.x); pg8::EpiProj E{WSP(bf16_t, WS_PROJ)};
        pg8::gemm_phase<pg8::EpiProj, pg8::ProjOrder>(ring, g, S, E); } ) PH_END

    { constexpr int l = 0;
        if (l > 0) { PH_BEGIN REP(32768,  ph_norm<0>(C, WSP(bf16_t, WS_XB), nullptr, INF32(I_MIXN) + l * D, nullptr); ) PH_END }
        PH_BEGIN REP(4096,  { pg8::Gemm g{WSP(bf16_t, WS_H), WSP(bf16_t, WS_WIN + l * SZ_WIN1), D, D}; pg8::StaticOrder S; S.init(T, N_INP, C.G, (int)blockIdx.x);
            pg8::EpiWin E{WSP(bf16_t, WS_SBQKV), WSP(bf16_t, WS_UF), WSP(bf16_t, WS_GATE)};
            pg8::gemm_phase<pg8::EpiWin, pg8::StaticOrder>(ring, g, S, E); } ) PH_END
        PH_BEGIN REP(16384,  ph_prep(C, l); ph_vt(C); ph_latent(C, l); ) PH_END
        PH_BEGIN REP(256,  { pg8::Gemm g{WSP(bf16_t, WS_ALORA), WSP(bf16_t, WS_WLORA + l * SZ_WLORA1), 256, 256}; pg8::StaticOrder S; S.init(T, 3072, C.G, (int)blockIdx.x);
            pg8::EpiLora E{WSP(float, WS_DEC), WSP(bf16_t, WS_AA), WSP(bf16_t, WS_GG), INF32(I_RWW0) + l * 1024, INF32(I_RWA0) + l * 1024};
            pg8::gemm_phase<pg8::EpiLora, pg8::StaticOrder>(ring, g, S, E); } ) PH_END
        PH_BEGIN REP(32,  if (!(DBG_SKIP_MASK & 2)) { if (USE_FAST & 256) { ph_rwkv_scan5<1>(C, l); if (PROBE_MASK & 2097152) ph_rwkv_scan5<0>(C, l); if ((PROBE_MASK & 4194304) && l == 0) ph_rwkv_scan5<PROBE_CONV>(C, l); } else if (USE_FAST & 128) ph_rwkv_scan4(C, l); else if (USE_FAST & 64) ph_rwkv_scan3(C, l); else if (USE_FAST & 32) ph_rwkv_scan_conv(C, l); else if (USE_FAST & 2) ph_rwkv_scan_fast(C); else ph_rwkv_scan_naive(C); } ) PH_END
        PH_BEGIN REP(8,  ph_sb_fast(C); ) REP(64,  ph_dsa_fast(C, l); ) REP(128,  ph_swa_fast(C, l); ) REP(65536,  ph_rwkv_post(C, l); ) PH_END
        PH_BEGIN REP(512,  { pg8::Gemm g{WSP(bf16_t, WS_Y), WSP(bf16_t, WS_WBR + l * SZ_WBR1), 4096, 1024}; pg8::BranchOrder S; S.init(C.G, (int)blockIdx.x);
            pg8::EpiBranch E{WSP(bf16_t, WS_GATE), WSP(bf16_t, WS_G)};
            pg8::gemm_phase<pg8::EpiBranch, pg8::BranchOrder>(ring, g, S, E); } ) PH_END
        PH_BEGIN { pg8::Gemm g{WSP(bf16_t, WS_G), WSP(bf16_t, WS_WOUT + l * SZ_DD), D, D}; pg8::StaticOrder S; S.init(T, D, C.G, (int)blockIdx.x);
            if (l == 0) { pg8::EpiResid<false, true> E{INF32(I_X), WSP(bf16_t, WS_XB)}; pg8::gemm_phase<pg8::EpiResid<false, true>, pg8::StaticOrder>(ring, g, S, E); }
            else { pg8::EpiResid<true, true> E{WSP(bf16_t, WS_XB), WSP(bf16_t, WS_XB)}; pg8::gemm_phase<pg8::EpiResid<true, true>, pg8::StaticOrder>(ring, g, S, E); } } PH_END
        PH_BEGIN if (l == 0) ph_norm<0>(C, WSP(bf16_t, WS_XB), nullptr, INF32(I_FFNN) + l * D, nullptr); else ph_norm<1>(C, WSP(bf16_t, WS_XB), nullptr, INF32(I_FFNN) + l * D, INF32(I_MR)); PH_END
        if (l == 0) {
            PH_BEGIN REP(2,  { pg8::Gemm g{WSP(bf16_t, WS_H), WSP(bf16_t, WS_WGU), D, D}; pg8::StaticOrder S; S.init(T, 2 * FF, C.G, (int)blockIdx.x); pg8::EpiUp E{WSP(bf16_t, WS_ACT)};
                pg8::gemm_phase<pg8::EpiUp, pg8::StaticOrder>(ring, g, S, E); } ) PH_END
            PH_BEGIN REP(2048,  { pg8::Gemm g{WSP(bf16_t, WS_ACT), WSP(bf16_t, WS_WD), FF, FF}; pg8::StaticOrder S; S.init(T, D, C.G, (int)blockIdx.x); pg8::EpiResid<true, true> E{WSP(bf16_t, WS_XB), WSP(bf16_t, WS_XB)};
                pg8::gemm_phase<pg8::EpiResid<true, true>, pg8::StaticOrder>(ring, g, S, E); } ) PH_END
            PH_BEGIN REP(32768,  ph_norm<0>(C, WSP(bf16_t, WS_XB), nullptr, INF32(I_PLEN) + l * D, nullptr); ) PH_END
        } else {
            PH_BEGIN REP(131072,  ph_moe_gather(C); ) PH_END
            PH_BEGIN REP(8192,  { moe_tile_table(C); pg8::MoeOrder S; S.tab = (const LAS int*)(C.lds + MOETAB_OFF); S.NT = __builtin_amdgcn_readfirstlane(S.tab[MOE_MAXRT]); S.nct = NCT_UP; S.G = C.G; S.c = (int)blockIdx.x;
                pg8::Gemm g{WSP(bf16_t, WS_HS), WSP(bf16_t, WS_MWGU), D, D}; pg8::EpiUp E{WSP(bf16_t, WS_ACTS)};
                pg8::gemm_phase<pg8::EpiUp, pg8::MoeOrder>(ring, g, S, E); } ) PH_END
            PH_BEGIN REP(2048,  { moe_tile_table(C); const LAS int* mtab = (const LAS int*)(C.lds + MOETAB_OFF);
                pg8::MoeDownOrder S; S.init(mtab, __builtin_amdgcn_readfirstlane(mtab[MOE_MAXRT]), C.G, (int)blockIdx.x);
                pg8::Gemm g{WSP(bf16_t, WS_ACTS), WSP(bf16_t, WS_MWD), FF, FF}; pg8::EpiMoeDown E{WSP(bf16_t, WS_OS), WSP(float, WS_WSLOT), WSP(float, WS_OSP), S.S};
                pg8::gemm_phase<pg8::EpiMoeDown, pg8::MoeDownOrder>(ring, g, S, E); } ) PH_END
            PH_BEGIN REP(16,  { int toff[NE + 1]; moe_offsets(C, toff); pg8::MoeDownOrder S; S.init(nullptr, toff[NE], C.G, 0); ph_norm<2>(C, WSP(bf16_t, WS_XB), WSP(bf16_t, WS_XB), INF32(I_PLEN) + l * D, nullptr, S.S); } ) PH_END
        }
        PH_BEGIN REP(262144,  { pg8::Gemm g{WSP(bf16_t, WS_H), WSP(bf16_t, WS_WPG + l * SZ_DD), D, D}; pg8::StaticOrder S; S.init(T, D, C.G, (int)blockIdx.x);
            if (l == NL - 1) { pg8::EpiPle<false> E{WSP(bf16_t, WS_XB), C.out, WSP(bf16_t, WS_PROJ) + (size_t)l * T * D}; pg8::gemm_phase<pg8::EpiPle<false>, pg8::StaticOrder>(ring, g, S, E); }
            else { pg8::EpiPle<true> E{WSP(bf16_t, WS_XB), WSP(bf16_t, WS_XB), WSP(bf16_t, WS_PROJ) + (size_t)l * T * D}; pg8::gemm_phase<pg8::EpiPle<true>, pg8::StaticOrder>(ring, g, S, E); } } ) PH_END
    }
    { constexpr int l = 1;
        if (l > 0) { PH_BEGIN REP(32768,  ph_norm<0>(C, WSP(bf16_t, WS_XB), nullptr, INF32(I_MIXN) + l * D, nullptr); ) PH_END }
        PH_BEGIN REP(4096,  { pg8::Gemm g{WSP(bf16_t, WS_H), WSP(bf16_t, WS_WIN + l * SZ_WIN1), D, D}; pg8::StaticOrder S; S.init(T, N_INP, C.G, (int)blockIdx.x);
            pg8::EpiWin E{WSP(bf16_t, WS_SBQKV), WSP(bf16_t, WS_UF), WSP(bf16_t, WS_GATE)};
            pg8::gemm_phase<pg8::EpiWin, pg8::StaticOrder>(ring, g, S, E); } ) PH_END
        PH_BEGIN REP(16384,  ph_prep(C, l); ph_vt(C); ph_latent(C, l); ) PH_END
        PH_BEGIN REP(256,  { pg8::Gemm g{WSP(bf16_t, WS_ALORA), WSP(bf16_t, WS_WLORA + l * SZ_WLORA1), 256, 256}; pg8::StaticOrder S; S.init(T, 3072, C.G, (int)blockIdx.x);
            pg8::EpiLora E{WSP(float, WS_DEC), WSP(bf16_t, WS_AA), WSP(bf16_t, WS_GG), INF32(I_RWW0) + l * 1024, INF32(I_RWA0) + l * 1024};
            pg8::gemm_phase<pg8::EpiLora, pg8::StaticOrder>(ring, g, S, E); } ) PH_END
        PH_BEGIN REP(32,  if (!(DBG_SKIP_MASK & 2)) { if (USE_FAST & 256) { ph_rwkv_scan5<1>(C, l); if (PROBE_MASK & 2097152) ph_rwkv_scan5<0>(C, l); if ((PROBE_MASK & 4194304) && l == 0) ph_rwkv_scan5<PROBE_CONV>(C, l); } else if (USE_FAST & 128) ph_rwkv_scan4(C, l); else if (USE_FAST & 64) ph_rwkv_scan3(C, l); else if (USE_FAST & 32) ph_rwkv_scan_conv(C, l); else if (USE_FAST & 2) ph_rwkv_scan_fast(C); else ph_rwkv_scan_naive(C); } ) PH_END
        PH_BEGIN REP(8,  ph_sb_fast(C); ) REP(64,  ph_dsa_fast(C, l); ) REP(128,  ph_swa_fast(C, l); ) REP(65536,  ph_rwkv_post(C, l); ) PH_END
        PH_BEGIN REP(512,  { pg8::Gemm g{WSP(bf16_t, WS_Y), WSP(bf16_t, WS_WBR + l * SZ_WBR1), 4096, 1024}; pg8::BranchOrder S; S.init(C.G, (int)blockIdx.x);
            pg8::EpiBranch E{WSP(bf16_t, WS_GATE), WSP(bf16_t, WS_G)};
            pg8::gemm_phase<pg8::EpiBranch, pg8::BranchOrder>(ring, g, S, E); } ) PH_END
        PH_BEGIN { pg8::Gemm g{WSP(bf16_t, WS_G), WSP(bf16_t, WS_WOUT + l * SZ_DD), D, D}; pg8::StaticOrder S; S.init(T, D, C.G, (int)blockIdx.x);
            if (l == 0) { pg8::EpiResid<false, true> E{INF32(I_X), WSP(bf16_t, WS_XB)}; pg8::gemm_phase<pg8::EpiResid<false, true>, pg8::StaticOrder>(ring, g, S, E); }
            else { pg8::EpiResid<true, true> E{WSP(bf16_t, WS_XB), WSP(bf16_t, WS_XB)}; pg8::gemm_phase<pg8::EpiResid<true, true>, pg8::StaticOrder>(ring, g, S, E); } } PH_END
        PH_BEGIN if (l == 0) ph_norm<0>(C, WSP(bf16_t, WS_XB), nullptr, INF32(I_FFNN) + l * D, nullptr); else ph_norm<1>(C, WSP(bf16_t, WS_XB), nullptr, INF32(I_FFNN) + l * D, INF32(I_MR)); PH_END
        if (l == 0) {
            PH_BEGIN REP(2,  { pg8::Gemm g{WSP(bf16_t, WS_H), WSP(bf16_t, WS_WGU), D, D}; pg8::StaticOrder S; S.init(T, 2 * FF, C.G, (int)blockIdx.x); pg8::EpiUp E{WSP(bf16_t, WS_ACT)};
                pg8::gemm_phase<pg8::EpiUp, pg8::StaticOrder>(ring, g, S, E); } ) PH_END
            PH_BEGIN REP(2048,  { pg8::Gemm g{WSP(bf16_t, WS_ACT), WSP(bf16_t, WS_WD), FF, FF}; pg8::StaticOrder S; S.init(T, D, C.G, (int)blockIdx.x); pg8::EpiResid<true, true> E{WSP(bf16_t, WS_XB), WSP(bf16_t, WS_XB)};
                pg8::gemm_phase<pg8::EpiResid<true, true>, pg8::StaticOrder>(ring, g, S, E); } ) PH_END
            PH_BEGIN REP(32768,  ph_norm<0>(C, WSP(bf16_t, WS_XB), nullptr, INF32(I_PLEN) + l * D, nullptr); ) PH_END
        } else {
            PH_BEGIN REP(131072,  ph_moe_gather(C); ) PH_END
            PH_BEGIN REP(8192,  { moe_tile_table(C); pg8::MoeOrder S; S.tab = (const LAS int*)(C.lds + MOETAB_OFF); S.NT = __builtin_amdgcn_readfirstlane(S.tab[MOE_MAXRT]); S.nct = NCT_UP; S.G = C.G; S.c = (int)blockIdx.x;
                pg8::Gemm g{WSP(bf16_t, WS_HS), WSP(bf16_t, WS_MWGU), D, D}; pg8::EpiUp E{WSP(bf16_t, WS_ACTS)};
                pg8::gemm_phase<pg8::EpiUp, pg8::MoeOrder>(ring, g, S, E); } ) PH_END
            PH_BEGIN REP(2048,  { moe_tile_table(C); const LAS int* mtab = (const LAS int*)(C.lds + MOETAB_OFF);
                pg8::MoeDownOrder S; S.init(mtab, __builtin_amdgcn_readfirstlane(mtab[MOE_MAXRT]), C.G, (int)blockIdx.x);
                pg8::Gemm g{WSP(bf16_t, WS_ACTS), WSP(bf16_t, WS_MWD), FF, FF}; pg8::EpiMoeDown E{WSP(bf16_t, WS_OS), WSP(float, WS_WSLOT), WSP(float, WS_OSP), S.S};
                pg8::gemm_phase<pg8::EpiMoeDown, pg8::MoeDownOrder>(ring, g, S, E); } ) PH_END
            PH_BEGIN REP(16,  { int toff[NE + 1]; moe_offsets(C, toff); pg8::MoeDownOrder S; S.init(nullptr, toff[NE], C.G, 0); ph_norm<2>(C, WSP(bf16_t, WS_XB), WSP(bf16_t, WS_XB), INF32(I_PLEN) + l * D, nullptr, S.S); } ) PH_END
        }
        PH_BEGIN REP(262144,  { pg8::Gemm g{WSP(bf16_t, WS_H), WSP(bf16_t, WS_WPG + l * SZ_DD), D, D}; pg8::StaticOrder S; S.init(T, D, C.G, (int)blockIdx.x);
            if (l == NL - 1) { pg8::EpiPle<false> E{WSP(bf16_t, WS_XB), C.out, WSP(bf16_t, WS_PROJ) + (size_t)l * T * D}; pg8::gemm_phase<pg8::EpiPle<false>, pg8::StaticOrder>(ring, g, S, E); }
            else { pg8::EpiPle<true> E{WSP(bf16_t, WS_XB), WSP(bf16_t, WS_XB), WSP(bf16_t, WS_PROJ) + (size_t)l * T * D}; pg8::gemm_phase<pg8::EpiPle<true>, pg8::StaticOrder>(ring, g, S, E); } } ) PH_END
    }
#undef PH_BEGIN
#undef PH_END
}

#ifndef MK_ONE_LAUNCH
#define MK_ONE_LAUNCH 0
#endif
extern "C" void kernel_launch(void* const* d_in, const int* in_sizes, int n_in, void* d_out, int out_size, void* d_ws, size_t ws_size, hipStream_t stream) {
    static int grid = 0;
    if (grid == 0) {
        if (n_in != N_INPUTS || out_size != T * D || ws_size < WS_END3) { fprintf(stderr, "kernel_launch: unexpected problem (n_in %d, out %d, ws %zu < %zu)\n", n_in, out_size, ws_size, (size_t)WS_END3); grid = -1; return; }
        int dev = 0, cus = 0, per_cu = 0;
        if (hipGetDevice(&dev) != hipSuccess || hipDeviceGetAttribute(&cus, hipDeviceAttributeMultiprocessorCount, dev) != hipSuccess) { grid = -1; return; }
        if (hipFuncSetAttribute((const void*)fwd_kernel, hipFuncAttributeMaxDynamicSharedMemorySize, LDS_BYTES) != hipSuccess) { fprintf(stderr, "kernel_launch: hipFuncSetAttribute failed\n"); grid = -1; return; }
        if (hipOccupancyMaxActiveBlocksPerMultiprocessor(&per_cu, (const void*)fwd_kernel, NTHR, LDS_BYTES) != hipSuccess || per_cu < 1) fprintf(stderr, "kernel_launch: occupancy query reports %d\n", per_cu);
        (void)hipGetLastError();
        grid = cus;
    }
    if (grid < 0) return;
    (void)hipMemsetAsync((char*)d_ws + WS_CTL, 0, CTL_BYTES, stream);
    Args a{};
    for (int i = 0; i < N_INPUTS; ++i) a.in[i] = d_in[i];
    a.out = (float*)d_out; a.ws = (unsigned char*)d_ws;
#if MK_ONE_LAUNCH
    a.ph_lo = 0; a.ph_hi = N_PHASES;
    hipLaunchKernelGGL(fwd_kernel, dim3(grid), dim3(NTHR), LDS_BYTES, stream, a);
#else
    for (int p = 0; p < N_PHASES; ++p) { a.ph_lo = p; a.ph_hi = p + 1; hipLaunchKernelGGL(fwd_kernel, dim3(grid), dim3(NTHR), LDS_BYTES, stream, a); }
#endif
}
```

```cpp
#define MK_ONE_LAUNCH 1
#include <hip/hip_runtime.h>
#include <cstdio>
#include <cstdint>

#define LAS __attribute__((address_space(3)))
#define GAS __attribute__((address_space(1)))
#define GLB __attribute__((address_space(1)))
typedef unsigned short bf16_t;
typedef short bf16x8 __attribute__((ext_vector_type(8)));
typedef float f32x4 __attribute__((ext_vector_type(4)));
typedef float f32x2 __attribute__((ext_vector_type(2)));
typedef unsigned u32x4 __attribute__((ext_vector_type(4)));
typedef unsigned u32x2 __attribute__((ext_vector_type(2)));

constexpr int NB = 4, SEQ = 2048, T = NB * SEQ, D = 2048, NL = 2;
constexpr int N_IN = 18256, N_INP = 18432, FF = 7168, NE = 8;
constexpr int UFW = 7168;
constexpr int UF_RW = 0, UF_DQ = 3328, UF_CKV = 4352, UF_IQ = 4608, UF_SQ = 5632, UF_SK = 6656, UF_SV = 6784, UF_IK = 6912, UF_IW = 6976;
constexpr int MOE_ROWS = 18432, MOE_MAXRT = 72, NCT_UP = 56, NCT_DN = 8;
constexpr int NWAVES = 8, NTHR = 512;

constexpr size_t WS_CTL = 0, CTL_BYTES = 1u << 20;
constexpr size_t SZ_WIN1 = (size_t)N_INP * D * 2, SZ_WBR1 = (size_t)4 * 2048 * 1024 * 2, SZ_DD = (size_t)D * D * 2;
constexpr size_t SZ_WGU1 = (size_t)2 * FF * D * 2, SZ_WD1 = (size_t)D * FF * 2, SZ_WLORA1 = (size_t)3072 * 256 * 2;
constexpr size_t WS_WIN = CTL_BYTES;
constexpr size_t WS_WBR = WS_WIN + NL * SZ_WIN1;
constexpr size_t WS_WOUT = WS_WBR + NL * SZ_WBR1;
constexpr size_t WS_WGU = WS_WOUT + NL * SZ_DD;
constexpr size_t WS_WD = WS_WGU + SZ_WGU1;
constexpr size_t WS_MWGU = WS_WD + SZ_WD1;
constexpr size_t WS_MWD = WS_MWGU + NE * SZ_WGU1;
constexpr size_t WS_WPG = WS_MWD + NE * SZ_WD1;
constexpr size_t WS_WPP = WS_WPG + NL * SZ_DD;
constexpr size_t WS_WLORA = WS_WPP + (size_t)NL * D * 256 * 2;
constexpr size_t WS_H = WS_WLORA + NL * SZ_WLORA1;
constexpr size_t WS_PCAT = WS_H + (size_t)T * D * 2;
constexpr size_t WS_PROJ = WS_PCAT + (size_t)T * 512 * 2;
constexpr size_t WS_ROUTE = WS_PROJ + (size_t)NL * T * D * 2;
constexpr size_t WS_TOKSLOT = WS_ROUTE + (size_t)T * 32;
constexpr size_t WS_WSLOT = WS_TOKSLOT + (size_t)T * 8;
constexpr size_t WS_ACT0 = WS_WSLOT + (size_t)MOE_ROWS * 4 + 256 * 30;
constexpr size_t SZ_T1K = (size_t)T * 1024 * 4;
constexpr size_t WS_SBQKV = (WS_ACT0 + 255) & ~(size_t)255;
constexpr size_t WS_GATE = WS_SBQKV + (size_t)T * 3072 * 2;
constexpr size_t WS_UF = WS_GATE + (size_t)T * 8192 * 2;
constexpr size_t WS_Y = WS_UF;
constexpr size_t WS_GSUM = WS_Y + (size_t)T * 4096 * 2;
constexpr size_t WS_G = WS_GSUM + (size_t)T * 2048 * 4;
constexpr size_t WS_YRAW = WS_G + (size_t)T * 2048 * 2;
constexpr size_t WS_RW = WS_UF + (size_t)T * UFW * 4;
static_assert(WS_YRAW + SZ_T1K <= WS_RW, "UF aliases");
constexpr size_t WS_R = WS_RW, WS_K = WS_RW + SZ_T1K, WS_V = WS_RW + 2 * SZ_T1K, WS_DEC = WS_RW + 3 * SZ_T1K, WS_AA = WS_RW + 4 * SZ_T1K, WS_KK = WS_RW + 5 * SZ_T1K, WS_GG = WS_RW + 6 * SZ_T1K;
constexpr size_t WS_ALORA = WS_RW + 7 * SZ_T1K;
constexpr size_t WS_QD = WS_ALORA + (size_t)T * 256 * 2;
constexpr size_t WS_KD = WS_QD + (size_t)T * 1024 * 2;
constexpr size_t WS_VD = WS_KD + (size_t)T * 128 * 2;
constexpr size_t WS_QI = WS_VD + (size_t)T * 128 * 2;
constexpr size_t WS_KI = WS_QI + (size_t)T * 1024 * 2;
constexpr size_t WS_WI = WS_KI + (size_t)T * 64 * 2;
constexpr size_t WS_QS = WS_WI + (size_t)T * 16 * 4;
constexpr size_t WS_KS = WS_QS + (size_t)T * 1024 * 2;
constexpr size_t WS_VS = WS_KS + (size_t)T * 128 * 2;
constexpr size_t WS_MIX_END = WS_VS + (size_t)T * 128 * 2;
constexpr size_t WS_ACT = WS_SBQKV;
constexpr size_t WS_HS = WS_SBQKV;
constexpr size_t WS_ACTS = WS_HS + (size_t)MOE_ROWS * D * 2;
constexpr size_t WS_OS = WS_ACTS + (size_t)MOE_ROWS * FF * 2;
constexpr size_t WS_OSP = WS_OS + (size_t)MOE_ROWS * D * 4;
constexpr size_t WS_FFN_END = WS_OSP + (size_t)256 * 65536 * 4;
constexpr size_t WS_END = WS_MIX_END > WS_FFN_END ? WS_MIX_END : WS_FFN_END;
static_assert(WS_END < (size_t)2000 * 1000 * 1000, "workspace budget");

constexpr int CW_BAR = 4096;
constexpr int CW_MOECNT = 8192;

constexpr int RING_BYTES = 131072;
constexpr int MISC_OFF = 143360;
constexpr int LDS_BYTES = 147456;

#define LDS_WAIT() asm volatile("s_waitcnt lgkmcnt(0)" ::: "memory")
#define VM_WAIT() asm volatile("s_waitcnt vmcnt(0)" ::: "memory")
__device__ __forceinline__ float bflo(unsigned u) { return __builtin_bit_cast(float, u << 16); }
__device__ __forceinline__ float bfhi(unsigned u) { return __builtin_bit_cast(float, u & 0xffff0000u); }
__device__ __forceinline__ float bf1(bf16_t u) { return __builtin_bit_cast(float, (unsigned)u << 16); }
__device__ __forceinline__ unsigned f2bf(float f) { unsigned u = __builtin_bit_cast(unsigned, f); return (u + 0x7fffu + ((u >> 16) & 1u)) >> 16; }
typedef __bf16 bf16x2v __attribute__((ext_vector_type(2)));
__device__ __forceinline__ unsigned pk2(float lo, float hi) { const f32x2 v = {lo, hi}; return __builtin_bit_cast(unsigned, __builtin_convertvector(v, bf16x2v)); }
__device__ __forceinline__ float wave_sum(float v) {
#pragma unroll
    for (int o = 1; o < 64; o <<= 1) v += __shfl_xor(v, o);
    return v;
}
__device__ __forceinline__ float wave_max(float v) {
#pragma unroll
    for (int o = 1; o < 64; o <<= 1) v = fmaxf(v, __shfl_xor(v, o));
    return v;
}
__device__ __forceinline__ float sigmoidf_(float x) { return __builtin_amdgcn_rcpf(1.0f + __builtin_amdgcn_exp2f(-1.4426950408889634f * x)); }
__device__ __forceinline__ float logsigf_(float x) { return fminf(x, 0.f) - __logf(1.0f + __expf(-fabsf(x))); }
__device__ __forceinline__ float rdlane(float v, int l) { return __builtin_bit_cast(float, __builtin_amdgcn_readlane(__builtin_bit_cast(int, v), l)); }

#define XB_TMO      128
#define XB_XCNT(j)  (256  + 64 * (j))
#define XB_XSUB(j)  (1280 + 64 * (j))
#define XB_XGEN(j)  (2304 + 64 * (j))
#define XB_TOP      3328
#define XB_TOPGEN   3392
#define XCD_BAR_WORDS 3456
#define XB_SPIN_CAP (1u << 18)
__device__ __forceinline__ unsigned xb_ld(unsigned* p)              { return __hip_atomic_load(p, __ATOMIC_RELAXED, __HIP_MEMORY_SCOPE_AGENT); }
__device__ __forceinline__ unsigned xb_add(unsigned* p, unsigned v) { return __hip_atomic_fetch_add(p, v, __ATOMIC_RELAXED, __HIP_MEMORY_SCOPE_AGENT); }
__device__ __forceinline__ unsigned xb_xcc_id() { return (unsigned)__builtin_amdgcn_s_getreg((3 << 11) | 20) & 0xFu; }
#define XB_SPIN(cond, bar) do { unsigned _sp = 0; while (cond) { __builtin_amdgcn_s_sleep(1); \
    if ((++_sp & 255u) == 0u) { if (xb_ld(&(bar)[XB_TMO])) break; if (_sp > XB_SPIN_CAP) { atomicAdd(&(bar)[XB_TMO], 1u); break; } } } } while (0)
struct XcdBarrier { unsigned* bar; unsigned x; volatile LAS unsigned* st; };
__device__ __forceinline__ XcdBarrier xcd_barrier_post(unsigned* bar, volatile LAS unsigned* st) {
    XcdBarrier b; b.bar = bar; b.x = xb_xcc_id(); b.st = st;
    if (threadIdx.x == 0) (void)xb_add(&bar[XB_XCNT(b.x)], 1u);
    return b;
}
__device__ __forceinline__ void xcd_barrier_complete(unsigned* bar, unsigned x, unsigned& nloc, unsigned& nx) {
    const unsigned G = gridDim.x * gridDim.y * gridDim.z;
    unsigned sum, cnt, mine, sp = 0u;
    for (;;) {
        sum = 0u; cnt = 0u; mine = 0u;
#pragma unroll
        for (unsigned j = 0; j < 16; ++j) { const unsigned c = xb_ld(&bar[XB_XCNT(j)]); sum += c; cnt += (c > 0u) ? 1u : 0u; mine = (j == x) ? c : mine; }
        if (sum == G) break;
        __builtin_amdgcn_s_sleep(1);
        if ((++sp & 255u) == 0u) { if (xb_ld(&bar[XB_TMO])) break; if (sp > XB_SPIN_CAP) { atomicAdd(&bar[XB_TMO], 1u); break; } }
    }
    nloc = mine > 0u ? mine : 1u; nx = cnt > 0u ? cnt : 1u;
}
__device__ __forceinline__ void xcd_barrier(const XcdBarrier& b) {
    asm volatile("s_waitcnt vmcnt(0)" ::: "memory");
    __syncthreads();
    if (threadIdx.x == 0) {
        unsigned* bar = b.bar;
        __builtin_amdgcn_s_waitcnt(0);
        unsigned nloc = b.st[0], nx = b.st[1];
        if (nloc == 0u) { xcd_barrier_complete(bar, b.x, nloc, nx); b.st[0] = nloc; b.st[1] = nx; }
        const unsigned old = xb_add(&bar[XB_XSUB(b.x)], 1u);
        const unsigned gen = old / nloc;
        if (old + 1u == (gen + 1u) * nloc) {
            __builtin_amdgcn_fence(__ATOMIC_RELEASE, "agent");
            asm volatile("s_waitcnt vmcnt(0)" ::: "memory");
            const unsigned og = xb_add(&bar[XB_TOP], 1u);
            const unsigned tg = og / nx;
            if (og + 1u == (tg + 1u) * nx) xb_add(&bar[XB_TOPGEN], 1u);
            else XB_SPIN(xb_ld(&bar[XB_TOPGEN]) == tg, bar);
            __builtin_amdgcn_fence(__ATOMIC_ACQUIRE, "agent");
            xb_add(&bar[XB_XGEN(b.x)], 1u);
            asm volatile("s_waitcnt vmcnt(0)" ::: "memory");
        } else {
            XB_SPIN(xb_ld(&bar[XB_XGEN(b.x)]) == gen, bar);
            __builtin_amdgcn_fence(__ATOMIC_ACQUIRE, "agent");
            asm volatile("s_waitcnt vmcnt(0)" ::: "memory");
        }
    }
    __syncthreads();
}
namespace pg8 {
#define PG8_LAS __attribute__((address_space(3)))
#ifndef PG8_WGM
#define PG8_WGM 4
#endif
constexpr int BM = 256, BK = 64, HALF = 128, HTB = HALF * BK * 2, STAGE_BYTES = 8 * HTB, NXCD = 8, WGM = PG8_WGM;
__host__ __device__ __forceinline__ int lds_byte(int r, int c) { const int st = (r >> 4) * 2 + (c >> 5), rr = r & 15, cc = c & 31, ob = rr * 64 + cc * 2; return st * 1024 + (ob ^ (((ob >> 9) & 1) << 5)); }
__host__ __device__ __forceinline__ void stage_rc(int b, int& R, int& C) { const int st = b / 1024, sb = b % 1024, swz = sb ^ (((sb >> 9) & 1) << 5); R = (st >> 1) * 16 + swz / 64; C = (st & 1) * 32 + (swz % 64) / 2; }
__host__ __device__ __forceinline__ int perm32(int rho) { const int n = rho >> 4, i = rho & 15; return 8 * (i >> 2) + 4 * n + (i & 3); }

struct Unit { int pm, pn, ka, kb, nt, aux; };
struct Gemm { const GLB bf16_t* A; const GLB bf16_t* Bt; int lda, K; };

struct StaticOrder {
    int nM, nN, nwg, G, c;
    __device__ __forceinline__ void init(int M, int N, int G_, int c_) { nM = M / BM; nN = N / BM; nwg = nM * nN; G = G_; c = c_; }
    __device__ __forceinline__ bool tile(long L, Unit& u) const {
        if (L >= nwg) return false;
        int wgid = (int)L; { const int q = nwg / NXCD, r = nwg % NXCD, xcd = wgid % NXCD, off = wgid / NXCD; wgid = (xcd < r ? xcd * (q + 1) : r * (q + 1) + (xcd - r) * q) + off; }
        const int nig = WGM * nN, gid = wgid / nig, fm = gid * WGM, gsz = (nM - fm) < WGM ? (nM - fm) : WGM;
        u.pm = fm + ((wgid % nig) % gsz); u.pn = (wgid % nig) / gsz; u.ka = 0; u.kb = 0; u.nt = 0; u.aux = 0; return true;
    }
    __device__ __forceinline__ bool next(int i, Unit& u) const { return tile((long)i * G + c, u); }
};
struct BranchOrder {
    int G, c, cnt;
    __device__ __forceinline__ void init(int G_, int c_) { G = G_; c = c_; cnt = (c_ < 256) ? (255 - c_) / G_ + 1 : 0; }
    __device__ __forceinline__ bool next(int i, Unit& u) const {
        if (cnt == 0) return false;
        const int n = i / cnt, r = i - n * cnt; if (n >= 4) return false;
        StaticOrder so; so.init(T, 2048, G, c); so.tile((long)r * G + c, u);
        u.pn += n * 8; u.ka = n * 1024; return true;
    }
};
struct ProjOrder {
    StaticOrder so;
    __device__ __forceinline__ void init(int G_, int c_) { so.init(T, 4096, G_, c_); }
    __device__ __forceinline__ bool next(int i, Unit& u) const { if (!so.next(i, u)) return false; u.ka = (u.pn >> 3) * 256; return true; }
};
struct MoeOrder {
    const PG8_LAS int* tab; int NT, nct, G, c;
    __device__ __forceinline__ bool next(int i, Unit& u) const {
        StaticOrder so; so.nM = NT; so.nN = nct; so.nwg = NT * nct; so.G = G; so.c = c;
        if (!so.tile((long)i * G + c, u)) return false;
        const int e = __builtin_amdgcn_readfirstlane(tab[u.pm]);
        u.pn += e * nct; u.ka = 0; return true;
    }
};

struct MoeDownOrder {
    const PG8_LAS int* tab; int NT, G, c, S;
    __device__ __forceinline__ void init(const PG8_LAS int* tab_, int NT_, int G_, int c_) { tab = tab_; NT = NT_; G = G_; c = c_;
        const int tu = (NT_ - 64) * 8; S = (tu <= 0) ? 1 : ((tu * 8 <= G_) ? 8 : ((tu * 4 <= G_) ? 4 : ((tu * 2 <= G_) ? 2 : 1))); }
    __device__ __forceinline__ bool next(int i, Unit& u) const {
        const int F = (NT < 64) ? NT : 64, nfull = F * 8, rf = (nfull + G - 1) / G;
        if (i < rf) {
            StaticOrder so; so.nM = F; so.nN = 8; so.nwg = nfull; so.G = G; so.c = c;
            if (so.tile((long)i * G + c, u)) { const int e = __builtin_amdgcn_readfirstlane(tab[u.pm]); u.pn += e * 8; return true; }
            i = rf;
        }
        const int q = (i - rf) * G + c, ntail = (NT - F) * 8 * S;
        if (q >= ntail) return false;
        const int tu = q / S, sl = q - tu * S, rt = F + (tu >> 3), pl = tu & 7;
        const int e = __builtin_amdgcn_readfirstlane(tab[rt]);
        u.pm = rt; u.pn = e * 8 + pl; u.ka = sl * (FF / S); u.kb = u.ka; u.nt = (FF / 64) / S; u.aux = 1 + sl; return true;
    }
};

template <class Epi, class Sched>
__device__ __forceinline__ void gemm_phase(PG8_LAS unsigned char* lds, const Gemm g, const Sched& S, const Epi& E) {
    int tid = threadIdx.x; asm volatile("" : "+v"(tid));
    const int wid = __builtin_amdgcn_readfirstlane(tid >> 6), lane = tid & 63, wr = wid >> 2, wc = wid & 3, fr = lane & 15, fq = lane >> 4;
    int K = g.K, lda = g.lda; asm volatile("" : "+s"(K), "+s"(lda));
    const int nt = K / BK;
    unsigned voffA[2], voffB[2];
#pragma unroll
    for (int i = 0; i < 2; ++i) { int R, C; stage_rc(tid * 16 + i * 8192, R, C); const int Rb = Epi::PERM ? ((R & ~31) + perm32(R & 31)) : R;
        voffA[i] = (unsigned)(R * lda + C) * 2u; voffB[i] = (unsigned)(Rb * K + C) * 2u; }
    const size_t kstep = (size_t)(BK * 2);
    const size_t hstepA = (size_t)HALF * lda * 2, hstepB = (size_t)HALF * K * 2;
    const size_t tstepA = 2 * hstepA, tstepB = 2 * hstepB;
    const unsigned ldsw = (unsigned)wid * 1024u;
    const int aoff = lds_byte(wr * 64 + fr, fq * 8), boff = lds_byte(wc * 32 + fr, fq * 8);
#define PG8_SA(b, h) (((b) * 2 + (h)) * HTB)
#define PG8_SB(b, h) ((4 + (b) * 2 + (h)) * HTB)
#define PG8_STAGE(bufoff, gbase, voff) do { _Pragma("unroll") for (int _i = 0; _i < 2; ++_i) \
        __builtin_amdgcn_global_load_lds((const GLB unsigned*)((const char*)(gbase) + (voff)[_i]), (PG8_LAS unsigned*)(lds + (bufoff) + ldsw + _i * 8192), 16, 0, 0); } while (0)
#define PG8_LDA(dst, b, h) do { _Pragma("unroll") for (int m = 0; m < 4; ++m) _Pragma("unroll") for (int k = 0; k < 2; ++k) dst[m][k] = *(const PG8_LAS bf16x8*)(lds + PG8_SA(b, h) + aoff + m * 2048 + k * 1024); } while (0)
#define PG8_LDB(dst, b, h) do { _Pragma("unroll") for (int n = 0; n < 2; ++n) _Pragma("unroll") for (int k = 0; k < 2; ++k) dst[n][k] = *(const PG8_LAS bf16x8*)(lds + PG8_SB(b, h) + boff + n * 2048 + k * 1024); } while (0)
#define PG8_MMA(ai, bj, At, Bt) do { __builtin_amdgcn_s_setprio(1); _Pragma("unroll") for (int m = 0; m < 4; ++m) _Pragma("unroll") for (int n = 0; n < 2; ++n) _Pragma("unroll") for (int k = 0; k < 2; ++k) \
        acc[ai][bj][m][n] = __builtin_amdgcn_mfma_f32_16x16x32_bf16(Bt[n][k], At[m][k], acc[ai][bj][m][n], 0, 0, 0); __builtin_amdgcn_s_setprio(0); } while (0)
#define PG8_WAIT_V(n) asm volatile("s_waitcnt vmcnt(" #n ")" ::: "memory")
#define PG8_WAIT_L(n) asm volatile("s_waitcnt lgkmcnt(" #n ")" ::: "memory")
#define PG8_BAR __builtin_amdgcn_s_barrier()
#define PG8_SCHED __builtin_amdgcn_sched_barrier(0)
    Unit cur, nxt; int ui = 0;
    if (!S.next(0, cur)) return;
    f32x4 acc[2][2][4][2];
#pragma unroll
    for (int a = 0; a < 2; ++a)
#pragma unroll
        for (int b = 0; b < 2; ++b)
#pragma unroll
            for (int m = 0; m < 4; ++m)
#pragma unroll
                for (int n = 0; n < 2; ++n) acc[a][b][m][n] = (f32x4){0.f, 0.f, 0.f, 0.f};
    bf16x8 At[4][2], B0[2][2], B1[2][2];
    const char* cA = (const char*)g.A + (size_t)cur.pm * tstepA + (size_t)cur.ka * 2; const char* cB = (const char*)g.Bt + (size_t)cur.pn * tstepB + (size_t)cur.kb * 2;
    PG8_STAGE(PG8_SB(0, 0), cB, voffB); PG8_STAGE(PG8_SB(0, 1), cB + hstepB, voffB); PG8_STAGE(PG8_SA(0, 0), cA, voffA); PG8_STAGE(PG8_SA(0, 1), cA + hstepA, voffA);
    if (wr == 1) PG8_BAR;
    PG8_WAIT_V(2); PG8_BAR;
    PG8_STAGE(PG8_SB(1, 0), cB + kstep, voffB); PG8_STAGE(PG8_SA(1, 0), cA + kstep, voffA); PG8_STAGE(PG8_SB(1, 1), cB + hstepB + kstep, voffB);
    PG8_WAIT_V(6); PG8_BAR;
    for (;;) {
        const bool has_next = S.next(ui + 1, nxt);
        const char* nA = has_next ? (const char*)g.A + (size_t)nxt.pm * tstepA + (size_t)nxt.ka * 2 : cA; const char* nB = has_next ? (const char*)g.Bt + (size_t)nxt.pn * tstepB + (size_t)nxt.kb * 2 : cB;
        const int ntu = cur.nt ? cur.nt : nt;
        for (int t = 0; t < ntu; t += 2) {
            const bool last = (t == ntu - 2);
            const char* a1 = cA + (size_t)(t + 1) * kstep;
            const char* a2 = last ? nA : cA + (size_t)(t + 2) * kstep; const char* b2 = last ? nB : cB + (size_t)(t + 2) * kstep;
            const char* a3 = a2 + kstep; const char* b3 = b2 + kstep;
            PG8_LDB(B0, 0, 0); PG8_LDB(B1, 0, 1); PG8_SCHED; PG8_LDA(At, 0, 0); PG8_STAGE(PG8_SA(1, 1), a1 + hstepA, voffA);
            PG8_WAIT_V(8); PG8_WAIT_L(0); PG8_BAR; PG8_MMA(0, 0, At, B0); PG8_MMA(0, 1, At, B1); PG8_BAR; PG8_SCHED;
            PG8_LDA(At, 0, 1); PG8_STAGE(PG8_SB(0, 0), b2, voffB); PG8_STAGE(PG8_SB(0, 1), b2 + hstepB, voffB); PG8_STAGE(PG8_SA(0, 0), a2, voffA);
            PG8_WAIT_V(8); PG8_WAIT_L(0); PG8_BAR; PG8_MMA(1, 0, At, B0); PG8_MMA(1, 1, At, B1); PG8_BAR; PG8_SCHED;
            PG8_LDB(B0, 1, 0); PG8_LDB(B1, 1, 1); PG8_SCHED; PG8_LDA(At, 1, 0); PG8_STAGE(PG8_SA(0, 1), a2 + hstepA, voffA);
            PG8_WAIT_V(8); PG8_WAIT_L(0); PG8_BAR; PG8_MMA(0, 0, At, B0); PG8_MMA(0, 1, At, B1); PG8_BAR; PG8_SCHED;
            PG8_LDA(At, 1, 1); PG8_STAGE(PG8_SB(1, 0), b3, voffB); PG8_STAGE(PG8_SB(1, 1), b3 + hstepB, voffB); PG8_STAGE(PG8_SA(1, 0), a3, voffA);
            PG8_WAIT_V(8); PG8_WAIT_L(0); PG8_BAR; PG8_MMA(1, 0, At, B0); PG8_MMA(1, 1, At, B1); PG8_BAR; PG8_SCHED;
        }
        if (wr == 0) PG8_BAR;
        E(acc, cur, wr, wc, fr, fq);
        if (!has_next) break;
#pragma unroll
        for (int a = 0; a < 2; ++a)
#pragma unroll
            for (int b = 0; b < 2; ++b)
#pragma unroll
                for (int m = 0; m < 4; ++m)
#pragma unroll
                    for (int n = 0; n < 2; ++n) acc[a][b][m][n] = (f32x4){0.f, 0.f, 0.f, 0.f};
        cur = nxt; cA = nA; cB = nB; ++ui;
        if (wr == 1) PG8_BAR;
    }
    PG8_WAIT_V(0);
    PG8_BAR;
#undef PG8_SA
#undef PG8_SB
#undef PG8_STAGE
#undef PG8_LDA
#undef PG8_LDB
#undef PG8_MMA
#undef PG8_WAIT_V
#undef PG8_WAIT_L
#undef PG8_BAR
#undef PG8_SCHED
}

#define EPI_ROWS(u) const int row0 = (u).pm * BM + wr * 64 + fr; const int ct0 = wc * 32 + 8 * fq
#define EPI_FOR_ROWS _Pragma("unroll") for (int ai = 0; ai < 2; ++ai) _Pragma("unroll") for (int m = 0; m < 4; ++m)
__device__ __forceinline__ u32x4 pack8(f32x4 v0, f32x4 v1) { u32x4 w; w.x = pk2(v0[0], v0[1]); w.y = pk2(v0[2], v0[3]); w.z = pk2(v1[0], v1[1]); w.w = pk2(v1[2], v1[3]); return w; }
__device__ __forceinline__ void unpack8(u32x4 w, f32x4& v0, f32x4& v1) { v0 = (f32x4){bflo(w.x), bfhi(w.x), bflo(w.y), bfhi(w.y)}; v1 = (f32x4){bflo(w.z), bfhi(w.z), bflo(w.w), bfhi(w.w)}; }
__device__ __forceinline__ f32x4 sig4(f32x4 v) { return (f32x4){sigmoidf_(v[0]), sigmoidf_(v[1]), sigmoidf_(v[2]), sigmoidf_(v[3])}; }

struct EpiWin { static constexpr bool PERM = true;
    GLB bf16_t* sbqkv; GLB bf16_t* uf; GLB bf16_t* gate;
    __device__ __forceinline__ void operator()(const f32x4 (&acc)[2][2][4][2], const Unit& u, int wr, int wc, int fr, int fq) const {
        EPI_ROWS(u); const int pn = u.pn;
        if (pn < 40) {
            GLB bf16_t* base = (pn < 12) ? sbqkv + pn * 256 : uf + (pn - 12) * 256; const int ld = (pn < 12) ? 3072 : UFW;
            EPI_FOR_ROWS { GLB bf16_t* rp = base + (size_t)(row0 + ai * HALF + m * 16) * ld + ct0;
#pragma unroll
                for (int bj = 0; bj < 2; ++bj) *(GLB u32x4*)(rp + bj * HALF) = pack8(acc[ai][bj][m][0], acc[ai][bj][m][1]); }
        } else {
            EPI_FOR_ROWS { GLB bf16_t* rp = gate + (size_t)(row0 + ai * HALF + m * 16) * 8192 + (pn - 40) * 256 + ct0;
#pragma unroll
                for (int bj = 0; bj < 2; ++bj) *(GLB u32x4*)(rp + bj * HALF) = pack8(sig4(acc[ai][bj][m][0]), sig4(acc[ai][bj][m][1])); }
        }
    }
};
struct EpiNull { static constexpr bool PERM = true;
    __device__ __forceinline__ void operator()(const f32x4 (&acc)[2][2][4][2], const Unit& u, int wr, int wc, int fr, int fq) const {
#pragma unroll
        for (int ai = 0; ai < 2; ++ai)
#pragma unroll
            for (int bj = 0; bj < 2; ++bj) asm volatile("" :: "v"(acc[ai][bj][0][0]), "v"(acc[ai][bj][0][1]), "v"(acc[ai][bj][1][0]), "v"(acc[ai][bj][1][1]), "v"(acc[ai][bj][2][0]), "v"(acc[ai][bj][2][1]), "v"(acc[ai][bj][3][0]), "v"(acc[ai][bj][3][1]));
    }
};
struct EpiLora { static constexpr bool PERM = true;
    GLB float* dec; GLB bf16_t* aa; GLB bf16_t* gg; const GLB float* w0; const GLB float* a0;
    __device__ __forceinline__ void operator()(const f32x4 (&acc)[2][2][4][2], const Unit& u, int wr, int wc, int fr, int fq) const {
        EPI_ROWS(u); const int kind = u.pn >> 2, cb = (u.pn & 3) * 256 + ct0;
        EPI_FOR_ROWS { const size_t ro = (size_t)(row0 + ai * HALF + m * 16) * 1024 + cb;
#pragma unroll
            for (int bj = 0; bj < 2; ++bj) { const int co = bj * HALF;
                if (kind == 0) {
#pragma unroll
                    for (int n = 0; n < 2; ++n) { const f32x4 v = acc[ai][bj][m][n]; const f32x4 b = *(const GLB f32x4*)(w0 + cb + co + 4 * n); f32x4 o;
#pragma unroll
                        for (int j = 0; j < 4; ++j) { const float pre = v[j] + b[j]; const float y = -pre; const float sp = fmaxf(y, 0.f) + __logf(1.0f + __expf(-fabsf(y)));
                            o[j] = __expf(-__expf(-sp - 0.5f)); }
                        *(GLB f32x4*)(dec + ro + co + 4 * n) = o; }
                } else if (kind == 1) { const f32x4 b0 = *(const GLB f32x4*)(a0 + cb + co), b1 = *(const GLB f32x4*)(a0 + cb + co + 4);
                    *(GLB u32x4*)(aa + ro + co) = pack8(sig4(acc[ai][bj][m][0] + b0), sig4(acc[ai][bj][m][1] + b1)); }
                else *(GLB u32x4*)(gg + ro + co) = pack8(acc[ai][bj][m][0], acc[ai][bj][m][1]); } }
    }
};
struct EpiBranch { static constexpr bool PERM = true;
    const GLB bf16_t* gate; GLB bf16_t* gout;
    __device__ __forceinline__ void operator()(const f32x4 (&acc)[2][2][4][2], const Unit& u, int wr, int wc, int fr, int fq) const {
        EPI_ROWS(u); const int n = u.pn >> 3, cb = (u.pn & 7) * 256 + ct0;
        EPI_FOR_ROWS { const size_t r = (size_t)(row0 + ai * HALF + m * 16);
#pragma unroll
            for (int bj = 0; bj < 2; ++bj) { const int c = cb + bj * HALF; f32x4 g0, g1; unpack8(*(const GLB u32x4*)(gate + r * 8192 + n * 2048 + c), g0, g1);
                f32x4 s0 = g0 * acc[ai][bj][m][0], s1 = g1 * acc[ai][bj][m][1];
                GLB u32x4* gp = (GLB u32x4*)(gout + r * 2048 + c);
                if (n > 0) { f32x4 p0, p1; unpack8(*gp, p0, p1); s0 += p0; s1 += p1; }
                *gp = pack8(s0, s1); } }
    }
};
template <bool RB, bool OB>
struct EpiResid { static constexpr bool PERM = true;
    const GLB void* resid; GLB void* out;
    __device__ __forceinline__ void operator()(const f32x4 (&acc)[2][2][4][2], const Unit& u, int wr, int wc, int fr, int fq) const {
        EPI_ROWS(u); const int cb = u.pn * 256 + ct0;
        EPI_FOR_ROWS { const size_t ro = (size_t)(row0 + ai * HALF + m * 16) * D + cb;
#pragma unroll
            for (int bj = 0; bj < 2; ++bj) { f32x4 r0, r1;
                if (RB) unpack8(*(const GLB u32x4*)((const GLB bf16_t*)resid + ro + bj * HALF), r0, r1);
                else { r0 = *(const GLB f32x4*)((const GLB float*)resid + ro + bj * HALF); r1 = *(const GLB f32x4*)((const GLB float*)resid + ro + bj * HALF + 4); }
                r0 = r0 + acc[ai][bj][m][0]; r1 = r1 + acc[ai][bj][m][1];
                if (OB) *(GLB u32x4*)((GLB bf16_t*)out + ro + bj * HALF) = pack8(r0, r1);
                else { *(GLB f32x4*)((GLB float*)out + ro + bj * HALF) = r0; *(GLB f32x4*)((GLB float*)out + ro + bj * HALF + 4) = r1; } } }
    }
};
struct EpiUp { static constexpr bool PERM = true;
    GLB bf16_t* act;
    __device__ __forceinline__ void operator()(const f32x4 (&acc)[2][2][4][2], const Unit& u, int wr, int wc, int fr, int fq) const {
        EPI_ROWS(u); const int cb = (u.pn % NCT_UP) * 128 + ct0;
        EPI_FOR_ROWS { f32x4 o[2];
#pragma unroll
            for (int n = 0; n < 2; ++n) { const f32x4 g = acc[ai][0][m][n], up = acc[ai][1][m][n];
#pragma unroll
                for (int j = 0; j < 4; ++j) o[n][j] = g[j] * sigmoidf_(g[j]) * up[j]; }
            *(GLB u32x4*)(act + (size_t)(row0 + ai * HALF + m * 16) * FF + cb) = pack8(o[0], o[1]); }
    }
};
struct EpiMoeDown { static constexpr bool PERM = true;
    GLB bf16_t* os; const GLB float* wslot; GLB float* osp; int S;
    __device__ __forceinline__ void operator()(const f32x4 (&acc)[2][2][4][2], const Unit& u, int wr, int wc, int fr, int fq) const {
        EPI_ROWS(u); const int pl = u.pn % NCT_DN;
        if (u.aux == 0) {
            const int cb = pl * 256 + ct0;
            EPI_FOR_ROWS { const int r = row0 + ai * HALF + m * 16; const float w = wslot[r]; GLB bf16_t* rp = os + (size_t)r * D + cb;
#pragma unroll
                for (int bj = 0; bj < 2; ++bj) *(GLB u32x4*)(rp + bj * HALF) = pack8(acc[ai][bj][m][0] * w, acc[ai][bj][m][1] * w); }
        } else {
            GLB float* tp = osp + ((size_t)(((u.pm - 64) * 8 + pl) * S + (u.aux - 1)) << 16);
            EPI_FOR_ROWS { const int rl = wr * 64 + fr + ai * HALF + m * 16; const float w = wslot[u.pm * BM + rl]; GLB float* rp = tp + rl * 256 + ct0;
#pragma unroll
                for (int bj = 0; bj < 2; ++bj) { *(GLB f32x4*)(rp + bj * HALF) = acc[ai][bj][m][0] * w; *(GLB f32x4*)(rp + bj * HALF + 4) = acc[ai][bj][m][1] * w; } }
        }
    }
};
template <bool OB>
struct EpiPle { static constexpr bool PERM = true;
    const GLB bf16_t* resid; GLB void* out; const GLB bf16_t* proj;
    __device__ __forceinline__ void operator()(const f32x4 (&acc)[2][2][4][2], const Unit& u, int wr, int wc, int fr, int fq) const {
        EPI_ROWS(u); const int cb = u.pn * 256 + ct0;
        EPI_FOR_ROWS { const size_t ro = (size_t)(row0 + ai * HALF + m * 16) * D + cb;
#pragma unroll
            for (int bj = 0; bj < 2; ++bj) { f32x4 p0, p1, r0, r1; unpack8(*(const GLB u32x4*)(proj + ro + bj * HALF), p0, p1); unpack8(*(const GLB u32x4*)(resid + ro + bj * HALF), r0, r1);
                r0 = r0 + sig4(acc[ai][bj][m][0]) * p0; r1 = r1 + sig4(acc[ai][bj][m][1]) * p1;
                if (OB) *(GLB u32x4*)((GLB bf16_t*)out + ro + bj * HALF) = pack8(r0, r1);
                else { *(GLB f32x4*)((GLB float*)out + ro + bj * HALF) = r0; *(GLB f32x4*)((GLB float*)out + ro + bj * HALF + 4) = r1; } } }
    }
};
struct EpiProj { static constexpr bool PERM = true;
    GLB bf16_t* proj;
    __device__ __forceinline__ void operator()(const f32x4 (&acc)[2][2][4][2], const Unit& u, int wr, int wc, int fr, int fq) const {
        EPI_ROWS(u); GLB bf16_t* base = proj + (size_t)(u.pn >> 3) * T * D + (u.pn & 7) * 256 + ct0;
        EPI_FOR_ROWS { GLB bf16_t* rp = base + (size_t)(row0 + ai * HALF + m * 16) * D;
#pragma unroll
            for (int bj = 0; bj < 2; ++bj) *(GLB u32x4*)(rp + bj * HALF) = pack8(acc[ai][bj][m][0], acc[ai][bj][m][1]); }
    }
};
}
struct Ctx {
    LAS unsigned char* lds;
    GLB unsigned char* ws;
    GLB float* out;
    int tid, lane, wave, gw, NGW, G;
};
#define WSP(type, off) ((GLB type*)(C.ws + (off)))
constexpr int INTAB_OFF = MISC_OFF + 1024;
constexpr int TAB_WS = 37, TAB_OUT = 38, TAB_RANGE = 39;
__device__ __forceinline__ const GLB void* inptr(LAS unsigned char* lds, int i) {
    const LAS unsigned* t = (const LAS unsigned*)(lds + INTAB_OFF) + 2 * i;
    const unsigned lo = __builtin_amdgcn_readfirstlane(t[0]), hi = __builtin_amdgcn_readfirstlane(t[1]);
    return (const GLB void*)(((unsigned long long)hi << 32) | lo);
}
#define INF32(i) ((const GLB float*)inptr(C.lds, (i)))
__device__ __forceinline__ Ctx make_ctx(LAS unsigned char* lds) {
    Ctx C; C.lds = lds;
    int tid = threadIdx.x; asm volatile("" : "+v"(tid));
    C.tid = tid; C.lane = tid & 63; C.wave = __builtin_amdgcn_readfirstlane(tid >> 6);
    C.G = gridDim.x; C.gw = blockIdx.x * NWAVES + C.wave; C.NGW = C.G * NWAVES;
    C.ws = (GLB unsigned char*)inptr(lds, TAB_WS); C.out = (GLB float*)inptr(lds, TAB_OUT);
    return C;
}
enum { I_X = 0, I_P, I_POS, I_WIN, I_MIXN, I_FFNN, I_PLEN, I_RWMU, I_RWW0, I_RWW2, I_RWA0, I_RWA2, I_RWG2, I_RWKK, I_RWKA, I_RWRK, I_RWLNG, I_RWLNB,
       I_DQN, I_DKN, I_DKVN, I_DWUK, I_DWUV, I_SQN, I_SKN, I_SSINK, I_WBR, I_WOUT, I_FG, I_FU, I_FD, I_MR, I_MG, I_MU, I_MD, I_PG, I_PP, N_INPUTS };

__device__ __forceinline__ void conv_tile(const GLB float* W, int ldw, int k0, int s0, int nv, GLB bf16_t* Bt, int K, int n0, LAS float* scr, int lane) {
    const int cq = lane & 15, rq = lane >> 4;
    f32x4 v[16];
#pragma unroll
    for (int i = 0; i < 16; ++i) {
        const int kk = 4 * i + rq;
        v[i] = (4 * cq < nv) ? *(const GLB f32x4*)(W + (size_t)(k0 + kk) * ldw + s0 + 4 * cq) : (f32x4){0.f, 0.f, 0.f, 0.f};
    }
#pragma unroll
    for (int i = 0; i < 16; ++i) { const int kk = 4 * i + rq; LAS float* d = scr + kk * 65 + 4 * cq; d[0] = v[i][0]; d[1] = v[i][1]; d[2] = v[i][2]; d[3] = v[i][3]; }
    LDS_WAIT();
    const int c = lane & 7;
#pragma unroll
    for (int j = 0; j < 8; ++j) { const int n = (lane >> 3) + 8 * j; const LAS float* s = scr + (8 * c) * 65 + n;
        u32x4 o; o.x = pk2(s[0 * 65], s[1 * 65]); o.y = pk2(s[2 * 65], s[3 * 65]); o.z = pk2(s[4 * 65], s[5 * 65]); o.w = pk2(s[6 * 65], s[7 * 65]);
        *(GLB u32x4*)(Bt + (size_t)(n0 + n) * K + k0 + 8 * c) = o; }
    LDS_WAIT();
}
__device__ __forceinline__ void win_map(int g, int& s0, int& nv) {
    const int d0 = 64 * g; nv = 64;
    if (d0 < 8704) s0 = d0;
    else if (d0 < 9728) s0 = 8784 + (d0 - 8704);
    else if (d0 < 9984) s0 = 9808 + (d0 - 9728);
    else if (d0 < 10240) { const int off = d0 - 9984; if (off == 0) s0 = 8704; else if (off == 64) { s0 = 8768; nv = 16; } else { s0 = 0; nv = 0; } }
    else s0 = 10064 + (d0 - 10240);
}
#ifndef MOE_SCAN_TILES
#define MOE_SCAN_TILES 42
#endif
#ifndef MOE_CONV_IN_PROLOGUE
#define MOE_CONV_IN_PROLOGUE 0
#endif
constexpr int MOE_CONV_ITEMS = NE * ((D / 64) * (2 * FF / 64) + (FF / 64) * (D / 64));
__device__ __forceinline__ void conv_moe_item(const Ctx& C, int idx, LAS float* scr, int lane) {
    constexpr int I_GU1 = (D / 64) * (2 * FF / 64), I_DN1 = (FF / 64) * (D / 64);
    if (idx < NE * I_GU1) {
        const int e = idx / I_GU1, r = idx % I_GU1, nb = r % (2 * FF / 64), kb = r / (2 * FF / 64);
        const int tile = nb >> 2, q = nb & 3; const int sc = 128 * tile + 64 * (q & 1);
        conv_tile(((q < 2) ? INF32(I_MG) : INF32(I_MU)) + (size_t)e * D * FF, FF, 64 * kb, sc, 64, WSP(bf16_t, WS_MWGU) + (size_t)e * 2 * FF * D, D, 64 * nb, scr, lane);
    } else {
        const int r0 = idx - NE * I_GU1, e = r0 / I_DN1, r = r0 % I_DN1, nb = r % 32, kb = r / 32;
        conv_tile(INF32(I_MD) + (size_t)e * FF * D, D, 64 * kb, 64 * nb, 64, WSP(bf16_t, WS_MWD) + (size_t)e * D * FF, FF, 64 * nb, scr, lane);
    }
}
__device__ __forceinline__ void ph_prologue(const Ctx& C) {
    LAS float* scr = (LAS float*)(C.lds + C.wave * 16640);
    const int gw = C.gw, NGW = C.NGW; int lane = C.lane; asm volatile("" : "+v"(lane)); lane &= 63;
    constexpr int I_WIN1 = (D / 64) * (N_INP / 64);
    constexpr int I_BR1 = (1024 / 64) * (2048 / 64);
    constexpr int I_DD = (D / 64) * (D / 64);
    constexpr int I_GU1 = (D / 64) * (2 * FF / 64);
    constexpr int I_DN1 = (FF / 64) * (D / 64);
    constexpr int I_PP1 = (256 / 64) * (D / 64);
    constexpr int S0 = 0, S1 = S0 + NL * I_WIN1, S2 = S1 + NL * 4 * I_BR1, S3 = S2 + NL * I_DD, S4 = S3 + I_GU1, S5 = S4 + I_DN1, S6 = S5 + NE * I_GU1, S7 = S6 + NE * I_DN1,
                  S8 = S7 + NL * I_DD, S9 = S8 + NL * I_PP1;
    for (int it = gw; it < S9; it += NGW) {
        if (it < S1) { const int l = it / I_WIN1, r = it % I_WIN1, nb = r % (N_INP / 64), kb = r / (N_INP / 64); int s0, nv; win_map(nb, s0, nv);
            conv_tile(INF32(I_WIN) + (size_t)l * D * N_IN, N_IN, 64 * kb, s0, nv, WSP(bf16_t, WS_WIN + l * SZ_WIN1), D, 64 * nb, scr, lane); }
        else if (it < S2) { const int q = (it - S1) / I_BR1, r = (it - S1) % I_BR1, nb = r % 32, kb = r / 32;
            conv_tile(INF32(I_WBR) + (size_t)q * 1024 * 2048, 2048, 64 * kb, 64 * nb, 64, WSP(bf16_t, WS_WBR) + (size_t)q * 2048 * 1024, 1024, 64 * nb, scr, lane); }
        else if (it < S3) { const int l = (it - S2) / I_DD, r = (it - S2) % I_DD, nb = r % 32, kb = r / 32;
            conv_tile(INF32(I_WOUT) + (size_t)l * D * D, D, 64 * kb, 64 * nb, 64, WSP(bf16_t, WS_WOUT + l * SZ_DD), D, 64 * nb, scr, lane); }
        else if (it < S4) {
            const int r = it - S3, nb = r % (2 * FF / 64), kb = r / (2 * FF / 64);
            const int tile = nb >> 2, q = nb & 3; const int sc = 128 * tile + 64 * (q & 1);
            conv_tile((q < 2) ? INF32(I_FG) : INF32(I_FU), FF, 64 * kb, sc, 64, WSP(bf16_t, WS_WGU), D, 64 * nb, scr, lane); }
        else if (it < S5) { const int r = it - S4, nb = r % 32, kb = r / 32;
            conv_tile(INF32(I_FD), D, 64 * kb, 64 * nb, 64, WSP(bf16_t, WS_WD), FF, 64 * nb, scr, lane); }
        else if (it < S7) { if (MOE_CONV_IN_PROLOGUE || it - S5 >= 2 * 1024 * MOE_SCAN_TILES) conv_moe_item(C, it - S5, scr, lane); }
        else if (it < S8) { const int l = (it - S7) / I_DD, r = (it - S7) % I_DD, nb = r % 32, kb = r / 32;
            conv_tile(INF32(I_PG) + (size_t)l * D * D, D, 64 * kb, 64 * nb, 64, WSP(bf16_t, WS_WPG + l * SZ_DD), D, 64 * nb, scr, lane); }
        else { const int l = (it - S8) / I_PP1, r = (it - S8) % I_PP1, nb = r % 32, kb = r / 32;
            conv_tile(INF32(I_PP) + (size_t)l * 256 * D, D, 64 * kb, 64 * nb, 64, WSP(bf16_t, WS_WPP) + (size_t)l * D * 256, 256, 64 * nb, scr, lane); }
    }
    for (int idx = gw * 64 + lane; idx < NL * 3072 * 256; idx += NGW * 64) {
        const int k = idx & 255, n = (idx >> 8) % 3072, l = idx / (3072 * 256);
        float v = 0.f;
        if (n < 1024) { if (k < 96) v = INF32(I_RWW2)[((size_t)l * 96 + k) * 1024 + n]; }
        else if (n < 2048) { if (k >= 96 && k < 192) v = INF32(I_RWA2)[((size_t)l * 96 + (k - 96)) * 1024 + (n - 1024)]; }
        else { if (k >= 192) v = INF32(I_RWG2)[((size_t)l * 64 + (k - 192)) * 1024 + (n - 2048)]; }
        WSP(bf16_t, WS_WLORA)[idx] = (bf16_t)f2bf(v);
    }
    for (int idx = gw * 64 + lane; idx < NL * T * 64; idx += NGW * 64) {
        const int c4 = idx & 63, t = (idx >> 6) % T, l = idx / (T * 64);
        const f32x4 v = *(const GLB f32x4*)(INF32(I_P) + ((size_t)l * T + t) * 256 + 4 * c4);
        u32x2 o; o.x = pk2(v[0], v[1]); o.y = pk2(v[2], v[3]);
        *(GLB u32x2*)(WSP(bf16_t, WS_PCAT) + (size_t)t * 512 + l * 256 + 4 * c4) = o;
    }
}

template <int MODE, bool XBF = true>
__device__ __forceinline__ void ph_norm(const Ctx& C, const GLB void* xin, GLB void* xout, const GLB float* gain, const GLB float* router, int moeS = 1) {
    int lane = C.lane; asm volatile("" : "+v"(lane)); lane &= 63;
    for (int m = C.gw; m < T; m += C.NGW) {
        f32x4 v[8]; float s = 0.f;
        if (XBF) { const GLB u32x2* xr = (const GLB u32x2*)((const GLB bf16_t*)xin + (size_t)m * D) + lane;
#pragma unroll
            for (int j = 0; j < 8; ++j) { const u32x2 w = xr[64 * j]; v[j] = (f32x4){bflo(w.x), bfhi(w.x), bflo(w.y), bfhi(w.y)}; }
        } else { const GLB f32x4* xr = (const GLB f32x4*)((const GLB float*)xin + (size_t)m * D) + lane;
#pragma unroll
            for (int j = 0; j < 8; ++j) v[j] = xr[64 * j]; }
        if (MODE == 2) {
            const GLB int* ts = WSP(int, WS_TOKSLOT) + 2 * m;
#pragma unroll
            for (int q = 0; q < 2; ++q) {
                const int sl = ts[q];
                if (sl < 64 * 256 || moeS <= 1) {
                    const GLB u32x2* o0 = (const GLB u32x2*)(WSP(bf16_t, WS_OS) + (size_t)sl * D) + lane;
#pragma unroll
                    for (int j = 0; j < 8; ++j) { const u32x2 w = o0[64 * j]; v[j] = v[j] + (f32x4){bflo(w.x), bfhi(w.x), bflo(w.y), bfhi(w.y)}; }
                } else {
                    const int tu0 = ((sl >> 8) - 64) * 8, rl = sl & 255;
#pragma unroll
                    for (int j = 0; j < 8; ++j)
                        for (int k = 0; k < moeS; ++k) v[j] = v[j] + *((const GLB f32x4*)(WSP(float, WS_OSP) + ((size_t)((tu0 + j) * moeS + k) << 16) + rl * 256) + lane);
                }
            }
#pragma unroll
            for (int j = 0; j < 8; ++j) { u32x2 o; o.x = pk2(v[j][0], v[j][1]); o.y = pk2(v[j][2], v[j][3]); ((GLB u32x2*)((GLB bf16_t*)xout + (size_t)m * D) + lane)[64 * j] = o;
                v[j] = (f32x4){bflo(o.x), bfhi(o.x), bflo(o.y), bfhi(o.y)}; }
        }
#pragma unroll
        for (int j = 0; j < 8; ++j) s += (v[j][0] * v[j][0] + v[j][1] * v[j][1]) + (v[j][2] * v[j][2] + v[j][3] * v[j][3]);
        const float rstd = 1.0f / sqrtf(wave_sum(s) * (1.0f / D) + 1e-6f);
        GLB u32x2* o8 = (GLB u32x2*)(WSP(bf16_t, WS_H) + (size_t)m * D) + lane;
        float lg[NE];
        if (MODE == 1) {
#pragma unroll
            for (int e = 0; e < NE; ++e) lg[e] = 0.f;
        }
#pragma unroll
        for (int j = 0; j < 8; ++j) { const f32x4 g = ((const GLB f32x4*)gain)[lane + 64 * j]; const f32x4 hv = v[j] * rstd * g; v[j] = hv;
            u32x2 o; o.x = pk2(hv[0], hv[1]); o.y = pk2(hv[2], hv[3]); o8[64 * j] = o; }
        if (MODE == 1) {
#pragma unroll 2
            for (int j = 0; j < 8; ++j) {
#pragma unroll
                for (int q = 0; q < 4; ++q) { const GLB f32x4* rr = (const GLB f32x4*)(router + (size_t)(4 * (lane + 64 * j) + q) * NE); const f32x4 r0 = rr[0], r1 = rr[1]; const float hq = v[j][q];
                    lg[0] += hq * r0[0]; lg[1] += hq * r0[1]; lg[2] += hq * r0[2]; lg[3] += hq * r0[3]; lg[4] += hq * r1[0]; lg[5] += hq * r1[1]; lg[6] += hq * r1[2]; lg[7] += hq * r1[3]; }
            }
        }
        if (MODE == 1) {
#pragma unroll
            for (int e = 0; e < NE; ++e) lg[e] = wave_sum(lg[e]);
            if (lane == 0) {
                int e1 = 0; float v1 = lg[0];
#pragma unroll
                for (int e = 1; e < NE; ++e) if (lg[e] > v1) { v1 = lg[e]; e1 = e; }
                int e2 = -1; float v2 = -3.0e38f;
#pragma unroll
                for (int e = 0; e < NE; ++e) if (e != e1 && lg[e] > v2) { v2 = lg[e]; e2 = e; }
                const float ex = __expf(v2 - v1), w1 = 1.0f / (1.0f + ex), w2 = ex / (1.0f + ex);
                GLB unsigned* cnt = WSP(unsigned, WS_CTL) + CW_MOECNT;
                const unsigned p1 = atomicAdd((unsigned*)cnt + 64 * e1, 1u), p2 = atomicAdd((unsigned*)cnt + 64 * e2, 1u);
                GLB unsigned* rt = WSP(unsigned, WS_ROUTE) + (size_t)m * 8;
                rt[0] = (unsigned)e1; rt[1] = p1; rt[2] = __builtin_bit_cast(unsigned, w1); rt[3] = (unsigned)e2; rt[4] = p2; rt[5] = __builtin_bit_cast(unsigned, w2);
            }
        }
    }
}
__device__ __forceinline__ void moe_offsets(const Ctx& C, int (&toff)[NE + 1]) {
    const GLB unsigned* cnt = WSP(unsigned, WS_CTL) + CW_MOECNT; int acc = 0;
#pragma unroll
    for (int e = 0; e < NE; ++e) { toff[e] = acc; const unsigned c = __hip_atomic_load(cnt + 64 * e, __ATOMIC_RELAXED, __HIP_MEMORY_SCOPE_AGENT); acc += (int)((c + 255u) >> 8); }
    toff[NE] = acc;
}
constexpr int MOETAB_OFF = MISC_OFF + 2048;
__device__ __forceinline__ void moe_tile_table(const Ctx& C) {
    int toff[NE + 1]; moe_offsets(C, toff);
    LAS int* tab = (LAS int*)(C.lds + MOETAB_OFF);
    if (C.tid <= MOE_MAXRT) { int e = 0;
#pragma unroll
        for (int j = 1; j < NE; ++j) e += (C.tid >= toff[j]) ? 1 : 0;
        tab[C.tid] = (C.tid == MOE_MAXRT) ? toff[NE] : e; }
    LDS_WAIT(); __syncthreads();
}
__device__ __forceinline__ void ph_moe_gather(const Ctx& C) {
    int toff[NE + 1]; moe_offsets(C, toff);
    int lane = C.lane; asm volatile("" : "+v"(lane)); lane &= 63;
    for (int m = C.gw; m < T; m += C.NGW) {
        const GLB unsigned* rt = WSP(unsigned, WS_ROUTE) + (size_t)m * 8;
        const int e1 = (int)rt[0], p1 = (int)rt[1], e2 = (int)rt[3], p2 = (int)rt[4];
        int o1 = 0, o2 = 0;
#pragma unroll
        for (int e = 0; e < NE; ++e) { o1 = (e == e1) ? toff[e] : o1; o2 = (e == e2) ? toff[e] : o2; }
        const int s1 = o1 * 256 + p1, s2 = o2 * 256 + p2;
        const GLB u32x4* src = (const GLB u32x4*)(WSP(bf16_t, WS_H) + (size_t)m * D) + lane;
        GLB u32x4* d1 = (GLB u32x4*)(WSP(bf16_t, WS_HS) + (size_t)s1 * D) + lane; GLB u32x4* d2 = (GLB u32x4*)(WSP(bf16_t, WS_HS) + (size_t)s2 * D) + lane;
#pragma unroll
        for (int j = 0; j < 4; ++j) { const u32x4 v = src[64 * j]; d1[64 * j] = v; d2[64 * j] = v; }
        if (lane == 0) { WSP(int, WS_TOKSLOT)[2 * m] = s1; WSP(int, WS_TOKSLOT)[2 * m + 1] = s2;
            WSP(unsigned, WS_WSLOT)[s1] = rt[2]; WSP(unsigned, WS_WSLOT)[s2] = rt[5]; }
    }
}

__device__ __forceinline__ float rope_inv_freq(int i, int half) { return exp2f(-13.287712379549449f * (float)i / (float)half); }
__device__ __forceinline__ void ph_prep(const Ctx& C, int l) {
    int lane = C.lane; asm volatile("" : "+v"(lane)); lane &= 63;
    const GLB bf16_t* UF = WSP(bf16_t, WS_UF);
    const int d = lane & 31, hh = lane >> 5;
    for (int m = C.gw; m < T; m += C.NGW) {
        const int t = m % SEQ;
        const GLB bf16_t* u = UF + (size_t)m * UFW;
        const float posf = (float)((const GLB int*)inptr(C.lds, I_POS))[m];
        float qa[8], qb[8], ia[8], ib[8], sa[8], sb[8];
#pragma unroll
        for (int h = 0; h < 8; ++h) { qa[h] = bf1(u[UF_DQ + h * 128 + lane]); qb[h] = bf1(u[UF_DQ + h * 128 + 64 + lane]); }
#pragma unroll
        for (int hp = 0; hp < 8; ++hp) { const int h = 2 * hp + hh; ia[hp] = bf1(u[UF_IQ + h * 64 + d]); ib[hp] = bf1(u[UF_IQ + h * 64 + 32 + d]); sa[hp] = bf1(u[UF_SQ + h * 64 + d]); sb[hp] = bf1(u[UF_SQ + h * 64 + 32 + d]); }
        const float ika = bf1(u[UF_IK + d]), ikb = bf1(u[UF_IK + 32 + d]), iwv = bf1(u[UF_IW + (lane & 15)]);
        const float ska = bf1(u[UF_SK + hh * 64 + d]), skb = bf1(u[UF_SK + hh * 64 + 32 + d]), sv0 = bf1(u[UF_SV + lane]), sv1 = bf1(u[UF_SV + 64 + lane]);
        {
            const GLB float* mu = INF32(I_RWMU) + (size_t)l * 3328;
#pragma unroll
            for (int half = 0; half < 2; ++half) {
                constexpr int J0[2] = {0, 7}, J1[2] = {7, 13};
                f32x4 cur[7], prv[7], mm[7];
#pragma unroll
                for (int j = J0[half]; j < J1[half]; ++j) { const int c = 4 * (lane + 64 * j), q = j - J0[half];
                    { const u32x2 w = *(const GLB u32x2*)(u + UF_RW + c); cur[q] = (f32x4){bflo(w.x), bfhi(w.x), bflo(w.y), bfhi(w.y)}; }
                    if (t > 0) { const u32x2 w = *(const GLB u32x2*)(u - UFW + UF_RW + c); prv[q] = (f32x4){bflo(w.x), bfhi(w.x), bflo(w.y), bfhi(w.y)}; } else prv[q] = (f32x4){0.f, 0.f, 0.f, 0.f};
                    mm[q] = *(const GLB f32x4*)(mu + c); }
#pragma unroll
                for (int j = J0[half]; j < J1[half]; ++j) { const int c = 4 * (lane + 64 * j), q = j - J0[half];
                    const f32x4 o = cur[q] + mm[q] * (prv[q] - cur[q]);
                    if (j < 12) { GLB bf16_t* dst = WSP(bf16_t, (j < 4 ? WS_R : (j < 8 ? WS_K : WS_V))) + (size_t)m * 1024 + (c & 1023); u32x2 w; w.x = pk2(o[0], o[1]); w.y = pk2(o[2], o[3]); *(GLB u32x2*)dst = w; }
                    else { const int k = c - 3072; f32x4 a;
                        if (k < 96) a = (f32x4){tanhf(o[0]), tanhf(o[1]), tanhf(o[2]), tanhf(o[3])};
                        else if (k < 192) a = o;
                        else a = pg8::sig4(o);
                        u32x2 w; w.x = pk2(a[0], a[1]); w.y = pk2(a[2], a[3]);
                        *(GLB u32x2*)(WSP(bf16_t, WS_ALORA) + (size_t)m * 256 + k) = w; }
                }
            }
        }
        {
            const float invf = rope_inv_freq(lane, 64); float sn, cn; sincosf(posf * invf, &sn, &cn);
            const float g1 = INF32(I_DQN)[l * 128 + lane], g2 = INF32(I_DQN)[l * 128 + 64 + lane];
#pragma unroll
            for (int h = 0; h < 8; ++h) {
                const float a = qa[h], b = qb[h];
                const float rs = 1.0f / sqrtf(wave_sum(a * a + b * b) * (1.0f / 128.f) + 1e-6f);
                const float x1 = a * rs * g1, x2 = b * rs * g2;
                GLB bf16_t* q = WSP(bf16_t, WS_QD) + (size_t)m * 1024 + h * 128;
                q[lane] = (bf16_t)f2bf(x1 * cn - x2 * sn); q[64 + lane] = (bf16_t)f2bf(x2 * cn + x1 * sn);
            }
        }
        {
            const float invf = rope_inv_freq(d, 32); float sn, cn; sincosf(posf * invf, &sn, &cn);
#pragma unroll
            for (int hp = 0; hp < 8; ++hp) { const int h = 2 * hp + hh; const float a = ia[hp], b = ib[hp];
                GLB bf16_t* q = WSP(bf16_t, WS_QI) + (size_t)m * 1024 + h * 64; q[d] = (bf16_t)f2bf(a * cn - b * sn); q[32 + d] = (bf16_t)f2bf(b * cn + a * sn); }
            if (hh == 0) { GLB bf16_t* q = WSP(bf16_t, WS_KI) + (size_t)m * 64; q[d] = (bf16_t)f2bf(ika * cn - ikb * sn); q[32 + d] = (bf16_t)f2bf(ikb * cn + ika * sn); }
            if (lane < 16) WSP(float, WS_WI)[(size_t)m * 16 + lane] = iwv * 0.03125f;
            const float sg1 = INF32(I_SQN)[l * 64 + d], sg2 = INF32(I_SQN)[l * 64 + 32 + d];
#pragma unroll
            for (int hp = 0; hp < 8; ++hp) { const int h = 2 * hp + hh; const float a = sa[hp], b = sb[hp];
                float s2 = a * a + b * b;
#pragma unroll
                for (int o = 1; o < 32; o <<= 1) s2 += __shfl_xor(s2, o);
                const float rs = 1.0f / sqrtf(s2 * (1.0f / 64.f) + 1e-6f); const float x1 = a * rs * sg1, x2 = b * rs * sg2;
                GLB bf16_t* q = WSP(bf16_t, WS_QS) + (size_t)m * 1024 + h * 64; q[d] = (bf16_t)f2bf(x1 * cn - x2 * sn); q[32 + d] = (bf16_t)f2bf(x2 * cn + x1 * sn); }
            { const float kg1 = INF32(I_SKN)[l * 64 + d], kg2 = INF32(I_SKN)[l * 64 + 32 + d];
              float s2 = ska * ska + skb * skb;
#pragma unroll
              for (int o = 1; o < 32; o <<= 1) s2 += __shfl_xor(s2, o);
              const float rs = 1.0f / sqrtf(s2 * (1.0f / 64.f) + 1e-6f); const float x1 = ska * rs * kg1, x2 = skb * rs * kg2;
              GLB bf16_t* q = WSP(bf16_t, WS_KS) + (size_t)m * 128 + hh * 64; q[d] = (bf16_t)f2bf(x1 * cn - x2 * sn); q[32 + d] = (bf16_t)f2bf(x2 * cn + x1 * sn);
              GLB bf16_t* vv = WSP(bf16_t, WS_VS) + (size_t)m * 128; vv[lane] = (bf16_t)f2bf(sv0); vv[64 + lane] = (bf16_t)f2bf(sv1); }
        }
    }
}

__device__ __forceinline__ void ph_latent(const Ctx& C, int l) {
    int lane = C.lane; asm volatile("" : "+v"(lane)); lane &= 63;
    LAS float* cs = (LAS float*)(C.lds + C.wave * 8192);
    const GLB bf16_t* UF = WSP(bf16_t, WS_UF);
    const GLB float* wuk = INF32(I_DWUK) + (size_t)l * 256 * 128; const GLB float* wuv = INF32(I_DWUV) + (size_t)l * 256 * 128;
    for (int g8 = C.gw; g8 < T / 8; g8 += C.NGW) {
        const int m0 = 8 * g8;
        float cv[8][4];
#pragma unroll
        for (int tk = 0; tk < 8; ++tk)
#pragma unroll
            for (int j = 0; j < 4; ++j) cv[tk][j] = bf1(UF[(size_t)(m0 + tk) * UFW + UF_CKV + lane + 64 * j]);
#pragma unroll
        for (int tk = 0; tk < 8; ++tk) {
            float ss = 0.f;
#pragma unroll
            for (int j = 0; j < 4; ++j) ss += cv[tk][j] * cv[tk][j];
            const float rc = 1.0f / sqrtf(wave_sum(ss) * (1.0f / 256.f) + 1e-6f);
#pragma unroll
            for (int j = 0; j < 4; ++j) cs[(lane + 64 * j) * 8 + tk] = cv[tk][j] * rc * INF32(I_DKVN)[l * 256 + lane + 64 * j];
        }
        LDS_WAIT();
        float acc[8][4];
#pragma unroll
        for (int tk = 0; tk < 8; ++tk) { acc[tk][0] = 0.f; acc[tk][1] = 0.f; acc[tk][2] = 0.f; acc[tk][3] = 0.f; }
#pragma unroll 8
        for (int k = 0; k < 256; ++k) {
            const float w0 = wuk[k * 128 + lane], w1 = wuk[k * 128 + 64 + lane], w2 = wuv[k * 128 + lane], w3 = wuv[k * 128 + 64 + lane];
            const f32x4 ca = *(const LAS f32x4*)(cs + k * 8), cb = *(const LAS f32x4*)(cs + k * 8 + 4);
#pragma unroll
            for (int tk = 0; tk < 8; ++tk) { const float c = (tk < 4) ? ca[tk & 3] : cb[tk & 3]; acc[tk][0] += c * w0; acc[tk][1] += c * w1; acc[tk][2] += c * w2; acc[tk][3] += c * w3; }
        }
        const float invf = rope_inv_freq(lane, 64);
        const float g1 = INF32(I_DKN)[l * 128 + lane], g2 = INF32(I_DKN)[l * 128 + 64 + lane];
#pragma unroll
        for (int tk = 0; tk < 8; ++tk) {
            const int m = m0 + tk;
            const float posf = (float)((const GLB int*)inptr(C.lds, I_POS))[m];
            float sn, cn; sincosf(posf * invf, &sn, &cn);
            const float k1 = acc[tk][0], k2 = acc[tk][1];
            const float rk = 1.0f / sqrtf(wave_sum(k1 * k1 + k2 * k2) * (1.0f / 128.f) + 1e-6f);
            const float y1 = k1 * rk * g1, y2 = k2 * rk * g2;
            GLB bf16_t* kd = WSP(bf16_t, WS_KD) + (size_t)m * 128; GLB bf16_t* vd = WSP(bf16_t, WS_VD) + (size_t)m * 128;
            kd[lane] = (bf16_t)f2bf(y1 * cn - y2 * sn); kd[64 + lane] = (bf16_t)f2bf(y2 * cn + y1 * sn);
            vd[lane] = (bf16_t)f2bf(acc[tk][2]); vd[64 + lane] = (bf16_t)f2bf(acc[tk][3]);
        }
        LDS_WAIT();
    }
}

__device__ __forceinline__ void ph_rwkv_kk(const Ctx& C, int l) {
    int lane = C.lane; asm volatile("" : "+v"(lane)); lane &= 63;
    for (int m = C.gw; m < T; m += C.NGW) {
#pragma unroll
        for (int i = 0; i < 4; ++i) {
            const int c = 256 * i + 4 * lane; const size_t o = (size_t)m * 1024 + c;
            const f32x4 k = *(const GLB f32x4*)(WSP(float, WS_K) + o), a = *(const GLB f32x4*)(WSP(float, WS_AA) + o);
            const f32x4 kkw = *(const GLB f32x4*)(INF32(I_RWKK) + l * 1024 + c), ka = *(const GLB f32x4*)(INF32(I_RWKA) + l * 1024 + c);
            f32x4 kk = k * kkw; float s = (kk[0] * kk[0] + kk[1] * kk[1]) + (kk[2] * kk[2] + kk[3] * kk[3]);
#pragma unroll
            for (int q = 1; q < 16; q <<= 1) s += __shfl_xor(s, q);
            const float inv = 1.0f / fmaxf(sqrtf(s), 1e-12f); kk = kk * inv;
            *(GLB f32x4*)(WSP(float, WS_KK) + o) = kk;
            *(GLB f32x4*)(WSP(float, WS_K) + o) = k * (1.0f + (a - 1.0f) * ka);
            *(GLB f32x4*)(WSP(float, WS_AA) + o) = kk * a;
        }
    }
}
__device__ __forceinline__ void ph_rwkv_scan_naive(const Ctx& C) {
    if (C.wave != 0) return;
    int lane = C.lane; asm volatile("" : "+v"(lane)); lane &= 63;
    LAS float* buf = (LAS float*)C.lds;
    for (int it = blockIdx.x; it < NB * 16; it += C.G) {
        const int b = it >> 4, h = it & 15;
        float S[64];
#pragma unroll
        for (int k = 0; k < 64; ++k) S[k] = 0.f;
        const size_t base = (size_t)b * SEQ * 1024 + h * 64 + lane;
        for (int t0 = 0; t0 < SEQ; t0 += 16) {
#pragma unroll
            for (int st = 0; st < 16; ++st) { const size_t o = base + (size_t)(t0 + st) * 1024; LAS float* d = buf + st * 384 + lane;
                d[0] = WSP(float, WS_R)[o]; d[64] = WSP(float, WS_DEC)[o]; d[128] = WSP(float, WS_K)[o]; d[192] = WSP(float, WS_KK)[o]; d[256] = WSP(float, WS_AA)[o]; d[320] = WSP(float, WS_V)[o]; }
            LDS_WAIT();
            for (int st = 0; st < 16; ++st) {
                const LAS float* rb = buf + st * 384;
                float p = 0.f;
#pragma unroll
                for (int k = 0; k < 64; k += 4) { const f32x4 q = *(const LAS f32x4*)(rb + 192 + k); p += S[k] * q[0] + S[k + 1] * q[1] + S[k + 2] * q[2] + S[k + 3] * q[3]; }
                const float vv = rb[320 + lane]; float y = 0.f;
#pragma unroll
                for (int k = 0; k < 64; k += 4) { const f32x4 w = *(const LAS f32x4*)(rb + 64 + k), bb = *(const LAS f32x4*)(rb + 256 + k), kq = *(const LAS f32x4*)(rb + 128 + k), r = *(const LAS f32x4*)(rb + k);
#pragma unroll
                    for (int j = 0; j < 4; ++j) { S[k + j] = S[k + j] * w[j] - p * bb[j] + vv * kq[j]; y += S[k + j] * r[j]; } }
                WSP(float, WS_YRAW)[base + (size_t)(t0 + st) * 1024] = y;
            }
            LDS_WAIT();
        }
    }
}
__device__ __forceinline__ f32x4 ld4bf(const GLB bf16_t* q) { const u32x2 w = *(const GLB u32x2*)q; return (f32x4){bflo(w.x), bfhi(w.x), bflo(w.y), bfhi(w.y)}; }
__device__ __forceinline__ void ph_rwkv_post(const Ctx& C, int l) {
    int lane = C.lane; asm volatile("" : "+v"(lane)); lane &= 63;
    if (C.wave >= 4) return;
    for (int m = blockIdx.x * 4 + C.wave; m < T; m += C.G * 4) {
#pragma unroll
        for (int i = 0; i < 4; ++i) {
            const int c = 256 * i + 4 * lane; const size_t o = (size_t)m * 1024 + c;
            const f32x4 y = *(const GLB f32x4*)(WSP(float, WS_YRAW) + o);
            float s = (y[0] + y[1]) + (y[2] + y[3]);
#pragma unroll
            for (int q = 1; q < 16; q <<= 1) s += __shfl_xor(s, q);
            const float mean = s * (1.0f / 64.f); const f32x4 dlt = y - mean;
            float s2 = (dlt[0] * dlt[0] + dlt[1] * dlt[1]) + (dlt[2] * dlt[2] + dlt[3] * dlt[3]);
#pragma unroll
            for (int q = 1; q < 16; q <<= 1) s2 += __shfl_xor(s2, q);
            const float rstd = 1.0f / sqrtf(s2 * (1.0f / 64.f) + 64e-5f);
            const f32x4 r = ld4bf(WSP(bf16_t, WS_R) + o), kraw = ld4bf(WSP(bf16_t, WS_K) + o), av = ld4bf(WSP(bf16_t, WS_AA) + o), v = ld4bf(WSP(bf16_t, WS_V) + o), g = ld4bf(WSP(bf16_t, WS_GG) + o);
            const f32x4 k = kraw * (1.0f + (av - 1.0f) * *(const GLB f32x4*)(INF32(I_RWKA) + l * 1024 + c));
            const f32x4 rk = *(const GLB f32x4*)(INF32(I_RWRK) + l * 1024 + c), lg = *(const GLB f32x4*)(INF32(I_RWLNG) + l * 1024 + c), lb = *(const GLB f32x4*)(INF32(I_RWLNB) + l * 1024 + c);
            const f32x4 pr = r * k * rk; float bs = (pr[0] + pr[1]) + (pr[2] + pr[3]);
#pragma unroll
            for (int q = 1; q < 16; q <<= 1) bs += __shfl_xor(bs, q);
            const f32x4 res = (dlt * rstd * lg + lb + bs * v) * g;
            u32x2 w; w.x = pk2(res[0], res[1]); w.y = pk2(res[2], res[3]);
            *(GLB u32x2*)(WSP(bf16_t, WS_Y) + (size_t)m * 4096 + 1024 + c) = w;
        }
    }
}
__device__ __forceinline__ float dot8(u32x4 kv, f32x4 qa, f32x4 qb) {
    return bflo(kv.x) * qa[0] + bfhi(kv.x) * qa[1] + bflo(kv.y) * qa[2] + bfhi(kv.y) * qa[3] + bflo(kv.z) * qb[0] + bfhi(kv.z) * qb[1] + bflo(kv.w) * qb[2] + bfhi(kv.w) * qb[3];
}
__device__ __forceinline__ void ph_sb_naive(const Ctx& C) {
    int lane = C.lane; asm volatile("" : "+v"(lane));
    LAS float* qs = (LAS float*)(C.lds + C.wave * 512);
    const GLB bf16_t* QKV = WSP(bf16_t, WS_SBQKV); GLB bf16_t* Y = WSP(bf16_t, WS_Y);
    for (int it = C.gw; it < NB * 8 * SEQ; it += C.NGW) {
        const int t = it % SEQ, bh = it / SEQ, h = bh & 7, b = bh >> 3;
        const size_t m = (size_t)b * SEQ + t;
        { const unsigned qq = *(const GLB unsigned*)(QKV + m * 3072 + h * 128 + 2 * lane); qs[2 * lane] = bflo(qq); qs[2 * lane + 1] = bfhi(qq); }
        LDS_WAIT();
        float o0 = 0.f, o1 = 0.f, carry = 0.f;
        const int nch = (t + 63) >> 6;
        for (int c = nch - 1; c >= 0; --c) {
            const int s = c * 64 + lane; const bool valid = s < t; const int sc = valid ? s : 0;
            const GLB u32x4* kp = (const GLB u32x4*)(QKV + ((size_t)b * SEQ + sc) * 3072 + 1024 + h * 128);
            float dot = 0.f;
#pragma unroll
            for (int j = 0; j < 16; ++j) dot += dot8(kp[j], *(const LAS f32x4*)(qs + 8 * j), *(const LAS f32x4*)(qs + 8 * j + 4));
            const float z = dot * 0.08838834764831845f;
            const float lk = valid ? logsigf_(-z) : 0.f, lb = logsigf_(z);
            float inc = lk;
#pragma unroll
            for (int off = 1; off < 64; off <<= 1) { const float o = __shfl_down(inc, off); if (lane + off < 64) inc += o; }
            const float w = valid ? __expf(lb + carry + inc - lk) : 0.f;
            carry += rdlane(inc, 0);
            const int nk = (t - c * 64) < 64 ? (t - c * 64) : 64;
            const GLB bf16_t* vp = QKV + ((size_t)b * SEQ + c * 64) * 3072 + 2048 + h * 128 + 2 * lane;
            for (int j = 0; j < nk; ++j) { const float wj = rdlane(w, j); const unsigned vv = *(const GLB unsigned*)(vp + (size_t)j * 3072); o0 += wj * bflo(vv); o1 += wj * bfhi(vv); }
        }
        *(GLB unsigned*)(Y + m * 4096 + h * 128 + 2 * lane) = pk2(o0, o1);
        LDS_WAIT();
    }
}
__device__ __forceinline__ void ph_swa_naive(const Ctx& C, int l) {
    int lane = C.lane; asm volatile("" : "+v"(lane));
    LAS float* qs = (LAS float*)(C.lds + C.wave * 512);
    const GLB bf16_t* QS = WSP(bf16_t, WS_QS); const GLB bf16_t* KS = WSP(bf16_t, WS_KS); const GLB bf16_t* VS = WSP(bf16_t, WS_VS); GLB bf16_t* Y = WSP(bf16_t, WS_Y);
    for (int it = C.gw; it < T * 16; it += C.NGW) {
        const int h = it & 15, m = it >> 4, t = m % SEQ, b = m / SEQ, kvh = h >> 3;
        qs[lane] = bf1(QS[(size_t)m * 1024 + h * 64 + lane]);
        LDS_WAIT();
        float lg[2];
#pragma unroll
        for (int i = 0; i < 2; ++i) { const int s = t - 127 + lane + 64 * i; const bool valid = s >= 0;
            const GLB u32x4* kp = (const GLB u32x4*)(KS + ((size_t)b * SEQ + (valid ? s : 0)) * 128 + kvh * 64);
            float dot = 0.f;
#pragma unroll
            for (int j = 0; j < 8; ++j) dot += dot8(kp[j], *(const LAS f32x4*)(qs + 8 * j), *(const LAS f32x4*)(qs + 8 * j + 4));
            lg[i] = valid ? dot * 0.125f : -3.0e38f; }
        const float sink = INF32(I_SSINK)[l * 16 + h];
        const float mx = fmaxf(wave_max(fmaxf(lg[0], lg[1])), sink);
        const float e0 = (lg[0] > -1.0e38f) ? __expf(lg[0] - mx) : 0.f, e1 = (lg[1] > -1.0e38f) ? __expf(lg[1] - mx) : 0.f;
        const float den = wave_sum(e0 + e1) + __expf(sink - mx);
        const float p0 = e0 / den, p1 = e1 / den;
        float o = 0.f;
        const int j0 = (t >= 127) ? 0 : 127 - t;
        for (int j = j0; j < 128; ++j) { const float pj = (j < 64) ? rdlane(p0, j) : rdlane(p1, j - 64); const int s = t - 127 + j;
            o += pj * bf1(VS[((size_t)b * SEQ + s) * 128 + kvh * 64 + lane]); }
        Y[(size_t)m * 4096 + 3072 + h * 64 + lane] = (bf16_t)f2bf(o);
        LDS_WAIT();
    }
}
__device__ __forceinline__ unsigned ordkey(float f) { const unsigned u = __builtin_bit_cast(unsigned, f); return (u & 0x80000000u) ? ~u : (u | 0x80000000u); }
__device__ __forceinline__ void ph_dsa_naive(const Ctx& C) {
    int lane = C.lane; asm volatile("" : "+v"(lane));
    LAS float* A = (LAS float*)(C.lds + C.wave * 13312);
    LAS float* Bs = A + 1024;
    LAS int* Cs = (LAS int*)(Bs + 2048);
    const GLB bf16_t* QI = WSP(bf16_t, WS_QI); const GLB bf16_t* KI = WSP(bf16_t, WS_KI); const GLB float* WI = WSP(float, WS_WI);
    const GLB bf16_t* QD = WSP(bf16_t, WS_QD); const GLB bf16_t* KD = WSP(bf16_t, WS_KD); const GLB bf16_t* VD = WSP(bf16_t, WS_VD); GLB bf16_t* Y = WSP(bf16_t, WS_Y);
    for (int m = C.gw; m < T; m += C.NGW) {
        const int t = m % SEQ, b = m / SEQ, n = t + 1;
        const size_t bm = (size_t)b * SEQ;
#pragma unroll
        for (int i = 0; i < 2; ++i) { const int e = 8 * (lane + 64 * i); const u32x4 q = *(const GLB u32x4*)(QI + (size_t)m * 1024 + e);
            *(LAS f32x4*)(A + e) = (f32x4){bflo(q.x), bfhi(q.x), bflo(q.y), bfhi(q.y)}; *(LAS f32x4*)(A + e + 4) = (f32x4){bflo(q.z), bfhi(q.z), bflo(q.w), bfhi(q.w)}; }
        const float wl = WI[(size_t)m * 16 + (lane & 15)];
        LDS_WAIT();
        const int nch = (n + 63) >> 6;
        for (int c = 0; c < nch; ++c) {
            const int s = c * 64 + lane; const bool valid = s < n;
            const GLB u32x4* kp = (const GLB u32x4*)(KI + (bm + (valid ? s : 0)) * 64);
            u32x4 kv[8];
#pragma unroll
            for (int j = 0; j < 8; ++j) kv[j] = kp[j];
            float sc = 0.f;
#pragma unroll 1
            for (int h = 0; h < 16; ++h) { float dot = 0.f;
#pragma unroll
                for (int j = 0; j < 8; ++j) dot += dot8(kv[j], *(const LAS f32x4*)(A + h * 64 + 8 * j), *(const LAS f32x4*)(A + h * 64 + 8 * j + 4));
                sc += rdlane(wl, h) * fmaxf(dot, 0.f); }
            Bs[s] = sc;
        }
        LDS_WAIT();
        int nsel;
        if (n <= 256) { nsel = n;
#pragma unroll
            for (int i = 0; i < 4; ++i) if (lane + 64 * i < n) Cs[lane + 64 * i] = lane + 64 * i;
        } else {
            nsel = 256;
            unsigned key[32];
#pragma unroll
            for (int i = 0; i < 32; ++i) { const int s = lane + 64 * i; key[i] = (s < n) ? ordkey(Bs[s]) : 0u; }
            unsigned tau = 0u;
            for (int bit = 31; bit >= 0; --bit) {
                const unsigned cand = tau | (1u << bit); int cnt = 0;
#pragma unroll
                for (int i = 0; i < 32; ++i) cnt += (key[i] >= cand) ? 1 : 0;
#pragma unroll
                for (int o = 1; o < 64; o <<= 1) cnt += __shfl_xor(cnt, o);
                if (cnt >= 256) tau = cand;
            }
            int cgt = 0;
#pragma unroll
            for (int i = 0; i < 32; ++i) cgt += (key[i] > tau) ? 1 : 0;
#pragma unroll
            for (int o = 1; o < 64; o <<= 1) cgt += __shfl_xor(cgt, o);
            const int need = 256 - cgt;
            int base = 0, eqbase = 0;
            const unsigned long long lt = (1ull << lane) - 1ull;
#pragma unroll
            for (int i = 0; i < 32; ++i) {
                const bool gt = key[i] > tau, eq = key[i] == tau;
                const unsigned long long beq = __ballot(eq);
                const int eqrank = eqbase + __popcll(beq & lt);
                const bool sel = gt || (eq && eqrank < need);
                const unsigned long long bs = __ballot(sel);
                if (sel) Cs[base + __popcll(bs & lt)] = lane + 64 * i;
                base += __popcll(bs); eqbase += __popcll(beq);
            }
        }
        LDS_WAIT();
#pragma unroll
        for (int i = 0; i < 2; ++i) { const int e = 8 * (lane + 64 * i); const u32x4 q = *(const GLB u32x4*)(QD + (size_t)m * 1024 + e);
            *(LAS f32x4*)(A + e) = (f32x4){bflo(q.x), bfhi(q.x), bflo(q.y), bfhi(q.y)}; *(LAS f32x4*)(A + e + 4) = (f32x4){bflo(q.z), bfhi(q.z), bflo(q.w), bfhi(q.w)}; }
        LDS_WAIT();
        float lg[8][4];
#pragma unroll
        for (int i = 0; i < 4; ++i) { const int j = lane + 64 * i; const bool valid = j < nsel; const int s = valid ? Cs[j] : 0;
            const GLB u32x4* kp = (const GLB u32x4*)(KD + (bm + s) * 128);
            float a8[8];
#pragma unroll
            for (int h = 0; h < 8; ++h) a8[h] = 0.f;
#pragma unroll 1
            for (int pc = 0; pc < 16; ++pc) { const u32x4 kv = kp[pc];
#pragma unroll
                for (int h = 0; h < 8; ++h) a8[h] += dot8(kv, *(const LAS f32x4*)(A + h * 128 + 8 * pc), *(const LAS f32x4*)(A + h * 128 + 8 * pc + 4)); }
#pragma unroll
            for (int h = 0; h < 8; ++h) lg[h][i] = valid ? a8[h] * 0.08838834764831845f : -3.0e38f; }
#pragma unroll
        for (int h = 0; h < 8; ++h) {
            const float mx = wave_max(fmaxf(fmaxf(lg[h][0], lg[h][1]), fmaxf(lg[h][2], lg[h][3])));
            float e[4]; float sm = 0.f;
#pragma unroll
            for (int i = 0; i < 4; ++i) { e[i] = (lg[h][i] > -1.0e38f) ? __expf(lg[h][i] - mx) : 0.f; sm += e[i]; }
            const float inv = 1.0f / wave_sum(sm);
#pragma unroll
            for (int i = 0; i < 4; ++i) Bs[(lane + 64 * i) * 8 + h] = e[i] * inv;
        }
        LDS_WAIT();
        float o[8][2];
#pragma unroll
        for (int h = 0; h < 8; ++h) { o[h][0] = 0.f; o[h][1] = 0.f; }
        for (int j = 0; j < nsel; ++j) { const int s = Cs[j]; const unsigned vv = *(const GLB unsigned*)(VD + (bm + s) * 128 + 2 * lane); const float v0 = bflo(vv), v1 = bfhi(vv);
            const f32x4 pa = *(const LAS f32x4*)(Bs + j * 8), pb = *(const LAS f32x4*)(Bs + j * 8 + 4);
#pragma unroll
            for (int h = 0; h < 4; ++h) { o[h][0] += pa[h] * v0; o[h][1] += pa[h] * v1; o[4 + h][0] += pb[h] * v0; o[4 + h][1] += pb[h] * v1; } }
#pragma unroll
        for (int h = 0; h < 8; ++h) *(GLB unsigned*)(Y + (size_t)m * 4096 + 2048 + h * 128 + 2 * lane) = pk2(o[h][0], o[h][1]);
        LDS_WAIT();
    }
}
typedef float f32x16 __attribute__((ext_vector_type(16)));
__device__ __forceinline__ int wave_isum(int x) {
    x += __builtin_amdgcn_mov_dpp(x, 0x128, 0xf, 0xf, true); x += __builtin_amdgcn_mov_dpp(x, 0x124, 0xf, 0xf, true);
    x += __builtin_amdgcn_mov_dpp(x, 0x122, 0xf, 0xf, true); x += __builtin_amdgcn_mov_dpp(x, 0x121, 0xf, 0xf, true);
    return __builtin_amdgcn_readlane(x, 0) + __builtin_amdgcn_readlane(x, 16) + __builtin_amdgcn_readlane(x, 32) + __builtin_amdgcn_readlane(x, 48);
}
constexpr size_t WS_SBVT = WS_MIX_END;
constexpr size_t WS_SWVT = WS_SBVT + (size_t)32 * 128 * SEQ * 2;
constexpr size_t WS_VDT = WS_SWVT + (size_t)NB * 2 * 64 * SEQ * 2;
constexpr size_t WS_SC = WS_VDT + (size_t)NB * 128 * SEQ * 2;
constexpr size_t WS_SELB = WS_SC + (size_t)T * SEQ * 4;
constexpr size_t WS_END2 = WS_SELB + (size_t)T * 32 * 8;
constexpr size_t WS_XB = (WS_END2 + 255) & ~(size_t)255;
constexpr size_t WS_END3 = WS_XB + (size_t)T * D * 2;
static_assert(WS_END3 < (size_t)2000 * 1000 * 1000, "workspace budget");

__device__ __forceinline__ void vt_tile(const GLB bf16_t* src, int src_ld, GLB bf16_t* dst, LAS bf16_t* scr, int lane) {
    const int cq = lane & 7, rq = lane >> 3;
    u32x4 v[8];
#pragma unroll
    for (int j = 0; j < 8; ++j) v[j] = *(const GLB u32x4*)(src + (size_t)(rq + 8 * j) * src_ld + 8 * cq);
#pragma unroll
    for (int j = 0; j < 8; ++j) { LAS unsigned* d = (LAS unsigned*)(scr + (rq + 8 * j) * 66 + 8 * cq); d[0] = v[j].x; d[1] = v[j].y; d[2] = v[j].z; d[3] = v[j].w; }
    LDS_WAIT();
#pragma unroll
    for (int j = 0; j < 8; ++j) { const int d = rq + 8 * j; const LAS bf16_t* s = scr + (8 * cq) * 66 + d;
        u32x4 o; o.x = (unsigned)s[0] | ((unsigned)s[66] << 16); o.y = (unsigned)s[2 * 66] | ((unsigned)s[3 * 66] << 16);
        o.z = (unsigned)s[4 * 66] | ((unsigned)s[5 * 66] << 16); o.w = (unsigned)s[6 * 66] | ((unsigned)s[7 * 66] << 16);
        *(GLB u32x4*)(dst + (size_t)d * SEQ + 8 * cq) = o; }
    LDS_WAIT();
}
__device__ __forceinline__ void ph_vt(const Ctx& C) {
    int lane = C.lane; asm volatile("" : "+v"(lane)); lane &= 63;
    LAS bf16_t* scr = (LAS bf16_t*)(C.lds + 65536 + C.wave * 8448);
    for (int it = C.gw; it < 32 * 2 * 32; it += C.NGW) {
        const int sb = it & 31, db = (it >> 5) & 1, bh = it >> 6, b = bh >> 3, h = bh & 7;
        vt_tile(WSP(bf16_t, WS_SBQKV) + ((size_t)b * SEQ + 64 * sb) * 3072 + 2048 + h * 128 + 64 * db, 3072,
                WSP(bf16_t, WS_SBVT) + ((size_t)bh * 128 + 64 * db) * SEQ + 64 * sb, scr, lane);
    }
}

__device__ __forceinline__ void ph_vt_small(const Ctx& C) {
    int lane = C.lane; asm volatile("" : "+v"(lane)); lane &= 63;
    LAS bf16_t* scr = (LAS bf16_t*)(C.lds + C.wave * 8448);
    for (int it = C.gw; it < 512; it += C.NGW) {
        const int sb = it & 31, hd = (it >> 5) & 1, b = (it >> 6) & 3, which = it >> 8;
        if (which == 0) vt_tile(WSP(bf16_t, WS_VS) + ((size_t)b * SEQ + 64 * sb) * 128 + 64 * hd, 128, WSP(bf16_t, WS_SWVT) + ((size_t)(b * 2 + hd) * 64) * SEQ + 64 * sb, scr, lane);
        else vt_tile(WSP(bf16_t, WS_VD) + ((size_t)b * SEQ + 64 * sb) * 128 + 64 * hd, 128, WSP(bf16_t, WS_VDT) + ((size_t)b * 128 + 64 * hd) * SEQ + 64 * sb, scr, lane);
    }
}

#ifndef SB_EXIT_MASS
#define SB_EXIT_MASS 9.094947017729282e-13f
#endif
__device__ __forceinline__ void sb_item(const Ctx& C, int lane, int bh, int qb) {
    const int c = lane & 31, hh = lane >> 5, b = bh >> 3, h = bh & 7, q0 = 32 * qb;
    const GLB bf16_t* QKV = WSP(bf16_t, WS_SBQKV); const GLB bf16_t* VT = WSP(bf16_t, WS_SBVT);
    const GLB bf16_t* qp = QKV + ((size_t)b * SEQ + q0 + c) * 3072 + h * 128 + 8 * hh;
    bf16x8 qf[8];
#pragma unroll
    for (int ks = 0; ks < 8; ++ks) qf[ks] = *(const GLB bf16x8*)(qp + 16 * ks);
    f32x16 O[4];
#pragma unroll
    for (int db = 0; db < 4; ++db)
#pragma unroll
        for (int r = 0; r < 16; ++r) O[db][r] = 0.f;
    float carry = 1.0f;
    const int km = 16 * ((c >> 2) & 1) + 4 * (c >> 3) + (c & 3);
    const GLB bf16_t* kbase = QKV + ((size_t)b * SEQ + km) * 3072 + 1024 + h * 128 + 8 * hh;
    const GLB bf16_t* vbase = VT + ((size_t)bh * 128 + c) * SEQ + 16 * hh;
    bf16x8 kf[8];
#pragma unroll
    for (int ks = 0; ks < 8; ++ks) kf[ks] = *(const GLB bf16x8*)(kbase + (size_t)q0 * 3072 + 16 * ks);
    for (int kt = qb; kt >= 0; --kt) {
        const int k0 = 32 * kt;
        bf16x8 vf[2][4];
#pragma unroll
        for (int s = 0; s < 2; ++s)
#pragma unroll
            for (int db = 0; db < 4; ++db) vf[s][db] = *(const GLB bf16x8*)(vbase + (size_t)(32 * db) * SEQ + k0 + 8 * s);
        f32x16 S;
#pragma unroll
        for (int r = 0; r < 16; ++r) S[r] = 0.f;
#pragma unroll
        for (int ks = 0; ks < 8; ++ks) S = __builtin_amdgcn_mfma_f32_32x32x16_bf16(kf[ks], qf[ks], S, 0, 0, 0);
        if (kt > 0) {
#pragma unroll
            for (int ks = 0; ks < 8; ++ks) kf[ks] = *(const GLB bf16x8*)(kbase + (size_t)(k0 - 32) * 3072 + 16 * ks);
        }
        const bool diag = (kt == qb);
        float w[16]; float sp = 1.0f;
#pragma unroll
        for (int r = 15; r >= 0; --r) {
            const float e = __builtin_amdgcn_exp2f(fminf(S[r] * -0.12751743074602535f, 115.0f)), rr = __builtin_amdgcn_rcpf(1.0f + e), er = e * rr;
            const bool valid = !diag || (16 * hh + r < c);
            const float beta = valid ? rr : 0.f, om = valid ? er : 1.0f;
            w[r] = beta * sp; sp *= om;
        }
        const float tot_other = __shfl_xor(sp, 32);
        const float pre = carry * (hh == 0 ? tot_other : 1.0f);
        carry *= sp * tot_other;
        const bool live = __ballot(carry >= SB_EXIT_MASS) != 0ull;
        bf16x8 pw[2];
#pragma unroll
        for (int s = 0; s < 2; ++s) { u32x4 t; t.x = pk2(w[8 * s] * pre, w[8 * s + 1] * pre); t.y = pk2(w[8 * s + 2] * pre, w[8 * s + 3] * pre);
            t.z = pk2(w[8 * s + 4] * pre, w[8 * s + 5] * pre); t.w = pk2(w[8 * s + 6] * pre, w[8 * s + 7] * pre); pw[s] = __builtin_bit_cast(bf16x8, t); }
#pragma unroll
        for (int s = 0; s < 2; ++s)
#pragma unroll
            for (int db = 0; db < 4; ++db) O[db] = __builtin_amdgcn_mfma_f32_32x32x16_bf16(vf[s][db], pw[s], O[db], 0, 0, 0);
        if (!live) break;
    }
    GLB bf16_t* yp = WSP(bf16_t, WS_Y) + ((size_t)b * SEQ + q0 + c) * 4096 + h * 128 + 4 * hh;
#pragma unroll
    for (int db = 0; db < 4; ++db)
#pragma unroll
        for (int a = 0; a < 4; ++a) { u32x2 o; o.x = pk2(O[db][4 * a], O[db][4 * a + 1]); o.y = pk2(O[db][4 * a + 2], O[db][4 * a + 3]);
            *(GLB u32x2*)(yp + 32 * db + 8 * a) = o; }
}
__device__ __forceinline__ void ph_sb_fast(const Ctx& C) {
    int lane = C.lane; asm volatile("" : "+v"(lane)); lane &= 63;
    const int pi = blockIdx.x * 4 + (C.wave & 3);
    if (pi < 1024) { const int bh = pi >> 5, j = pi & 31; sb_item(C, lane, bh, (C.wave >> 2) ? 63 - j : j); }
}

#ifndef SWA_OUT_OFF
#define SWA_OUT_OFF WS_Y
#endif
__device__ __forceinline__ void swa_item(const Ctx& C, int lane, int l, int b, int h, int tb) {
    const int c = lane & 31, hh = lane >> 5, t0 = 32 * tb, kvh = h >> 3;
    const GLB bf16_t* qp = WSP(bf16_t, WS_QS) + ((size_t)b * SEQ + t0 + c) * 1024 + h * 64 + 8 * hh;
    bf16x8 qf[4];
#pragma unroll
    for (int ks = 0; ks < 4; ++ks) qf[ks] = *(const GLB bf16x8*)(qp + 16 * ks);
    const int km = 16 * ((c >> 2) & 1) + 4 * (c >> 3) + (c & 3);
    const GLB bf16_t* kbase = WSP(bf16_t, WS_KS) + ((size_t)b * SEQ + km) * 128 + kvh * 64 + 8 * hh;
    const GLB bf16_t* vbase = WSP(bf16_t, WS_SWVT) + ((size_t)(b * 2 + kvh) * 64 + c) * SEQ + 16 * hh;
    float mrun = INF32(I_SSINK)[l * 16 + h], lrun = 1.0f;
    f32x16 O[2];
#pragma unroll
    for (int db = 0; db < 2; ++db)
#pragma unroll
        for (int r = 0; r < 16; ++r) O[db][r] = 0.f;
    const int i0 = (tb >= 4) ? 0 : 4 - tb;
    for (int i = i0; i < 5; ++i) {
        const int k0 = t0 - 128 + 32 * i;
        bf16x8 kf[4], vf[2][2];
#pragma unroll
        for (int ks = 0; ks < 4; ++ks) kf[ks] = *(const GLB bf16x8*)(kbase + (size_t)k0 * 128 + 16 * ks);
#pragma unroll
        for (int s = 0; s < 2; ++s)
#pragma unroll
            for (int db = 0; db < 2; ++db) vf[s][db] = *(const GLB bf16x8*)(vbase + (size_t)(32 * db) * SEQ + k0 + 8 * s);
        f32x16 a;
#pragma unroll
        for (int r = 0; r < 16; ++r) a[r] = 0.f;
#pragma unroll
        for (int ks = 0; ks < 4; ++ks) a = __builtin_amdgcn_mfma_f32_32x32x16_bf16(kf[ks], qf[ks], a, 0, 0, 0);
        float tmax = -1.0e30f;
#pragma unroll
        for (int r = 0; r < 16; ++r) { const int kr = 16 * hh + r; const bool valid = (i == 0) ? (kr > c) : ((i == 4) ? (kr <= c) : true); a[r] = valid ? a[r] * 0.125f : -1.0e30f; tmax = fmaxf(tmax, a[r]); }
        tmax = fmaxf(tmax, __shfl_xor(tmax, 32));
        const float mnew = fmaxf(mrun, tmax), alpha = __expf(mrun - mnew);
        float psum = 0.f;
#pragma unroll
        for (int r = 0; r < 16; ++r) { a[r] = __expf(a[r] - mnew); psum += a[r]; }
        psum += __shfl_xor(psum, 32);
        lrun = lrun * alpha + psum; mrun = mnew;
#pragma unroll
        for (int db = 0; db < 2; ++db)
#pragma unroll
            for (int r = 0; r < 16; ++r) O[db][r] *= alpha;
#pragma unroll
        for (int s = 0; s < 2; ++s) {
            u32x4 t; t.x = pk2(a[8 * s], a[8 * s + 1]); t.y = pk2(a[8 * s + 2], a[8 * s + 3]); t.z = pk2(a[8 * s + 4], a[8 * s + 5]); t.w = pk2(a[8 * s + 6], a[8 * s + 7]);
            const bf16x8 pw = __builtin_bit_cast(bf16x8, t);
#pragma unroll
            for (int db = 0; db < 2; ++db) O[db] = __builtin_amdgcn_mfma_f32_32x32x16_bf16(vf[s][db], pw, O[db], 0, 0, 0);
        }
    }
    const float inv = 1.0f / lrun;
    GLB bf16_t* yp = WSP(bf16_t, SWA_OUT_OFF) + ((size_t)b * SEQ + t0 + c) * 4096 + 3072 + h * 64 + 4 * hh;
#pragma unroll
    for (int db = 0; db < 2; ++db)
#pragma unroll
        for (int a4 = 0; a4 < 4; ++a4) { u32x2 o; o.x = pk2(O[db][4 * a4] * inv, O[db][4 * a4 + 1] * inv); o.y = pk2(O[db][4 * a4 + 2] * inv, O[db][4 * a4 + 3] * inv);
            *(GLB u32x2*)(yp + 32 * db + 8 * a4) = o; }
}
__device__ __forceinline__ void ph_swa_fast(const Ctx& C, int l) {
    int lane = C.lane; asm volatile("" : "+v"(lane)); lane &= 63;
    if (C.wave >= 4) return;
    for (int it = blockIdx.x * 4 + C.wave; it < NB * 64 * 16; it += C.G * 4) { const int h = it & 15, tb = (it >> 4) & 63, b = it >> 10; swa_item(C, lane, l, b, h, tb); }
}

__device__ __forceinline__ float row16_sum(float x) {
    x += __builtin_bit_cast(float, __builtin_amdgcn_mov_dpp(__builtin_bit_cast(int, x), 0x128, 0xf, 0xf, true));
    x += __builtin_bit_cast(float, __builtin_amdgcn_mov_dpp(__builtin_bit_cast(int, x), 0x124, 0xf, 0xf, true));
    x += __builtin_bit_cast(float, __builtin_amdgcn_mov_dpp(__builtin_bit_cast(int, x), 0x122, 0xf, 0xf, true));
    x += __builtin_bit_cast(float, __builtin_amdgcn_mov_dpp(__builtin_bit_cast(int, x), 0x121, 0xf, 0xf, true));
    return x;
}
__device__ __forceinline__ void ph_rwkv_scan_fast(const Ctx& C) {
    int tid = C.tid; asm volatile("" : "+v"(tid));
    const int lane = tid & 63, wave = C.wave;
    LAS float* buf = (LAS float*)C.lds;
    constexpr int CH = 32, CHF = CH * 384;
    for (int it = blockIdx.x; it < NB * 16 * 4; it += C.G) {
        const int qr = it & 3, h = (it >> 2) & 15, b = it >> 6;
        const size_t gbase = (size_t)b * SEQ * 1024 + h * 64;
        const int ro = lane >> 4, kq = lane & 15, row = 16 * qr + 4 * (wave & 3) + ro;
        float S0 = 0.f, S1 = 0.f, S2 = 0.f, S3 = 0.f;
        const int lj = tid - 256;
        auto load_chunk = [&](int cidx) {
            f32x4 v[12];
#pragma unroll
            for (int i = 0; i < 12; ++i) { const int idx = lj + 256 * i, step = idx / 96, rem = idx - step * 96, vec = rem >> 4, e4 = rem & 15;
                const size_t off = (vec == 0) ? WS_R : (vec == 1) ? WS_DEC : (vec == 2) ? WS_K : (vec == 3) ? WS_KK : (vec == 4) ? WS_AA : WS_V;
                v[i] = *(const GLB f32x4*)(WSP(float, off) + gbase + (size_t)(cidx * CH + step) * 1024 + 4 * e4); }
            LAS float* d = buf + (cidx & 1) * CHF;
#pragma unroll
            for (int i = 0; i < 12; ++i) { const int idx = lj + 256 * i, step = idx / 96, rem = idx - step * 96; *(LAS f32x4*)(d + step * 384 + rem * 4) = v[i]; }
        };
        if (wave >= 4) load_chunk(0);
        LDS_WAIT(); __syncthreads();
        for (int cidx = 0; cidx < SEQ / CH; ++cidx) {
            if (wave >= 4) { if (cidx + 1 < SEQ / CH) load_chunk(cidx + 1); }
            else {
                const LAS float* cb = buf + (cidx & 1) * CHF;
#pragma unroll 4
                for (int st = 0; st < CH; ++st) {
                    const LAS float* rb = cb + st * 384;
                    const f32x4 kk4 = *(const LAS f32x4*)(rb + 192 + 4 * kq);
                    const float p = row16_sum(S0 * kk4[0] + S1 * kk4[1] + S2 * kk4[2] + S3 * kk4[3]);
                    const f32x4 w4 = *(const LAS f32x4*)(rb + 64 + 4 * kq), b4 = *(const LAS f32x4*)(rb + 256 + 4 * kq), k4 = *(const LAS f32x4*)(rb + 128 + 4 * kq), r4 = *(const LAS f32x4*)(rb + 4 * kq);
                    const float vv = rb[320 + row];
                    S0 = S0 * w4[0] - p * b4[0] + vv * k4[0]; S1 = S1 * w4[1] - p * b4[1] + vv * k4[1]; S2 = S2 * w4[2] - p * b4[2] + vv * k4[2]; S3 = S3 * w4[3] - p * b4[3] + vv * k4[3];
                    const float y = row16_sum(S0 * r4[0] + S1 * r4[1] + S2 * r4[2] + S3 * r4[3]);
                    if (kq == 0) WSP(float, WS_YRAW)[gbase + (size_t)(cidx * CH + st) * 1024 + row] = y;
                }
            }
            LDS_WAIT(); __syncthreads();
        }
    }
}

__device__ __forceinline__ void dsa_item(const Ctx& C, int lane, int wave, int b, int g, int layer) {
    const int c = lane & 31, hh = lane >> 5, t0 = 4 * g;
    LAS float* sc = (LAS float*)(C.lds + wave * 17408);
    LAS unsigned* bm = (LAS unsigned*)(C.lds + wave * 17408 + 16384);
    const size_t bm0 = (size_t)b * SEQ;
    const int ntile = (t0 + 3) / 32 + 1;
    const int hw = wave >> 2, wq = wave & 3;
    volatile LAS unsigned* cnt = (volatile LAS unsigned*)(C.lds + MISC_OFF + 128 + 4 * hw);
    unsigned target = (unsigned)layer * 4u * (unsigned)(ntile + 6);
    auto arrive = [&]() { asm volatile("s_waitcnt vmcnt(0) lgkmcnt(0)" ::: "memory"); if (lane == 0) (void)__hip_atomic_fetch_add((LAS unsigned*)(C.lds + MISC_OFF + 128 + 4 * hw), 1u, __ATOMIC_RELAXED, __HIP_MEMORY_SCOPE_WORKGROUP); };
    auto wait_all = [&]() { target += 4u; while ((int)(*cnt - target) < 0) __builtin_amdgcn_s_sleep(1); asm volatile("" ::: "memory"); };
#pragma unroll 1
    for (int p = 0; p < 2; ++p) {
        {
            arrive(); wait_all();
            const int hd = (c & 3) + 4 * (c >> 3);
            bf16x8 qf[4][4]; f32x4 w4[4][4];
#pragma unroll
            for (int j = 0; j < 4; ++j) { const int t0j = t0 + 4 * (hw ? (wq - j) : (j - wq));
                const GLB bf16_t* qp = WSP(bf16_t, WS_QI) + (bm0 + t0j + 2 * p + ((c >> 2) & 1)) * 1024 + hd * 64 + 8 * hh;
                const GLB float* wp = WSP(float, WS_WI) + (bm0 + t0j + 2 * p + hh) * 16;
#pragma unroll
                for (int ks = 0; ks < 4; ++ks) { qf[j][ks] = *(const GLB bf16x8*)(qp + 16 * ks); w4[j][ks] = *(const GLB f32x4*)(wp + 4 * ks); } }
            const GLB bf16_t* kp = WSP(bf16_t, WS_KI) + (bm0 + c) * 64 + 8 * hh;
            bf16x8 kf[4];
            if (wq < ntile) {
#pragma unroll
                for (int ks = 0; ks < 4; ++ks) kf[ks] = *(const GLB bf16x8*)(kp + (size_t)(32 * wq) * 64 + 16 * ks);
            }
            for (int kt = wq; kt < ntile; kt += 4) {
                f32x16 a[4];
#pragma unroll
                for (int j = 0; j < 4; ++j)
#pragma unroll
                    for (int r = 0; r < 16; ++r) a[j][r] = 0.f;
#pragma unroll
                for (int ks = 0; ks < 4; ++ks)
#pragma unroll
                    for (int j = 0; j < 4; ++j) a[j] = __builtin_amdgcn_mfma_f32_32x32x16_bf16(qf[j][ks], kf[ks], a[j], 0, 0, 0);
                if (kt + 4 < ntile) {
#pragma unroll
                    for (int ks = 0; ks < 4; ++ks) kf[ks] = *(const GLB bf16x8*)(kp + (size_t)(32 * (kt + 4)) * 64 + 16 * ks);
                }
#pragma unroll
                for (int j = 0; j < 4; ++j) { float s = 0.f;
#pragma unroll
                    for (int r = 0; r < 16; ++r) s += w4[j][r >> 2][r & 3] * fmaxf(a[j][r], 0.f);
                    ((LAS float*)(C.lds + (4 * hw + j) * 17408))[hh * 2048 + 32 * kt + c] = s; }
            }
            arrive(); wait_all();
        }
        LDS_WAIT();
#pragma unroll 1
        for (int qs = 0; qs < 2; ++qs) {
            const int t = t0 + 2 * p + qs, n = t + 1;
            const LAS float* sq = sc + qs * 2048;
            unsigned myword_lo = 0u, myword_hi = 0u;
            if (n <= 256) {
#pragma unroll
                for (int i = 0; i < 4; ++i) { const unsigned long long bal = __ballot(lane + 64 * i < n); if (lane == i) { myword_lo = (unsigned)bal; myword_hi = (unsigned)(bal >> 32); } }
            } else {
                unsigned key[32];
#pragma unroll
                for (int i = 0; i < 32; ++i) { const int s = lane + 64 * i; key[i] = (s < n) ? ordkey(sq[s]) : 0u; }
                unsigned tau = 0u;
                for (int bit = 31; bit >= 0; --bit) {
                    const unsigned cand = tau | (1u << bit); int cl = 0;
#pragma unroll
                    for (int i = 0; i < 32; ++i) cl += (key[i] >= cand) ? 1 : 0;
                    const int cnt = wave_isum(cl);
                    if (cnt >= 256) { tau = cand; if (cnt == 256) break; }
                }
                int cgl = 0;
#pragma unroll
                for (int i = 0; i < 32; ++i) cgl += (key[i] > tau) ? 1 : 0;
                const int cgt = wave_isum(cgl);
                const int need = 256 - cgt; int eqbase = 0;
                const unsigned long long lt = (1ull << lane) - 1ull;
#pragma unroll
                for (int i = 0; i < 32; ++i) {
                    const bool gt = key[i] > tau, eq = key[i] == tau;
                    const unsigned long long beq = __ballot(eq);
                    const bool sel = gt || (eq && (eqbase + __popcll(beq & lt)) < need);
                    const unsigned long long bal = __ballot(sel);
                    if (lane == i) { myword_lo = (unsigned)bal; myword_hi = (unsigned)(bal >> 32); }
                    eqbase += __popcll(beq);
                }
            }
            if (lane < 32) { bm[(2 * p + qs) * 64 + 2 * lane] = myword_lo; bm[(2 * p + qs) * 64 + 2 * lane + 1] = myword_hi; }
        }
        LDS_WAIT();
    }
    const int cq = c >> 3, ch = c & 7;
    const GLB bf16_t* qp = WSP(bf16_t, WS_QD) + (bm0 + t0 + cq) * 1024 + ch * 128 + 8 * hh;
    bf16x8 qf[8];
#pragma unroll
    for (int ks = 0; ks < 8; ++ks) qf[ks] = *(const GLB bf16x8*)(qp + 16 * ks);
    const int km = 16 * ((c >> 2) & 1) + 4 * (c >> 3) + (c & 3);
    const GLB bf16_t* kbase = WSP(bf16_t, WS_KD) + (bm0 + km) * 128 + 8 * hh;
    const GLB bf16_t* vbase = WSP(bf16_t, WS_VDT) + ((size_t)b * 128 + c) * SEQ + 16 * hh;
    const LAS unsigned short* bmh = (const LAS unsigned short*)(bm + cq * 64) + hh;
    float mrun = -1.0e20f, lrun = 0.f;
    f32x16 O[4];
#pragma unroll
    for (int db = 0; db < 4; ++db)
#pragma unroll
        for (int r = 0; r < 16; ++r) O[db][r] = 0.f;
    const GLB char* kg = (const GLB char*)(WSP(bf16_t, WS_KD) + bm0 * 128);
    const GLB char* vg = (const GLB char*)(WSP(bf16_t, WS_VDT) + (size_t)b * 128 * SEQ);
    auto stage = [&](int kt) {
        LAS char* tb = (LAS char*)(C.lds + (4 * hw + kt % 3) * 17408);
#pragma unroll
        for (int i = 0; i < 2; ++i) { const int r = 8 * wq + 4 * i + (lane >> 4), pch = lane & 15, key = (r & 7) + 8 * (r >> 4);
            __builtin_amdgcn_global_load_lds((const GLB unsigned*)(kg + ((size_t)(32 * kt + r) * 256 + 16 * (pch ^ key))), (LAS unsigned*)(tb + (8 * wq + 4 * i) * 256), 16, 0, 0); }
#pragma unroll
        for (int i = 0; i < 2; ++i) { const int d = 32 * wq + 16 * i + (lane >> 2), pch = lane & 3, key = (d >> 2) & 3;
            __builtin_amdgcn_global_load_lds((const GLB unsigned*)(vg + ((size_t)d * (SEQ * 2) + 64 * kt + 16 * (pch ^ key))), (LAS unsigned*)(tb + 8192 + (32 * wq + 16 * i) * 64), 16, 0, 0); }
    };
    arrive(); wait_all();
    stage(0); if (ntile > 1) stage(1);
    arrive();
    const int kkey = (km & 7) + 8 * (km >> 4);
    for (int kt = 0; kt < ntile; ++kt) {
        wait_all();
        const LAS char* tb = (const LAS char*)(C.lds + (4 * hw + kt % 3) * 17408);
        bf16x8 kf[8], vf[2][4];
#pragma unroll
        for (int ks = 0; ks < 8; ++ks) kf[ks] = *(const LAS bf16x8*)(tb + km * 256 + 16 * ((hh + 2 * ks) ^ kkey));
#pragma unroll
        for (int s = 0; s < 2; ++s)
#pragma unroll
            for (int db = 0; db < 4; ++db) { const int d = c + 32 * db; vf[s][db] = *(const LAS bf16x8*)(tb + 8192 + d * 64 + 16 * ((2 * hh + s) ^ ((d >> 2) & 3))); }
        const unsigned bits = bmh[2 * kt];
        asm volatile("s_waitcnt lgkmcnt(0)" ::: "memory");
        if (kt + 2 < ntile) stage(kt + 2);
        f32x16 a;
#pragma unroll
        for (int r = 0; r < 16; ++r) a[r] = 0.f;
#pragma unroll
        for (int ks = 0; ks < 8; ++ks) a = __builtin_amdgcn_mfma_f32_32x32x16_bf16(kf[ks], qf[ks], a, 0, 0, 0);
        float tmax = -1.0e30f;
#pragma unroll
        for (int r = 0; r < 16; ++r) { a[r] = ((bits >> r) & 1u) ? a[r] * 0.08838834764831845f : -1.0e30f; tmax = fmaxf(tmax, a[r]); }
        tmax = fmaxf(tmax, __shfl_xor(tmax, 32));
        if (__ballot(tmax > mrun + 8.0f) != 0ull) {
            const float mnew = fmaxf(mrun, tmax), alpha = __expf(mrun - mnew);
            lrun *= alpha; mrun = mnew;
#pragma unroll
            for (int db = 0; db < 4; ++db)
#pragma unroll
                for (int r = 0; r < 16; ++r) O[db][r] *= alpha;
        }
        float psum = 0.f;
#pragma unroll
        for (int r = 0; r < 16; ++r) { a[r] = __expf(a[r] - mrun); psum += a[r]; }
        psum += __shfl_xor(psum, 32);
        lrun += psum;
#pragma unroll
        for (int s = 0; s < 2; ++s) {
            u32x4 t; t.x = pk2(a[8 * s], a[8 * s + 1]); t.y = pk2(a[8 * s + 2], a[8 * s + 3]); t.z = pk2(a[8 * s + 4], a[8 * s + 5]); t.w = pk2(a[8 * s + 6], a[8 * s + 7]);
            const bf16x8 pw = __builtin_bit_cast(bf16x8, t);
#pragma unroll
            for (int db = 0; db < 4; ++db) O[db] = __builtin_amdgcn_mfma_f32_32x32x16_bf16(vf[s][db], pw, O[db], 0, 0, 0);
        }
        arrive();
    }
    const float inv = 1.0f / lrun;
    GLB bf16_t* yp = WSP(bf16_t, WS_Y) + (bm0 + t0 + cq) * 4096 + 2048 + ch * 128 + 4 * hh;
#pragma unroll
    for (int db = 0; db < 4; ++db)
#pragma unroll
        for (int a4 = 0; a4 < 4; ++a4) { u32x2 o; o.x = pk2(O[db][4 * a4] * inv, O[db][4 * a4 + 1] * inv); o.y = pk2(O[db][4 * a4 + 2] * inv, O[db][4 * a4 + 3] * inv);
            *(GLB u32x2*)(yp + 32 * db + 8 * a4) = o; }
    LDS_WAIT();
}
__device__ __forceinline__ void ph_dsa_fast(const Ctx& C, int l) {
    int lane = C.lane; asm volatile("" : "+v"(lane)); lane &= 63;
    const int pi = blockIdx.x * 4 + (C.wave & 3);
    if (pi < 1024) { const int b = pi >> 8, j = pi & 255; dsa_item(C, lane, C.wave, b, (C.wave >> 2) ? 511 - j : j, l); }
}

constexpr int SCAN_CNT_OFF = MISC_OFF + 64;
__device__ __forceinline__ void ph_rwkv_scan_conv(const Ctx& C, int l) {
    int tid = C.tid; asm volatile("" : "+v"(tid));
    const int lane = tid & 63, wave = C.wave;
    if (wave >= 4) {
        LAS float* scr = (LAS float*)(C.lds + 65536 + (wave - 4) * 16640);
        constexpr int PER = MOE_CONV_ITEMS / 2 / 1024;
        const int first = l * (MOE_CONV_ITEMS / 2) + (blockIdx.x * 4 + (wave - 4)) * PER;
        if (!MOE_CONV_IN_PROLOGUE && blockIdx.x < 256)
            for (int i = 0; i < PER; ++i) conv_moe_item(C, first + i, scr, lane);
        return;
    }
    constexpr int CH = 16, CHF = CH * 384, NCH = SEQ / CH;
    LAS float* buf = (LAS float*)C.lds;
    volatile LAS unsigned* cnt = (volatile LAS unsigned*)(C.lds + SCAN_CNT_OFF);
    const int it = blockIdx.x;
    if (it >= NB * 16 * 4) return;
    const int qr = it & 3, h = (it >> 2) & 15, b = it >> 6;
    const size_t gbase = (size_t)b * SEQ * 1024 + h * 64;
    const int ro = lane >> 4, kq = lane & 15, row = 16 * qr + 4 * wave + ro;
    unsigned target = (unsigned)l * 4u * (NCH + 1);
    auto issue = [&](int cidx) {
#pragma unroll
        for (int j = 0; j < 6; ++j) { const int i = wave + 4 * j, rho = 4 * i + ro, step = rho / 6, vec = rho - 6 * step;
            const size_t off = (vec == 0) ? WS_R : (vec == 1) ? WS_DEC : (vec == 2) ? WS_K : (vec == 3) ? WS_KK : (vec == 4) ? WS_AA : WS_V;
            const GLB float* src = WSP(float, off) + gbase + (size_t)(cidx * CH + step) * 1024 + 4 * kq;
            __builtin_amdgcn_global_load_lds((const GLB unsigned*)src, (LAS unsigned*)(buf + (cidx & 1) * CHF + i * 256), 16, 0, 0); }
    };
    auto arrive_wait = [&]() {
        asm volatile("s_waitcnt vmcnt(0)" ::: "memory");
        target += 4u;
        if (lane == 0) (void)__hip_atomic_fetch_add((LAS unsigned*)(C.lds + SCAN_CNT_OFF), 1u, __ATOMIC_RELAXED, __HIP_MEMORY_SCOPE_WORKGROUP);
        while ((int)(*cnt - target) < 0) __builtin_amdgcn_s_sleep(1);
        asm volatile("" ::: "memory");
    };
    float S0 = 0.f, S1 = 0.f, S2 = 0.f, S3 = 0.f;
    issue(0); arrive_wait();
    for (int cidx = 0; cidx < NCH; ++cidx) {
        if (cidx + 1 < NCH) issue(cidx + 1);
        const LAS float* cb = buf + (cidx & 1) * CHF;
#pragma unroll 4
        for (int st = 0; st < CH; ++st) {
            const LAS float* rb = cb + st * 384;
            const f32x4 kk4 = *(const LAS f32x4*)(rb + 192 + 4 * kq);
            const float p = row16_sum(S0 * kk4[0] + S1 * kk4[1] + S2 * kk4[2] + S3 * kk4[3]);
            const f32x4 w4 = *(const LAS f32x4*)(rb + 64 + 4 * kq), b4 = *(const LAS f32x4*)(rb + 256 + 4 * kq), k4 = *(const LAS f32x4*)(rb + 128 + 4 * kq), r4 = *(const LAS f32x4*)(rb + 4 * kq);
            const float vv = rb[320 + row];
            S0 = S0 * w4[0] - p * b4[0] + vv * k4[0]; S1 = S1 * w4[1] - p * b4[1] + vv * k4[1]; S2 = S2 * w4[2] - p * b4[2] + vv * k4[2]; S3 = S3 * w4[3] - p * b4[3] + vv * k4[3];
            const float y = row16_sum(S0 * r4[0] + S1 * r4[1] + S2 * r4[2] + S3 * r4[3]);
            if (kq == 0) WSP(float, WS_YRAW)[gbase + (size_t)(cidx * CH + st) * 1024 + row] = y;
        }
        asm volatile("s_waitcnt lgkmcnt(0)" ::: "memory");
        arrive_wait();
    }
}

#ifndef SCAN3_CONV_MODE
#define SCAN3_CONV_MODE 0
#endif
#ifndef CONV_NT
#define CONV_NT 0
#endif
__device__ __forceinline__ void conv_tile_load(const GLB float* W, int ldw, int k0, int s0, f32x4 (&v)[16], int lane) {
    const int cq = lane & 15, rq = lane >> 4;
    const unsigned loff = (unsigned)(rq * ldw + 4 * cq);
    const GLB float* base = W + (size_t)k0 * ldw + s0;
#pragma unroll
    for (int i = 0; i < 16; ++i) { const GLB float* rowp = base + (size_t)(4 * i) * ldw; v[i] = CONV_NT ? __builtin_nontemporal_load((const GLB f32x4*)(rowp + loff)) : *(const GLB f32x4*)(rowp + loff); }
}
__device__ __forceinline__ void conv_tile_to_lds(const f32x4 (&v)[16], LAS float* scr, int lane) {
    const int cq = lane & 15, rq = lane >> 4;
#pragma unroll
    for (int i = 0; i < 16; ++i) { const int kk = 4 * i + rq; LAS float* d = scr + kk * 65 + 4 * cq; d[0] = v[i][0]; d[1] = v[i][1]; d[2] = v[i][2]; d[3] = v[i][3]; }
}
__device__ __forceinline__ void conv_tile_from_lds(GLB bf16_t* Bt, int K, int n0, int k0, LAS float* scr, int lane) {
    const int c = lane & 7;
#pragma unroll
    for (int j = 0; j < 8; ++j) { const int n = (lane >> 3) + 8 * j; const LAS float* s = scr + (8 * c) * 65 + n;
        u32x4 o; o.x = pk2(s[0 * 65], s[1 * 65]); o.y = pk2(s[2 * 65], s[3 * 65]); o.z = pk2(s[4 * 65], s[5 * 65]); o.w = pk2(s[6 * 65], s[7 * 65]);
        if (CONV_NT & 2) __builtin_nontemporal_store(o, (GLB u32x4*)(Bt + (size_t)(n0 + n) * K + k0 + 8 * c)); else *(GLB u32x4*)(Bt + (size_t)(n0 + n) * K + k0 + 8 * c) = o; }
}
__device__ __forceinline__ void conv_tile_finish(const f32x4 (&v)[16], GLB bf16_t* Bt, int K, int n0, int k0, LAS float* scr, int lane) {
    conv_tile_to_lds(v, scr, lane); LDS_WAIT(); conv_tile_from_lds(Bt, K, n0, k0, scr, lane); LDS_WAIT();
}
struct MoeTile { const GLB float* W; GLB bf16_t* Bt; int ldw, K, k0, s0, n0; };
__device__ __forceinline__ MoeTile moe_tile_desc(const Ctx& C, int idx) {
    constexpr int I_GU1 = (D / 64) * (2 * FF / 64), I_DN1 = (FF / 64) * (D / 64);
    MoeTile t;
    if (idx < NE * I_GU1) {
        const int e = idx / I_GU1, r = idx % I_GU1, nb = r % (2 * FF / 64), kb = r / (2 * FF / 64), tile = nb >> 2, q = nb & 3;
        t.W = ((q < 2) ? INF32(I_MG) : INF32(I_MU)) + (size_t)e * D * FF; t.ldw = FF; t.k0 = 64 * kb; t.s0 = 128 * tile + 64 * (q & 1);
        t.Bt = WSP(bf16_t, WS_MWGU) + (size_t)e * 2 * FF * D; t.K = D; t.n0 = 64 * nb;
    } else {
        const int r0 = idx - NE * I_GU1, e = r0 / I_DN1, r = r0 % I_DN1, nb = r % 32, kb = r / 32;
        t.W = INF32(I_MD) + (size_t)e * FF * D; t.ldw = D; t.k0 = 64 * kb; t.s0 = 64 * nb; t.Bt = WSP(bf16_t, WS_MWD) + (size_t)e * D * FF; t.K = FF; t.n0 = 64 * nb;
    }
    return t;
}
__device__ __forceinline__ void ph_rwkv_scan4(const Ctx& C, int l) {
    int tid = C.tid; asm volatile("" : "+v"(tid));
    const int lane = tid & 63, wave = C.wave;
    if (wave >= 4) {
        if (MOE_CONV_IN_PROLOGUE || blockIdx.x >= 256) return;
        LAS float* scr = (LAS float*)(C.lds + 65536 + (wave - 4) * 16640);
        constexpr int PER = MOE_CONV_ITEMS / 2 / 1024;
        const int first = l * (MOE_CONV_ITEMS / 2) + (blockIdx.x * 4 + (wave - 4)) * PER;
        f32x4 va[16], vb[16];
        MoeTile ta = moe_tile_desc(C, first), tb;
        conv_tile_load(ta.W, ta.ldw, ta.k0, ta.s0, va, lane);
        for (int i = 0; i < PER; i += 2) {
            tb = moe_tile_desc(C, first + i + 1);
            conv_tile_load(tb.W, tb.ldw, tb.k0, tb.s0, vb, lane);
            conv_tile_finish(va, ta.Bt, ta.K, ta.n0, ta.k0, scr, lane);
            if (i + 2 < PER) { ta = moe_tile_desc(C, first + i + 2); conv_tile_load(ta.W, ta.ldw, ta.k0, ta.s0, va, lane); }
            conv_tile_finish(vb, tb.Bt, tb.K, tb.n0, tb.k0, scr, lane);
        }
        return;
    }
    constexpr int CH = 16, CHF = CH * 384, NCH = SEQ / CH;
    LAS float* buf = (LAS float*)C.lds;
    LAS float* ybuf = (LAS float*)(C.lds + 49152);
    volatile LAS unsigned* cnt = (volatile LAS unsigned*)(C.lds + SCAN_CNT_OFF);
    const int it = blockIdx.x;
    if (it >= NB * 16 * 4) return;
    const int qr = it & 3, h = (it >> 2) & 15, b = it >> 6;
    const size_t gbase = (size_t)b * SEQ * 1024 + h * 64;
    const int ro = lane >> 4, kq = lane & 15, rloc = 4 * wave + ro;
    unsigned target = (unsigned)l * 4u * (NCH + 1);
    auto issue = [&](int cidx) {
#pragma unroll
        for (int j = 0; j < 6; ++j) { const int i = wave + 4 * j, rho = 4 * i + ro, step = rho / 6, vec = rho - 6 * step;
            const size_t off = (vec == 0) ? WS_R : (vec == 1) ? WS_DEC : (vec == 2) ? WS_K : (vec == 3) ? WS_KK : (vec == 4) ? WS_AA : WS_V;
            const GLB float* src = WSP(float, off) + gbase + (size_t)(cidx * CH + step) * 1024 + 4 * kq;
            __builtin_amdgcn_global_load_lds((const GLB unsigned*)src, (LAS unsigned*)(buf + (cidx & 1) * CHF + i * 256), 16, 0, 0); }
    };
    auto arrive_wait = [&]() {
        asm volatile("s_waitcnt vmcnt(0) lgkmcnt(0)" ::: "memory");
        target += 4u;
        if (lane == 0) (void)__hip_atomic_fetch_add((LAS unsigned*)(C.lds + SCAN_CNT_OFF), 1u, __ATOMIC_RELAXED, __HIP_MEMORY_SCOPE_WORKGROUP);
        while ((int)(*cnt - target) < 0) __builtin_amdgcn_s_sleep(1);
        asm volatile("" ::: "memory");
    };
    auto flush_y = [&](int cidx) {
        const int st = lane >> 2, r = lane & 3;
        WSP(float, WS_YRAW)[gbase + (size_t)(cidx * CH + st) * 1024 + 16 * qr + 4 * wave + r] = ybuf[(cidx & 1) * 256 + st * 16 + 4 * wave + r];
    };
    f32x2 Sa = {0.f, 0.f}, Sb = {0.f, 0.f};
    issue(0); arrive_wait();
    for (int cidx = 0; cidx < NCH; ++cidx) {
        if (cidx > 0) flush_y(cidx - 1);
        if (cidx + 1 < NCH) issue(cidx + 1);
        const LAS float* cb = buf + (cidx & 1) * CHF;
        LAS float* yb = ybuf + (cidx & 1) * 256;
#pragma unroll 4
        for (int st = 0; st < CH; ++st) {
            const LAS float* rb = cb + st * 384;
            const f32x4 kk4 = *(const LAS f32x4*)(rb + 192 + 4 * kq);
            const f32x2 tp = Sa * (f32x2){kk4[0], kk4[1]} + Sb * (f32x2){kk4[2], kk4[3]};
            const float p = row16_sum(tp[0] + tp[1]);
            const f32x4 w4 = *(const LAS f32x4*)(rb + 64 + 4 * kq), b4 = *(const LAS f32x4*)(rb + 256 + 4 * kq), k4 = *(const LAS f32x4*)(rb + 128 + 4 * kq), r4 = *(const LAS f32x4*)(rb + 4 * kq);
            const float vv = rb[320 + 16 * qr + rloc];
            const f32x2 pp = {p, p}, vv2 = {vv, vv};
            Sa = Sa * (f32x2){w4[0], w4[1]} - pp * (f32x2){b4[0], b4[1]} + vv2 * (f32x2){k4[0], k4[1]};
            Sb = Sb * (f32x2){w4[2], w4[3]} - pp * (f32x2){b4[2], b4[3]} + vv2 * (f32x2){k4[2], k4[3]};
            const f32x2 ty = Sa * (f32x2){r4[0], r4[1]} + Sb * (f32x2){r4[2], r4[3]};
            const float y = row16_sum(ty[0] + ty[1]);
            if (kq == 0) yb[st * 16 + rloc] = y;
        }
        arrive_wait();
    }
    flush_y(NCH - 1);
}

#ifndef SCAN_TOUCH
#define SCAN_TOUCH 1
#endif
#ifndef SCAN_SCHED
#define SCAN_SCHED 1
#endif
#ifndef SCAN_UNROLL
#define SCAN_UNROLL 4
#endif
__device__ __forceinline__ void ph_rwkv_scan3(const Ctx& C, int l) {
    int tid = C.tid; asm volatile("" : "+v"(tid));
    const int lane = tid & 63, wave = C.wave;
    constexpr int CH = 16, CHF = CH * 384, NCH = SEQ / CH;
    LAS float* buf = (LAS float*)C.lds;
    LAS float* ybuf = (LAS float*)(C.lds + 49152);
    LAS float* scr = (LAS float*)(C.lds + 65536 + (wave & 3) * 16640);
    const int it = blockIdx.x;
    if (it >= NB * 16 * 4) return;
    const int qr = it & 3, h = (it >> 2) & 15, b = it >> 6;
    const size_t gbase = (size_t)b * SEQ * 1024 + h * 64;
    const int ro = lane >> 4, kq = lane & 15, rloc = 4 * (wave & 3) + ro;
    const int lj = tid - 256;
    constexpr int PER = MOE_CONV_ITEMS / 2 / 1024;
    static_assert(PER * 1024 * 2 == MOE_CONV_ITEMS && PER * 3 <= NCH, "conversion slots");
    const int cfirst = l * (MOE_CONV_ITEMS / 2) + (blockIdx.x * 4 + (wave & 3)) * PER;
    auto load_chunk = [&](int cidx) {
        f32x4 v[6];
#pragma unroll
        for (int i = 0; i < 6; ++i) { const int idx = lj + 256 * i, step = idx / 96, rem = idx - step * 96, vec = rem >> 4, e4 = rem & 15;
            const size_t off = (vec == 0) ? WS_R : (vec == 1) ? WS_DEC : (vec == 2) ? WS_K : (vec == 3) ? WS_KK : (vec == 4) ? WS_AA : WS_V;
            v[i] = *(const GLB f32x4*)(WSP(float, off) + gbase + (size_t)(cidx * CH + step) * 1024 + 4 * e4); }
        LAS float* d = buf + (cidx & 1) * CHF;
#pragma unroll
        for (int i = 0; i < 6; ++i) { const int idx = lj + 256 * i, step = idx / 96, rem = idx - step * 96; *(LAS f32x4*)(d + step * 384 + rem * 4) = v[i]; }
    };
    auto flush_y = [&](int cidx) {
        const int st = lj >> 4, r = lj & 15;
        WSP(float, WS_YRAW)[gbase + (size_t)(cidx * CH + st) * 1024 + 16 * qr + r] = ybuf[(cidx & 1) * 256 + lj];
    };
    f32x2 Sa = {0.f, 0.f}, Sb = {0.f, 0.f};
    f32x4 cv[16]; MoeTile ct; ct.W = nullptr; ct.Bt = nullptr; ct.ldw = 0; ct.K = 0; ct.k0 = 0; ct.s0 = 0; ct.n0 = 0;
#pragma unroll
    for (int i = 0; i < 16; ++i) cv[i] = (f32x4){0.f, 0.f, 0.f, 0.f};
    if (wave >= 4) load_chunk(0);
    LDS_WAIT(); __syncthreads();
    for (int cidx = 0; cidx < NCH; ++cidx) {
        if (wave >= 4) {
            if (cidx + 1 < NCH) load_chunk(cidx + 1);
            if (cidx > 0) flush_y(cidx - 1);
            if (!MOE_CONV_IN_PROLOGUE) {
                const int q3 = cidx / 3, r3 = cidx - 3 * q3;
                if (r3 == 0 && q3 < PER) { ct = moe_tile_desc(C, cfirst + q3); conv_tile_load(ct.W, ct.ldw, ct.k0, ct.s0, cv, lane); }
                else if (r3 == 1 && q3 < PER) conv_tile_finish(cv, ct.Bt, ct.K, ct.n0, ct.k0, scr, lane);
            }
        } else {
            const LAS float* cb = buf + (cidx & 1) * CHF;
            LAS float* yb = ybuf + (cidx & 1) * 256;
            __builtin_amdgcn_s_setprio(3);
#pragma unroll SCAN_UNROLL
            for (int st = 0; st < CH; ++st) {
                const LAS float* rb = cb + st * 384;
                const f32x4 kk4 = *(const LAS f32x4*)(rb + 192 + 4 * kq);
                const f32x2 tp = Sa * (f32x2){kk4[0], kk4[1]} + Sb * (f32x2){kk4[2], kk4[3]};
                const float p = row16_sum(tp[0] + tp[1]);
                const f32x4 w4 = *(const LAS f32x4*)(rb + 64 + 4 * kq), b4 = *(const LAS f32x4*)(rb + 256 + 4 * kq), k4 = *(const LAS f32x4*)(rb + 128 + 4 * kq), r4 = *(const LAS f32x4*)(rb + 4 * kq);
                const float vv = rb[320 + 16 * qr + rloc];
                const f32x2 pp = {p, p}, vv2 = {vv, vv};
                Sa = Sa * (f32x2){w4[0], w4[1]} - pp * (f32x2){b4[0], b4[1]} + vv2 * (f32x2){k4[0], k4[1]};
                Sb = Sb * (f32x2){w4[2], w4[3]} - pp * (f32x2){b4[2], b4[3]} + vv2 * (f32x2){k4[2], k4[3]};
                const f32x2 ty = Sa * (f32x2){r4[0], r4[1]} + Sb * (f32x2){r4[2], r4[3]};
                const float y = row16_sum(ty[0] + ty[1]);
                if (kq == 0) yb[st * 16 + rloc] = y;
            }
            __builtin_amdgcn_s_setprio(0);
        }
        LDS_WAIT(); __builtin_amdgcn_s_barrier(); asm volatile("" ::: "memory");
    }
    if (wave >= 4) flush_y(NCH - 1);
}


template <int CONV>
__device__ __forceinline__ void ph_rwkv_scan5(const Ctx& C, int l) {
    int tid = C.tid; asm volatile("" : "+v"(tid));
    const int lane = tid & 63, wave = C.wave;
    constexpr int CH = 16, CHF = CH * 384, NCH = SEQ / CH;
    LAS float* buf = (LAS float*)C.lds;
    LAS float* ybuf = (LAS float*)(C.lds + 49152);
    const int it = blockIdx.x;
    if (it >= NB * 16 * 4) return;
    const int qr = it & 3, h = (it >> 2) & 15, b = it >> 6;
    const size_t gbase = (size_t)b * SEQ * 1024 + h * 64;
#define SCAN5_BAR() do { LDS_WAIT(); __builtin_amdgcn_s_barrier(); asm volatile("" ::: "memory"); } while (0)
    if (wave >= 4) {
        LAS float* scr = (LAS float*)(C.lds + 65536 + (wave & 3) * 16640);
        const int lj = tid - 256;
        constexpr int PER = MOE_SCAN_TILES;
        static_assert(PER * 1024 * 2 <= MOE_CONV_ITEMS && PER * 3 + 2 <= NCH && PER % 2 == 0, "conversion slots");
        const int cfirst = ((CONV >= 2) ? 1 : l) * (1024 * PER) + (blockIdx.x * 4 + (wave & 3));
        f32x4 nx[5];
        const unsigned lo_g = (unsigned)((lj >> 4) * 1024 + 4 * (lj & 15));
        const int lo_l = (lj >> 4) * 384 + 4 * (lj & 15);
        const f32x4 kkw = *(const GLB f32x4*)(INF32(I_RWKK) + l * 1024 + h * 64 + 4 * (lj & 15)), kaw = *(const GLB f32x4*)(INF32(I_RWKA) + l * 1024 + h * 64 + 4 * (lj & 15));
        u32x2 nb[4];
        auto fetch_chunk = [&](int cidx) {
            nx[1] = *(const GLB f32x4*)(WSP(float, WS_DEC) + gbase + (size_t)(cidx * CH) * 1024 + lo_g);
#pragma unroll
            for (int i = 0; i < 4; ++i) { const size_t off = (i == 0) ? WS_R : (i == 1) ? WS_K : (i == 2) ? WS_AA : WS_V;
                nb[i] = *(const GLB u32x2*)(WSP(bf16_t, off) + gbase + (size_t)(cidx * CH) * 1024 + lo_g); }
        };
        auto put_chunk = [&](int cidx) {
            LAS float* d = buf + (cidx & 1) * CHF + lo_l;
            asm volatile("" : "+v"(nx[1]), "+v"(nb[0]), "+v"(nb[1]), "+v"(nb[2]), "+v"(nb[3]));
            nx[0] = (f32x4){bflo(nb[0].x), bfhi(nb[0].x), bflo(nb[0].y), bfhi(nb[0].y)}; nx[4] = (f32x4){bflo(nb[3].x), bfhi(nb[3].x), bflo(nb[3].y), bfhi(nb[3].y)};
            const f32x4 kr = (f32x4){bflo(nb[1].x), bfhi(nb[1].x), bflo(nb[1].y), bfhi(nb[1].y)}, av = (f32x4){bflo(nb[2].x), bfhi(nb[2].x), bflo(nb[2].y), bfhi(nb[2].y)};
            f32x4 kk = kr * kkw;
            const float ss = row16_sum((kk[0] * kk[0] + kk[1] * kk[1]) + (kk[2] * kk[2] + kk[3] * kk[3]));
            kk = kk * (1.0f / fmaxf(sqrtf(ss), 1e-12f));
            *(LAS f32x4*)(d) = nx[0]; *(LAS f32x4*)(d + 64) = nx[1]; *(LAS f32x4*)(d + 128) = kr * (1.0f + (av - 1.0f) * kaw);
            *(LAS f32x4*)(d + 192) = kk; *(LAS f32x4*)(d + 256) = kk * av; *(LAS f32x4*)(d + 320) = nx[4];
        };
        auto flush_y = [&](int cidx) {
            const int st = lj >> 4, r = lj & 15;
            WSP(float, WS_YRAW)[gbase + (size_t)(cidx * CH + st) * 1024 + 16 * qr + r] = ybuf[(cidx & 1) * 256 + lj];
        };
#if SCAN_SCHED == 4
        struct FS { f32x4 dec; u32x2 nb[4]; };
        FS fs[6];
        auto fetch2 = [&](int cidx, FS& f) {
            f.dec = *(const GLB f32x4*)(WSP(float, WS_DEC) + gbase + (size_t)(cidx * CH) * 1024 + lo_g);
#pragma unroll
            for (int i = 0; i < 4; ++i) { const size_t off = (i == 0) ? WS_R : (i == 1) ? WS_K : (i == 2) ? WS_AA : WS_V;
                f.nb[i] = *(const GLB u32x2*)(WSP(bf16_t, off) + gbase + (size_t)(cidx * CH) * 1024 + lo_g); }
        };
        auto put2 = [&](int cidx, FS& f) {
            LAS float* d = buf + (cidx & 1) * CHF + lo_l;
            asm volatile("" : "+v"(f.dec), "+v"(f.nb[0]), "+v"(f.nb[1]), "+v"(f.nb[2]), "+v"(f.nb[3]));
            const f32x4 rr = (f32x4){bflo(f.nb[0].x), bfhi(f.nb[0].x), bflo(f.nb[0].y), bfhi(f.nb[0].y)}, vv = (f32x4){bflo(f.nb[3].x), bfhi(f.nb[3].x), bflo(f.nb[3].y), bfhi(f.nb[3].y)};
            const f32x4 kr = (f32x4){bflo(f.nb[1].x), bfhi(f.nb[1].x), bflo(f.nb[1].y), bfhi(f.nb[1].y)}, av = (f32x4){bflo(f.nb[2].x), bfhi(f.nb[2].x), bflo(f.nb[2].y), bfhi(f.nb[2].y)};
            f32x4 kk = kr * kkw;
            const float ss = row16_sum((kk[0] * kk[0] + kk[1] * kk[1]) + (kk[2] * kk[2] + kk[3] * kk[3]));
            kk = kk * (1.0f / fmaxf(sqrtf(ss), 1e-12f));
            *(LAS f32x4*)(d) = rr; *(LAS f32x4*)(d + 64) = f.dec; *(LAS f32x4*)(d + 128) = kr * (1.0f + (av - 1.0f) * kaw);
            *(LAS f32x4*)(d + 192) = kk; *(LAS f32x4*)(d + 256) = kk * av; *(LAS f32x4*)(d + 320) = vv;
        };
        f32x4 cv[16]; MoeTile ct; ct.W = nullptr; ct.Bt = nullptr; ct.ldw = 0; ct.K = 0; ct.k0 = 0; ct.s0 = 0; ct.n0 = 0;
#pragma unroll
        for (int i = 0; i < 16; ++i) cv[i] = (f32x4){0.f, 0.f, 0.f, 0.f};
        {
            const int vit = blockIdx.x * 4 + (wave & 3);
            if (vit < 512) { const int sb = vit & 31, hd = (vit >> 5) & 1, vb = (vit >> 6) & 3;
                if ((vit >> 8) == 0) vt_tile(WSP(bf16_t, WS_VS) + ((size_t)vb * SEQ + 64 * sb) * 128 + 64 * hd, 128, WSP(bf16_t, WS_SWVT) + ((size_t)(vb * 2 + hd) * 64) * SEQ + 64 * sb, (LAS bf16_t*)scr, lane);
                else vt_tile(WSP(bf16_t, WS_VD) + ((size_t)vb * SEQ + 64 * sb) * 128 + 64 * hd, 128, WSP(bf16_t, WS_VDT) + ((size_t)vb * 128 + 64 * hd) * SEQ + 64 * sb, (LAS bf16_t*)scr, lane); }
        }
        static_assert(PER * 3 + 2 == NCH && PER % 2 == 0, "period schedule");
        const int off = (int)((blockIdx.x * 4u + (unsigned)(wave & 3)) & 1u);
        fetch2(0, fs[0]); put2(0, fs[0]); fetch2(1, fs[0]);
        SCAN5_BAR();
        int c = 0;
        for (; c < 1 + off; ++c) { put2(c + 1, fs[0]); fetch2(c + 2, fs[0]); if (c > 0) flush_y(c - 1); SCAN5_BAR(); }
#pragma unroll
        for (int i = 1; i < 6; ++i) fetch2(c + 1 + i, fs[i]);
        asm volatile("; MARK scan5 periodic begin");
        auto period = [&](int j6, bool first) {
#pragma unroll
            for (int m6 = 0; m6 < 6; ++m6) {
                asm volatile("; MARK m6 iter");
                put2(c + 1, fs[m6]); fetch2(c + 7 < NCH ? c + 7 : NCH - 1, fs[m6]); flush_y(c - 1);
                if (!MOE_CONV_IN_PROLOGUE && CONV) {
                    if (m6 == 0) { if (!first) conv_tile_finish(cv, ct.Bt, ct.K, ct.n0, ct.k0, scr, lane);
                        ct = moe_tile_desc(C, cfirst + 1024 * (2 * j6)); conv_tile_load(ct.W, ct.ldw, ct.k0, ct.s0, cv, lane); }
                    if (m6 == 3 && !first) { const MoeTile cb = moe_tile_desc(C, cfirst + 1024 * (2 * j6 - 1)); conv_tile_from_lds(cb.Bt, cb.K, cb.n0, cb.k0, scr, lane); }
                }
                SCAN5_BAR(); ++c;
            }
        };
        period(0, true);
        for (int j6 = 1; j6 < PER / 2; ++j6) period(j6, false);
        asm volatile("; MARK scan5 periodic end");
        for (; c < NCH; ++c) { flush_y(c - 1); SCAN5_BAR(); }
        if (!MOE_CONV_IN_PROLOGUE && CONV) {
            conv_tile_finish(cv, ct.Bt, ct.K, ct.n0, ct.k0, scr, lane);
            SCAN5_BAR();
            SCAN5_BAR();
            { const MoeTile cb = moe_tile_desc(C, cfirst + 1024 * (PER - 1)); conv_tile_from_lds(cb.Bt, cb.K, cb.n0, cb.k0, scr, lane); }
        }
#elif SCAN_SCHED == 3
        struct FS { f32x4 dec; u32x2 nb[4]; };
        FS fs[6];
        auto fetch2 = [&](int cidx, FS& f) {
            f.dec = *(const GLB f32x4*)(WSP(float, WS_DEC) + gbase + (size_t)(cidx * CH) * 1024 + lo_g);
#pragma unroll
            for (int i = 0; i < 4; ++i) { const size_t off = (i == 0) ? WS_R : (i == 1) ? WS_K : (i == 2) ? WS_AA : WS_V;
                f.nb[i] = *(const GLB u32x2*)(WSP(bf16_t, off) + gbase + (size_t)(cidx * CH) * 1024 + lo_g); }
        };
        auto put2 = [&](int cidx, FS& f) {
            LAS float* d = buf + (cidx & 1) * CHF + lo_l;
            asm volatile("" : "+v"(f.dec), "+v"(f.nb[0]), "+v"(f.nb[1]), "+v"(f.nb[2]), "+v"(f.nb[3]));
            const f32x4 rr = (f32x4){bflo(f.nb[0].x), bfhi(f.nb[0].x), bflo(f.nb[0].y), bfhi(f.nb[0].y)}, vv = (f32x4){bflo(f.nb[3].x), bfhi(f.nb[3].x), bflo(f.nb[3].y), bfhi(f.nb[3].y)};
            const f32x4 kr = (f32x4){bflo(f.nb[1].x), bfhi(f.nb[1].x), bflo(f.nb[1].y), bfhi(f.nb[1].y)}, av = (f32x4){bflo(f.nb[2].x), bfhi(f.nb[2].x), bflo(f.nb[2].y), bfhi(f.nb[2].y)};
            f32x4 kk = kr * kkw;
            const float ss = row16_sum((kk[0] * kk[0] + kk[1] * kk[1]) + (kk[2] * kk[2] + kk[3] * kk[3]));
            kk = kk * (1.0f / fmaxf(sqrtf(ss), 1e-12f));
            *(LAS f32x4*)(d) = rr; *(LAS f32x4*)(d + 64) = f.dec; *(LAS f32x4*)(d + 128) = kr * (1.0f + (av - 1.0f) * kaw);
            *(LAS f32x4*)(d + 192) = kk; *(LAS f32x4*)(d + 256) = kk * av; *(LAS f32x4*)(d + 320) = vv;
        };
        f32x4 cv[16]; MoeTile ct; ct.W = nullptr; ct.Bt = nullptr; ct.ldw = 0; ct.K = 0; ct.k0 = 0; ct.s0 = 0; ct.n0 = 0;
#pragma unroll
        for (int i = 0; i < 16; ++i) cv[i] = (f32x4){0.f, 0.f, 0.f, 0.f};
        {
            const int vit = blockIdx.x * 4 + (wave & 3);
            if (vit < 512) { const int sb = vit & 31, hd = (vit >> 5) & 1, vb = (vit >> 6) & 3;
                if ((vit >> 8) == 0) vt_tile(WSP(bf16_t, WS_VS) + ((size_t)vb * SEQ + 64 * sb) * 128 + 64 * hd, 128, WSP(bf16_t, WS_SWVT) + ((size_t)(vb * 2 + hd) * 64) * SEQ + 64 * sb, (LAS bf16_t*)scr, lane);
                else vt_tile(WSP(bf16_t, WS_VD) + ((size_t)vb * SEQ + 64 * sb) * 128 + 64 * hd, 128, WSP(bf16_t, WS_VDT) + ((size_t)vb * 128 + 64 * hd) * SEQ + 64 * sb, (LAS bf16_t*)scr, lane); }
        }
        static_assert(PER * 3 + 2 == NCH && PER % 2 == 0, "period schedule");
        const int off = (int)((blockIdx.x * 4u + (unsigned)(wave & 3)) & 1u);
        fetch2(0, fs[0]); put2(0, fs[0]); fetch2(1, fs[0]);
        SCAN5_BAR();
        int c = 0;
        for (; c < 1 + off; ++c) { put2(c + 1, fs[0]); fetch2(c + 2, fs[0]); if (c > 0) flush_y(c - 1); SCAN5_BAR(); }
#pragma unroll
        for (int i = 1; i < 6; ++i) fetch2(c + 1 + i, fs[i]);
        asm volatile("; MARK scan5 periodic begin");
        auto period = [&](int j6, bool first) {
#pragma unroll
            for (int m6 = 0; m6 < 6; ++m6) {
                asm volatile("; MARK m6 iter");
                put2(c + 1, fs[m6]); fetch2(c + 7 < NCH ? c + 7 : NCH - 1, fs[m6]); flush_y(c - 1);
                if (!MOE_CONV_IN_PROLOGUE && CONV && (m6 == 0 || (m6 == 3 && CONV != 5))) {
                    if (!(first && m6 == 0)) { if (CONV == 1) conv_tile_finish(cv, ct.Bt, ct.K, ct.n0, ct.k0, scr, lane);
                        else { asm volatile("" :: "v"(cv[0]), "v"(cv[1]), "v"(cv[2]), "v"(cv[3]), "v"(cv[4]), "v"(cv[5]), "v"(cv[6]), "v"(cv[7])); asm volatile("" :: "v"(cv[8]), "v"(cv[9]), "v"(cv[10]), "v"(cv[11]), "v"(cv[12]), "v"(cv[13]), "v"(cv[14]), "v"(cv[15])); } }
                    ct = moe_tile_desc(C, cfirst + 1024 * (2 * j6 + (m6 == 3 ? 1 : 0))); conv_tile_load(ct.W, ct.ldw, ct.k0, ct.s0, cv, lane);
                }
                SCAN5_BAR(); ++c;
            }
        };
        period(0, true);
        for (int j6 = 1; j6 < PER / 2; ++j6) period(j6, false);
        asm volatile("; MARK scan5 periodic end");
        for (; c < NCH; ++c) { flush_y(c - 1); SCAN5_BAR(); }
        if (!MOE_CONV_IN_PROLOGUE && CONV == 1) conv_tile_finish(cv, ct.Bt, ct.K, ct.n0, ct.k0, scr, lane);
#elif SCAN_SCHED == 2
        struct FS { f32x4 dec; u32x2 nb[4]; };
        FS fs[2];
        auto fetch2 = [&](int cidx, FS& f) {
            f.dec = *(const GLB f32x4*)(WSP(float, WS_DEC) + gbase + (size_t)(cidx * CH) * 1024 + lo_g);
#pragma unroll
            for (int i = 0; i < 4; ++i) { const size_t off = (i == 0) ? WS_R : (i == 1) ? WS_K : (i == 2) ? WS_AA : WS_V;
                f.nb[i] = *(const GLB u32x2*)(WSP(bf16_t, off) + gbase + (size_t)(cidx * CH) * 1024 + lo_g); }
        };
        auto put2 = [&](int cidx, FS& f) {
            LAS float* d = buf + (cidx & 1) * CHF + lo_l;
            asm volatile("" : "+v"(f.dec), "+v"(f.nb[0]), "+v"(f.nb[1]), "+v"(f.nb[2]), "+v"(f.nb[3]));
            const f32x4 rr = (f32x4){bflo(f.nb[0].x), bfhi(f.nb[0].x), bflo(f.nb[0].y), bfhi(f.nb[0].y)}, vv = (f32x4){bflo(f.nb[3].x), bfhi(f.nb[3].x), bflo(f.nb[3].y), bfhi(f.nb[3].y)};
            const f32x4 kr = (f32x4){bflo(f.nb[1].x), bfhi(f.nb[1].x), bflo(f.nb[1].y), bfhi(f.nb[1].y)}, av = (f32x4){bflo(f.nb[2].x), bfhi(f.nb[2].x), bflo(f.nb[2].y), bfhi(f.nb[2].y)};
            f32x4 kk = kr * kkw;
            const float ss = row16_sum((kk[0] * kk[0] + kk[1] * kk[1]) + (kk[2] * kk[2] + kk[3] * kk[3]));
            kk = kk * (1.0f / fmaxf(sqrtf(ss), 1e-12f));
            *(LAS f32x4*)(d) = rr; *(LAS f32x4*)(d + 64) = f.dec; *(LAS f32x4*)(d + 128) = kr * (1.0f + (av - 1.0f) * kaw);
            *(LAS f32x4*)(d + 192) = kk; *(LAS f32x4*)(d + 256) = kk * av; *(LAS f32x4*)(d + 320) = vv;
        };
        f32x4 cv[16]; MoeTile ct; ct.W = nullptr; ct.Bt = nullptr; ct.ldw = 0; ct.K = 0; ct.k0 = 0; ct.s0 = 0; ct.n0 = 0;
#pragma unroll
        for (int i = 0; i < 16; ++i) cv[i] = (f32x4){0.f, 0.f, 0.f, 0.f};
        {
            const int vit = blockIdx.x * 4 + (wave & 3);
            if (vit < 512) { const int sb = vit & 31, hd = (vit >> 5) & 1, vb = (vit >> 6) & 3;
                if ((vit >> 8) == 0) vt_tile(WSP(bf16_t, WS_VS) + ((size_t)vb * SEQ + 64 * sb) * 128 + 64 * hd, 128, WSP(bf16_t, WS_SWVT) + ((size_t)(vb * 2 + hd) * 64) * SEQ + 64 * sb, (LAS bf16_t*)scr, lane);
                else vt_tile(WSP(bf16_t, WS_VD) + ((size_t)vb * SEQ + 64 * sb) * 128 + 64 * hd, 128, WSP(bf16_t, WS_VDT) + ((size_t)vb * 128 + 64 * hd) * SEQ + 64 * sb, (LAS bf16_t*)scr, lane); }
        }
        static_assert(PER * 3 + 2 == NCH && PER % 2 == 0, "period schedule");
        const int off = (int)((blockIdx.x * 4u + (unsigned)(wave & 3)) & 1u);
        fetch2(0, fs[0]); put2(0, fs[0]); fetch2(1, fs[0]);
        SCAN5_BAR();
        int c = 0;
        for (; c < 1 + off; ++c) { put2(c + 1, fs[0]); fetch2(c + 2, fs[0]); if (c > 0) flush_y(c - 1); SCAN5_BAR(); }
        fetch2(c + 2, fs[1]);
        asm volatile("; MARK scan5 periodic begin");
        auto period = [&](int j6, bool first) {
#pragma unroll
            for (int m6 = 0; m6 < 6; ++m6) {
                asm volatile("; MARK m6 iter");
                put2(c + 1, fs[m6 & 1]); fetch2(c + 3 < NCH ? c + 3 : NCH - 1, fs[m6 & 1]); flush_y(c - 1);
                if (!MOE_CONV_IN_PROLOGUE && CONV && (m6 == 0 || (m6 == 3 && CONV != 5))) {
                    if (!(first && m6 == 0)) {
                        if (CONV == 1 || CONV == 4) conv_tile_finish(cv, ct.Bt, ct.K, ct.n0, ct.k0, scr, lane);
                        else if (CONV == 3) { const int cc = lane & 7;
#pragma unroll
                            for (int j = 0; j < 8; ++j) { const int n = (lane >> 3) + 8 * j; u32x4 o; o.x = pk2(cv[2 * j][0], cv[2 * j][1]); o.y = pk2(cv[2 * j][2], cv[2 * j][3]); o.z = pk2(cv[2 * j + 1][0], cv[2 * j + 1][1]); o.w = pk2(cv[2 * j + 1][2], cv[2 * j + 1][3]);
                                *(GLB u32x4*)(ct.Bt + (size_t)(ct.n0 + n) * ct.K + ct.k0 + 8 * cc) = o; } }
                        else { asm volatile("" :: "v"(cv[0]), "v"(cv[1]), "v"(cv[2]), "v"(cv[3]), "v"(cv[4]), "v"(cv[5]), "v"(cv[6]), "v"(cv[7])); asm volatile("" :: "v"(cv[8]), "v"(cv[9]), "v"(cv[10]), "v"(cv[11]), "v"(cv[12]), "v"(cv[13]), "v"(cv[14]), "v"(cv[15])); }
                    }
                    ct = moe_tile_desc(C, cfirst + 1024 * (2 * j6 + (m6 == 3 ? 1 : 0))); conv_tile_load(ct.W, ct.ldw, ct.k0, ct.s0, cv, lane);
                }
                SCAN5_BAR(); ++c;
            }
        };
        period(0, true);
        for (int j6 = 1; j6 < PER / 2; ++j6) period(j6, false);
        asm volatile("; MARK scan5 periodic end");
        for (; c < NCH; ++c) { flush_y(c - 1); SCAN5_BAR(); }
        if (!MOE_CONV_IN_PROLOGUE && (CONV == 1 || CONV == 4)) conv_tile_finish(cv, ct.Bt, ct.K, ct.n0, ct.k0, scr, lane);
#elif SCAN_SCHED == 1
        f32x4 cv[16]; MoeTile ct; ct.W = nullptr; ct.Bt = nullptr; ct.ldw = 0; ct.K = 0; ct.k0 = 0; ct.s0 = 0; ct.n0 = 0;
#pragma unroll
        for (int i = 0; i < 16; ++i) cv[i] = (f32x4){0.f, 0.f, 0.f, 0.f};
        {
            const int vit = blockIdx.x * 4 + (wave & 3);
            if (vit < 512) { const int sb = vit & 31, hd = (vit >> 5) & 1, vb = (vit >> 6) & 3;
                if ((vit >> 8) == 0) vt_tile(WSP(bf16_t, WS_VS) + ((size_t)vb * SEQ + 64 * sb) * 128 + 64 * hd, 128, WSP(bf16_t, WS_SWVT) + ((size_t)(vb * 2 + hd) * 64) * SEQ + 64 * sb, (LAS bf16_t*)scr, lane);
                else vt_tile(WSP(bf16_t, WS_VD) + ((size_t)vb * SEQ + 64 * sb) * 128 + 64 * hd, 128, WSP(bf16_t, WS_VDT) + ((size_t)vb * 128 + 64 * hd) * SEQ + 64 * sb, (LAS bf16_t*)scr, lane); }
        }
        static_assert(PER * 3 + 2 == NCH && PER % 2 == 0, "period schedule");
        const int off = (int)((blockIdx.x * 4u + (unsigned)(wave & 3)) & 1u);
        auto plain = [&](int c) { if (c + 1 < NCH) put_chunk(c + 1); if (c + 2 < NCH) fetch_chunk(c + 2); if (c > 0) flush_y(c - 1); };
        auto plain_nc = [&](int c) { put_chunk(c + 1); fetch_chunk(c + 2 < NCH ? c + 2 : NCH - 1); flush_y(c - 1); };
        fetch_chunk(0); put_chunk(0); fetch_chunk(1);
        SCAN5_BAR();
        int c = 0;
        for (; c < 1 + off; ++c) { plain(c); SCAN5_BAR(); }
        asm volatile("; MARK scan5 periodic begin");
        auto period = [&](int j6) {
#pragma unroll
            for (int m6 = 0; m6 < 6; ++m6) {
                asm volatile("; MARK m6 iter");
                plain_nc(c);
                if (!MOE_CONV_IN_PROLOGUE && CONV) {
                    if (m6 == 0 || m6 == 3) { ct = moe_tile_desc(C, cfirst + 1024 * (2 * j6 + (m6 == 3 ? 1 : 0))); conv_tile_load(ct.W, ct.ldw, ct.k0, ct.s0, cv, lane); }
                    if (m6 == 2 || m6 == 5) conv_tile_finish(cv, ct.Bt, ct.K, ct.n0, ct.k0, scr, lane);
                }
                SCAN5_BAR(); ++c;
            }
        };
        period(0);
        for (int j6 = 1; j6 < PER / 2; ++j6) period(j6);
        asm volatile("; MARK scan5 periodic end");
        for (; c < NCH; ++c) { plain(c); SCAN5_BAR(); }
#else
        f32x4 cv[16], cv2[16]; MoeTile ct; ct.W = nullptr; ct.Bt = nullptr; ct.ldw = 0; ct.K = 0; ct.k0 = 0; ct.s0 = 0; ct.n0 = 0; MoeTile ct2 = ct;
#pragma unroll
        for (int i = 0; i < 16; ++i) { cv[i] = (f32x4){0.f, 0.f, 0.f, 0.f}; cv2[i] = cv[i]; }
        {
            const int vit = blockIdx.x * 4 + (wave & 3);
            if (vit < 512) { const int sb = vit & 31, hd = (vit >> 5) & 1, vb = (vit >> 6) & 3;
                if ((vit >> 8) == 0) vt_tile(WSP(bf16_t, WS_VS) + ((size_t)vb * SEQ + 64 * sb) * 128 + 64 * hd, 128, WSP(bf16_t, WS_SWVT) + ((size_t)(vb * 2 + hd) * 64) * SEQ + 64 * sb, (LAS bf16_t*)scr, lane);
                else vt_tile(WSP(bf16_t, WS_VD) + ((size_t)vb * SEQ + 64 * sb) * 128 + 64 * hd, 128, WSP(bf16_t, WS_VDT) + ((size_t)vb * 128 + 64 * hd) * SEQ + 64 * sb, (LAS bf16_t*)scr, lane); }
        }
        fetch_chunk(0); put_chunk(0); fetch_chunk(1);
        SCAN5_BAR();
        for (int cidx = 0; cidx < NCH; ++cidx) {
            if (cidx + 1 < NCH) put_chunk(cidx + 1);
            if (cidx + 2 < NCH) fetch_chunk(cidx + 2);
            if (cidx > 0) flush_y(cidx - 1);
            if (!MOE_CONV_IN_PROLOGUE) {
                const int j6 = cidx / 6, m6 = cidx - 6 * j6;
                if (m6 == 0 && 2 * j6 < PER) { ct = moe_tile_desc(C, cfirst + 1024 * (2 * j6)); conv_tile_load(ct.W, ct.ldw, ct.k0, ct.s0, cv, lane); }
                else if (m6 == 4 && 2 * j6 < PER) conv_tile_finish(cv, ct.Bt, ct.K, ct.n0, ct.k0, scr, lane);
                else if (m6 == 3 && 2 * j6 + 1 < PER) { ct2 = moe_tile_desc(C, cfirst + 1024 * (2 * j6 + 1)); conv_tile_load(ct2.W, ct2.ldw, ct2.k0, ct2.s0, cv2, lane); }
                else if (m6 == 1 && j6 >= 1 && 2 * j6 - 1 < PER) conv_tile_finish(cv2, ct2.Bt, ct2.K, ct2.n0, ct2.k0, scr, lane);
            }
            SCAN5_BAR();
        }
#endif
        flush_y(NCH - 1);
    } else {
        const int ro = lane >> 4, kq = lane & 15, rloc = 4 * wave + ro;
        f32x2 Sa = {0.f, 0.f}, Sb = {0.f, 0.f};
        constexpr bool CONVB = SCAN_SCHED == 4 && CONV == 1 && !MOE_CONV_IN_PROLOGUE;
        f32x4 cvB[16];
#pragma unroll
        for (int i = 0; i < 16; ++i) cvB[i] = (f32x4){0.f, 0.f, 0.f, 0.f};
        LAS float* scrp = (LAS float*)(C.lds + 65536 + wave * 16640);
        const int cfirstc = l * (1024 * MOE_SCAN_TILES) + (blockIdx.x * 4 + wave);
        int bj = 0, bnext = 2 + (int)((blockIdx.x * 4u + (unsigned)wave) & 1u);
        SCAN5_BAR();
        for (int cidx = 0; cidx < NCH; ++cidx) {
            if (CONVB && cidx == bnext) {
                if (bj >= 1) conv_tile_to_lds(cvB, scrp, lane);
                if (bj < MOE_SCAN_TILES / 2) { const MoeTile tb = moe_tile_desc(C, cfirstc + 1024 * (2 * bj + 1)); conv_tile_load(tb.W, tb.ldw, tb.k0, tb.s0, cvB, lane); }
                ++bj; bnext += 6;
            }
            const LAS float* cb = buf + (cidx & 1) * CHF + 4 * kq;
            const LAS float* vb = buf + (cidx & 1) * CHF + 320 + 16 * qr + rloc;
            float ykeep = 0.f;
            f32x4 kk4 = *(const LAS f32x4*)(cb + 192), w4 = *(const LAS f32x4*)(cb + 64), b4 = *(const LAS f32x4*)(cb + 256), k4 = *(const LAS f32x4*)(cb + 128), r4 = *(const LAS f32x4*)(cb);
            float vv = vb[0];
#pragma unroll
            for (int st = 0; st < CH; ++st) {
                f32x4 kk4n = kk4, w4n = w4, b4n = b4, k4n = k4, r4n = r4; float vvn = vv;
                if (st + 1 < CH) { const LAS float* nb = cb + (st + 1) * 384;
                    kk4n = *(const LAS f32x4*)(nb + 192); w4n = *(const LAS f32x4*)(nb + 64); b4n = *(const LAS f32x4*)(nb + 256); k4n = *(const LAS f32x4*)(nb + 128); r4n = *(const LAS f32x4*)(nb); vvn = vb[(st + 1) * 384]; }
                const f32x2 tp = Sa * (f32x2){kk4[0], kk4[1]} + Sb * (f32x2){kk4[2], kk4[3]};
                const float p = row16_sum(tp[0] + tp[1]);
                const f32x2 pp = {p, p}, vv2 = {vv, vv};
                Sa = Sa * (f32x2){w4[0], w4[1]} - pp * (f32x2){b4[0], b4[1]} + vv2 * (f32x2){k4[0], k4[1]};
                Sb = Sb * (f32x2){w4[2], w4[3]} - pp * (f32x2){b4[2], b4[3]} + vv2 * (f32x2){k4[2], k4[3]};
                const f32x2 ty = Sa * (f32x2){r4[0], r4[1]} + Sb * (f32x2){r4[2], r4[3]};
                const float y = row16_sum(ty[0] + ty[1]);
                ykeep = (kq == st) ? y : ykeep;
                kk4 = kk4n; w4 = w4n; b4 = b4n; k4 = k4n; r4 = r4n; vv = vvn;
            }
            ybuf[(cidx & 1) * 256 + kq * 16 + rloc] = ykeep;
            SCAN5_BAR();
        }
        if (CONVB) { SCAN5_BAR(); conv_tile_to_lds(cvB, scrp, lane); SCAN5_BAR(); }
    }
#undef SCAN5_BAR
}
struct Args { const void* in[N_INPUTS]; float* out; unsigned char* ws; int ph_lo, ph_hi; };
static_assert(sizeof(Args) == N_INPUTS * 8 + 24, "Args has no padding");

constexpr int N_PHASES = 2 + 12 + 14;

#ifndef USE_FAST
#define USE_FAST 271
#endif
#ifndef PROBE_CONV
#define PROBE_CONV 3
#endif
#ifndef PROBE_MASK
#define PROBE_MASK 0
#endif
#ifndef DBG_SKIP_MASK
#define DBG_SKIP_MASK 0
#endif

__global__ void __launch_bounds__(NTHR, 2) fwd_kernel(Args args) {
    extern __shared__ __attribute__((aligned(16))) unsigned char lds_raw[];
    LAS unsigned char* const lds = (LAS unsigned char*)lds_raw;
    {
        const int tid0 = threadIdx.x;
        volatile LAS unsigned* MISC0 = (volatile LAS unsigned*)(lds + MISC_OFF);
        for (int u = tid0; u < (LDS_BYTES - MISC_OFF) / 4; u += NTHR) MISC0[u] = 0u;
        __syncthreads();
        LAS unsigned long long* tab = (LAS unsigned long long*)(lds + INTAB_OFF);
        if (tid0 < N_INPUTS) tab[tid0] = (unsigned long long)args.in[tid0];
        if (tid0 == 64) { tab[TAB_WS] = (unsigned long long)args.ws; tab[TAB_OUT] = (unsigned long long)args.out;
            tab[TAB_RANGE] = ((unsigned long long)(unsigned)args.ph_hi << 32) | (unsigned)args.ph_lo; }
        __syncthreads();
        if (args.ph_hi - args.ph_lo > 1) (void)xcd_barrier_post((unsigned*)(args.ws + WS_CTL) + CW_BAR, MISC0 + 8);
    }
    LAS unsigned char* ring = lds;
    int ph = 0;
#define PH_BEGIN { const int lo = (int)__builtin_amdgcn_readfirstlane(((const LAS unsigned*)(lds + INTAB_OFF))[2 * TAB_RANGE]), hi = (int)__builtin_amdgcn_readfirstlane(((const LAS unsigned*)(lds + INTAB_OFF))[2 * TAB_RANGE + 1]); \
    if (ph >= lo && ph < hi) { const Ctx C = make_ctx(lds);
#define PH_END if (ph + 1 < hi) { XcdBarrier bar; bar.bar = (unsigned*)WSP(unsigned, WS_CTL) + CW_BAR; bar.x = xb_xcc_id(); bar.st = (volatile LAS unsigned*)(lds + MISC_OFF) + 8; xcd_barrier(bar); } \
    else { VM_WAIT(); __syncthreads(); } } } ++ph;
#define REP(g, ...) { GLB float* XOUT = C.out; (void)XOUT; __VA_ARGS__ } if (PROBE_MASK & (g)) { GLB float* XOUT = WSP(float, WS_SC); (void)XOUT; __VA_ARGS__ }

    PH_BEGIN REP(1,  ph_prologue(C); ph_norm<0, false>(C, INF32(I_X), nullptr, INF32(I_MIXN), nullptr); ) PH_END
    PH_BEGIN REP(256,  { pg8::Gemm g{WSP(bf16_t, WS_PCAT), WSP(bf16_t, WS_WPP), 512, 256}; pg8::ProjOrder S; S.init(C.G, (int)blockIdx.x); pg8::EpiProj E{WSP(bf16_t, WS_PROJ)};
        pg8::gemm_phase<pg8::EpiProj, pg8::ProjOrder>(ring, g, S, E); } ) PH_END

    { constexpr int l = 0;
        if (l > 0) { PH_BEGIN REP(32768,  ph_norm<0>(C, WSP(bf16_t, WS_XB), nullptr, INF32(I_MIXN) + l * D, nullptr); ) PH_END }
        PH_BEGIN REP(4096,  { pg8::Gemm g{WSP(bf16_t, WS_H), WSP(bf16_t, WS_WIN + l * SZ_WIN1), D, D}; pg8::StaticOrder S; S.init(T, N_INP, C.G, (int)blockIdx.x);
            pg8::EpiWin E{WSP(bf16_t, WS_SBQKV), WSP(bf16_t, WS_UF), WSP(bf16_t, WS_GATE)};
            pg8::gemm_phase<pg8::EpiWin, pg8::StaticOrder>(ring, g, S, E); } ) PH_END
        PH_BEGIN REP(16384,  ph_prep(C, l); ph_vt(C); ph_latent(C, l); ) PH_END
        PH_BEGIN REP(256,  { pg8::Gemm g{WSP(bf16_t, WS_ALORA), WSP(bf16_t, WS_WLORA + l * SZ_WLORA1), 256, 256}; pg8::StaticOrder S; S.init(T, 3072, C.G, (int)blockIdx.x);
            pg8::EpiLora E{WSP(float, WS_DEC), WSP(bf16_t, WS_AA), WSP(bf16_t, WS_GG), INF32(I_RWW0) + l * 1024, INF32(I_RWA0) + l * 1024};
            pg8::gemm_phase<pg8::EpiLora, pg8::StaticOrder>(ring, g, S, E); } ) PH_END
        PH_BEGIN REP(32,  if (!(DBG_SKIP_MASK & 2)) { if (USE_FAST & 256) { ph_rwkv_scan5<1>(C, l); if (PROBE_MASK & 2097152) ph_rwkv_scan5<0>(C, l); if ((PROBE_MASK & 4194304) && l == 0) ph_rwkv_scan5<PROBE_CONV>(C, l); } else if (USE_FAST & 128) ph_rwkv_scan4(C, l); else if (USE_FAST & 64) ph_rwkv_scan3(C, l); else if (USE_FAST & 32) ph_rwkv_scan_conv(C, l); else if (USE_FAST & 2) ph_rwkv_scan_fast(C); else ph_rwkv_scan_naive(C); } ) PH_END
        PH_BEGIN REP(8,  ph_sb_fast(C); ) REP(64,  ph_dsa_fast(C, l); ) REP(128,  ph_swa_fast(C, l); ) REP(65536,  ph_rwkv_post(C, l); ) PH_END
        PH_BEGIN REP(512,  { pg8::Gemm g{WSP(bf16_t, WS_Y), WSP(bf16_t, WS_WBR + l * SZ_WBR1), 4096, 1024}; pg8::BranchOrder S; S.init(C.G, (int)blockIdx.x);
            pg8::EpiBranch E{WSP(bf16_t, WS_GATE), WSP(bf16_t, WS_G)};
            pg8::gemm_phase<pg8::EpiBranch, pg8::BranchOrder>(ring, g, S, E); } ) PH_END
        PH_BEGIN { pg8::Gemm g{WSP(bf16_t, WS_G), WSP(bf16_t, WS_WOUT + l * SZ_DD), D, D}; pg8::StaticOrder S; S.init(T, D, C.G, (int)blockIdx.x);
            if (l == 0) { pg8::EpiResid<false, true> E{INF32(I_X), WSP(bf16_t, WS_XB)}; pg8::gemm_phase<pg8::EpiResid<false, true>, pg8::StaticOrder>(ring, g, S, E); }
            else { pg8::EpiResid<true, true> E{WSP(bf16_t, WS_XB), WSP(bf16_t, WS_XB)}; pg8::gemm_phase<pg8::EpiResid<true, true>, pg8::StaticOrder>(ring, g, S, E); } } PH_END
        PH_BEGIN if (l == 0) ph_norm<0>(C, WSP(bf16_t, WS_XB), nullptr, INF32(I_FFNN) + l * D, nullptr); else ph_norm<1>(C, WSP(bf16_t, WS_XB), nullptr, INF32(I_FFNN) + l * D, INF32(I_MR)); PH_END
        if (l == 0) {
            PH_BEGIN REP(2,  { pg8::Gemm g{WSP(bf16_t, WS_H), WSP(bf16_t, WS_WGU), D, D}; pg8::StaticOrder S; S.init(T, 2 * FF, C.G, (int)blockIdx.x); pg8::EpiUp E{WSP(bf16_t, WS_ACT)};
                pg8::gemm_phase<pg8::EpiUp, pg8::StaticOrder>(ring, g, S, E); } ) PH_END
            PH_BEGIN REP(2048,  { pg8::Gemm g{WSP(bf16_t, WS_ACT), WSP(bf16_t, WS_WD), FF, FF}; pg8::StaticOrder S; S.init(T, D, C.G, (int)blockIdx.x); pg8::EpiResid<true, true> E{WSP(bf16_t, WS_XB), WSP(bf16_t, WS_XB)};
                pg8::gemm_phase<pg8::EpiResid<true, true>, pg8::StaticOrder>(ring, g, S, E); } ) PH_END
            PH_BEGIN REP(32768,  ph_norm<0>(C, WSP(bf16_t, WS_XB), nullptr, INF32(I_PLEN) + l * D, nullptr); ) PH_END
        } else {
            PH_BEGIN REP(131072,  ph_moe_gather(C); ) PH_END
            PH_BEGIN REP(8192,  { moe_tile_table(C); pg8::MoeOrder S; S.tab = (const LAS int*)(C.lds + MOETAB_OFF); S.NT = __builtin_amdgcn_readfirstlane(S.tab[MOE_MAXRT]); S.nct = NCT_UP; S.G = C.G; S.c = (int)blockIdx.x;
                pg8::Gemm g{WSP(bf16_t, WS_HS), WSP(bf16_t, WS_MWGU), D, D}; pg8::EpiUp E{WSP(bf16_t, WS_ACTS)};
                pg8::gemm_phase<pg8::EpiUp, pg8::MoeOrder>(ring, g, S, E); } ) PH_END
            PH_BEGIN REP(2048,  { moe_tile_table(C); const LAS int* mtab = (const LAS int*)(C.lds + MOETAB_OFF);
                pg8::MoeDownOrder S; S.init(mtab, __builtin_amdgcn_readfirstlane(mtab[MOE_MAXRT]), C.G, (int)blockIdx.x);
                pg8::Gemm g{WSP(bf16_t, WS_ACTS), WSP(bf16_t, WS_MWD), FF, FF}; pg8::EpiMoeDown E{WSP(bf16_t, WS_OS), WSP(float, WS_WSLOT), WSP(float, WS_OSP), S.S};
                pg8::gemm_phase<pg8::EpiMoeDown, pg8::MoeDownOrder>(ring, g, S, E); } ) PH_END
            PH_BEGIN REP(16,  { int toff[NE + 1]; moe_offsets(C, toff); pg8::MoeDownOrder S; S.init(nullptr, toff[NE], C.G, 0); ph_norm<2>(C, WSP(bf16_t, WS_XB), WSP(bf16_t, WS_XB), INF32(I_PLEN) + l * D, nullptr, S.S); } ) PH_END
        }
        PH_BEGIN REP(262144,  { pg8::Gemm g{WSP(bf16_t, WS_H), WSP(bf16_t, WS_WPG + l * SZ_DD), D, D}; pg8::StaticOrder S; S.init(T, D, C.G, (int)blockIdx.x);
            if (l == NL - 1) { pg8::EpiPle<false> E{WSP(bf16_t, WS_XB), C.out, WSP(bf16_t, WS_PROJ) + (size_t)l * T * D}; pg8::gemm_phase<pg8::EpiPle<false>, pg8::StaticOrder>(ring, g, S, E); }
            else { pg8::EpiPle<true> E{WSP(bf16_t, WS_XB), WSP(bf16_t, WS_XB), WSP(bf16_t, WS_PROJ) + (size_t)l * T * D}; pg8::gemm_phase<pg8::EpiPle<true>, pg8::StaticOrder>(ring, g, S, E); } } ) PH_END
    }
    { constexpr int l = 1;
        if (l > 0) { PH_BEGIN REP(32768,  ph_norm<0>(C, WSP(bf16_t, WS_XB), nullptr, INF32(I_MIXN) + l * D, nullptr); ) PH_END }
        PH_BEGIN REP(4096,  { pg8::Gemm g{WSP(bf16_t, WS_H), WSP(bf16_t, WS_WIN + l * SZ_WIN1), D, D}; pg8::StaticOrder S; S.init(T, N_INP, C.G, (int)blockIdx.x);
            pg8::EpiWin E{WSP(bf16_t, WS_SBQKV), WSP(bf16_t, WS_UF), WSP(bf16_t, WS_GATE)};
            pg8::gemm_phase<pg8::EpiWin, pg8::StaticOrder>(ring, g, S, E); } ) PH_END
        PH_BEGIN REP(16384,  ph_prep(C, l); ph_vt(C); ph_latent(C, l); ) PH_END
        PH_BEGIN REP(256,  { pg8::Gemm g{WSP(bf16_t, WS_ALORA), WSP(bf16_t, WS_WLORA + l * SZ_WLORA1), 256, 256}; pg8::StaticOrder S; S.init(T, 3072, C.G, (int)blockIdx.x);
            pg8::EpiLora E{WSP(float, WS_DEC), WSP(bf16_t, WS_AA), WSP(bf16_t, WS_GG), INF32(I_RWW0) + l * 1024, INF32(I_RWA0) + l * 1024};
            pg8::gemm_phase<pg8::EpiLora, pg8::StaticOrder>(ring, g, S, E); } ) PH_END
        PH_BEGIN REP(32,  if (!(DBG_SKIP_MASK & 2)) { if (USE_FAST & 256) { ph_rwkv_scan5<1>(C, l); if (PROBE_MASK & 2097152) ph_rwkv_scan5<0>(C, l); if ((PROBE_MASK & 4194304) && l == 0) ph_rwkv_scan5<PROBE_CONV>(C, l); } else if (USE_FAST & 128) ph_rwkv_scan4(C, l); else if (USE_FAST & 64) ph_rwkv_scan3(C, l); else if (USE_FAST & 32) ph_rwkv_scan_conv(C, l); else if (USE_FAST & 2) ph_rwkv_scan_fast(C); else ph_rwkv_scan_naive(C); } ) PH_END
        PH_BEGIN REP(8,  ph_sb_fast(C); ) REP(64,  ph_dsa_fast(C, l); ) REP(128,  ph_swa_fast(C, l); ) REP(65536,  ph_rwkv_post(C, l); ) PH_END
        PH_BEGIN REP(512,  { pg8::Gemm g{WSP(bf16_t, WS_Y), WSP(bf16_t, WS_WBR + l * SZ_WBR1), 4096, 1024}; pg8::BranchOrder S; S.init(C.G, (int)blockIdx.x);
            pg8::EpiBranch E{WSP(bf16_t, WS_GATE), WSP(bf16_t, WS_G)};
            pg8::gemm_phase<pg8::EpiBranch, pg8::BranchOrder>(ring, g, S, E); } ) PH_END
        PH_BEGIN { pg8::Gemm g{WSP(bf16_t, WS_G), WSP(bf16_t, WS_WOUT + l * SZ_DD), D, D}; pg8::StaticOrder S; S.init(T, D, C.G, (int)blockIdx.x);
            if (l == 0) { pg8::EpiResid<false, true> E{INF32(I_X), WSP(bf16_t, WS_XB)}; pg8::gemm_phase<pg8::EpiResid<false, true>, pg8::StaticOrder>(ring, g, S, E); }
            else { pg8::EpiResid<true, true> E{WSP(bf16_t, WS_XB), WSP(bf16_t, WS_XB)}; pg8::gemm_phase<pg8::EpiResid<true, true>, pg8::StaticOrder>(ring, g, S, E); } } PH_END
        PH_BEGIN if (l == 0) ph_norm<0>(C, WSP(bf16_t, WS_XB), nullptr, INF32(I_FFNN) + l * D, nullptr); else ph_norm<1>(C, WSP(bf16_t, WS_XB), nullptr, INF32(I_FFNN) + l * D, INF32(I_MR)); PH_END
        if (l == 0) {
            PH_BEGIN REP(2,  { pg8::Gemm g{WSP(bf16_t, WS_H), WSP(bf16_t, WS_WGU), D, D}; pg8::StaticOrder S; S.init(T, 2 * FF, C.G, (int)blockIdx.x); pg8::EpiUp E{WSP(bf16_t, WS_ACT)};
                pg8::gemm_phase<pg8::EpiUp, pg8::StaticOrder>(ring, g, S, E); } ) PH_END
            PH_BEGIN REP(2048,  { pg8::Gemm g{WSP(bf16_t, WS_ACT), WSP(bf16_t, WS_WD), FF, FF}; pg8::StaticOrder S; S.init(T, D, C.G, (int)blockIdx.x); pg8::EpiResid<true, true> E{WSP(bf16_t, WS_XB), WSP(bf16_t, WS_XB)};
                pg8::gemm_phase<pg8::EpiResid<true, true>, pg8::StaticOrder>(ring, g, S, E); } ) PH_END
            PH_BEGIN REP(32768,  ph_norm<0>(C, WSP(bf16_t, WS_XB), nullptr, INF32(I_PLEN) + l * D, nullptr); ) PH_END
        } else {
            PH_BEGIN REP(131072,  ph_moe_gather(C); ) PH_END
            PH_BEGIN REP(8192,  { moe_tile_table(C); pg8::MoeOrder S; S.tab = (const LAS int*)(C.lds + MOETAB_OFF); S.NT = __builtin_amdgcn_readfirstlane(S.tab[MOE_MAXRT]); S.nct = NCT_UP; S.G = C.G; S.c = (int)blockIdx.x;
                pg8::Gemm g{WSP(bf16_t, WS_HS), WSP(bf16_t, WS_MWGU), D, D}; pg8::EpiUp E{WSP(bf16_t, WS_ACTS)};
                pg8::gemm_phase<pg8::EpiUp, pg8::MoeOrder>(ring, g, S, E); } ) PH_END
            PH_BEGIN REP(2048,  { moe_tile_table(C); const LAS int* mtab = (const LAS int*)(C.lds + MOETAB_OFF);
                pg8::MoeDownOrder S; S.init(mtab, __builtin_amdgcn_readfirstlane(mtab[MOE_MAXRT]), C.G, (int)blockIdx.x);
                pg8::Gemm g{WSP(bf16_t, WS_ACTS), WSP(bf16_t, WS_MWD), FF, FF}; pg8::EpiMoeDown E{WSP(bf16_t, WS_OS), WSP(float, WS_WSLOT), WSP(float, WS_OSP), S.S};
                pg8::gemm_phase<pg8::EpiMoeDown, pg8::MoeDownOrder>(ring, g, S, E); } ) PH_END
            PH_BEGIN REP(16,  { int toff[NE + 1]; moe_offsets(C, toff); pg8::MoeDownOrder S; S.init(nullptr, toff[NE], C.G, 0); ph_norm<2>(C, WSP(bf16_t, WS_XB), WSP(bf16_t, WS_XB), INF32(I_PLEN) + l * D, nullptr, S.S); } ) PH_END
        }
        PH_BEGIN REP(262144,  { pg8::Gemm g{WSP(bf16_t, WS_H), WSP(bf16_t, WS_WPG + l * SZ_DD), D, D}; pg8::StaticOrder S; S.init(T, D, C.G, (int)blockIdx.x);
            if (l == NL - 1) { pg8::EpiPle<false> E{WSP(bf16_t, WS_XB), C.out, WSP(bf16_t, WS_PROJ) + (size_t)l * T * D}; pg8::gemm_phase<pg8::EpiPle<false>, pg8::StaticOrder>(ring, g, S, E); }
            else { pg8::EpiPle<true> E{WSP(bf16_t, WS_XB), WSP(bf16_t, WS_XB), WSP(bf16_t, WS_PROJ) + (size_t)l * T * D}; pg8::gemm_phase<pg8::EpiPle<true>, pg8::StaticOrder>(ring, g, S, E); } } ) PH_END
    }
#undef PH_BEGIN
#undef PH_END
}

#ifndef MK_ONE_LAUNCH
#define MK_ONE_LAUNCH 0
#endif
extern "C" void kernel_launch(void* const* d_in, const int* in_sizes, int n_in, void* d_out, int out_size, void* d_ws, size_t ws_size, hipStream_t stream) {
    static int grid = 0;
    if (grid == 0) {
        if (n_in != N_INPUTS || out_size != T * D || ws_size < WS_END3) { fprintf(stderr, "kernel_launch: unexpected problem (n_in %d, out %d, ws %zu < %zu)\n", n_in, out_size, ws_size, (size_t)WS_END3); grid = -1; return; }
        int dev = 0, cus = 0, per_cu = 0;
        if (hipGetDevice(&dev) != hipSuccess || hipDeviceGetAttribute(&cus, hipDeviceAttributeMultiprocessorCount, dev) != hipSuccess) { grid = -1; return; }
        if (hipFuncSetAttribute((const void*)fwd_kernel, hipFuncAttributeMaxDynamicSharedMemorySize, LDS_BYTES) != hipSuccess) { fprintf(stderr, "kernel_launch: hipFuncSetAttribute failed\n"); grid = -1; return; }
        if (hipOccupancyMaxActiveBlocksPerMultiprocessor(&per_cu, (const void*)fwd_kernel, NTHR, LDS_BYTES) != hipSuccess || per_cu < 1) fprintf(stderr, "kernel_launch: occupancy query reports %d\n", per_cu);
        (void)hipGetLastError();
        grid = cus;
    }
    if (grid < 0) return;
    (void)hipMemsetAsync((char*)d_ws + WS_CTL, 0, CTL_BYTES, stream);
    Args a{};
    for (int i = 0; i < N_INPUTS; ++i) a.in[i] = d_in[i];
    a.out = (float*)d_out; a.ws = (unsigned char*)d_ws;
#if MK_ONE_LAUNCH
    a.ph_lo = 0; a.ph_hi = N_PHASES;
    hipLaunchKernelGGL(fwd_kernel, dim3(grid), dim3(NTHR), LDS_BYTES, stream, a);
#else
    for (int p = 0; p < N_PHASES; ++p) { a.ph_lo = p; a.ph_hi = p + 1; hipLaunchKernelGGL(fwd_kernel, dim3(grid), dim3(NTHR), LDS_BYTES, stream, a); }
#endif
}
```

```cpp
#define MK_ONE_LAUNCH 1
#include <hip/hip_runtime.h>
#include <cstdio>
#include <cstdint>

#define LAS __attribute__((address_space(3)))
#define GAS __attribute__((address_space(1)))
#define GLB __attribute__((address_space(1)))
typedef unsigned short bf16_t;
typedef short bf16x8 __attribute__((ext_vector_type(8)));
typedef float f32x4 __attribute__((ext_vector_type(4)));
typedef float f32x2 __attribute__((ext_vector_type(2)));
typedef unsigned u32x4 __attribute__((ext_vector_type(4)));
typedef unsigned u32x2 __attribute__((ext_vector_type(2)));

constexpr int NB = 4, SEQ = 2048, T = NB * SEQ, D = 2048, NL = 2;
constexpr int N_IN = 18256, N_INP = 18432, FF = 7168, NE = 8;
constexpr int UFW = 7168;
constexpr int UF_RW = 0, UF_DQ = 3328, UF_CKV = 4352, UF_IQ = 4608, UF_SQ = 5632, UF_SK = 6656, UF_SV = 6784, UF_IK = 6912, UF_IW = 6976;
constexpr int MOE_ROWS = 18432, MOE_MAXRT = 72, NCT_UP = 56, NCT_DN = 8;
constexpr int NWAVES = 8, NTHR = 512;

constexpr size_t WS_CTL = 0, CTL_BYTES = 1u << 20;
constexpr size_t SZ_WIN1 = (size_t)N_INP * D * 2, SZ_WBR1 = (size_t)4 * 2048 * 1024 * 2, SZ_DD = (size_t)D * D * 2;
constexpr size_t SZ_WGU1 = (size_t)2 * FF * D * 2, SZ_WD1 = (size_t)D * FF * 2, SZ_WLORA1 = (size_t)3072 * 256 * 2;
constexpr size_t WS_WIN = CTL_BYTES;
constexpr size_t WS_WBR = WS_WIN + NL * SZ_WIN1;
constexpr size_t WS_WOUT = WS_WBR + NL * SZ_WBR1;
constexpr size_t WS_WGU = WS_WOUT + NL * SZ_DD;
constexpr size_t WS_WD = WS_WGU + SZ_WGU1;
constexpr size_t WS_MWGU = WS_WD + SZ_WD1;
constexpr size_t WS_MWD = WS_MWGU + NE * SZ_WGU1;
constexpr size_t WS_WPG = WS_MWD + NE * SZ_WD1;
constexpr size_t WS_WPP = WS_WPG + NL * SZ_DD;
constexpr size_t WS_WLORA = WS_WPP + (size_t)NL * D * 256 * 2;
constexpr size_t WS_H = WS_WLORA + NL * SZ_WLORA1;
constexpr size_t WS_PCAT = WS_H + (size_t)T * D * 2;
constexpr size_t WS_PROJ = WS_PCAT + (size_t)T * 512 * 2;
constexpr size_t WS_ROUTE = WS_PROJ + (size_t)NL * T * D * 2;
constexpr size_t WS_TOKSLOT = WS_ROUTE + (size_t)T * 32;
constexpr size_t WS_WSLOT = WS_TOKSLOT + (size_t)T * 8;
constexpr size_t WS_ACT0 = WS_WSLOT + (size_t)MOE_ROWS * 4 + 256 * 30;
constexpr size_t SZ_T1K = (size_t)T * 1024 * 4;
constexpr size_t WS_SBQKV = (WS_ACT0 + 255) & ~(size_t)255;
constexpr size_t WS_GATE = WS_SBQKV + (size_t)T * 3072 * 2;
constexpr size_t WS_UF = WS_GATE + (size_t)T * 8192 * 2;
constexpr size_t WS_Y = WS_UF;
constexpr size_t WS_GSUM = WS_Y + (size_t)T * 4096 * 2;
constexpr size_t WS_G = WS_GSUM + (size_t)T * 2048 * 4;
constexpr size_t WS_YRAW = WS_G + (size_t)T * 2048 * 2;
constexpr size_t WS_RW = WS_UF + (size_t)T * UFW * 4;
static_assert(WS_YRAW + SZ_T1K <= WS_RW, "UF aliases");
constexpr size_t WS_R = WS_RW, WS_K = WS_RW + SZ_T1K, WS_V = WS_RW + 2 * SZ_T1K, WS_DEC = WS_RW + 3 * SZ_T1K, WS_AA = WS_RW + 4 * SZ_T1K, WS_KK = WS_RW + 5 * SZ_T1K, WS_GG = WS_RW + 6 * SZ_T1K;
constexpr size_t WS_ALORA = WS_RW + 7 * SZ_T1K;
constexpr size_t WS_QD = WS_ALORA + (size_t)T * 256 * 2;
constexpr size_t WS_KD = WS_QD + (size_t)T * 1024 * 2;
constexpr size_t WS_VD = WS_KD + (size_t)T * 128 * 2;
constexpr size_t WS_QI = WS_VD + (size_t)T * 128 * 2;
constexpr size_t WS_KI = WS_QI + (size_t)T * 1024 * 2;
constexpr size_t WS_WI = WS_KI + (size_t)T * 64 * 2;
constexpr size_t WS_QS = WS_WI + (size_t)T * 16 * 4;
constexpr size_t WS_KS = WS_QS + (size_t)T * 1024 * 2;
constexpr size_t WS_VS = WS_KS + (size_t)T * 128 * 2;
constexpr size_t WS_MIX_END = WS_VS + (size_t)T * 128 * 2;
constexpr size_t WS_ACT = WS_SBQKV;
constexpr size_t WS_HS = WS_SBQKV;
constexpr size_t WS_ACTS = WS_HS + (size_t)MOE_ROWS * D * 2;
constexpr size_t WS_OS = WS_ACTS + (size_t)MOE_ROWS * FF * 2;
constexpr size_t WS_OSP = WS_OS + (size_t)MOE_ROWS * D * 4;
constexpr size_t WS_FFN_END = WS_OSP + (size_t)256 * 65536 * 4;
constexpr size_t WS_END = WS_MIX_END > WS_FFN_END ? WS_MIX_END : WS_FFN_END;
static_assert(WS_END < (size_t)2000 * 1000 * 1000, "workspace budget");

constexpr int CW_BAR = 4096;
constexpr int CW_MOECNT = 8192;

constexpr int RING_BYTES = 131072;
constexpr int MISC_OFF = 143360;
constexpr int LDS_BYTES = 147456;

#define LDS_WAIT() asm volatile("s_waitcnt lgkmcnt(0)" ::: "memory")
#define VM_WAIT() asm volatile("s_waitcnt vmcnt(0)" ::: "memory")
__device__ __forceinline__ float bflo(unsigned u) { return __builtin_bit_cast(float, u << 16); }
__device__ __forceinline__ float bfhi(unsigned u) { return __builtin_bit_cast(float, u & 0xffff0000u); }
__device__ __forceinline__ float bf1(bf16_t u) { return __builtin_bit_cast(float, (unsigned)u << 16); }
__device__ __forceinline__ unsigned f2bf(float f) { unsigned u = __builtin_bit_cast(unsigned, f); return (u + 0x7fffu + ((u >> 16) & 1u)) >> 16; }
typedef __bf16 bf16x2v __attribute__((ext_vector_type(2)));
__device__ __forceinline__ unsigned pk2(float lo, float hi) { const f32x2 v = {lo, hi}; return __builtin_bit_cast(unsigned, __builtin_convertvector(v, bf16x2v)); }
__device__ __forceinline__ float wave_sum(float v) {
#pragma unroll
    for (int o = 1; o < 64; o <<= 1) v += __shfl_xor(v, o);
    return v;
}
__device__ __forceinline__ float wave_max(float v) {
#pragma unroll
    for (int o = 1; o < 64; o <<= 1) v = fmaxf(v, __shfl_xor(v, o));
    return v;
}
__device__ __forceinline__ float sigmoidf_(float x) { return __builtin_amdgcn_rcpf(1.0f + __builtin_amdgcn_exp2f(-1.4426950408889634f * x)); }
__device__ __forceinline__ float logsigf_(float x) { return fminf(x, 0.f) - __logf(1.0f + __expf(-fabsf(x))); }
__device__ __forceinline__ float rdlane(float v, int l) { return __builtin_bit_cast(float, __builtin_amdgcn_readlane(__builtin_bit_cast(int, v), l)); }

#define XB_TMO      128
#define XB_XCNT(j)  (256  + 64 * (j))
#define XB_XSUB(j)  (1280 + 64 * (j))
#define XB_XGEN(j)  (2304 + 64 * (j))
#define XB_TOP      3328
#define XB_TOPGEN   3392
#define XCD_BAR_WORDS 3456
#define XB_SPIN_CAP (1u << 18)
__device__ __forceinline__ unsigned xb_ld(unsigned* p)              { return __hip_atomic_load(p, __ATOMIC_RELAXED, __HIP_MEMORY_SCOPE_AGENT); }
__device__ __forceinline__ unsigned xb_add(unsigned* p, unsigned v) { return __hip_atomic_fetch_add(p, v, __ATOMIC_RELAXED, __HIP_MEMORY_SCOPE_AGENT); }
__device__ __forceinline__ unsigned xb_xcc_id() { return (unsigned)__builtin_amdgcn_s_getreg((3 << 11) | 20) & 0xFu; }
#define XB_SPIN(cond, bar) do { unsigned _sp = 0; while (cond) { __builtin_amdgcn_s_sleep(1); \
    if ((++_sp & 255u) == 0u) { if (xb_ld(&(bar)[XB_TMO])) break; if (_sp > XB_SPIN_CAP) { atomicAdd(&(bar)[XB_TMO], 1u); break; } } } } while (0)
struct XcdBarrier { unsigned* bar; unsigned x; volatile LAS unsigned* st; };
__device__ __forceinline__ XcdBarrier xcd_barrier_post(unsigned* bar, volatile LAS unsigned* st) {
    XcdBarrier b; b.bar = bar; b.x = xb_xcc_id(); b.st = st;
    if (threadIdx.x == 0) (void)xb_add(&bar[XB_XCNT(b.x)], 1u);
    return b;
}
__device__ __forceinline__ void xcd_barrier_complete(unsigned* bar, unsigned x, unsigned& nloc, unsigned& nx) {
    const unsigned G = gridDim.x * gridDim.y * gridDim.z;
    unsigned sum, cnt, mine, sp = 0u;
    for (;;) {
        sum = 0u; cnt = 0u; mine = 0u;
#pragma unroll
        for (unsigned j = 0; j < 16; ++j) { const unsigned c = xb_ld(&bar[XB_XCNT(j)]); sum += c; cnt += (c > 0u) ? 1u : 0u; mine = (j == x) ? c : mine; }
        if (sum == G) break;
        __builtin_amdgcn_s_sleep(1);
        if ((++sp & 255u) == 0u) { if (xb_ld(&bar[XB_TMO])) break; if (sp > XB_SPIN_CAP) { atomicAdd(&bar[XB_TMO], 1u); break; } }
    }
    nloc = mine > 0u ? mine : 1u; nx = cnt > 0u ? cnt : 1u;
}
__device__ __forceinline__ void xcd_barrier(const XcdBarrier& b) {
    asm volatile("s_waitcnt vmcnt(0)" ::: "memory");
    __syncthreads();
    if (threadIdx.x == 0) {
        unsigned* bar = b.bar;
        __builtin_amdgcn_s_waitcnt(0);
        unsigned nloc = b.st[0], nx = b.st[1];
        if (nloc == 0u) { xcd_barrier_complete(bar, b.x, nloc, nx); b.st[0] = nloc; b.st[1] = nx; }
        const unsigned old = xb_add(&bar[XB_XSUB(b.x)], 1u);
        const unsigned gen = old / nloc;
        if (old + 1u == (gen + 1u) * nloc) {
            __builtin_amdgcn_fence(__ATOMIC_RELEASE, "agent");
            asm volatile("s_waitcnt vmcnt(0)" ::: "memory");
            const unsigned og = xb_add(&bar[XB_TOP], 1u);
            const unsigned tg = og / nx;
            if (og + 1u == (tg + 1u) * nx) xb_add(&bar[XB_TOPGEN], 1u);
            else XB_SPIN(xb_ld(&bar[XB_TOPGEN]) == tg, bar);
            __builtin_amdgcn_fence(__ATOMIC_ACQUIRE, "agent");
            xb_add(&bar[XB_XGEN(b.x)], 1u);
            asm volatile("s_waitcnt vmcnt(0)" ::: "memory");
        } else {
            XB_SPIN(xb_ld(&bar[XB_XGEN(b.x)]) == gen, bar);
            __builtin_amdgcn_fence(__ATOMIC_ACQUIRE, "agent");
            asm volatile("s_waitcnt vmcnt(0)" ::: "memory");
        }
    }
    __syncthreads();
}
namespace pg8 {
#define PG8_LAS __attribute__((address_space(3)))
#ifndef PG8_WGM
#define PG8_WGM 4
#endif
constexpr int BM = 256, BK = 64, HALF = 128, HTB = HALF * BK * 2, STAGE_BYTES = 8 * HTB, NXCD = 8, WGM = PG8_WGM;
__host__ __device__ __forceinline__ int lds_byte(int r, int c) { const int st = (r >> 4) * 2 + (c >> 5), rr = r & 15, cc = c & 31, ob = rr * 64 + cc * 2; return st * 1024 + (ob ^ (((ob >> 9) & 1) << 5)); }
__host__ __device__ __forceinline__ void stage_rc(int b, int& R, int& C) { const int st = b / 1024, sb = b % 1024, swz = sb ^ (((sb >> 9) & 1) << 5); R = (st >> 1) * 16 + swz / 64; C = (st & 1) * 32 + (swz % 64) / 2; }
__host__ __device__ __forceinline__ int perm32(int rho) { const int n = rho >> 4, i = rho & 15; return 8 * (i >> 2) + 4 * n + (i & 3); }

struct Unit { int pm, pn, ka, kb, nt, aux; };
struct Gemm { const GLB bf16_t* A; const GLB bf16_t* Bt; int lda, K; };

struct StaticOrder {
    int nM, nN, nwg, G, c;
    __device__ __forceinline__ void init(int M, int N, int G_, int c_) { nM = M / BM; nN = N / BM; nwg = nM * nN; G = G_; c = c_; }
    __device__ __forceinline__ bool tile(long L, Unit& u) const {
        if (L >= nwg) return false;
        int wgid = (int)L; { const int q = nwg / NXCD, r = nwg % NXCD, xcd = wgid % NXCD, off = wgid / NXCD; wgid = (xcd < r ? xcd * (q + 1) : r * (q + 1) + (xcd - r) * q) + off; }
        const int nig = WGM * nN, gid = wgid / nig, fm = gid * WGM, gsz = (nM - fm) < WGM ? (nM - fm) : WGM;
        u.pm = fm + ((wgid % nig) % gsz); u.pn = (wgid % nig) / gsz; u.ka = 0; u.kb = 0; u.nt = 0; u.aux = 0; return true;
    }
    __device__ __forceinline__ bool next(int i, Unit& u) const { return tile((long)i * G + c, u); }
};
struct BranchOrder {
    int G, c, cnt;
    __device__ __forceinline__ void init(int G_, int c_) { G = G_; c = c_; cnt = (c_ < 256) ? (255 - c_) / G_ + 1 : 0; }
    __device__ __forceinline__ bool next(int i, Unit& u) const {
        if (cnt == 0) return false;
        const int n = i / cnt, r = i - n * cnt; if (n >= 4) return false;
        StaticOrder so; so.init(T, 2048, G, c); so.tile((long)r * G + c, u);
        u.pn += n * 8; u.ka = n * 1024; return true;
    }
};
struct ProjOrder {
    StaticOrder so;
    __device__ __forceinline__ void init(int G_, int c_) { so.init(T, 4096, G_, c_); }
    __device__ __forceinline__ bool next(int i, Unit& u) const { if (!so.next(i, u)) return false; u.ka = (u.pn >> 3) * 256; return true; }
};
struct MoeOrder {
    const PG8_LAS int* tab; int NT, nct, G, c;
    __device__ __forceinline__ bool next(int i, Unit& u) const {
        StaticOrder so; so.nM = NT; so.nN = nct; so.nwg = NT * nct; so.G = G; so.c = c;
        if (!so.tile((long)i * G + c, u)) return false;
        const int e = __builtin_amdgcn_readfirstlane(tab[u.pm]);
        u.pn += e * nct; u.ka = 0; return true;
    }
};

struct MoeDownOrder {
    const PG8_LAS int* tab; int NT, G, c, S;
    __device__ __forceinline__ void init(const PG8_LAS int* tab_, int NT_, int G_, int c_) { tab = tab_; NT = NT_; G = G_; c = c_;
        const int tu = (NT_ - 64) * 8; S = (tu <= 0) ? 1 : ((tu * 8 <= G_) ? 8 : ((tu * 4 <= G_) ? 4 : ((tu * 2 <= G_) ? 2 : 1))); }
    __device__ __forceinline__ bool next(int i, Unit& u) const {
        const int F = (NT < 64) ? NT : 64, nfull = F * 8, rf = (nfull + G - 1) / G;
        if (i < rf) {
            StaticOrder so; so.nM = F; so.nN = 8; so.nwg = nfull; so.G = G; so.c = c;
            if (so.tile((long)i * G + c, u)) { const int e = __builtin_amdgcn_readfirstlane(tab[u.pm]); u.pn += e * 8; return true; }
            i = rf;
        }
        const int q = (i - rf) * G + c, ntail = (NT - F) * 8 * S;
        if (q >= ntail) return false;
        const int tu = q / S, sl = q - tu * S, rt = F + (tu >> 3), pl = tu & 7;
        const int e = __builtin_amdgcn_readfirstlane(tab[rt]);
        u.pm = rt; u.pn = e * 8 + pl; u.ka = sl * (FF / S); u.kb = u.ka; u.nt = (FF / 64) / S; u.aux = 1 + sl; return true;
    }
};

template <class Epi, class Sched>
__device__ __forceinline__ void gemm_phase(PG8_LAS unsigned char* lds, const Gemm g, const Sched& S, const Epi& E) {
    int tid = threadIdx.x; asm volatile("" : "+v"(tid));
    const int wid = __builtin_amdgcn_readfirstlane(tid >> 6), lane = tid & 63, wr = wid >> 2, wc = wid & 3, fr = lane & 15, fq = lane >> 4;
    int K = g.K, lda = g.lda; asm volatile("" : "+s"(K), "+s"(lda));
    const int nt = K / BK;
    unsigned voffA[2], voffB[2];
#pragma unroll
    for (int i = 0; i < 2; ++i) { int R, C; stage_rc(tid * 16 + i * 8192, R, C); const int Rb = Epi::PERM ? ((R & ~31) + perm32(R & 31)) : R;
        voffA[i] = (unsigned)(R * lda + C) * 2u; voffB[i] = (unsigned)(Rb * K + C) * 2u; }
    const size_t kstep = (size_t)(BK * 2);
    const size_t hstepA = (size_t)HALF * lda * 2, hstepB = (size_t)HALF * K * 2;
    const size_t tstepA = 2 * hstepA, tstepB = 2 * hstepB;
    const unsigned ldsw = (unsigned)wid * 1024u;
    const int aoff = lds_byte(wr * 64 + fr, fq * 8), boff = lds_byte(wc * 32 + fr, fq * 8);
#define PG8_SA(b, h) (((b) * 2 + (h)) * HTB)
#define PG8_SB(b, h) ((4 + (b) * 2 + (h)) * HTB)
#define PG8_STAGE(bufoff, gbase, voff) do { _Pragma("unroll") for (int _i = 0; _i < 2; ++_i) \
        __builtin_amdgcn_global_load_lds((const GLB unsigned*)((const char*)(gbase) + (voff)[_i]), (PG8_LAS unsigned*)(lds + (bufoff) + ldsw + _i * 8192), 16, 0, 0); } while (0)
#define PG8_LDA(dst, b, h) do { _Pragma("unroll") for (int m = 0; m < 4; ++m) _Pragma("unroll") for (int k = 0; k < 2; ++k) dst[m][k] = *(const PG8_LAS bf16x8*)(lds + PG8_SA(b, h) + aoff + m * 2048 + k * 1024); } while (0)
#define PG8_LDB(dst, b, h) do { _Pragma("unroll") for (int n = 0; n < 2; ++n) _Pragma("unroll") for (int k = 0; k < 2; ++k) dst[n][k] = *(const PG8_LAS bf16x8*)(lds + PG8_SB(b, h) + boff + n * 2048 + k * 1024); } while (0)
#define PG8_MMA(ai, bj, At, Bt) do { __builtin_amdgcn_s_setprio(1); _Pragma("unroll") for (int m = 0; m < 4; ++m) _Pragma("unroll") for (int n = 0; n < 2; ++n) _Pragma("unroll") for (int k = 0; k < 2; ++k) \
        acc[ai][bj][m][n] = __builtin_amdgcn_mfma_f32_16x16x32_bf16(Bt[n][k], At[m][k], acc[ai][bj][m][n], 0, 0, 0); __builtin_amdgcn_s_setprio(0); } while (0)
#define PG8_WAIT_V(n) asm volatile("s_waitcnt vmcnt(" #n ")" ::: "memory")
#define PG8_WAIT_L(n) asm volatile("s_waitcnt lgkmcnt(" #n ")" ::: "memory")
#define PG8_BAR __builtin_amdgcn_s_barrier()
#define PG8_SCHED __builtin_amdgcn_sched_barrier(0)
    Unit cur, nxt; int ui = 0;
    if (!S.next(0, cur)) return;
    f32x4 acc[2][2][4][2];
#pragma unroll
    for (int a = 0; a < 2; ++a)
#pragma unroll
        for (int b = 0; b < 2; ++b)
#pragma unroll
            for (int m = 0; m < 4; ++m)
#pragma unroll
                for (int n = 0; n < 2; ++n) acc[a][b][m][n] = (f32x4){0.f, 0.f, 0.f, 0.f};
    bf16x8 At[4][2], B0[2][2], B1[2][2];
    const char* cA = (const char*)g.A + (size_t)cur.pm * tstepA + (size_t)cur.ka * 2; const char* cB = (const char*)g.Bt + (size_t)cur.pn * tstepB + (size_t)cur.kb * 2;
    PG8_STAGE(PG8_SB(0, 0), cB, voffB); PG8_STAGE(PG8_SB(0, 1), cB + hstepB, voffB); PG8_STAGE(PG8_SA(0, 0), cA, voffA); PG8_STAGE(PG8_SA(0, 1), cA + hstepA, voffA);
    if (wr == 1) PG8_BAR;
    PG8_WAIT_V(2); PG8_BAR;
    PG8_STAGE(PG8_SB(1, 0), cB + kstep, voffB); PG8_STAGE(PG8_SA(1, 0), cA + kstep, voffA); PG8_STAGE(PG8_SB(1, 1), cB + hstepB + kstep, voffB);
    PG8_WAIT_V(6); PG8_BAR;
    for (;;) {
        const bool has_next = S.next(ui + 1, nxt);
        const char* nA = has_next ? (const char*)g.A + (size_t)nxt.pm * tstepA + (size_t)nxt.ka * 2 : cA; const char* nB = has_next ? (const char*)g.Bt + (size_t)nxt.pn * tstepB + (size_t)nxt.kb * 2 : cB;
        const int ntu = cur.nt ? cur.nt : nt;
        for (int t = 0; t < ntu; t += 2) {
            const bool last = (t == ntu - 2);
            const char* a1 = cA + (size_t)(t + 1) * kstep;
            const char* a2 = last ? nA : cA + (size_t)(t + 2) * kstep; const char* b2 = last ? nB : cB + (size_t)(t + 2) * kstep;
            const char* a3 = a2 + kstep; const char* b3 = b2 + kstep;
            PG8_LDB(B0, 0, 0); PG8_LDB(B1, 0, 1); PG8_SCHED; PG8_LDA(At, 0, 0); PG8_STAGE(PG8_SA(1, 1), a1 + hstepA, voffA);
            PG8_WAIT_V(8); PG8_WAIT_L(0); PG8_BAR; PG8_MMA(0, 0, At, B0); PG8_MMA(0, 1, At, B1); PG8_BAR; PG8_SCHED;
            PG8_LDA(At, 0, 1); PG8_STAGE(PG8_SB(0, 0), b2, voffB); PG8_STAGE(PG8_SB(0, 1), b2 + hstepB, voffB); PG8_STAGE(PG8_SA(0, 0), a2, voffA);
            PG8_WAIT_V(8); PG8_WAIT_L(0); PG8_BAR; PG8_MMA(1, 0, At, B0); PG8_MMA(1, 1, At, B1); PG8_BAR; PG8_SCHED;
            PG8_LDB(B0, 1, 0); PG8_LDB(B1, 1, 1); PG8_SCHED; PG8_LDA(At, 1, 0); PG8_STAGE(PG8_SA(0, 1), a2 + hstepA, voffA);
            PG8_WAIT_V(8); PG8_WAIT_L(0); PG8_BAR; PG8_MMA(0, 0, At, B0); PG8_MMA(0, 1, At, B1); PG8_BAR; PG8_SCHED;
            PG8_LDA(At, 1, 1); PG8_STAGE(PG8_SB(1, 0), b3, voffB); PG8_STAGE(PG8_SB(1, 1), b3 + hstepB, voffB); PG8_STAGE(PG8_SA(1, 0), a3, voffA);
            PG8_WAIT_V(8); PG8_WAIT_L(0); PG8_BAR; PG8_MMA(1, 0, At, B0); PG8_MMA(1, 1, At, B1); PG8_BAR; PG8_SCHED;
        }
        if (wr == 0) PG8_BAR;
        E(acc, cur, wr, wc, fr, fq);
        if (!has_next) break;
#pragma unroll
        for (int a = 0; a < 2; ++a)
#pragma unroll
            for (int b = 0; b < 2; ++b)
#pragma unroll
                for (int m = 0; m < 4; ++m)
#pragma unroll
                    for (int n = 0; n < 2; ++n) acc[a][b][m][n] = (f32x4){0.f, 0.f, 0.f, 0.f};
        cur = nxt; cA = nA; cB = nB; ++ui;
        if (wr == 1) PG8_BAR;
    }
    PG8_WAIT_V(0);
    PG8_BAR;
#undef PG8_SA
#undef PG8_SB
#undef PG8_STAGE
#undef PG8_LDA
#undef PG8_LDB
#undef PG8_MMA
#undef PG8_WAIT_V
#undef PG8_WAIT_L
#undef PG8_BAR
#undef PG8_SCHED
}

#define EPI_ROWS(u) const int row0 = (u).pm * BM + wr * 64 + fr; const int ct0 = wc * 32 + 8 * fq
#define EPI_FOR_ROWS _Pragma("unroll") for (int ai = 0; ai < 2; ++ai) _Pragma("unroll") for (int m = 0; m < 4; ++m)
__device__ __forceinline__ u32x4 pack8(f32x4 v0, f32x4 v1) { u32x4 w; w.x = pk2(v0[0], v0[1]); w.y = pk2(v0[2], v0[3]); w.z = pk2(v1[0], v1[1]); w.w = pk2(v1[2], v1[3]); return w; }
__device__ __forceinline__ void unpack8(u32x4 w, f32x4& v0, f32x4& v1) { v0 = (f32x4){bflo(w.x), bfhi(w.x), bflo(w.y), bfhi(w.y)}; v1 = (f32x4){bflo(w.z), bfhi(w.z), bflo(w.w), bfhi(w.w)}; }
__device__ __forceinline__ f32x4 sig4(f32x4 v) { return (f32x4){sigmoidf_(v[0]), sigmoidf_(v[1]), sigmoidf_(v[2]), sigmoidf_(v[3])}; }

struct EpiWin { static constexpr bool PERM = true;
    GLB bf16_t* sbqkv; GLB bf16_t* uf; GLB bf16_t* gate;
    __device__ __forceinline__ void operator()(const f32x4 (&acc)[2][2][4][2], const Unit& u, int wr, int wc, int fr, int fq) const {
        EPI_ROWS(u); const int pn = u.pn;
        if (pn < 40) {
            GLB bf16_t* base = (pn < 12) ? sbqkv + pn * 256 : uf + (pn - 12) * 256; const int ld = (pn < 12) ? 3072 : UFW;
            EPI_FOR_ROWS { GLB bf16_t* rp = base + (size_t)(row0 + ai * HALF + m * 16) * ld + ct0;
#pragma unroll
                for (int bj = 0; bj < 2; ++bj) *(GLB u32x4*)(rp + bj * HALF) = pack8(acc[ai][bj][m][0], acc[ai][bj][m][1]); }
        } else {
            EPI_FOR_ROWS { GLB bf16_t* rp = gate + (size_t)(row0 + ai * HALF + m * 16) * 8192 + (pn - 40) * 256 + ct0;
#pragma unroll
                for (int bj = 0; bj < 2; ++bj) *(GLB u32x4*)(rp + bj * HALF) = pack8(sig4(acc[ai][bj][m][0]), sig4(acc[ai][bj][m][1])); }
        }
    }
};
struct EpiNull { static constexpr bool PERM = true;
    __device__ __forceinline__ void operator()(const f32x4 (&acc)[2][2][4][2], const Unit& u, int wr, int wc, int fr, int fq) const {
#pragma unroll
        for (int ai = 0; ai < 2; ++ai)
#pragma unroll
            for (int bj = 0; bj < 2; ++bj) asm volatile("" :: "v"(acc[ai][bj][0][0]), "v"(acc[ai][bj][0][1]), "v"(acc[ai][bj][1][0]), "v"(acc[ai][bj][1][1]), "v"(acc[ai][bj][2][0]), "v"(acc[ai][bj][2][1]), "v"(acc[ai][bj][3][0]), "v"(acc[ai][bj][3][1]));
    }
};
struct EpiLora { static constexpr bool PERM = true;
    GLB float* dec; GLB bf16_t* aa; GLB bf16_t* gg; const GLB float* w0; const GLB float* a0;
    __device__ __forceinline__ void operator()(const f32x4 (&acc)[2][2][4][2], const Unit& u, int wr, int wc, int fr, int fq) const {
        EPI_ROWS(u); const int kind = u.pn >> 2, cb = (u.pn & 3) * 256 + ct0;
        EPI_FOR_ROWS { const size_t ro = (size_t)(row0 + ai * HALF + m * 16) * 1024 + cb;
#pragma unroll
            for (int bj = 0; bj < 2; ++bj) { const int co = bj * HALF;
                if (kind == 0) {
#pragma unroll
                    for (int n = 0; n < 2; ++n) { const f32x4 v = acc[ai][bj][m][n]; const f32x4 b = *(const GLB f32x4*)(w0 + cb + co + 4 * n); f32x4 o;
#pragma unroll
                        for (int j = 0; j < 4; ++j) { const float pre = v[j] + b[j]; const float y = -pre; const float sp = fmaxf(y, 0.f) + __logf(1.0f + __expf(-fabsf(y)));
                            o[j] = __expf(-__expf(-sp - 0.5f)); }
                        *(GLB f32x4*)(dec + ro + co + 4 * n) = o; }
                } else if (kind == 1) { const f32x4 b0 = *(const GLB f32x4*)(a0 + cb + co), b1 = *(const GLB f32x4*)(a0 + cb + co + 4);
                    *(GLB u32x4*)(aa + ro + co) = pack8(sig4(acc[ai][bj][m][0] + b0), sig4(acc[ai][bj][m][1] + b1)); }
                else *(GLB u32x4*)(gg + ro + co) = pack8(acc[ai][bj][m][0], acc[ai][bj][m][1]); } }
    }
};
struct EpiBranch { static constexpr bool PERM = true;
    const GLB bf16_t* gate; GLB bf16_t* gout;
    __device__ __forceinline__ void operator()(const f32x4 (&acc)[2][2][4][2], const Unit& u, int wr, int wc, int fr, int fq) const {
        EPI_ROWS(u); const int n = u.pn >> 3, cb = (u.pn & 7) * 256 + ct0;
        EPI_FOR_ROWS { const size_t r = (size_t)(row0 + ai * HALF + m * 16);
#pragma unroll
            for (int bj = 0; bj < 2; ++bj) { const int c = cb + bj * HALF; f32x4 g0, g1; unpack8(*(const GLB u32x4*)(gate + r * 8192 + n * 2048 + c), g0, g1);
                f32x4 s0 = g0 * acc[ai][bj][m][0], s1 = g1 * acc[ai][bj][m][1];
                GLB u32x4* gp = (GLB u32x4*)(gout + r * 2048 + c);
                if (n > 0) { f32x4 p0, p1; unpack8(*gp, p0, p1); s0 += p0; s1 += p1; }
                *gp = pack8(s0, s1); } }
    }
};
template <bool RB, bool OB>
struct EpiResid { static constexpr bool PERM = true;
    const GLB void* resid; GLB void* out;
    __device__ __forceinline__ void operator()(const f32x4 (&acc)[2][2][4][2], const Unit& u, int wr, int wc, int fr, int fq) const {
        EPI_ROWS(u); const int cb = u.pn * 256 + ct0;
        EPI_FOR_ROWS { const size_t ro = (size_t)(row0 + ai * HALF + m * 16) * D + cb;
#pragma unroll
            for (int bj = 0; bj < 2; ++bj) { f32x4 r0, r1;
                if (RB) unpack8(*(const GLB u32x4*)((const GLB bf16_t*)resid + ro + bj * HALF), r0, r1);
                else { r0 = *(const GLB f32x4*)((const GLB float*)resid + ro + bj * HALF); r1 = *(const GLB f32x4*)((const GLB float*)resid + ro + bj * HALF + 4); }
                r0 = r0 + acc[ai][bj][m][0]; r1 = r1 + acc[ai][bj][m][1];
                if (OB) *(GLB u32x4*)((GLB bf16_t*)out + ro + bj * HALF) = pack8(r0, r1);
                else { *(GLB f32x4*)((GLB float*)out + ro + bj * HALF) = r0; *(GLB f32x4*)((GLB float*)out + ro + bj * HALF + 4) = r1; } } }
    }
};
struct EpiUp { static constexpr bool PERM = true;
    GLB bf16_t* act;
    __device__ __forceinline__ void operator()(const f32x4 (&acc)[2][2][4][2], const Unit& u, int wr, int wc, int fr, int fq) const {
        EPI_ROWS(u); const int cb = (u.pn % NCT_UP) * 128 + ct0;
        EPI_FOR_ROWS { f32x4 o[2];
#pragma unroll
            for (int n = 0; n < 2; ++n) { const f32x4 g = acc[ai][0][m][n], up = acc[ai][1][m][n];
#pragma unroll
                for (int j = 0; j < 4; ++j) o[n][j] = g[j] * sigmoidf_(g[j]) * up[j]; }
            *(GLB u32x4*)(act + (size_t)(row0 + ai * HALF + m * 16) * FF + cb) = pack8(o[0], o[1]); }
    }
};
struct EpiMoeDown { static constexpr bool PERM = true;
    GLB bf16_t* os; const GLB float* wslot; GLB float* osp; int S;
    __device__ __forceinline__ void operator()(const f32x4 (&acc)[2][2][4][2], const Unit& u, int wr, int wc, int fr, int fq) const {
        EPI_ROWS(u); const int pl = u.pn % NCT_DN;
        if (u.aux == 0) {
            const int cb = pl * 256 + ct0;
            EPI_FOR_ROWS { const int r = row0 + ai * HALF + m * 16; const float w = wslot[r]; GLB bf16_t* rp = os + (size_t)r * D + cb;
#pragma unroll
                for (int bj = 0; bj < 2; ++bj) *(GLB u32x4*)(rp + bj * HALF) = pack8(acc[ai][bj][m][0] * w, acc[ai][bj][m][1] * w); }
        } else {
            GLB float* tp = osp + ((size_t)(((u.pm - 64) * 8 + pl) * S + (u.aux - 1)) << 16);
            EPI_FOR_ROWS { const int rl = wr * 64 + fr + ai * HALF + m * 16; const float w = wslot[u.pm * BM + rl]; GLB float* rp = tp + rl * 256 + ct0;
#pragma unroll
                for (int bj = 0; bj < 2; ++bj) { *(GLB f32x4*)(rp + bj * HALF) = acc[ai][bj][m][0] * w; *(GLB f32x4*)(rp + bj * HALF + 4) = acc[ai][bj][m][1] * w; } }
        }
    }
};
template <bool OB>
struct EpiPle { static constexpr bool PERM = true;
    const GLB bf16_t* resid; GLB void* out; const GLB bf16_t* proj;
    __device__ __forceinline__ void operator()(const f32x4 (&acc)[2][2][4][2], const Unit& u, int wr, int wc, int fr, int fq) const {
        EPI_ROWS(u); const int cb = u.pn * 256 + ct0;
        EPI_FOR_ROWS { const size_t ro = (size_t)(row0 + ai * HALF + m * 16) * D + cb;
#pragma unroll
            for (int bj = 0; bj < 2; ++bj) { f32x4 p0, p1, r0, r1; unpack8(*(const GLB u32x4*)(proj + ro + bj * HALF), p0, p1); unpack8(*(const GLB u32x4*)(resid + ro + bj * HALF), r0, r1);
                r0 = r0 + sig4(acc[ai][bj][m][0]) * p0; r1 = r1 + sig4(acc[ai][bj][m][1]) * p1;
                if (OB) *(GLB u32x4*)((GLB bf16_t*)out + ro + bj * HALF) = pack8(r0, r1);
                else { *(GLB f32x4*)((GLB float*)out + ro + bj * HALF) = r0; *(GLB f32x4*)((GLB float*)out + ro + bj * HALF + 4) = r1; } } }
    }
};
struct EpiProj { static constexpr bool PERM = true;
    GLB bf16_t* proj;
    __device__ __forceinline__ void operator()(const f32x4 (&acc)[2][2][4][2], const Unit& u, int wr, int wc, int fr, int fq) const {
        EPI_ROWS(u); GLB bf16_t* base = proj + (size_t)(u.pn >> 3) * T * D + (u.pn & 7) * 256 + ct0;
        EPI_FOR_ROWS { GLB bf16_t* rp = base + (size_t)(row0 + ai * HALF + m * 16) * D;
#pragma unroll
            for (int bj = 0; bj < 2; ++bj) *(GLB u32x4*)(rp + bj * HALF) = pack8(acc[ai][bj][m][0], acc[ai][bj][m][1]); }
    }
};
}
struct Ctx {
    LAS unsigned char* lds;
    GLB unsigned char* ws;
    GLB float* out;
    int tid, lane, wave, gw, NGW, G;
};
#define WSP(type, off) ((GLB type*)(C.ws + (off)))
constexpr int INTAB_OFF = MISC_OFF + 1024;
constexpr int TAB_WS = 37, TAB_OUT = 38, TAB_RANGE = 39;
__device__ __forceinline__ const GLB void* inptr(LAS unsigned char* lds, int i) {
    const LAS unsigned* t = (const LAS unsigned*)(lds + INTAB_OFF) + 2 * i;
    const unsigned lo = __builtin_amdgcn_readfirstlane(t[0]), hi = __builtin_amdgcn_readfirstlane(t[1]);
    return (const GLB void*)(((unsigned long long)hi << 32) | lo);
}
#define INF32(i) ((const GLB float*)inptr(C.lds, (i)))
__device__ __forceinline__ Ctx make_ctx(LAS unsigned char* lds) {
    Ctx C; C.lds = lds;
    int tid = threadIdx.x; asm volatile("" : "+v"(tid));
    C.tid = tid; C.lane = tid & 63; C.wave = __builtin_amdgcn_readfirstlane(tid >> 6);
    C.G = gridDim.x; C.gw = blockIdx.x * NWAVES + C.wave; C.NGW = C.G * NWAVES;
    C.ws = (GLB unsigned char*)inptr(lds, TAB_WS); C.out = (GLB float*)inptr(lds, TAB_OUT);
    return C;
}
enum { I_X = 0, I_P, I_POS, I_WIN, I_MIXN, I_FFNN, I_PLEN, I_RWMU, I_RWW0, I_RWW2, I_RWA0, I_RWA2, I_RWG2, I_RWKK, I_RWKA, I_RWRK, I_RWLNG, I_RWLNB,
       I_DQN, I_DKN, I_DKVN, I_DWUK, I_DWUV, I_SQN, I_SKN, I_SSINK, I_WBR, I_WOUT, I_FG, I_FU, I_FD, I_MR, I_MG, I_MU, I_MD, I_PG, I_PP, N_INPUTS };

__device__ __forceinline__ void conv_tile(const GLB float* W, int ldw, int k0, int s0, int nv, GLB bf16_t* Bt, int K, int n0, LAS float* scr, int lane) {
    const int cq = lane & 15, rq = lane >> 4;
    f32x4 v[16];
#pragma unroll
    for (int i = 0; i < 16; ++i) {
        const int kk = 4 * i + rq;
        v[i] = (4 * cq < nv) ? *(const GLB f32x4*)(W + (size_t)(k0 + kk) * ldw + s0 + 4 * cq) : (f32x4){0.f, 0.f, 0.f, 0.f};
    }
#pragma unroll
    for (int i = 0; i < 16; ++i) { const int kk = 4 * i + rq; LAS float* d = scr + kk * 65 + 4 * cq; d[0] = v[i][0]; d[1] = v[i][1]; d[2] = v[i][2]; d[3] = v[i][3]; }
    LDS_WAIT();
    const int c = lane & 7;
#pragma unroll
    for (int j = 0; j < 8; ++j) { const int n = (lane >> 3) + 8 * j; const LAS float* s = scr + (8 * c) * 65 + n;
        u32x4 o; o.x = pk2(s[0 * 65], s[1 * 65]); o.y = pk2(s[2 * 65], s[3 * 65]); o.z = pk2(s[4 * 65], s[5 * 65]); o.w = pk2(s[6 * 65], s[7 * 65]);
        *(GLB u32x4*)(Bt + (size_t)(n0 + n) * K + k0 + 8 * c) = o; }
    LDS_WAIT();
}
__device__ __forceinline__ void win_map(int g, int& s0, int& nv) {
    const int d0 = 64 * g; nv = 64;
    if (d0 < 8704) s0 = d0;
    else if (d0 < 9728) s0 = 8784 + (d0 - 8704);
    else if (d0 < 9984) s0 = 9808 + (d0 - 9728);
    else if (d0 < 10240) { const int off = d0 - 9984; if (off == 0) s0 = 8704; else if (off == 64) { s0 = 8768; nv = 16; } else { s0 = 0; nv = 0; } }
    else s0 = 10064 + (d0 - 10240);
}
#ifndef MOE_SCAN_TILES
#define MOE_SCAN_TILES 42
#endif
#ifndef MOE_CONV_IN_PROLOGUE
#define MOE_CONV_IN_PROLOGUE 0
#endif
constexpr int MOE_CONV_ITEMS = NE * ((D / 64) * (2 * FF / 64) + (FF / 64) * (D / 64));
__device__ __forceinline__ void conv_moe_item(const Ctx& C, int idx, LAS float* scr, int lane) {
    constexpr int I_GU1 = (D / 64) * (2 * FF / 64), I_DN1 = (FF / 64) * (D / 64);
    if (idx < NE * I_GU1) {
        const int e = idx / I_GU1, r = idx % I_GU1, nb = r % (2 * FF / 64), kb = r / (2 * FF / 64);
        const int tile = nb >> 2, q = nb & 3; const int sc = 128 * tile + 64 * (q & 1);
        conv_tile(((q < 2) ? INF32(I_MG) : INF32(I_MU)) + (size_t)e * D * FF, FF, 64 * kb, sc, 64, WSP(bf16_t, WS_MWGU) + (size_t)e * 2 * FF * D, D, 64 * nb, scr, lane);
    } else {
        const int r0 = idx - NE * I_GU1, e = r0 / I_DN1, r = r0 % I_DN1, nb = r % 32, kb = r / 32;
        conv_tile(INF32(I_MD) + (size_t)e * FF * D, D, 64 * kb, 64 * nb, 64, WSP(bf16_t, WS_MWD) + (size_t)e * D * FF, FF, 64 * nb, scr, lane);
    }
}
__device__ __forceinline__ void ph_prologue(const Ctx& C) {
    LAS float* scr = (LAS float*)(C.lds + C.wave * 16640);
    const int gw = C.gw, NGW = C.NGW; int lane = C.lane; asm volatile("" : "+v"(lane)); lane &= 63;
    constexpr int I_WIN1 = (D / 64) * (N_INP / 64);
    constexpr int I_BR1 = (1024 / 64) * (2048 / 64);
    constexpr int I_DD = (D / 64) * (D / 64);
    constexpr int I_GU1 = (D / 64) * (2 * FF / 64);
    constexpr int I_DN1 = (FF / 64) * (D / 64);
    constexpr int I_PP1 = (256 / 64) * (D / 64);
    constexpr int S0 = 0, S1 = S0 + NL * I_WIN1, S2 = S1 + NL * 4 * I_BR1, S3 = S2 + NL * I_DD, S4 = S3 + I_GU1, S5 = S4 + I_DN1, S6 = S5 + NE * I_GU1, S7 = S6 + NE * I_DN1,
                  S8 = S7 + NL * I_DD, S9 = S8 + NL * I_PP1;
    for (int it = gw; it < S9; it += NGW) {
        if (it < S1) { const int l = it / I_WIN1, r = it % I_WIN1, nb = r % (N_INP / 64), kb = r / (N_INP / 64); int s0, nv; win_map(nb, s0, nv);
            conv_tile(INF32(I_WIN) + (size_t)l * D * N_IN, N_IN, 64 * kb, s0, nv, WSP(bf16_t, WS_WIN + l * SZ_WIN1), D, 64 * nb, scr, lane); }
        else if (it < S2) { const int q = (it - S1) / I_BR1, r = (it - S1) % I_BR1, nb = r % 32, kb = r / 32;
            conv_tile(INF32(I_WBR) + (size_t)q * 1024 * 2048, 2048, 64 * kb, 64 * nb, 64, WSP(bf16_t, WS_WBR) + (size_t)q * 2048 * 1024, 1024, 64 * nb, scr, lane); }
        else if (it < S3) { const int l = (it - S2) / I_DD, r = (it - S2) % I_DD, nb = r % 32, kb = r / 32;
            conv_tile(INF32(I_WOUT) + (size_t)l * D * D, D, 64 * kb, 64 * nb, 64, WSP(bf16_t, WS_WOUT + l * SZ_DD), D, 64 * nb, scr, lane); }
        else if (it < S4) {
            const int r = it - S3, nb = r % (2 * FF / 64), kb = r / (2 * FF / 64);
            const int tile = nb >> 2, q = nb & 3; const int sc = 128 * tile + 64 * (q & 1);
            conv_tile((q < 2) ? INF32(I_FG) : INF32(I_FU), FF, 64 * kb, sc, 64, WSP(bf16_t, WS_WGU), D, 64 * nb, scr, lane); }
        else if (it < S5) { const int r = it - S4, nb = r % 32, kb = r / 32;
            conv_tile(INF32(I_FD), D, 64 * kb, 64 * nb, 64, WSP(bf16_t, WS_WD), FF, 64 * nb, scr, lane); }
        else if (it < S7) { if (MOE_CONV_IN_PROLOGUE || it - S5 >= 2 * 1024 * MOE_SCAN_TILES) conv_moe_item(C, it - S5, scr, lane); }
        else if (it < S8) { const int l = (it - S7) / I_DD, r = (it - S7) % I_DD, nb = r % 32, kb = r / 32;
            conv_tile(INF32(I_PG) + (size_t)l * D * D, D, 64 * kb, 64 * nb, 64, WSP(bf16_t, WS_WPG + l * SZ_DD), D, 64 * nb, scr, lane); }
        else { const int l = (it - S8) / I_PP1, r = (it - S8) % I_PP1, nb = r % 32, kb = r / 32;
            conv_tile(INF32(I_PP) + (size_t)l * 256 * D, D, 64 * kb, 64 * nb, 64, WSP(bf16_t, WS_WPP) + (size_t)l * D * 256, 256, 64 * nb, scr, lane); }
    }
    for (int idx = gw * 64 + lane; idx < NL * 3072 * 256; idx += NGW * 64) {
        const int k = idx & 255, n = (idx >> 8) % 3072, l = idx / (3072 * 256);
        float v = 0.f;
        if (n < 1024) { if (k < 96) v = INF32(I_RWW2)[((size_t)l * 96 + k) * 1024 + n]; }
        else if (n < 2048) { if (k >= 96 && k < 192) v = INF32(I_RWA2)[((size_t)l * 96 + (k - 96)) * 1024 + (n - 1024)]; }
        else { if (k >= 192) v = INF32(I_RWG2)[((size_t)l * 64 + (k - 192)) * 1024 + (n - 2048)]; }
        WSP(bf16_t, WS_WLORA)[idx] = (bf16_t)f2bf(v);
    }
    for (int idx = gw * 64 + lane; idx < NL * T * 64; idx += NGW * 64) {
        const int c4 = idx & 63, t = (idx >> 6) % T, l = idx / (T * 64);
        const f32x4 v = *(const GLB f32x4*)(INF32(I_P) + ((size_t)l * T + t) * 256 + 4 * c4);
        u32x2 o; o.x = pk2(v[0], v[1]); o.y = pk2(v[2], v[3]);
        *(GLB u32x2*)(WSP(bf16_t, WS_PCAT) + (size_t)t * 512 + l * 256 + 4 * c4) = o;
    }
}

template <int MODE, bool XBF = true>
__device__ __forceinline__ void ph_norm(const Ctx& C, const GLB void* xin, GLB void* xout, const GLB float* gain, const GLB float* router, int moeS = 1) {
    int lane = C.lane; asm volatile("" : "+v"(lane)); lane &= 63;
    for (int m = C.gw; m < T; m += C.NGW) {
        f32x4 v[8]; float s = 0.f;
        if (XBF) { const GLB u32x2* xr = (const GLB u32x2*)((const GLB bf16_t*)xin + (size_t)m * D) + lane;
#pragma unroll
            for (int j = 0; j < 8; ++j) { const u32x2 w = xr[64 * j]; v[j] = (f32x4){bflo(w.x), bfhi(w.x), bflo(w.y), bfhi(w.y)}; }
        } else { const GLB f32x4* xr = (const GLB f32x4*)((const GLB float*)xin + (size_t)m * D) + lane;
#pragma unroll
            for (int j = 0; j < 8; ++j) v[j] = xr[64 * j]; }
        if (MODE == 2) {
            const GLB int* ts = WSP(int, WS_TOKSLOT) + 2 * m;
#pragma unroll
            for (int q = 0; q < 2; ++q) {
                const int sl = ts[q];
                if (sl < 64 * 256 || moeS <= 1) {
                    const GLB u32x2* o0 = (const GLB u32x2*)(WSP(bf16_t, WS_OS) + (size_t)sl * D) + lane;
#pragma unroll
                    for (int j = 0; j < 8; ++j) { const u32x2 w = o0[64 * j]; v[j] = v[j] + (f32x4){bflo(w.x), bfhi(w.x), bflo(w.y), bfhi(w.y)}; }
                } else {
                    const int tu0 = ((sl >> 8) - 64) * 8, rl = sl & 255;
#pragma unroll
                    for (int j = 0; j < 8; ++j)
                        for (int k = 0; k < moeS; ++k) v[j] = v[j] + *((const GLB f32x4*)(WSP(float, WS_OSP) + ((size_t)((tu0 + j) * moeS + k) << 16) + rl * 256) + lane);
                }
            }
#pragma unroll
            for (int j = 0; j < 8; ++j) { u32x2 o; o.x = pk2(v[j][0], v[j][1]); o.y = pk2(v[j][2], v[j][3]); ((GLB u32x2*)((GLB bf16_t*)xout + (size_t)m * D) + lane)[64 * j] = o;
                v[j] = (f32x4){bflo(o.x), bfhi(o.x), bflo(o.y), bfhi(o.y)}; }
        }
#pragma unroll
        for (int j = 0; j < 8; ++j) s += (v[j][0] * v[j][0] + v[j][1] * v[j][1]) + (v[j][2] * v[j][2] + v[j][3] * v[j][3]);
        const float rstd = 1.0f / sqrtf(wave_sum(s) * (1.0f / D) + 1e-6f);
        GLB u32x2* o8 = (GLB u32x2*)(WSP(bf16_t, WS_H) + (size_t)m * D) + lane;
        float lg[NE];
        if (MODE == 1) {
#pragma unroll
            for (int e = 0; e < NE; ++e) lg[e] = 0.f;
        }
#pragma unroll
        for (int j = 0; j < 8; ++j) { const f32x4 g = ((const GLB f32x4*)gain)[lane + 64 * j]; const f32x4 hv = v[j] * rstd * g; v[j] = hv;
            u32x2 o; o.x = pk2(hv[0], hv[1]); o.y = pk2(hv[2], hv[3]); o8[64 * j] = o; }
        if (MODE == 1) {
#pragma unroll 2
            for (int j = 0; j < 8; ++j) {
#pragma unroll
                for (int q = 0; q < 4; ++q) { const GLB f32x4* rr = (const GLB f32x4*)(router + (size_t)(4 * (lane + 64 * j) + q) * NE); const f32x4 r0 = rr[0], r1 = rr[1]; const float hq = v[j][q];
                    lg[0] += hq * r0[0]; lg[1] += hq * r0[1]; lg[2] += hq * r0[2]; lg[3] += hq * r0[3]; lg[4] += hq * r1[0]; lg[5] += hq * r1[1]; lg[6] += hq * r1[2]; lg[7] += hq * r1[3]; }
            }
        }
        if (MODE == 1) {
#pragma unroll
            for (int e = 0; e < NE; ++e) lg[e] = wave_sum(lg[e]);
            if (lane == 0) {
                int e1 = 0; float v1 = lg[0];
#pragma unroll
                for (int e = 1; e < NE; ++e) if (lg[e] > v1) { v1 = lg[e]; e1 = e; }
                int e2 = -1; float v2 = -3.0e38f;
#pragma unroll
                for (int e = 0; e < NE; ++e) if (e != e1 && lg[e] > v2) { v2 = lg[e]; e2 = e; }
                const float ex = __expf(v2 - v1), w1 = 1.0f / (1.0f + ex), w2 = ex / (1.0f + ex);
                GLB unsigned* cnt = WSP(unsigned, WS_CTL) + CW_MOECNT;
                const unsigned p1 = atomicAdd((unsigned*)cnt + 64 * e1, 1u), p2 = atomicAdd((unsigned*)cnt + 64 * e2, 1u);
                GLB unsigned* rt = WSP(unsigned, WS_ROUTE) + (size_t)m * 8;
                rt[0] = (unsigned)e1; rt[1] = p1; rt[2] = __builtin_bit_cast(unsigned, w1); rt[3] = (unsigned)e2; rt[4] = p2; rt[5] = __builtin_bit_cast(unsigned, w2);
            }
        }
    }
}
__device__ __forceinline__ void moe_offsets(const Ctx& C, int (&toff)[NE + 1]) {
    const GLB unsigned* cnt = WSP(unsigned, WS_CTL) + CW_MOECNT; int acc = 0;
#pragma unroll
    for (int e = 0; e < NE; ++e) { toff[e] = acc; const unsigned c = __hip_atomic_load(cnt + 64 * e, __ATOMIC_RELAXED, __HIP_MEMORY_SCOPE_AGENT); acc += (int)((c + 255u) >> 8); }
    toff[NE] = acc;
}
constexpr int MOETAB_OFF = MISC_OFF + 2048;
__device__ __forceinline__ void moe_tile_table(const Ctx& C) {
    int toff[NE + 1]; moe_offsets(C, toff);
    LAS int* tab = (LAS int*)(C.lds + MOETAB_OFF);
    if (C.tid <= MOE_MAXRT) { int e = 0;
#pragma unroll
        for (int j = 1; j < NE; ++j) e += (C.tid >= toff[j]) ? 1 : 0;
        tab[C.tid] = (C.tid == MOE_MAXRT) ? toff[NE] : e; }
    LDS_WAIT(); __syncthreads();
}
__device__ __forceinline__ void ph_moe_gather(const Ctx& C) {
    int toff[NE + 1]; moe_offsets(C, toff);
    int lane = C.lane; asm volatile("" : "+v"(lane)); lane &= 63;
    for (int m = C.gw; m < T; m += C.NGW) {
        const GLB unsigned* rt = WSP(unsigned, WS_ROUTE) + (size_t)m * 8;
        const int e1 = (int)rt[0], p1 = (int)rt[1], e2 = (int)rt[3], p2 = (int)rt[4];
        int o1 = 0, o2 = 0;
#pragma unroll
        for (int e = 0; e < NE; ++e) { o1 = (e == e1) ? toff[e] : o1; o2 = (e == e2) ? toff[e] : o2; }
        const int s1 = o1 * 256 + p1, s2 = o2 * 256 + p2;
        const GLB u32x4* src = (const GLB u32x4*)(WSP(bf16_t, WS_H) + (size_t)m * D) + lane;
        GLB u32x4* d1 = (GLB u32x4*)(WSP(bf16_t, WS_HS) + (size_t)s1 * D) + lane; GLB u32x4* d2 = (GLB u32x4*)(WSP(bf16_t, WS_HS) + (size_t)s2 * D) + lane;
#pragma unroll
        for (int j = 0; j < 4; ++j) { const u32x4 v = src[64 * j]; d1[64 * j] = v; d2[64 * j] = v; }
        if (lane == 0) { WSP(int, WS_TOKSLOT)[2 * m] = s1; WSP(int, WS_TOKSLOT)[2 * m + 1] = s2;
            WSP(unsigned, WS_WSLOT)[s1] = rt[2]; WSP(unsigned, WS_WSLOT)[s2] = rt[5]; }
    }
}

__device__ __forceinline__ float rope_inv_freq(int i, int half) { return exp2f(-13.287712379549449f * (float)i / (float)half); }
__device__ __forceinline__ void ph_prep(const Ctx& C, int l) {
    int lane = C.lane; asm volatile("" : "+v"(lane)); lane &= 63;
    const GLB bf16_t* UF = WSP(bf16_t, WS_UF);
    const int d = lane & 31, hh = lane >> 5;
    for (int m = C.gw; m < T; m += C.NGW) {
        const int t = m % SEQ;
        const GLB bf16_t* u = UF + (size_t)m * UFW;
        const float posf = (float)((const GLB int*)inptr(C.lds, I_POS))[m];
        float qa[8], qb[8], ia[8], ib[8], sa[8], sb[8];
#pragma unroll
        for (int h = 0; h < 8; ++h) { qa[h] = bf1(u[UF_DQ + h * 128 + lane]); qb[h] = bf1(u[UF_DQ + h * 128 + 64 + lane]); }
#pragma unroll
        for (int hp = 0; hp < 8; ++hp) { const int h = 2 * hp + hh; ia[hp] = bf1(u[UF_IQ + h * 64 + d]); ib[hp] = bf1(u[UF_IQ + h * 64 + 32 + d]); sa[hp] = bf1(u[UF_SQ + h * 64 + d]); sb[hp] = bf1(u[UF_SQ + h * 64 + 32 + d]); }
        const float ika = bf1(u[UF_IK + d]), ikb = bf1(u[UF_IK + 32 + d]), iwv = bf1(u[UF_IW + (lane & 15)]);
        const float ska = bf1(u[UF_SK + hh * 64 + d]), skb = bf1(u[UF_SK + hh * 64 + 32 + d]), sv0 = bf1(u[UF_SV + lane]), sv1 = bf1(u[UF_SV + 64 + lane]);
        {
            const GLB float* mu = INF32(I_RWMU) + (size_t)l * 3328;
#pragma unroll
            for (int half = 0; half < 2; ++half) {
                constexpr int J0[2] = {0, 7}, J1[2] = {7, 13};
                f32x4 cur[7], prv[7], mm[7];
#pragma unroll
                for (int j = J0[half]; j < J1[half]; ++j) { const int c = 4 * (lane + 64 * j), q = j - J0[half];
                    { const u32x2 w = *(const GLB u32x2*)(u + UF_RW + c); cur[q] = (f32x4){bflo(w.x), bfhi(w.x), bflo(w.y), bfhi(w.y)}; }
                    if (t > 0) { const u32x2 w = *(const GLB u32x2*)(u - UFW + UF_RW + c); prv[q] = (f32x4){bflo(w.x), bfhi(w.x), bflo(w.y), bfhi(w.y)}; } else prv[q] = (f32x4){0.f, 0.f, 0.f, 0.f};
                    mm[q] = *(const GLB f32x4*)(mu + c); }
#pragma unroll
                for (int j = J0[half]; j < J1[half]; ++j) { const int c = 4 * (lane + 64 * j), q = j - J0[half];
                    const f32x4 o = cur[q] + mm[q] * (prv[q] - cur[q]);
                    if (j < 12) { GLB bf16_t* dst = WSP(bf16_t, (j < 4 ? WS_R : (j < 8 ? WS_K : WS_V))) + (size_t)m * 1024 + (c & 1023); u32x2 w; w.x = pk2(o[0], o[1]); w.y = pk2(o[2], o[3]); *(GLB u32x2*)dst = w; }
                    else { const int k = c - 3072; f32x4 a;
                        if (k < 96) a = (f32x4){tanhf(o[0]), tanhf(o[1]), tanhf(o[2]), tanhf(o[3])};
                        else if (k < 192) a = o;
                        else a = pg8::sig4(o);
                        u32x2 w; w.x = pk2(a[0], a[1]); w.y = pk2(a[2], a[3]);
                        *(GLB u32x2*)(WSP(bf16_t, WS_ALORA) + (size_t)m * 256 + k) = w; }
                }
            }
        }
        {
            const float invf = rope_inv_freq(lane, 64); float sn, cn; sincosf(posf * invf, &sn, &cn);
            const float g1 = INF32(I_DQN)[l * 128 + lane], g2 = INF32(I_DQN)[l * 128 + 64 + lane];
#pragma unroll
            for (int h = 0; h < 8; ++h) {
                const float a = qa[h], b = qb[h];
                const float rs = 1.0f / sqrtf(wave_sum(a * a + b * b) * (1.0f / 128.f) + 1e-6f);
                const float x1 = a * rs * g1, x2 = b * rs * g2;
                GLB bf16_t* q = WSP(bf16_t, WS_QD) + (size_t)m * 1024 + h * 128;
                q[lane] = (bf16_t)f2bf(x1 * cn - x2 * sn); q[64 + lane] = (bf16_t)f2bf(x2 * cn + x1 * sn);
            }
        }
        {
            const float invf = rope_inv_freq(d, 32); float sn, cn; sincosf(posf * invf, &sn, &cn);
#pragma unroll
            for (int hp = 0; hp < 8; ++hp) { const int h = 2 * hp + hh; const float a = ia[hp], b = ib[hp];
                GLB bf16_t* q = WSP(bf16_t, WS_QI) + (size_t)m * 1024 + h * 64; q[d] = (bf16_t)f2bf(a * cn - b * sn); q[32 + d] = (bf16_t)f2bf(b * cn + a * sn); }
            if (hh == 0) { GLB bf16_t* q = WSP(bf16_t, WS_KI) + (size_t)m * 64; q[d] = (bf16_t)f2bf(ika * cn - ikb * sn); q[32 + d] = (bf16_t)f2bf(ikb * cn + ika * sn); }
            if (lane < 16) WSP(float, WS_WI)[(size_t)m * 16 + lane] = iwv * 0.03125f;
            const float sg1 = INF32(I_SQN)[l * 64 + d], sg2 = INF32(I_SQN)[l * 64 + 32 + d];
#pragma unroll
            for (int hp = 0; hp < 8; ++hp) { const int h = 2 * hp + hh; const float a = sa[hp], b = sb[hp];
                float s2 = a * a + b * b;
#pragma unroll
                for (int o = 1; o < 32; o <<= 1) s2 += __shfl_xor(s2, o);
                const float rs = 1.0f / sqrtf(s2 * (1.0f / 64.f) + 1e-6f); const float x1 = a * rs * sg1, x2 = b * rs * sg2;
                GLB bf16_t* q = WSP(bf16_t, WS_QS) + (size_t)m * 1024 + h * 64; q[d] = (bf16_t)f2bf(x1 * cn - x2 * sn); q[32 + d] = (bf16_t)f2bf(x2 * cn + x1 * sn); }
            { const float kg1 = INF32(I_SKN)[l * 64 + d], kg2 = INF32(I_SKN)[l * 64 + 32 + d];
              float s2 = ska * ska + skb * skb;
#pragma unroll
              for (int o = 1; o < 32; o <<= 1) s2 += __shfl_xor(s2, o);
              const float rs = 1.0f / sqrtf(s2 * (1.0f / 64.f) + 1e-6f); const float x1 = ska * rs * kg1, x2 = skb * rs * kg2;
              GLB bf16_t* q = WSP(bf16_t, WS_KS) + (size_t)m * 128 + hh * 64; q[d] = (bf16_t)f2bf(x1 * cn - x2 * sn); q[32 + d] = (bf16_t)f2bf(x2 * cn + x1 * sn);
              GLB bf16_t* vv = WSP(bf16_t, WS_VS) + (size_t)m * 128; vv[lane] = (bf16_t)f2bf(sv0); vv[64 + lane] = (bf16_t)f2bf(sv1); }
        }
    }
}

__device__ __forceinline__ void ph_latent(const Ctx& C, int l) {
    int lane = C.lane; asm volatile("" : "+v"(lane)); lane &= 63;
    LAS float* cs = (LAS float*)(C.lds + C.wave * 8192);
    const GLB bf16_t* UF = WSP(bf16_t, WS_UF);
    const GLB float* wuk = INF32(I_DWUK) + (size_t)l * 256 * 128; const GLB float* wuv = INF32(I_DWUV) + (size_t)l * 256 * 128;
    for (int g8 = C.gw; g8 < T / 8; g8 += C.NGW) {
        const int m0 = 8 * g8;
        float cv[8][4];
#pragma unroll
        for (int tk = 0; tk < 8; ++tk)
#pragma unroll
            for (int j = 0; j < 4; ++j) cv[tk][j] = bf1(UF[(size_t)(m0 + tk) * UFW + UF_CKV + lane + 64 * j]);
#pragma unroll
        for (int tk = 0; tk < 8; ++tk) {
            float ss = 0.f;
#pragma unroll
            for (int j = 0; j < 4; ++j) ss += cv[tk][j] * cv[tk][j];
            const float rc = 1.0f / sqrtf(wave_sum(ss) * (1.0f / 256.f) + 1e-6f);
#pragma unroll
            for (int j = 0; j < 4; ++j) cs[(lane + 64 * j) * 8 + tk] = cv[tk][j] * rc * INF32(I_DKVN)[l * 256 + lane + 64 * j];
        }
        LDS_WAIT();
        float acc[8][4];
#pragma unroll
        for (int tk = 0; tk < 8; ++tk) { acc[tk][0] = 0.f; acc[tk][1] = 0.f; acc[tk][2] = 0.f; acc[tk][3] = 0.f; }
#pragma unroll 8
        for (int k = 0; k < 256; ++k) {
            const float w0 = wuk[k * 128 + lane], w1 = wuk[k * 128 + 64 + lane], w2 = wuv[k * 128 + lane], w3 = wuv[k * 128 + 64 + lane];
            const f32x4 ca = *(const LAS f32x4*)(cs + k * 8), cb = *(const LAS f32x4*)(cs + k * 8 + 4);
#pragma unroll
            for (int tk = 0; tk < 8; ++tk) { const float c = (tk < 4) ? ca[tk & 3] : cb[tk & 3]; acc[tk][0] += c * w0; acc[tk][1] += c * w1; acc[tk][2] += c * w2; acc[tk][3] += c * w3; }
        }
        const float invf = rope_inv_freq(lane, 64);
        const float g1 = INF32(I_DKN)[l * 128 + lane], g2 = INF32(I_DKN)[l * 128 + 64 + lane];
#pragma unroll
        for (int tk = 0; tk < 8; ++tk) {
            const int m = m0 + tk;
            const float posf = (float)((const GLB int*)inptr(C.lds, I_POS))[m];
            float sn, cn; sincosf(posf * invf, &sn, &cn);
            const float k1 = acc[tk][0], k2 = acc[tk][1];
            const float rk = 1.0f / sqrtf(wave_sum(k1 * k1 + k2 * k2) * (1.0f / 128.f) + 1e-6f);
            const float y1 = k1 * rk * g1, y2 = k2 * rk * g2;
            GLB bf16_t* kd = WSP(bf16_t, WS_KD) + (size_t)m * 128; GLB bf16_t* vd = WSP(bf16_t, WS_VD) + (size_t)m * 128;
            kd[lane] = (bf16_t)f2bf(y1 * cn - y2 * sn); kd[64 + lane] = (bf16_t)f2bf(y2 * cn + y1 * sn);
            vd[lane] = (bf16_t)f2bf(acc[tk][2]); vd[64 + lane] = (bf16_t)f2bf(acc[tk][3]);
        }
        LDS_WAIT();
    }
}

__device__ __forceinline__ void ph_rwkv_kk(const Ctx& C, int l) {
    int lane = C.lane; asm volatile("" : "+v"(lane)); lane &= 63;
    for (int m = C.gw; m < T; m += C.NGW) {
#pragma unroll
        for (int i = 0; i < 4; ++i) {
            const int c = 256 * i + 4 * lane; const size_t o = (size_t)m * 1024 + c;
            const f32x4 k = *(const GLB f32x4*)(WSP(float, WS_K) + o), a = *(const GLB f32x4*)(WSP(float, WS_AA) + o);
            const f32x4 kkw = *(const GLB f32x4*)(INF32(I_RWKK) + l * 1024 + c), ka = *(const GLB f32x4*)(INF32(I_RWKA) + l * 1024 + c);
            f32x4 kk = k * kkw; float s = (kk[0] * kk[0] + kk[1] * kk[1]) + (kk[2] * kk[2] + kk[3] * kk[3]);
#pragma unroll
            for (int q = 1; q < 16; q <<= 1) s += __shfl_xor(s, q);
            const float inv = 1.0f / fmaxf(sqrtf(s), 1e-12f); kk = kk * inv;
            *(GLB f32x4*)(WSP(float, WS_KK) + o) = kk;
            *(GLB f32x4*)(WSP(float, WS_K) + o) = k * (1.0f + (a - 1.0f) * ka);
            *(GLB f32x4*)(WSP(float, WS_AA) + o) = kk * a;
        }
    }
}
__device__ __forceinline__ void ph_rwkv_scan_naive(const Ctx& C) {
    if (C.wave != 0) return;
    int lane = C.lane; asm volatile("" : "+v"(lane)); lane &= 63;
    LAS float* buf = (LAS float*)C.lds;
    for (int it = blockIdx.x; it < NB * 16; it += C.G) {
        const int b = it >> 4, h = it & 15;
        float S[64];
#pragma unroll
        for (int k = 0; k < 64; ++k) S[k] = 0.f;
        const size_t base = (size_t)b * SEQ * 1024 + h * 64 + lane;
        for (int t0 = 0; t0 < SEQ; t0 += 16) {
#pragma unroll
            for (int st = 0; st < 16; ++st) { const size_t o = base + (size_t)(t0 + st) * 1024; LAS float* d = buf + st * 384 + lane;
                d[0] = WSP(float, WS_R)[o]; d[64] = WSP(float, WS_DEC)[o]; d[128] = WSP(float, WS_K)[o]; d[192] = WSP(float, WS_KK)[o]; d[256] = WSP(float, WS_AA)[o]; d[320] = WSP(float, WS_V)[o]; }
            LDS_WAIT();
            for (int st = 0; st < 16; ++st) {
                const LAS float* rb = buf + st * 384;
                float p = 0.f;
#pragma unroll
                for (int k = 0; k < 64; k += 4) { const f32x4 q = *(const LAS f32x4*)(rb + 192 + k); p += S[k] * q[0] + S[k + 1] * q[1] + S[k + 2] * q[2] + S[k + 3] * q[3]; }
                const float vv = rb[320 + lane]; float y = 0.f;
#pragma unroll
                for (int k = 0; k < 64; k += 4) { const f32x4 w = *(const LAS f32x4*)(rb + 64 + k), bb = *(const LAS f32x4*)(rb + 256 + k), kq = *(const LAS f32x4*)(rb + 128 + k), r = *(const LAS f32x4*)(rb + k);
#pragma unroll
                    for (int j = 0; j < 4; ++j) { S[k + j] = S[k + j] * w[j] - p * bb[j] + vv * kq[j]; y += S[k + j] * r[j]; } }
                WSP(float, WS_YRAW)[base + (size_t)(t0 + st) * 1024] = y;
            }
            LDS_WAIT();
        }
    }
}
__device__ __forceinline__ f32x4 ld4bf(const GLB bf16_t* q) { const u32x2 w = *(const GLB u32x2*)q; return (f32x4){bflo(w.x), bfhi(w.x), bflo(w.y), bfhi(w.y)}; }
__device__ __forceinline__ void ph_rwkv_post(const Ctx& C, int l) {
    int lane = C.lane; asm volatile("" : "+v"(lane)); lane &= 63;
    if (C.wave >= 4) return;
    for (int m = blockIdx.x * 4 + C.wave; m < T; m += C.G * 4) {
#pragma unroll
        for (int i = 0; i < 4; ++i) {
            const int c = 256 * i + 4 * lane; const size_t o = (size_t)m * 1024 + c;
            const f32x4 y = *(const GLB f32x4*)(WSP(float, WS_YRAW) + o);
            float s = (y[0] + y[1]) + (y[2] + y[3]);
#pragma unroll
            for (int q = 1; q < 16; q <<= 1) s += __shfl_xor(s, q);
            const float mean = s * (1.0f / 64.f); const f32x4 dlt = y - mean;
            float s2 = (dlt[0] * dlt[0] + dlt[1] * dlt[1]) + (dlt[2] * dlt[2] + dlt[3] * dlt[3]);
#pragma unroll
            for (int q = 1; q < 16; q <<= 1) s2 += __shfl_xor(s2, q);
            const float rstd = 1.0f / sqrtf(s2 * (1.0f / 64.f) + 64e-5f);
            const f32x4 r = ld4bf(WSP(bf16_t, WS_R) + o), kraw = ld4bf(WSP(bf16_t, WS_K) + o), av = ld4bf(WSP(bf16_t, WS_AA) + o), v = ld4bf(WSP(bf16_t, WS_V) + o), g = ld4bf(WSP(bf16_t, WS_GG) + o);
            const f32x4 k = kraw * (1.0f + (av - 1.0f) * *(const GLB f32x4*)(INF32(I_RWKA) + l * 1024 + c));
            const f32x4 rk = *(const GLB f32x4*)(INF32(I_RWRK) + l * 1024 + c), lg = *(const GLB f32x4*)(INF32(I_RWLNG) + l * 1024 + c), lb = *(const GLB f32x4*)(INF32(I_RWLNB) + l * 1024 + c);
            const f32x4 pr = r * k * rk; float bs = (pr[0] + pr[1]) + (pr[2] + pr[3]);
#pragma unroll
            for (int q = 1; q < 16; q <<= 1) bs += __shfl_xor(bs, q);
            const f32x4 res = (dlt * rstd * lg + lb + bs * v) * g;
            u32x2 w; w.x = pk2(res[0], res[1]); w.y = pk2(res[2], res[3]);
            *(GLB u32x2*)(WSP(bf16_t, WS_Y) + (size_t)m * 4096 + 1024 + c) = w;
        }
    }
}
__device__ __forceinline__ float dot8(u32x4 kv, f32x4 qa, f32x4 qb) {
    return bflo(kv.x) * qa[0] + bfhi(kv.x) * qa[1] + bflo(kv.y) * qa[2] + bfhi(kv.y) * qa[3] + bflo(kv.z) * qb[0] + bfhi(kv.z) * qb[1] + bflo(kv.w) * qb[2] + bfhi(kv.w) * qb[3];
}
__device__ __forceinline__ void ph_sb_naive(const Ctx& C) {
    int lane = C.lane; asm volatile("" : "+v"(lane));
    LAS float* qs = (LAS float*)(C.lds + C.wave * 512);
    const GLB bf16_t* QKV = WSP(bf16_t, WS_SBQKV); GLB bf16_t* Y = WSP(bf16_t, WS_Y);
    for (int it = C.gw; it < NB * 8 * SEQ; it += C.NGW) {
        const int t = it % SEQ, bh = it / SEQ, h = bh & 7, b = bh >> 3;
        const size_t m = (size_t)b * SEQ + t;
        { const unsigned qq = *(const GLB unsigned*)(QKV + m * 3072 + h * 128 + 2 * lane); qs[2 * lane] = bflo(qq); qs[2 * lane + 1] = bfhi(qq); }
        LDS_WAIT();
        float o0 = 0.f, o1 = 0.f, carry = 0.f;
        const int nch = (t + 63) >> 6;
        for (int c = nch - 1; c >= 0; --c) {
            const int s = c * 64 + lane; const bool valid = s < t; const int sc = valid ? s : 0;
            const GLB u32x4* kp = (const GLB u32x4*)(QKV + ((size_t)b * SEQ + sc) * 3072 + 1024 + h * 128);
            float dot = 0.f;
#pragma unroll
            for (int j = 0; j < 16; ++j) dot += dot8(kp[j], *(const LAS f32x4*)(qs + 8 * j), *(const LAS f32x4*)(qs + 8 * j + 4));
            const float z = dot * 0.08838834764831845f;
            const float lk = valid ? logsigf_(-z) : 0.f, lb = logsigf_(z);
            float inc = lk;
#pragma unroll
            for (int off = 1; off < 64; off <<= 1) { const float o = __shfl_down(inc, off); if (lane + off < 64) inc += o; }
            const float w = valid ? __expf(lb + carry + inc - lk) : 0.f;
            carry += rdlane(inc, 0);
            const int nk = (t - c * 64) < 64 ? (t - c * 64) : 64;
            const GLB bf16_t* vp = QKV + ((size_t)b * SEQ + c * 64) * 3072 + 2048 + h * 128 + 2 * lane;
            for (int j = 0; j < nk; ++j) { const float wj = rdlane(w, j); const unsigned vv = *(const GLB unsigned*)(vp + (size_t)j * 3072); o0 += wj * bflo(vv); o1 += wj * bfhi(vv); }
        }
        *(GLB unsigned*)(Y + m * 4096 + h * 128 + 2 * lane) = pk2(o0, o1);
        LDS_WAIT();
    }
}
__device__ __forceinline__ void ph_swa_naive(const Ctx& C, int l) {
    int lane = C.lane; asm volatile("" : "+v"(lane));
    LAS float* qs = (LAS float*)(C.lds + C.wave * 512);
    const GLB bf16_t* QS = WSP(bf16_t, WS_QS); const GLB bf16_t* KS = WSP(bf16_t, WS_KS); const GLB bf16_t* VS = WSP(bf16_t, WS_VS); GLB bf16_t* Y = WSP(bf16_t, WS_Y);
    for (int it = C.gw; it < T * 16; it += C.NGW) {
        const int h = it & 15, m = it >> 4, t = m % SEQ, b = m / SEQ, kvh = h >> 3;
        qs[lane] = bf1(QS[(size_t)m * 1024 + h * 64 + lane]);
        LDS_WAIT();
        float lg[2];
#pragma unroll
        for (int i = 0; i < 2; ++i) { const int s = t - 127 + lane + 64 * i; const bool valid = s >= 0;
            const GLB u32x4* kp = (const GLB u32x4*)(KS + ((size_t)b * SEQ + (valid ? s : 0)) * 128 + kvh * 64);
            float dot = 0.f;
#pragma unroll
            for (int j = 0; j < 8; ++j) dot += dot8(kp[j], *(const LAS f32x4*)(qs + 8 * j), *(const LAS f32x4*)(qs + 8 * j + 4));
            lg[i] = valid ? dot * 0.125f : -3.0e38f; }
        const float sink = INF32(I_SSINK)[l * 16 + h];
        const float mx = fmaxf(wave_max(fmaxf(lg[0], lg[1])), sink);
        const float e0 = (lg[0] > -1.0e38f) ? __expf(lg[0] - mx) : 0.f, e1 = (lg[1] > -1.0e38f) ? __expf(lg[1] - mx) : 0.f;
        const float den = wave_sum(e0 + e1) + __expf(sink - mx);
        const float p0 = e0 / den, p1 = e1 / den;
        float o = 0.f;
        const int j0 = (t >= 127) ? 0 : 127 - t;
        for (int j = j0; j < 128; ++j) { const float pj = (j < 64) ? rdlane(p0, j) : rdlane(p1, j - 64); const int s = t - 127 + j;
            o += pj * bf1(VS[((size_t)b * SEQ + s) * 128 + kvh * 64 + lane]); }
        Y[(size_t)m * 4096 + 3072 + h * 64 + lane] = (bf16_t)f2bf(o);
        LDS_WAIT();
    }
}
__device__ __forceinline__ unsigned ordkey(float f) { const unsigned u = __builtin_bit_cast(unsigned, f); return (u & 0x80000000u) ? ~u : (u | 0x80000000u); }
__device__ __forceinline__ void ph_dsa_naive(const Ctx& C) {
    int lane = C.lane; asm volatile("" : "+v"(lane));
    LAS float* A = (LAS float*)(C.lds + C.wave * 13312);
    LAS float* Bs = A + 1024;
    LAS int* Cs = (LAS int*)(Bs + 2048);
    const GLB bf16_t* QI = WSP(bf16_t, WS_QI); const GLB bf16_t* KI = WSP(bf16_t, WS_KI); const GLB float* WI = WSP(float, WS_WI);
    const GLB bf16_t* QD = WSP(bf16_t, WS_QD); const GLB bf16_t* KD = WSP(bf16_t, WS_KD); const GLB bf16_t* VD = WSP(bf16_t, WS_VD); GLB bf16_t* Y = WSP(bf16_t, WS_Y);
    for (int m = C.gw; m < T; m += C.NGW) {
        const int t = m % SEQ, b = m / SEQ, n = t + 1;
        const size_t bm = (size_t)b * SEQ;
#pragma unroll
        for (int i = 0; i < 2; ++i) { const int e = 8 * (lane + 64 * i); const u32x4 q = *(const GLB u32x4*)(QI + (size_t)m * 1024 + e);
            *(LAS f32x4*)(A + e) = (f32x4){bflo(q.x), bfhi(q.x), bflo(q.y), bfhi(q.y)}; *(LAS f32x4*)(A + e + 4) = (f32x4){bflo(q.z), bfhi(q.z), bflo(q.w), bfhi(q.w)}; }
        const float wl = WI[(size_t)m * 16 + (lane & 15)];
        LDS_WAIT();
        const int nch = (n + 63) >> 6;
        for (int c = 0; c < nch; ++c) {
            const int s = c * 64 + lane; const bool valid = s < n;
            const GLB u32x4* kp = (const GLB u32x4*)(KI + (bm + (valid ? s : 0)) * 64);
            u32x4 kv[8];
#pragma unroll
            for (int j = 0; j < 8; ++j) kv[j] = kp[j];
            float sc = 0.f;
#pragma unroll 1
            for (int h = 0; h < 16; ++h) { float dot = 0.f;
#pragma unroll
                for (int j = 0; j < 8; ++j) dot += dot8(kv[j], *(const LAS f32x4*)(A + h * 64 + 8 * j), *(const LAS f32x4*)(A + h * 64 + 8 * j + 4));
                sc += rdlane(wl, h) * fmaxf(dot, 0.f); }
            Bs[s] = sc;
        }
        LDS_WAIT();
        int nsel;
        if (n <= 256) { nsel = n;
#pragma unroll
            for (int i = 0; i < 4; ++i) if (lane + 64 * i < n) Cs[lane + 64 * i] = lane + 64 * i;
        } else {
            nsel = 256;
            unsigned key[32];
#pragma unroll
            for (int i = 0; i < 32; ++i) { const int s = lane + 64 * i; key[i] = (s < n) ? ordkey(Bs[s]) : 0u; }
            unsigned tau = 0u;
            for (int bit = 31; bit >= 0; --bit) {
                const unsigned cand = tau | (1u << bit); int cnt = 0;
#pragma unroll
                for (int i = 0; i < 32; ++i) cnt += (key[i] >= cand) ? 1 : 0;
#pragma unroll
                for (int o = 1; o < 64; o <<= 1) cnt += __shfl_xor(cnt, o);
                if (cnt >= 256) tau = cand;
            }
            int cgt = 0;
#pragma unroll
            for (int i = 0; i < 32; ++i) cgt += (key[i] > tau) ? 1 : 0;
#pragma unroll
            for (int o = 1; o < 64; o <<= 1) cgt += __shfl_xor(cgt, o);
            const int need = 256 - cgt;
            int base = 0, eqbase = 0;
            const unsigned long long lt = (1ull << lane) - 1ull;
#pragma unroll
            for (int i = 0; i < 32; ++i) {
                const bool gt = key[i] > tau, eq = key[i] == tau;
                const unsigned long long beq = __ballot(eq);
                const int eqrank = eqbase + __popcll(beq & lt);
                const bool sel = gt || (eq && eqrank < need);
                const unsigned long long bs = __ballot(sel);
                if (sel) Cs[base + __popcll(bs & lt)] = lane + 64 * i;
                base += __popcll(bs); eqbase += __popcll(beq);
            }
        }
        LDS_WAIT();
#pragma unroll
        for (int i = 0; i < 2; ++i) { const int e = 8 * (lane + 64 * i); const u32x4 q = *(const GLB u32x4*)(QD + (size_t)m * 1024 + e);
            *(LAS f32x4*)(A + e) = (f32x4){bflo(q.x), bfhi(q.x), bflo(q.y), bfhi(q.y)}; *(LAS f32x4*)(A + e + 4) = (f32x4){bflo(q.z), bfhi(q.z), bflo(q.w), bfhi(q.w)}; }
        LDS_WAIT();
        float lg[8][4];
#pragma unroll
        for (int i = 0; i < 4; ++i) { const int j = lane + 64 * i; const bool valid = j < nsel; const int s = valid ? Cs[j] : 0;
            const GLB u32x4* kp = (const GLB u32x4*)(KD + (bm + s) * 128);
            float a8[8];
#pragma unroll
            for (int h = 0; h < 8; ++h) a8[h] = 0.f;
#pragma unroll 1
            for (int pc = 0; pc < 16; ++pc) { const u32x4 kv = kp[pc];
#pragma unroll
                for (int h = 0; h < 8; ++h) a8[h] += dot8(kv, *(const LAS f32x4*)(A + h * 128 + 8 * pc), *(const LAS f32x4*)(A + h * 128 + 8 * pc + 4)); }
#pragma unroll
            for (int h = 0; h < 8; ++h) lg[h][i] = valid ? a8[h] * 0.08838834764831845f : -3.0e38f; }
#pragma unroll
        for (int h = 0; h < 8; ++h) {
            const float mx = wave_max(fmaxf(fmaxf(lg[h][0], lg[h][1]), fmaxf(lg[h][2], lg[h][3])));
            float e[4]; float sm = 0.f;
#pragma unroll
            for (int i = 0; i < 4; ++i) { e[i] = (lg[h][i] > -1.0e38f) ? __expf(lg[h][i] - mx) : 0.f; sm += e[i]; }
            const float inv = 1.0f / wave_sum(sm);
#pragma unroll
            for (int i = 0; i < 4; ++i) Bs[(lane + 64 * i) * 8 + h] = e[i] * inv;
        }
        LDS_WAIT();
        float o[8][2];
#pragma unroll
        for (int h = 0; h < 8; ++h) { o[h][0] = 0.f; o[h][1] = 0.f; }
        for (int j = 0; j < nsel; ++j) { const int s = Cs[j]; const unsigned vv = *(const GLB unsigned*)(VD + (bm + s) * 128 + 2 * lane); const float v0 = bflo(vv), v1 = bfhi(vv);
            const f32x4 pa = *(const LAS f32x4*)(Bs + j * 8), pb = *(const LAS f32x4*)(Bs + j * 8 + 4);
#pragma unroll
            for (int h = 0; h < 4; ++h) { o[h][0] += pa[h] * v0; o[h][1] += pa[h] * v1; o[4 + h][0] += pb[h] * v0; o[4 + h][1] += pb[h] * v1; } }
#pragma unroll
        for (int h = 0; h < 8; ++h) *(GLB unsigned*)(Y + (size_t)m * 4096 + 2048 + h * 128 + 2 * lane) = pk2(o[h][0], o[h][1]);
        LDS_WAIT();
    }
}
typedef float f32x16 __attribute__((ext_vector_type(16)));
__device__ __forceinline__ int wave_isum(int x) {
    x += __builtin_amdgcn_mov_dpp(x, 0x128, 0xf, 0xf, true); x += __builtin_amdgcn_mov_dpp(x, 0x124, 0xf, 0xf, true);
    x += __builtin_amdgcn_mov_dpp(x, 0x122, 0xf, 0xf, true); x += __builtin_amdgcn_mov_dpp(x, 0x121, 0xf, 0xf, true);
    return __builtin_amdgcn_readlane(x, 0) + __builtin_amdgcn_readlane(x, 16) + __builtin_amdgcn_readlane(x, 32) + __builtin_amdgcn_readlane(x, 48);
}
constexpr size_t WS_SBVT = WS_MIX_END;
constexpr size_t WS_SWVT = WS_SBVT + (size_t)32 * 128 * SEQ * 2;
constexpr size_t WS_VDT = WS_SWVT + (size_t)NB * 2 * 64 * SEQ * 2;
constexpr size_t WS_SC = WS_VDT + (size_t)NB * 128 * SEQ * 2;
constexpr size_t WS_SELB = WS_SC + (size_t)T * SEQ * 4;
constexpr size_t WS_END2 = WS_SELB + (size_t)T * 32 * 8;
constexpr size_t WS_XB = (WS_END2 + 255) & ~(size_t)255;
constexpr size_t WS_END3 = WS_XB + (size_t)T * D * 2;
static_assert(WS_END3 < (size_t)2000 * 1000 * 1000, "workspace budget");

__device__ __forceinline__ void vt_tile(const GLB bf16_t* src, int src_ld, GLB bf16_t* dst, LAS bf16_t* scr, int lane) {
    const int cq = lane & 7, rq = lane >> 3;
    u32x4 v[8];
#pragma unroll
    for (int j = 0; j < 8; ++j) v[j] = *(const GLB u32x4*)(src + (size_t)(rq + 8 * j) * src_ld + 8 * cq);
#pragma unroll
    for (int j = 0; j < 8; ++j) { LAS unsigned* d = (LAS unsigned*)(scr + (rq + 8 * j) * 66 + 8 * cq); d[0] = v[j].x; d[1] = v[j].y; d[2] = v[j].z; d[3] = v[j].w; }
    LDS_WAIT();
#pragma unroll
    for (int j = 0; j < 8; ++j) { const int d = rq + 8 * j; const LAS bf16_t* s = scr + (8 * cq) * 66 + d;
        u32x4 o; o.x = (unsigned)s[0] | ((unsigned)s[66] << 16); o.y = (unsigned)s[2 * 66] | ((unsigned)s[3 * 66] << 16);
        o.z = (unsigned)s[4 * 66] | ((unsigned)s[5 * 66] << 16); o.w = (unsigned)s[6 * 66] | ((unsigned)s[7 * 66] << 16);
        *(GLB u32x4*)(dst + (size_t)d * SEQ + 8 * cq) = o; }
    LDS_WAIT();
}
__device__ __forceinline__ void ph_vt(const Ctx& C) {
    int lane = C.lane; asm volatile("" : "+v"(lane)); lane &= 63;
    LAS bf16_t* scr = (LAS bf16_t*)(C.lds + 65536 + C.wave * 8448);
    for (int it = C.gw; it < 32 * 2 * 32; it += C.NGW) {
        const int sb = it & 31, db = (it >> 5) & 1, bh = it >> 6, b = bh >> 3, h = bh & 7;
        vt_tile(WSP(bf16_t, WS_SBQKV) + ((size_t)b * SEQ + 64 * sb) * 3072 + 2048 + h * 128 + 64 * db, 3072,
                WSP(bf16_t, WS_SBVT) + ((size_t)bh * 128 + 64 * db) * SEQ + 64 * sb, scr, lane);
    }
}

__device__ __forceinline__ void ph_vt_small(const Ctx& C) {
    int lane = C.lane; asm volatile("" : "+v"(lane)); lane &= 63;
    LAS bf16_t* scr = (LAS bf16_t*)(C.lds + C.wave * 8448);
    for (int it = C.gw; it < 512; it += C.NGW) {
        const int sb = it & 31, hd = (it >> 5) & 1, b = (it >> 6) & 3, which = it >> 8;
        if (which == 0) vt_tile(WSP(bf16_t, WS_VS) + ((size_t)b * SEQ + 64 * sb) * 128 + 64 * hd, 128, WSP(bf16_t, WS_SWVT) + ((size_t)(b * 2 + hd) * 64) * SEQ + 64 * sb, scr, lane);
        else vt_tile(WSP(bf16_t, WS_VD) + ((size_t)b * SEQ + 64 * sb) * 128 + 64 * hd, 128, WSP(bf16_t, WS_VDT) + ((size_t)b * 128 + 64 * hd) * SEQ + 64 * sb, scr, lane);
    }
}

#ifndef SB_EXIT_MASS
#define SB_EXIT_MASS 9.094947017729282e-13f
#endif
__device__ __forceinline__ void sb_item(const Ctx& C, int lane, int bh, int qb) {
    const int c = lane & 31, hh = lane >> 5, b = bh >> 3, h = bh & 7, q0 = 32 * qb;
    const GLB bf16_t* QKV = WSP(bf16_t, WS_SBQKV); const GLB bf16_t* VT = WSP(bf16_t, WS_SBVT);
    const GLB bf16_t* qp = QKV + ((size_t)b * SEQ + q0 + c) * 3072 + h * 128 + 8 * hh;
    bf16x8 qf[8];
#pragma unroll
    for (int ks = 0; ks < 8; ++ks) qf[ks] = *(const GLB bf16x8*)(qp + 16 * ks);
    f32x16 O[4];
#pragma unroll
    for (int db = 0; db < 4; ++db)
#pragma unroll
        for (int r = 0; r < 16; ++r) O[db][r] = 0.f;
    float carry = 1.0f;
    const int km = 16 * ((c >> 2) & 1) + 4 * (c >> 3) + (c & 3);
    const GLB bf16_t* kbase = QKV + ((size_t)b * SEQ + km) * 3072 + 1024 + h * 128 + 8 * hh;
    const GLB bf16_t* vbase = VT + ((size_t)bh * 128 + c) * SEQ + 16 * hh;
    bf16x8 kf[8];
#pragma unroll
    for (int ks = 0; ks < 8; ++ks) kf[ks] = *(const GLB bf16x8*)(kbase + (size_t)q0 * 3072 + 16 * ks);
    for (int kt = qb; kt >= 0; --kt) {
        const int k0 = 32 * kt;
        bf16x8 vf[2][4];
#pragma unroll
        for (int s = 0; s < 2; ++s)
#pragma unroll
            for (int db = 0; db < 4; ++db) vf[s][db] = *(const GLB bf16x8*)(vbase + (size_t)(32 * db) * SEQ + k0 + 8 * s);
        f32x16 S;
#pragma unroll
        for (int r = 0; r < 16; ++r) S[r] = 0.f;
#pragma unroll
        for (int ks = 0; ks < 8; ++ks) S = __builtin_amdgcn_mfma_f32_32x32x16_bf16(kf[ks], qf[ks], S, 0, 0, 0);
        if (kt > 0) {
#pragma unroll
            for (int ks = 0; ks < 8; ++ks) kf[ks] = *(const GLB bf16x8*)(kbase + (size_t)(k0 - 32) * 3072 + 16 * ks);
        }
        const bool diag = (kt == qb);
        float w[16]; float sp = 1.0f;
#pragma unroll
        for (int r = 15; r >= 0; --r) {
            const float e = __builtin_amdgcn_exp2f(fminf(S[r] * -0.12751743074602535f, 115.0f)), rr = __builtin_amdgcn_rcpf(1.0f + e), er = e * rr;
            const bool valid = !diag || (16 * hh + r < c);
            const float beta = valid ? rr : 0.f, om = valid ? er : 1.0f;
            w[r] = beta * sp; sp *= om;
        }
        const float tot_other = __shfl_xor(sp, 32);
        const float pre = carry * (hh == 0 ? tot_other : 1.0f);
        carry *= sp * tot_other;
        const bool live = __ballot(carry >= SB_EXIT_MASS) != 0ull;
        bf16x8 pw[2];
#pragma unroll
        for (int s = 0; s < 2; ++s) { u32x4 t; t.x = pk2(w[8 * s] * pre, w[8 * s + 1] * pre); t.y = pk2(w[8 * s + 2] * pre, w[8 * s + 3] * pre);
            t.z = pk2(w[8 * s + 4] * pre, w[8 * s + 5] * pre); t.w = pk2(w[8 * s + 6] * pre, w[8 * s + 7] * pre); pw[s] = __builtin_bit_cast(bf16x8, t); }
#pragma unroll
        for (int s = 0; s < 2; ++s)
#pragma unroll
            for (int db = 0; db < 4; ++db) O[db] = __builtin_amdgcn_mfma_f32_32x32x16_bf16(vf[s][db], pw[s], O[db], 0, 0, 0);
        if (!live) break;
    }
    GLB bf16_t* yp = WSP(bf16_t, WS_Y) + ((size_t)b * SEQ + q0 + c) * 4096 + h * 128 + 4 * hh;
#pragma unroll
    for (int db = 0; db < 4; ++db)
#pragma unroll
        for (int a = 0; a < 4; ++a) { u32x2 o; o.x = pk2(O[db][4 * a], O[db][4 * a + 1]); o.y = pk2(O[db][4 * a + 2], O[db][4 * a + 3]);
            *(GLB u32x2*)(yp + 32 * db + 8 * a) = o; }
}
__device__ __forceinline__ void ph_sb_fast(const Ctx& C) {
    int lane = C.lane; asm volatile("" : "+v"(lane)); lane &= 63;
    const int pi = blockIdx.x * 4 + (C.wave & 3);
    if (pi < 1024) { const int bh = pi >> 5, j = pi & 31; sb_item(C, lane, bh, (C.wave >> 2) ? 63 - j : j); }
}

#ifndef SWA_OUT_OFF
#define SWA_OUT_OFF WS_Y
#endif
__device__ __forceinline__ void swa_item(const Ctx& C, int lane, int l, int b, int h, int tb) {
    const int c = lane & 31, hh = lane >> 5, t0 = 32 * tb, kvh = h >> 3;
    const GLB bf16_t* qp = WSP(bf16_t, WS_QS) + ((size_t)b * SEQ + t0 + c) * 1024 + h * 64 + 8 * hh;
    bf16x8 qf[4];
#pragma unroll
    for (int ks = 0; ks < 4; ++ks) qf[ks] = *(const GLB bf16x8*)(qp + 16 * ks);
    const int km = 16 * ((c >> 2) & 1) + 4 * (c >> 3) + (c & 3);
    const GLB bf16_t* kbase = WSP(bf16_t, WS_KS) + ((size_t)b * SEQ + km) * 128 + kvh * 64 + 8 * hh;
    const GLB bf16_t* vbase = WSP(bf16_t, WS_SWVT) + ((size_t)(b * 2 + kvh) * 64 + c) * SEQ + 16 * hh;
    float mrun = INF32(I_SSINK)[l * 16 + h], lrun = 1.0f;
    f32x16 O[2];
#pragma unroll
    for (int db = 0; db < 2; ++db)
#pragma unroll
        for (int r = 0; r < 16; ++r) O[db][r] = 0.f;
    const int i0 = (tb >= 4) ? 0 : 4 - tb;
    for (int i = i0; i < 5; ++i) {
        const int k0 = t0 - 128 + 32 * i;
        bf16x8 kf[4], vf[2][2];
#pragma unroll
        for (int ks = 0; ks < 4; ++ks) kf[ks] = *(const GLB bf16x8*)(kbase + (size_t)k0 * 128 + 16 * ks);
#pragma unroll
        for (int s = 0; s < 2; ++s)
#pragma unroll
            for (int db = 0; db < 2; ++db) vf[s][db] = *(const GLB bf16x8*)(vbase + (size_t)(32 * db) * SEQ + k0 + 8 * s);
        f32x16 a;
#pragma unroll
        for (int r = 0; r < 16; ++r) a[r] = 0.f;
#pragma unroll
        for (int ks = 0; ks < 4; ++ks) a = __builtin_amdgcn_mfma_f32_32x32x16_bf16(kf[ks], qf[ks], a, 0, 0, 0);
        float tmax = -1.0e30f;
#pragma unroll
        for (int r = 0; r < 16; ++r) { const int kr = 16 * hh + r; const bool valid = (i == 0) ? (kr > c) : ((i == 4) ? (kr <= c) : true); a[r] = valid ? a[r] * 0.125f : -1.0e30f; tmax = fmaxf(tmax, a[r]); }
        tmax = fmaxf(tmax, __shfl_xor(tmax, 32));
        const float mnew = fmaxf(mrun, tmax), alpha = __expf(mrun - mnew);
        float psum = 0.f;
#pragma unroll
        for (int r = 0; r < 16; ++r) { a[r] = __expf(a[r] - mnew); psum += a[r]; }
        psum += __shfl_xor(psum, 32);
        lrun = lrun * alpha + psum; mrun = mnew;
#pragma unroll
        for (int db = 0; db < 2; ++db)
#pragma unroll
            for (int r = 0; r < 16; ++r) O[db][r] *= alpha;
#pragma unroll
        for (int s = 0; s < 2; ++s) {
            u32x4 t; t.x = pk2(a[8 * s], a[8 * s + 1]); t.y = pk2(a[8 * s + 2], a[8 * s + 3]); t.z = pk2(a[8 * s + 4], a[8 * s + 5]); t.w = pk2(a[8 * s + 6], a[8 * s + 7]);
            const bf16x8 pw = __builtin_bit_cast(bf16x8, t);
#pragma unroll
            for (int db = 0; db < 2; ++db) O[db] = __builtin_amdgcn_mfma_f32_32x32x16_bf16(vf[s][db], pw, O[db], 0, 0, 0);
        }
    }
    const float inv = 1.0f / lrun;
    GLB bf16_t* yp = WSP(bf16_t, SWA_OUT_OFF) + ((size_t)b * SEQ + t0 + c) * 4096 + 3072 + h * 64 + 4 * hh;
#pragma unroll
    for (int db = 0; db < 2; ++db)
#pragma unroll
        for (int a4 = 0; a4 < 4; ++a4) { u32x2 o; o.x = pk2(O[db][4 * a4] * inv, O[db][4 * a4 + 1] * inv); o.y = pk2(O[db][4 * a4 + 2] * inv, O[db][4 * a4 + 3] * inv);
            *(GLB u32x2*)(yp + 32 * db + 8 * a4) = o; }
}
__device__ __forceinline__ void ph_swa_fast(const Ctx& C, int l) {
    int lane = C.lane; asm volatile("" : "+v"(lane)); lane &= 63;
    if (C.wave >= 4) return;
    for (int it = blockIdx.x * 4 + C.wave; it < NB * 64 * 16; it += C.G * 4) { const int h = it & 15, tb = (it >> 4) & 63, b = it >> 10; swa_item(C, lane, l, b, h, tb); }
}

__device__ __forceinline__ float row16_sum(float x) {
    x += __builtin_bit_cast(float, __builtin_amdgcn_mov_dpp(__builtin_bit_cast(int, x), 0x128, 0xf, 0xf, true));
    x += __builtin_bit_cast(float, __builtin_amdgcn_mov_dpp(__builtin_bit_cast(int, x), 0x124, 0xf, 0xf, true));
    x += __builtin_bit_cast(float, __builtin_amdgcn_mov_dpp(__builtin_bit_cast(int, x), 0x122, 0xf, 0xf, true));
    x += __builtin_bit_cast(float, __builtin_amdgcn_mov_dpp(__builtin_bit_cast(int, x), 0x121, 0xf, 0xf, true));
    return x;
}
__device__ __forceinline__ void ph_rwkv_scan_fast(const Ctx& C) {
    int tid = C.tid; asm volatile("" : "+v"(tid));
    const int lane = tid & 63, wave = C.wave;
    LAS float* buf = (LAS float*)C.lds;
    constexpr int CH = 32, CHF = CH * 384;
    for (int it = blockIdx.x; it < NB * 16 * 4; it += C.G) {
        const int qr = it & 3, h = (it >> 2) & 15, b = it >> 6;
        const size_t gbase = (size_t)b * SEQ * 1024 + h * 64;
        const int ro = lane >> 4, kq = lane & 15, row = 16 * qr + 4 * (wave & 3) + ro;
        float S0 = 0.f, S1 = 0.f, S2 = 0.f, S3 = 0.f;
        const int lj = tid - 256;
        auto load_chunk = [&](int cidx) {
            f32x4 v[12];
#pragma unroll
            for (int i = 0; i < 12; ++i) { const int idx = lj + 256 * i, step = idx / 96, rem = idx - step * 96, vec = rem >> 4, e4 = rem & 15;
                const size_t off = (vec == 0) ? WS_R : (vec == 1) ? WS_DEC : (vec == 2) ? WS_K : (vec == 3) ? WS_KK : (vec == 4) ? WS_AA : WS_V;
                v[i] = *(const GLB f32x4*)(WSP(float, off) + gbase + (size_t)(cidx * CH + step) * 1024 + 4 * e4); }
            LAS float* d = buf + (cidx & 1) * CHF;
#pragma unroll
            for (int i = 0; i < 12; ++i) { const int idx = lj + 256 * i, step = idx / 96, rem = idx - step * 96; *(LAS f32x4*)(d + step * 384 + rem * 4) = v[i]; }
        };
        if (wave >= 4) load_chunk(0);
        LDS_WAIT(); __syncthreads();
        for (int cidx = 0; cidx < SEQ / CH; ++cidx) {
            if (wave >= 4) { if (cidx + 1 < SEQ / CH) load_chunk(cidx + 1); }
            else {
                const LAS float* cb = buf + (cidx & 1) * CHF;
#pragma unroll 4
                for (int st = 0; st < CH; ++st) {
                    const LAS float* rb = cb + st * 384;
                    const f32x4 kk4 = *(const LAS f32x4*)(rb + 192 + 4 * kq);
                    const float p = row16_sum(S0 * kk4[0] + S1 * kk4[1] + S2 * kk4[2] + S3 * kk4[3]);
                    const f32x4 w4 = *(const LAS f32x4*)(rb + 64 + 4 * kq), b4 = *(const LAS f32x4*)(rb + 256 + 4 * kq), k4 = *(const LAS f32x4*)(rb + 128 + 4 * kq), r4 = *(const LAS f32x4*)(rb + 4 * kq);
                    const float vv = rb[320 + row];
                    S0 = S0 * w4[0] - p * b4[0] + vv * k4[0]; S1 = S1 * w4[1] - p * b4[1] + vv * k4[1]; S2 = S2 * w4[2] - p * b4[2] + vv * k4[2]; S3 = S3 * w4[3] - p * b4[3] + vv * k4[3];
                    const float y = row16_sum(S0 * r4[0] + S1 * r4[1] + S2 * r4[2] + S3 * r4[3]);
                    if (kq == 0) WSP(float, WS_YRAW)[gbase + (size_t)(cidx * CH + st) * 1024 + row] = y;
                }
            }
            LDS_WAIT(); __syncthreads();
        }
    }
}

__device__ __forceinline__ void dsa_item(const Ctx& C, int lane, int wave, int b, int g, int layer) {
    const int c = lane & 31, hh = lane >> 5, t0 = 4 * g;
    LAS float* sc = (LAS float*)(C.lds + wave * 17408);
    LAS unsigned* bm = (LAS unsigned*)(C.lds + wave * 17408 + 16384);
    const size_t bm0 = (size_t)b * SEQ;
    const int ntile = (t0 + 3) / 32 + 1;
    const int hw = wave >> 2, wq = wave & 3;
    volatile LAS unsigned* cnt = (volatile LAS unsigned*)(C.lds + MISC_OFF + 128 + 4 * hw);
    unsigned target = (unsigned)layer * 4u * (unsigned)(ntile + 6);
    auto arrive = [&]() { asm volatile("s_waitcnt vmcnt(0) lgkmcnt(0)" ::: "memory"); if (lane == 0) (void)__hip_atomic_fetch_add((LAS unsigned*)(C.lds + MISC_OFF + 128 + 4 * hw), 1u, __ATOMIC_RELAXED, __HIP_MEMORY_SCOPE_WORKGROUP); };
    auto wait_all = [&]() { target += 4u; while ((int)(*cnt - target) < 0) __builtin_amdgcn_s_sleep(1); asm volatile("" ::: "memory"); };
#pragma unroll 1
    for (int p = 0; p < 2; ++p) {
        {
            arrive(); wait_all();
            const int hd = (c & 3) + 4 * (c >> 3);
            bf16x8 qf[4][4]; f32x4 w4[4][4];
#pragma unroll
            for (int j = 0; j < 4; ++j) { const int t0j = t0 + 4 * (hw ? (wq - j) : (j - wq));
                const GLB bf16_t* qp = WSP(bf16_t, WS_QI) + (bm0 + t0j + 2 * p + ((c >> 2) & 1)) * 1024 + hd * 64 + 8 * hh;
                const GLB float* wp = WSP(float, WS_WI) + (bm0 + t0j + 2 * p + hh) * 16;
#pragma unroll
                for (int ks = 0; ks < 4; ++ks) { qf[j][ks] = *(const GLB bf16x8*)(qp + 16 * ks); w4[j][ks] = *(const GLB f32x4*)(wp + 4 * ks); } }
            const GLB bf16_t* kp = WSP(bf16_t, WS_KI) + (bm0 + c) * 64 + 8 * hh;
            bf16x8 kf[4];
            if (wq < ntile) {
#pragma unroll
                for (int ks = 0; ks < 4; ++ks) kf[ks] = *(const GLB bf16x8*)(kp + (size_t)(32 * wq) * 64 + 16 * ks);
            }
            for (int kt = wq; kt < ntile; kt += 4) {
                f32x16 a[4];
#pragma unroll
                for (int j = 0; j < 4; ++j)
#pragma unroll
                    for (int r = 0; r < 16; ++r) a[j][r] = 0.f;
#pragma unroll
                for (int ks = 0; ks < 4; ++ks)
#pragma unroll
                    for (int j = 0; j < 4; ++j) a[j] = __builtin_amdgcn_mfma_f32_32x32x16_bf16(qf[j][ks], kf[ks], a[j], 0, 0, 0);
                if (kt + 4 < ntile) {
#pragma unroll
                    for (int ks = 0; ks < 4; ++ks) kf[ks] = *(const GLB bf16x8*)(kp + (size_t)(32 * (kt + 4)) * 64 + 16 * ks);
                }
#pragma unroll
                for (int j = 0; j < 4; ++j) { float s = 0.f;
#pragma unroll
                    for (int r = 0; r < 16; ++r) s += w4[j][r >> 2][r & 3] * fmaxf(a[j][r], 0.f);
                    ((LAS float*)(C.lds + (4 * hw + j) * 17408))[hh * 2048 + 32 * kt + c] = s; }
            }
            arrive(); wait_all();
        }
        LDS_WAIT();
#pragma unroll 1
        for (int qs = 0; qs < 2; ++qs) {
            const int t = t0 + 2 * p + qs, n = t + 1;
            const LAS float* sq = sc + qs * 2048;
            unsigned myword_lo = 0u, myword_hi = 0u;
            if (n <= 256) {
#pragma unroll
                for (int i = 0; i < 4; ++i) { const unsigned long long bal = __ballot(lane + 64 * i < n); if (lane == i) { myword_lo = (unsigned)bal; myword_hi = (unsigned)(bal >> 32); } }
            } else {
                unsigned key[32];
#pragma unroll
                for (int i = 0; i < 32; ++i) { const int s = lane + 64 * i; key[i] = (s < n) ? ordkey(sq[s]) : 0u; }
                unsigned tau = 0u;
                for (int bit = 31; bit >= 0; --bit) {
                    const unsigned cand = tau | (1u << bit); int cl = 0;
#pragma unroll
                    for (int i = 0; i < 32; ++i) cl += (key[i] >= cand) ? 1 : 0;
                    const int cnt = wave_isum(cl);
                    if (cnt >= 256) { tau = cand; if (cnt == 256) break; }
                }
                int cgl = 0;
#pragma unroll
                for (int i = 0; i < 32; ++i) cgl += (key[i] > tau) ? 1 : 0;
                const int cgt = wave_isum(cgl);
                const int need = 256 - cgt; int eqbase = 0;
                const unsigned long long lt = (1ull << lane) - 1ull;
#pragma unroll
                for (int i = 0; i < 32; ++i) {
                    const bool gt = key[i] > tau, eq = key[i] == tau;
                    const unsigned long long beq = __ballot(eq);
                    const bool sel = gt || (eq && (eqbase + __popcll(beq & lt)) < need);
                    const unsigned long long bal = __ballot(sel);
                    if (lane == i) { myword_lo = (unsigned)bal; myword_hi = (unsigned)(bal >> 32); }
                    eqbase += __popcll(beq);
                }
            }
            if (lane < 32) { bm[(2 * p + qs) * 64 + 2 * lane] = myword_lo; bm[(2 * p + qs) * 64 + 2 * lane + 1] = myword_hi; }
        }
        LDS_WAIT();
    }
    const int cq = c >> 3, ch = c & 7;
    const GLB bf16_t* qp = WSP(bf16_t, WS_QD) + (bm0 + t0 + cq) * 1024 + ch * 128 + 8 * hh;
    bf16x8 qf[8];
#pragma unroll
    for (int ks = 0; ks < 8; ++ks) qf[ks] = *(const GLB bf16x8*)(qp + 16 * ks);
    const int km = 16 * ((c >> 2) & 1) + 4 * (c >> 3) + (c & 3);
    const GLB bf16_t* kbase = WSP(bf16_t, WS_KD) + (bm0 + km) * 128 + 8 * hh;
    const GLB bf16_t* vbase = WSP(bf16_t, WS_VDT) + ((size_t)b * 128 + c) * SEQ + 16 * hh;
    const LAS unsigned short* bmh = (const LAS unsigned short*)(bm + cq * 64) + hh;
    float mrun = -1.0e20f, lrun = 0.f;
    f32x16 O[4];
#pragma unroll
    for (int db = 0; db < 4; ++db)
#pragma unroll
        for (int r = 0; r < 16; ++r) O[db][r] = 0.f;
    const GLB char* kg = (const GLB char*)(WSP(bf16_t, WS_KD) + bm0 * 128);
    const GLB char* vg = (const GLB char*)(WSP(bf16_t, WS_VDT) + (size_t)b * 128 * SEQ);
    auto stage = [&](int kt) {
        LAS char* tb = (LAS char*)(C.lds + (4 * hw + kt % 3) * 17408);
#pragma unroll
        for (int i = 0; i < 2; ++i) { const int r = 8 * wq + 4 * i + (lane >> 4), pch = lane & 15, key = (r & 7) + 8 * (r >> 4);
            __builtin_amdgcn_global_load_lds((const GLB unsigned*)(kg + ((size_t)(32 * kt + r) * 256 + 16 * (pch ^ key))), (LAS unsigned*)(tb + (8 * wq + 4 * i) * 256), 16, 0, 0); }
#pragma unroll
        for (int i = 0; i < 2; ++i) { const int d = 32 * wq + 16 * i + (lane >> 2), pch = lane & 3, key = (d >> 2) & 3;
            __builtin_amdgcn_global_load_lds((const GLB unsigned*)(vg + ((size_t)d * (SEQ * 2) + 64 * kt + 16 * (pch ^ key))), (LAS unsigned*)(tb + 8192 + (32 * wq + 16 * i) * 64), 16, 0, 0); }
    };
    arrive(); wait_all();
    stage(0); if (ntile > 1) stage(1);
    arrive();
    const int kkey = (km & 7) + 8 * (km >> 4);
    for (int kt = 0; kt < ntile; ++kt) {
        wait_all();
        const LAS char* tb = (const LAS char*)(C.lds + (4 * hw + kt % 3) * 17408);
        bf16x8 kf[8], vf[2][4];
#pragma unroll
        for (int ks = 0; ks < 8; ++ks) kf[ks] = *(const LAS bf16x8*)(tb + km * 256 + 16 * ((hh + 2 * ks) ^ kkey));
#pragma unroll
        for (int s = 0; s < 2; ++s)
#pragma unroll
            for (int db = 0; db < 4; ++db) { const int d = c + 32 * db; vf[s][db] = *(const LAS bf16x8*)(tb + 8192 + d * 64 + 16 * ((2 * hh + s) ^ ((d >> 2) & 3))); }
        const unsigned bits = bmh[2 * kt];
        asm volatile("s_waitcnt lgkmcnt(0)" ::: "memory");
        if (kt + 2 < ntile) stage(kt + 2);
        f32x16 a;
#pragma unroll
        for (int r = 0; r < 16; ++r) a[r] = 0.f;
#pragma unroll
        for (int ks = 0; ks < 8; ++ks) a = __builtin_amdgcn_mfma_f32_32x32x16_bf16(kf[ks], qf[ks], a, 0, 0, 0);
        float tmax = -1.0e30f;
#pragma unroll
        for (int r = 0; r < 16; ++r) { const float x = a[r] * 0.12751743074602535f; const int mk = (int)(bits << (31 - r)) >> 31;
            a[r] = __builtin_bit_cast(float, (__builtin_bit_cast(int, x) & mk) | (~mk & (int)0xF149F2CAu)); tmax = fmaxf(tmax, a[r]); }
        tmax = fmaxf(tmax, __shfl_xor(tmax, 32));
        if (__ballot(tmax > mrun + 11.541560327111707f) != 0ull) {
            const float mnew = fmaxf(mrun, tmax), alpha = __builtin_amdgcn_exp2f(mrun - mnew);
            lrun *= alpha; mrun = mnew;
#pragma unroll
            for (int db = 0; db < 4; ++db)
#pragma unroll
                for (int r = 0; r < 16; ++r) O[db][r] *= alpha;
        }
        float psum = 0.f;
#pragma unroll
        for (int r = 0; r < 16; ++r) { a[r] = __builtin_amdgcn_exp2f(a[r] - mrun); psum += a[r]; }
        psum += __shfl_xor(psum, 32);
        lrun += psum;
#pragma unroll
        for (int s = 0; s < 2; ++s) {
            u32x4 t; t.x = pk2(a[8 * s], a[8 * s + 1]); t.y = pk2(a[8 * s + 2], a[8 * s + 3]); t.z = pk2(a[8 * s + 4], a[8 * s + 5]); t.w = pk2(a[8 * s + 6], a[8 * s + 7]);
            const bf16x8 pw = __builtin_bit_cast(bf16x8, t);
#pragma unroll
            for (int db = 0; db < 4; ++db) O[db] = __builtin_amdgcn_mfma_f32_32x32x16_bf16(vf[s][db], pw, O[db], 0, 0, 0);
        }
        arrive();
    }
    const float inv = 1.0f / lrun;
    GLB bf16_t* yp = WSP(bf16_t, WS_Y) + (bm0 + t0 + cq) * 4096 + 2048 + ch * 128 + 4 * hh;
#pragma unroll
    for (int db = 0; db < 4; ++db)
#pragma unroll
        for (int a4 = 0; a4 < 4; ++a4) { u32x2 o; o.x = pk2(O[db][4 * a4] * inv, O[db][4 * a4 + 1] * inv); o.y = pk2(O[db][4 * a4 + 2] * inv, O[db][4 * a4 + 3] * inv);
            *(GLB u32x2*)(yp + 32 * db + 8 * a4) = o; }
    LDS_WAIT();
}
__device__ __forceinline__ void ph_dsa_fast(const Ctx& C, int l) {
    int lane = C.lane; asm volatile("" : "+v"(lane)); lane &= 63;
    const int pi = blockIdx.x * 4 + (C.wave & 3);
    if (pi < 1024) { const int b = pi >> 8, j = pi & 255; dsa_item(C, lane, C.wave, b, (C.wave >> 2) ? 511 - j : j, l); }
}

constexpr int SCAN_CNT_OFF = MISC_OFF + 64;
__device__ __forceinline__ void ph_rwkv_scan_conv(const Ctx& C, int l) {
    int tid = C.tid; asm volatile("" : "+v"(tid));
    const int lane = tid & 63, wave = C.wave;
    if (wave >= 4) {
        LAS float* scr = (LAS float*)(C.lds + 65536 + (wave - 4) * 16640);
        constexpr int PER = MOE_CONV_ITEMS / 2 / 1024;
        const int first = l * (MOE_CONV_ITEMS / 2) + (blockIdx.x * 4 + (wave - 4)) * PER;
        if (!MOE_CONV_IN_PROLOGUE && blockIdx.x < 256)
            for (int i = 0; i < PER; ++i) conv_moe_item(C, first + i, scr, lane);
        return;
    }
    constexpr int CH = 16, CHF = CH * 384, NCH = SEQ / CH;
    LAS float* buf = (LAS float*)C.lds;
    volatile LAS unsigned* cnt = (volatile LAS unsigned*)(C.lds + SCAN_CNT_OFF);
    const int it = blockIdx.x;
    if (it >= NB * 16 * 4) return;
    const int qr = it & 3, h = (it >> 2) & 15, b = it >> 6;
    const size_t gbase = (size_t)b * SEQ * 1024 + h * 64;
    const int ro = lane >> 4, kq = lane & 15, row = 16 * qr + 4 * wave + ro;
    unsigned target = (unsigned)l * 4u * (NCH + 1);
    auto issue = [&](int cidx) {
#pragma unroll
        for (int j = 0; j < 6; ++j) { const int i = wave + 4 * j, rho = 4 * i + ro, step = rho / 6, vec = rho - 6 * step;
            const size_t off = (vec == 0) ? WS_R : (vec == 1) ? WS_DEC : (vec == 2) ? WS_K : (vec == 3) ? WS_KK : (vec == 4) ? WS_AA : WS_V;
            const GLB float* src = WSP(float, off) + gbase + (size_t)(cidx * CH + step) * 1024 + 4 * kq;
            __builtin_amdgcn_global_load_lds((const GLB unsigned*)src, (LAS unsigned*)(buf + (cidx & 1) * CHF + i * 256), 16, 0, 0); }
    };
    auto arrive_wait = [&]() {
        asm volatile("s_waitcnt vmcnt(0)" ::: "memory");
        target += 4u;
        if (lane == 0) (void)__hip_atomic_fetch_add((LAS unsigned*)(C.lds + SCAN_CNT_OFF), 1u, __ATOMIC_RELAXED, __HIP_MEMORY_SCOPE_WORKGROUP);
        while ((int)(*cnt - target) < 0) __builtin_amdgcn_s_sleep(1);
        asm volatile("" ::: "memory");
    };
    float S0 = 0.f, S1 = 0.f, S2 = 0.f, S3 = 0.f;
    issue(0); arrive_wait();
    for (int cidx = 0; cidx < NCH; ++cidx) {
        if (cidx + 1 < NCH) issue(cidx + 1);
        const LAS float* cb = buf + (cidx & 1) * CHF;
#pragma unroll 4
        for (int st = 0; st < CH; ++st) {
            const LAS float* rb = cb + st * 384;
            const f32x4 kk4 = *(const LAS f32x4*)(rb + 192 + 4 * kq);
            const float p = row16_sum(S0 * kk4[0] + S1 * kk4[1] + S2 * kk4[2] + S3 * kk4[3]);
            const f32x4 w4 = *(const LAS f32x4*)(rb + 64 + 4 * kq), b4 = *(const LAS f32x4*)(rb + 256 + 4 * kq), k4 = *(const LAS f32x4*)(rb + 128 + 4 * kq), r4 = *(const LAS f32x4*)(rb + 4 * kq);
            const float vv = rb[320 + row];
            S0 = S0 * w4[0] - p * b4[0] + vv * k4[0]; S1 = S1 * w4[1] - p * b4[1] + vv * k4[1]; S2 = S2 * w4[2] - p * b4[2] + vv * k4[2]; S3 = S3 * w4[3] - p * b4[3] + vv * k4[3];
            const float y = row16_sum(S0 * r4[0] + S1 * r4[1] + S2 * r4[2] + S3 * r4[3]);
            if (kq == 0) WSP(float, WS_YRAW)[gbase + (size_t)(cidx * CH + st) * 1024 + row] = y;
        }
        asm volatile("s_waitcnt lgkmcnt(0)" ::: "memory");
        arrive_wait();
    }
}

#ifndef SCAN3_CONV_MODE
#define SCAN3_CONV_MODE 0
#endif
#ifndef CONV_NT
#define CONV_NT 0
#endif
__device__ __forceinline__ void conv_tile_load(const GLB float* W, int ldw, int k0, int s0, f32x4 (&v)[16], int lane) {
    const int cq = lane & 15, rq = lane >> 4;
    const unsigned loff = (unsigned)(rq * ldw + 4 * cq);
    const GLB float* base = W + (size_t)k0 * ldw + s0;
#pragma unroll
    for (int i = 0; i < 16; ++i) { const GLB float* rowp = base + (size_t)(4 * i) * ldw; v[i] = CONV_NT ? __builtin_nontemporal_load((const GLB f32x4*)(rowp + loff)) : *(const GLB f32x4*)(rowp + loff); }
}
__device__ __forceinline__ void conv_tile_to_lds(const f32x4 (&v)[16], LAS float* scr, int lane) {
    const int cq = lane & 15, rq = lane >> 4;
#pragma unroll
    for (int i = 0; i < 16; ++i) { const int kk = 4 * i + rq; LAS float* d = scr + kk * 65 + 4 * cq; d[0] = v[i][0]; d[1] = v[i][1]; d[2] = v[i][2]; d[3] = v[i][3]; }
}
__device__ __forceinline__ void conv_tile_from_lds(GLB bf16_t* Bt, int K, int n0, int k0, LAS float* scr, int lane) {
    const int c = lane & 7;
#pragma unroll
    for (int j = 0; j < 8; ++j) { const int n = (lane >> 3) + 8 * j; const LAS float* s = scr + (8 * c) * 65 + n;
        u32x4 o; o.x = pk2(s[0 * 65], s[1 * 65]); o.y = pk2(s[2 * 65], s[3 * 65]); o.z = pk2(s[4 * 65], s[5 * 65]); o.w = pk2(s[6 * 65], s[7 * 65]);
        if (CONV_NT & 2) __builtin_nontemporal_store(o, (GLB u32x4*)(Bt + (size_t)(n0 + n) * K + k0 + 8 * c)); else *(GLB u32x4*)(Bt + (size_t)(n0 + n) * K + k0 + 8 * c) = o; }
}
__device__ __forceinline__ void conv_tile_finish(const f32x4 (&v)[16], GLB bf16_t* Bt, int K, int n0, int k0, LAS float* scr, int lane) {
    conv_tile_to_lds(v, scr, lane); LDS_WAIT(); conv_tile_from_lds(Bt, K, n0, k0, scr, lane); LDS_WAIT();
}
struct MoeTile { const GLB float* W; GLB bf16_t* Bt; int ldw, K, k0, s0, n0; };
__device__ __forceinline__ MoeTile moe_tile_desc(const Ctx& C, int idx) {
    constexpr int I_GU1 = (D / 64) * (2 * FF / 64), I_DN1 = (FF / 64) * (D / 64);
    MoeTile t;
    if (idx < NE * I_GU1) {
        const int e = idx / I_GU1, r = idx % I_GU1, nb = r % (2 * FF / 64), kb = r / (2 * FF / 64), tile = nb >> 2, q = nb & 3;
        t.W = ((q < 2) ? INF32(I_MG) : INF32(I_MU)) + (size_t)e * D * FF; t.ldw = FF; t.k0 = 64 * kb; t.s0 = 128 * tile + 64 * (q & 1);
        t.Bt = WSP(bf16_t, WS_MWGU) + (size_t)e * 2 * FF * D; t.K = D; t.n0 = 64 * nb;
    } else {
        const int r0 = idx - NE * I_GU1, e = r0 / I_DN1, r = r0 % I_DN1, nb = r % 32, kb = r / 32;
        t.W = INF32(I_MD) + (size_t)e * FF * D; t.ldw = D; t.k0 = 64 * kb; t.s0 = 64 * nb; t.Bt = WSP(bf16_t, WS_MWD) + (size_t)e * D * FF; t.K = FF; t.n0 = 64 * nb;
    }
    return t;
}
__device__ __forceinline__ void ph_rwkv_scan4(const Ctx& C, int l) {
    int tid = C.tid; asm volatile("" : "+v"(tid));
    const int lane = tid & 63, wave = C.wave;
    if (wave >= 4) {
        if (MOE_CONV_IN_PROLOGUE || blockIdx.x >= 256) return;
        LAS float* scr = (LAS float*)(C.lds + 65536 + (wave - 4) * 16640);
        constexpr int PER = MOE_CONV_ITEMS / 2 / 1024;
        const int first = l * (MOE_CONV_ITEMS / 2) + (blockIdx.x * 4 + (wave - 4)) * PER;
        f32x4 va[16], vb[16];
        MoeTile ta = moe_tile_desc(C, first), tb;
        conv_tile_load(ta.W, ta.ldw, ta.k0, ta.s0, va, lane);
        for (int i = 0; i < PER; i += 2) {
            tb = moe_tile_desc(C, first + i + 1);
            conv_tile_load(tb.W, tb.ldw, tb.k0, tb.s0, vb, lane);
            conv_tile_finish(va, ta.Bt, ta.K, ta.n0, ta.k0, scr, lane);
            if (i + 2 < PER) { ta = moe_tile_desc(C, first + i + 2); conv_tile_load(ta.W, ta.ldw, ta.k0, ta.s0, va, lane); }
            conv_tile_finish(vb, tb.Bt, tb.K, tb.n0, tb.k0, scr, lane);
        }
        return;
    }
    constexpr int CH = 16, CHF = CH * 384, NCH = SEQ / CH;
    LAS float* buf = (LAS float*)C.lds;
    LAS float* ybuf = (LAS float*)(C.lds + 49152);
    volatile LAS unsigned* cnt = (volatile LAS unsigned*)(C.lds + SCAN_CNT_OFF);
    const int it = blockIdx.x;
    if (it >= NB * 16 * 4) return;
    const int qr = it & 3, h = (it >> 2) & 15, b = it >> 6;
    const size_t gbase = (size_t)b * SEQ * 1024 + h * 64;
    const int ro = lane >> 4, kq = lane & 15, rloc = 4 * wave + ro;
    unsigned target = (unsigned)l * 4u * (NCH + 1);
    auto issue = [&](int cidx) {
#pragma unroll
        for (int j = 0; j < 6; ++j) { const int i = wave + 4 * j, rho = 4 * i + ro, step = rho / 6, vec = rho - 6 * step;
            const size_t off = (vec == 0) ? WS_R : (vec == 1) ? WS_DEC : (vec == 2) ? WS_K : (vec == 3) ? WS_KK : (vec == 4) ? WS_AA : WS_V;
            const GLB float* src = WSP(float, off) + gbase + (size_t)(cidx * CH + step) * 1024 + 4 * kq;
            __builtin_amdgcn_global_load_lds((const GLB unsigned*)src, (LAS unsigned*)(buf + (cidx & 1) * CHF + i * 256), 16, 0, 0); }
    };
    auto arrive_wait = [&]() {
        asm volatile("s_waitcnt vmcnt(0) lgkmcnt(0)" ::: "memory");
        target += 4u;
        if (lane == 0) (void)__hip_atomic_fetch_add((LAS unsigned*)(C.lds + SCAN_CNT_OFF), 1u, __ATOMIC_RELAXED, __HIP_MEMORY_SCOPE_WORKGROUP);
        while ((int)(*cnt - target) < 0) __builtin_amdgcn_s_sleep(1);
        asm volatile("" ::: "memory");
    };
    auto flush_y = [&](int cidx) {
        const int st = lane >> 2, r = lane & 3;
        WSP(float, WS_YRAW)[gbase + (size_t)(cidx * CH + st) * 1024 + 16 * qr + 4 * wave + r] = ybuf[(cidx & 1) * 256 + st * 16 + 4 * wave + r];
    };
    f32x2 Sa = {0.f, 0.f}, Sb = {0.f, 0.f};
    issue(0); arrive_wait();
    for (int cidx = 0; cidx < NCH; ++cidx) {
        if (cidx > 0) flush_y(cidx - 1);
        if (cidx + 1 < NCH) issue(cidx + 1);
        const LAS float* cb = buf + (cidx & 1) * CHF;
        LAS float* yb = ybuf + (cidx & 1) * 256;
#pragma unroll 4
        for (int st = 0; st < CH; ++st) {
            const LAS float* rb = cb + st * 384;
            const f32x4 kk4 = *(const LAS f32x4*)(rb + 192 + 4 * kq);
            const f32x2 tp = Sa * (f32x2){kk4[0], kk4[1]} + Sb * (f32x2){kk4[2], kk4[3]};
            const float p = row16_sum(tp[0] + tp[1]);
            const f32x4 w4 = *(const LAS f32x4*)(rb + 64 + 4 * kq), b4 = *(const LAS f32x4*)(rb + 256 + 4 * kq), k4 = *(const LAS f32x4*)(rb + 128 + 4 * kq), r4 = *(const LAS f32x4*)(rb + 4 * kq);
            const float vv = rb[320 + 16 * qr + rloc];
            const f32x2 pp = {p, p}, vv2 = {vv, vv};
            Sa = Sa * (f32x2){w4[0], w4[1]} - pp * (f32x2){b4[0], b4[1]} + vv2 * (f32x2){k4[0], k4[1]};
            Sb = Sb * (f32x2){w4[2], w4[3]} - pp * (f32x2){b4[2], b4[3]} + vv2 * (f32x2){k4[2], k4[3]};
            const f32x2 ty = Sa * (f32x2){r4[0], r4[1]} + Sb * (f32x2){r4[2], r4[3]};
            const float y = row16_sum(ty[0] + ty[1]);
            if (kq == 0) yb[st * 16 + rloc] = y;
        }
        arrive_wait();
    }
    flush_y(NCH - 1);
}

#ifndef SCAN_TOUCH
#define SCAN_TOUCH 1
#endif
#ifndef SCAN_SCHED
#define SCAN_SCHED 1
#endif
#ifndef SCAN_UNROLL
#define SCAN_UNROLL 4
#endif
__device__ __forceinline__ void ph_rwkv_scan3(const Ctx& C, int l) {
    int tid = C.tid; asm volatile("" : "+v"(tid));
    const int lane = tid & 63, wave = C.wave;
    constexpr int CH = 16, CHF = CH * 384, NCH = SEQ / CH;
    LAS float* buf = (LAS float*)C.lds;
    LAS float* ybuf = (LAS float*)(C.lds + 49152);
    LAS float* scr = (LAS float*)(C.lds + 65536 + (wave & 3) * 16640);
    const int it = blockIdx.x;
    if (it >= NB * 16 * 4) return;
    const int qr = it & 3, h = (it >> 2) & 15, b = it >> 6;
    const size_t gbase = (size_t)b * SEQ * 1024 + h * 64;
    const int ro = lane >> 4, kq = lane & 15, rloc = 4 * (wave & 3) + ro;
    const int lj = tid - 256;
    constexpr int PER = MOE_CONV_ITEMS / 2 / 1024;
    static_assert(PER * 1024 * 2 == MOE_CONV_ITEMS && PER * 3 <= NCH, "conversion slots");
    const int cfirst = l * (MOE_CONV_ITEMS / 2) + (blockIdx.x * 4 + (wave & 3)) * PER;
    auto load_chunk = [&](int cidx) {
        f32x4 v[6];
#pragma unroll
        for (int i = 0; i < 6; ++i) { const int idx = lj + 256 * i, step = idx / 96, rem = idx - step * 96, vec = rem >> 4, e4 = rem & 15;
            const size_t off = (vec == 0) ? WS_R : (vec == 1) ? WS_DEC : (vec == 2) ? WS_K : (vec == 3) ? WS_KK : (vec == 4) ? WS_AA : WS_V;
            v[i] = *(const GLB f32x4*)(WSP(float, off) + gbase + (size_t)(cidx * CH + step) * 1024 + 4 * e4); }
        LAS float* d = buf + (cidx & 1) * CHF;
#pragma unroll
        for (int i = 0; i < 6; ++i) { const int idx = lj + 256 * i, step = idx / 96, rem = idx - step * 96; *(LAS f32x4*)(d + step * 384 + rem * 4) = v[i]; }
    };
    auto flush_y = [&](int cidx) {
        const int st = lj >> 4, r = lj & 15;
        WSP(float, WS_YRAW)[gbase + (size_t)(cidx * CH + st) * 1024 + 16 * qr + r] = ybuf[(cidx & 1) * 256 + lj];
    };
    f32x2 Sa = {0.f, 0.f}, Sb = {0.f, 0.f};
    f32x4 cv[16]; MoeTile ct; ct.W = nullptr; ct.Bt = nullptr; ct.ldw = 0; ct.K = 0; ct.k0 = 0; ct.s0 = 0; ct.n0 = 0;
#pragma unroll
    for (int i = 0; i < 16; ++i) cv[i] = (f32x4){0.f, 0.f, 0.f, 0.f};
    if (wave >= 4) load_chunk(0);
    LDS_WAIT(); __syncthreads();
    for (int cidx = 0; cidx < NCH; ++cidx) {
        if (wave >= 4) {
            if (cidx + 1 < NCH) load_chunk(cidx + 1);
            if (cidx > 0) flush_y(cidx - 1);
            if (!MOE_CONV_IN_PROLOGUE) {
                const int q3 = cidx / 3, r3 = cidx - 3 * q3;
                if (r3 == 0 && q3 < PER) { ct = moe_tile_desc(C, cfirst + q3); conv_tile_load(ct.W, ct.ldw, ct.k0, ct.s0, cv, lane); }
                else if (r3 == 1 && q3 < PER) conv_tile_finish(cv, ct.Bt, ct.K, ct.n0, ct.k0, scr, lane);
            }
        } else {
            const LAS float* cb = buf + (cidx & 1) * CHF;
            LAS float* yb = ybuf + (cidx & 1) * 256;
            __builtin_amdgcn_s_setprio(3);
#pragma unroll SCAN_UNROLL
            for (int st = 0; st < CH; ++st) {
                const LAS float* rb = cb + st * 384;
                const f32x4 kk4 = *(const LAS f32x4*)(rb + 192 + 4 * kq);
                const f32x2 tp = Sa * (f32x2){kk4[0], kk4[1]} + Sb * (f32x2){kk4[2], kk4[3]};
                const float p = row16_sum(tp[0] + tp[1]);
                const f32x4 w4 = *(const LAS f32x4*)(rb + 64 + 4 * kq), b4 = *(const LAS f32x4*)(rb + 256 + 4 * kq), k4 = *(const LAS f32x4*)(rb + 128 + 4 * kq), r4 = *(const LAS f32x4*)(rb + 4 * kq);
                const float vv = rb[320 + 16 * qr + rloc];
                const f32x2 pp = {p, p}, vv2 = {vv, vv};
                Sa = Sa * (f32x2){w4[0], w4[1]} - pp * (f32x2){b4[0], b4[1]} + vv2 * (f32x2){k4[0], k4[1]};
                Sb = Sb * (f32x2){w4[2], w4[3]} - pp * (f32x2){b4[2], b4[3]} + vv2 * (f32x2){k4[2], k4[3]};
                const f32x2 ty = Sa * (f32x2){r4[0], r4[1]} + Sb * (f32x2){r4[2], r4[3]};
                const float y = row16_sum(ty[0] + ty[1]);
                if (kq == 0) yb[st * 16 + rloc] = y;
            }
            __builtin_amdgcn_s_setprio(0);
        }
        LDS_WAIT(); __builtin_amdgcn_s_barrier(); asm volatile("" ::: "memory");
    }
    if (wave >= 4) flush_y(NCH - 1);
}


template <int CONV>
__device__ __forceinline__ void ph_rwkv_scan5(const Ctx& C, int l) {
    int tid = C.tid; asm volatile("" : "+v"(tid));
    const int lane = tid & 63, wave = C.wave;
    constexpr int CH = 16, CHF = CH * 384, NCH = SEQ / CH;
    LAS float* buf = (LAS float*)C.lds;
    LAS float* ybuf = (LAS float*)(C.lds + 49152);
    const int it = blockIdx.x;
    if (it >= NB * 16 * 4) return;
    const int qr = it & 3, h = (it >> 2) & 15, b = it >> 6;
    const size_t gbase = (size_t)b * SEQ * 1024 + h * 64;
#define SCAN5_BAR() do { LDS_WAIT(); __builtin_amdgcn_s_barrier(); asm volatile("" ::: "memory"); } while (0)
    if (wave >= 4) {
        LAS float* scr = (LAS float*)(C.lds + 65536 + (wave & 3) * 16640);
        const int lj = tid - 256;
        constexpr int PER = MOE_SCAN_TILES;
        static_assert(PER * 1024 * 2 <= MOE_CONV_ITEMS && PER * 3 + 2 <= NCH && PER % 2 == 0, "conversion slots");
        const int cfirst = ((CONV >= 2) ? 1 : l) * (1024 * PER) + (blockIdx.x * 4 + (wave & 3));
        f32x4 nx[5];
        const unsigned lo_g = (unsigned)((lj >> 4) * 1024 + 4 * (lj & 15));
        const int lo_l = (lj >> 4) * 384 + 4 * (lj & 15);
        const f32x4 kkw = *(const GLB f32x4*)(INF32(I_RWKK) + l * 1024 + h * 64 + 4 * (lj & 15)), kaw = *(const GLB f32x4*)(INF32(I_RWKA) + l * 1024 + h * 64 + 4 * (lj & 15));
        u32x2 nb[4];
        auto fetch_chunk = [&](int cidx) {
            nx[1] = *(const GLB f32x4*)(WSP(float, WS_DEC) + gbase + (size_t)(cidx * CH) * 1024 + lo_g);
#pragma unroll
            for (int i = 0; i < 4; ++i) { const size_t off = (i == 0) ? WS_R : (i == 1) ? WS_K : (i == 2) ? WS_AA : WS_V;
                nb[i] = *(const GLB u32x2*)(WSP(bf16_t, off) + gbase + (size_t)(cidx * CH) * 1024 + lo_g); }
        };
        auto put_chunk = [&](int cidx) {
            LAS float* d = buf + (cidx & 1) * CHF + lo_l;
            asm volatile("" : "+v"(nx[1]), "+v"(nb[0]), "+v"(nb[1]), "+v"(nb[2]), "+v"(nb[3]));
            nx[0] = (f32x4){bflo(nb[0].x), bfhi(nb[0].x), bflo(nb[0].y), bfhi(nb[0].y)}; nx[4] = (f32x4){bflo(nb[3].x), bfhi(nb[3].x), bflo(nb[3].y), bfhi(nb[3].y)};
            const f32x4 kr = (f32x4){bflo(nb[1].x), bfhi(nb[1].x), bflo(nb[1].y), bfhi(nb[1].y)}, av = (f32x4){bflo(nb[2].x), bfhi(nb[2].x), bflo(nb[2].y), bfhi(nb[2].y)};
            f32x4 kk = kr * kkw;
            const float ss = row16_sum((kk[0] * kk[0] + kk[1] * kk[1]) + (kk[2] * kk[2] + kk[3] * kk[3]));
            kk = kk * (1.0f / fmaxf(sqrtf(ss), 1e-12f));
            *(LAS f32x4*)(d) = nx[0]; *(LAS f32x4*)(d + 64) = nx[1]; *(LAS f32x4*)(d + 128) = kr * (1.0f + (av - 1.0f) * kaw);
            *(LAS f32x4*)(d + 192) = kk; *(LAS f32x4*)(d + 256) = kk * av; *(LAS f32x4*)(d + 320) = nx[4];
        };
        auto flush_y = [&](int cidx) {
            const int st = lj >> 4, r = lj & 15;
            WSP(float, WS_YRAW)[gbase + (size_t)(cidx * CH + st) * 1024 + 16 * qr + r] = ybuf[(cidx & 1) * 256 + lj];
        };
#if SCAN_SCHED == 4
        struct FS { f32x4 dec; u32x2 nb[4]; };
        FS fs[6];
        auto fetch2 = [&](int cidx, FS& f) {
            f.dec = *(const GLB f32x4*)(WSP(float, WS_DEC) + gbase + (size_t)(cidx * CH) * 1024 + lo_g);
#pragma unroll
            for (int i = 0; i < 4; ++i) { const size_t off = (i == 0) ? WS_R : (i == 1) ? WS_K : (i == 2) ? WS_AA : WS_V;
                f.nb[i] = *(const GLB u32x2*)(WSP(bf16_t, off) + gbase + (size_t)(cidx * CH) * 1024 + lo_g); }
        };
        auto put2 = [&](int cidx, FS& f) {
            LAS float* d = buf + (cidx & 1) * CHF + lo_l;
            asm volatile("" : "+v"(f.dec), "+v"(f.nb[0]), "+v"(f.nb[1]), "+v"(f.nb[2]), "+v"(f.nb[3]));
            const f32x4 rr = (f32x4){bflo(f.nb[0].x), bfhi(f.nb[0].x), bflo(f.nb[0].y), bfhi(f.nb[0].y)}, vv = (f32x4){bflo(f.nb[3].x), bfhi(f.nb[3].x), bflo(f.nb[3].y), bfhi(f.nb[3].y)};
            const f32x4 kr = (f32x4){bflo(f.nb[1].x), bfhi(f.nb[1].x), bflo(f.nb[1].y), bfhi(f.nb[1].y)}, av = (f32x4){bflo(f.nb[2].x), bfhi(f.nb[2].x), bflo(f.nb[2].y), bfhi(f.nb[2].y)};
            f32x4 kk = kr * kkw;
            const float ss = row16_sum((kk[0] * kk[0] + kk[1] * kk[1]) + (kk[2] * kk[2] + kk[3] * kk[3]));
            kk = kk * (1.0f / fmaxf(sqrtf(ss), 1e-12f));
            *(LAS f32x4*)(d) = rr; *(LAS f32x4*)(d + 64) = f.dec; *(LAS f32x4*)(d + 128) = kr * (1.0f + (av - 1.0f) * kaw);
            *(LAS f32x4*)(d + 192) = kk; *(LAS f32x4*)(d + 256) = kk * av; *(LAS f32x4*)(d + 320) = vv;
        };
        f32x4 cv[16]; MoeTile ct; ct.W = nullptr; ct.Bt = nullptr; ct.ldw = 0; ct.K = 0; ct.k0 = 0; ct.s0 = 0; ct.n0 = 0;
#pragma unroll
        for (int i = 0; i < 16; ++i) cv[i] = (f32x4){0.f, 0.f, 0.f, 0.f};
        {
            const int vit = blockIdx.x * 4 + (wave & 3);
            if (vit < 512) { const int sb = vit & 31, hd = (vit >> 5) & 1, vb = (vit >> 6) & 3;
                if ((vit >> 8) == 0) vt_tile(WSP(bf16_t, WS_VS) + ((size_t)vb * SEQ + 64 * sb) * 128 + 64 * hd, 128, WSP(bf16_t, WS_SWVT) + ((size_t)(vb * 2 + hd) * 64) * SEQ + 64 * sb, (LAS bf16_t*)scr, lane);
                else vt_tile(WSP(bf16_t, WS_VD) + ((size_t)vb * SEQ + 64 * sb) * 128 + 64 * hd, 128, WSP(bf16_t, WS_VDT) + ((size_t)vb * 128 + 64 * hd) * SEQ + 64 * sb, (LAS bf16_t*)scr, lane); }
        }
        static_assert(PER * 3 + 2 == NCH && PER % 2 == 0, "period schedule");
        const int off = (int)((blockIdx.x * 4u + (unsigned)(wave & 3)) & 1u);
        fetch2(0, fs[0]); put2(0, fs[0]); fetch2(1, fs[0]);
        SCAN5_BAR();
        int c = 0;
        for (; c < 1 + off; ++c) { put2(c + 1, fs[0]); fetch2(c + 2, fs[0]); if (c > 0) flush_y(c - 1); SCAN5_BAR(); }
#pragma unroll
        for (int i = 1; i < 6; ++i) fetch2(c + 1 + i, fs[i]);
        asm volatile("; MARK scan5 periodic begin");
        auto period = [&](int j6, bool first) {
#pragma unroll
            for (int m6 = 0; m6 < 6; ++m6) {
                asm volatile("; MARK m6 iter");
                put2(c + 1, fs[m6]); fetch2(c + 7 < NCH ? c + 7 : NCH - 1, fs[m6]); flush_y(c - 1);
                if (!MOE_CONV_IN_PROLOGUE && CONV) {
                    if (m6 == 0) { if (!first) conv_tile_finish(cv, ct.Bt, ct.K, ct.n0, ct.k0, scr, lane);
                        ct = moe_tile_desc(C, cfirst + 1024 * (2 * j6)); conv_tile_load(ct.W, ct.ldw, ct.k0, ct.s0, cv, lane); }
                    if (m6 == 3 && !first) { const MoeTile cb = moe_tile_desc(C, cfirst + 1024 * (2 * j6 - 1)); conv_tile_from_lds(cb.Bt, cb.K, cb.n0, cb.k0, scr, lane); }
                }
                SCAN5_BAR(); ++c;
            }
        };
        period(0, true);
        for (int j6 = 1; j6 < PER / 2; ++j6) period(j6, false);
        asm volatile("; MARK scan5 periodic end");
        for (; c < NCH; ++c) { flush_y(c - 1); SCAN5_BAR(); }
        if (!MOE_CONV_IN_PROLOGUE && CONV) {
            conv_tile_finish(cv, ct.Bt, ct.K, ct.n0, ct.k0, scr, lane);
            SCAN5_BAR();
            SCAN5_BAR();
            { const MoeTile cb = moe_tile_desc(C, cfirst + 1024 * (PER - 1)); conv_tile_from_lds(cb.Bt, cb.K, cb.n0, cb.k0, scr, lane); }
        }
#elif SCAN_SCHED == 3
        struct FS { f32x4 dec; u32x2 nb[4]; };
        FS fs[6];
        auto fetch2 = [&](int cidx, FS& f) {
            f.dec = *(const GLB f32x4*)(WSP(float, WS_DEC) + gbase + (size_t)(cidx * CH) * 1024 + lo_g);
#pragma unroll
            for (int i = 0; i < 4; ++i) { const size_t off = (i == 0) ? WS_R : (i == 1) ? WS_K : (i == 2) ? WS_AA : WS_V;
                f.nb[i] = *(const GLB u32x2*)(WSP(bf16_t, off) + gbase + (size_t)(cidx * CH) * 1024 + lo_g); }
        };
        auto put2 = [&](int cidx, FS& f) {
            LAS float* d = buf + (cidx & 1) * CHF + lo_l;
            asm volatile("" : "+v"(f.dec), "+v"(f.nb[0]), "+v"(f.nb[1]), "+v"(f.nb[2]), "+v"(f.nb[3]));
            const f32x4 rr = (f32x4){bflo(f.nb[0].x), bfhi(f.nb[0].x), bflo(f.nb[0].y), bfhi(f.nb[0].y)}, vv = (f32x4){bflo(f.nb[3].x), bfhi(f.nb[3].x), bflo(f.nb[3].y), bfhi(f.nb[3].y)};
            const f32x4 kr = (f32x4){bflo(f.nb[1].x), bfhi(f.nb[1].x), bflo(f.nb[1].y), bfhi(f.nb[1].y)}, av = (f32x4){bflo(f.nb[2].x), bfhi(f.nb[2].x), bflo(f.nb[2].y), bfhi(f.nb[2].y)};
            f32x4 kk = kr * kkw;
            const float ss = row16_sum((kk[0] * kk[0] + kk[1] * kk[1]) + (kk[2] * kk[2] + kk[3] * kk[3]));
            kk = kk * (1.0f / fmaxf(sqrtf(ss), 1e-12f));
            *(LAS f32x4*)(d) = rr; *(LAS f32x4*)(d + 64) = f.dec; *(LAS f32x4*)(d + 128) = kr * (1.0f + (av - 1.0f) * kaw);
            *(LAS f32x4*)(d + 192) = kk; *(LAS f32x4*)(d + 256) = kk * av; *(LAS f32x4*)(d + 320) = vv;
        };
        f32x4 cv[16]; MoeTile ct; ct.W = nullptr; ct.Bt = nullptr; ct.ldw = 0; ct.K = 0; ct.k0 = 0; ct.s0 = 0; ct.n0 = 0;
#pragma unroll
        for (int i = 0; i < 16; ++i) cv[i] = (f32x4){0.f, 0.f, 0.f, 0.f};
        {
            const int vit = blockIdx.x * 4 + (wave & 3);
            if (vit < 512) { const int sb = vit & 31, hd = (vit >> 5) & 1, vb = (vit >> 6) & 3;
                if ((vit >> 8) == 0) vt_tile(WSP(bf16_t, WS_VS) + ((size_t)vb * SEQ + 64 * sb) * 128 + 64 * hd, 128, WSP(bf16_t, WS_SWVT) + ((size_t)(vb * 2 + hd) * 64) * SEQ + 64 * sb, (LAS bf16_t*)scr, lane);
                else vt_tile(WSP(bf16_t, WS_VD) + ((size_t)vb * SEQ + 64 * sb) * 128 + 64 * hd, 128, WSP(bf16_t, WS_VDT) + ((size_t)vb * 128 + 64 * hd) * SEQ + 64 * sb, (LAS bf16_t*)scr, lane); }
        }
        static_assert(PER * 3 + 2 == NCH && PER % 2 == 0, "period schedule");
        const int off = (int)((blockIdx.x * 4u + (unsigned)(wave & 3)) & 1u);
        fetch2(0, fs[0]); put2(0, fs[0]); fetch2(1, fs[0]);
        SCAN5_BAR();
        int c = 0;
        for (; c < 1 + off; ++c) { put2(c + 1, fs[0]); fetch2(c + 2, fs[0]); if (c > 0) flush_y(c - 1); SCAN5_BAR(); }
#pragma unroll
        for (int i = 1; i < 6; ++i) fetch2(c + 1 + i, fs[i]);
        asm volatile("; MARK scan5 periodic begin");
        auto period = [&](int j6, bool first) {
#pragma unroll
            for (int m6 = 0; m6 < 6; ++m6) {
                asm volatile("; MARK m6 iter");
                put2(c + 1, fs[m6]); fetch2(c + 7 < NCH ? c + 7 : NCH - 1, fs[m6]); flush_y(c - 1);
                if (!MOE_CONV_IN_PROLOGUE && CONV && (m6 == 0 || (m6 == 3 && CONV != 5))) {
                    if (!(first && m6 == 0)) { if (CONV == 1) conv_tile_finish(cv, ct.Bt, ct.K, ct.n0, ct.k0, scr, lane);
                        else { asm volatile("" :: "v"(cv[0]), "v"(cv[1]), "v"(cv[2]), "v"(cv[3]), "v"(cv[4]), "v"(cv[5]), "v"(cv[6]), "v"(cv[7])); asm volatile("" :: "v"(cv[8]), "v"(cv[9]), "v"(cv[10]), "v"(cv[11]), "v"(cv[12]), "v"(cv[13]), "v"(cv[14]), "v"(cv[15])); } }
                    ct = moe_tile_desc(C, cfirst + 1024 * (2 * j6 + (m6 == 3 ? 1 : 0))); conv_tile_load(ct.W, ct.ldw, ct.k0, ct.s0, cv, lane);
                }
                SCAN5_BAR(); ++c;
            }
        };
        period(0, true);
        for (int j6 = 1; j6 < PER / 2; ++j6) period(j6, false);
        asm volatile("; MARK scan5 periodic end");
        for (; c < NCH; ++c) { flush_y(c - 1); SCAN5_BAR(); }
        if (!MOE_CONV_IN_PROLOGUE && CONV == 1) conv_tile_finish(cv, ct.Bt, ct.K, ct.n0, ct.k0, scr, lane);
#elif SCAN_SCHED == 2
        struct FS { f32x4 dec; u32x2 nb[4]; };
        FS fs[2];
        auto fetch2 = [&](int cidx, FS& f) {
            f.dec = *(const GLB f32x4*)(WSP(float, WS_DEC) + gbase + (size_t)(cidx * CH) * 1024 + lo_g);
#pragma unroll
            for (int i = 0; i < 4; ++i) { const size_t off = (i == 0) ? WS_R : (i == 1) ? WS_K : (i == 2) ? WS_AA : WS_V;
                f.nb[i] = *(const GLB u32x2*)(WSP(bf16_t, off) + gbase + (size_t)(cidx * CH) * 1024 + lo_g); }
        };
        auto put2 = [&](int cidx, FS& f) {
            LAS float* d = buf + (cidx & 1) * CHF + lo_l;
            asm volatile("" : "+v"(f.dec), "+v"(f.nb[0]), "+v"(f.nb[1]), "+v"(f.nb[2]), "+v"(f.nb[3]));
            const f32x4 rr = (f32x4){bflo(f.nb[0].x), bfhi(f.nb[0].x), bflo(f.nb[0].y), bfhi(f.nb[0].y)}, vv = (f32x4){bflo(f.nb[3].x), bfhi(f.nb[3].x), bflo(f.nb[3].y), bfhi(f.nb[3].y)};
            const f32x4 kr = (f32x4){bflo(f.nb[1].x), bfhi(f.nb[1].x), bflo(f.nb[1].y), bfhi(f.nb[1].y)}, av = (f32x4){bflo(f.nb[2].x), bfhi(f.nb[2].x), bflo(f.nb[2].y), bfhi(f.nb[2].y)};
            f32x4 kk = kr * kkw;
            const float ss = row16_sum((kk[0] * kk[0] + kk[1] * kk[1]) + (kk[2] * kk[2] + kk[3] * kk[3]));
            kk = kk * (1.0f / fmaxf(sqrtf(ss), 1e-12f));
            *(LAS f32x4*)(d) = rr; *(LAS f32x4*)(d + 64) = f.dec; *(LAS f32x4*)(d + 128) = kr * (1.0f + (av - 1.0f) * kaw);
            *(LAS f32x4*)(d + 192) = kk; *(LAS f32x4*)(d + 256) = kk * av; *(LAS f32x4*)(d + 320) = vv;
        };
        f32x4 cv[16]; MoeTile ct; ct.W = nullptr; ct.Bt = nullptr; ct.ldw = 0; ct.K = 0; ct.k0 = 0; ct.s0 = 0; ct.n0 = 0;
#pragma unroll
        for (int i = 0; i < 16; ++i) cv[i] = (f32x4){0.f, 0.f, 0.f, 0.f};
        {
            const int vit = blockIdx.x * 4 + (wave & 3);
            if (vit < 512) { const int sb = vit & 31, hd = (vit >> 5) & 1, vb = (vit >> 6) & 3;
                if ((vit >> 8) == 0) vt_tile(WSP(bf16_t, WS_VS) + ((size_t)vb * SEQ + 64 * sb) * 128 + 64 * hd, 128, WSP(bf16_t, WS_SWVT) + ((size_t)(vb * 2 + hd) * 64) * SEQ + 64 * sb, (LAS bf16_t*)scr, lane);
                else vt_tile(WSP(bf16_t, WS_VD) + ((size_t)vb * SEQ + 64 * sb) * 128 + 64 * hd, 128, WSP(bf16_t, WS_VDT) + ((size_t)vb * 128 + 64 * hd) * SEQ + 64 * sb, (LAS bf16_t*)scr, lane); }
        }
        static_assert(PER * 3 + 2 == NCH && PER % 2 == 0, "period schedule");
        const int off = (int)((blockIdx.x * 4u + (unsigned)(wave & 3)) & 1u);
        fetch2(0, fs[0]); put2(0, fs[0]); fetch2(1, fs[0]);
        SCAN5_BAR();
        int c = 0;
        for (; c < 1 + off; ++c) { put2(c + 1, fs[0]); fetch2(c + 2, fs[0]); if (c > 0) flush_y(c - 1); SCAN5_BAR(); }
        fetch2(c + 2, fs[1]);
        asm volatile("; MARK scan5 periodic begin");
        auto period = [&](int j6, bool first) {
#pragma unroll
            for (int m6 = 0; m6 < 6; ++m6) {
                asm volatile("; MARK m6 iter");
                put2(c + 1, fs[m6 & 1]); fetch2(c + 3 < NCH ? c + 3 : NCH - 1, fs[m6 & 1]); flush_y(c - 1);
                if (!MOE_CONV_IN_PROLOGUE && CONV && (m6 == 0 || (m6 == 3 && CONV != 5))) {
                    if (!(first && m6 == 0)) {
                        if (CONV == 1 || CONV == 4) conv_tile_finish(cv, ct.Bt, ct.K, ct.n0, ct.k0, scr, lane);
                        else if (CONV == 3) { const int cc = lane & 7;
#pragma unroll
                            for (int j = 0; j < 8; ++j) { const int n = (lane >> 3) + 8 * j; u32x4 o; o.x = pk2(cv[2 * j][0], cv[2 * j][1]); o.y = pk2(cv[2 * j][2], cv[2 * j][3]); o.z = pk2(cv[2 * j + 1][0], cv[2 * j + 1][1]); o.w = pk2(cv[2 * j + 1][2], cv[2 * j + 1][3]);
                                *(GLB u32x4*)(ct.Bt + (size_t)(ct.n0 + n) * ct.K + ct.k0 + 8 * cc) = o; } }
                        else { asm volatile("" :: "v"(cv[0]), "v"(cv[1]), "v"(cv[2]), "v"(cv[3]), "v"(cv[4]), "v"(cv[5]), "v"(cv[6]), "v"(cv[7])); asm volatile("" :: "v"(cv[8]), "v"(cv[9]), "v"(cv[10]), "v"(cv[11]), "v"(cv[12]), "v"(cv[13]), "v"(cv[14]), "v"(cv[15])); }
                    }
                    ct = moe_tile_desc(C, cfirst + 1024 * (2 * j6 + (m6 == 3 ? 1 : 0))); conv_tile_load(ct.W, ct.ldw, ct.k0, ct.s0, cv, lane);
                }
                SCAN5_BAR(); ++c;
            }
        };
        period(0, true);
        for (int j6 = 1; j6 < PER / 2; ++j6) period(j6, false);
        asm volatile("; MARK scan5 periodic end");
        for (; c < NCH; ++c) { flush_y(c - 1); SCAN5_BAR(); }
        if (!MOE_CONV_IN_PROLOGUE && (CONV == 1 || CONV == 4)) conv_tile_finish(cv, ct.Bt, ct.K, ct.n0, ct.k0, scr, lane);
#elif SCAN_SCHED == 1
        f32x4 cv[16]; MoeTile ct; ct.W = nullptr; ct.Bt = nullptr; ct.ldw = 0; ct.K = 0; ct.k0 = 0; ct.s0 = 0; ct.n0 = 0;
#pragma unroll
        for (int i = 0; i < 16; ++i) cv[i] = (f32x4){0.f, 0.f, 0.f, 0.f};
        {
            const int vit = blockIdx.x * 4 + (wave & 3);
            if (vit < 512) { const int sb = vit & 31, hd = (vit >> 5) & 1, vb = (vit >> 6) & 3;
                if ((vit >> 8) == 0) vt_tile(WSP(bf16_t, WS_VS) + ((size_t)vb * SEQ + 64 * sb) * 128 + 64 * hd, 128, WSP(bf16_t, WS_SWVT) + ((size_t)(vb * 2 + hd) * 64) * SEQ + 64 * sb, (LAS bf16_t*)scr, lane);
                else vt_tile(WSP(bf16_t, WS_VD) + ((size_t)vb * SEQ + 64 * sb) * 128 + 64 * hd, 128, WSP(bf16_t, WS_VDT) + ((size_t)vb * 128 + 64 * hd) * SEQ + 64 * sb, (LAS bf16_t*)scr, lane); }
        }
        static_assert(PER * 3 + 2 == NCH && PER % 2 == 0, "period schedule");
        const int off = (int)((blockIdx.x * 4u + (unsigned)(wave & 3)) & 1u);
        auto plain = [&](int c) { if (c + 1 < NCH) put_chunk(c + 1); if (c + 2 < NCH) fetch_chunk(c + 2); if (c > 0) flush_y(c - 1); };
        auto plain_nc = [&](int c) { put_chunk(c + 1); fetch_chunk(c + 2 < NCH ? c + 2 : NCH - 1); flush_y(c - 1); };
        fetch_chunk(0); put_chunk(0); fetch_chunk(1);
        SCAN5_BAR();
        int c = 0;
        for (; c < 1 + off; ++c) { plain(c); SCAN5_BAR(); }
        asm volatile("; MARK scan5 periodic begin");
        auto period = [&](int j6) {
#pragma unroll
            for (int m6 = 0; m6 < 6; ++m6) {
                asm volatile("; MARK m6 iter");
                plain_nc(c);
                if (!MOE_CONV_IN_PROLOGUE && CONV) {
                    if (m6 == 0 || m6 == 3) { ct = moe_tile_desc(C, cfirst + 1024 * (2 * j6 + (m6 == 3 ? 1 : 0))); conv_tile_load(ct.W, ct.ldw, ct.k0, ct.s0, cv, lane); }
                    if (m6 == 2 || m6 == 5) conv_tile_finish(cv, ct.Bt, ct.K, ct.n0, ct.k0, scr, lane);
                }
                SCAN5_BAR(); ++c;
            }
        };
        period(0);
        for (int j6 = 1; j6 < PER / 2; ++j6) period(j6);
        asm volatile("; MARK scan5 periodic end");
        for (; c < NCH; ++c) { plain(c); SCAN5_BAR(); }
#else
        f32x4 cv[16], cv2[16]; MoeTile ct; ct.W = nullptr; ct.Bt = nullptr; ct.ldw = 0; ct.K = 0; ct.k0 = 0; ct.s0 = 0; ct.n0 = 0; MoeTile ct2 = ct;
#pragma unroll
        for (int i = 0; i < 16; ++i) { cv[i] = (f32x4){0.f, 0.f, 0.f, 0.f}; cv2[i] = cv[i]; }
        {
            const int vit = blockIdx.x * 4 + (wave & 3);
            if (vit < 512) { const int sb = vit & 31, hd = (vit >> 5) & 1, vb = (vit >> 6) & 3;
                if ((vit >> 8) == 0) vt_tile(WSP(bf16_t, WS_VS) + ((size_t)vb * SEQ + 64 * sb) * 128 + 64 * hd, 128, WSP(bf16_t, WS_SWVT) + ((size_t)(vb * 2 + hd) * 64) * SEQ + 64 * sb, (LAS bf16_t*)scr, lane);
                else vt_tile(WSP(bf16_t, WS_VD) + ((size_t)vb * SEQ + 64 * sb) * 128 + 64 * hd, 128, WSP(bf16_t, WS_VDT) + ((size_t)vb * 128 + 64 * hd) * SEQ + 64 * sb, (LAS bf16_t*)scr, lane); }
        }
        fetch_chunk(0); put_chunk(0); fetch_chunk(1);
        SCAN5_BAR();
        for (int cidx = 0; cidx < NCH; ++cidx) {
            if (cidx + 1 < NCH) put_chunk(cidx + 1);
            if (cidx + 2 < NCH) fetch_chunk(cidx + 2);
            if (cidx > 0) flush_y(cidx - 1);
            if (!MOE_CONV_IN_PROLOGUE) {
                const int j6 = cidx / 6, m6 = cidx - 6 * j6;
                if (m6 == 0 && 2 * j6 < PER) { ct = moe_tile_desc(C, cfirst + 1024 * (2 * j6)); conv_tile_load(ct.W, ct.ldw, ct.k0, ct.s0, cv, lane); }
                else if (m6 == 4 && 2 * j6 < PER) conv_tile_finish(cv, ct.Bt, ct.K, ct.n0, ct.k0, scr, lane);
                else if (m6 == 3 && 2 * j6 + 1 < PER) { ct2 = moe_tile_desc(C, cfirst + 1024 * (2 * j6 + 1)); conv_tile_load(ct2.W, ct2.ldw, ct2.k0, ct2.s0, cv2, lane); }
                else if (m6 == 1 && j6 >= 1 && 2 * j6 - 1 < PER) conv_tile_finish(cv2, ct2.Bt, ct2.K, ct2.n0, ct2.k0, scr, lane);
            }
            SCAN5_BAR();
        }
#endif
        flush_y(NCH - 1);
    } else {
        const int ro = lane >> 4, kq = lane & 15, rloc = 4 * wave + ro;
        f32x2 Sa = {0.f, 0.f}, Sb = {0.f, 0.f};
        constexpr bool CONVB = SCAN_SCHED == 4 && CONV == 1 && !MOE_CONV_IN_PROLOGUE;
        f32x4 cvB[16];
#pragma unroll
        for (int i = 0; i < 16; ++i) cvB[i] = (f32x4){0.f, 0.f, 0.f, 0.f};
        LAS float* scrp = (LAS float*)(C.lds + 65536 + wave * 16640);
        const int cfirstc = l * (1024 * MOE_SCAN_TILES) + (blockIdx.x * 4 + wave);
        int bj = 0, bnext = 2 + (int)((blockIdx.x * 4u + (unsigned)wave) & 1u);
        SCAN5_BAR();
        for (int cidx = 0; cidx < NCH; ++cidx) {
            if (CONVB && cidx == bnext) {
                if (bj >= 1) conv_tile_to_lds(cvB, scrp, lane);
                if (bj < MOE_SCAN_TILES / 2) { const MoeTile tb = moe_tile_desc(C, cfirstc + 1024 * (2 * bj + 1)); conv_tile_load(tb.W, tb.ldw, tb.k0, tb.s0, cvB, lane); }
                ++bj; bnext += 6;
            }
            const LAS float* cb = buf + (cidx & 1) * CHF + 4 * kq;
            const LAS float* vb = buf + (cidx & 1) * CHF + 320 + 16 * qr + rloc;
            float ykeep = 0.f;
            f32x4 kk4 = *(const LAS f32x4*)(cb + 192), w4 = *(const LAS f32x4*)(cb + 64), b4 = *(const LAS f32x4*)(cb + 256), k4 = *(const LAS f32x4*)(cb + 128), r4 = *(const LAS f32x4*)(cb);
            float vv = vb[0];
#pragma unroll
            for (int st = 0; st < CH; ++st) {
                f32x4 kk4n = kk4, w4n = w4, b4n = b4, k4n = k4, r4n = r4; float vvn = vv;
                if (st + 1 < CH) { const LAS float* nb = cb + (st + 1) * 384;
                    kk4n = *(const LAS f32x4*)(nb + 192); w4n = *(const LAS f32x4*)(nb + 64); b4n = *(const LAS f32x4*)(nb + 256); k4n = *(const LAS f32x4*)(nb + 128); r4n = *(const LAS f32x4*)(nb); vvn = vb[(st + 1) * 384]; }
                const f32x2 tp = Sa * (f32x2){kk4[0], kk4[1]} + Sb * (f32x2){kk4[2], kk4[3]};
                const float p = row16_sum(tp[0] + tp[1]);
                const f32x2 pp = {p, p}, vv2 = {vv, vv};
                Sa = Sa * (f32x2){w4[0], w4[1]} - pp * (f32x2){b4[0], b4[1]} + vv2 * (f32x2){k4[0], k4[1]};
                Sb = Sb * (f32x2){w4[2], w4[3]} - pp * (f32x2){b4[2], b4[3]} + vv2 * (f32x2){k4[2], k4[3]};
                const f32x2 ty = Sa * (f32x2){r4[0], r4[1]} + Sb * (f32x2){r4[2], r4[3]};
                const float y = row16_sum(ty[0] + ty[1]);
                ykeep = (kq == st) ? y : ykeep;
                kk4 = kk4n; w4 = w4n; b4 = b4n; k4 = k4n; r4 = r4n; vv = vvn;
            }
            ybuf[(cidx & 1) * 256 + kq * 16 + rloc] = ykeep;
            SCAN5_BAR();
        }
        if (CONVB) { SCAN5_BAR(); conv_tile_to_lds(cvB, scrp, lane); SCAN5_BAR(); }
    }
#undef SCAN5_BAR
}
struct Args { const void* in[N_INPUTS]; float* out; unsigned char* ws; int ph_lo, ph_hi; };
static_assert(sizeof(Args) == N_INPUTS * 8 + 24, "Args has no padding");

constexpr int N_PHASES = 2 + 12 + 14;

#ifndef USE_FAST
#define USE_FAST 271
#endif
#ifndef PROBE_CONV
#define PROBE_CONV 3
#endif
#ifndef PROBE_MASK
#define PROBE_MASK 0
#endif
#ifndef DBG_SKIP_MASK
#define DBG_SKIP_MASK 0
#endif

__global__ void __launch_bounds__(NTHR, 2) fwd_kernel(Args args) {
    extern __shared__ __attribute__((aligned(16))) unsigned char lds_raw[];
    LAS unsigned char* const lds = (LAS unsigned char*)lds_raw;
    {
        const int tid0 = threadIdx.x;
        volatile LAS unsigned* MISC0 = (volatile LAS unsigned*)(lds + MISC_OFF);
        for (int u = tid0; u < (LDS_BYTES - MISC_OFF) / 4; u += NTHR) MISC0[u] = 0u;
        __syncthreads();
        LAS unsigned long long* tab = (LAS unsigned long long*)(lds + INTAB_OFF);
        if (tid0 < N_INPUTS) tab[tid0] = (unsigned long long)args.in[tid0];
        if (tid0 == 64) { tab[TAB_WS] = (unsigned long long)args.ws; tab[TAB_OUT] = (unsigned long long)args.out;
            tab[TAB_RANGE] = ((unsigned long long)(unsigned)args.ph_hi << 32) | (unsigned)args.ph_lo; }
        __syncthreads();
        if (args.ph_hi - args.ph_lo > 1) (void)xcd_barrier_post((unsigned*)(args.ws + WS_CTL) + CW_BAR, MISC0 + 8);
    }
    LAS unsigned char* ring = lds;
    int ph = 0;
#define PH_BEGIN { const int lo = (int)__builtin_amdgcn_readfirstlane(((const LAS unsigned*)(lds + INTAB_OFF))[2 * TAB_RANGE]), hi = (int)__builtin_amdgcn_readfirstlane(((const LAS unsigned*)(lds + INTAB_OFF))[2 * TAB_RANGE + 1]); \
    if (ph >= lo && ph < hi) { const Ctx C = make_ctx(lds);
#define PH_END if (ph + 1 < hi) { XcdBarrier bar; bar.bar = (unsigned*)WSP(unsigned, WS_CTL) + CW_BAR; bar.x = xb_xcc_id(); bar.st = (volatile LAS unsigned*)(lds + MISC_OFF) + 8; xcd_barrier(bar); } \
    else { VM_WAIT(); __syncthreads(); } } } ++ph;
#define REP(g, ...) { GLB float* XOUT = C.out; (void)XOUT; __VA_ARGS__ } if (PROBE_MASK & (g)) { GLB float* XOUT = WSP(float, WS_SC); (void)XOUT; __VA_ARGS__ }

    PH_BEGIN REP(1,  ph_prologue(C); ph_norm<0, false>(C, INF32(I_X), nullptr, INF32(I_MIXN), nullptr); ) PH_END
    PH_BEGIN REP(256,  { pg8::Gemm g{WSP(bf16_t, WS_PCAT), WSP(bf16_t, WS_WPP), 512, 256}; pg8::ProjOrder S; S.init(C.G, (int)blockIdx.x); pg8::EpiProj E{WSP(bf16_t, WS_PROJ)};
        pg8::gemm_phase<pg8::EpiProj, pg8::ProjOrder>(ring, g, S, E); } ) PH_END

    { constexpr int l = 0;
        if (l > 0) { PH_BEGIN REP(32768,  ph_norm<0>(C, WSP(bf16_t, WS_XB), nullptr, INF32(I_MIXN) + l * D, nullptr); ) PH_END }
        PH_BEGIN REP(4096,  { pg8::Gemm g{WSP(bf16_t, WS_H), WSP(bf16_t, WS_WIN + l * SZ_WIN1), D, D}; pg8::StaticOrder S; S.init(T, N_INP, C.G, (int)blockIdx.x);
            pg8::EpiWin E{WSP(bf16_t, WS_SBQKV), WSP(bf16_t, WS_UF), WSP(bf16_t, WS_GATE)};
            pg8::gemm_phase<pg8::EpiWin, pg8::StaticOrder>(ring, g, S, E); } ) PH_END
        PH_BEGIN REP(16384,  ph_prep(C, l); ph_vt(C); ph_latent(C, l); ) PH_END
        PH_BEGIN REP(256,  { pg8::Gemm g{WSP(bf16_t, WS_ALORA), WSP(bf16_t, WS_WLORA + l * SZ_WLORA1), 256, 256}; pg8::StaticOrder S; S.init(T, 3072, C.G, (int)blockIdx.x);
            pg8::EpiLora E{WSP(float, WS_DEC), WSP(bf16_t, WS_AA), WSP(bf16_t, WS_GG), INF32(I_RWW0) + l * 1024, INF32(I_RWA0) + l * 1024};
            pg8::gemm_phase<pg8::EpiLora, pg8::StaticOrder>(ring, g, S, E); } ) PH_END
        PH_BEGIN REP(32,  if (!(DBG_SKIP_MASK & 2)) { if (USE_FAST & 256) { ph_rwkv_scan5<1>(C, l); if (PROBE_MASK & 2097152) ph_rwkv_scan5<0>(C, l); if ((PROBE_MASK & 4194304) && l == 0) ph_rwkv_scan5<PROBE_CONV>(C, l); } else if (USE_FAST & 128) ph_rwkv_scan4(C, l); else if (USE_FAST & 64) ph_rwkv_scan3(C, l); else if (USE_FAST & 32) ph_rwkv_scan_conv(C, l); else if (USE_FAST & 2) ph_rwkv_scan_fast(C); else ph_rwkv_scan_naive(C); } ) PH_END
        PH_BEGIN REP(8,  ph_sb_fast(C); ) REP(64,  ph_dsa_fast(C, l); ) REP(128,  ph_swa_fast(C, l); ) REP(65536,  ph_rwkv_post(C, l); ) PH_END
        PH_BEGIN REP(512,  { pg8::Gemm g{WSP(bf16_t, WS_Y), WSP(bf16_t, WS_WBR + l * SZ_WBR1), 4096, 1024}; pg8::BranchOrder S; S.init(C.G, (int)blockIdx.x);
            pg8::EpiBranch E{WSP(bf16_t, WS_GATE), WSP(bf16_t, WS_G)};
            pg8::gemm_phase<pg8::EpiBranch, pg8::BranchOrder>(ring, g, S, E); } ) PH_END
        PH_BEGIN { pg8::Gemm g{WSP(bf16_t, WS_G), WSP(bf16_t, WS_WOUT + l * SZ_DD), D, D}; pg8::StaticOrder S; S.init(T, D, C.G, (int)blockIdx.x);
            if (l == 0) { pg8::EpiResid<false, true> E{INF32(I_X), WSP(bf16_t, WS_XB)}; pg8::gemm_phase<pg8::EpiResid<false, true>, pg8::StaticOrder>(ring, g, S, E); }
            else { pg8::EpiResid<true, true> E{WSP(bf16_t, WS_XB), WSP(bf16_t, WS_XB)}; pg8::gemm_phase<pg8::EpiResid<true, true>, pg8::StaticOrder>(ring, g, S, E); } } PH_END
        PH_BEGIN if (l == 0) ph_norm<0>(C, WSP(bf16_t, WS_XB), nullptr, INF32(I_FFNN) + l * D, nullptr); else ph_norm<1>(C, WSP(bf16_t, WS_XB), nullptr, INF32(I_FFNN) + l * D, INF32(I_MR)); PH_END
        if (l == 0) {
            PH_BEGIN REP(2,  { pg8::Gemm g{WSP(bf16_t, WS_H), WSP(bf16_t, WS_WGU), D, D}; pg8::StaticOrder S; S.init(T, 2 * FF, C.G, (int)blockIdx.x); pg8::EpiUp E{WSP(bf16_t, WS_ACT)};
                pg8::gemm_phase<pg8::EpiUp, pg8::StaticOrder>(ring, g, S, E); } ) PH_END
            PH_BEGIN REP(2048,  { pg8::Gemm g{WSP(bf16_t, WS_ACT), WSP(bf16_t, WS_WD), FF, FF}; pg8::StaticOrder S; S.init(T, D, C.G, (int)blockIdx.x); pg8::EpiResid<true, true> E{WSP(bf16_t, WS_XB), WSP(bf16_t, WS_XB)};
                pg8::gemm_phase<pg8::EpiResid<true, true>, pg8::StaticOrder>(ring, g, S, E); } ) PH_END
            PH_BEGIN REP(32768,  ph_norm<0>(C, WSP(bf16_t, WS_XB), nullptr, INF32(I_PLEN) + l * D, nullptr); ) PH_END
        } else {
            PH_BEGIN REP(131072,  ph_moe_gather(C); ) PH_END
            PH_BEGIN REP(8192,  { moe_tile_table(C); pg8::MoeOrder S; S.tab = (const LAS int*)(C.lds + MOETAB_OFF); S.NT = __builtin_amdgcn_readfirstlane(S.tab[MOE_MAXRT]); S.nct = NCT_UP; S.G = C.G; S.c = (int)blockIdx.x;
                pg8::Gemm g{WSP(bf16_t, WS_HS), WSP(bf16_t, WS_MWGU), D, D}; pg8::EpiUp E{WSP(bf16_t, WS_ACTS)};
                pg8::gemm_phase<pg8::EpiUp, pg8::MoeOrder>(ring, g, S, E); } ) PH_END
            PH_BEGIN REP(2048,  { moe_tile_table(C); const LAS int* mtab = (const LAS int*)(C.lds + MOETAB_OFF);
                pg8::MoeDownOrder S; S.init(mtab, __builtin_amdgcn_readfirstlane(mtab[MOE_MAXRT]), C.G, (int)blockIdx.x);
                pg8::Gemm g{WSP(bf16_t, WS_ACTS), WSP(bf16_t, WS_MWD), FF, FF}; pg8::EpiMoeDown E{WSP(bf16_t, WS_OS), WSP(float, WS_WSLOT), WSP(float, WS_OSP), S.S};
                pg8::gemm_phase<pg8::EpiMoeDown, pg8::MoeDownOrder>(ring, g, S, E); } ) PH_END
            PH_BEGIN REP(16,  { int toff[NE + 1]; moe_offsets(C, toff); pg8::MoeDownOrder S; S.init(nullptr, toff[NE], C.G, 0); ph_norm<2>(C, WSP(bf16_t, WS_XB), WSP(bf16_t, WS_XB), INF32(I_PLEN) + l * D, nullptr, S.S); } ) PH_END
        }
        PH_BEGIN REP(262144,  { pg8::Gemm g{WSP(bf16_t, WS_H), WSP(bf16_t, WS_WPG + l * SZ_DD), D, D}; pg8::StaticOrder S; S.init(T, D, C.G, (int)blockIdx.x);
            if (l == NL - 1) { pg8::EpiPle<false> E{WSP(bf16_t, WS_XB), C.out, WSP(bf16_t, WS_PROJ) + (size_t)l * T * D}; pg8::gemm_phase<pg8::EpiPle<false>, pg8::StaticOrder>(ring, g, S, E); }
            else { pg8::EpiPle<true> E{WSP(bf16_t, WS_XB), WSP(bf16_t, WS_XB), WSP(bf16_t, WS_PROJ) + (size_t)l * T * D}; pg8::gemm_phase<pg8::EpiPle<true>, pg8::StaticOrder>(ring, g, S, E); } } ) PH_END
    }
    { constexpr int l = 1;
        if (l > 0) { PH_BEGIN REP(32768,  ph_norm<0>(C, WSP(bf16_t, WS_XB), nullptr, INF32(I_MIXN) + l * D, nullptr); ) PH_END }
        PH_BEGIN REP(4096,  { pg8::Gemm g{WSP(bf16_t, WS_H), WSP(bf16_t, WS_WIN + l * SZ_WIN1), D, D}; pg8::StaticOrder S; S.init(T, N_INP, C.G, (int)blockIdx.x);
            pg8::EpiWin E{WSP(bf16_t, WS_SBQKV), WSP(bf16_t, WS_UF), WSP(bf16_t, WS_GATE)};
            pg8::gemm_phase<pg8::EpiWin, pg8::StaticOrder>(ring, g, S, E); } ) PH_END
        PH_BEGIN REP(16384,  ph_prep(C, l); ph_vt(C); ph_latent(C, l); ) PH_END
        PH_BEGIN REP(256,  { pg8::Gemm g{WSP(bf16_t, WS_ALORA), WSP(bf16_t, WS_WLORA + l * SZ_WLORA1), 256, 256}; pg8::StaticOrder S; S.init(T, 3072, C.G, (int)blockIdx.x);
            pg8::EpiLora E{WSP(float, WS_DEC), WSP(bf16_t, WS_AA), WSP(bf16_t, WS_GG), INF32(I_RWW0) + l * 1024, INF32(I_RWA0) + l * 1024};
            pg8::gemm_phase<pg8::EpiLora, pg8::StaticOrder>(ring, g, S, E); } ) PH_END
        PH_BEGIN REP(32,  if (!(DBG_SKIP_MASK & 2)) { if (USE_FAST & 256) { ph_rwkv_scan5<1>(C, l); if (PROBE_MASK & 2097152) ph_rwkv_scan5<0>(C, l); if ((PROBE_MASK & 4194304) && l == 0) ph_rwkv_scan5<PROBE_CONV>(C, l); } else if (USE_FAST & 128) ph_rwkv_scan4(C, l); else if (USE_FAST & 64) ph_rwkv_scan3(C, l); else if (USE_FAST & 32) ph_rwkv_scan_conv(C, l); else if (USE_FAST & 2) ph_rwkv_scan_fast(C); else ph_rwkv_scan_naive(C); } ) PH_END
        PH_BEGIN REP(8,  ph_sb_fast(C); ) REP(64,  ph_dsa_fast(C, l); ) REP(128,  ph_swa_fast(C, l); ) REP(65536,  ph_rwkv_post(C, l); ) PH_END
        PH_BEGIN REP(512,  { pg8::Gemm g{WSP(bf16_t, WS_Y), WSP(bf16_t, WS_WBR + l * SZ_WBR1), 4096, 1024}; pg8::BranchOrder S; S.init(C.G, (int)blockIdx.x);
            pg8::EpiBranch E{WSP(bf16_t, WS_GATE), WSP(bf16_t, WS_G)};
            pg8::gemm_phase<pg8::EpiBranch, pg8::BranchOrder>(ring, g, S, E); } ) PH_END
        PH_BEGIN { pg8::Gemm g{WSP(bf16_t, WS_G), WSP(bf16_t, WS_WOUT + l * SZ_DD), D, D}; pg8::StaticOrder S; S.init(T, D, C.G, (int)blockIdx.x);
            if (l == 0) { pg8::EpiResid<false, true> E{INF32(I_X), WSP(bf16_t, WS_XB)}; pg8::gemm_phase<pg8::EpiResid<false, true>, pg8::StaticOrder>(ring, g, S, E); }
            else { pg8::EpiResid<true, true> E{WSP(bf16_t, WS_XB), WSP(bf16_t, WS_XB)}; pg8::gemm_phase<pg8::EpiResid<true, true>, pg8::StaticOrder>(ring, g, S, E); } } PH_END
        PH_BEGIN if (l == 0) ph_norm<0>(C, WSP(bf16_t, WS_XB), nullptr, INF32(I_FFNN) + l * D, nullptr); else ph_norm<1>(C, WSP(bf16_t, WS_XB), nullptr, INF32(I_FFNN) + l * D, INF32(I_MR)); PH_END
        if (l == 0) {
            PH_BEGIN REP(2,  { pg8::Gemm g{WSP(bf16_t, WS_H), WSP(bf16_t, WS_WGU), D, D}; pg8::StaticOrder S; S.init(T, 2 * FF, C.G, (int)blockIdx.x); pg8::EpiUp E{WSP(bf16_t, WS_ACT)};
                pg8::gemm_phase<pg8::EpiUp, pg8::StaticOrder>(ring, g, S, E); } ) PH_END
            PH_BEGIN REP(2048,  { pg8::Gemm g{WSP(bf16_t, WS_ACT), WSP(bf16_t, WS_WD), FF, FF}; pg8::StaticOrder S; S.init(T, D, C.G, (int)blockIdx.x); pg8::EpiResid<true, true> E{WSP(bf16_t, WS_XB), WSP(bf16_t, WS_XB)};
                pg8::gemm_phase<pg8::EpiResid<true, true>, pg8::StaticOrder>(ring, g, S, E); } ) PH_END
            PH_BEGIN REP(32768,  ph_norm<0>(C, WSP(bf16_t, WS_XB), nullptr, INF32(I_PLEN) + l * D, nullptr); ) PH_END
        } else {
            PH_BEGIN REP(131072,  ph_moe_gather(C); ) PH_END
            PH_BEGIN REP(8192,  { moe_tile_table(C); pg8::MoeOrder S; S.tab = (const LAS int*)(C.lds + MOETAB_OFF); S.NT = __builtin_amdgcn_readfirstlane(S.tab[MOE_MAXRT]); S.nct = NCT_UP; S.G = C.G; S.c = (int)blockIdx.x;
                pg8::Gemm g{WSP(bf16_t, WS_HS), WSP(bf16_t, WS_MWGU), D, D}; pg8::EpiUp E{WSP(bf16_t, WS_ACTS)};
                pg8::gemm_phase<pg8::EpiUp, pg8::MoeOrder>(ring, g, S, E); } ) PH_END
            PH_BEGIN REP(2048,  { moe_tile_table(C); const LAS int* mtab = (const LAS int*)(C.lds + MOETAB_OFF);
                pg8::MoeDownOrder S; S.init(mtab, __builtin_amdgcn_readfirstlane(mtab[MOE_MAXRT]), C.G, (int)blockIdx.x);
                pg8::Gemm g{WSP(bf16_t, WS_ACTS), WSP(bf16_t, WS_MWD), FF, FF}; pg8::EpiMoeDown E{WSP(bf16_t, WS_OS), WSP(float, WS_WSLOT), WSP(float, WS_OSP), S.S};
                pg8::gemm_phase<pg8::EpiMoeDown, pg8::MoeDownOrder>(ring, g, S, E); } ) PH_END
            PH_BEGIN REP(16,  { int toff[NE + 1]; moe_offsets(C, toff); pg8::MoeDownOrder S; S.init(nullptr, toff[NE], C.G, 0); ph_norm<2>(C, WSP(bf16_t, WS_XB), WSP(bf16_t, WS_XB), INF32(I_PLEN) + l * D, nullptr, S.S); } ) PH_END
        }
        PH_BEGIN REP(262144,  { pg8::Gemm g{WSP(bf16_t, WS_H), WSP(bf16_t, WS_WPG + l * SZ_DD), D, D}; pg8::StaticOrder S; S.init(T, D, C.G, (int)blockIdx.x);
            if (l == NL - 1) { pg8::EpiPle<false> E{WSP(bf16_t, WS_XB), C.out, WSP(bf16_t, WS_PROJ) + (size_t)l * T * D}; pg8::gemm_phase<pg8::EpiPle<false>, pg8::StaticOrder>(ring, g, S, E); }
            else { pg8::EpiPle<true> E{WSP(bf16_t, WS_XB), WSP(bf16_t, WS_XB), WSP(bf16_t, WS_PROJ) + (size_t)l * T * D}; pg8::gemm_phase<pg8::EpiPle<true>, pg8::StaticOrder>(ring, g, S, E); } } ) PH_END
    }
#undef PH_BEGIN
#undef PH_END
}

#ifndef MK_ONE_LAUNCH
#define MK_ONE_LAUNCH 0
#endif
extern "C" void kernel_launch(void* const* d_in, const int* in_sizes, int n_in, void* d_out, int out_size, void* d_ws, size_t ws_size, hipStream_t stream) {
    static int grid = 0;
    if (grid == 0) {
        if (n_in != N_INPUTS || out_size != T * D || ws_size < WS_END3) { fprintf(stderr, "kernel_launch: unexpected problem (n_in %d, out %d, ws %zu < %zu)\n", n_in, out_size, ws_size, (size_t)WS_END3); grid = -1; return; }
        int dev = 0, cus = 0, per_cu = 0;
        if (hipGetDevice(&dev) != hipSuccess || hipDeviceGetAttribute(&cus, hipDeviceAttributeMultiprocessorCount, dev) != hipSuccess) { grid = -1; return; }
        if (hipFuncSetAttribute((const void*)fwd_kernel, hipFuncAttributeMaxDynamicSharedMemorySize, LDS_BYTES) != hipSuccess) { fprintf(stderr, "kernel_launch: hipFuncSetAttribute failed\n"); grid = -1; return; }
        if (hipOccupancyMaxActiveBlocksPerMultiprocessor(&per_cu, (const void*)fwd_kernel, NTHR, LDS_BYTES) != hipSuccess || per_cu < 1) fprintf(stderr, "kernel_launch: occupancy query reports %d\n", per_cu);
        (void)hipGetLastError();
        grid = cus;
    }
    if (grid < 0) return;
    (void)hipMemsetAsync((char*)d_ws + WS_CTL, 0, CTL_BYTES, stream);
    Args a{};
    for (int i = 0; i < N_INPUTS; ++i) a.in[i] = d_in[i];
    a.out = (float*)d_out; a.ws = (unsigned char*)d_ws;
#if MK_ONE_LAUNCH
    a.ph_lo = 0; a.ph_hi = N_PHASES;
    hipLaunchKernelGGL(fwd_kernel, dim3(grid), dim3(NTHR), LDS_BYTES, stream, a);
#else
    for (int p = 0; p < N_PHASES; ++p) { a.ph_lo = p; a.ph_hi = p + 1; hipLaunchKernelGGL(fwd_kernel, dim3(grid), dim3(NTHR), LDS_BYTES, stream, a); }
#endif
}
```

```cpp
#define MK_ONE_LAUNCH 1
#include <hip/hip_runtime.h>
#include <cstdio>
#include <cstdint>

#define LAS __attribute__((address_space(3)))
#define GAS __attribute__((address_space(1)))
#define GLB __attribute__((address_space(1)))
typedef unsigned short bf16_t;
typedef short bf16x8 __attribute__((ext_vector_type(8)));
typedef float f32x4 __attribute__((ext_vector_type(4)));
typedef float f32x2 __attribute__((ext_vector_type(2)));
typedef unsigned u32x4 __attribute__((ext_vector_type(4)));
typedef unsigned u32x2 __attribute__((ext_vector_type(2)));

constexpr int NB = 4, SEQ = 2048, T = NB * SEQ, D = 2048, NL = 2;
constexpr int N_IN = 18256, N_INP = 18432, FF = 7168, NE = 8;
constexpr int UFW = 7168;
constexpr int UF_RW = 0, UF_DQ = 3328, UF_CKV = 4352, UF_IQ = 4608, UF_SQ = 5632, UF_SK = 6656, UF_SV = 6784, UF_IK = 6912, UF_IW = 6976;
constexpr int MOE_ROWS = 18432, MOE_MAXRT = 72, NCT_UP = 56, NCT_DN = 8;
constexpr int NWAVES = 8, NTHR = 512;

constexpr size_t WS_CTL = 0, CTL_BYTES = 1u << 20;
constexpr size_t SZ_WIN1 = (size_t)N_INP * D * 2, SZ_WBR1 = (size_t)4 * 2048 * 1024 * 2, SZ_DD = (size_t)D * D * 2;
constexpr size_t SZ_WGU1 = (size_t)2 * FF * D * 2, SZ_WD1 = (size_t)D * FF * 2, SZ_WLORA1 = (size_t)3072 * 256 * 2;
constexpr size_t WS_WIN = CTL_BYTES;
constexpr size_t WS_WBR = WS_WIN + NL * SZ_WIN1;
constexpr size_t WS_WOUT = WS_WBR + NL * SZ_WBR1;
constexpr size_t WS_WGU = WS_WOUT + NL * SZ_DD;
constexpr size_t WS_WD = WS_WGU + SZ_WGU1;
constexpr size_t WS_MWGU = WS_WD + SZ_WD1;
constexpr size_t WS_MWD = WS_MWGU + NE * SZ_WGU1;
constexpr size_t WS_WPG = WS_MWD + NE * SZ_WD1;
constexpr size_t WS_WPP = WS_WPG + NL * SZ_DD;
constexpr size_t WS_WLORA = WS_WPP + (size_t)NL * D * 256 * 2;
constexpr size_t WS_H = WS_WLORA + NL * SZ_WLORA1;
constexpr size_t WS_PCAT = WS_H + (size_t)T * D * 2;
constexpr size_t WS_PROJ = WS_PCAT + (size_t)T * 512 * 2;
constexpr size_t WS_ROUTE = WS_PROJ + (size_t)NL * T * D * 2;
constexpr size_t WS_TOKSLOT = WS_ROUTE + (size_t)T * 32;
constexpr size_t WS_WSLOT = WS_TOKSLOT + (size_t)T * 8;
constexpr size_t WS_ACT0 = WS_WSLOT + (size_t)MOE_ROWS * 4 + 256 * 30;
constexpr size_t SZ_T1K = (size_t)T * 1024 * 4;
constexpr size_t WS_SBQKV = (WS_ACT0 + 255) & ~(size_t)255;
constexpr size_t WS_GATE = WS_SBQKV + (size_t)T * 3072 * 2;
constexpr size_t WS_UF = WS_GATE + (size_t)T * 8192 * 2;
constexpr size_t WS_Y = WS_UF;
constexpr size_t WS_GSUM = WS_Y + (size_t)T * 4096 * 2;
constexpr size_t WS_G = WS_GSUM + (size_t)T * 2048 * 4;
constexpr size_t WS_YRAW = WS_G + (size_t)T * 2048 * 2;
constexpr size_t WS_RW = WS_UF + (size_t)T * UFW * 4;
static_assert(WS_YRAW + SZ_T1K <= WS_RW, "UF aliases");
constexpr size_t WS_R = WS_RW, WS_K = WS_RW + SZ_T1K, WS_V = WS_RW + 2 * SZ_T1K, WS_DEC = WS_RW + 3 * SZ_T1K, WS_AA = WS_RW + 4 * SZ_T1K, WS_KK = WS_RW + 5 * SZ_T1K, WS_GG = WS_RW + 6 * SZ_T1K;
constexpr size_t WS_ALORA = WS_RW + 7 * SZ_T1K;
constexpr size_t WS_QD = WS_ALORA + (size_t)T * 256 * 2;
constexpr size_t WS_KD = WS_QD + (size_t)T * 1024 * 2;
constexpr size_t WS_VD = WS_KD + (size_t)T * 128 * 2;
constexpr size_t WS_QI = WS_VD + (size_t)T * 128 * 2;
constexpr size_t WS_KI = WS_QI + (size_t)T * 1024 * 2;
constexpr size_t WS_WI = WS_KI + (size_t)T * 64 * 2;
constexpr size_t WS_QS = WS_WI + (size_t)T * 16 * 4;
constexpr size_t WS_KS = WS_QS + (size_t)T * 1024 * 2;
constexpr size_t WS_VS = WS_KS + (size_t)T * 128 * 2;
constexpr size_t WS_MIX_END = WS_VS + (size_t)T * 128 * 2;
constexpr size_t WS_ACT = WS_SBQKV;
constexpr size_t WS_HS = WS_SBQKV;
constexpr size_t WS_ACTS = WS_HS + (size_t)MOE_ROWS * D * 2;
constexpr size_t WS_OS = WS_ACTS + (size_t)MOE_ROWS * FF * 2;
constexpr size_t WS_OSP = WS_OS + (size_t)MOE_ROWS * D * 4;
constexpr size_t WS_FFN_END = WS_OSP + (size_t)256 * 65536 * 4;
constexpr size_t WS_END = WS_MIX_END > WS_FFN_END ? WS_MIX_END : WS_FFN_END;
static_assert(WS_END < (size_t)2000 * 1000 * 1000, "workspace budget");

constexpr int CW_BAR = 4096;
constexpr int CW_MOECNT = 8192;

constexpr int RING_BYTES = 131072;
constexpr int MISC_OFF = 143360;
constexpr int LDS_BYTES = 147456;

#define LDS_WAIT() asm volatile("s_waitcnt lgkmcnt(0)" ::: "memory")
#define VM_WAIT() asm volatile("s_waitcnt vmcnt(0)" ::: "memory")
__device__ __forceinline__ float bflo(unsigned u) { return __builtin_bit_cast(float, u << 16); }
__device__ __forceinline__ float bfhi(unsigned u) { return __builtin_bit_cast(float, u & 0xffff0000u); }
__device__ __forceinline__ float bf1(bf16_t u) { return __builtin_bit_cast(float, (unsigned)u << 16); }
__device__ __forceinline__ unsigned f2bf(float f) { unsigned u = __builtin_bit_cast(unsigned, f); return (u + 0x7fffu + ((u >> 16) & 1u)) >> 16; }
typedef __bf16 bf16x2v __attribute__((ext_vector_type(2)));
__device__ __forceinline__ unsigned pk2(float lo, float hi) { const f32x2 v = {lo, hi}; return __builtin_bit_cast(unsigned, __builtin_convertvector(v, bf16x2v)); }
__device__ __forceinline__ float wave_sum(float v) {
#pragma unroll
    for (int o = 1; o < 64; o <<= 1) v += __shfl_xor(v, o);
    return v;
}
__device__ __forceinline__ float wave_max(float v) {
#pragma unroll
    for (int o = 1; o < 64; o <<= 1) v = fmaxf(v, __shfl_xor(v, o));
    return v;
}
__device__ __forceinline__ float sigmoidf_(float x) { return __builtin_amdgcn_rcpf(1.0f + __builtin_amdgcn_exp2f(-1.4426950408889634f * x)); }
__device__ __forceinline__ float logsigf_(float x) { return fminf(x, 0.f) - __logf(1.0f + __expf(-fabsf(x))); }
__device__ __forceinline__ float rdlane(float v, int l) { return __builtin_bit_cast(float, __builtin_amdgcn_readlane(__builtin_bit_cast(int, v), l)); }

#define XB_TMO      128
#define XB_XCNT(j)  (256  + 64 * (j))
#define XB_XSUB(j)  (1280 + 64 * (j))
#define XB_XGEN(j)  (2304 + 64 * (j))
#define XB_TOP      3328
#define XB_TOPGEN   3392
#define XCD_BAR_WORDS 3456
#define XB_SPIN_CAP (1u << 18)
__device__ __forceinline__ unsigned xb_ld(unsigned* p)              { return __hip_atomic_load(p, __ATOMIC_RELAXED, __HIP_MEMORY_SCOPE_AGENT); }
__device__ __forceinline__ unsigned xb_add(unsigned* p, unsigned v) { return __hip_atomic_fetch_add(p, v, __ATOMIC_RELAXED, __HIP_MEMORY_SCOPE_AGENT); }
__device__ __forceinline__ unsigned xb_xcc_id() { return (unsigned)__builtin_amdgcn_s_getreg((3 << 11) | 20) & 0xFu; }
#define XB_SPIN(cond, bar) do { unsigned _sp = 0; while (cond) { __builtin_amdgcn_s_sleep(1); \
    if ((++_sp & 255u) == 0u) { if (xb_ld(&(bar)[XB_TMO])) break; if (_sp > XB_SPIN_CAP) { atomicAdd(&(bar)[XB_TMO], 1u); break; } } } } while (0)
struct XcdBarrier { unsigned* bar; unsigned x; volatile LAS unsigned* st; };
__device__ __forceinline__ XcdBarrier xcd_barrier_post(unsigned* bar, volatile LAS unsigned* st) {
    XcdBarrier b; b.bar = bar; b.x = xb_xcc_id(); b.st = st;
    if (threadIdx.x == 0) (void)xb_add(&bar[XB_XCNT(b.x)], 1u);
    return b;
}
__device__ __forceinline__ void xcd_barrier_complete(unsigned* bar, unsigned x, unsigned& nloc, unsigned& nx) {
    const unsigned G = gridDim.x * gridDim.y * gridDim.z;
    unsigned sum, cnt, mine, sp = 0u;
    for (;;) {
        sum = 0u; cnt = 0u; mine = 0u;
#pragma unroll
        for (unsigned j = 0; j < 16; ++j) { const unsigned c = xb_ld(&bar[XB_XCNT(j)]); sum += c; cnt += (c > 0u) ? 1u : 0u; mine = (j == x) ? c : mine; }
        if (sum == G) break;
        __builtin_amdgcn_s_sleep(1);
        if ((++sp & 255u) == 0u) { if (xb_ld(&bar[XB_TMO])) break; if (sp > XB_SPIN_CAP) { atomicAdd(&bar[XB_TMO], 1u); break; } }
    }
    nloc = mine > 0u ? mine : 1u; nx = cnt > 0u ? cnt : 1u;
}
__device__ __forceinline__ void xcd_barrier(const XcdBarrier& b) {
    asm volatile("s_waitcnt vmcnt(0)" ::: "memory");
    __syncthreads();
    if (threadIdx.x == 0) {
        unsigned* bar = b.bar;
        __builtin_amdgcn_s_waitcnt(0);
        unsigned nloc = b.st[0], nx = b.st[1];
        if (nloc == 0u) { xcd_barrier_complete(bar, b.x, nloc, nx); b.st[0] = nloc; b.st[1] = nx; }
        const unsigned old = xb_add(&bar[XB_XSUB(b.x)], 1u);
        const unsigned gen = old / nloc;
        if (old + 1u == (gen + 1u) * nloc) {
            __builtin_amdgcn_fence(__ATOMIC_RELEASE, "agent");
            asm volatile("s_waitcnt vmcnt(0)" ::: "memory");
            const unsigned og = xb_add(&bar[XB_TOP], 1u);
            const unsigned tg = og / nx;
            if (og + 1u == (tg + 1u) * nx) xb_add(&bar[XB_TOPGEN], 1u);
            else XB_SPIN(xb_ld(&bar[XB_TOPGEN]) == tg, bar);
            __builtin_amdgcn_fence(__ATOMIC_ACQUIRE, "agent");
            xb_add(&bar[XB_XGEN(b.x)], 1u);
            asm volatile("s_waitcnt vmcnt(0)" ::: "memory");
        } else {
            XB_SPIN(xb_ld(&bar[XB_XGEN(b.x)]) == gen, bar);
            __builtin_amdgcn_fence(__ATOMIC_ACQUIRE, "agent");
            asm volatile("s_waitcnt vmcnt(0)" ::: "memory");
        }
    }
    __syncthreads();
}
namespace pg8 {
#define PG8_LAS __attribute__((address_space(3)))
#ifndef PG8_WGM
#define PG8_WGM 4
#endif
constexpr int BM = 256, BK = 64, HALF = 128, HTB = HALF * BK * 2, STAGE_BYTES = 8 * HTB, NXCD = 8, WGM = PG8_WGM;
__host__ __device__ __forceinline__ int lds_byte(int r, int c) { const int st = (r >> 4) * 2 + (c >> 5), rr = r & 15, cc = c & 31, ob = rr * 64 + cc * 2; return st * 1024 + (ob ^ (((ob >> 9) & 1) << 5)); }
__host__ __device__ __forceinline__ void stage_rc(int b, int& R, int& C) { const int st = b / 1024, sb = b % 1024, swz = sb ^ (((sb >> 9) & 1) << 5); R = (st >> 1) * 16 + swz / 64; C = (st & 1) * 32 + (swz % 64) / 2; }
__host__ __device__ __forceinline__ int perm32(int rho) { const int n = rho >> 4, i = rho & 15; return 8 * (i >> 2) + 4 * n + (i & 3); }

struct Unit { int pm, pn, ka, kb, nt, aux; };
struct Gemm { const GLB bf16_t* A; const GLB bf16_t* Bt; int lda, K; };

struct StaticOrder {
    int nM, nN, nwg, G, c;
    __device__ __forceinline__ void init(int M, int N, int G_, int c_) { nM = M / BM; nN = N / BM; nwg = nM * nN; G = G_; c = c_; }
    __device__ __forceinline__ bool tile(long L, Unit& u) const {
        if (L >= nwg) return false;
        int wgid = (int)L; { const int q = nwg / NXCD, r = nwg % NXCD, xcd = wgid % NXCD, off = wgid / NXCD; wgid = (xcd < r ? xcd * (q + 1) : r * (q + 1) + (xcd - r) * q) + off; }
        const int nig = WGM * nN, gid = wgid / nig, fm = gid * WGM, gsz = (nM - fm) < WGM ? (nM - fm) : WGM;
        u.pm = fm + ((wgid % nig) % gsz); u.pn = (wgid % nig) / gsz; u.ka = 0; u.kb = 0; u.nt = 0; u.aux = 0; return true;
    }
    __device__ __forceinline__ bool next(int i, Unit& u) const { return tile((long)i * G + c, u); }
};
struct BranchOrder {
    int G, c, cnt;
    __device__ __forceinline__ void init(int G_, int c_) { G = G_; c = c_; cnt = (c_ < 256) ? (255 - c_) / G_ + 1 : 0; }
    __device__ __forceinline__ bool next(int i, Unit& u) const {
        if (cnt == 0) return false;
        const int n = i / cnt, r = i - n * cnt; if (n >= 4) return false;
        StaticOrder so; so.init(T, 2048, G, c); so.tile((long)r * G + c, u);
        u.pn += n * 8; u.ka = n * 1024; return true;
    }
};
struct ProjOrder {
    StaticOrder so;
    __device__ __forceinline__ void init(int G_, int c_) { so.init(T, 4096, G_, c_); }
    __device__ __forceinline__ bool next(int i, Unit& u) const { if (!so.next(i, u)) return false; u.ka = (u.pn >> 3) * 256; return true; }
};
struct MoeOrder {
    const PG8_LAS int* tab; int NT, nct, G, c;
    __device__ __forceinline__ bool next(int i, Unit& u) const {
        StaticOrder so; so.nM = NT; so.nN = nct; so.nwg = NT * nct; so.G = G; so.c = c;
        if (!so.tile((long)i * G + c, u)) return false;
        const int e = __builtin_amdgcn_readfirstlane(tab[u.pm]);
        u.pn += e * nct; u.ka = 0; return true;
    }
};

struct MoeDownOrder {
    const PG8_LAS int* tab; int NT, G, c, S;
    __device__ __forceinline__ void init(const PG8_LAS int* tab_, int NT_, int G_, int c_) { tab = tab_; NT = NT_; G = G_; c = c_;
        const int tu = (NT_ - 64) * 8; S = (tu <= 0) ? 1 : ((tu * 8 <= G_) ? 8 : ((tu * 4 <= G_) ? 4 : ((tu * 2 <= G_) ? 2 : 1))); }
    __device__ __forceinline__ bool next(int i, Unit& u) const {
        const int F = (NT < 64) ? NT : 64, nfull = F * 8, rf = (nfull + G - 1) / G;
        if (i < rf) {
            StaticOrder so; so.nM = F; so.nN = 8; so.nwg = nfull; so.G = G; so.c = c;
            if (so.tile((long)i * G + c, u)) { const int e = __builtin_amdgcn_readfirstlane(tab[u.pm]); u.pn += e * 8; return true; }
            i = rf;
        }
        const int q = (i - rf) * G + c, ntail = (NT - F) * 8 * S;
        if (q >= ntail) return false;
        const int tu = q / S, sl = q - tu * S, rt = F + (tu >> 3), pl = tu & 7;
        const int e = __builtin_amdgcn_readfirstlane(tab[rt]);
        u.pm = rt; u.pn = e * 8 + pl; u.ka = sl * (FF / S); u.kb = u.ka; u.nt = (FF / 64) / S; u.aux = 1 + sl; return true;
    }
};

template <class Epi, class Sched>
__device__ __forceinline__ void gemm_phase(PG8_LAS unsigned char* lds, const Gemm g, const Sched& S, const Epi& E) {
    int tid = threadIdx.x; asm volatile("" : "+v"(tid));
    const int wid = __builtin_amdgcn_readfirstlane(tid >> 6), lane = tid & 63, wr = wid >> 2, wc = wid & 3, fr = lane & 15, fq = lane >> 4;
    int K = g.K, lda = g.lda; asm volatile("" : "+s"(K), "+s"(lda));
    const int nt = K / BK;
    unsigned voffA[2], voffB[2];
#pragma unroll
    for (int i = 0; i < 2; ++i) { int R, C; stage_rc(tid * 16 + i * 8192, R, C); const int Rb = Epi::PERM ? ((R & ~31) + perm32(R & 31)) : R;
        voffA[i] = (unsigned)(R * lda + C) * 2u; voffB[i] = (unsigned)(Rb * K + C) * 2u; }
    const size_t kstep = (size_t)(BK * 2);
    const size_t hstepA = (size_t)HALF * lda * 2, hstepB = (size_t)HALF * K * 2;
    const size_t tstepA = 2 * hstepA, tstepB = 2 * hstepB;
    const unsigned ldsw = (unsigned)wid * 1024u;
    const int aoff = lds_byte(wr * 64 + fr, fq * 8), boff = lds_byte(wc * 32 + fr, fq * 8);
#define PG8_SA(b, h) (((b) * 2 + (h)) * HTB)
#define PG8_SB(b, h) ((4 + (b) * 2 + (h)) * HTB)
#define PG8_STAGE(bufoff, gbase, voff) do { _Pragma("unroll") for (int _i = 0; _i < 2; ++_i) \
        __builtin_amdgcn_global_load_lds((const GLB unsigned*)((const char*)(gbase) + (voff)[_i]), (PG8_LAS unsigned*)(lds + (bufoff) + ldsw + _i * 8192), 16, 0, 0); } while (0)
#define PG8_LDA(dst, b, h) do { _Pragma("unroll") for (int m = 0; m < 4; ++m) _Pragma("unroll") for (int k = 0; k < 2; ++k) dst[m][k] = *(const PG8_LAS bf16x8*)(lds + PG8_SA(b, h) + aoff + m * 2048 + k * 1024); } while (0)
#define PG8_LDB(dst, b, h) do { _Pragma("unroll") for (int n = 0; n < 2; ++n) _Pragma("unroll") for (int k = 0; k < 2; ++k) dst[n][k] = *(const PG8_LAS bf16x8*)(lds + PG8_SB(b, h) + boff + n * 2048 + k * 1024); } while (0)
#define PG8_MMA(ai, bj, At, Bt) do { __builtin_amdgcn_s_setprio(1); _Pragma("unroll") for (int m = 0; m < 4; ++m) _Pragma("unroll") for (int n = 0; n < 2; ++n) _Pragma("unroll") for (int k = 0; k < 2; ++k) \
        acc[ai][bj][m][n] = __builtin_amdgcn_mfma_f32_16x16x32_bf16(Bt[n][k], At[m][k], acc[ai][bj][m][n], 0, 0, 0); __builtin_amdgcn_s_setprio(0); } while (0)
#define PG8_WAIT_V(n) asm volatile("s_waitcnt vmcnt(" #n ")" ::: "memory")
#define PG8_WAIT_L(n) asm volatile("s_waitcnt lgkmcnt(" #n ")" ::: "memory")
#define PG8_BAR __builtin_amdgcn_s_barrier()
#define PG8_SCHED __builtin_amdgcn_sched_barrier(0)
    Unit cur, nxt; int ui = 0;
    if (!S.next(0, cur)) return;
    f32x4 acc[2][2][4][2];
#pragma unroll
    for (int a = 0; a < 2; ++a)
#pragma unroll
        for (int b = 0; b < 2; ++b)
#pragma unroll
            for (int m = 0; m < 4; ++m)
#pragma unroll
                for (int n = 0; n < 2; ++n) acc[a][b][m][n] = (f32x4){0.f, 0.f, 0.f, 0.f};
    bf16x8 At[4][2], B0[2][2], B1[2][2];
    const char* cA = (const char*)g.A + (size_t)cur.pm * tstepA + (size_t)cur.ka * 2; const char* cB = (const char*)g.Bt + (size_t)cur.pn * tstepB + (size_t)cur.kb * 2;
    PG8_STAGE(PG8_SB(0, 0), cB, voffB); PG8_STAGE(PG8_SB(0, 1), cB + hstepB, voffB); PG8_STAGE(PG8_SA(0, 0), cA, voffA); PG8_STAGE(PG8_SA(0, 1), cA + hstepA, voffA);
    if (wr == 1) PG8_BAR;
    PG8_WAIT_V(2); PG8_BAR;
    PG8_STAGE(PG8_SB(1, 0), cB + kstep, voffB); PG8_STAGE(PG8_SA(1, 0), cA + kstep, voffA); PG8_STAGE(PG8_SB(1, 1), cB + hstepB + kstep, voffB);
    PG8_WAIT_V(6); PG8_BAR;
    for (;;) {
        const bool has_next = S.next(ui + 1, nxt);
        const char* nA = has_next ? (const char*)g.A + (size_t)nxt.pm * tstepA + (size_t)nxt.ka * 2 : cA; const char* nB = has_next ? (const char*)g.Bt + (size_t)nxt.pn * tstepB + (size_t)nxt.kb * 2 : cB;
        const int ntu = cur.nt ? cur.nt : nt;
        for (int t = 0; t < ntu; t += 2) {
            const bool last = (t == ntu - 2);
            const char* a1 = cA + (size_t)(t + 1) * kstep;
            const char* a2 = last ? nA : cA + (size_t)(t + 2) * kstep; const char* b2 = last ? nB : cB + (size_t)(t + 2) * kstep;
            const char* a3 = a2 + kstep; const char* b3 = b2 + kstep;
            PG8_LDB(B0, 0, 0); PG8_LDB(B1, 0, 1); PG8_SCHED; PG8_LDA(At, 0, 0); PG8_STAGE(PG8_SA(1, 1), a1 + hstepA, voffA);
            PG8_WAIT_V(8); PG8_WAIT_L(0); PG8_BAR; PG8_MMA(0, 0, At, B0); PG8_MMA(0, 1, At, B1); PG8_BAR; PG8_SCHED;
            PG8_LDA(At, 0, 1); PG8_STAGE(PG8_SB(0, 0), b2, voffB); PG8_STAGE(PG8_SB(0, 1), b2 + hstepB, voffB); PG8_STAGE(PG8_SA(0, 0), a2, voffA);
            PG8_WAIT_V(8); PG8_WAIT_L(0); PG8_BAR; PG8_MMA(1, 0, At, B0); PG8_MMA(1, 1, At, B1); PG8_BAR; PG8_SCHED;
            PG8_LDB(B0, 1, 0); PG8_LDB(B1, 1, 1); PG8_SCHED; PG8_LDA(At, 1, 0); PG8_STAGE(PG8_SA(0, 1), a2 + hstepA, voffA);
            PG8_WAIT_V(8); PG8_WAIT_L(0); PG8_BAR; PG8_MMA(0, 0, At, B0); PG8_MMA(0, 1, At, B1); PG8_BAR; PG8_SCHED;
            PG8_LDA(At, 1, 1); PG8_STAGE(PG8_SB(1, 0), b3, voffB); PG8_STAGE(PG8_SB(1, 1), b3 + hstepB, voffB); PG8_STAGE(PG8_SA(1, 0), a3, voffA);
            PG8_WAIT_V(8); PG8_WAIT_L(0); PG8_BAR; PG8_MMA(1, 0, At, B0); PG8_MMA(1, 1, At, B1); PG8_BAR; PG8_SCHED;
        }
        if (wr == 0) PG8_BAR;
        E(acc, cur, wr, wc, fr, fq);
        if (!has_next) break;
#pragma unroll
        for (int a = 0; a < 2; ++a)
#pragma unroll
            for (int b = 0; b < 2; ++b)
#pragma unroll
                for (int m = 0; m < 4; ++m)
#pragma unroll
                    for (int n = 0; n < 2; ++n) acc[a][b][m][n] = (f32x4){0.f, 0.f, 0.f, 0.f};
        cur = nxt; cA = nA; cB = nB; ++ui;
        if (wr == 1) PG8_BAR;
    }
    PG8_WAIT_V(0);
    PG8_BAR;
#undef PG8_SA
#undef PG8_SB
#undef PG8_STAGE
#undef PG8_LDA
#undef PG8_LDB
#undef PG8_MMA
#undef PG8_WAIT_V
#undef PG8_WAIT_L
#undef PG8_BAR
#undef PG8_SCHED
}

#define EPI_ROWS(u) const int row0 = (u).pm * BM + wr * 64 + fr; const int ct0 = wc * 32 + 8 * fq
#define EPI_FOR_ROWS _Pragma("unroll") for (int ai = 0; ai < 2; ++ai) _Pragma("unroll") for (int m = 0; m < 4; ++m)
__device__ __forceinline__ u32x4 pack8(f32x4 v0, f32x4 v1) { u32x4 w; w.x = pk2(v0[0], v0[1]); w.y = pk2(v0[2], v0[3]); w.z = pk2(v1[0], v1[1]); w.w = pk2(v1[2], v1[3]); return w; }
__device__ __forceinline__ void unpack8(u32x4 w, f32x4& v0, f32x4& v1) { v0 = (f32x4){bflo(w.x), bfhi(w.x), bflo(w.y), bfhi(w.y)}; v1 = (f32x4){bflo(w.z), bfhi(w.z), bflo(w.w), bfhi(w.w)}; }
__device__ __forceinline__ f32x4 sig4(f32x4 v) { return (f32x4){sigmoidf_(v[0]), sigmoidf_(v[1]), sigmoidf_(v[2]), sigmoidf_(v[3])}; }

struct EpiWin { static constexpr bool PERM = true;
    GLB bf16_t* sbqkv; GLB bf16_t* uf; GLB bf16_t* gate;
    __device__ __forceinline__ void operator()(const f32x4 (&acc)[2][2][4][2], const Unit& u, int wr, int wc, int fr, int fq) const {
        EPI_ROWS(u); const int pn = u.pn;
        if (pn < 40) {
            GLB bf16_t* base = (pn < 12) ? sbqkv + pn * 256 : uf + (pn - 12) * 256; const int ld = (pn < 12) ? 3072 : UFW;
            EPI_FOR_ROWS { GLB bf16_t* rp = base + (size_t)(row0 + ai * HALF + m * 16) * ld + ct0;
#pragma unroll
                for (int bj = 0; bj < 2; ++bj) *(GLB u32x4*)(rp + bj * HALF) = pack8(acc[ai][bj][m][0], acc[ai][bj][m][1]); }
        } else {
            EPI_FOR_ROWS { GLB bf16_t* rp = gate + (size_t)(row0 + ai * HALF + m * 16) * 8192 + (pn - 40) * 256 + ct0;
#pragma unroll
                for (int bj = 0; bj < 2; ++bj) *(GLB u32x4*)(rp + bj * HALF) = pack8(sig4(acc[ai][bj][m][0]), sig4(acc[ai][bj][m][1])); }
        }
    }
};
struct EpiNull { static constexpr bool PERM = true;
    __device__ __forceinline__ void operator()(const f32x4 (&acc)[2][2][4][2], const Unit& u, int wr, int wc, int fr, int fq) const {
#pragma unroll
        for (int ai = 0; ai < 2; ++ai)
#pragma unroll
            for (int bj = 0; bj < 2; ++bj) asm volatile("" :: "v"(acc[ai][bj][0][0]), "v"(acc[ai][bj][0][1]), "v"(acc[ai][bj][1][0]), "v"(acc[ai][bj][1][1]), "v"(acc[ai][bj][2][0]), "v"(acc[ai][bj][2][1]), "v"(acc[ai][bj][3][0]), "v"(acc[ai][bj][3][1]));
    }
};
struct EpiLora { static constexpr bool PERM = true;
    GLB float* dec; GLB bf16_t* aa; GLB bf16_t* gg; const GLB float* w0; const GLB float* a0;
    __device__ __forceinline__ void operator()(const f32x4 (&acc)[2][2][4][2], const Unit& u, int wr, int wc, int fr, int fq) const {
        EPI_ROWS(u); const int kind = u.pn >> 2, cb = (u.pn & 3) * 256 + ct0;
        EPI_FOR_ROWS { const size_t ro = (size_t)(row0 + ai * HALF + m * 16) * 1024 + cb;
#pragma unroll
            for (int bj = 0; bj < 2; ++bj) { const int co = bj * HALF;
                if (kind == 0) {
#pragma unroll
                    for (int n = 0; n < 2; ++n) { const f32x4 v = acc[ai][bj][m][n]; const f32x4 b = *(const GLB f32x4*)(w0 + cb + co + 4 * n); f32x4 o;
#pragma unroll
                        for (int j = 0; j < 4; ++j) { const float pre = v[j] + b[j]; const float y = -pre; const float sp = fmaxf(y, 0.f) + __logf(1.0f + __expf(-fabsf(y)));
                            o[j] = __expf(-__expf(-sp - 0.5f)); }
                        *(GLB f32x4*)(dec + ro + co + 4 * n) = o; }
                } else if (kind == 1) { const f32x4 b0 = *(const GLB f32x4*)(a0 + cb + co), b1 = *(const GLB f32x4*)(a0 + cb + co + 4);
                    *(GLB u32x4*)(aa + ro + co) = pack8(sig4(acc[ai][bj][m][0] + b0), sig4(acc[ai][bj][m][1] + b1)); }
                else *(GLB u32x4*)(gg + ro + co) = pack8(acc[ai][bj][m][0], acc[ai][bj][m][1]); } }
    }
};
struct EpiBranch { static constexpr bool PERM = true;
    const GLB bf16_t* gate; GLB bf16_t* gout;
    __device__ __forceinline__ void operator()(const f32x4 (&acc)[2][2][4][2], const Unit& u, int wr, int wc, int fr, int fq) const {
        EPI_ROWS(u); const int n = u.pn >> 3, cb = (u.pn & 7) * 256 + ct0;
        EPI_FOR_ROWS { const size_t r = (size_t)(row0 + ai * HALF + m * 16);
#pragma unroll
            for (int bj = 0; bj < 2; ++bj) { const int c = cb + bj * HALF; f32x4 g0, g1; unpack8(*(const GLB u32x4*)(gate + r * 8192 + n * 2048 + c), g0, g1);
                f32x4 s0 = g0 * acc[ai][bj][m][0], s1 = g1 * acc[ai][bj][m][1];
                GLB u32x4* gp = (GLB u32x4*)(gout + r * 2048 + c);
                if (n > 0) { f32x4 p0, p1; unpack8(*gp, p0, p1); s0 += p0; s1 += p1; }
                *gp = pack8(s0, s1); } }
    }
};
template <bool RB, bool OB>
struct EpiResid { static constexpr bool PERM = true;
    const GLB void* resid; GLB void* out;
    __device__ __forceinline__ void operator()(const f32x4 (&acc)[2][2][4][2], const Unit& u, int wr, int wc, int fr, int fq) const {
        EPI_ROWS(u); const int cb = u.pn * 256 + ct0;
        EPI_FOR_ROWS { const size_t ro = (size_t)(row0 + ai * HALF + m * 16) * D + cb;
#pragma unroll
            for (int bj = 0; bj < 2; ++bj) { f32x4 r0, r1;
                if (RB) unpack8(*(const GLB u32x4*)((const GLB bf16_t*)resid + ro + bj * HALF), r0, r1);
                else { r0 = *(const GLB f32x4*)((const GLB float*)resid + ro + bj * HALF); r1 = *(const GLB f32x4*)((const GLB float*)resid + ro + bj * HALF + 4); }
                r0 = r0 + acc[ai][bj][m][0]; r1 = r1 + acc[ai][bj][m][1];
                if (OB) *(GLB u32x4*)((GLB bf16_t*)out + ro + bj * HALF) = pack8(r0, r1);
                else { *(GLB f32x4*)((GLB float*)out + ro + bj * HALF) = r0; *(GLB f32x4*)((GLB float*)out + ro + bj * HALF + 4) = r1; } } }
    }
};
struct EpiUp { static constexpr bool PERM = true;
    GLB bf16_t* act;
    __device__ __forceinline__ void operator()(const f32x4 (&acc)[2][2][4][2], const Unit& u, int wr, int wc, int fr, int fq) const {
        EPI_ROWS(u); const int cb = (u.pn % NCT_UP) * 128 + ct0;
        EPI_FOR_ROWS { f32x4 o[2];
#pragma unroll
            for (int n = 0; n < 2; ++n) { const f32x4 g = acc[ai][0][m][n], up = acc[ai][1][m][n];
#pragma unroll
                for (int j = 0; j < 4; ++j) o[n][j] = g[j] * sigmoidf_(g[j]) * up[j]; }
            *(GLB u32x4*)(act + (size_t)(row0 + ai * HALF + m * 16) * FF + cb) = pack8(o[0], o[1]); }
    }
};
struct EpiMoeDown { static constexpr bool PERM = true;
    GLB bf16_t* os; const GLB float* wslot; GLB float* osp; int S;
    __device__ __forceinline__ void operator()(const f32x4 (&acc)[2][2][4][2], const Unit& u, int wr, int wc, int fr, int fq) const {
        EPI_ROWS(u); const int pl = u.pn % NCT_DN;
        if (u.aux == 0) {
            const int cb = pl * 256 + ct0;
            EPI_FOR_ROWS { const int r = row0 + ai * HALF + m * 16; const float w = wslot[r]; GLB bf16_t* rp = os + (size_t)r * D + cb;
#pragma unroll
                for (int bj = 0; bj < 2; ++bj) *(GLB u32x4*)(rp + bj * HALF) = pack8(acc[ai][bj][m][0] * w, acc[ai][bj][m][1] * w); }
        } else {
            GLB float* tp = osp + ((size_t)(((u.pm - 64) * 8 + pl) * S + (u.aux - 1)) << 16);
            EPI_FOR_ROWS { const int rl = wr * 64 + fr + ai * HALF + m * 16; const float w = wslot[u.pm * BM + rl]; GLB float* rp = tp + rl * 256 + ct0;
#pragma unroll
                for (int bj = 0; bj < 2; ++bj) { *(GLB f32x4*)(rp + bj * HALF) = acc[ai][bj][m][0] * w; *(GLB f32x4*)(rp + bj * HALF + 4) = acc[ai][bj][m][1] * w; } }
        }
    }
};
template <bool OB>
struct EpiPle { static constexpr bool PERM = true;
    const GLB bf16_t* resid; GLB void* out; const GLB bf16_t* proj;
    __device__ __forceinline__ void operator()(const f32x4 (&acc)[2][2][4][2], const Unit& u, int wr, int wc, int fr, int fq) const {
        EPI_ROWS(u); const int cb = u.pn * 256 + ct0;
        EPI_FOR_ROWS { const size_t ro = (size_t)(row0 + ai * HALF + m * 16) * D + cb;
#pragma unroll
            for (int bj = 0; bj < 2; ++bj) { f32x4 p0, p1, r0, r1; unpack8(*(const GLB u32x4*)(proj + ro + bj * HALF), p0, p1); unpack8(*(const GLB u32x4*)(resid + ro + bj * HALF), r0, r1);
                r0 = r0 + sig4(acc[ai][bj][m][0]) * p0; r1 = r1 + sig4(acc[ai][bj][m][1]) * p1;
                if (OB) *(GLB u32x4*)((GLB bf16_t*)out + ro + bj * HALF) = pack8(r0, r1);
                else { *(GLB f32x4*)((GLB float*)out + ro + bj * HALF) = r0; *(GLB f32x4*)((GLB float*)out + ro + bj * HALF + 4) = r1; } } }
    }
};
struct EpiProj { static constexpr bool PERM = true;
    GLB bf16_t* proj;
    __device__ __forceinline__ void operator()(const f32x4 (&acc)[2][2][4][2], const Unit& u, int wr, int wc, int fr, int fq) const {
        EPI_ROWS(u); GLB bf16_t* base = proj + (size_t)(u.pn >> 3) * T * D + (u.pn & 7) * 256 + ct0;
        EPI_FOR_ROWS { GLB bf16_t* rp = base + (size_t)(row0 + ai * HALF + m * 16) * D;
#pragma unroll
            for (int bj = 0; bj < 2; ++bj) *(GLB u32x4*)(rp + bj * HALF) = pack8(acc[ai][bj][m][0], acc[ai][bj][m][1]); }
    }
};
}
struct Ctx {
    LAS unsigned char* lds;
    GLB unsigned char* ws;
    GLB float* out;
    int tid, lane, wave, gw, NGW, G;
};
#define WSP(type, off) ((GLB type*)(C.ws + (off)))
constexpr int INTAB_OFF = MISC_OFF + 1024;
constexpr int TAB_WS = 37, TAB_OUT = 38, TAB_RANGE = 39;
__device__ __forceinline__ const GLB void* inptr(LAS unsigned char* lds, int i) {
    const LAS unsigned* t = (const LAS unsigned*)(lds + INTAB_OFF) + 2 * i;
    const unsigned lo = __builtin_amdgcn_readfirstlane(t[0]), hi = __builtin_amdgcn_readfirstlane(t[1]);
    return (const GLB void*)(((unsigned long long)hi << 32) | lo);
}
#define INF32(i) ((const GLB float*)inptr(C.lds, (i)))
__device__ __forceinline__ Ctx make_ctx(LAS unsigned char* lds) {
    Ctx C; C.lds = lds;
    int tid = threadIdx.x; asm volatile("" : "+v"(tid));
    C.tid = tid; C.lane = tid & 63; C.wave = __builtin_amdgcn_readfirstlane(tid >> 6);
    C.G = gridDim.x; C.gw = blockIdx.x * NWAVES + C.wave; C.NGW = C.G * NWAVES;
    C.ws = (GLB unsigned char*)inptr(lds, TAB_WS); C.out = (GLB float*)inptr(lds, TAB_OUT);
    return C;
}
enum { I_X = 0, I_P, I_POS, I_WIN, I_MIXN, I_FFNN, I_PLEN, I_RWMU, I_RWW0, I_RWW2, I_RWA0, I_RWA2, I_RWG2, I_RWKK, I_RWKA, I_RWRK, I_RWLNG, I_RWLNB,
       I_DQN, I_DKN, I_DKVN, I_DWUK, I_DWUV, I_SQN, I_SKN, I_SSINK, I_WBR, I_WOUT, I_FG, I_FU, I_FD, I_MR, I_MG, I_MU, I_MD, I_PG, I_PP, N_INPUTS };

__device__ __forceinline__ void conv_tile(const GLB float* W, int ldw, int k0, int s0, int nv, GLB bf16_t* Bt, int K, int n0, LAS float* scr, int lane) {
    const int cq = lane & 15, rq = lane >> 4;
    f32x4 v[16];
#pragma unroll
    for (int i = 0; i < 16; ++i) {
        const int kk = 4 * i + rq;
        v[i] = (4 * cq < nv) ? *(const GLB f32x4*)(W + (size_t)(k0 + kk) * ldw + s0 + 4 * cq) : (f32x4){0.f, 0.f, 0.f, 0.f};
    }
#pragma unroll
    for (int i = 0; i < 16; ++i) { const int kk = 4 * i + rq; LAS float* d = scr + kk * 65 + 4 * cq; d[0] = v[i][0]; d[1] = v[i][1]; d[2] = v[i][2]; d[3] = v[i][3]; }
    LDS_WAIT();
    const int c = lane & 7;
#pragma unroll
    for (int j = 0; j < 8; ++j) { const int n = (lane >> 3) + 8 * j; const LAS float* s = scr + (8 * c) * 65 + n;
        u32x4 o; o.x = pk2(s[0 * 65], s[1 * 65]); o.y = pk2(s[2 * 65], s[3 * 65]); o.z = pk2(s[4 * 65], s[5 * 65]); o.w = pk2(s[6 * 65], s[7 * 65]);
        *(GLB u32x4*)(Bt + (size_t)(n0 + n) * K + k0 + 8 * c) = o; }
    LDS_WAIT();
}
__device__ __forceinline__ void win_map(int g, int& s0, int& nv) {
    const int d0 = 64 * g; nv = 64;
    if (d0 < 8704) s0 = d0;
    else if (d0 < 9728) s0 = 8784 + (d0 - 8704);
    else if (d0 < 9984) s0 = 9808 + (d0 - 9728);
    else if (d0 < 10240) { const int off = d0 - 9984; if (off == 0) s0 = 8704; else if (off == 64) { s0 = 8768; nv = 16; } else { s0 = 0; nv = 0; } }
    else s0 = 10064 + (d0 - 10240);
}
#ifndef MOE_SCAN_TILES
#define MOE_SCAN_TILES 42
#endif
#ifndef MOE_CONV_IN_PROLOGUE
#define MOE_CONV_IN_PROLOGUE 0
#endif
constexpr int MOE_CONV_ITEMS = NE * ((D / 64) * (2 * FF / 64) + (FF / 64) * (D / 64));
__device__ __forceinline__ void conv_moe_item(const Ctx& C, int idx, LAS float* scr, int lane) {
    constexpr int I_GU1 = (D / 64) * (2 * FF / 64), I_DN1 = (FF / 64) * (D / 64);
    if (idx < NE * I_GU1) {
        const int e = idx / I_GU1, r = idx % I_GU1, nb = r % (2 * FF / 64), kb = r / (2 * FF / 64);
        const int tile = nb >> 2, q = nb & 3; const int sc = 128 * tile + 64 * (q & 1);
        conv_tile(((q < 2) ? INF32(I_MG) : INF32(I_MU)) + (size_t)e * D * FF, FF, 64 * kb, sc, 64, WSP(bf16_t, WS_MWGU) + (size_t)e * 2 * FF * D, D, 64 * nb, scr, lane);
    } else {
        const int r0 = idx - NE * I_GU1, e = r0 / I_DN1, r = r0 % I_DN1, nb = r % 32, kb = r / 32;
        conv_tile(INF32(I_MD) + (size_t)e * FF * D, D, 64 * kb, 64 * nb, 64, WSP(bf16_t, WS_MWD) + (size_t)e * D * FF, FF, 64 * nb, scr, lane);
    }
}
__device__ __forceinline__ void ph_prologue(const Ctx& C) {
    LAS float* scr = (LAS float*)(C.lds + C.wave * 16640);
    const int gw = C.gw, NGW = C.NGW; int lane = C.lane; asm volatile("" : "+v"(lane)); lane &= 63;
    constexpr int I_WIN1 = (D / 64) * (N_INP / 64);
    constexpr int I_BR1 = (1024 / 64) * (2048 / 64);
    constexpr int I_DD = (D / 64) * (D / 64);
    constexpr int I_GU1 = (D / 64) * (2 * FF / 64);
    constexpr int I_DN1 = (FF / 64) * (D / 64);
    constexpr int I_PP1 = (256 / 64) * (D / 64);
    constexpr int S0 = 0, S1 = S0 + NL * I_WIN1, S2 = S1 + NL * 4 * I_BR1, S3 = S2 + NL * I_DD, S4 = S3 + I_GU1, S5 = S4 + I_DN1, S6 = S5 + NE * I_GU1, S7 = S6 + NE * I_DN1,
                  S8 = S7 + NL * I_DD, S9 = S8 + NL * I_PP1;
    for (int it = gw; it < S9; it += NGW) {
        if (it < S1) { const int l = it / I_WIN1, r = it % I_WIN1, nb = r % (N_INP / 64), kb = r / (N_INP / 64); int s0, nv; win_map(nb, s0, nv);
            conv_tile(INF32(I_WIN) + (size_t)l * D * N_IN, N_IN, 64 * kb, s0, nv, WSP(bf16_t, WS_WIN + l * SZ_WIN1), D, 64 * nb, scr, lane); }
        else if (it < S2) { const int q = (it - S1) / I_BR1, r = (it - S1) % I_BR1, nb = r % 32, kb = r / 32;
            conv_tile(INF32(I_WBR) + (size_t)q * 1024 * 2048, 2048, 64 * kb, 64 * nb, 64, WSP(bf16_t, WS_WBR) + (size_t)q * 2048 * 1024, 1024, 64 * nb, scr, lane); }
        else if (it < S3) { const int l = (it - S2) / I_DD, r = (it - S2) % I_DD, nb = r % 32, kb = r / 32;
            conv_tile(INF32(I_WOUT) + (size_t)l * D * D, D, 64 * kb, 64 * nb, 64, WSP(bf16_t, WS_WOUT + l * SZ_DD), D, 64 * nb, scr, lane); }
        else if (it < S4) {
            const int r = it - S3, nb = r % (2 * FF / 64), kb = r / (2 * FF / 64);
            const int tile = nb >> 2, q = nb & 3; const int sc = 128 * tile + 64 * (q & 1);
            conv_tile((q < 2) ? INF32(I_FG) : INF32(I_FU), FF, 64 * kb, sc, 64, WSP(bf16_t, WS_WGU), D, 64 * nb, scr, lane); }
        else if (it < S5) { const int r = it - S4, nb = r % 32, kb = r / 32;
            conv_tile(INF32(I_FD), D, 64 * kb, 64 * nb, 64, WSP(bf16_t, WS_WD), FF, 64 * nb, scr, lane); }
        else if (it < S7) { if (MOE_CONV_IN_PROLOGUE || it - S5 >= 2 * 1024 * MOE_SCAN_TILES) conv_moe_item(C, it - S5, scr, lane); }
        else if (it < S8) { const int l = (it - S7) / I_DD, r = (it - S7) % I_DD, nb = r % 32, kb = r / 32;
            conv_tile(INF32(I_PG) + (size_t)l * D * D, D, 64 * kb, 64 * nb, 64, WSP(bf16_t, WS_WPG + l * SZ_DD), D, 64 * nb, scr, lane); }
        else { const int l = (it - S8) / I_PP1, r = (it - S8) % I_PP1, nb = r % 32, kb = r / 32;
            conv_tile(INF32(I_PP) + (size_t)l * 256 * D, D, 64 * kb, 64 * nb, 64, WSP(bf16_t, WS_WPP) + (size_t)l * D * 256, 256, 64 * nb, scr, lane); }
    }
    for (int idx = gw * 64 + lane; idx < NL * 3072 * 256; idx += NGW * 64) {
        const int k = idx & 255, n = (idx >> 8) % 3072, l = idx / (3072 * 256);
        float v = 0.f;
        if (n < 1024) { if (k < 96) v = INF32(I_RWW2)[((size_t)l * 96 + k) * 1024 + n]; }
        else if (n < 2048) { if (k >= 96 && k < 192) v = INF32(I_RWA2)[((size_t)l * 96 + (k - 96)) * 1024 + (n - 1024)]; }
        else { if (k >= 192) v = INF32(I_RWG2)[((size_t)l * 64 + (k - 192)) * 1024 + (n - 2048)]; }
        WSP(bf16_t, WS_WLORA)[idx] = (bf16_t)f2bf(v);
    }
    for (int idx = gw * 64 + lane; idx < NL * T * 64; idx += NGW * 64) {
        const int c4 = idx & 63, t = (idx >> 6) % T, l = idx / (T * 64);
        const f32x4 v = *(const GLB f32x4*)(INF32(I_P) + ((size_t)l * T + t) * 256 + 4 * c4);
        u32x2 o; o.x = pk2(v[0], v[1]); o.y = pk2(v[2], v[3]);
        *(GLB u32x2*)(WSP(bf16_t, WS_PCAT) + (size_t)t * 512 + l * 256 + 4 * c4) = o;
    }
}

template <int MODE, bool XBF = true>
__device__ __forceinline__ void ph_norm(const Ctx& C, const GLB void* xin, GLB void* xout, const GLB float* gain, const GLB float* router, int moeS = 1) {
    int lane = C.lane; asm volatile("" : "+v"(lane)); lane &= 63;
    for (int m = C.gw; m < T; m += C.NGW) {
        f32x4 v[8]; float s = 0.f;
        if (XBF) { const GLB u32x2* xr = (const GLB u32x2*)((const GLB bf16_t*)xin + (size_t)m * D) + lane;
#pragma unroll
            for (int j = 0; j < 8; ++j) { const u32x2 w = xr[64 * j]; v[j] = (f32x4){bflo(w.x), bfhi(w.x), bflo(w.y), bfhi(w.y)}; }
        } else { const GLB f32x4* xr = (const GLB f32x4*)((const GLB float*)xin + (size_t)m * D) + lane;
#pragma unroll
            for (int j = 0; j < 8; ++j) v[j] = xr[64 * j]; }
        if (MODE == 2) {
            const GLB int* ts = WSP(int, WS_TOKSLOT) + 2 * m;
#pragma unroll
            for (int q = 0; q < 2; ++q) {
                const int sl = ts[q];
                if (sl < 64 * 256 || moeS <= 1) {
                    const GLB u32x2* o0 = (const GLB u32x2*)(WSP(bf16_t, WS_OS) + (size_t)sl * D) + lane;
#pragma unroll
                    for (int j = 0; j < 8; ++j) { const u32x2 w = o0[64 * j]; v[j] = v[j] + (f32x4){bflo(w.x), bfhi(w.x), bflo(w.y), bfhi(w.y)}; }
                } else {
                    const int tu0 = ((sl >> 8) - 64) * 8, rl = sl & 255;
#pragma unroll
                    for (int j = 0; j < 8; ++j)
                        for (int k = 0; k < moeS; ++k) v[j] = v[j] + *((const GLB f32x4*)(WSP(float, WS_OSP) + ((size_t)((tu0 + j) * moeS + k) << 16) + rl * 256) + lane);
                }
            }
#pragma unroll
            for (int j = 0; j < 8; ++j) { u32x2 o; o.x = pk2(v[j][0], v[j][1]); o.y = pk2(v[j][2], v[j][3]); ((GLB u32x2*)((GLB bf16_t*)xout + (size_t)m * D) + lane)[64 * j] = o;
                v[j] = (f32x4){bflo(o.x), bfhi(o.x), bflo(o.y), bfhi(o.y)}; }
        }
#pragma unroll
        for (int j = 0; j < 8; ++j) s += (v[j][0] * v[j][0] + v[j][1] * v[j][1]) + (v[j][2] * v[j][2] + v[j][3] * v[j][3]);
        const float rstd = 1.0f / sqrtf(wave_sum(s) * (1.0f / D) + 1e-6f);
        GLB u32x2* o8 = (GLB u32x2*)(WSP(bf16_t, WS_H) + (size_t)m * D) + lane;
        float lg[NE];
        if (MODE == 1) {
#pragma unroll
            for (int e = 0; e < NE; ++e) lg[e] = 0.f;
        }
#pragma unroll
        for (int j = 0; j < 8; ++j) { const f32x4 g = ((const GLB f32x4*)gain)[lane + 64 * j]; const f32x4 hv = v[j] * rstd * g; v[j] = hv;
            u32x2 o; o.x = pk2(hv[0], hv[1]); o.y = pk2(hv[2], hv[3]); o8[64 * j] = o; }
        if (MODE == 1) {
#pragma unroll 2
            for (int j = 0; j < 8; ++j) {
#pragma unroll
                for (int q = 0; q < 4; ++q) { const GLB f32x4* rr = (const GLB f32x4*)(router + (size_t)(4 * (lane + 64 * j) + q) * NE); const f32x4 r0 = rr[0], r1 = rr[1]; const float hq = v[j][q];
                    lg[0] += hq * r0[0]; lg[1] += hq * r0[1]; lg[2] += hq * r0[2]; lg[3] += hq * r0[3]; lg[4] += hq * r1[0]; lg[5] += hq * r1[1]; lg[6] += hq * r1[2]; lg[7] += hq * r1[3]; }
            }
        }
        if (MODE == 1) {
#pragma unroll
            for (int e = 0; e < NE; ++e) lg[e] = wave_sum(lg[e]);
            if (lane == 0) {
                int e1 = 0; float v1 = lg[0];
#pragma unroll
                for (int e = 1; e < NE; ++e) if (lg[e] > v1) { v1 = lg[e]; e1 = e; }
                int e2 = -1; float v2 = -3.0e38f;
#pragma unroll
                for (int e = 0; e < NE; ++e) if (e != e1 && lg[e] > v2) { v2 = lg[e]; e2 = e; }
                const float ex = __expf(v2 - v1), w1 = 1.0f / (1.0f + ex), w2 = ex / (1.0f + ex);
                GLB unsigned* cnt = WSP(unsigned, WS_CTL) + CW_MOECNT;
                const unsigned p1 = atomicAdd((unsigned*)cnt + 64 * e1, 1u), p2 = atomicAdd((unsigned*)cnt + 64 * e2, 1u);
                GLB unsigned* rt = WSP(unsigned, WS_ROUTE) + (size_t)m * 8;
                rt[0] = (unsigned)e1; rt[1] = p1; rt[2] = __builtin_bit_cast(unsigned, w1); rt[3] = (unsigned)e2; rt[4] = p2; rt[5] = __builtin_bit_cast(unsigned, w2);
            }
        }
    }
}
__device__ __forceinline__ void moe_offsets(const Ctx& C, int (&toff)[NE + 1]) {
    const GLB unsigned* cnt = WSP(unsigned, WS_CTL) + CW_MOECNT; int acc = 0;
#pragma unroll
    for (int e = 0; e < NE; ++e) { toff[e] = acc; const unsigned c = __hip_atomic_load(cnt + 64 * e, __ATOMIC_RELAXED, __HIP_MEMORY_SCOPE_AGENT); acc += (int)((c + 255u) >> 8); }
    toff[NE] = acc;
}
constexpr int MOETAB_OFF = MISC_OFF + 2048;
__device__ __forceinline__ void moe_tile_table(const Ctx& C) {
    int toff[NE + 1]; moe_offsets(C, toff);
    LAS int* tab = (LAS int*)(C.lds + MOETAB_OFF);
    if (C.tid <= MOE_MAXRT) { int e = 0;
#pragma unroll
        for (int j = 1; j < NE; ++j) e += (C.tid >= toff[j]) ? 1 : 0;
        tab[C.tid] = (C.tid == MOE_MAXRT) ? toff[NE] : e; }
    LDS_WAIT(); __syncthreads();
}
__device__ __forceinline__ void ph_moe_gather(const Ctx& C) {
    int toff[NE + 1]; moe_offsets(C, toff);
    int lane = C.lane; asm volatile("" : "+v"(lane)); lane &= 63;
    for (int m = C.gw; m < T; m += C.NGW) {
        const GLB unsigned* rt = WSP(unsigned, WS_ROUTE) + (size_t)m * 8;
        const int e1 = (int)rt[0], p1 = (int)rt[1], e2 = (int)rt[3], p2 = (int)rt[4];
        int o1 = 0, o2 = 0;
#pragma unroll
        for (int e = 0; e < NE; ++e) { o1 = (e == e1) ? toff[e] : o1; o2 = (e == e2) ? toff[e] : o2; }
        const int s1 = o1 * 256 + p1, s2 = o2 * 256 + p2;
        const GLB u32x4* src = (const GLB u32x4*)(WSP(bf16_t, WS_H) + (size_t)m * D) + lane;
        GLB u32x4* d1 = (GLB u32x4*)(WSP(bf16_t, WS_HS) + (size_t)s1 * D) + lane; GLB u32x4* d2 = (GLB u32x4*)(WSP(bf16_t, WS_HS) + (size_t)s2 * D) + lane;
#pragma unroll
        for (int j = 0; j < 4; ++j) { const u32x4 v = src[64 * j]; d1[64 * j] = v; d2[64 * j] = v; }
        if (lane == 0) { WSP(int, WS_TOKSLOT)[2 * m] = s1; WSP(int, WS_TOKSLOT)[2 * m + 1] = s2;
            WSP(unsigned, WS_WSLOT)[s1] = rt[2]; WSP(unsigned, WS_WSLOT)[s2] = rt[5]; }
    }
}

__device__ __forceinline__ float rope_inv_freq(int i, int half) { return exp2f(-13.287712379549449f * (float)i / (float)half); }
__device__ __forceinline__ void ph_prep(const Ctx& C, int l) {
    int lane = C.lane; asm volatile("" : "+v"(lane)); lane &= 63;
    const GLB bf16_t* UF = WSP(bf16_t, WS_UF);
    const int d = lane & 31, hh = lane >> 5;
    for (int m = C.gw; m < T; m += C.NGW) {
        const int t = m % SEQ;
        const GLB bf16_t* u = UF + (size_t)m * UFW;
        const float posf = (float)((const GLB int*)inptr(C.lds, I_POS))[m];
        float qa[8], qb[8], ia[8], ib[8], sa[8], sb[8];
#pragma unroll
        for (int h = 0; h < 8; ++h) { qa[h] = bf1(u[UF_DQ + h * 128 + lane]); qb[h] = bf1(u[UF_DQ + h * 128 + 64 + lane]); }
#pragma unroll
        for (int hp = 0; hp < 8; ++hp) { const int h = 2 * hp + hh; ia[hp] = bf1(u[UF_IQ + h * 64 + d]); ib[hp] = bf1(u[UF_IQ + h * 64 + 32 + d]); sa[hp] = bf1(u[UF_SQ + h * 64 + d]); sb[hp] = bf1(u[UF_SQ + h * 64 + 32 + d]); }
        const float ika = bf1(u[UF_IK + d]), ikb = bf1(u[UF_IK + 32 + d]), iwv = bf1(u[UF_IW + (lane & 15)]);
        const float ska = bf1(u[UF_SK + hh * 64 + d]), skb = bf1(u[UF_SK + hh * 64 + 32 + d]), sv0 = bf1(u[UF_SV + lane]), sv1 = bf1(u[UF_SV + 64 + lane]);
        {
            const GLB float* mu = INF32(I_RWMU) + (size_t)l * 3328;
#pragma unroll
            for (int half = 0; half < 2; ++half) {
                constexpr int J0[2] = {0, 7}, J1[2] = {7, 13};
                f32x4 cur[7], prv[7], mm[7];
#pragma unroll
                for (int j = J0[half]; j < J1[half]; ++j) { const int c = 4 * (lane + 64 * j), q = j - J0[half];
                    { const u32x2 w = *(const GLB u32x2*)(u + UF_RW + c); cur[q] = (f32x4){bflo(w.x), bfhi(w.x), bflo(w.y), bfhi(w.y)}; }
                    if (t > 0) { const u32x2 w = *(const GLB u32x2*)(u - UFW + UF_RW + c); prv[q] = (f32x4){bflo(w.x), bfhi(w.x), bflo(w.y), bfhi(w.y)}; } else prv[q] = (f32x4){0.f, 0.f, 0.f, 0.f};
                    mm[q] = *(const GLB f32x4*)(mu + c); }
#pragma unroll
                for (int j = J0[half]; j < J1[half]; ++j) { const int c = 4 * (lane + 64 * j), q = j - J0[half];
                    const f32x4 o = cur[q] + mm[q] * (prv[q] - cur[q]);
                    if (j < 12) { GLB bf16_t* dst = WSP(bf16_t, (j < 4 ? WS_R : (j < 8 ? WS_K : WS_V))) + (size_t)m * 1024 + (c & 1023); u32x2 w; w.x = pk2(o[0], o[1]); w.y = pk2(o[2], o[3]); *(GLB u32x2*)dst = w; }
                    else { const int k = c - 3072; f32x4 a;
                        if (k < 96) a = (f32x4){tanhf(o[0]), tanhf(o[1]), tanhf(o[2]), tanhf(o[3])};
                        else if (k < 192) a = o;
                        else a = pg8::sig4(o);
                        u32x2 w; w.x = pk2(a[0], a[1]); w.y = pk2(a[2], a[3]);
                        *(GLB u32x2*)(WSP(bf16_t, WS_ALORA) + (size_t)m * 256 + k) = w; }
                }
            }
        }
        {
            const float invf = rope_inv_freq(lane, 64); float sn, cn; sincosf(posf * invf, &sn, &cn);
            const float g1 = INF32(I_DQN)[l * 128 + lane], g2 = INF32(I_DQN)[l * 128 + 64 + lane];
#pragma unroll
            for (int h = 0; h < 8; ++h) {
                const float a = qa[h], b = qb[h];
                const float rs = 1.0f / sqrtf(wave_sum(a * a + b * b) * (1.0f / 128.f) + 1e-6f);
                const float x1 = a * rs * g1, x2 = b * rs * g2;
                GLB bf16_t* q = WSP(bf16_t, WS_QD) + (size_t)m * 1024 + h * 128;
                q[lane] = (bf16_t)f2bf(x1 * cn - x2 * sn); q[64 + lane] = (bf16_t)f2bf(x2 * cn + x1 * sn);
            }
        }
        {
            const float invf = rope_inv_freq(d, 32); float sn, cn; sincosf(posf * invf, &sn, &cn);
#pragma unroll
            for (int hp = 0; hp < 8; ++hp) { const int h = 2 * hp + hh; const float a = ia[hp], b = ib[hp];
                GLB bf16_t* q = WSP(bf16_t, WS_QI) + (size_t)m * 1024 + h * 64; q[d] = (bf16_t)f2bf(a * cn - b * sn); q[32 + d] = (bf16_t)f2bf(b * cn + a * sn); }
            if (hh == 0) { GLB bf16_t* q = WSP(bf16_t, WS_KI) + (size_t)m * 64; q[d] = (bf16_t)f2bf(ika * cn - ikb * sn); q[32 + d] = (bf16_t)f2bf(ikb * cn + ika * sn); }
            if (lane < 16) WSP(float, WS_WI)[(size_t)m * 16 + lane] = iwv * 0.03125f;
            const float sg1 = INF32(I_SQN)[l * 64 + d], sg2 = INF32(I_SQN)[l * 64 + 32 + d];
#pragma unroll
            for (int hp = 0; hp < 8; ++hp) { const int h = 2 * hp + hh; const float a = sa[hp], b = sb[hp];
                float s2 = a * a + b * b;
#pragma unroll
                for (int o = 1; o < 32; o <<= 1) s2 += __shfl_xor(s2, o);
                const float rs = 1.0f / sqrtf(s2 * (1.0f / 64.f) + 1e-6f); const float x1 = a * rs * sg1, x2 = b * rs * sg2;
                GLB bf16_t* q = WSP(bf16_t, WS_QS) + (size_t)m * 1024 + h * 64; q[d] = (bf16_t)f2bf(x1 * cn - x2 * sn); q[32 + d] = (bf16_t)f2bf(x2 * cn + x1 * sn); }
            { const float kg1 = INF32(I_SKN)[l * 64 + d], kg2 = INF32(I_SKN)[l * 64 + 32 + d];
              float s2 = ska * ska + skb * skb;
#pragma unroll
              for (int o = 1; o < 32; o <<= 1) s2 += __shfl_xor(s2, o);
              const float rs = 1.0f / sqrtf(s2 * (1.0f / 64.f) + 1e-6f); const float x1 = ska * rs * kg1, x2 = skb * rs * kg2;
              GLB bf16_t* q = WSP(bf16_t, WS_KS) + (size_t)m * 128 + hh * 64; q[d] = (bf16_t)f2bf(x1 * cn - x2 * sn); q[32 + d] = (bf16_t)f2bf(x2 * cn + x1 * sn);
              GLB bf16_t* vv = WSP(bf16_t, WS_VS) + (size_t)m * 128; vv[lane] = (bf16_t)f2bf(sv0); vv[64 + lane] = (bf16_t)f2bf(sv1); }
        }
    }
}

__device__ __forceinline__ void ph_latent(const Ctx& C, int l) {
    int lane = C.lane; asm volatile("" : "+v"(lane)); lane &= 63;
    LAS float* cs = (LAS float*)(C.lds + C.wave * 8192);
    const GLB bf16_t* UF = WSP(bf16_t, WS_UF);
    const GLB float* wuk = INF32(I_DWUK) + (size_t)l * 256 * 128; const GLB float* wuv = INF32(I_DWUV) + (size_t)l * 256 * 128;
    for (int g8 = C.gw; g8 < T / 8; g8 += C.NGW) {
        const int m0 = 8 * g8;
        float cv[8][4];
#pragma unroll
        for (int tk = 0; tk < 8; ++tk)
#pragma unroll
            for (int j = 0; j < 4; ++j) cv[tk][j] = bf1(UF[(size_t)(m0 + tk) * UFW + UF_CKV + lane + 64 * j]);
#pragma unroll
        for (int tk = 0; tk < 8; ++tk) {
            float ss = 0.f;
#pragma unroll
            for (int j = 0; j < 4; ++j) ss += cv[tk][j] * cv[tk][j];
            const float rc = 1.0f / sqrtf(wave_sum(ss) * (1.0f / 256.f) + 1e-6f);
#pragma unroll
            for (int j = 0; j < 4; ++j) cs[(lane + 64 * j) * 8 + tk] = cv[tk][j] * rc * INF32(I_DKVN)[l * 256 + lane + 64 * j];
        }
        LDS_WAIT();
        float acc[8][4];
#pragma unroll
        for (int tk = 0; tk < 8; ++tk) { acc[tk][0] = 0.f; acc[tk][1] = 0.f; acc[tk][2] = 0.f; acc[tk][3] = 0.f; }
#pragma unroll 8
        for (int k = 0; k < 256; ++k) {
            const float w0 = wuk[k * 128 + lane], w1 = wuk[k * 128 + 64 + lane], w2 = wuv[k * 128 + lane], w3 = wuv[k * 128 + 64 + lane];
            const f32x4 ca = *(const LAS f32x4*)(cs + k * 8), cb = *(const LAS f32x4*)(cs + k * 8 + 4);
#pragma unroll
            for (int tk = 0; tk < 8; ++tk) { const float c = (tk < 4) ? ca[tk & 3] : cb[tk & 3]; acc[tk][0] += c * w0; acc[tk][1] += c * w1; acc[tk][2] += c * w2; acc[tk][3] += c * w3; }
        }
        const float invf = rope_inv_freq(lane, 64);
        const float g1 = INF32(I_DKN)[l * 128 + lane], g2 = INF32(I_DKN)[l * 128 + 64 + lane];
#pragma unroll
        for (int tk = 0; tk < 8; ++tk) {
            const int m = m0 + tk;
            const float posf = (float)((const GLB int*)inptr(C.lds, I_POS))[m];
            float sn, cn; sincosf(posf * invf, &sn, &cn);
            const float k1 = acc[tk][0], k2 = acc[tk][1];
            const float rk = 1.0f / sqrtf(wave_sum(k1 * k1 + k2 * k2) * (1.0f / 128.f) + 1e-6f);
            const float y1 = k1 * rk * g1, y2 = k2 * rk * g2;
            GLB bf16_t* kd = WSP(bf16_t, WS_KD) + (size_t)m * 128; GLB bf16_t* vd = WSP(bf16_t, WS_VD) + (size_t)m * 128;
            kd[lane] = (bf16_t)f2bf(y1 * cn - y2 * sn); kd[64 + lane] = (bf16_t)f2bf(y2 * cn + y1 * sn);
            vd[lane] = (bf16_t)f2bf(acc[tk][2]); vd[64 + lane] = (bf16_t)f2bf(acc[tk][3]);
        }
        LDS_WAIT();
    }
}

__device__ __forceinline__ void ph_rwkv_kk(const Ctx& C, int l) {
    int lane = C.lane; asm volatile("" : "+v"(lane)); lane &= 63;
    for (int m = C.gw; m < T; m += C.NGW) {
#pragma unroll
        for (int i = 0; i < 4; ++i) {
            const int c = 256 * i + 4 * lane; const size_t o = (size_t)m * 1024 + c;
            const f32x4 k = *(const GLB f32x4*)(WSP(float, WS_K) + o), a = *(const GLB f32x4*)(WSP(float, WS_AA) + o);
            const f32x4 kkw = *(const GLB f32x4*)(INF32(I_RWKK) + l * 1024 + c), ka = *(const GLB f32x4*)(INF32(I_RWKA) + l * 1024 + c);
            f32x4 kk = k * kkw; float s = (kk[0] * kk[0] + kk[1] * kk[1]) + (kk[2] * kk[2] + kk[3] * kk[3]);
#pragma unroll
            for (int q = 1; q < 16; q <<= 1) s += __shfl_xor(s, q);
            const float inv = 1.0f / fmaxf(sqrtf(s), 1e-12f); kk = kk * inv;
            *(GLB f32x4*)(WSP(float, WS_KK) + o) = kk;
            *(GLB f32x4*)(WSP(float, WS_K) + o) = k * (1.0f + (a - 1.0f) * ka);
            *(GLB f32x4*)(WSP(float, WS_AA) + o) = kk * a;
        }
    }
}
__device__ __forceinline__ void ph_rwkv_scan_naive(const Ctx& C) {
    if (C.wave != 0) return;
    int lane = C.lane; asm volatile("" : "+v"(lane)); lane &= 63;
    LAS float* buf = (LAS float*)C.lds;
    for (int it = blockIdx.x; it < NB * 16; it += C.G) {
        const int b = it >> 4, h = it & 15;
        float S[64];
#pragma unroll
        for (int k = 0; k < 64; ++k) S[k] = 0.f;
        const size_t base = (size_t)b * SEQ * 1024 + h * 64 + lane;
        for (int t0 = 0; t0 < SEQ; t0 += 16) {
#pragma unroll
            for (int st = 0; st < 16; ++st) { const size_t o = base + (size_t)(t0 + st) * 1024; LAS float* d = buf + st * 384 + lane;
                d[0] = WSP(float, WS_R)[o]; d[64] = WSP(float, WS_DEC)[o]; d[128] = WSP(float, WS_K)[o]; d[192] = WSP(float, WS_KK)[o]; d[256] = WSP(float, WS_AA)[o]; d[320] = WSP(float, WS_V)[o]; }
            LDS_WAIT();
            for (int st = 0; st < 16; ++st) {
                const LAS float* rb = buf + st * 384;
                float p = 0.f;
#pragma unroll
                for (int k = 0; k < 64; k += 4) { const f32x4 q = *(const LAS f32x4*)(rb + 192 + k); p += S[k] * q[0] + S[k + 1] * q[1] + S[k + 2] * q[2] + S[k + 3] * q[3]; }
                const float vv = rb[320 + lane]; float y = 0.f;
#pragma unroll
                for (int k = 0; k < 64; k += 4) { const f32x4 w = *(const LAS f32x4*)(rb + 64 + k), bb = *(const LAS f32x4*)(rb + 256 + k), kq = *(const LAS f32x4*)(rb + 128 + k), r = *(const LAS f32x4*)(rb + k);
#pragma unroll
                    for (int j = 0; j < 4; ++j) { S[k + j] = S[k + j] * w[j] - p * bb[j] + vv * kq[j]; y += S[k + j] * r[j]; } }
                WSP(float, WS_YRAW)[base + (size_t)(t0 + st) * 1024] = y;
            }
            LDS_WAIT();
        }
    }
}
__device__ __forceinline__ f32x4 ld4bf(const GLB bf16_t* q) { const u32x2 w = *(const GLB u32x2*)q; return (f32x4){bflo(w.x), bfhi(w.x), bflo(w.y), bfhi(w.y)}; }
__device__ __forceinline__ void ph_rwkv_post(const Ctx& C, int l) {
    int lane = C.lane; asm volatile("" : "+v"(lane)); lane &= 63;
    if (C.wave >= 4) return;
    for (int m = blockIdx.x * 4 + C.wave; m < T; m += C.G * 4) {
#pragma unroll
        for (int i = 0; i < 4; ++i) {
            const int c = 256 * i + 4 * lane; const size_t o = (size_t)m * 1024 + c;
            const f32x4 y = *(const GLB f32x4*)(WSP(float, WS_YRAW) + o);
            float s = (y[0] + y[1]) + (y[2] + y[3]);
#pragma unroll
            for (int q = 1; q < 16; q <<= 1) s += __shfl_xor(s, q);
            const float mean = s * (1.0f / 64.f); const f32x4 dlt = y - mean;
            float s2 = (dlt[0] * dlt[0] + dlt[1] * dlt[1]) + (dlt[2] * dlt[2] + dlt[3] * dlt[3]);
#pragma unroll
            for (int q = 1; q < 16; q <<= 1) s2 += __shfl_xor(s2, q);
            const float rstd = 1.0f / sqrtf(s2 * (1.0f / 64.f) + 64e-5f);
            const f32x4 r = ld4bf(WSP(bf16_t, WS_R) + o), kraw = ld4bf(WSP(bf16_t, WS_K) + o), av = ld4bf(WSP(bf16_t, WS_AA) + o), v = ld4bf(WSP(bf16_t, WS_V) + o), g = ld4bf(WSP(bf16_t, WS_GG) + o);
            const f32x4 k = kraw * (1.0f + (av - 1.0f) * *(const GLB f32x4*)(INF32(I_RWKA) + l * 1024 + c));
            const f32x4 rk = *(const GLB f32x4*)(INF32(I_RWRK) + l * 1024 + c), lg = *(const GLB f32x4*)(INF32(I_RWLNG) + l * 1024 + c), lb = *(const GLB f32x4*)(INF32(I_RWLNB) + l * 1024 + c);
            const f32x4 pr = r * k * rk; float bs = (pr[0] + pr[1]) + (pr[2] + pr[3]);
#pragma unroll
            for (int q = 1; q < 16; q <<= 1) bs += __shfl_xor(bs, q);
            const f32x4 res = (dlt * rstd * lg + lb + bs * v) * g;
            u32x2 w; w.x = pk2(res[0], res[1]); w.y = pk2(res[2], res[3]);
            *(GLB u32x2*)(WSP(bf16_t, WS_Y) + (size_t)m * 4096 + 1024 + c) = w;
        }
    }
}
__device__ __forceinline__ float dot8(u32x4 kv, f32x4 qa, f32x4 qb) {
    return bflo(kv.x) * qa[0] + bfhi(kv.x) * qa[1] + bflo(kv.y) * qa[2] + bfhi(kv.y) * qa[3] + bflo(kv.z) * qb[0] + bfhi(kv.z) * qb[1] + bflo(kv.w) * qb[2] + bfhi(kv.w) * qb[3];
}
__device__ __forceinline__ void ph_sb_naive(const Ctx& C) {
    int lane = C.lane; asm volatile("" : "+v"(lane));
    LAS float* qs = (LAS float*)(C.lds + C.wave * 512);
    const GLB bf16_t* QKV = WSP(bf16_t, WS_SBQKV); GLB bf16_t* Y = WSP(bf16_t, WS_Y);
    for (int it = C.gw; it < NB * 8 * SEQ; it += C.NGW) {
        const int t = it % SEQ, bh = it / SEQ, h = bh & 7, b = bh >> 3;
        const size_t m = (size_t)b * SEQ + t;
        { const unsigned qq = *(const GLB unsigned*)(QKV + m * 3072 + h * 128 + 2 * lane); qs[2 * lane] = bflo(qq); qs[2 * lane + 1] = bfhi(qq); }
        LDS_WAIT();
        float o0 = 0.f, o1 = 0.f, carry = 0.f;
        const int nch = (t + 63) >> 6;
        for (int c = nch - 1; c >= 0; --c) {
            const int s = c * 64 + lane; const bool valid = s < t; const int sc = valid ? s : 0;
            const GLB u32x4* kp = (const GLB u32x4*)(QKV + ((size_t)b * SEQ + sc) * 3072 + 1024 + h * 128);
            float dot = 0.f;
#pragma unroll
            for (int j = 0; j < 16; ++j) dot += dot8(kp[j], *(const LAS f32x4*)(qs + 8 * j), *(const LAS f32x4*)(qs + 8 * j + 4));
            const float z = dot * 0.08838834764831845f;
            const float lk = valid ? logsigf_(-z) : 0.f, lb = logsigf_(z);
            float inc = lk;
#pragma unroll
            for (int off = 1; off < 64; off <<= 1) { const float o = __shfl_down(inc, off); if (lane + off < 64) inc += o; }
            const float w = valid ? __expf(lb + carry + inc - lk) : 0.f;
            carry += rdlane(inc, 0);
            const int nk = (t - c * 64) < 64 ? (t - c * 64) : 64;
            const GLB bf16_t* vp = QKV + ((size_t)b * SEQ + c * 64) * 3072 + 2048 + h * 128 + 2 * lane;
            for (int j = 0; j < nk; ++j) { const float wj = rdlane(w, j); const unsigned vv = *(const GLB unsigned*)(vp + (size_t)j * 3072); o0 += wj * bflo(vv); o1 += wj * bfhi(vv); }
        }
        *(GLB unsigned*)(Y + m * 4096 + h * 128 + 2 * lane) = pk2(o0, o1);
        LDS_WAIT();
    }
}
__device__ __forceinline__ void ph_swa_naive(const Ctx& C, int l) {
    int lane = C.lane; asm volatile("" : "+v"(lane));
    LAS float* qs = (LAS float*)(C.lds + C.wave * 512);
    const GLB bf16_t* QS = WSP(bf16_t, WS_QS); const GLB bf16_t* KS = WSP(bf16_t, WS_KS); const GLB bf16_t* VS = WSP(bf16_t, WS_VS); GLB bf16_t* Y = WSP(bf16_t, WS_Y);
    for (int it = C.gw; it < T * 16; it += C.NGW) {
        const int h = it & 15, m = it >> 4, t = m % SEQ, b = m / SEQ, kvh = h >> 3;
        qs[lane] = bf1(QS[(size_t)m * 1024 + h * 64 + lane]);
        LDS_WAIT();
        float lg[2];
#pragma unroll
        for (int i = 0; i < 2; ++i) { const int s = t - 127 + lane + 64 * i; const bool valid = s >= 0;
            const GLB u32x4* kp = (const GLB u32x4*)(KS + ((size_t)b * SEQ + (valid ? s : 0)) * 128 + kvh * 64);
            float dot = 0.f;
#pragma unroll
            for (int j = 0; j < 8; ++j) dot += dot8(kp[j], *(const LAS f32x4*)(qs + 8 * j), *(const LAS f32x4*)(qs + 8 * j + 4));
            lg[i] = valid ? dot * 0.125f : -3.0e38f; }
        const float sink = INF32(I_SSINK)[l * 16 + h];
        const float mx = fmaxf(wave_max(fmaxf(lg[0], lg[1])), sink);
        const float e0 = (lg[0] > -1.0e38f) ? __expf(lg[0] - mx) : 0.f, e1 = (lg[1] > -1.0e38f) ? __expf(lg[1] - mx) : 0.f;
        const float den = wave_sum(e0 + e1) + __expf(sink - mx);
        const float p0 = e0 / den, p1 = e1 / den;
        float o = 0.f;
        const int j0 = (t >= 127) ? 0 : 127 - t;
        for (int j = j0; j < 128; ++j) { const float pj = (j < 64) ? rdlane(p0, j) : rdlane(p1, j - 64); const int s = t - 127 + j;
            o += pj * bf1(VS[((size_t)b * SEQ + s) * 128 + kvh * 64 + lane]); }
        Y[(size_t)m * 4096 + 3072 + h * 64 + lane] = (bf16_t)f2bf(o);
        LDS_WAIT();
    }
}
__device__ __forceinline__ unsigned ordkey(float f) { const unsigned u = __builtin_bit_cast(unsigned, f); return (u & 0x80000000u) ? ~u : (u | 0x80000000u); }
__device__ __forceinline__ void ph_dsa_naive(const Ctx& C) {
    int lane = C.lane; asm volatile("" : "+v"(lane));
    LAS float* A = (LAS float*)(C.lds + C.wave * 13312);
    LAS float* Bs = A + 1024;
    LAS int* Cs = (LAS int*)(Bs + 2048);
    const GLB bf16_t* QI = WSP(bf16_t, WS_QI); const GLB bf16_t* KI = WSP(bf16_t, WS_KI); const GLB float* WI = WSP(float, WS_WI);
    const GLB bf16_t* QD = WSP(bf16_t, WS_QD); const GLB bf16_t* KD = WSP(bf16_t, WS_KD); const GLB bf16_t* VD = WSP(bf16_t, WS_VD); GLB bf16_t* Y = WSP(bf16_t, WS_Y);
    for (int m = C.gw; m < T; m += C.NGW) {
        const int t = m % SEQ, b = m / SEQ, n = t + 1;
        const size_t bm = (size_t)b * SEQ;
#pragma unroll
        for (int i = 0; i < 2; ++i) { const int e = 8 * (lane + 64 * i); const u32x4 q = *(const GLB u32x4*)(QI + (size_t)m * 1024 + e);
            *(LAS f32x4*)(A + e) = (f32x4){bflo(q.x), bfhi(q.x), bflo(q.y), bfhi(q.y)}; *(LAS f32x4*)(A + e + 4) = (f32x4){bflo(q.z), bfhi(q.z), bflo(q.w), bfhi(q.w)}; }
        const float wl = WI[(size_t)m * 16 + (lane & 15)];
        LDS_WAIT();
        const int nch = (n + 63) >> 6;
        for (int c = 0; c < nch; ++c) {
            const int s = c * 64 + lane; const bool valid = s < n;
            const GLB u32x4* kp = (const GLB u32x4*)(KI + (bm + (valid ? s : 0)) * 64);
            u32x4 kv[8];
#pragma unroll
            for (int j = 0; j < 8; ++j) kv[j] = kp[j];
            float sc = 0.f;
#pragma unroll 1
            for (int h = 0; h < 16; ++h) { float dot = 0.f;
#pragma unroll
                for (int j = 0; j < 8; ++j) dot += dot8(kv[j], *(const LAS f32x4*)(A + h * 64 + 8 * j), *(const LAS f32x4*)(A + h * 64 + 8 * j + 4));
                sc += rdlane(wl, h) * fmaxf(dot, 0.f); }
            Bs[s] = sc;
        }
        LDS_WAIT();
        int nsel;
        if (n <= 256) { nsel = n;
#pragma unroll
            for (int i = 0; i < 4; ++i) if (lane + 64 * i < n) Cs[lane + 64 * i] = lane + 64 * i;
        } else {
            nsel = 256;
            unsigned key[32];
#pragma unroll
            for (int i = 0; i < 32; ++i) { const int s = lane + 64 * i; key[i] = (s < n) ? ordkey(Bs[s]) : 0u; }
            unsigned tau = 0u;
            for (int bit = 31; bit >= 0; --bit) {
                const unsigned cand = tau | (1u << bit); int cnt = 0;
#pragma unroll
                for (int i = 0; i < 32; ++i) cnt += (key[i] >= cand) ? 1 : 0;
#pragma unroll
                for (int o = 1; o < 64; o <<= 1) cnt += __shfl_xor(cnt, o);
                if (cnt >= 256) tau = cand;
            }
            int cgt = 0;
#pragma unroll
            for (int i = 0; i < 32; ++i) cgt += (key[i] > tau) ? 1 : 0;
#pragma unroll
            for (int o = 1; o < 64; o <<= 1) cgt += __shfl_xor(cgt, o);
            const int need = 256 - cgt;
            int base = 0, eqbase = 0;
            const unsigned long long lt = (1ull << lane) - 1ull;
#pragma unroll
            for (int i = 0; i < 32; ++i) {
                const bool gt = key[i] > tau, eq = key[i] == tau;
                const unsigned long long beq = __ballot(eq);
                const int eqrank = eqbase + __popcll(beq & lt);
                const bool sel = gt || (eq && eqrank < need);
                const unsigned long long bs = __ballot(sel);
                if (sel) Cs[base + __popcll(bs & lt)] = lane + 64 * i;
                base += __popcll(bs); eqbase += __popcll(beq);
            }
        }
        LDS_WAIT();
#pragma unroll
        for (int i = 0; i < 2; ++i) { const int e = 8 * (lane + 64 * i); const u32x4 q = *(const GLB u32x4*)(QD + (size_t)m * 1024 + e);
            *(LAS f32x4*)(A + e) = (f32x4){bflo(q.x), bfhi(q.x), bflo(q.y), bfhi(q.y)}; *(LAS f32x4*)(A + e + 4) = (f32x4){bflo(q.z), bfhi(q.z), bflo(q.w), bfhi(q.w)}; }
        LDS_WAIT();
        float lg[8][4];
#pragma unroll
        for (int i = 0; i < 4; ++i) { const int j = lane + 64 * i; const bool valid = j < nsel; const int s = valid ? Cs[j] : 0;
            const GLB u32x4* kp = (const GLB u32x4*)(KD + (bm + s) * 128);
            float a8[8];
#pragma unroll
            for (int h = 0; h < 8; ++h) a8[h] = 0.f;
#pragma unroll 1
            for (int pc = 0; pc < 16; ++pc) { const u32x4 kv = kp[pc];
#pragma unroll
                for (int h = 0; h < 8; ++h) a8[h] += dot8(kv, *(const LAS f32x4*)(A + h * 128 + 8 * pc), *(const LAS f32x4*)(A + h * 128 + 8 * pc + 4)); }
#pragma unroll
            for (int h = 0; h < 8; ++h) lg[h][i] = valid ? a8[h] * 0.08838834764831845f : -3.0e38f; }
#pragma unroll
        for (int h = 0; h < 8; ++h) {
            const float mx = wave_max(fmaxf(fmaxf(lg[h][0], lg[h][1]), fmaxf(lg[h][2], lg[h][3])));
            float e[4]; float sm = 0.f;
#pragma unroll
            for (int i = 0; i < 4; ++i) { e[i] = (lg[h][i] > -1.0e38f) ? __expf(lg[h][i] - mx) : 0.f; sm += e[i]; }
            const float inv = 1.0f / wave_sum(sm);
#pragma unroll
            for (int i = 0; i < 4; ++i) Bs[(lane + 64 * i) * 8 + h] = e[i] * inv;
        }
        LDS_WAIT();
        float o[8][2];
#pragma unroll
        for (int h = 0; h < 8; ++h) { o[h][0] = 0.f; o[h][1] = 0.f; }
        for (int j = 0; j < nsel; ++j) { const int s = Cs[j]; const unsigned vv = *(const GLB unsigned*)(VD + (bm + s) * 128 + 2 * lane); const float v0 = bflo(vv), v1 = bfhi(vv);
            const f32x4 pa = *(const LAS f32x4*)(Bs + j * 8), pb = *(const LAS f32x4*)(Bs + j * 8 + 4);
#pragma unroll
            for (int h = 0; h < 4; ++h) { o[h][0] += pa[h] * v0; o[h][1] += pa[h] * v1; o[4 + h][0] += pb[h] * v0; o[4 + h][1] += pb[h] * v1; } }
#pragma unroll
        for (int h = 0; h < 8; ++h) *(GLB unsigned*)(Y + (size_t)m * 4096 + 2048 + h * 128 + 2 * lane) = pk2(o[h][0], o[h][1]);
        LDS_WAIT();
    }
}
typedef float f32x16 __attribute__((ext_vector_type(16)));
__device__ __forceinline__ int wave_isum(int x) {
    x += __builtin_amdgcn_mov_dpp(x, 0x128, 0xf, 0xf, true); x += __builtin_amdgcn_mov_dpp(x, 0x124, 0xf, 0xf, true);
    x += __builtin_amdgcn_mov_dpp(x, 0x122, 0xf, 0xf, true); x += __builtin_amdgcn_mov_dpp(x, 0x121, 0xf, 0xf, true);
    return __builtin_amdgcn_readlane(x, 0) + __builtin_amdgcn_readlane(x, 16) + __builtin_amdgcn_readlane(x, 32) + __builtin_amdgcn_readlane(x, 48);
}
constexpr size_t WS_SBVT = WS_MIX_END;
constexpr size_t WS_SWVT = WS_SBVT + (size_t)32 * 128 * SEQ * 2;
constexpr size_t WS_VDT = WS_SWVT + (size_t)NB * 2 * 64 * SEQ * 2;
constexpr size_t WS_SC = WS_VDT + (size_t)NB * 128 * SEQ * 2;
constexpr size_t WS_SELB = WS_SC + (size_t)T * SEQ * 4;
constexpr size_t WS_END2 = WS_SELB + (size_t)T * 32 * 8;
constexpr size_t WS_XB = (WS_END2 + 255) & ~(size_t)255;
constexpr size_t WS_END3 = WS_XB + (size_t)T * D * 2;
static_assert(WS_END3 < (size_t)2000 * 1000 * 1000, "workspace budget");

__device__ __forceinline__ void vt_tile(const GLB bf16_t* src, int src_ld, GLB bf16_t* dst, LAS bf16_t* scr, int lane) {
    const int cq = lane & 7, rq = lane >> 3;
    u32x4 v[8];
#pragma unroll
    for (int j = 0; j < 8; ++j) v[j] = *(const GLB u32x4*)(src + (size_t)(rq + 8 * j) * src_ld + 8 * cq);
#pragma unroll
    for (int j = 0; j < 8; ++j) { LAS unsigned* d = (LAS unsigned*)(scr + (rq + 8 * j) * 66 + 8 * cq); d[0] = v[j].x; d[1] = v[j].y; d[2] = v[j].z; d[3] = v[j].w; }
    LDS_WAIT();
#pragma unroll
    for (int j = 0; j < 8; ++j) { const int d = rq + 8 * j; const LAS bf16_t* s = scr + (8 * cq) * 66 + d;
        u32x4 o; o.x = (unsigned)s[0] | ((unsigned)s[66] << 16); o.y = (unsigned)s[2 * 66] | ((unsigned)s[3 * 66] << 16);
        o.z = (unsigned)s[4 * 66] | ((unsigned)s[5 * 66] << 16); o.w = (unsigned)s[6 * 66] | ((unsigned)s[7 * 66] << 16);
        *(GLB u32x4*)(dst + (size_t)d * SEQ + 8 * cq) = o; }
    LDS_WAIT();
}
__device__ __forceinline__ void ph_vt(const Ctx& C) {
    int lane = C.lane; asm volatile("" : "+v"(lane)); lane &= 63;
    LAS bf16_t* scr = (LAS bf16_t*)(C.lds + 65536 + C.wave * 8448);
    for (int it = C.gw; it < 32 * 2 * 32; it += C.NGW) {
        const int sb = it & 31, db = (it >> 5) & 1, bh = it >> 6, b = bh >> 3, h = bh & 7;
        vt_tile(WSP(bf16_t, WS_SBQKV) + ((size_t)b * SEQ + 64 * sb) * 3072 + 2048 + h * 128 + 64 * db, 3072,
                WSP(bf16_t, WS_SBVT) + ((size_t)bh * 128 + 64 * db) * SEQ + 64 * sb, scr, lane);
    }
}

__device__ __forceinline__ void ph_vt_small(const Ctx& C) {
    int lane = C.lane; asm volatile("" : "+v"(lane)); lane &= 63;
    LAS bf16_t* scr = (LAS bf16_t*)(C.lds + C.wave * 8448);
    for (int it = C.gw; it < 512; it += C.NGW) {
        const int sb = it & 31, hd = (it >> 5) & 1, b = (it >> 6) & 3, which = it >> 8;
        if (which == 0) vt_tile(WSP(bf16_t, WS_VS) + ((size_t)b * SEQ + 64 * sb) * 128 + 64 * hd, 128, WSP(bf16_t, WS_SWVT) + ((size_t)(b * 2 + hd) * 64) * SEQ + 64 * sb, scr, lane);
        else vt_tile(WSP(bf16_t, WS_VD) + ((size_t)b * SEQ + 64 * sb) * 128 + 64 * hd, 128, WSP(bf16_t, WS_VDT) + ((size_t)b * 128 + 64 * hd) * SEQ + 64 * sb, scr, lane);
    }
}

#ifndef SB_EXIT_MASS
#define SB_EXIT_MASS 9.094947017729282e-13f
#endif
__device__ __forceinline__ void sb_item(const Ctx& C, int lane, int bh, int qb) {
    const int c = lane & 31, hh = lane >> 5, b = bh >> 3, h = bh & 7, q0 = 32 * qb;
    const GLB bf16_t* QKV = WSP(bf16_t, WS_SBQKV); const GLB bf16_t* VT = WSP(bf16_t, WS_SBVT);
    const GLB bf16_t* qp = QKV + ((size_t)b * SEQ + q0 + c) * 3072 + h * 128 + 8 * hh;
    bf16x8 qf[8];
#pragma unroll
    for (int ks = 0; ks < 8; ++ks) qf[ks] = *(const GLB bf16x8*)(qp + 16 * ks);
    f32x16 O[4];
#pragma unroll
    for (int db = 0; db < 4; ++db)
#pragma unroll
        for (int r = 0; r < 16; ++r) O[db][r] = 0.f;
    float carry = 1.0f;
    const int km = 16 * ((c >> 2) & 1) + 4 * (c >> 3) + (c & 3);
    const GLB bf16_t* kbase = QKV + ((size_t)b * SEQ + km) * 3072 + 1024 + h * 128 + 8 * hh;
    const GLB bf16_t* vbase = VT + ((size_t)bh * 128 + c) * SEQ + 16 * hh;
    bf16x8 kf[8];
#pragma unroll
    for (int ks = 0; ks < 8; ++ks) kf[ks] = *(const GLB bf16x8*)(kbase + (size_t)q0 * 3072 + 16 * ks);
    for (int kt = qb; kt >= 0; --kt) {
        const int k0 = 32 * kt;
        bf16x8 vf[2][4];
#pragma unroll
        for (int s = 0; s < 2; ++s)
#pragma unroll
            for (int db = 0; db < 4; ++db) vf[s][db] = *(const GLB bf16x8*)(vbase + (size_t)(32 * db) * SEQ + k0 + 8 * s);
        f32x16 S;
#pragma unroll
        for (int r = 0; r < 16; ++r) S[r] = 0.f;
#pragma unroll
        for (int ks = 0; ks < 8; ++ks) S = __builtin_amdgcn_mfma_f32_32x32x16_bf16(kf[ks], qf[ks], S, 0, 0, 0);
        if (kt > 0) {
#pragma unroll
            for (int ks = 0; ks < 8; ++ks) kf[ks] = *(const GLB bf16x8*)(kbase + (size_t)(k0 - 32) * 3072 + 16 * ks);
        }
        const bool diag = (kt == qb);
        float w[16]; float sp = 1.0f;
#pragma unroll
        for (int r = 15; r >= 0; --r) {
            const float e = __builtin_amdgcn_exp2f(fminf(S[r] * -0.12751743074602535f, 115.0f)), rr = __builtin_amdgcn_rcpf(1.0f + e), er = e * rr;
            const bool valid = !diag || (16 * hh + r < c);
            const float beta = valid ? rr : 0.f, om = valid ? er : 1.0f;
            w[r] = beta * sp; sp *= om;
        }
        const float tot_other = __shfl_xor(sp, 32);
        const float pre = carry * (hh == 0 ? tot_other : 1.0f);
        carry *= sp * tot_other;
        const bool live = __ballot(carry >= SB_EXIT_MASS) != 0ull;
        bf16x8 pw[2];
#pragma unroll
        for (int s = 0; s < 2; ++s) { u32x4 t; t.x = pk2(w[8 * s] * pre, w[8 * s + 1] * pre); t.y = pk2(w[8 * s + 2] * pre, w[8 * s + 3] * pre);
            t.z = pk2(w[8 * s + 4] * pre, w[8 * s + 5] * pre); t.w = pk2(w[8 * s + 6] * pre, w[8 * s + 7] * pre); pw[s] = __builtin_bit_cast(bf16x8, t); }
#pragma unroll
        for (int s = 0; s < 2; ++s)
#pragma unroll
            for (int db = 0; db < 4; ++db) O[db] = __builtin_amdgcn_mfma_f32_32x32x16_bf16(vf[s][db], pw[s], O[db], 0, 0, 0);
        if (!live) break;
    }
    GLB bf16_t* yp = WSP(bf16_t, WS_Y) + ((size_t)b * SEQ + q0 + c) * 4096 + h * 128 + 4 * hh;
#pragma unroll
    for (int db = 0; db < 4; ++db)
#pragma unroll
        for (int a = 0; a < 4; ++a) { u32x2 o; o.x = pk2(O[db][4 * a], O[db][4 * a + 1]); o.y = pk2(O[db][4 * a + 2], O[db][4 * a + 3]);
            *(GLB u32x2*)(yp + 32 * db + 8 * a) = o; }
}
__device__ __forceinline__ void ph_sb_fast(const Ctx& C) {
    int lane = C.lane; asm volatile("" : "+v"(lane)); lane &= 63;
    const int pi = blockIdx.x * 4 + (C.wave & 3);
    if (pi < 1024) { const int bh = pi >> 5, j = pi & 31; sb_item(C, lane, bh, (C.wave >> 2) ? 63 - j : j); }
}

#ifndef SWA_OUT_OFF
#define SWA_OUT_OFF WS_Y
#endif
__device__ __forceinline__ void swa_item(const Ctx& C, int lane, int l, int b, int h, int tb) {
    const int c = lane & 31, hh = lane >> 5, t0 = 32 * tb, kvh = h >> 3;
    const GLB bf16_t* qp = WSP(bf16_t, WS_QS) + ((size_t)b * SEQ + t0 + c) * 1024 + h * 64 + 8 * hh;
    bf16x8 qf[4];
#pragma unroll
    for (int ks = 0; ks < 4; ++ks) qf[ks] = *(const GLB bf16x8*)(qp + 16 * ks);
    const int km = 16 * ((c >> 2) & 1) + 4 * (c >> 3) + (c & 3);
    const GLB bf16_t* kbase = WSP(bf16_t, WS_KS) + ((size_t)b * SEQ + km) * 128 + kvh * 64 + 8 * hh;
    const GLB bf16_t* vbase = WSP(bf16_t, WS_SWVT) + ((size_t)(b * 2 + kvh) * 64 + c) * SEQ + 16 * hh;
    float mrun = INF32(I_SSINK)[l * 16 + h], lrun = 1.0f;
    f32x16 O[2];
#pragma unroll
    for (int db = 0; db < 2; ++db)
#pragma unroll
        for (int r = 0; r < 16; ++r) O[db][r] = 0.f;
    const int i0 = (tb >= 4) ? 0 : 4 - tb;
    for (int i = i0; i < 5; ++i) {
        const int k0 = t0 - 128 + 32 * i;
        bf16x8 kf[4], vf[2][2];
#pragma unroll
        for (int ks = 0; ks < 4; ++ks) kf[ks] = *(const GLB bf16x8*)(kbase + (size_t)k0 * 128 + 16 * ks);
#pragma unroll
        for (int s = 0; s < 2; ++s)
#pragma unroll
            for (int db = 0; db < 2; ++db) vf[s][db] = *(const GLB bf16x8*)(vbase + (size_t)(32 * db) * SEQ + k0 + 8 * s);
        f32x16 a;
#pragma unroll
        for (int r = 0; r < 16; ++r) a[r] = 0.f;
#pragma unroll
        for (int ks = 0; ks < 4; ++ks) a = __builtin_amdgcn_mfma_f32_32x32x16_bf16(kf[ks], qf[ks], a, 0, 0, 0);
        float tmax = -1.0e30f;
#pragma unroll
        for (int r = 0; r < 16; ++r) { const int kr = 16 * hh + r; const bool valid = (i == 0) ? (kr > c) : ((i == 4) ? (kr <= c) : true); a[r] = valid ? a[r] * 0.125f : -1.0e30f; tmax = fmaxf(tmax, a[r]); }
        tmax = fmaxf(tmax, __shfl_xor(tmax, 32));
        const float mnew = fmaxf(mrun, tmax), alpha = __expf(mrun - mnew);
        float psum = 0.f;
#pragma unroll
        for (int r = 0; r < 16; ++r) { a[r] = __expf(a[r] - mnew); psum += a[r]; }
        psum += __shfl_xor(psum, 32);
        lrun = lrun * alpha + psum; mrun = mnew;
#pragma unroll
        for (int db = 0; db < 2; ++db)
#pragma unroll
            for (int r = 0; r < 16; ++r) O[db][r] *= alpha;
#pragma unroll
        for (int s = 0; s < 2; ++s) {
            u32x4 t; t.x = pk2(a[8 * s], a[8 * s + 1]); t.y = pk2(a[8 * s + 2], a[8 * s + 3]); t.z = pk2(a[8 * s + 4], a[8 * s + 5]); t.w = pk2(a[8 * s + 6], a[8 * s + 7]);
            const bf16x8 pw = __builtin_bit_cast(bf16x8, t);
#pragma unroll
            for (int db = 0; db < 2; ++db) O[db] = __builtin_amdgcn_mfma_f32_32x32x16_bf16(vf[s][db], pw, O[db], 0, 0, 0);
        }
    }
    const float inv = 1.0f / lrun;
    GLB bf16_t* yp = WSP(bf16_t, SWA_OUT_OFF) + ((size_t)b * SEQ + t0 + c) * 4096 + 3072 + h * 64 + 4 * hh;
#pragma unroll
    for (int db = 0; db < 2; ++db)
#pragma unroll
        for (int a4 = 0; a4 < 4; ++a4) { u32x2 o; o.x = pk2(O[db][4 * a4] * inv, O[db][4 * a4 + 1] * inv); o.y = pk2(O[db][4 * a4 + 2] * inv, O[db][4 * a4 + 3] * inv);
            *(GLB u32x2*)(yp + 32 * db + 8 * a4) = o; }
}
__device__ __forceinline__ void ph_swa_fast(const Ctx& C, int l) {
    int lane = C.lane; asm volatile("" : "+v"(lane)); lane &= 63;
    if (C.wave >= 4) return;
    for (int it = blockIdx.x * 4 + C.wave; it < NB * 64 * 16; it += C.G * 4) { const int h = it & 15, tb = (it >> 4) & 63, b = it >> 10; swa_item(C, lane, l, b, h, tb); }
}

__device__ __forceinline__ float row16_sum(float x) {
    x += __builtin_bit_cast(float, __builtin_amdgcn_mov_dpp(__builtin_bit_cast(int, x), 0x128, 0xf, 0xf, true));
    x += __builtin_bit_cast(float, __builtin_amdgcn_mov_dpp(__builtin_bit_cast(int, x), 0x124, 0xf, 0xf, true));
    x += __builtin_bit_cast(float, __builtin_amdgcn_mov_dpp(__builtin_bit_cast(int, x), 0x122, 0xf, 0xf, true));
    x += __builtin_bit_cast(float, __builtin_amdgcn_mov_dpp(__builtin_bit_cast(int, x), 0x121, 0xf, 0xf, true));
    return x;
}
__device__ __forceinline__ void ph_rwkv_scan_fast(const Ctx& C) {
    int tid = C.tid; asm volatile("" : "+v"(tid));
    const int lane = tid & 63, wave = C.wave;
    LAS float* buf = (LAS float*)C.lds;
    constexpr int CH = 32, CHF = CH * 384;
    for (int it = blockIdx.x; it < NB * 16 * 4; it += C.G) {
        const int qr = it & 3, h = (it >> 2) & 15, b = it >> 6;
        const size_t gbase = (size_t)b * SEQ * 1024 + h * 64;
        const int ro = lane >> 4, kq = lane & 15, row = 16 * qr + 4 * (wave & 3) + ro;
        float S0 = 0.f, S1 = 0.f, S2 = 0.f, S3 = 0.f;
        const int lj = tid - 256;
        auto load_chunk = [&](int cidx) {
            f32x4 v[12];
#pragma unroll
            for (int i = 0; i < 12; ++i) { const int idx = lj + 256 * i, step = idx / 96, rem = idx - step * 96, vec = rem >> 4, e4 = rem & 15;
                const size_t off = (vec == 0) ? WS_R : (vec == 1) ? WS_DEC : (vec == 2) ? WS_K : (vec == 3) ? WS_KK : (vec == 4) ? WS_AA : WS_V;
                v[i] = *(const GLB f32x4*)(WSP(float, off) + gbase + (size_t)(cidx * CH + step) * 1024 + 4 * e4); }
            LAS float* d = buf + (cidx & 1) * CHF;
#pragma unroll
            for (int i = 0; i < 12; ++i) { const int idx = lj + 256 * i, step = idx / 96, rem = idx - step * 96; *(LAS f32x4*)(d + step * 384 + rem * 4) = v[i]; }
        };
        if (wave >= 4) load_chunk(0);
        LDS_WAIT(); __syncthreads();
        for (int cidx = 0; cidx < SEQ / CH; ++cidx) {
            if (wave >= 4) { if (cidx + 1 < SEQ / CH) load_chunk(cidx + 1); }
            else {
                const LAS float* cb = buf + (cidx & 1) * CHF;
#pragma unroll 4
                for (int st = 0; st < CH; ++st) {
                    const LAS float* rb = cb + st * 384;
                    const f32x4 kk4 = *(const LAS f32x4*)(rb + 192 + 4 * kq);
                    const float p = row16_sum(S0 * kk4[0] + S1 * kk4[1] + S2 * kk4[2] + S3 * kk4[3]);
                    const f32x4 w4 = *(const LAS f32x4*)(rb + 64 + 4 * kq), b4 = *(const LAS f32x4*)(rb + 256 + 4 * kq), k4 = *(const LAS f32x4*)(rb + 128 + 4 * kq), r4 = *(const LAS f32x4*)(rb + 4 * kq);
                    const float vv = rb[320 + row];
                    S0 = S0 * w4[0] - p * b4[0] + vv * k4[0]; S1 = S1 * w4[1] - p * b4[1] + vv * k4[1]; S2 = S2 * w4[2] - p * b4[2] + vv * k4[2]; S3 = S3 * w4[3] - p * b4[3] + vv * k4[3];
                    const float y = row16_sum(S0 * r4[0] + S1 * r4[1] + S2 * r4[2] + S3 * r4[3]);
                    if (kq == 0) WSP(float, WS_YRAW)[gbase + (size_t)(cidx * CH + st) * 1024 + row] = y;
                }
            }
            LDS_WAIT(); __syncthreads();
        }
    }
}

__device__ __forceinline__ void dsa_item(const Ctx& C, int lane, int wave, int b, int g, int layer) {
    const int c = lane & 31, hh = lane >> 5, t0 = 4 * g;
    LAS float* sc = (LAS float*)(C.lds + wave * 17408);
    LAS unsigned* bm = (LAS unsigned*)(C.lds + wave * 17408 + 16384);
    const size_t bm0 = (size_t)b * SEQ;
    const int ntile = (t0 + 3) / 32 + 1;
    const int hw = wave >> 2, wq = wave & 3;
    volatile LAS unsigned* cnt = (volatile LAS unsigned*)(C.lds + MISC_OFF + 128 + 4 * hw);
    unsigned target = (unsigned)layer * 4u * (unsigned)(ntile + 6);
    auto arrive = [&]() { asm volatile("s_waitcnt vmcnt(0) lgkmcnt(0)" ::: "memory"); if (lane == 0) (void)__hip_atomic_fetch_add((LAS unsigned*)(C.lds + MISC_OFF + 128 + 4 * hw), 1u, __ATOMIC_RELAXED, __HIP_MEMORY_SCOPE_WORKGROUP); };
    auto wait_all = [&]() { target += 4u; while ((int)(*cnt - target) < 0) __builtin_amdgcn_s_sleep(1); asm volatile("" ::: "memory"); };
#pragma unroll 1
    for (int p = 0; p < 2; ++p) {
        {
            arrive(); wait_all();
            const int hd = (c & 3) + 4 * (c >> 3);
            bf16x8 qf[4][4]; f32x4 w4[4][4];
#pragma unroll
            for (int j = 0; j < 4; ++j) { const int t0j = t0 + 4 * (hw ? (wq - j) : (j - wq));
                const GLB bf16_t* qp = WSP(bf16_t, WS_QI) + (bm0 + t0j + 2 * p + ((c >> 2) & 1)) * 1024 + hd * 64 + 8 * hh;
                const GLB float* wp = WSP(float, WS_WI) + (bm0 + t0j + 2 * p + hh) * 16;
#pragma unroll
                for (int ks = 0; ks < 4; ++ks) { qf[j][ks] = *(const GLB bf16x8*)(qp + 16 * ks); w4[j][ks] = *(const GLB f32x4*)(wp + 4 * ks); } }
            const GLB bf16_t* kp = WSP(bf16_t, WS_KI) + (bm0 + c) * 64 + 8 * hh;
            bf16x8 kf[4];
            if (wq < ntile) {
#pragma unroll
                for (int ks = 0; ks < 4; ++ks) kf[ks] = *(const GLB bf16x8*)(kp + (size_t)(32 * wq) * 64 + 16 * ks);
            }
            for (int kt = wq; kt < ntile; kt += 4) {
                f32x16 a[4];
#pragma unroll
                for (int j = 0; j < 4; ++j)
#pragma unroll
                    for (int r = 0; r < 16; ++r) a[j][r] = 0.f;
#pragma unroll
                for (int ks = 0; ks < 4; ++ks)
#pragma unroll
                    for (int j = 0; j < 4; ++j) a[j] = __builtin_amdgcn_mfma_f32_32x32x16_bf16(qf[j][ks], kf[ks], a[j], 0, 0, 0);
                if (kt + 4 < ntile) {
#pragma unroll
                    for (int ks = 0; ks < 4; ++ks) kf[ks] = *(const GLB bf16x8*)(kp + (size_t)(32 * (kt + 4)) * 64 + 16 * ks);
                }
#pragma unroll
                for (int j = 0; j < 4; ++j) { float s = 0.f;
#pragma unroll
                    for (int r = 0; r < 16; ++r) s += w4[j][r >> 2][r & 3] * fmaxf(a[j][r], 0.f);
                    ((LAS float*)(C.lds + (4 * hw + j) * 17408))[hh * 2048 + 32 * kt + c] = s; }
            }
            arrive(); wait_all();
        }
        LDS_WAIT();
#pragma unroll 1
        for (int qs = 0; qs < 2; ++qs) {
            const int t = t0 + 2 * p + qs, n = t + 1;
            const LAS float* sq = sc + qs * 2048;
            unsigned myword_lo = 0u, myword_hi = 0u;
            if (n <= 256) {
#pragma unroll
                for (int i = 0; i < 4; ++i) { const unsigned long long bal = __ballot(lane + 64 * i < n); if (lane == i) { myword_lo = (unsigned)bal; myword_hi = (unsigned)(bal >> 32); } }
            } else {
                unsigned key[32];
#pragma unroll
                for (int i = 0; i < 32; ++i) { const int s = lane + 64 * i; key[i] = (s < n) ? ordkey(sq[s]) : 0u; }
                unsigned tau = 0u;
                for (int bit = 31; bit >= 0; --bit) {
                    const unsigned cand = tau | (1u << bit); int cl = 0;
#pragma unroll
                    for (int i = 0; i < 32; ++i) cl += (key[i] >= cand) ? 1 : 0;
                    const int cnt = wave_isum(cl);
                    if (cnt >= 256) { tau = cand; if (cnt == 256) break; }
                }
                int cgl = 0;
#pragma unroll
                for (int i = 0; i < 32; ++i) cgl += (key[i] > tau) ? 1 : 0;
                const int cgt = wave_isum(cgl);
                const int need = 256 - cgt; int eqbase = 0;
                const unsigned long long lt = (1ull << lane) - 1ull;
#pragma unroll
                for (int i = 0; i < 32; ++i) {
                    const bool gt = key[i] > tau, eq = key[i] == tau;
                    const unsigned long long beq = __ballot(eq);
                    const bool sel = gt || (eq && (eqbase + __popcll(beq & lt)) < need);
                    const unsigned long long bal = __ballot(sel);
                    if (lane == i) { myword_lo = (unsigned)bal; myword_hi = (unsigned)(bal >> 32); }
                    eqbase += __popcll(beq);
                }
            }
            if (lane < 32) { bm[(2 * p + qs) * 64 + 2 * lane] = myword_lo; bm[(2 * p + qs) * 64 + 2 * lane + 1] = myword_hi; }
        }
        LDS_WAIT();
    }
    const int cq = c >> 3, ch = c & 7;
    const GLB bf16_t* qp = WSP(bf16_t, WS_QD) + (bm0 + t0 + cq) * 1024 + ch * 128 + 8 * hh;
    bf16x8 qf[8];
#pragma unroll
    for (int ks = 0; ks < 8; ++ks) qf[ks] = *(const GLB bf16x8*)(qp + 16 * ks);
    const int km = 16 * ((c >> 2) & 1) + 4 * (c >> 3) + (c & 3);
    const GLB bf16_t* kbase = WSP(bf16_t, WS_KD) + (bm0 + km) * 128 + 8 * hh;
    const GLB bf16_t* vbase = WSP(bf16_t, WS_VDT) + ((size_t)b * 128 + c) * SEQ + 16 * hh;
    const LAS unsigned short* bmh = (const LAS unsigned short*)(bm + cq * 64) + hh;
    float mrun = -1.0e20f, lrun = 0.f;
    f32x16 O[4];
#pragma unroll
    for (int db = 0; db < 4; ++db)
#pragma unroll
        for (int r = 0; r < 16; ++r) O[db][r] = 0.f;
    const GLB char* kg = (const GLB char*)(WSP(bf16_t, WS_KD) + bm0 * 128);
    const GLB char* vg = (const GLB char*)(WSP(bf16_t, WS_VDT) + (size_t)b * 128 * SEQ);
    auto stage = [&](int kt) {
        LAS char* tb = (LAS char*)(C.lds + (4 * hw + kt % 3) * 17408);
#pragma unroll
        for (int i = 0; i < 2; ++i) { const int r = 8 * wq + 4 * i + (lane >> 4), pch = lane & 15, key = (r & 7) + 8 * (r >> 4);
            __builtin_amdgcn_global_load_lds((const GLB unsigned*)(kg + ((size_t)(32 * kt + r) * 256 + 16 * (pch ^ key))), (LAS unsigned*)(tb + (8 * wq + 4 * i) * 256), 16, 0, 0); }
#pragma unroll
        for (int i = 0; i < 2; ++i) { const int d = 32 * wq + 16 * i + (lane >> 2), pch = lane & 3, key = (d >> 2) & 3;
            __builtin_amdgcn_global_load_lds((const GLB unsigned*)(vg + ((size_t)d * (SEQ * 2) + 64 * kt + 16 * (pch ^ key))), (LAS unsigned*)(tb + 8192 + (32 * wq + 16 * i) * 64), 16, 0, 0); }
    };
    arrive(); wait_all();
    stage(0); if (ntile > 1) stage(1);
    arrive();
    const int kkey = (km & 7) + 8 * (km >> 4);
    f32x16 a;
    {
        wait_all();
        const LAS char* tb0 = (const LAS char*)(C.lds + (4 * hw) * 17408);
        bf16x8 kf0[8];
#pragma unroll
        for (int ks = 0; ks < 8; ++ks) kf0[ks] = *(const LAS bf16x8*)(tb0 + km * 256 + 16 * ((hh + 2 * ks) ^ kkey));
#pragma unroll
        for (int r = 0; r < 16; ++r) a[r] = 0.f;
#pragma unroll
        for (int ks = 0; ks < 8; ++ks) a = __builtin_amdgcn_mfma_f32_32x32x16_bf16(kf0[ks], qf[ks], a, 0, 0, 0);
    }
    for (int kt = 0; kt < ntile; ++kt) {
        if (kt > 0) wait_all();
        const LAS char* tb = (const LAS char*)(C.lds + (4 * hw + kt % 3) * 17408);
        const LAS char* tn = (const LAS char*)(C.lds + (4 * hw + (kt + 1) % 3) * 17408);
        const bool nxt = kt + 1 < ntile;
        bf16x8 kf[8], vf[2][4];
        if (nxt) {
#pragma unroll
            for (int ks = 0; ks < 8; ++ks) kf[ks] = *(const LAS bf16x8*)(tn + km * 256 + 16 * ((hh + 2 * ks) ^ kkey));
        }
#pragma unroll
        for (int s = 0; s < 2; ++s)
#pragma unroll
            for (int db = 0; db < 4; ++db) { const int d = c + 32 * db; vf[s][db] = *(const LAS bf16x8*)(tb + 8192 + d * 64 + 16 * ((2 * hh + s) ^ ((d >> 2) & 3))); }
        const unsigned bits = bmh[2 * kt];
        asm volatile("s_waitcnt lgkmcnt(0)" ::: "memory");
        if (kt + 2 < ntile) stage(kt + 2);
        f32x16 an;
#pragma unroll
        for (int r = 0; r < 16; ++r) an[r] = 0.f;
        if (nxt) {
#pragma unroll
            for (int ks = 0; ks < 8; ++ks) an = __builtin_amdgcn_mfma_f32_32x32x16_bf16(kf[ks], qf[ks], an, 0, 0, 0);
        }
        float tmax = -1.0e30f;
#pragma unroll
        for (int r = 0; r < 16; ++r) { const float x = a[r] * 0.12751743074602535f; const int mk = (int)(bits << (31 - r)) >> 31;
            a[r] = __builtin_bit_cast(float, (__builtin_bit_cast(int, x) & mk) | (~mk & (int)0xF149F2CAu)); tmax = fmaxf(tmax, a[r]); }
        tmax = fmaxf(tmax, __shfl_xor(tmax, 32));
        if (__ballot(tmax > mrun + 11.541560327111707f) != 0ull) {
            const float mnew = fmaxf(mrun, tmax), alpha = __builtin_amdgcn_exp2f(mrun - mnew);
            lrun *= alpha; mrun = mnew;
#pragma unroll
            for (int db = 0; db < 4; ++db)
#pragma unroll
                for (int r = 0; r < 16; ++r) O[db][r] *= alpha;
        }
        float psum = 0.f;
#pragma unroll
        for (int r = 0; r < 16; ++r) { a[r] = __builtin_amdgcn_exp2f(a[r] - mrun); psum += a[r]; }
        psum += __shfl_xor(psum, 32);
        lrun += psum;
#pragma unroll
        for (int s = 0; s < 2; ++s) {
            u32x4 t; t.x = pk2(a[8 * s], a[8 * s + 1]); t.y = pk2(a[8 * s + 2], a[8 * s + 3]); t.z = pk2(a[8 * s + 4], a[8 * s + 5]); t.w = pk2(a[8 * s + 6], a[8 * s + 7]);
            const bf16x8 pw = __builtin_bit_cast(bf16x8, t);
#pragma unroll
            for (int db = 0; db < 4; ++db) O[db] = __builtin_amdgcn_mfma_f32_32x32x16_bf16(vf[s][db], pw, O[db], 0, 0, 0);
        }
        a = an;
        arrive();
    }
    const float inv = 1.0f / lrun;
    GLB bf16_t* yp = WSP(bf16_t, WS_Y) + (bm0 + t0 + cq) * 4096 + 2048 + ch * 128 + 4 * hh;
#pragma unroll
    for (int db = 0; db < 4; ++db)
#pragma unroll
        for (int a4 = 0; a4 < 4; ++a4) { u32x2 o; o.x = pk2(O[db][4 * a4] * inv, O[db][4 * a4 + 1] * inv); o.y = pk2(O[db][4 * a4 + 2] * inv, O[db][4 * a4 + 3] * inv);
            *(GLB u32x2*)(yp + 32 * db + 8 * a4) = o; }
    LDS_WAIT();
}
__device__ __forceinline__ void ph_dsa_fast(const Ctx& C, int l) {
    int lane = C.lane; asm volatile("" : "+v"(lane)); lane &= 63;
    const int pi = blockIdx.x * 4 + (C.wave & 3);
    if (pi < 1024) { const int b = pi >> 8, j = pi & 255; dsa_item(C, lane, C.wave, b, (C.wave >> 2) ? 511 - j : j, l); }
}

constexpr int SCAN_CNT_OFF = MISC_OFF + 64;
__device__ __forceinline__ void ph_rwkv_scan_conv(const Ctx& C, int l) {
    int tid = C.tid; asm volatile("" : "+v"(tid));
    const int lane = tid & 63, wave = C.wave;
    if (wave >= 4) {
        LAS float* scr = (LAS float*)(C.lds + 65536 + (wave - 4) * 16640);
        constexpr int PER = MOE_CONV_ITEMS / 2 / 1024;
        const int first = l * (MOE_CONV_ITEMS / 2) + (blockIdx.x * 4 + (wave - 4)) * PER;
        if (!MOE_CONV_IN_PROLOGUE && blockIdx.x < 256)
            for (int i = 0; i < PER; ++i) conv_moe_item(C, first + i, scr, lane);
        return;
    }
    constexpr int CH = 16, CHF = CH * 384, NCH = SEQ / CH;
    LAS float* buf = (LAS float*)C.lds;
    volatile LAS unsigned* cnt = (volatile LAS unsigned*)(C.lds + SCAN_CNT_OFF);
    const int it = blockIdx.x;
    if (it >= NB * 16 * 4) return;
    const int qr = it & 3, h = (it >> 2) & 15, b = it >> 6;
    const size_t gbase = (size_t)b * SEQ * 1024 + h * 64;
    const int ro = lane >> 4, kq = lane & 15, row = 16 * qr + 4 * wave + ro;
    unsigned target = (unsigned)l * 4u * (NCH + 1);
    auto issue = [&](int cidx) {
#pragma unroll
        for (int j = 0; j < 6; ++j) { const int i = wave + 4 * j, rho = 4 * i + ro, step = rho / 6, vec = rho - 6 * step;
            const size_t off = (vec == 0) ? WS_R : (vec == 1) ? WS_DEC : (vec == 2) ? WS_K : (vec == 3) ? WS_KK : (vec == 4) ? WS_AA : WS_V;
            const GLB float* src = WSP(float, off) + gbase + (size_t)(cidx * CH + step) * 1024 + 4 * kq;
            __builtin_amdgcn_global_load_lds((const GLB unsigned*)src, (LAS unsigned*)(buf + (cidx & 1) * CHF + i * 256), 16, 0, 0); }
    };
    auto arrive_wait = [&]() {
        asm volatile("s_waitcnt vmcnt(0)" ::: "memory");
        target += 4u;
        if (lane == 0) (void)__hip_atomic_fetch_add((LAS unsigned*)(C.lds + SCAN_CNT_OFF), 1u, __ATOMIC_RELAXED, __HIP_MEMORY_SCOPE_WORKGROUP);
        while ((int)(*cnt - target) < 0) __builtin_amdgcn_s_sleep(1);
        asm volatile("" ::: "memory");
    };
    float S0 = 0.f, S1 = 0.f, S2 = 0.f, S3 = 0.f;
    issue(0); arrive_wait();
    for (int cidx = 0; cidx < NCH; ++cidx) {
        if (cidx + 1 < NCH) issue(cidx + 1);
        const LAS float* cb = buf + (cidx & 1) * CHF;
#pragma unroll 4
        for (int st = 0; st < CH; ++st) {
            const LAS float* rb = cb + st * 384;
            const f32x4 kk4 = *(const LAS f32x4*)(rb + 192 + 4 * kq);
            const float p = row16_sum(S0 * kk4[0] + S1 * kk4[1] + S2 * kk4[2] + S3 * kk4[3]);
            const f32x4 w4 = *(const LAS f32x4*)(rb + 64 + 4 * kq), b4 = *(const LAS f32x4*)(rb + 256 + 4 * kq), k4 = *(const LAS f32x4*)(rb + 128 + 4 * kq), r4 = *(const LAS f32x4*)(rb + 4 * kq);
            const float vv = rb[320 + row];
            S0 = S0 * w4[0] - p * b4[0] + vv * k4[0]; S1 = S1 * w4[1] - p * b4[1] + vv * k4[1]; S2 = S2 * w4[2] - p * b4[2] + vv * k4[2]; S3 = S3 * w4[3] - p * b4[3] + vv * k4[3];
            const float y = row16_sum(S0 * r4[0] + S1 * r4[1] + S2 * r4[2] + S3 * r4[3]);
            if (kq == 0) WSP(float, WS_YRAW)[gbase + (size_t)(cidx * CH + st) * 1024 + row] = y;
        }
        asm volatile("s_waitcnt lgkmcnt(0)" ::: "memory");
        arrive_wait();
    }
}

#ifndef SCAN3_CONV_MODE
#define SCAN3_CONV_MODE 0
#endif
#ifndef CONV_NT
#define CONV_NT 0
#endif
__device__ __forceinline__ void conv_tile_load(const GLB float* W, int ldw, int k0, int s0, f32x4 (&v)[16], int lane) {
    const int cq = lane & 15, rq = lane >> 4;
    const unsigned loff = (unsigned)(rq * ldw + 4 * cq);
    const GLB float* base = W + (size_t)k0 * ldw + s0;
#pragma unroll
    for (int i = 0; i < 16; ++i) { const GLB float* rowp = base + (size_t)(4 * i) * ldw; v[i] = CONV_NT ? __builtin_nontemporal_load((const GLB f32x4*)(rowp + loff)) : *(const GLB f32x4*)(rowp + loff); }
}
__device__ __forceinline__ void conv_tile_to_lds(const f32x4 (&v)[16], LAS float* scr, int lane) {
    const int cq = lane & 15, rq = lane >> 4;
#pragma unroll
    for (int i = 0; i < 16; ++i) { const int kk = 4 * i + rq; LAS float* d = scr + kk * 65 + 4 * cq; d[0] = v[i][0]; d[1] = v[i][1]; d[2] = v[i][2]; d[3] = v[i][3]; }
}
__device__ __forceinline__ void conv_tile_from_lds(GLB bf16_t* Bt, int K, int n0, int k0, LAS float* scr, int lane) {
    const int c = lane & 7;
#pragma unroll
    for (int j = 0; j < 8; ++j) { const int n = (lane >> 3) + 8 * j; const LAS float* s = scr + (8 * c) * 65 + n;
        u32x4 o; o.x = pk2(s[0 * 65], s[1 * 65]); o.y = pk2(s[2 * 65], s[3 * 65]); o.z = pk2(s[4 * 65], s[5 * 65]); o.w = pk2(s[6 * 65], s[7 * 65]);
        if (CONV_NT & 2) __builtin_nontemporal_store(o, (GLB u32x4*)(Bt + (size_t)(n0 + n) * K + k0 + 8 * c)); else *(GLB u32x4*)(Bt + (size_t)(n0 + n) * K + k0 + 8 * c) = o; }
}
__device__ __forceinline__ void conv_tile_finish(const f32x4 (&v)[16], GLB bf16_t* Bt, int K, int n0, int k0, LAS float* scr, int lane) {
    conv_tile_to_lds(v, scr, lane); LDS_WAIT(); conv_tile_from_lds(Bt, K, n0, k0, scr, lane); LDS_WAIT();
}
struct MoeTile { const GLB float* W; GLB bf16_t* Bt; int ldw, K, k0, s0, n0; };
__device__ __forceinline__ MoeTile moe_tile_desc(const Ctx& C, int idx) {
    constexpr int I_GU1 = (D / 64) * (2 * FF / 64), I_DN1 = (FF / 64) * (D / 64);
    MoeTile t;
    if (idx < NE * I_GU1) {
        const int e = idx / I_GU1, r = idx % I_GU1, nb = r % (2 * FF / 64), kb = r / (2 * FF / 64), tile = nb >> 2, q = nb & 3;
        t.W = ((q < 2) ? INF32(I_MG) : INF32(I_MU)) + (size_t)e * D * FF; t.ldw = FF; t.k0 = 64 * kb; t.s0 = 128 * tile + 64 * (q & 1);
        t.Bt = WSP(bf16_t, WS_MWGU) + (size_t)e * 2 * FF * D; t.K = D; t.n0 = 64 * nb;
    } else {
        const int r0 = idx - NE * I_GU1, e = r0 / I_DN1, r = r0 % I_DN1, nb = r % 32, kb = r / 32;
        t.W = INF32(I_MD) + (size_t)e * FF * D; t.ldw = D; t.k0 = 64 * kb; t.s0 = 64 * nb; t.Bt = WSP(bf16_t, WS_MWD) + (size_t)e * D * FF; t.K = FF; t.n0 = 64 * nb;
    }
    return t;
}
__device__ __forceinline__ void ph_rwkv_scan4(const Ctx& C, int l) {
    int tid = C.tid; asm volatile("" : "+v"(tid));
    const int lane = tid & 63, wave = C.wave;
    if (wave >= 4) {
        if (MOE_CONV_IN_PROLOGUE || blockIdx.x >= 256) return;
        LAS float* scr = (LAS float*)(C.lds + 65536 + (wave - 4) * 16640);
        constexpr int PER = MOE_CONV_ITEMS / 2 / 1024;
        const int first = l * (MOE_CONV_ITEMS / 2) + (blockIdx.x * 4 + (wave - 4)) * PER;
        f32x4 va[16], vb[16];
        MoeTile ta = moe_tile_desc(C, first), tb;
        conv_tile_load(ta.W, ta.ldw, ta.k0, ta.s0, va, lane);
        for (int i = 0; i < PER; i += 2) {
            tb = moe_tile_desc(C, first + i + 1);
            conv_tile_load(tb.W, tb.ldw, tb.k0, tb.s0, vb, lane);
            conv_tile_finish(va, ta.Bt, ta.K, ta.n0, ta.k0, scr, lane);
            if (i + 2 < PER) { ta = moe_tile_desc(C, first + i + 2); conv_tile_load(ta.W, ta.ldw, ta.k0, ta.s0, va, lane); }
            conv_tile_finish(vb, tb.Bt, tb.K, tb.n0, tb.k0, scr, lane);
        }
        return;
    }
    constexpr int CH = 16, CHF = CH * 384, NCH = SEQ / CH;
    LAS float* buf = (LAS float*)C.lds;
    LAS float* ybuf = (LAS float*)(C.lds + 49152);
    volatile LAS unsigned* cnt = (volatile LAS unsigned*)(C.lds + SCAN_CNT_OFF);
    const int it = blockIdx.x;
    if (it >= NB * 16 * 4) return;
    const int qr = it & 3, h = (it >> 2) & 15, b = it >> 6;
    const size_t gbase = (size_t)b * SEQ * 1024 + h * 64;
    const int ro = lane >> 4, kq = lane & 15, rloc = 4 * wave + ro;
    unsigned target = (unsigned)l * 4u * (NCH + 1);
    auto issue = [&](int cidx) {
#pragma unroll
        for (int j = 0; j < 6; ++j) { const int i = wave + 4 * j, rho = 4 * i + ro, step = rho / 6, vec = rho - 6 * step;
            const size_t off = (vec == 0) ? WS_R : (vec == 1) ? WS_DEC : (vec == 2) ? WS_K : (vec == 3) ? WS_KK : (vec == 4) ? WS_AA : WS_V;
            const GLB float* src = WSP(float, off) + gbase + (size_t)(cidx * CH + step) * 1024 + 4 * kq;
            __builtin_amdgcn_global_load_lds((const GLB unsigned*)src, (LAS unsigned*)(buf + (cidx & 1) * CHF + i * 256), 16, 0, 0); }
    };
    auto arrive_wait = [&]() {
        asm volatile("s_waitcnt vmcnt(0) lgkmcnt(0)" ::: "memory");
        target += 4u;
        if (lane == 0) (void)__hip_atomic_fetch_add((LAS unsigned*)(C.lds + SCAN_CNT_OFF), 1u, __ATOMIC_RELAXED, __HIP_MEMORY_SCOPE_WORKGROUP);
        while ((int)(*cnt - target) < 0) __builtin_amdgcn_s_sleep(1);
        asm volatile("" ::: "memory");
    };
    auto flush_y = [&](int cidx) {
        const int st = lane >> 2, r = lane & 3;
        WSP(float, WS_YRAW)[gbase + (size_t)(cidx * CH + st) * 1024 + 16 * qr + 4 * wave + r] = ybuf[(cidx & 1) * 256 + st * 16 + 4 * wave + r];
    };
    f32x2 Sa = {0.f, 0.f}, Sb = {0.f, 0.f};
    issue(0); arrive_wait();
    for (int cidx = 0; cidx < NCH; ++cidx) {
        if (cidx > 0) flush_y(cidx - 1);
        if (cidx + 1 < NCH) issue(cidx + 1);
        const LAS float* cb = buf + (cidx & 1) * CHF;
        LAS float* yb = ybuf + (cidx & 1) * 256;
#pragma unroll 4
        for (int st = 0; st < CH; ++st) {
            const LAS float* rb = cb + st * 384;
            const f32x4 kk4 = *(const LAS f32x4*)(rb + 192 + 4 * kq);
            const f32x2 tp = Sa * (f32x2){kk4[0], kk4[1]} + Sb * (f32x2){kk4[2], kk4[3]};
            const float p = row16_sum(tp[0] + tp[1]);
            const f32x4 w4 = *(const LAS f32x4*)(rb + 64 + 4 * kq), b4 = *(const LAS f32x4*)(rb + 256 + 4 * kq), k4 = *(const LAS f32x4*)(rb + 128 + 4 * kq), r4 = *(const LAS f32x4*)(rb + 4 * kq);
            const float vv = rb[320 + 16 * qr + rloc];
            const f32x2 pp = {p, p}, vv2 = {vv, vv};
            Sa = Sa * (f32x2){w4[0], w4[1]} - pp * (f32x2){b4[0], b4[1]} + vv2 * (f32x2){k4[0], k4[1]};
            Sb = Sb * (f32x2){w4[2], w4[3]} - pp * (f32x2){b4[2], b4[3]} + vv2 * (f32x2){k4[2], k4[3]};
            const f32x2 ty = Sa * (f32x2){r4[0], r4[1]} + Sb * (f32x2){r4[2], r4[3]};
            const float y = row16_sum(ty[0] + ty[1]);
            if (kq == 0) yb[st * 16 + rloc] = y;
        }
        arrive_wait();
    }
    flush_y(NCH - 1);
}

#ifndef SCAN_TOUCH
#define SCAN_TOUCH 1
#endif
#ifndef SCAN_SCHED
#define SCAN_SCHED 1
#endif
#ifndef SCAN_UNROLL
#define SCAN_UNROLL 4
#endif
__device__ __forceinline__ void ph_rwkv_scan3(const Ctx& C, int l) {
    int tid = C.tid; asm volatile("" : "+v"(tid));
    const int lane = tid & 63, wave = C.wave;
    constexpr int CH = 16, CHF = CH * 384, NCH = SEQ / CH;
    LAS float* buf = (LAS float*)C.lds;
    LAS float* ybuf = (LAS float*)(C.lds + 49152);
    LAS float* scr = (LAS float*)(C.lds + 65536 + (wave & 3) * 16640);
    const int it = blockIdx.x;
    if (it >= NB * 16 * 4) return;
    const int qr = it & 3, h = (it >> 2) & 15, b = it >> 6;
    const size_t gbase = (size_t)b * SEQ * 1024 + h * 64;
    const int ro = lane >> 4, kq = lane & 15, rloc = 4 * (wave & 3) + ro;
    const int lj = tid - 256;
    constexpr int PER = MOE_CONV_ITEMS / 2 / 1024;
    static_assert(PER * 1024 * 2 == MOE_CONV_ITEMS && PER * 3 <= NCH, "conversion slots");
    const int cfirst = l * (MOE_CONV_ITEMS / 2) + (blockIdx.x * 4 + (wave & 3)) * PER;
    auto load_chunk = [&](int cidx) {
        f32x4 v[6];
#pragma unroll
        for (int i = 0; i < 6; ++i) { const int idx = lj + 256 * i, step = idx / 96, rem = idx - step * 96, vec = rem >> 4, e4 = rem & 15;
            const size_t off = (vec == 0) ? WS_R : (vec == 1) ? WS_DEC : (vec == 2) ? WS_K : (vec == 3) ? WS_KK : (vec == 4) ? WS_AA : WS_V;
            v[i] = *(const GLB f32x4*)(WSP(float, off) + gbase + (size_t)(cidx * CH + step) * 1024 + 4 * e4); }
        LAS float* d = buf + (cidx & 1) * CHF;
#pragma unroll
        for (int i = 0; i < 6; ++i) { const int idx = lj + 256 * i, step = idx / 96, rem = idx - step * 96; *(LAS f32x4*)(d + step * 384 + rem * 4) = v[i]; }
    };
    auto flush_y = [&](int cidx) {
        const int st = lj >> 4, r = lj & 15;
        WSP(float, WS_YRAW)[gbase + (size_t)(cidx * CH + st) * 1024 + 16 * qr + r] = ybuf[(cidx & 1) * 256 + lj];
    };
    f32x2 Sa = {0.f, 0.f}, Sb = {0.f, 0.f};
    f32x4 cv[16]; MoeTile ct; ct.W = nullptr; ct.Bt = nullptr; ct.ldw = 0; ct.K = 0; ct.k0 = 0; ct.s0 = 0; ct.n0 = 0;
#pragma unroll
    for (int i = 0; i < 16; ++i) cv[i] = (f32x4){0.f, 0.f, 0.f, 0.f};
    if (wave >= 4) load_chunk(0);
    LDS_WAIT(); __syncthreads();
    for (int cidx = 0; cidx < NCH; ++cidx) {
        if (wave >= 4) {
            if (cidx + 1 < NCH) load_chunk(cidx + 1);
            if (cidx > 0) flush_y(cidx - 1);
            if (!MOE_CONV_IN_PROLOGUE) {
                const int q3 = cidx / 3, r3 = cidx - 3 * q3;
                if (r3 == 0 && q3 < PER) { ct = moe_tile_desc(C, cfirst + q3); conv_tile_load(ct.W, ct.ldw, ct.k0, ct.s0, cv, lane); }
                else if (r3 == 1 && q3 < PER) conv_tile_finish(cv, ct.Bt, ct.K, ct.n0, ct.k0, scr, lane);
            }
        } else {
            const LAS float* cb = buf + (cidx & 1) * CHF;
            LAS float* yb = ybuf + (cidx & 1) * 256;
            __builtin_amdgcn_s_setprio(3);
#pragma unroll SCAN_UNROLL
            for (int st = 0; st < CH; ++st) {
                const LAS float* rb = cb + st * 384;
                const f32x4 kk4 = *(const LAS f32x4*)(rb + 192 + 4 * kq);
                const f32x2 tp = Sa * (f32x2){kk4[0], kk4[1]} + Sb * (f32x2){kk4[2], kk4[3]};
                const float p = row16_sum(tp[0] + tp[1]);
                const f32x4 w4 = *(const LAS f32x4*)(rb + 64 + 4 * kq), b4 = *(const LAS f32x4*)(rb + 256 + 4 * kq), k4 = *(const LAS f32x4*)(rb + 128 + 4 * kq), r4 = *(const LAS f32x4*)(rb + 4 * kq);
                const float vv = rb[320 + 16 * qr + rloc];
                const f32x2 pp = {p, p}, vv2 = {vv, vv};
                Sa = Sa * (f32x2){w4[0], w4[1]} - pp * (f32x2){b4[0], b4[1]} + vv2 * (f32x2){k4[0], k4[1]};
                Sb = Sb * (f32x2){w4[2], w4[3]} - pp * (f32x2){b4[2], b4[3]} + vv2 * (f32x2){k4[2], k4[3]};
                const f32x2 ty = Sa * (f32x2){r4[0], r4[1]} + Sb * (f32x2){r4[2], r4[3]};
                const float y = row16_sum(ty[0] + ty[1]);
                if (kq == 0) yb[st * 16 + rloc] = y;
            }
            __builtin_amdgcn_s_setprio(0);
        }
        LDS_WAIT(); __builtin_amdgcn_s_barrier(); asm volatile("" ::: "memory");
    }
    if (wave >= 4) flush_y(NCH - 1);
}


template <int CONV>
__device__ __forceinline__ void ph_rwkv_scan5(const Ctx& C, int l) {
    int tid = C.tid; asm volatile("" : "+v"(tid));
    const int lane = tid & 63, wave = C.wave;
    constexpr int CH = 16, CHF = CH * 384, NCH = SEQ / CH;
    LAS float* buf = (LAS float*)C.lds;
    LAS float* ybuf = (LAS float*)(C.lds + 49152);
    const int it = blockIdx.x;
    if (it >= NB * 16 * 4) return;
    const int qr = it & 3, h = (it >> 2) & 15, b = it >> 6;
    const size_t gbase = (size_t)b * SEQ * 1024 + h * 64;
#define SCAN5_BAR() do { LDS_WAIT(); __builtin_amdgcn_s_barrier(); asm volatile("" ::: "memory"); } while (0)
    if (wave >= 4) {
        LAS float* scr = (LAS float*)(C.lds + 65536 + (wave & 3) * 16640);
        const int lj = tid - 256;
        constexpr int PER = MOE_SCAN_TILES;
        static_assert(PER * 1024 * 2 <= MOE_CONV_ITEMS && PER * 3 + 2 <= NCH && PER % 2 == 0, "conversion slots");
        const int cfirst = ((CONV >= 2) ? 1 : l) * (1024 * PER) + (blockIdx.x * 4 + (wave & 3));
        f32x4 nx[5];
        const unsigned lo_g = (unsigned)((lj >> 4) * 1024 + 4 * (lj & 15));
        const int lo_l = (lj >> 4) * 384 + 4 * (lj & 15);
        const f32x4 kkw = *(const GLB f32x4*)(INF32(I_RWKK) + l * 1024 + h * 64 + 4 * (lj & 15)), kaw = *(const GLB f32x4*)(INF32(I_RWKA) + l * 1024 + h * 64 + 4 * (lj & 15));
        u32x2 nb[4];
        auto fetch_chunk = [&](int cidx) {
            nx[1] = *(const GLB f32x4*)(WSP(float, WS_DEC) + gbase + (size_t)(cidx * CH) * 1024 + lo_g);
#pragma unroll
            for (int i = 0; i < 4; ++i) { const size_t off = (i == 0) ? WS_R : (i == 1) ? WS_K : (i == 2) ? WS_AA : WS_V;
                nb[i] = *(const GLB u32x2*)(WSP(bf16_t, off) + gbase + (size_t)(cidx * CH) * 1024 + lo_g); }
        };
        auto put_chunk = [&](int cidx) {
            LAS float* d = buf + (cidx & 1) * CHF + lo_l;
            asm volatile("" : "+v"(nx[1]), "+v"(nb[0]), "+v"(nb[1]), "+v"(nb[2]), "+v"(nb[3]));
            nx[0] = (f32x4){bflo(nb[0].x), bfhi(nb[0].x), bflo(nb[0].y), bfhi(nb[0].y)}; nx[4] = (f32x4){bflo(nb[3].x), bfhi(nb[3].x), bflo(nb[3].y), bfhi(nb[3].y)};
            const f32x4 kr = (f32x4){bflo(nb[1].x), bfhi(nb[1].x), bflo(nb[1].y), bfhi(nb[1].y)}, av = (f32x4){bflo(nb[2].x), bfhi(nb[2].x), bflo(nb[2].y), bfhi(nb[2].y)};
            f32x4 kk = kr * kkw;
            const float ss = row16_sum((kk[0] * kk[0] + kk[1] * kk[1]) + (kk[2] * kk[2] + kk[3] * kk[3]));
            kk = kk * (1.0f / fmaxf(sqrtf(ss), 1e-12f));
            *(LAS f32x4*)(d) = nx[0]; *(LAS f32x4*)(d + 64) = nx[1]; *(LAS f32x4*)(d + 128) = kr * (1.0f + (av - 1.0f) * kaw);
            *(LAS f32x4*)(d + 192) = kk; *(LAS f32x4*)(d + 256) = kk * av; *(LAS f32x4*)(d + 320) = nx[4];
        };
        auto flush_y = [&](int cidx) {
            const int st = lj >> 4, r = lj & 15;
            WSP(float, WS_YRAW)[gbase + (size_t)(cidx * CH + st) * 1024 + 16 * qr + r] = ybuf[(cidx & 1) * 256 + lj];
        };
#if SCAN_SCHED == 4
        struct FS { f32x4 dec; u32x2 nb[4]; };
        FS fs[6];
        auto fetch2 = [&](int cidx, FS& f) {
            f.dec = *(const GLB f32x4*)(WSP(float, WS_DEC) + gbase + (size_t)(cidx * CH) * 1024 + lo_g);
#pragma unroll
            for (int i = 0; i < 4; ++i) { const size_t off = (i == 0) ? WS_R : (i == 1) ? WS_K : (i == 2) ? WS_AA : WS_V;
                f.nb[i] = *(const GLB u32x2*)(WSP(bf16_t, off) + gbase + (size_t)(cidx * CH) * 1024 + lo_g); }
        };
        auto put2 = [&](int cidx, FS& f) {
            LAS float* d = buf + (cidx & 1) * CHF + lo_l;
            asm volatile("" : "+v"(f.dec), "+v"(f.nb[0]), "+v"(f.nb[1]), "+v"(f.nb[2]), "+v"(f.nb[3]));
            const f32x4 rr = (f32x4){bflo(f.nb[0].x), bfhi(f.nb[0].x), bflo(f.nb[0].y), bfhi(f.nb[0].y)}, vv = (f32x4){bflo(f.nb[3].x), bfhi(f.nb[3].x), bflo(f.nb[3].y), bfhi(f.nb[3].y)};
            const f32x4 kr = (f32x4){bflo(f.nb[1].x), bfhi(f.nb[1].x), bflo(f.nb[1].y), bfhi(f.nb[1].y)}, av = (f32x4){bflo(f.nb[2].x), bfhi(f.nb[2].x), bflo(f.nb[2].y), bfhi(f.nb[2].y)};
            f32x4 kk = kr * kkw;
            const float ss = row16_sum((kk[0] * kk[0] + kk[1] * kk[1]) + (kk[2] * kk[2] + kk[3] * kk[3]));
            kk = kk * (1.0f / fmaxf(sqrtf(ss), 1e-12f));
            *(LAS f32x4*)(d) = rr; *(LAS f32x4*)(d + 64) = f.dec; *(LAS f32x4*)(d + 128) = kr * (1.0f + (av - 1.0f) * kaw);
            *(LAS f32x4*)(d + 192) = kk; *(LAS f32x4*)(d + 256) = kk * av; *(LAS f32x4*)(d + 320) = vv;
        };
        f32x4 cv[16]; MoeTile ct; ct.W = nullptr; ct.Bt = nullptr; ct.ldw = 0; ct.K = 0; ct.k0 = 0; ct.s0 = 0; ct.n0 = 0;
#pragma unroll
        for (int i = 0; i < 16; ++i) cv[i] = (f32x4){0.f, 0.f, 0.f, 0.f};
        {
            const int vit = blockIdx.x * 4 + (wave & 3);
            if (vit < 512) { const int sb = vit & 31, hd = (vit >> 5) & 1, vb = (vit >> 6) & 3;
                if ((vit >> 8) == 0) vt_tile(WSP(bf16_t, WS_VS) + ((size_t)vb * SEQ + 64 * sb) * 128 + 64 * hd, 128, WSP(bf16_t, WS_SWVT) + ((size_t)(vb * 2 + hd) * 64) * SEQ + 64 * sb, (LAS bf16_t*)scr, lane);
                else vt_tile(WSP(bf16_t, WS_VD) + ((size_t)vb * SEQ + 64 * sb) * 128 + 64 * hd, 128, WSP(bf16_t, WS_VDT) + ((size_t)vb * 128 + 64 * hd) * SEQ + 64 * sb, (LAS bf16_t*)scr, lane); }
        }
        static_assert(PER * 3 + 2 == NCH && PER % 2 == 0, "period schedule");
        const int off = (int)((blockIdx.x * 4u + (unsigned)(wave & 3)) & 1u);
        fetch2(0, fs[0]); put2(0, fs[0]); fetch2(1, fs[0]);
        SCAN5_BAR();
        int c = 0;
        for (; c < 1 + off; ++c) { put2(c + 1, fs[0]); fetch2(c + 2, fs[0]); if (c > 0) flush_y(c - 1); SCAN5_BAR(); }
#pragma unroll
        for (int i = 1; i < 6; ++i) fetch2(c + 1 + i, fs[i]);
        asm volatile("; MARK scan5 periodic begin");
        auto period = [&](int j6, bool first) {
#pragma unroll
            for (int m6 = 0; m6 < 6; ++m6) {
                asm volatile("; MARK m6 iter");
                put2(c + 1, fs[m6]); fetch2(c + 7 < NCH ? c + 7 : NCH - 1, fs[m6]); flush_y(c - 1);
                if (!MOE_CONV_IN_PROLOGUE && CONV) {
                    if (m6 == 0) { if (!first) conv_tile_finish(cv, ct.Bt, ct.K, ct.n0, ct.k0, scr, lane);
                        ct = moe_tile_desc(C, cfirst + 1024 * (2 * j6)); conv_tile_load(ct.W, ct.ldw, ct.k0, ct.s0, cv, lane); }
                    if (m6 == 3 && !first) { const MoeTile cb = moe_tile_desc(C, cfirst + 1024 * (2 * j6 - 1)); conv_tile_from_lds(cb.Bt, cb.K, cb.n0, cb.k0, scr, lane); }
                }
                SCAN5_BAR(); ++c;
            }
        };
        period(0, true);
        for (int j6 = 1; j6 < PER / 2; ++j6) period(j6, false);
        asm volatile("; MARK scan5 periodic end");
        for (; c < NCH; ++c) { flush_y(c - 1); SCAN5_BAR(); }
        if (!MOE_CONV_IN_PROLOGUE && CONV) {
            conv_tile_finish(cv, ct.Bt, ct.K, ct.n0, ct.k0, scr, lane);
            SCAN5_BAR();
            SCAN5_BAR();
            { const MoeTile cb = moe_tile_desc(C, cfirst + 1024 * (PER - 1)); conv_tile_from_lds(cb.Bt, cb.K, cb.n0, cb.k0, scr, lane); }
        }
#elif SCAN_SCHED == 3
        struct FS { f32x4 dec; u32x2 nb[4]; };
        FS fs[6];
        auto fetch2 = [&](int cidx, FS& f) {
            f.dec = *(const GLB f32x4*)(WSP(float, WS_DEC) + gbase + (size_t)(cidx * CH) * 1024 + lo_g);
#pragma unroll
            for (int i = 0; i < 4; ++i) { const size_t off = (i == 0) ? WS_R : (i == 1) ? WS_K : (i == 2) ? WS_AA : WS_V;
                f.nb[i] = *(const GLB u32x2*)(WSP(bf16_t, off) + gbase + (size_t)(cidx * CH) * 1024 + lo_g); }
        };
        auto put2 = [&](int cidx, FS& f) {
            LAS float* d = buf + (cidx & 1) * CHF + lo_l;
            asm volatile("" : "+v"(f.dec), "+v"(f.nb[0]), "+v"(f.nb[1]), "+v"(f.nb[2]), "+v"(f.nb[3]));
            const f32x4 rr = (f32x4){bflo(f.nb[0].x), bfhi(f.nb[0].x), bflo(f.nb[0].y), bfhi(f.nb[0].y)}, vv = (f32x4){bflo(f.nb[3].x), bfhi(f.nb[3].x), bflo(f.nb[3].y), bfhi(f.nb[3].y)};
            const f32x4 kr = (f32x4){bflo(f.nb[1].x), bfhi(f.nb[1].x), bflo(f.nb[1].y), bfhi(f.nb[1].y)}, av = (f32x4){bflo(f.nb[2].x), bfhi(f.nb[2].x), bflo(f.nb[2].y), bfhi(f.nb[2].y)};
            f32x4 kk = kr * kkw;
            const float ss = row16_sum((kk[0] * kk[0] + kk[1] * kk[1]) + (kk[2] * kk[2] + kk[3] * kk[3]));
            kk = kk * (1.0f / fmaxf(sqrtf(ss), 1e-12f));
            *(LAS f32x4*)(d) = rr; *(LAS f32x4*)(d + 64) = f.dec; *(LAS f32x4*)(d + 128) = kr * (1.0f + (av - 1.0f) * kaw);
            *(LAS f32x4*)(d + 192) = kk; *(LAS f32x4*)(d + 256) = kk * av; *(LAS f32x4*)(d + 320) = vv;
        };
        f32x4 cv[16]; MoeTile ct; ct.W = nullptr; ct.Bt = nullptr; ct.ldw = 0; ct.K = 0; ct.k0 = 0; ct.s0 = 0; ct.n0 = 0;
#pragma unroll
        for (int i = 0; i < 16; ++i) cv[i] = (f32x4){0.f, 0.f, 0.f, 0.f};
        {
            const int vit = blockIdx.x * 4 + (wave & 3);
            if (vit < 512) { const int sb = vit & 31, hd = (vit >> 5) & 1, vb = (vit >> 6) & 3;
                if ((vit >> 8) == 0) vt_tile(WSP(bf16_t, WS_VS) + ((size_t)vb * SEQ + 64 * sb) * 128 + 64 * hd, 128, WSP(bf16_t, WS_SWVT) + ((size_t)(vb * 2 + hd) * 64) * SEQ + 64 * sb, (LAS bf16_t*)scr, lane);
                else vt_tile(WSP(bf16_t, WS_VD) + ((size_t)vb * SEQ + 64 * sb) * 128 + 64 * hd, 128, WSP(bf16_t, WS_VDT) + ((size_t)vb * 128 + 64 * hd) * SEQ + 64 * sb, (LAS bf16_t*)scr, lane); }
        }
        static_assert(PER * 3 + 2 == NCH && PER % 2 == 0, "period schedule");
        const int off = (int)((blockIdx.x * 4u + (unsigned)(wave & 3)) & 1u);
        fetch2(0, fs[0]); put2(0, fs[0]); fetch2(1, fs[0]);
        SCAN5_BAR();
        int c = 0;
        for (; c < 1 + off; ++c) { put2(c + 1, fs[0]); fetch2(c + 2, fs[0]); if (c > 0) flush_y(c - 1); SCAN5_BAR(); }
#pragma unroll
        for (int i = 1; i < 6; ++i) fetch2(c + 1 + i, fs[i]);
        asm volatile("; MARK scan5 periodic begin");
        auto period = [&](int j6, bool first) {
#pragma unroll
            for (int m6 = 0; m6 < 6; ++m6) {
                asm volatile("; MARK m6 iter");
                put2(c + 1, fs[m6]); fetch2(c + 7 < NCH ? c + 7 : NCH - 1, fs[m6]); flush_y(c - 1);
                if (!MOE_CONV_IN_PROLOGUE && CONV && (m6 == 0 || (m6 == 3 && CONV != 5))) {
                    if (!(first && m6 == 0)) { if (CONV == 1) conv_tile_finish(cv, ct.Bt, ct.K, ct.n0, ct.k0, scr, lane);
                        else { asm volatile("" :: "v"(cv[0]), "v"(cv[1]), "v"(cv[2]), "v"(cv[3]), "v"(cv[4]), "v"(cv[5]), "v"(cv[6]), "v"(cv[7])); asm volatile("" :: "v"(cv[8]), "v"(cv[9]), "v"(cv[10]), "v"(cv[11]), "v"(cv[12]), "v"(cv[13]), "v"(cv[14]), "v"(cv[15])); } }
                    ct = moe_tile_desc(C, cfirst + 1024 * (2 * j6 + (m6 == 3 ? 1 : 0))); conv_tile_load(ct.W, ct.ldw, ct.k0, ct.s0, cv, lane);
                }
                SCAN5_BAR(); ++c;
            }
        };
        period(0, true);
        for (int j6 = 1; j6 < PER / 2; ++j6) period(j6, false);
        asm volatile("; MARK scan5 periodic end");
        for (; c < NCH; ++c) { flush_y(c - 1); SCAN5_BAR(); }
        if (!MOE_CONV_IN_PROLOGUE && CONV == 1) conv_tile_finish(cv, ct.Bt, ct.K, ct.n0, ct.k0, scr, lane);
#elif SCAN_SCHED == 2
        struct FS { f32x4 dec; u32x2 nb[4]; };
        FS fs[2];
        auto fetch2 = [&](int cidx, FS& f) {
            f.dec = *(const GLB f32x4*)(WSP(float, WS_DEC) + gbase + (size_t)(cidx * CH) * 1024 + lo_g);
#pragma unroll
            for (int i = 0; i < 4; ++i) { const size_t off = (i == 0) ? WS_R : (i == 1) ? WS_K : (i == 2) ? WS_AA : WS_V;
                f.nb[i] = *(const GLB u32x2*)(WSP(bf16_t, off) + gbase + (size_t)(cidx * CH) * 1024 + lo_g); }
        };
        auto put2 = [&](int cidx, FS& f) {
            LAS float* d = buf + (cidx & 1) * CHF + lo_l;
            asm volatile("" : "+v"(f.dec), "+v"(f.nb[0]), "+v"(f.nb[1]), "+v"(f.nb[2]), "+v"(f.nb[3]));
            const f32x4 rr = (f32x4){bflo(f.nb[0].x), bfhi(f.nb[0].x), bflo(f.nb[0].y), bfhi(f.nb[0].y)}, vv = (f32x4){bflo(f.nb[3].x), bfhi(f.nb[3].x), bflo(f.nb[3].y), bfhi(f.nb[3].y)};
            const f32x4 kr = (f32x4){bflo(f.nb[1].x), bfhi(f.nb[1].x), bflo(f.nb[1].y), bfhi(f.nb[1].y)}, av = (f32x4){bflo(f.nb[2].x), bfhi(f.nb[2].x), bflo(f.nb[2].y), bfhi(f.nb[2].y)};
            f32x4 kk = kr * kkw;
            const float ss = row16_sum((kk[0] * kk[0] + kk[1] * kk[1]) + (kk[2] * kk[2] + kk[3] * kk[3]));
            kk = kk * (1.0f / fmaxf(sqrtf(ss), 1e-12f));
            *(LAS f32x4*)(d) = rr; *(LAS f32x4*)(d + 64) = f.dec; *(LAS f32x4*)(d + 128) = kr * (1.0f + (av - 1.0f) * kaw);
            *(LAS f32x4*)(d + 192) = kk; *(LAS f32x4*)(d + 256) = kk * av; *(LAS f32x4*)(d + 320) = vv;
        };
        f32x4 cv[16]; MoeTile ct; ct.W = nullptr; ct.Bt = nullptr; ct.ldw = 0; ct.K = 0; ct.k0 = 0; ct.s0 = 0; ct.n0 = 0;
#pragma unroll
        for (int i = 0; i < 16; ++i) cv[i] = (f32x4){0.f, 0.f, 0.f, 0.f};
        {
            const int vit = blockIdx.x * 4 + (wave & 3);
            if (vit < 512) { const int sb = vit & 31, hd = (vit >> 5) & 1, vb = (vit >> 6) & 3;
                if ((vit >> 8) == 0) vt_tile(WSP(bf16_t, WS_VS) + ((size_t)vb * SEQ + 64 * sb) * 128 + 64 * hd, 128, WSP(bf16_t, WS_SWVT) + ((size_t)(vb * 2 + hd) * 64) * SEQ + 64 * sb, (LAS bf16_t*)scr, lane);
                else vt_tile(WSP(bf16_t, WS_VD) + ((size_t)vb * SEQ + 64 * sb) * 128 + 64 * hd, 128, WSP(bf16_t, WS_VDT) + ((size_t)vb * 128 + 64 * hd) * SEQ + 64 * sb, (LAS bf16_t*)scr, lane); }
        }
        static_assert(PER * 3 + 2 == NCH && PER % 2 == 0, "period schedule");
        const int off = (int)((blockIdx.x * 4u + (unsigned)(wave & 3)) & 1u);
        fetch2(0, fs[0]); put2(0, fs[0]); fetch2(1, fs[0]);
        SCAN5_BAR();
        int c = 0;
        for (; c < 1 + off; ++c) { put2(c + 1, fs[0]); fetch2(c + 2, fs[0]); if (c > 0) flush_y(c - 1); SCAN5_BAR(); }
        fetch2(c + 2, fs[1]);
        asm volatile("; MARK scan5 periodic begin");
        auto period = [&](int j6, bool first) {
#pragma unroll
            for (int m6 = 0; m6 < 6; ++m6) {
                asm volatile("; MARK m6 iter");
                put2(c + 1, fs[m6 & 1]); fetch2(c + 3 < NCH ? c + 3 : NCH - 1, fs[m6 & 1]); flush_y(c - 1);
                if (!MOE_CONV_IN_PROLOGUE && CONV && (m6 == 0 || (m6 == 3 && CONV != 5))) {
                    if (!(first && m6 == 0)) {
                        if (CONV == 1 || CONV == 4) conv_tile_finish(cv, ct.Bt, ct.K, ct.n0, ct.k0, scr, lane);
                        else if (CONV == 3) { const int cc = lane & 7;
#pragma unroll
                            for (int j = 0; j < 8; ++j) { const int n = (lane >> 3) + 8 * j; u32x4 o; o.x = pk2(cv[2 * j][0], cv[2 * j][1]); o.y = pk2(cv[2 * j][2], cv[2 * j][3]); o.z = pk2(cv[2 * j + 1][0], cv[2 * j + 1][1]); o.w = pk2(cv[2 * j + 1][2], cv[2 * j + 1][3]);
                                *(GLB u32x4*)(ct.Bt + (size_t)(ct.n0 + n) * ct.K + ct.k0 + 8 * cc) = o; } }
                        else { asm volatile("" :: "v"(cv[0]), "v"(cv[1]), "v"(cv[2]), "v"(cv[3]), "v"(cv[4]), "v"(cv[5]), "v"(cv[6]), "v"(cv[7])); asm volatile("" :: "v"(cv[8]), "v"(cv[9]), "v"(cv[10]), "v"(cv[11]), "v"(cv[12]), "v"(cv[13]), "v"(cv[14]), "v"(cv[15])); }
                    }
                    ct = moe_tile_desc(C, cfirst + 1024 * (2 * j6 + (m6 == 3 ? 1 : 0))); conv_tile_load(ct.W, ct.ldw, ct.k0, ct.s0, cv, lane);
                }
                SCAN5_BAR(); ++c;
            }
        };
        period(0, true);
        for (int j6 = 1; j6 < PER / 2; ++j6) period(j6, false);
        asm volatile("; MARK scan5 periodic end");
        for (; c < NCH; ++c) { flush_y(c - 1); SCAN5_BAR(); }
        if (!MOE_CONV_IN_PROLOGUE && (CONV == 1 || CONV == 4)) conv_tile_finish(cv, ct.Bt, ct.K, ct.n0, ct.k0, scr, lane);
#elif SCAN_SCHED == 1
        f32x4 cv[16]; MoeTile ct; ct.W = nullptr; ct.Bt = nullptr; ct.ldw = 0; ct.K = 0; ct.k0 = 0; ct.s0 = 0; ct.n0 = 0;
#pragma unroll
        for (int i = 0; i < 16; ++i) cv[i] = (f32x4){0.f, 0.f, 0.f, 0.f};
        {
            const int vit = blockIdx.x * 4 + (wave & 3);
            if (vit < 512) { const int sb = vit & 31, hd = (vit >> 5) & 1, vb = (vit >> 6) & 3;
                if ((vit >> 8) == 0) vt_tile(WSP(bf16_t, WS_VS) + ((size_t)vb * SEQ + 64 * sb) * 128 + 64 * hd, 128, WSP(bf16_t, WS_SWVT) + ((size_t)(vb * 2 + hd) * 64) * SEQ + 64 * sb, (LAS bf16_t*)scr, lane);
                else vt_tile(WSP(bf16_t, WS_VD) + ((size_t)vb * SEQ + 64 * sb) * 128 + 64 * hd, 128, WSP(bf16_t, WS_VDT) + ((size_t)vb * 128 + 64 * hd) * SEQ + 64 * sb, (LAS bf16_t*)scr, lane); }
        }
        static_assert(PER * 3 + 2 == NCH && PER % 2 == 0, "period schedule");
        const int off = (int)((blockIdx.x * 4u + (unsigned)(wave & 3)) & 1u);
        auto plain = [&](int c) { if (c + 1 < NCH) put_chunk(c + 1); if (c + 2 < NCH) fetch_chunk(c + 2); if (c > 0) flush_y(c - 1); };
        auto plain_nc = [&](int c) { put_chunk(c + 1); fetch_chunk(c + 2 < NCH ? c + 2 : NCH - 1); flush_y(c - 1); };
        fetch_chunk(0); put_chunk(0); fetch_chunk(1);
        SCAN5_BAR();
        int c = 0;
        for (; c < 1 + off; ++c) { plain(c); SCAN5_BAR(); }
        asm volatile("; MARK scan5 periodic begin");
        auto period = [&](int j6) {
#pragma unroll
            for (int m6 = 0; m6 < 6; ++m6) {
                asm volatile("; MARK m6 iter");
                plain_nc(c);
                if (!MOE_CONV_IN_PROLOGUE && CONV) {
                    if (m6 == 0 || m6 == 3) { ct = moe_tile_desc(C, cfirst + 1024 * (2 * j6 + (m6 == 3 ? 1 : 0))); conv_tile_load(ct.W, ct.ldw, ct.k0, ct.s0, cv, lane); }
                    if (m6 == 2 || m6 == 5) conv_tile_finish(cv, ct.Bt, ct.K, ct.n0, ct.k0, scr, lane);
                }
                SCAN5_BAR(); ++c;
            }
        };
        period(0);
        for (int j6 = 1; j6 < PER / 2; ++j6) period(j6);
        asm volatile("; MARK scan5 periodic end");
        for (; c < NCH; ++c) { plain(c); SCAN5_BAR(); }
#else
        f32x4 cv[16], cv2[16]; MoeTile ct; ct.W = nullptr; ct.Bt = nullptr; ct.ldw = 0; ct.K = 0; ct.k0 = 0; ct.s0 = 0; ct.n0 = 0; MoeTile ct2 = ct;
#pragma unroll
        for (int i = 0; i < 16; ++i) { cv[i] = (f32x4){0.f, 0.f, 0.f, 0.f}; cv2[i] = cv[i]; }
        {
            const int vit = blockIdx.x * 4 + (wave & 3);
            if (vit < 512) { const int sb = vit & 31, hd = (vit >> 5) & 1, vb = (vit >> 6) & 3;
                if ((vit >> 8) == 0) vt_tile(WSP(bf16_t, WS_VS) + ((size_t)vb * SEQ + 64 * sb) * 128 + 64 * hd, 128, WSP(bf16_t, WS_SWVT) + ((size_t)(vb * 2 + hd) * 64) * SEQ + 64 * sb, (LAS bf16_t*)scr, lane);
                else vt_tile(WSP(bf16_t, WS_VD) + ((size_t)vb * SEQ + 64 * sb) * 128 + 64 * hd, 128, WSP(bf16_t, WS_VDT) + ((size_t)vb * 128 + 64 * hd) * SEQ + 64 * sb, (LAS bf16_t*)scr, lane); }
        }
        fetch_chunk(0); put_chunk(0); fetch_chunk(1);
        SCAN5_BAR();
        for (int cidx = 0; cidx < NCH; ++cidx) {
            if (cidx + 1 < NCH) put_chunk(cidx + 1);
            if (cidx + 2 < NCH) fetch_chunk(cidx + 2);
            if (cidx > 0) flush_y(cidx - 1);
            if (!MOE_CONV_IN_PROLOGUE) {
                const int j6 = cidx / 6, m6 = cidx - 6 * j6;
                if (m6 == 0 && 2 * j6 < PER) { ct = moe_tile_desc(C, cfirst + 1024 * (2 * j6)); conv_tile_load(ct.W, ct.ldw, ct.k0, ct.s0, cv, lane); }
                else if (m6 == 4 && 2 * j6 < PER) conv_tile_finish(cv, ct.Bt, ct.K, ct.n0, ct.k0, scr, lane);
                else if (m6 == 3 && 2 * j6 + 1 < PER) { ct2 = moe_tile_desc(C, cfirst + 1024 * (2 * j6 + 1)); conv_tile_load(ct2.W, ct2.ldw, ct2.k0, ct2.s0, cv2, lane); }
                else if (m6 == 1 && j6 >= 1 && 2 * j6 - 1 < PER) conv_tile_finish(cv2, ct2.Bt, ct2.K, ct2.n0, ct2.k0, scr, lane);
            }
            SCAN5_BAR();
        }
#endif
        flush_y(NCH - 1);
    } else {
        const int ro = lane >> 4, kq = lane & 15, rloc = 4 * wave + ro;
        f32x2 Sa = {0.f, 0.f}, Sb = {0.f, 0.f};
        constexpr bool CONVB = SCAN_SCHED == 4 && CONV == 1 && !MOE_CONV_IN_PROLOGUE;
        f32x4 cvB[16];
#pragma unroll
        for (int i = 0; i < 16; ++i) cvB[i] = (f32x4){0.f, 0.f, 0.f, 0.f};
        LAS float* scrp = (LAS float*)(C.lds + 65536 + wave * 16640);
        const int cfirstc = l * (1024 * MOE_SCAN_TILES) + (blockIdx.x * 4 + wave);
        int bj = 0, bnext = 2 + (int)((blockIdx.x * 4u + (unsigned)wave) & 1u);
        SCAN5_BAR();
        for (int cidx = 0; cidx < NCH; ++cidx) {
            if (CONVB && cidx == bnext) {
                if (bj >= 1) conv_tile_to_lds(cvB, scrp, lane);
                if (bj < MOE_SCAN_TILES / 2) { const MoeTile tb = moe_tile_desc(C, cfirstc + 1024 * (2 * bj + 1)); conv_tile_load(tb.W, tb.ldw, tb.k0, tb.s0, cvB, lane); }
                ++bj; bnext += 6;
            }
            const LAS float* cb = buf + (cidx & 1) * CHF + 4 * kq;
            const LAS float* vb = buf + (cidx & 1) * CHF + 320 + 16 * qr + rloc;
            float ykeep = 0.f;
            f32x4 kk4 = *(const LAS f32x4*)(cb + 192), w4 = *(const LAS f32x4*)(cb + 64), b4 = *(const LAS f32x4*)(cb + 256), k4 = *(const LAS f32x4*)(cb + 128), r4 = *(const LAS f32x4*)(cb);
            float vv = vb[0];
#pragma unroll
            for (int st = 0; st < CH; ++st) {
                f32x4 kk4n = kk4, w4n = w4, b4n = b4, k4n = k4, r4n = r4; float vvn = vv;
                if (st + 1 < CH) { const LAS float* nb = cb + (st + 1) * 384;
                    kk4n = *(const LAS f32x4*)(nb + 192); w4n = *(const LAS f32x4*)(nb + 64); b4n = *(const LAS f32x4*)(nb + 256); k4n = *(const LAS f32x4*)(nb + 128); r4n = *(const LAS f32x4*)(nb); vvn = vb[(st + 1) * 384]; }
                const f32x2 tp = Sa * (f32x2){kk4[0], kk4[1]} + Sb * (f32x2){kk4[2], kk4[3]};
                const float p = row16_sum(tp[0] + tp[1]);
                const f32x2 pp = {p, p}, vv2 = {vv, vv};
                Sa = Sa * (f32x2){w4[0], w4[1]} - pp * (f32x2){b4[0], b4[1]} + vv2 * (f32x2){k4[0], k4[1]};
                Sb = Sb * (f32x2){w4[2], w4[3]} - pp * (f32x2){b4[2], b4[3]} + vv2 * (f32x2){k4[2], k4[3]};
                const f32x2 ty = Sa * (f32x2){r4[0], r4[1]} + Sb * (f32x2){r4[2], r4[3]};
                const float y = row16_sum(ty[0] + ty[1]);
                ykeep = (kq == st) ? y : ykeep;
                kk4 = kk4n; w4 = w4n; b4 = b4n; k4 = k4n; r4 = r4n; vv = vvn;
            }
            ybuf[(cidx & 1) * 256 + kq * 16 + rloc] = ykeep;
            SCAN5_BAR();
        }
        if (CONVB) { SCAN5_BAR(); conv_tile_to_lds(cvB, scrp, lane); SCAN5_BAR(); }
    }
#undef SCAN5_BAR
}
struct Args { const void* in[N_INPUTS]; float* out; unsigned char* ws; int ph_lo, ph_hi; };
static_assert(sizeof(Args) == N_INPUTS * 8 + 24, "Args has no padding");

constexpr int N_PHASES = 2 + 12 + 14;

#ifndef USE_FAST
#define USE_FAST 271
#endif
#ifndef PROBE_CONV
#define PROBE_CONV 3
#endif
#ifndef PROBE_MASK
#define PROBE_MASK 0
#endif
#ifndef DBG_SKIP_MASK
#define DBG_SKIP_MASK 0
#endif

__global__ void __launch_bounds__(NTHR, 2) fwd_kernel(Args args) {
    extern __shared__ __attribute__((aligned(16))) unsigned char lds_raw[];
    LAS unsigned char* const lds = (LAS unsigned char*)lds_raw;
    {
        const int tid0 = threadIdx.x;
        volatile LAS unsigned* MISC0 = (volatile LAS unsigned*)(lds + MISC_OFF);
        for (int u = tid0; u < (LDS_BYTES - MISC_OFF) / 4; u += NTHR) MISC0[u] = 0u;
        __syncthreads();
        LAS unsigned long long* tab = (LAS unsigned long long*)(lds + INTAB_OFF);
        if (tid0 < N_INPUTS) tab[tid0] = (unsigned long long)args.in[tid0];
        if (tid0 == 64) { tab[TAB_WS] = (unsigned long long)args.ws; tab[TAB_OUT] = (unsigned long long)args.out;
            tab[TAB_RANGE] = ((unsigned long long)(unsigned)args.ph_hi << 32) | (unsigned)args.ph_lo; }
        __syncthreads();
        if (args.ph_hi - args.ph_lo > 1) (void)xcd_barrier_post((unsigned*)(args.ws + WS_CTL) + CW_BAR, MISC0 + 8);
    }
    LAS unsigned char* ring = lds;
    int ph = 0;
#define PH_BEGIN { const int lo = (int)__builtin_amdgcn_readfirstlane(((const LAS unsigned*)(lds + INTAB_OFF))[2 * TAB_RANGE]), hi = (int)__builtin_amdgcn_readfirstlane(((const LAS unsigned*)(lds + INTAB_OFF))[2 * TAB_RANGE + 1]); \
    if (ph >= lo && ph < hi) { const Ctx C = make_ctx(lds);
#define PH_END if (ph + 1 < hi) { XcdBarrier bar; bar.bar = (unsigned*)WSP(unsigned, WS_CTL) + CW_BAR; bar.x = xb_xcc_id(); bar.st = (volatile LAS unsigned*)(lds + MISC_OFF) + 8; xcd_barrier(bar); } \
    else { VM_WAIT(); __syncthreads(); } } } ++ph;
#define REP(g, ...) { GLB float* XOUT = C.out; (void)XOUT; __VA_ARGS__ } if (PROBE_MASK & (g)) { GLB float* XOUT = WSP(float, WS_SC); (void)XOUT; __VA_ARGS__ }

    PH_BEGIN REP(1,  ph_prologue(C); ph_norm<0, false>(C, INF32(I_X), nullptr, INF32(I_MIXN), nullptr); ) PH_END
    PH_BEGIN REP(256,  { pg8::Gemm g{WSP(bf16_t, WS_PCAT), WSP(bf16_t, WS_WPP), 512, 256}; pg8::ProjOrder S; S.init(C.G, (int)blockIdx.x); pg8::EpiProj E{WSP(bf16_t, WS_PROJ)};
        pg8::gemm_phase<pg8::EpiProj, pg8::ProjOrder>(ring, g, S, E); } ) PH_END

    { constexpr int l = 0;
        if (l > 0) { PH_BEGIN REP(32768,  ph_norm<0>(C, WSP(bf16_t, WS_XB), nullptr, INF32(I_MIXN) + l * D, nullptr); ) PH_END }
        PH_BEGIN REP(4096,  { pg8::Gemm g{WSP(bf16_t, WS_H), WSP(bf16_t, WS_WIN + l * SZ_WIN1), D, D}; pg8::StaticOrder S; S.init(T, N_INP, C.G, (int)blockIdx.x);
            pg8::EpiWin E{WSP(bf16_t, WS_SBQKV), WSP(bf16_t, WS_UF), WSP(bf16_t, WS_GATE)};
            pg8::gemm_phase<pg8::EpiWin, pg8::StaticOrder>(ring, g, S, E); } ) PH_END
        PH_BEGIN REP(16384,  ph_prep(C, l); ph_vt(C); ph_latent(C, l); ) PH_END
        PH_BEGIN REP(256,  { pg8::Gemm g{WSP(bf16_t, WS_ALORA), WSP(bf16_t, WS_WLORA + l * SZ_WLORA1), 256, 256}; pg8::StaticOrder S; S.init(T, 3072, C.G, (int)blockIdx.x);
            pg8::EpiLora E{WSP(float, WS_DEC), WSP(bf16_t, WS_AA), WSP(bf16_t, WS_GG), INF32(I_RWW0) + l * 1024, INF32(I_RWA0) + l * 1024};
            pg8::gemm_phase<pg8::EpiLora, pg8::StaticOrder>(ring, g, S, E); } ) PH_END
        PH_BEGIN REP(32,  if (!(DBG_SKIP_MASK & 2)) { if (USE_FAST & 256) { ph_rwkv_scan5<1>(C, l); if (PROBE_MASK & 2097152) ph_rwkv_scan5<0>(C, l); if ((PROBE_MASK & 4194304) && l == 0) ph_rwkv_scan5<PROBE_CONV>(C, l); } else if (USE_FAST & 128) ph_rwkv_scan4(C, l); else if (USE_FAST & 64) ph_rwkv_scan3(C, l); else if (USE_FAST & 32) ph_rwkv_scan_conv(C, l); else if (USE_FAST & 2) ph_rwkv_scan_fast(C); else ph_rwkv_scan_naive(C); } ) PH_END
        PH_BEGIN REP(8,  ph_sb_fast(C); ) REP(64,  ph_dsa_fast(C, l); ) REP(128,  ph_swa_fast(C, l); ) REP(65536,  ph_rwkv_post(C, l); ) PH_END
        PH_BEGIN REP(512,  { pg8::Gemm g{WSP(bf16_t, WS_Y), WSP(bf16_t, WS_WBR + l * SZ_WBR1), 4096, 1024}; pg8::BranchOrder S; S.init(C.G, (int)blockIdx.x);
            pg8::EpiBranch E{WSP(bf16_t, WS_GATE), WSP(bf16_t, WS_G)};
            pg8::gemm_phase<pg8::EpiBranch, pg8::BranchOrder>(ring, g, S, E); } ) PH_END
        PH_BEGIN { pg8::Gemm g{WSP(bf16_t, WS_G), WSP(bf16_t, WS_WOUT + l * SZ_DD), D, D}; pg8::StaticOrder S; S.init(T, D, C.G, (int)blockIdx.x);
            if (l == 0) { pg8::EpiResid<false, true> E{INF32(I_X), WSP(bf16_t, WS_XB)}; pg8::gemm_phase<pg8::EpiResid<false, true>, pg8::StaticOrder>(ring, g, S, E); }
            else { pg8::EpiResid<true, true> E{WSP(bf16_t, WS_XB), WSP(bf16_t, WS_XB)}; pg8::gemm_phase<pg8::EpiResid<true, true>, pg8::StaticOrder>(ring, g, S, E); } } PH_END
        PH_BEGIN if (l == 0) ph_norm<0>(C, WSP(bf16_t, WS_XB), nullptr, INF32(I_FFNN) + l * D, nullptr); else ph_norm<1>(C, WSP(bf16_t, WS_XB), nullptr, INF32(I_FFNN) + l * D, INF32(I_MR)); PH_END
        if (l == 0) {
            PH_BEGIN REP(2,  { pg8::Gemm g{WSP(bf16_t, WS_H), WSP(bf16_t, WS_WGU), D, D}; pg8::StaticOrder S; S.init(T, 2 * FF, C.G, (int)blockIdx.x); pg8::EpiUp E{WSP(bf16_t, WS_ACT)};
                pg8::gemm_phase<pg8::EpiUp, pg8::StaticOrder>(ring, g, S, E); } ) PH_END
            PH_BEGIN REP(2048,  { pg8::Gemm g{WSP(bf16_t, WS_ACT), WSP(bf16_t, WS_WD), FF, FF}; pg8::StaticOrder S; S.init(T, D, C.G, (int)blockIdx.x); pg8::EpiResid<true, true> E{WSP(bf16_t, WS_XB), WSP(bf16_t, WS_XB)};
                pg8::gemm_phase<pg8::EpiResid<true, true>, pg8::StaticOrder>(ring, g, S, E); } ) PH_END
            PH_BEGIN REP(32768,  ph_norm<0>(C, WSP(bf16_t, WS_XB), nullptr, INF32(I_PLEN) + l * D, nullptr); ) PH_END
        } else {
            PH_BEGIN REP(131072,  ph_moe_gather(C); ) PH_END
            PH_BEGIN REP(8192,  { moe_tile_table(C); pg8::MoeOrder S; S.tab = (const LAS int*)(C.lds + MOETAB_OFF); S.NT = __builtin_amdgcn_readfirstlane(S.tab[MOE_MAXRT]); S.nct = NCT_UP; S.G = C.G; S.c = (int)blockIdx.x;
                pg8::Gemm g{WSP(bf16_t, WS_HS), WSP(bf16_t, WS_MWGU), D, D}; pg8::EpiUp E{WSP(bf16_t, WS_ACTS)};
                pg8::gemm_phase<pg8::EpiUp, pg8::MoeOrder>(ring, g, S, E); } ) PH_END
            PH_BEGIN REP(2048,  { moe_tile_table(C); const LAS int* mtab = (const LAS int*)(C.lds + MOETAB_OFF);
                pg8::MoeDownOrder S; S.init(mtab, __builtin_amdgcn_readfirstlane(mtab[MOE_MAXRT]), C.G, (int)blockIdx.x);
                pg8::Gemm g{WSP(bf16_t, WS_ACTS), WSP(bf16_t, WS_MWD), FF, FF}; pg8::EpiMoeDown E{WSP(bf16_t, WS_OS), WSP(float, WS_WSLOT), WSP(float, WS_OSP), S.S};
                pg8::gemm_phase<pg8::EpiMoeDown, pg8::MoeDownOrder>(ring, g, S, E); } ) PH_END
            PH_BEGIN REP(16,  { int toff[NE + 1]; moe_offsets(C, toff); pg8::MoeDownOrder S; S.init(nullptr, toff[NE], C.G, 0); ph_norm<2>(C, WSP(bf16_t, WS_XB), WSP(bf16_t, WS_XB), INF32(I_PLEN) + l * D, nullptr, S.S); } ) PH_END
        }
        PH_BEGIN REP(262144,  { pg8::Gemm g{WSP(bf16_t, WS_H), WSP(bf16_t, WS_WPG + l * SZ_DD), D, D}; pg8::StaticOrder S; S.init(T, D, C.G, (int)blockIdx.x);
            if (l == NL - 1) { pg8::EpiPle<false> E{WSP(bf16_t, WS_XB), C.out, WSP(bf16_t, WS_PROJ) + (size_t)l * T * D}; pg8::gemm_phase<pg8::EpiPle<false>, pg8::StaticOrder>(ring, g, S, E); }
            else { pg8::EpiPle<true> E{WSP(bf16_t, WS_XB), WSP(bf16_t, WS_XB), WSP(bf16_t, WS_PROJ) + (size_t)l * T * D}; pg8::gemm_phase<pg8::EpiPle<true>, pg8::StaticOrder>(ring, g, S, E); } } ) PH_END
    }
    { constexpr int l = 1;
        if (l > 0) { PH_BEGIN REP(32768,  ph_norm<0>(C, WSP(bf16_t, WS_XB), nullptr, INF32(I_MIXN) + l * D, nullptr); ) PH_END }
        PH_BEGIN REP(4096,  { pg8::Gemm g{WSP(bf16_t, WS_H), WSP(bf16_t, WS_WIN + l * SZ_WIN1), D, D}; pg8::StaticOrder S; S.init(T, N_INP, C.G, (int)blockIdx.x);
            pg8::EpiWin E{WSP(bf16_t, WS_SBQKV), WSP(bf16_t, WS_UF), WSP(bf16_t, WS_GATE)};
            pg8::gemm_phase<pg8::EpiWin, pg8::StaticOrder>(ring, g, S, E); } ) PH_END
        PH_BEGIN REP(16384,  ph_prep(C, l); ph_vt(C); ph_latent(C, l); ) PH_END
        PH_BEGIN REP(256,  { pg8::Gemm g{WSP(bf16_t, WS_ALORA), WSP(bf16_t, WS_WLORA + l * SZ_WLORA1), 256, 256}; pg8::StaticOrder S; S.init(T, 3072, C.G, (int)blockIdx.x);
            pg8::EpiLora E{WSP(float, WS_DEC), WSP(bf16_t, WS_AA), WSP(bf16_t, WS_GG), INF32(I_RWW0) + l * 1024, INF32(I_RWA0) + l * 1024};
            pg8::gemm_phase<pg8::EpiLora, pg8::StaticOrder>(ring, g, S, E); } ) PH_END
        PH_BEGIN REP(32,  if (!(DBG_SKIP_MASK & 2)) { if (USE_FAST & 256) { ph_rwkv_scan5<1>(C, l); if (PROBE_MASK & 2097152) ph_rwkv_scan5<0>(C, l); if ((PROBE_MASK & 4194304) && l == 0) ph_rwkv_scan5<PROBE_CONV>(C, l); } else if (USE_FAST & 128) ph_rwkv_scan4(C, l); else if (USE_FAST & 64) ph_rwkv_scan3(C, l); else if (USE_FAST & 32) ph_rwkv_scan_conv(C, l); else if (USE_FAST & 2) ph_rwkv_scan_fast(C); else ph_rwkv_scan_naive(C); } ) PH_END
        PH_BEGIN REP(8,  ph_sb_fast(C); ) REP(64,  ph_dsa_fast(C, l); ) REP(128,  ph_swa_fast(C, l); ) REP(65536,  ph_rwkv_post(C, l); ) PH_END
        PH_BEGIN REP(512,  { pg8::Gemm g{WSP(bf16_t, WS_Y), WSP(bf16_t, WS_WBR + l * SZ_WBR1), 4096, 1024}; pg8::BranchOrder S; S.init(C.G, (int)blockIdx.x);
            pg8::EpiBranch E{WSP(bf16_t, WS_GATE), WSP(bf16_t, WS_G)};
            pg8::gemm_phase<pg8::EpiBranch, pg8::BranchOrder>(ring, g, S, E); } ) PH_END
        PH_BEGIN { pg8::Gemm g{WSP(bf16_t, WS_G), WSP(bf16_t, WS_WOUT + l * SZ_DD), D, D}; pg8::StaticOrder S; S.init(T, D, C.G, (int)blockIdx.x);
            if (l == 0) { pg8::EpiResid<false, true> E{INF32(I_X), WSP(bf16_t, WS_XB)}; pg8::gemm_phase<pg8::EpiResid<false, true>, pg8::StaticOrder>(ring, g, S, E); }
            else { pg8::EpiResid<true, true> E{WSP(bf16_t, WS_XB), WSP(bf16_t, WS_XB)}; pg8::gemm_phase<pg8::EpiResid<true, true>, pg8::StaticOrder>(ring, g, S, E); } } PH_END
        PH_BEGIN if (l == 0) ph_norm<0>(C, WSP(bf16_t, WS_XB), nullptr, INF32(I_FFNN) + l * D, nullptr); else ph_norm<1>(C, WSP(bf16_t, WS_XB), nullptr, INF32(I_FFNN) + l * D, INF32(I_MR)); PH_END
        if (l == 0) {
            PH_BEGIN REP(2,  { pg8::Gemm g{WSP(bf16_t, WS_H), WSP(bf16_t, WS_WGU), D, D}; pg8::StaticOrder S; S.init(T, 2 * FF, C.G, (int)blockIdx.x); pg8::EpiUp E{WSP(bf16_t, WS_ACT)};
                pg8::gemm_phase<pg8::EpiUp, pg8::StaticOrder>(ring, g, S, E); } ) PH_END
            PH_BEGIN REP(2048,  { pg8::Gemm g{WSP(bf16_t, WS_ACT), WSP(bf16_t, WS_WD), FF, FF}; pg8::StaticOrder S; S.init(T, D, C.G, (int)blockIdx.x); pg8::EpiResid<true, true> E{WSP(bf16_t, WS_XB), WSP(bf16_t, WS_XB)};
                pg8::gemm_phase<pg8::EpiResid<true, true>, pg8::StaticOrder>(ring, g, S, E); } ) PH_END
            PH_BEGIN REP(32768,  ph_norm<0>(C, WSP(bf16_t, WS_XB), nullptr, INF32(I_PLEN) + l * D, nullptr); ) PH_END
        } else {
            PH_BEGIN REP(131072,  ph_moe_gather(C); ) PH_END
            PH_BEGIN REP(8192,  { moe_tile_table(C); pg8::MoeOrder S; S.tab = (const LAS int*)(C.lds + MOETAB_OFF); S.NT = __builtin_amdgcn_readfirstlane(S.tab[MOE_MAXRT]); S.nct = NCT_UP; S.G = C.G; S.c = (int)blockIdx.x;
                pg8::Gemm g{WSP(bf16_t, WS_HS), WSP(bf16_t, WS_MWGU), D, D}; pg8::EpiUp E{WSP(bf16_t, WS_ACTS)};
                pg8::gemm_phase<pg8::EpiUp, pg8::MoeOrder>(ring, g, S, E); } ) PH_END
            PH_BEGIN REP(2048,  { moe_tile_table(C); const LAS int* mtab = (const LAS int*)(C.lds + MOETAB_OFF);
                pg8::MoeDownOrder S; S.init(mtab, __builtin_amdgcn_readfirstlane(mtab[MOE_MAXRT]), C.G, (int)blockIdx.x);
                pg8::Gemm g{WSP(bf16_t, WS_ACTS), WSP(bf16_t, WS_MWD), FF, FF}; pg8::EpiMoeDown E{WSP(bf16_t, WS_OS), WSP(float, WS_WSLOT), WSP(float, WS_OSP), S.S};
                pg8::gemm_phase<pg8::EpiMoeDown, pg8::MoeDownOrder>(ring, g, S, E); } ) PH_END
            PH_BEGIN REP(16,  { int toff[NE + 1]; moe_offsets(C, toff); pg8::MoeDownOrder S; S.init(nullptr, toff[NE], C.G, 0); ph_norm<2>(C, WSP(bf16_t, WS_XB), WSP(bf16_t, WS_XB), INF32(I_PLEN) + l * D, nullptr, S.S); } ) PH_END
        }
        PH_BEGIN REP(262144,  { pg8::Gemm g{WSP(bf16_t, WS_H), WSP(bf16_t, WS_WPG + l * SZ_DD), D, D}; pg8::StaticOrder S; S.init(T, D, C.G, (int)blockIdx.x);
            if (l == NL - 1) { pg8::EpiPle<false> E{WSP(bf16_t, WS_XB), C.out, WSP(bf16_t, WS_PROJ) + (size_t)l * T * D}; pg8::gemm_phase<pg8::EpiPle<false>, pg8::StaticOrder>(ring, g, S, E); }
            else { pg8::EpiPle<true> E{WSP(bf16_t, WS_XB), WSP(bf16_t, WS_XB), WSP(bf16_t, WS_PROJ) + (size_t)l * T * D}; pg8::gemm_phase<pg8::EpiPle<true>, pg8::StaticOrder>(ring, g, S, E); } } ) PH_END
    }
#undef PH_BEGIN
#undef PH_END
}

#ifndef MK_ONE_LAUNCH
#define MK_ONE_LAUNCH 0
#endif
extern "C" void kernel_launch(void* const* d_in, const int* in_sizes, int n_in, void* d_out, int out_size, void* d_ws, size_t ws_size, hipStream_t stream) {
    static int grid = 0;
    if (grid == 0) {
        if (n_in != N_INPUTS || out_size != T * D || ws_size < WS_END3) { fprintf(stderr, "kernel_launch: unexpected problem (n_in %d, out %d, ws %zu < %zu)\n", n_in, out_size, ws_size, (size_t)WS_END3); grid = -1; return; }
        int dev = 0, cus = 0, per_cu = 0;
        if (hipGetDevice(&dev) != hipSuccess || hipDeviceGetAttribute(&cus, hipDeviceAttributeMultiprocessorCount, dev) != hipSuccess) { grid = -1; return; }
        if (hipFuncSetAttribute((const void*)fwd_kernel, hipFuncAttributeMaxDynamicSharedMemorySize, LDS_BYTES) != hipSuccess) { fprintf(stderr, "kernel_launch: hipFuncSetAttribute failed\n"); grid = -1; return; }
        if (hipOccupancyMaxActiveBlocksPerMultiprocessor(&per_cu, (const void*)fwd_kernel, NTHR, LDS_BYTES) != hipSuccess || per_cu < 1) fprintf(stderr, "kernel_launch: occupancy query reports %d\n", per_cu);
        (void)hipGetLastError();
        grid = cus;
    }
    if (grid < 0) return;
    (void)hipMemsetAsync((char*)d_ws + WS_CTL, 0, CTL_BYTES, stream);
    Args a{};
    for (int i = 0; i < N_INPUTS; ++i) a.in[i] = d_in[i];
    a.out = (float*)d_out; a.ws = (unsigned char*)d_ws;
#if MK_ONE_LAUNCH
    a.ph_lo = 0; a.ph_hi = N_PHASES;
    hipLaunchKernelGGL(fwd_kernel, dim3(grid), dim3(NTHR), LDS_BYTES, stream, a);
#else
    for (int p = 0; p < N_PHASES; ++p) { a.ph_lo = p; a.ph_hi = p + 1; hipLaunchKernelGGL(fwd_kernel, dim3(grid), dim3(NTHR), LDS_BYTES, stream, a); }
#endif
}
```
